# Optimizing an MI355X kernel written in HIP

```python
import math
import jax, jax.numpy as jnp
from jax import lax
import numpy as np

D_MODEL = 1024
BATCH = 16
SEQ = 2048
DEPTH = 1

N_META = 16
GRID_W = 64
Q_BLOCK = 128
ROPE_THETA = 10000.0

MLA_HEADS = 4
Q_LORA = 256
KV_LORA = 128
NOPE_DIM = 128
ROPE_DIM = 64
V_DIM = 128
QK_DIM = NOPE_DIM + ROPE_DIM

GQA_HEADS = 4
GQA_KV_HEADS = 2
GQA_DIM = 128
AXIAL_HALF = GQA_DIM // 2

MLA_WIDTH = MLA_HEADS * V_DIM
GQA_WIDTH = GQA_HEADS * GQA_DIM
MIX_WIDTH = MLA_WIDTH + GQA_WIDTH

IN_SPLITS = (Q_LORA, KV_LORA, ROPE_DIM, GQA_HEADS * GQA_DIM, GQA_KV_HEADS * GQA_DIM, GQA_KV_HEADS * GQA_DIM)
IN_COLS = sum(IN_SPLITS)
IN_OFFSETS = tuple(int(o) for o in np.cumsum(IN_SPLITS)[:-1])

N_EXPERTS = 32
TOP_K = 4
D_FF = D_MODEL
SWIGLU_LIMIT = 7.0
SWIGLU_ALPHA = 1.702

RMS_EPS = 1e-6
LN_EPS = 1e-5
DEEPNORM_ALPHA = (2.0 * DEPTH) ** 0.25
DEEPNORM_BETA = (8.0 * DEPTH) ** -0.25

kernel_name = 'hymba_mla_axialgqa_moe_deepnorm_encoder'


def _rmsnorm(x, g):
    xf = x.astype(jnp.float32)
    y = xf * lax.rsqrt(jnp.mean(xf * xf, axis=-1, keepdims=True) + RMS_EPS)
    return (y * g.astype(jnp.float32)).astype(x.dtype)


def _layernorm(x, g, b):
    xf = x.astype(jnp.float32)
    mu = jnp.mean(xf, axis=-1, keepdims=True)
    var = jnp.mean(jnp.square(xf - mu), axis=-1, keepdims=True)
    y = (xf - mu) * lax.rsqrt(var + LN_EPS)
    return (y * g.astype(jnp.float32) + b.astype(jnp.float32)).astype(x.dtype)


def _rope_cos_sin(pos, dim):
    inv = ROPE_THETA ** (-jnp.arange(0, dim, 2, dtype=jnp.float32) / dim)
    ang = pos.astype(jnp.float32)[:, None] * inv[None, :]
    return jnp.cos(ang)[:, None, :], jnp.sin(ang)[:, None, :]


def _rotate(x, cos, sin):
    xf = x.astype(jnp.float32)
    x1, x2 = jnp.split(xf, 2, axis=-1)
    return jnp.concatenate([x1 * cos - x2 * sin, x1 * sin + x2 * cos], axis=-1).astype(x.dtype)


def _attend(q, k, v, scale):
    s = jnp.einsum('bqkgd,bskd->bkgqs', q, k).astype(jnp.float32) * scale
    p = jax.nn.softmax(s, axis=-1).astype(v.dtype)
    return jnp.einsum('bkgqs,bskd->bqkgd', p, v)


def _blocked_attention(q, k, v, scale):
    B, L, H, Dq = q.shape
    Hk = k.shape[2]
    G = H // Hk
    Dv = v.shape[-1]
    q = q.reshape(B, L, Hk, G, Dq)
    o_meta = _attend(q[:, :N_META], k, v, scale)
    n_blk = (L - N_META) // Q_BLOCK
    qb = q[:, N_META:].reshape(B, n_blk, Q_BLOCK, Hk, G, Dq).transpose(1, 0, 2, 3, 4, 5)
    ob = lax.map(lambda qi: _attend(qi, k, v, scale), qb)
    ob = ob.transpose(1, 0, 2, 3, 4, 5).reshape(B, L - N_META, Hk, G, Dv)
    return jnp.concatenate([o_meta, ob], axis=1).reshape(B, L, H, Dv)


def _mixer(h, pos_1d, row, col, w_in, g_q_a, w_q_b, g_kv_a, w_kv_b, g_q_gqa, g_k_gqa, g_o_mla, g_o_gqa, w_o):
    B, L, _ = h.shape
    z = jnp.einsum('bld,dc->blc', h, w_in)
    q_a, kv_a, k_pe, q_g, k_g, v_g = jnp.split(z, IN_OFFSETS, axis=-1)

    cos1, sin1 = _rope_cos_sin(pos_1d, ROPE_DIM)
    q = jnp.einsum('blr,rc->blc', _rmsnorm(q_a, g_q_a), w_q_b).reshape(B, L, MLA_HEADS, QK_DIM)
    q_m = jnp.concatenate([q[..., :NOPE_DIM], _rotate(q[..., NOPE_DIM:], cos1, sin1)], axis=-1)
    kv = jnp.einsum('blr,rc->blc', _rmsnorm(kv_a, g_kv_a), w_kv_b).reshape(B, L, MLA_HEADS, NOPE_DIM + V_DIM)
    k_rot = _rotate(k_pe[:, :, None, :], cos1, sin1)
    k_m = jnp.concatenate([kv[..., :NOPE_DIM], jnp.broadcast_to(k_rot, (B, L, MLA_HEADS, ROPE_DIM))], axis=-1)
    v_m = kv[..., NOPE_DIM:]
    o_mla = _blocked_attention(q_m, k_m, v_m, QK_DIM ** -0.5).reshape(B, L, MLA_WIDTH)

    cos_r, sin_r = _rope_cos_sin(row, AXIAL_HALF)
    cos_c, sin_c = _rope_cos_sin(col, AXIAL_HALF)

    def axial(t):
        return jnp.concatenate([_rotate(t[..., :AXIAL_HALF], cos_r, sin_r),
                                _rotate(t[..., AXIAL_HALF:], cos_c, sin_c)], axis=-1)

    qg = axial(_rmsnorm(q_g.reshape(B, L, GQA_HEADS, GQA_DIM), g_q_gqa))
    kg = axial(_rmsnorm(k_g.reshape(B, L, GQA_KV_HEADS, GQA_DIM), g_k_gqa))
    vg = v_g.reshape(B, L, GQA_KV_HEADS, GQA_DIM)
    o_gqa = _blocked_attention(qg, kg, vg, GQA_DIM ** -0.5).reshape(B, L, GQA_WIDTH)

    o = jnp.concatenate([_rmsnorm(o_mla, g_o_mla), _rmsnorm(o_gqa, g_o_gqa)], axis=-1)
    return jnp.einsum('blc,cd->bld', o, w_o)


def _clamped_swiglu(hgu):
    x_glu = jnp.minimum(hgu[..., ::2], SWIGLU_LIMIT)
    x_lin = jnp.clip(hgu[..., 1::2], -SWIGLU_LIMIT, SWIGLU_LIMIT)
    return x_glu * jax.nn.sigmoid(SWIGLU_ALPHA * x_glu) * (x_lin + 1.0)


def _moe_sequence(h, w_router, b_router, w_gate_up, b_gate_up, w_down, b_down):
    L = h.shape[0]
    logits = (jnp.einsum('ld,de->le', h, w_router) + b_router).astype(jnp.float32)
    top_val, top_idx = lax.top_k(logits, TOP_K)
    gates = jax.nn.softmax(top_val, axis=-1).astype(h.dtype)
    flat_e = top_idx.reshape(-1)
    order = jnp.argsort(flat_e)
    tok = order // TOP_K
    e_sorted = flat_e[order]
    group_sizes = jnp.bincount(flat_e, length=N_EXPERTS).astype(jnp.int32)
    xs = h[tok]
    hgu = lax.ragged_dot(xs, w_gate_up, group_sizes) + b_gate_up[e_sorted]
    act = _clamped_swiglu(hgu)
    out = lax.ragged_dot(act, w_down, group_sizes) + b_down[e_sorted]
    out = out * gates.reshape(-1)[order][:, None]
    return jax.ops.segment_sum(out, tok, num_segments=L)


def setup_inputs(seed: int = 0) -> dict:
    key = jax.random.key(seed)
    ks = jax.random.split(key, 28)
    f32 = jnp.float32

    def nrm(k, shape, scale):
        return jax.random.normal(k, shape, f32) * scale

    def gain(k, shape):
        return 1.0 + 0.05 * jax.random.normal(k, shape, f32)

    Dp = DEPTH
    return {
        'x': jax.random.normal(ks[0], (BATCH, SEQ, D_MODEL), f32),
        'meta_tokens': nrm(ks[1], (N_META, D_MODEL), 1.0),
        'ln_emb_g': gain(ks[2], (D_MODEL,)),
        'ln_emb_b': nrm(ks[3], (D_MODEL,), 0.02),
        'w_in': nrm(ks[4], (Dp, D_MODEL, IN_COLS), D_MODEL ** -0.5),
        'g_q_a': gain(ks[5], (Dp, Q_LORA)),
        'w_q_b': nrm(ks[6], (Dp, Q_LORA, MLA_HEADS * QK_DIM), Q_LORA ** -0.5),
        'g_kv_a': gain(ks[7], (Dp, KV_LORA)),
        'w_kv_b': nrm(ks[8], (Dp, KV_LORA, MLA_HEADS * (NOPE_DIM + V_DIM)), KV_LORA ** -0.5),
        'g_q_gqa': gain(ks[9], (Dp, GQA_DIM)),
        'g_k_gqa': gain(ks[10], (Dp, GQA_DIM)),
        'g_o_mla': gain(ks[11], (Dp, MLA_WIDTH)),
        'g_o_gqa': gain(ks[12], (Dp, GQA_WIDTH)),
        'w_o': nrm(ks[13], (Dp, MIX_WIDTH, D_MODEL), DEEPNORM_BETA * MIX_WIDTH ** -0.5),
        'ln1_g': gain(ks[14], (Dp, D_MODEL)),
        'ln1_b': nrm(ks[15], (Dp, D_MODEL), 0.02),
        'w_router': nrm(ks[16], (Dp, D_MODEL, N_EXPERTS), D_MODEL ** -0.5),
        'b_router': nrm(ks[17], (Dp, N_EXPERTS), 0.01),
        'w_gate_up': nrm(ks[18], (Dp, N_EXPERTS, D_MODEL, 2 * D_FF), D_MODEL ** -0.5),
        'b_gate_up': nrm(ks[19], (Dp, N_EXPERTS, 2 * D_FF), 0.02),
        'w_down': nrm(ks[20], (Dp, N_EXPERTS, D_FF, D_MODEL), DEEPNORM_BETA * D_FF ** -0.5),
        'b_down': nrm(ks[21], (Dp, N_EXPERTS, D_MODEL), 0.02),
        'ln2_g': gain(ks[22], (Dp, D_MODEL)),
        'ln2_b': nrm(ks[23], (Dp, D_MODEL), 0.02),
    }


def reference(x, meta_tokens, ln_emb_g, ln_emb_b, w_in, g_q_a, w_q_b, g_kv_a, w_kv_b,
              g_q_gqa, g_k_gqa, g_o_mla, g_o_gqa, w_o, ln1_g, ln1_b,
              w_router, b_router, w_gate_up, b_gate_up, w_down, b_down, ln2_g, ln2_b):
    B, S, D = x.shape
    meta = jnp.broadcast_to(meta_tokens.astype(x.dtype)[None], (B, N_META, D))
    h = _layernorm(jnp.concatenate([meta, x], axis=1), ln_emb_g, ln_emb_b)
    L = S + N_META

    rows = S // GRID_W
    pos_1d = jnp.arange(L, dtype=jnp.int32)
    row = jnp.concatenate([jnp.full((N_META,), -1, jnp.int32), jnp.repeat(jnp.arange(rows, dtype=jnp.int32), GRID_W)])
    col = jnp.concatenate([jnp.arange(N_META, dtype=jnp.int32), jnp.tile(jnp.arange(GRID_W, dtype=jnp.int32), rows)])

    for i in range(DEPTH):
        mix = _mixer(h, pos_1d, row, col, w_in[i], g_q_a[i], w_q_b[i], g_kv_a[i], w_kv_b[i],
                     g_q_gqa[i], g_k_gqa[i], g_o_mla[i], g_o_gqa[i], w_o[i])
        h = _layernorm(DEEPNORM_ALPHA * h + mix, ln1_g[i], ln1_b[i])
        moe = lax.map(lambda hs: _moe_sequence(hs, w_router[i], b_router[i], w_gate_up[i],
                                               b_gate_up[i], w_down[i], b_down[i]), h)
        h = _layernorm(DEEPNORM_ALPHA * h + moe, ln2_g[i], ln2_b[i])

    return h[:, N_META:]
```

```cpp
#include <hip/hip_runtime.h>
#include <cstdio>
#include <cstdint>

#ifndef MK_SPLIT
#define MK_SPLIT 1
#endif

#define LAS __attribute__((address_space(3)))
typedef unsigned short bf16;
typedef short bf16x8 __attribute__((ext_vector_type(8)));
typedef short s16x4 __attribute__((ext_vector_type(4)));
typedef float f32x2 __attribute__((ext_vector_type(2)));
typedef float f32x4 __attribute__((ext_vector_type(4)));
typedef float f32x16 __attribute__((ext_vector_type(16)));
typedef unsigned u32x2 __attribute__((ext_vector_type(2)));
typedef unsigned u32x4 __attribute__((ext_vector_type(4)));
typedef __bf16 bf16x2_t __attribute__((ext_vector_type(2)));

constexpr int NB = 16, SEQ = 2048, DM = 1024, NMETA = 16;
constexpr int NTOK = NB * SEQ;
constexpr int MROWS = NTOK + NMETA;
constexpr int MPAD = 33024;
constexpr int LKP = 2112;
constexpr int NIN = 1472, ZLD = 1536;
constexpr int NE = 32, NPAIR = NTOK * 4, MOE_TILES_MAX = 544, MOE_ROWS_MAX = MOE_TILES_MAX * 256;
constexpr float ALPHA = 1.189207115002721f;
constexpr float RMS_EPS = 1e-6f, LN_EPS = 1e-5f;

constexpr size_t MiB = 1u << 20;
constexpr size_t WS_CTL = 0, CTL_ZERO_BYTES = 1 * MiB;
constexpr size_t WS_ROPE = 1 * MiB;
constexpr size_t WS_WQB = 2 * MiB;
constexpr size_t WS_WKVB = 2 * MiB + 512 * 1024;
constexpr size_t WS_WR = 3 * MiB;
constexpr size_t WS_LOGITS = 4 * MiB;
constexpr size_t WS_TOPK = 8 * MiB;
constexpr size_t WS_GATE = 8 * MiB + 512 * 1024;
constexpr size_t WS_PAIRPOS = 9 * MiB;
constexpr size_t WS_ROWGATE = 9 * MiB + 512 * 1024;
constexpr size_t WS_HIST = 10 * MiB + 512 * 1024;
constexpr size_t WS_MOETAB = 10 * MiB + 768 * 1024;
constexpr size_t WS_WIN = 12 * MiB;
constexpr size_t WS_WO = 15 * MiB;
constexpr size_t WS_WGU = 32 * MiB;
constexpr size_t WS_WDN = 160 * MiB;
constexpr size_t WS_H0 = 224 * MiB;
constexpr size_t WS_H1 = 289 * MiB;
constexpr size_t WS_QAN = 353 * MiB;
constexpr size_t WS_KVAN = 370 * MiB;
constexpr size_t WS_Z = 380 * MiB;
constexpr size_t WS_QM = 477 * MiB;
constexpr size_t WS_KM = 525 * MiB;
constexpr size_t WS_VM = 575 * MiB;
constexpr size_t WS_QG = 608 * MiB;
constexpr size_t WS_KG = 640 * MiB;
constexpr size_t WS_VG = 657 * MiB;
constexpr size_t WS_O = 674 * MiB;
constexpr size_t WS_Y1 = 738 * MiB;
constexpr size_t WS_XS = 380 * MiB;
constexpr size_t WS_ACT = 652 * MiB;
constexpr size_t WS_OUT2 = 380 * MiB;
constexpr size_t WS_END = 924 * MiB;
static_assert(WS_Z + (size_t)MPAD * ZLD * 2 <= WS_QM && WS_QM + (size_t)64 * 2048 * 192 * 2 <= WS_KM && WS_KM + (size_t)64 * LKP * 192 * 2 <= WS_VM && WS_VM + (size_t)64 * LKP * 128 * 2 <= WS_QG, "ws map 1");
static_assert(WS_QG + (size_t)64 * 2048 * 128 * 2 <= WS_KG && WS_KG + (size_t)32 * LKP * 128 * 2 <= WS_VG && WS_VG + (size_t)32 * LKP * 128 * 2 <= WS_O && WS_O + (size_t)NTOK * DM * 2 <= WS_Y1 && WS_Y1 + (size_t)NTOK * DM * 4 <= WS_END, "ws map 2");
static_assert(WS_XS + (size_t)MOE_ROWS_MAX * DM * 2 <= WS_ACT && WS_ACT + (size_t)MOE_ROWS_MAX * DM * 2 <= WS_END, "ws map 3");
static_assert(WS_H0 + (size_t)MPAD * DM * 2 <= WS_H1 && WS_H1 + (size_t)NTOK * DM * 2 <= WS_QAN && WS_QAN + (size_t)MPAD * 256 * 2 <= WS_KVAN && WS_KVAN + (size_t)MPAD * 128 * 2 <= WS_Z, "ws map 4");
constexpr int CW_BAR = 4096;

constexpr int RING_BYTES = 131072;
constexpr int LDSCTL_OFF = RING_BYTES;
constexpr int LDS_BYTES = 147456;
constexpr int NWAVES = 8;

#define LDS_WAIT() asm volatile("s_waitcnt lgkmcnt(0)" ::: "memory")
#define SBAR() __builtin_amdgcn_sched_barrier(0)
__device__ __forceinline__ unsigned cvtpk(float lo, float hi) { f32x2 v = {lo, hi}; bf16x2_t b = __builtin_convertvector(v, bf16x2_t); return __builtin_bit_cast(unsigned, b); }
__device__ __forceinline__ u32x4 pack8(const float (&v)[8]) { u32x4 r = {cvtpk(v[0], v[1]), cvtpk(v[2], v[3]), cvtpk(v[4], v[5]), cvtpk(v[6], v[7])}; return r; }
__device__ __forceinline__ void unpack8(u32x4 w, float (&v)[8]) {
    v[0] = __uint_as_float(w.x << 16); v[1] = __uint_as_float(w.x & 0xffff0000u); v[2] = __uint_as_float(w.y << 16); v[3] = __uint_as_float(w.y & 0xffff0000u);
    v[4] = __uint_as_float(w.z << 16); v[5] = __uint_as_float(w.z & 0xffff0000u); v[6] = __uint_as_float(w.w << 16); v[7] = __uint_as_float(w.w & 0xffff0000u);
}
__device__ __forceinline__ float wave_sum(float v) {
#pragma unroll
    for (int o = 1; o < 64; o <<= 1) v += __shfl_xor(v, o);
    return v;
}
__device__ __forceinline__ float rsq(float x) { return __builtin_amdgcn_rsqf(x); }

#define XB_TMO      128
#define XB_XCNT(j)  (256  + 64 * (j))
#define XB_XSUB(j)  (1280 + 64 * (j))
#define XB_XGEN(j)  (2304 + 64 * (j))
#define XB_TOP      3328
#define XB_TOPGEN   3392
#define XCD_BAR_WORDS 3456
#define XB_SPIN_CAP (1u << 18)
__device__ __forceinline__ unsigned xb_ld(unsigned* p)              { return __hip_atomic_load(p, __ATOMIC_RELAXED, __HIP_MEMORY_SCOPE_AGENT); }
__device__ __forceinline__ unsigned xb_add(unsigned* p, unsigned v) { return __hip_atomic_fetch_add(p, v, __ATOMIC_RELAXED, __HIP_MEMORY_SCOPE_AGENT); }
__device__ __forceinline__ unsigned xb_xcc_id() { return (unsigned)__builtin_amdgcn_s_getreg((3 << 11) | 20) & 0xFu; }
#define XB_SPIN(cond, bar) do { unsigned _sp = 0; while (cond) { __builtin_amdgcn_s_sleep(1); \
    if ((++_sp & 255u) == 0u) { if (xb_ld(&(bar)[XB_TMO])) break; if (_sp > XB_SPIN_CAP) { atomicAdd(&(bar)[XB_TMO], 1u); break; } } } } while (0)
struct XcdBarrier { unsigned* bar; unsigned x; volatile LAS unsigned* st; };
__device__ __forceinline__ XcdBarrier xcd_barrier_post(unsigned* bar, volatile LAS unsigned* st) {
    XcdBarrier b; b.bar = bar; b.x = xb_xcc_id(); b.st = st;
    if (threadIdx.x == 0) (void)xb_add(&bar[XB_XCNT(b.x)], 1u);
    return b;
}
__device__ __forceinline__ void xcd_barrier_complete(unsigned* bar, unsigned x, unsigned& nloc, unsigned& nx) {
    const unsigned G = gridDim.x * gridDim.y * gridDim.z;
    unsigned sum, cnt, mine, sp = 0u;
    for (;;) {
        sum = 0u; cnt = 0u; mine = 0u;
#pragma unroll
        for (unsigned j = 0; j < 16; ++j) { const unsigned c = xb_ld(&bar[XB_XCNT(j)]); sum += c; cnt += (c > 0u) ? 1u : 0u; mine = (j == x) ? c : mine; }
        if (sum == G) break;
        __builtin_amdgcn_s_sleep(1);
        if ((++sp & 255u) == 0u) { if (xb_ld(&bar[XB_TMO])) break; if (sp > XB_SPIN_CAP) { atomicAdd(&bar[XB_TMO], 1u); break; } }
    }
    nloc = mine > 0u ? mine : 1u; nx = cnt > 0u ? cnt : 1u;
}
__device__ __forceinline__ void xcd_barrier(const XcdBarrier& b) {
    asm volatile("s_waitcnt vmcnt(0)" ::: "memory");
    __syncthreads();
    if (threadIdx.x == 0) {
        unsigned* bar = b.bar;
        __builtin_amdgcn_s_waitcnt(0);
        unsigned nloc = b.st[0], nx = b.st[1];
        if (nloc == 0u) { xcd_barrier_complete(bar, b.x, nloc, nx); b.st[0] = nloc; b.st[1] = nx; }
        const unsigned old = xb_add(&bar[XB_XSUB(b.x)], 1u);
        const unsigned gen = old / nloc;
        if (old + 1u == (gen + 1u) * nloc) {
            __builtin_amdgcn_fence(__ATOMIC_RELEASE, "agent");
            asm volatile("s_waitcnt vmcnt(0)" ::: "memory");
            const unsigned og = xb_add(&bar[XB_TOP], 1u);
            const unsigned tg = og / nx;
            if (og + 1u == (tg + 1u) * nx) xb_add(&bar[XB_TOPGEN], 1u);
            else XB_SPIN(xb_ld(&bar[XB_TOPGEN]) == tg, bar);
            __builtin_amdgcn_fence(__ATOMIC_ACQUIRE, "agent");
            xb_add(&bar[XB_XGEN(b.x)], 1u);
            asm volatile("s_waitcnt vmcnt(0)" ::: "memory");
        } else {
            XB_SPIN(xb_ld(&bar[XB_XGEN(b.x)]) == gen, bar);
            __builtin_amdgcn_fence(__ATOMIC_ACQUIRE, "agent");
            asm volatile("s_waitcnt vmcnt(0)" ::: "memory");
        }
    }
    __syncthreads();
}

struct BSelNone { __device__ __forceinline__ size_t operator()(int) const { return 0; } };
struct BSelExpert { const int* tile_expert; size_t per; __device__ __forceinline__ size_t operator()(int m0) const { return (size_t)tile_expert[m0 >> 8] * per; } };
template <class Epi, class BSel>
__device__ __forceinline__ void simple_gemm(const bf16* __restrict__ A, const bf16* __restrict__ Bt, int K, int m_lo, int m_hi, int N, const Epi& E, const BSel& bsel, int gw, int ngw, int lane) {
    const int fr = lane & 15, fq = lane >> 4;
    const int mt = (m_hi - m_lo) / 64, nt = N / 32;
    for (int u = gw; u < mt * nt; u += ngw) {
        const int m0 = m_lo + (u / nt) * 64, n0 = (u % nt) * 32;
        const bf16* ap = A + (size_t)(m0 + fr) * K + fq * 8;
        const bf16* bp = Bt + bsel(m0) + (size_t)(n0 + 8 * (fr >> 2) + (fr & 3)) * K + fq * 8;
        f32x4 acc[4][2];
#pragma unroll
        for (int i = 0; i < 4; ++i) { acc[i][0] = (f32x4){0.f, 0.f, 0.f, 0.f}; acc[i][1] = (f32x4){0.f, 0.f, 0.f, 0.f}; }
#pragma unroll 2
        for (int k = 0; k < K; k += 32) {
            bf16x8 a[4], b[2];
#pragma unroll
            for (int i = 0; i < 4; ++i) a[i] = *(const bf16x8*)(ap + (size_t)i * 16 * K + k);
#pragma unroll
            for (int j = 0; j < 2; ++j) b[j] = *(const bf16x8*)(bp + (size_t)j * 4 * K + k);
#pragma unroll
            for (int i = 0; i < 4; ++i)
#pragma unroll
                for (int j = 0; j < 2; ++j) acc[i][j] = __builtin_amdgcn_mfma_f32_16x16x32_bf16(b[j], a[i], acc[i][j], 0, 0, 0);
        }
#pragma unroll
        for (int i = 0; i < 4; ++i) {
            const float v[8] = {acc[i][0][0], acc[i][0][1], acc[i][0][2], acc[i][0][3], acc[i][1][0], acc[i][1][1], acc[i][1][2], acc[i][1][3]};
            E.store8(m0 + 16 * i + fr, n0 + 8 * fq, v);
        }
    }
}

struct EpiZ { bf16* z;
    __device__ __forceinline__ void store8(int row, int col, const float (&v)[8]) const { if (col < NIN) *(u32x4*)(z + (size_t)row * ZLD + col) = pack8(v); } };
struct EpiQ { bf16* qm; const float* rope;
    __device__ __forceinline__ void store8(int row, int col, const float (&v)[8]) const {
        const int h = col / 192, w = col - h * 192, b = row >> 11, s = row & 2047;
        float o[8];
        if (w < 128) {
#pragma unroll
            for (int j = 0; j < 8; ++j) o[j] = v[j];
        } else {
            const float* t = rope + ((size_t)(16 + s + 1) * 32 + ((w - 128) >> 1)) * 2;
#pragma unroll
            for (int j = 0; j < 4; ++j) { const float c = t[2 * j], sn = t[2 * j + 1], x1 = v[2 * j], x2 = v[2 * j + 1]; o[2 * j] = x1 * c - x2 * sn; o[2 * j + 1] = x1 * sn + x2 * c; }
        }
        *(u32x4*)(qm + ((size_t)(b * 4 + h) * 2048 + s) * 192 + w) = pack8(o);
    } };
struct EpiKV { bf16* km; bf16* vm;
    __device__ __forceinline__ void store8(int row, int col, const float (&v)[8]) const {
        if (row >= MROWS) return;
        const int h = col >> 8, w = col & 255; const u32x4 pk = pack8(v);
        if (row < NTOK) { const int b = row >> 11, key = row & 2047; const size_t r = (size_t)(b * 4 + h) * LKP + key;
            if (w < 128) *(u32x4*)(km + r * 192 + w) = pk; else *(u32x4*)(vm + r * 128 + (w - 128)) = pk;
        } else { const int key = 2048 + (row - NTOK);
            for (int b = 0; b < NB; ++b) { const size_t r = (size_t)(b * 4 + h) * LKP + key;
                if (w < 128) *(u32x4*)(km + r * 192 + w) = pk; else *(u32x4*)(vm + r * 128 + (w - 128)) = pk; } }
    } };
struct EpiO { float* y1; const bf16* h0;
    __device__ __forceinline__ void store8(int row, int col, const float (&v)[8]) const {
        float h[8]; unpack8(*(const u32x4*)(h0 + (size_t)row * DM + col), h);
        float* y = y1 + (size_t)row * DM + col;
        *(f32x4*)y = (f32x4){ALPHA * h[0] + v[0], ALPHA * h[1] + v[1], ALPHA * h[2] + v[2], ALPHA * h[3] + v[3]};
        *(f32x4*)(y + 4) = (f32x4){ALPHA * h[4] + v[4], ALPHA * h[5] + v[5], ALPHA * h[6] + v[6], ALPHA * h[7] + v[7]};
    } };
struct EpiLogit { float* logits; const float* bias;
    __device__ __forceinline__ void store8(int row, int col, const float (&v)[8]) const {
        float* y = logits + (size_t)row * NE + col;
        *(f32x4*)y = (f32x4){v[0] + bias[col], v[1] + bias[col + 1], v[2] + bias[col + 2], v[3] + bias[col + 3]};
        *(f32x4*)(y + 4) = (f32x4){v[4] + bias[col + 4], v[5] + bias[col + 5], v[6] + bias[col + 6], v[7] + bias[col + 7]};
    } };
struct EpiGU { bf16* act; const float* bgu; const int* tile_expert;
    __device__ __forceinline__ void store8(int row, int col, const float (&v)[8]) const {
        const int e = tile_expert[row >> 8], ac = col >> 1;
        const float* bb = bgu + (size_t)e * 2048 + 2 * ac;
        const f32x4 b0 = *(const f32x4*)bb, b1 = *(const f32x4*)(bb + 4);
        const float bg[4] = {b0[0], b0[2], b1[0], b1[2]}, bl[4] = {b0[1], b0[3], b1[1], b1[3]};
        float o[4];
#pragma unroll
        for (int j = 0; j < 4; ++j) {
            const float xg = fminf(v[j] + bg[j], 7.f), xl = fminf(fmaxf(v[4 + j] + bl[j], -7.f), 7.f);
            const float sg = __builtin_amdgcn_rcpf(1.f + __builtin_amdgcn_exp2f(-1.702f * 1.4426950408889634f * xg));
            o[j] = xg * sg * (xl + 1.f);
        }
        *(u32x2*)(act + (size_t)row * DM + ac) = (u32x2){cvtpk(o[0], o[1]), cvtpk(o[2], o[3])};
    } };
struct EpiDN { bf16* out2; const float* bdn; const float* row_gate; const int* tile_expert;
    __device__ __forceinline__ void store8(int row, int col, const float (&v)[8]) const {
        const int e = tile_expert[row >> 8]; const float g = row_gate[row];
        const float* bb = bdn + (size_t)e * DM + col; const f32x4 b0 = *(const f32x4*)bb, b1 = *(const f32x4*)(bb + 4);
        const float o[8] = {(v[0] + b0[0]) * g, (v[1] + b0[1]) * g, (v[2] + b0[2]) * g, (v[3] + b0[3]) * g, (v[4] + b1[0]) * g, (v[5] + b1[1]) * g, (v[6] + b1[2]) * g, (v[7] + b1[3]) * g};
        *(u32x4*)(out2 + (size_t)row * DM + col) = pack8(o);
    } };

struct MapId { __device__ __forceinline__ int operator()(int n) const { return n; } };
struct MapIn { __device__ __forceinline__ int operator()(int n) const {
    if (n >= 384 && n < 448) { const int l = n - 384; return 384 + 2 * (l & 31) + (l >> 5); }
    if (n >= 448 && n < 1216) { const int l = n - 448, hd = l >> 7, d = l & 127; return 448 + hd * 128 + (d >> 6) * 64 + 2 * (d & 31) + ((d >> 5) & 1); }
    return n; } };
struct MapQ { __device__ __forceinline__ int operator()(int n) const { const int h = n / 192, w = n - h * 192; if (w < 128) return n; const int l = w - 128; return h * 192 + 128 + 2 * (l & 31) + (l >> 5); } };
struct MapGU { __device__ __forceinline__ int operator()(int n) const { const int a = n >> 1; return 8 * (a >> 2) + (a & 3) + 4 * (n & 1); } };
template <class Map>
__device__ __forceinline__ void transpose_item(const float* __restrict__ W, int K, int N, bf16* __restrict__ WT, LAS float* scr, int item, int lane, const Map& map) {
    const int nblk = N / 32, kb = item / nblk, nb = item - kb * nblk, k0 = 64 * kb, n0 = 32 * nb;
#pragma unroll 8
    for (int i = 0; i < 32; ++i) { const int kk = 2 * i + (lane >> 5); scr[kk * 33 + (lane & 31)] = W[(size_t)(k0 + kk) * N + n0 + (lane & 31)]; }
    LDS_WAIT(); asm volatile("" ::: "memory");
    const int c = lane & 7;
#pragma unroll
    for (int j = 0; j < 4; ++j) { const int n = (lane >> 3) + 8 * j; const LAS float* s = scr + (8 * c) * 33 + n;
        u32x4 o; o.x = cvtpk(s[0 * 33], s[1 * 33]); o.y = cvtpk(s[2 * 33], s[3 * 33]); o.z = cvtpk(s[4 * 33], s[5 * 33]); o.w = cvtpk(s[6 * 33], s[7 * 33]);
        *(u32x4*)(WT + (size_t)map(n0 + n) * K + k0 + 8 * c) = o; }
    LDS_WAIT(); asm volatile("" ::: "memory");
}
__device__ __forceinline__ void ln_row_f32_to_bf16(const float* __restrict__ xrow, const float* __restrict__ g, const float* __restrict__ bta, bf16* __restrict__ orow, int lane) {
    f32x4 v[4]; float s = 0.f;
#pragma unroll
    for (int j = 0; j < 4; ++j) { v[j] = ((const f32x4*)xrow)[lane + 64 * j]; s += (v[j].x + v[j].y) + (v[j].z + v[j].w); }
    const float mean = wave_sum(s) * (1.f / DM); float s2 = 0.f;
#pragma unroll
    for (int j = 0; j < 4; ++j) { v[j] = v[j] - mean; s2 += (v[j].x * v[j].x + v[j].y * v[j].y) + (v[j].z * v[j].z + v[j].w * v[j].w); }
    const float rstd = rsq(wave_sum(s2) * (1.f / DM) + LN_EPS);
#pragma unroll
    for (int j = 0; j < 4; ++j) { const f32x4 gg = ((const f32x4*)g)[lane + 64 * j], bb = ((const f32x4*)bta)[lane + 64 * j]; const f32x4 o = v[j] * rstd * gg + bb;
        ((u32x2*)orow)[lane + 64 * j] = (u32x2){cvtpk(o.x, o.y), cvtpk(o.z, o.w)}; }
}
__device__ __forceinline__ void zero_bytes(void* p, size_t bytes, int gtid, int ngt) {
    u32x4* q = (u32x4*)p; const size_t n = bytes / 16;
    for (size_t i = gtid; i < n; i += ngt) q[i] = (u32x4){0u, 0u, 0u, 0u};
}
__device__ __forceinline__ void sincos_d(float angf, float& sn, float& cs) {
    const double x = (double)angf; const double q = __builtin_rint(x * 0.63661977236758134308);
    const double r = (x - q * 1.57079632679489655800) - q * 6.123233995736766036e-17, r2 = r * r;
    const double sp = r * (1.0 + r2 * (-1.0 / 6 + r2 * (1.0 / 120 + r2 * (-1.0 / 5040 + r2 * (1.0 / 362880 + r2 * (-1.0 / 39916800 + r2 * (1.0 / 6227020800.0)))))));
    const double cp = 1.0 + r2 * (-0.5 + r2 * (1.0 / 24 + r2 * (-1.0 / 720 + r2 * (1.0 / 40320 + r2 * (-1.0 / 3628800 + r2 * (1.0 / 479001600.0))))));
    const int qi = ((int)q) & 3;
    const double s_ = (qi == 0) ? sp : (qi == 1) ? cp : (qi == 2) ? -sp : -cp;
    const double c_ = (qi == 0) ? cp : (qi == 1) ? -sp : (qi == 2) ? -cp : sp;
    sn = (float)s_; cs = (float)c_;
}

__device__ __forceinline__ void p2a_row(int row, const bf16* __restrict__ z, const float* __restrict__ rope, const float* __restrict__ g_q_a, const float* __restrict__ g_kv_a,
                                        const float* __restrict__ g_q_gqa, const float* __restrict__ g_k_gqa, bf16* qan, bf16* kvan, bf16* km, bf16* qg, bf16* kg, bf16* vg, int lane) {
    const bf16* zr = z + (size_t)row * ZLD;
    const bool meta = row >= NTOK;
    const int b = row >> 11, s = row & 2047, m = row - NTOK;
    const int pos1 = meta ? m : 16 + s, prow = meta ? -1 : (s >> 6), pcol = meta ? m : (s & 63), key = meta ? 2048 + m : s;
    {
        float f[8]; u32x4 w = {0u, 0u, 0u, 0u}; if (lane < 56) w = *(const u32x4*)(zr + 8 * lane); unpack8(w, f);
        float ss = 0.f;
#pragma unroll
        for (int j = 0; j < 8; ++j) ss += f[j] * f[j];
        ss += __shfl_xor(ss, 1); ss += __shfl_xor(ss, 2); ss += __shfl_xor(ss, 4); ss += __shfl_xor(ss, 8);
        const float s16 = ss, s32 = ss + __shfl_xor(ss, 16);
        if (lane < 32) { const float rs = rsq(s32 * (1.f / 256) + RMS_EPS); float o[8];
#pragma unroll
            for (int j = 0; j < 8; ++j) o[j] = f[j] * rs * g_q_a[8 * lane + j];
            *(u32x4*)(qan + (size_t)row * 256 + 8 * lane) = pack8(o);
        } else if (lane < 48) { const float rs = rsq(s16 * (1.f / 128) + RMS_EPS); float o[8];
#pragma unroll
            for (int j = 0; j < 8; ++j) o[j] = f[j] * rs * g_kv_a[8 * (lane - 32) + j];
            *(u32x4*)(kvan + (size_t)row * 128 + 8 * (lane - 32)) = pack8(o);
        } else if (lane < 56) { const int i0 = 4 * (lane - 48); const float* t = rope + ((size_t)(pos1 + 1) * 32 + i0) * 2; float o[8];
#pragma unroll
            for (int j = 0; j < 4; ++j) { const float c = t[2 * j], sn = t[2 * j + 1], x1 = f[2 * j], x2 = f[2 * j + 1]; o[2 * j] = x1 * c - x2 * sn; o[2 * j + 1] = x1 * sn + x2 * c; }
            const u32x4 pk = pack8(o);
            if (!meta) { for (int h = 0; h < 4; ++h) *(u32x4*)(km + ((size_t)(b * 4 + h) * LKP + key) * 192 + 128 + 8 * (lane - 48)) = pk; }
            else { for (int bb = 0; bb < NB; ++bb) for (int h = 0; h < 4; ++h) *(u32x4*)(km + ((size_t)(bb * 4 + h) * LKP + key) * 192 + 128 + 8 * (lane - 48)) = pk; }
        }
    }
    const int p0 = (lane & 15) * 8, half = p0 >> 6, i0 = (p0 & 63) >> 1;
    const int apos = half ? pcol : prow; const float* t = rope + ((size_t)(apos + 1) * 32 + i0) * 2;
    if (!meta) {
        float f[8]; unpack8(*(const u32x4*)(zr + 448 + 8 * lane), f);
        float ss = 0.f;
#pragma unroll
        for (int j = 0; j < 8; ++j) ss += f[j] * f[j];
        ss += __shfl_xor(ss, 1); ss += __shfl_xor(ss, 2); ss += __shfl_xor(ss, 4); ss += __shfl_xor(ss, 8);
        const float rs = rsq(ss * (1.f / 128) + RMS_EPS); float o[8];
#pragma unroll
        for (int j = 0; j < 4; ++j) { const int d1 = half * 64 + i0 + j, d2 = d1 + 32;
            const float x1 = f[2 * j] * rs * g_q_gqa[d1], x2 = f[2 * j + 1] * rs * g_q_gqa[d2], c = t[2 * j], sn = t[2 * j + 1];
            o[2 * j] = x1 * c - x2 * sn; o[2 * j + 1] = x1 * sn + x2 * c; }
        *(u32x4*)(qg + ((size_t)(b * 4 + (lane >> 4)) * 2048 + s) * 128 + p0) = pack8(o);
    }
    {
        float f[8]; unpack8(*(const u32x4*)(zr + 960 + 8 * lane), f);
        float ss = 0.f;
#pragma unroll
        for (int j = 0; j < 8; ++j) ss += f[j] * f[j];
        ss += __shfl_xor(ss, 1); ss += __shfl_xor(ss, 2); ss += __shfl_xor(ss, 4); ss += __shfl_xor(ss, 8);
        float o[8];
        if (lane < 32) { const float rs = rsq(ss * (1.f / 128) + RMS_EPS);
#pragma unroll
            for (int j = 0; j < 4; ++j) { const int d1 = half * 64 + i0 + j, d2 = d1 + 32;
                const float x1 = f[2 * j] * rs * g_k_gqa[d1], x2 = f[2 * j + 1] * rs * g_k_gqa[d2], c = t[2 * j], sn = t[2 * j + 1];
                o[2 * j] = x1 * c - x2 * sn; o[2 * j + 1] = x1 * sn + x2 * c; }
        } else {
#pragma unroll
            for (int j = 0; j < 8; ++j) o[j] = f[j];
        }
        const u32x4 pk = pack8(o); bf16* dst = lane < 32 ? kg : vg; const int hk = (lane >> 4) & 1;
        if (!meta) *(u32x4*)(dst + ((size_t)(b * 2 + hk) * LKP + key) * 128 + p0) = pk;
        else for (int bb = 0; bb < NB; ++bb) *(u32x4*)(dst + ((size_t)(bb * 2 + hk) * LKP + key) * 128 + p0) = pk;
    }
}

__device__ __forceinline__ int crow(int r, int hi) { return (r & 3) + 8 * (r >> 2) + 4 * hi; }
__device__ __forceinline__ int v_st(int k, int c) { const int kk = (k & ~0xC) | ((k & 4) << 1) | ((k & 8) >> 1); return ((kk >> 3) * 4 + (c >> 5)) * 512 + ((kk & 7) * 32 + (c & 31)) * 2; }
__device__ __forceinline__ int v_rd_base(int lane) { return ((lane & 3) << 3) | (((lane >> 2) & 3) << 6) | (((lane >> 4) & 1) << 5) | (((lane >> 5) & 1) << 8); }
constexpr int v_rd_off(int d0, int ks, int half) { return d0 * 512 + ks * 4096 + half * 2048; }
template <int OFF> __device__ __forceinline__ s16x4 tr_read(int vb) {
    s16x4 r; asm volatile("ds_read_b64_tr_b16 %0, %1 offset:%2" : "=&v"(r) : "v"(vb), "i"(OFF) : "memory"); return r;
}
template <int D0> __device__ __forceinline__ void pv_one(f32x16& od, int vb, bf16x8 pa0, bf16x8 pa1, bf16x8 pa2, bf16x8 pa3) {
    const s16x4 l0 = tr_read<v_rd_off(D0, 0, 0)>(vb), h0 = tr_read<v_rd_off(D0, 0, 1)>(vb), l1 = tr_read<v_rd_off(D0, 1, 0)>(vb), h1 = tr_read<v_rd_off(D0, 1, 1)>(vb);
    const s16x4 l2 = tr_read<v_rd_off(D0, 2, 0)>(vb), h2 = tr_read<v_rd_off(D0, 2, 1)>(vb), l3 = tr_read<v_rd_off(D0, 3, 0)>(vb), h3 = tr_read<v_rd_off(D0, 3, 1)>(vb);
    asm volatile("s_waitcnt lgkmcnt(0)" ::: "memory"); SBAR();
#define PK(L, H) (bf16x8){L[0], L[1], L[2], L[3], H[0], H[1], H[2], H[3]}
    od = __builtin_amdgcn_mfma_f32_32x32x16_bf16(pa0, PK(l0, h0), od, 0, 0, 0);
    od = __builtin_amdgcn_mfma_f32_32x32x16_bf16(pa1, PK(l1, h1), od, 0, 0, 0);
    od = __builtin_amdgcn_mfma_f32_32x32x16_bf16(pa2, PK(l2, h2), od, 0, 0, 0);
    od = __builtin_amdgcn_mfma_f32_32x32x16_bf16(pa3, PK(l3, h3), od, 0, 0, 0);
#undef PK
}
__device__ __forceinline__ void pv_d0(f32x16* o, int vb, bf16x8 pa0, bf16x8 pa1, bf16x8 pa2, bf16x8 pa3) {
    pv_one<0>(o[0], vb, pa0, pa1, pa2, pa3); pv_one<1>(o[1], vb, pa0, pa1, pa2, pa3); pv_one<2>(o[2], vb, pa0, pa1, pa2, pa3); pv_one<3>(o[3], vb, pa0, pa1, pa2, pa3);
}
template <int DQK> struct AttnC {
    static constexpr float SCALE = DQK == 192 ? 0.07216878364870322f : 0.08838834764831845f;
    static constexpr float C = SCALE * 1.4426950408889634f, THRS = 8.f / SCALE;
};
template <int DQK>
__device__ __forceinline__ void partialSM(f32x16& p0, f32x16& p1, float& m_reg, float& mn, float& alpha) {
    constexpr float C = AttnC<DQK>::C;
    float pmax = p0[0];
#pragma unroll
    for (int r = 1; r < 16; ++r) pmax = fmaxf(pmax, p0[r]);
#pragma unroll
    for (int r = 0; r < 16; ++r) pmax = fmaxf(pmax, p1[r]);
    { auto rr = __builtin_amdgcn_permlane32_swap(__float_as_uint(pmax), __float_as_uint(pmax), false, false);
      pmax = fmaxf(__uint_as_float(rr[0]), __uint_as_float(rr[1])); }
    if (__builtin_expect(__all(pmax - m_reg <= AttnC<DQK>::THRS), 1)) { mn = m_reg; alpha = 1.f; }
    else { mn = fmaxf(m_reg, pmax); alpha = __builtin_amdgcn_exp2f((m_reg - mn) * C); m_reg = mn; }
    const float mnC = -mn * C;
#pragma unroll
    for (int r = 0; r < 16; ++r) p0[r] = fmaf(p0[r], C, mnC);
#pragma unroll
    for (int r = 0; r < 16; ++r) p1[r] = fmaf(p1[r], C, mnC);
#pragma unroll
    for (int r = 0; r < 16; ++r) p0[r] = __builtin_amdgcn_exp2f(p0[r]);
}
__device__ __forceinline__ void finishSM(f32x16& p0, f32x16& p1, float alpha, float& l_reg, bf16x8& pa0, bf16x8& pa1, bf16x8& pa2, bf16x8& pa3) {
#pragma unroll
    for (int r = 0; r < 16; ++r) p1[r] = __builtin_amdgcn_exp2f(p1[r]);
    float ps = 0;
#pragma unroll
    for (int r = 0; r < 16; ++r) ps += p0[r];
#pragma unroll
    for (int r = 0; r < 16; ++r) ps += p1[r];
    { auto rr = __builtin_amdgcn_permlane32_swap(__float_as_uint(ps), __float_as_uint(ps), false, false);
      ps = __uint_as_float(rr[0]) + __uint_as_float(rr[1]); }
    l_reg = l_reg * alpha + ps;
#define PK4(P, BASE, OUT) do { unsigned a0 = cvtpk(P[BASE + 0], P[BASE + 1]), a1 = cvtpk(P[BASE + 2], P[BASE + 3]);   \
    unsigned b0 = cvtpk(P[BASE + 4], P[BASE + 5]), b1 = cvtpk(P[BASE + 6], P[BASE + 7]);                              \
    auto r0 = __builtin_amdgcn_permlane32_swap(a0, b0, false, false); auto r1 = __builtin_amdgcn_permlane32_swap(a1, b1, false, false); \
    u32x4 w = {r0[0], r1[0], r0[1], r1[1]}; OUT = *reinterpret_cast<bf16x8*>(&w); } while (0)
    PK4(p0, 0, pa0); PK4(p0, 8, pa1); PK4(p1, 0, pa2); PK4(p1, 8, pa3);
#undef PK4
}
template <int DQK>
__device__ __forceinline__ void qkt(f32x16& p0, f32x16& p1, const LAS char* Ks, const bf16x8* qr, const LAS char* ql, const int (&ko)[4]) {
    constexpr int KRB = DQK * 2;
    p0 = f32x16{}; p1 = f32x16{};
#pragma unroll
    for (int d0 = 0; d0 < DQK / 16; ++d0) { const LAS char* kp = Ks + ko[d0 & 3] + (d0 >> 2) * 128;
        const bf16x8 b0 = *(const LAS bf16x8*)(kp);
        const bf16x8 b1 = *(const LAS bf16x8*)(kp + 32 * KRB);
        bf16x8 q; if (d0 < 8) q = qr[d0]; else q = *(const LAS bf16x8*)(ql + (d0 - 8) * 1024);
        p0 = __builtin_amdgcn_mfma_f32_32x32x16_bf16(b0, q, p0, 0, 0, 0);
        p1 = __builtin_amdgcn_mfma_f32_32x32x16_bf16(b1, q, p1, 0, 0, 0); }
}
template <int DQK, int SD>
__device__ __forceinline__ void attn_body(const bf16* __restrict__ Qb, const bf16* __restrict__ Kh, const bf16* __restrict__ Vh, bf16* __restrict__ Ob, LAS char* lds) {
    constexpr int ND0 = DQK / 16, KRB = DQK * 2, SHM_K = 64 * KRB, SHM_V = 64 * 128 * 2, NKC = DQK / 64, CPR = DQK / 8, NT = LKP / 64;
    static_assert(NT % 2 == 1, "odd tile count: the tail below takes tiles NT-2 and NT-1");
    int tid = threadIdx.x; asm volatile("" : "+v"(tid));
    const int wid = tid >> 6, lane = tid & 63, r32 = lane & 31, hi = lane >> 5;
    LAS char* V_lds = lds; LAS char* K_lds = lds + 2 * SHM_V;
    __syncthreads();
    float m_reg = -1e30f, l_reg = 0; f32x16 o[4] = {}; bf16x8 qr[8];
    const bf16* Qw = Qb + (size_t)(wid * 32 + r32) * DQK + hi * 8;
#pragma unroll
    for (int d0 = 0; d0 < 8; ++d0) qr[d0] = *reinterpret_cast<const bf16x8*>(Qw + d0 * 16);
    LAS char* ql = lds + 2 * SHM_V + 2 * SHM_K + 2048 + wid * 4096 + lane * 16;
#pragma unroll
    for (int d0 = 8; d0 < ND0; ++d0) *(LAS bf16x8*)(ql + (d0 - 8) * 1024) = *reinterpret_cast<const bf16x8*>(Qw + d0 * 16);
    const int sr = tid >> 4, sc = (tid & 15) * 8, vst0 = v_st(sr, sc), vst1 = v_st(32 + sr, sc);
    int kst[NKC];
#pragma unroll
    for (int c = 0; c < NKC; ++c) { const int id = tid + 512 * c, kr = id / CPR, kc = (id - kr * CPR) * 8; kst[c] = kr * KRB + ((kc * 2) ^ ((kr & 7) << 4)); }
    const int voff = tid * 16;
    int ko[4];
#pragma unroll
    for (int q = 0; q < 4; ++q) ko[q] = r32 * KRB + ((q * 32 + hi * 16) ^ ((r32 & 7) << 4));
    const __amdgpu_buffer_rsrc_t rK = __builtin_amdgcn_make_buffer_rsrc((void*)Kh, 0, LKP * KRB, 0x00020000);
    const __amdgpu_buffer_rsrc_t rV = __builtin_amdgcn_make_buffer_rsrc((void*)Vh, 0, LKP * 256, 0x00020000);
    const int vb0 = (int)(unsigned)(uintptr_t)V_lds + v_rd_base(lane);
    struct { bf16x8 vs0, vs1, ks[NKC]; } sr_[SD];
#define SLOAD(i, k0) do { sr_[i].vs0 = __builtin_bit_cast(bf16x8, __builtin_amdgcn_raw_buffer_load_b128(rV, voff, (k0) * 256, 0)); sr_[i].vs1 = __builtin_bit_cast(bf16x8, __builtin_amdgcn_raw_buffer_load_b128(rV, voff, (k0) * 256 + 8192, 0)); \
    _Pragma("unroll") for (int c_ = 0; c_ < NKC; ++c_) sr_[i].ks[c_] = __builtin_bit_cast(bf16x8, __builtin_amdgcn_raw_buffer_load_b128(rK, voff, (k0) * KRB + c_ * 8192, 0)); } while (0)
#define SWRITE(b, i) do { *(LAS bf16x8*)(V_lds + (b) * SHM_V + vst0) = sr_[i].vs0; *(LAS bf16x8*)(V_lds + (b) * SHM_V + vst1) = sr_[i].vs1; \
    _Pragma("unroll") for (int c_ = 0; c_ < NKC; ++c_) *(LAS bf16x8*)(K_lds + (b) * SHM_K + kst[c_]) = sr_[i].ks[c_]; } while (0)
#define SWAIT() do { if constexpr (SD == 2) { if constexpr (NKC == 2) asm volatile("s_waitcnt vmcnt(4)" ::: "memory"); else asm volatile("s_waitcnt vmcnt(5)" ::: "memory"); } \
    else asm volatile("s_waitcnt vmcnt(0)" ::: "memory"); } while (0)
#define RESC(a) do { if (__any((a) < 1.f)) { int t_ = threadIdx.x; asm volatile("" : "+v"(t_)); const int r32_ = t_ & 31, hi_2 = (t_ >> 5) & 1; \
    LAS float* al_ = (LAS float*)(lds + 2 * SHM_V + 2 * SHM_K) + (t_ >> 6) * 64 + 32; if (hi_2 == 0) al_[r32_] = (a); asm volatile("s_waitcnt lgkmcnt(0)" ::: "memory"); \
    _Pragma("unroll") for (int d = 0; d < 4; ++d) _Pragma("unroll") for (int r = 0; r < 16; ++r) o[d][r] *= al_[crow(r, hi_2)]; } } while (0)
    f32x16 pA0, pA1, pB0, pB1; float mnA, mnB, alA, alB; bf16x8 pa0, pa1, pa2, pa3;
    constexpr int SE = 0, SO = SD - 1;
    SLOAD(SE, 0); asm volatile("s_waitcnt vmcnt(0)" ::: "memory"); SWRITE(0, SE); __syncthreads();
    qkt<DQK>(pA0, pA1, K_lds, qr, ql, ko); partialSM<DQK>(pA0, pA1, m_reg, mnA, alA);
    SLOAD(SO, 64); if constexpr (SD == 2) { SLOAD(SE, 128); }
    SWAIT(); SWRITE(1, SO); __syncthreads();
#pragma unroll 1
    for (int j = 1; j + 2 < NT; j += 2) {
        SBAR(); qkt<DQK>(pB0, pB1, K_lds + SHM_K, qr, ql, ko);
        finishSM(pA0, pA1, alA, l_reg, pa0, pa1, pa2, pa3); SBAR();
        SLOAD(SO, (j + SD) * 64); SBAR();
        pv_d0(o, vb0, pa0, pa1, pa2, pa3); partialSM<DQK>(pB0, pB1, m_reg, mnB, alB);
        __syncthreads(); SWAIT(); SWRITE(0, SE);
        RESC(alB); __syncthreads();
        SBAR(); qkt<DQK>(pA0, pA1, K_lds, qr, ql, ko);
        finishSM(pB0, pB1, alB, l_reg, pa0, pa1, pa2, pa3); SBAR();
        SLOAD(SE, (j + 1 + SD) * 64); SBAR();
        pv_d0(o, vb0 + SHM_V, pa0, pa1, pa2, pa3); partialSM<DQK>(pA0, pA1, m_reg, mnA, alA);
        __syncthreads(); SWAIT(); SWRITE(1, SO);
        RESC(alA); __syncthreads();
    }
    SBAR(); qkt<DQK>(pB0, pB1, K_lds + SHM_K, qr, ql, ko);
    finishSM(pA0, pA1, alA, l_reg, pa0, pa1, pa2, pa3); SBAR();
    if constexpr (SD == 1) { SLOAD(SE, (NT - 1) * 64); } SBAR();
    pv_d0(o, vb0, pa0, pa1, pa2, pa3); partialSM<DQK>(pB0, pB1, m_reg, mnB, alB);
    __syncthreads(); asm volatile("s_waitcnt vmcnt(0)" ::: "memory"); SWRITE(0, SE);
    RESC(alB); __syncthreads();
    SBAR(); qkt<DQK>(pA0, pA1, K_lds, qr, ql, ko);
#pragma unroll
    for (int r = 8; r < 16; ++r) pA0[r] = -1e30f;
#pragma unroll
    for (int r = 0; r < 16; ++r) pA1[r] = -1e30f;
    finishSM(pB0, pB1, alB, l_reg, pa0, pa1, pa2, pa3); SBAR();
    pv_d0(o, vb0 + SHM_V, pa0, pa1, pa2, pa3); partialSM<DQK>(pA0, pA1, m_reg, mnA, alA);
    RESC(alA);
    finishSM(pA0, pA1, alA, l_reg, pa0, pa1, pa2, pa3); SBAR();
    pv_d0(o, vb0, pa0, pa1, pa2, pa3);
    { int t_ = threadIdx.x; asm volatile("" : "+v"(t_)); const int r32_ = t_ & 31, hi_2 = (t_ >> 5) & 1, wid_ = t_ >> 6;
      LAS float* li_ = (LAS float*)(lds + 2 * SHM_V + 2 * SHM_K) + wid_ * 64;
      if (hi_2 == 0) li_[r32_] = l_reg; asm volatile("s_waitcnt lgkmcnt(0)" ::: "memory");
      float rli[16];
#pragma unroll
      for (int r = 0; r < 16; ++r) rli[r] = __builtin_amdgcn_rcpf(li_[crow(r, hi_2)]);
      bf16* Ow = Ob + (size_t)(wid_ * 32) * DM;
#pragma unroll
      for (int r = 0; r < 16; ++r) { const int orow = crow(r, hi_2);
#pragma unroll
          for (int d0 = 0; d0 < 4; ++d0) Ow[(size_t)orow * DM + d0 * 32 + r32_] = (bf16)(cvtpk(o[d0][r] * rli[r], 0.f) & 0xffffu); } }
#undef SLOAD
#undef SWRITE
#undef SWAIT
#undef RESC
}

constexpr int NPHASE = 14;
struct Args { const float* in[24]; float* out; unsigned char* ws; int ph_lo, ph_hi; };
__global__ void __launch_bounds__(NWAVES * 64, 2) hymba_fwd(Args args) {
    extern __shared__ __attribute__((aligned(16))) unsigned char lds[];
    const int tid = threadIdx.x, lane = tid & 63, wave = __builtin_amdgcn_readfirstlane(tid >> 6);
    const int G = gridDim.x, bx = blockIdx.x, vcu = (G % 8 == 0) ? (bx % 8) * (G / 8) + bx / 8 : bx;
    const int gw = vcu * NWAVES + wave, ngw = G * NWAVES, gtid = vcu * (NWAVES * 64) + tid, ngt = G * NWAVES * 64;
    unsigned char* ws = args.ws;
    volatile LAS unsigned* MISC = (volatile LAS unsigned*)((LAS unsigned char*)lds + LDSCTL_OFF);
    for (int u = tid; u < 1024; u += NWAVES * 64) ((LAS unsigned*)((LAS unsigned char*)lds + LDSCTL_OFF))[u] = 0u;
    __syncthreads();
#if !MK_SPLIT
    XcdBarrier bar = xcd_barrier_post((unsigned*)(ws + WS_CTL) + CW_BAR, MISC + 8);
#define GRID_BAR() xcd_barrier(bar)
#else
#define GRID_BAR() do {} while (0)
#endif
    const int lo = args.ph_lo, hi_ = args.ph_hi;
#define IN(k) (lo <= (k) && (k) < hi_)
#define SEAM(k) do { if (IN(k) && IN((k) + 1)) GRID_BAR(); } while (0)

    const float* x = args.in[0]; const float* meta_tok = args.in[1];
    float* rope = (float*)(ws + WS_ROPE);
    bf16* w_in_t = (bf16*)(ws + WS_WIN); bf16* w_qb_t = (bf16*)(ws + WS_WQB); bf16* w_kvb_t = (bf16*)(ws + WS_WKVB); bf16* w_o_t = (bf16*)(ws + WS_WO);
    bf16* w_r_t = (bf16*)(ws + WS_WR); bf16* w_gu_t = (bf16*)(ws + WS_WGU); bf16* w_dn_t = (bf16*)(ws + WS_WDN);
    bf16* h0 = (bf16*)(ws + WS_H0); bf16* h1 = (bf16*)(ws + WS_H1); bf16* qan = (bf16*)(ws + WS_QAN); bf16* kvan = (bf16*)(ws + WS_KVAN); bf16* z = (bf16*)(ws + WS_Z);
    bf16* qm = (bf16*)(ws + WS_QM); bf16* km = (bf16*)(ws + WS_KM); bf16* vm = (bf16*)(ws + WS_VM); bf16* qg = (bf16*)(ws + WS_QG); bf16* kg = (bf16*)(ws + WS_KG); bf16* vg = (bf16*)(ws + WS_VG);
    bf16* ob = (bf16*)(ws + WS_O); float* y1 = (float*)(ws + WS_Y1); float* logits = (float*)(ws + WS_LOGITS);
    int* topk = (int*)(ws + WS_TOPK); float* gate = (float*)(ws + WS_GATE); int* pair_pos = (int*)(ws + WS_PAIRPOS); float* row_gate = (float*)(ws + WS_ROWGATE);
    int* hist = (int*)(ws + WS_HIST); int* moetab = (int*)(ws + WS_MOETAB); int* tile_expert = moetab + 256;
    bf16* xs = (bf16*)(ws + WS_XS); bf16* act = (bf16*)(ws + WS_ACT); bf16* out2 = (bf16*)(ws + WS_OUT2);

    if (IN(0)) {
        LAS float* scr = (LAS float*)((LAS unsigned char*)lds + wave * 16384);
        constexpr int I_IN = 16 * 46, I_QB = 4 * 24, I_KVB = 2 * 32, I_O = 16 * 32, I_R = 16, I_GU1 = 16 * 64, I_DN1 = 16 * 32;
        constexpr int NITEMS = I_IN + I_QB + I_KVB + I_O + I_R + NE * I_GU1 + NE * I_DN1;
        for (int it = gw; it < NITEMS; it += ngw) {
            int r = it;
            if (r < I_IN) { transpose_item(args.in[4], 1024, NIN, w_in_t, scr, r, lane, MapIn()); continue; } r -= I_IN;
            if (r < I_QB) { transpose_item(args.in[6], 256, 768, w_qb_t, scr, r, lane, MapQ()); continue; } r -= I_QB;
            if (r < I_KVB) { transpose_item(args.in[8], 128, 1024, w_kvb_t, scr, r, lane, MapId()); continue; } r -= I_KVB;
            if (r < I_O) { transpose_item(args.in[13], 1024, 1024, w_o_t, scr, r, lane, MapId()); continue; } r -= I_O;
            if (r < I_R) { transpose_item(args.in[16], 1024, 32, w_r_t, scr, r, lane, MapId()); continue; } r -= I_R;
            if (r < NE * I_GU1) { const int e = r / I_GU1; transpose_item(args.in[18] + (size_t)e * 1024 * 2048, 1024, 2048, w_gu_t + (size_t)e * 2048 * 1024, scr, r - e * I_GU1, lane, MapGU()); continue; } r -= NE * I_GU1;
            { const int e = r / I_DN1; transpose_item(args.in[20] + (size_t)e * 1024 * 1024, 1024, 1024, w_dn_t + (size_t)e * 1024 * 1024, scr, r - e * I_DN1, lane, MapId()); }
        }
        for (int m = gw; m < MROWS; m += ngw) ln_row_f32_to_bf16(m < NTOK ? x + (size_t)m * DM : meta_tok + (size_t)(m - NTOK) * DM, args.in[2], args.in[3], h0 + (size_t)m * DM, lane);
        zero_bytes(h0 + (size_t)MROWS * DM, (size_t)(MPAD - MROWS) * DM * 2, gtid, ngt);
        zero_bytes(w_in_t + (size_t)NIN * 1024, (size_t)(ZLD - NIN) * 1024 * 2, gtid, ngt);
        for (int i = gw; i < 64 + 64 + 32 + 32; i += ngw) {
            bf16* p; size_t rb;
            if (i < 64) { p = km + ((size_t)i * LKP + 2064) * 192; rb = 48 * 192 * 2; }
            else if (i < 128) { p = vm + ((size_t)(i - 64) * LKP + 2064) * 128; rb = 48 * 128 * 2; }
            else if (i < 160) { p = kg + ((size_t)(i - 128) * LKP + 2064) * 128; rb = 48 * 128 * 2; }
            else { p = vg + ((size_t)(i - 160) * LKP + 2064) * 128; rb = 48 * 128 * 2; }
            zero_bytes(p, rb, lane, 64);
        }
        for (int i = gtid; i < 2065 * 32; i += ngt) {
            const int p = i / 32 - 1, f = i & 31; double inv = 1.0;
            for (int q = 0; q < f; ++q) inv *= 0.74989420933245582730;
            const float ang = (float)p * (float)inv; float sn, cs; sincos_d(fabsf(ang), sn, cs); if (ang < 0.f) sn = -sn;
            rope[2 * i] = cs; rope[2 * i + 1] = sn;
        }
    }
    SEAM(0);
    if (IN(1)) { EpiZ E{z}; simple_gemm(h0, w_in_t, 1024, 0, NTOK + 64, ZLD, E, BSelNone(), gw, ngw, lane); }
    SEAM(1);
    if (IN(2)) { for (int m = gw; m < MROWS; m += ngw) p2a_row(m, z, rope, args.in[5], args.in[7], args.in[9], args.in[10], qan, kvan, km, qg, kg, vg, lane); }
    SEAM(2);
    if (IN(3)) {
        { EpiQ E{qm, rope}; simple_gemm(qan, w_qb_t, 256, 0, NTOK, 768, E, BSelNone(), gw, ngw, lane); }
        { EpiKV E{km, vm}; simple_gemm(kvan, w_kvb_t, 128, 0, NTOK + 64, 1024, E, BSelNone(), gw, ngw, lane); }
    }
    SEAM(3);
    if (IN(4)) {
        for (int u = vcu; u < 1024; u += G) {
            if (u < 512) { const int b = u >> 5, h = (u >> 3) & 3, qb = u & 7, bh = b * 4 + h;
                attn_body<192, 1>(qm + ((size_t)bh * 2048 + qb * 256) * 192, km + (size_t)bh * LKP * 192, vm + (size_t)bh * LKP * 128, ob + ((size_t)b * 2048 + qb * 256) * DM + h * 128, (LAS char*)lds);
            } else { const int v = u - 512, b = v >> 5, h = (v >> 3) & 3, qb = v & 7, bh = b * 4 + h, bk = b * 2 + (h >> 1);
                attn_body<128, 2>(qg + ((size_t)bh * 2048 + qb * 256) * 128, kg + (size_t)bk * LKP * 128, vg + (size_t)bk * LKP * 128, ob + ((size_t)b * 2048 + qb * 256) * DM + 512 + h * 128, (LAS char*)lds);
            }
        }
    }
    SEAM(4);
    if (IN(5)) {
        for (int m = gw; m < NTOK; m += ngw) {
#pragma unroll
            for (int g = 0; g < 2; ++g) { bf16* p = ob + (size_t)m * DM + g * 512 + 8 * lane; float f[8]; unpack8(*(const u32x4*)p, f);
                float ss = 0.f;
#pragma unroll
                for (int j = 0; j < 8; ++j) ss += f[j] * f[j];
                const float rs = rsq(wave_sum(ss) * (1.f / 512) + RMS_EPS); const float* gg = (g ? args.in[12] : args.in[11]) + 8 * lane;
#pragma unroll
                for (int j = 0; j < 8; ++j) f[j] = f[j] * rs * gg[j];
                *(u32x4*)p = pack8(f); }
        }
    }
    SEAM(5);
    if (IN(6)) { EpiO E{y1, h0}; simple_gemm(ob, w_o_t, 1024, 0, NTOK, 1024, E, BSelNone(), gw, ngw, lane); }
    SEAM(6);
    if (IN(7)) { for (int m = gw; m < NTOK; m += ngw) ln_row_f32_to_bf16(y1 + (size_t)m * DM, args.in[14], args.in[15], h1 + (size_t)m * DM, lane); }
    SEAM(7);
    if (IN(8)) { EpiLogit E{logits, args.in[17]}; simple_gemm(h1, w_r_t, 1024, 0, NTOK, 32, E, BSelNone(), gw, ngw, lane); }
    SEAM(8);
    const int tpb = (NTOK + G - 1) / G, tok_lo = bx * tpb, tok_hi = (tok_lo + tpb < NTOK) ? tok_lo + tpb : NTOK;
    LAS int* L_hist = (LAS int*)((LAS unsigned char*)lds + LDSCTL_OFF + 256);
    LAS int* L_n = L_hist + 32; LAS int* L_base = L_hist + 64; LAS int* L_off = L_hist + 96;
    if (IN(9)) {
        if (tid < 32) L_hist[tid] = 0;
        __syncthreads();
        for (int t = tok_lo + wave; t < tok_hi; t += NWAVES) {
            float v = lane < 32 ? logits[(size_t)t * NE + lane] : -INFINITY; float tv[4]; int ti[4];
#pragma unroll
            for (int r = 0; r < 4; ++r) { float bv = v; int bi = lane;
#pragma unroll
                for (int off = 32; off >= 1; off >>= 1) { const float ov = __shfl_xor(bv, off); const int oi = __shfl_xor(bi, off); if (ov > bv || (ov == bv && oi < bi)) { bv = ov; bi = oi; } }
                tv[r] = bv; ti[r] = bi; if (lane == bi) v = -INFINITY; }
            const float e1 = __expf(tv[1] - tv[0]), e2 = __expf(tv[2] - tv[0]), e3 = __expf(tv[3] - tv[0]), inv = 1.f / (1.f + e1 + e2 + e3);
            if (lane == 0) { *(int4*)(topk + (size_t)t * 4) = make_int4(ti[0], ti[1], ti[2], ti[3]); *(f32x4*)(gate + (size_t)t * 4) = (f32x4){inv, e1 * inv, e2 * inv, e3 * inv};
                atomicAdd((int*)(L_hist + ti[0]), 1); atomicAdd((int*)(L_hist + ti[1]), 1); atomicAdd((int*)(L_hist + ti[2]), 1); atomicAdd((int*)(L_hist + ti[3]), 1); }
        }
        __syncthreads();
        if (tid < 32) hist[bx * 32 + tid] = L_hist[tid];
    }
    SEAM(9);
    if (IN(10)) {
        if (tid < 32) { int tot = 0, before = 0; for (int b = 0; b < G; ++b) { const int h = hist[b * 32 + tid]; tot += h; if (b < bx) before += h; } L_n[tid] = tot; L_base[tid] = before; L_hist[tid] = 0; }
        __syncthreads();
        if (tid == 0) { int off = 0; for (int e = 0; e < NE; ++e) { L_off[e] = off; off += (L_n[e] + 255) & ~255; } L_off[NE] = off; }
        __syncthreads();
        LAS int* L_pos = (LAS int*)((LAS unsigned char*)lds);
        for (int p = tok_lo * 4 + tid; p < tok_hi * 4; p += NWAVES * 64) { const int e = topk[p]; const int r = atomicAdd((int*)(L_hist + e), 1); const int pos = L_off[e] + L_base[e] + r;
            row_gate[pos] = gate[p]; pair_pos[p] = pos; L_pos[p - tok_lo * 4] = pos; }
        __syncthreads();
        for (int p = tok_lo * 4 + wave; p < tok_hi * 4; p += NWAVES) { const int pos = L_pos[p - tok_lo * 4]; const u32x4* src = (const u32x4*)(h1 + (size_t)(p >> 2) * DM); u32x4* dst = (u32x4*)(xs + (size_t)pos * DM);
            dst[lane] = src[lane]; dst[lane + 64] = src[lane + 64]; }
        if (bx == 0) { if (tid == 0) moetab[0] = L_off[NE];
            if (tid < 32) { moetab[64 + tid] = L_n[tid]; moetab[128 + tid] = L_off[tid]; for (int t = L_off[tid] >> 8; t < (L_off[tid + 1] >> 8); ++t) tile_expert[t] = tid; } }
        __syncthreads();
    }
    SEAM(10);
    if (IN(11)) { const int rows = moetab[0]; EpiGU E{act, args.in[19], tile_expert}; simple_gemm(xs, w_gu_t, 1024, 0, rows, 2048, E, BSelExpert{tile_expert, (size_t)2048 * 1024}, gw, ngw, lane); }
    SEAM(11);
    if (IN(12)) { const int rows = moetab[0]; EpiDN E{out2, args.in[21], row_gate, tile_expert}; simple_gemm(act, w_dn_t, 1024, 0, rows, 1024, E, BSelExpert{tile_expert, (size_t)1024 * 1024}, gw, ngw, lane); }
    SEAM(12);
    if (IN(13)) {
        for (int t = gw; t < NTOK; t += ngw) {
            const int4 pp = *(const int4*)(pair_pos + (size_t)t * 4); const int ps[4] = {pp.x, pp.y, pp.z, pp.w};
            float v[16];
#pragma unroll
            for (int hf = 0; hf < 2; ++hf) { float f[8]; unpack8(*(const u32x4*)(h1 + (size_t)t * DM + hf * 512 + 8 * lane), f);
#pragma unroll
                for (int j = 0; j < 8; ++j) v[hf * 8 + j] = ALPHA * f[j];
#pragma unroll
                for (int s4 = 0; s4 < 4; ++s4) { float g[8]; unpack8(*(const u32x4*)(out2 + (size_t)ps[s4] * DM + hf * 512 + 8 * lane), g);
#pragma unroll
                    for (int j = 0; j < 8; ++j) v[hf * 8 + j] += g[j]; } }
            float s = 0.f;
#pragma unroll
            for (int j = 0; j < 16; ++j) s += v[j];
            const float mean = wave_sum(s) * (1.f / DM); float s2 = 0.f;
#pragma unroll
            for (int j = 0; j < 16; ++j) { v[j] -= mean; s2 += v[j] * v[j]; }
            const float rstd = rsq(wave_sum(s2) * (1.f / DM) + LN_EPS);
#pragma unroll
            for (int hf = 0; hf < 2; ++hf) { const int c = hf * 512 + 8 * lane; const float* gg = args.in[22] + c; const float* bb = args.in[23] + c; float* o = args.out + (size_t)t * DM + c;
                *(f32x4*)o = (f32x4){v[hf * 8 + 0] * rstd * gg[0] + bb[0], v[hf * 8 + 1] * rstd * gg[1] + bb[1], v[hf * 8 + 2] * rstd * gg[2] + bb[2], v[hf * 8 + 3] * rstd * gg[3] + bb[3]};
                *(f32x4*)(o + 4) = (f32x4){v[hf * 8 + 4] * rstd * gg[4] + bb[4], v[hf * 8 + 5] * rstd * gg[5] + bb[5], v[hf * 8 + 6] * rstd * gg[6] + bb[6], v[hf * 8 + 7] * rstd * gg[7] + bb[7]}; }
        }
    }
#undef IN
#undef SEAM
}

extern "C" void kernel_launch(void* const* d_in, const int* in_sizes, int n_in, void* d_out, int out_size, void* d_ws, size_t ws_size, hipStream_t stream) {
    static int grid = 0;
    if (grid == 0) {
        if (n_in != 24 || in_sizes[0] != NTOK * DM || out_size != NTOK * DM || ws_size < WS_END) { fprintf(stderr, "kernel_launch: shape/workspace mismatch (n_in %d, ws %zu)\n", n_in, ws_size); grid = -1; return; }
        int dev = 0, cus = 0, per_cu = 0;
        if (hipGetDevice(&dev) != hipSuccess || hipDeviceGetAttribute(&cus, hipDeviceAttributeMultiprocessorCount, dev) != hipSuccess) { grid = -1; return; }
        if (hipFuncSetAttribute((const void*)hymba_fwd, hipFuncAttributeMaxDynamicSharedMemorySize, LDS_BYTES) != hipSuccess) { fprintf(stderr, "kernel_launch: hipFuncSetAttribute failed\n"); grid = -1; return; }
        if (hipOccupancyMaxActiveBlocksPerMultiprocessor(&per_cu, (const void*)hymba_fwd, NWAVES * 64, LDS_BYTES) != hipSuccess || per_cu < 1) fprintf(stderr, "kernel_launch: occupancy query says %d\n", per_cu);
        (void)hipGetLastError();
        grid = cus;
    }
    if (grid < 0) return;
    (void)hipMemsetAsync((char*)d_ws + WS_CTL, 0, CTL_ZERO_BYTES, stream);
    Args a{};
    for (int i = 0; i < 24; ++i) a.in[i] = (const float*)d_in[i];
    a.out = (float*)d_out; a.ws = (unsigned char*)d_ws;
#if MK_SPLIT
    for (int p = 0; p < NPHASE; ++p) { a.ph_lo = p; a.ph_hi = p + 1; hipLaunchKernelGGL(hymba_fwd, dim3(grid), dim3(NWAVES * 64), LDS_BYTES, stream, a); }
#else
    a.ph_lo = 0; a.ph_hi = NPHASE; hipLaunchKernelGGL(hymba_fwd, dim3(grid), dim3(NWAVES * 64), LDS_BYTES, stream, a);
#endif
}
```

```cpp
#include <hip/hip_runtime.h>
#include <cstdio>
#include <cstdint>

#ifndef MK_SPLIT
#define MK_SPLIT 0
#endif

#define LAS __attribute__((address_space(3)))
typedef unsigned short bf16;
typedef short bf16x8 __attribute__((ext_vector_type(8)));
typedef short s16x4 __attribute__((ext_vector_type(4)));
typedef float f32x2 __attribute__((ext_vector_type(2)));
typedef float f32x4 __attribute__((ext_vector_type(4)));
typedef float f32x16 __attribute__((ext_vector_type(16)));
typedef unsigned u32x2 __attribute__((ext_vector_type(2)));
typedef unsigned u32x4 __attribute__((ext_vector_type(4)));
typedef __bf16 bf16x2_t __attribute__((ext_vector_type(2)));

constexpr int NB = 16, SEQ = 2048, DM = 1024, NMETA = 16;
constexpr int NTOK = NB * SEQ;
constexpr int MROWS = NTOK + NMETA;
constexpr int MPAD = 33024;
constexpr int LKP = 2112;
constexpr int NIN = 1472, ZLD = 1536;
constexpr int NE = 32, NPAIR = NTOK * 4, MOE_TILES_MAX = 544, MOE_ROWS_MAX = MOE_TILES_MAX * 256;
constexpr float ALPHA = 1.189207115002721f;
constexpr float RMS_EPS = 1e-6f, LN_EPS = 1e-5f;

constexpr size_t MiB = 1u << 20;
constexpr size_t WS_CTL = 0, CTL_ZERO_BYTES = 1 * MiB;
constexpr size_t WS_ROPE = 1 * MiB;
constexpr size_t WS_WQB = 2 * MiB;
constexpr size_t WS_WKVB = 2 * MiB + 512 * 1024;
constexpr size_t WS_WR = 3 * MiB;
constexpr size_t WS_LOGITS = 4 * MiB;
constexpr size_t WS_TOPK = 8 * MiB;
constexpr size_t WS_GATE = 8 * MiB + 512 * 1024;
constexpr size_t WS_PAIRPOS = 9 * MiB;
constexpr size_t WS_ROWGATE = 9 * MiB + 512 * 1024;
constexpr size_t WS_HIST = 10 * MiB + 512 * 1024;
constexpr size_t WS_MOETAB = 10 * MiB + 768 * 1024;
constexpr size_t WS_WIN = 12 * MiB;
constexpr size_t WS_WO = 15 * MiB;
constexpr size_t WS_WGU = 32 * MiB;
constexpr size_t WS_WDN = 160 * MiB;
constexpr size_t WS_H0 = 224 * MiB;
constexpr size_t WS_H1 = 289 * MiB;
constexpr size_t WS_QAN = 353 * MiB;
constexpr size_t WS_KVAN = 370 * MiB;
constexpr size_t WS_Z = 380 * MiB;
constexpr size_t WS_QM = 477 * MiB;
constexpr size_t WS_KM = 525 * MiB;
constexpr size_t WS_VM = 575 * MiB;
constexpr size_t WS_QG = 608 * MiB;
constexpr size_t WS_KG = 640 * MiB;
constexpr size_t WS_VG = 657 * MiB;
constexpr size_t WS_O = 674 * MiB;
constexpr size_t WS_Y1 = 738 * MiB;
constexpr size_t WS_XS = 380 * MiB;
constexpr size_t WS_ACT = 652 * MiB;
constexpr size_t WS_OUT2 = 380 * MiB;
constexpr size_t WS_END = 924 * MiB;
static_assert(WS_Z + (size_t)MPAD * ZLD * 2 <= WS_QM && WS_QM + (size_t)64 * 2048 * 192 * 2 <= WS_KM && WS_KM + (size_t)64 * LKP * 192 * 2 <= WS_VM && WS_VM + (size_t)64 * LKP * 128 * 2 <= WS_QG, "ws map 1");
static_assert(WS_QG + (size_t)64 * 2048 * 128 * 2 <= WS_KG && WS_KG + (size_t)32 * LKP * 128 * 2 <= WS_VG && WS_VG + (size_t)32 * LKP * 128 * 2 <= WS_O && WS_O + (size_t)NTOK * DM * 2 <= WS_Y1 && WS_Y1 + (size_t)NTOK * DM * 4 <= WS_END, "ws map 2");
static_assert(WS_XS + (size_t)MOE_ROWS_MAX * DM * 2 <= WS_ACT && WS_ACT + (size_t)MOE_ROWS_MAX * DM * 2 <= WS_END, "ws map 3");
static_assert(WS_H0 + (size_t)MPAD * DM * 2 <= WS_H1 && WS_H1 + (size_t)NTOK * DM * 2 <= WS_QAN && WS_QAN + (size_t)MPAD * 256 * 2 <= WS_KVAN && WS_KVAN + (size_t)MPAD * 128 * 2 <= WS_Z, "ws map 4");
constexpr int CW_BAR = 4096;

constexpr int RING_BYTES = 131072;
constexpr int LDSCTL_OFF = RING_BYTES;
constexpr int LDS_BYTES = 147456;
constexpr int NWAVES = 8;

#define LDS_WAIT() asm volatile("s_waitcnt lgkmcnt(0)" ::: "memory")
#define SBAR() __builtin_amdgcn_sched_barrier(0)
__device__ __forceinline__ unsigned cvtpk(float lo, float hi) { f32x2 v = {lo, hi}; bf16x2_t b = __builtin_convertvector(v, bf16x2_t); return __builtin_bit_cast(unsigned, b); }
__device__ __forceinline__ u32x4 pack8(const float (&v)[8]) { u32x4 r = {cvtpk(v[0], v[1]), cvtpk(v[2], v[3]), cvtpk(v[4], v[5]), cvtpk(v[6], v[7])}; return r; }
__device__ __forceinline__ void unpack8(u32x4 w, float (&v)[8]) {
    v[0] = __uint_as_float(w.x << 16); v[1] = __uint_as_float(w.x & 0xffff0000u); v[2] = __uint_as_float(w.y << 16); v[3] = __uint_as_float(w.y & 0xffff0000u);
    v[4] = __uint_as_float(w.z << 16); v[5] = __uint_as_float(w.z & 0xffff0000u); v[6] = __uint_as_float(w.w << 16); v[7] = __uint_as_float(w.w & 0xffff0000u);
}
__device__ __forceinline__ float wave_sum(float v) {
#pragma unroll
    for (int o = 1; o < 64; o <<= 1) v += __shfl_xor(v, o);
    return v;
}
__device__ __forceinline__ float rsq(float x) { return __builtin_amdgcn_rsqf(x); }

#define XB_TMO      128
#define XB_XCNT(j)  (256  + 64 * (j))
#define XB_XSUB(j)  (1280 + 64 * (j))
#define XB_XGEN(j)  (2304 + 64 * (j))
#define XB_TOP      3328
#define XB_TOPGEN   3392
#define XCD_BAR_WORDS 3456
#define XB_SPIN_CAP (1u << 18)
__device__ __forceinline__ unsigned xb_ld(unsigned* p)              { return __hip_atomic_load(p, __ATOMIC_RELAXED, __HIP_MEMORY_SCOPE_AGENT); }
__device__ __forceinline__ unsigned xb_add(unsigned* p, unsigned v) { return __hip_atomic_fetch_add(p, v, __ATOMIC_RELAXED, __HIP_MEMORY_SCOPE_AGENT); }
__device__ __forceinline__ unsigned xb_xcc_id() { return (unsigned)__builtin_amdgcn_s_getreg((3 << 11) | 20) & 0xFu; }
#define XB_SPIN(cond, bar) do { unsigned _sp = 0; while (cond) { __builtin_amdgcn_s_sleep(1); \
    if ((++_sp & 255u) == 0u) { if (xb_ld(&(bar)[XB_TMO])) break; if (_sp > XB_SPIN_CAP) { atomicAdd(&(bar)[XB_TMO], 1u); break; } } } } while (0)
struct XcdBarrier { unsigned* bar; unsigned x; volatile LAS unsigned* st; };
__device__ __forceinline__ XcdBarrier xcd_barrier_post(unsigned* bar, volatile LAS unsigned* st) {
    XcdBarrier b; b.bar = bar; b.x = xb_xcc_id(); b.st = st;
    if (threadIdx.x == 0) (void)xb_add(&bar[XB_XCNT(b.x)], 1u);
    return b;
}
__device__ __forceinline__ void xcd_barrier_complete(unsigned* bar, unsigned x, unsigned& nloc, unsigned& nx) {
    const unsigned G = gridDim.x * gridDim.y * gridDim.z;
    unsigned sum, cnt, mine, sp = 0u;
    for (;;) {
        sum = 0u; cnt = 0u; mine = 0u;
#pragma unroll
        for (unsigned j = 0; j < 16; ++j) { const unsigned c = xb_ld(&bar[XB_XCNT(j)]); sum += c; cnt += (c > 0u) ? 1u : 0u; mine = (j == x) ? c : mine; }
        if (sum == G) break;
        __builtin_amdgcn_s_sleep(1);
        if ((++sp & 255u) == 0u) { if (xb_ld(&bar[XB_TMO])) break; if (sp > XB_SPIN_CAP) { atomicAdd(&bar[XB_TMO], 1u); break; } }
    }
    nloc = mine > 0u ? mine : 1u; nx = cnt > 0u ? cnt : 1u;
}
__device__ __forceinline__ void xcd_barrier(const XcdBarrier& b) {
    asm volatile("s_waitcnt vmcnt(0)" ::: "memory");
    __syncthreads();
    if (threadIdx.x == 0) {
        unsigned* bar = b.bar;
        __builtin_amdgcn_s_waitcnt(0);
        unsigned nloc = b.st[0], nx = b.st[1];
        if (nloc == 0u) { xcd_barrier_complete(bar, b.x, nloc, nx); b.st[0] = nloc; b.st[1] = nx; }
        const unsigned old = xb_add(&bar[XB_XSUB(b.x)], 1u);
        const unsigned gen = old / nloc;
        if (old + 1u == (gen + 1u) * nloc) {
            __builtin_amdgcn_fence(__ATOMIC_RELEASE, "agent");
            asm volatile("s_waitcnt vmcnt(0)" ::: "memory");
            const unsigned og = xb_add(&bar[XB_TOP], 1u);
            const unsigned tg = og / nx;
            if (og + 1u == (tg + 1u) * nx) xb_add(&bar[XB_TOPGEN], 1u);
            else XB_SPIN(xb_ld(&bar[XB_TOPGEN]) == tg, bar);
            __builtin_amdgcn_fence(__ATOMIC_ACQUIRE, "agent");
            xb_add(&bar[XB_XGEN(b.x)], 1u);
            asm volatile("s_waitcnt vmcnt(0)" ::: "memory");
        } else {
            XB_SPIN(xb_ld(&bar[XB_XGEN(b.x)]) == gen, bar);
            __builtin_amdgcn_fence(__ATOMIC_ACQUIRE, "agent");
            asm volatile("s_waitcnt vmcnt(0)" ::: "memory");
        }
    }
    __syncthreads();
}

struct BSelNone { __device__ __forceinline__ size_t operator()(int) const { return 0; } };
struct BSelExpert { const int* tile_expert; size_t per; __device__ __forceinline__ size_t operator()(int m0) const { return (size_t)tile_expert[m0 >> 8] * per; } };
template <class Epi, class BSel>
__device__ __forceinline__ void simple_gemm(const bf16* __restrict__ A, const bf16* __restrict__ Bt, int K, int m_lo, int m_hi, int N, const Epi& E, const BSel& bsel, int gw, int ngw, int lane) {
    const int fr = lane & 15, fq = lane >> 4;
    const int mt = (m_hi - m_lo) / 64, nt = N / 32;
    for (int u = gw; u < mt * nt; u += ngw) {
        const int m0 = m_lo + (u / nt) * 64, n0 = (u % nt) * 32;
        const bf16* ap = A + (size_t)(m0 + fr) * K + fq * 8;
        const bf16* bp = Bt + bsel(m0) + (size_t)(n0 + 8 * (fr >> 2) + (fr & 3)) * K + fq * 8;
        f32x4 acc[4][2];
#pragma unroll
        for (int i = 0; i < 4; ++i) { acc[i][0] = (f32x4){0.f, 0.f, 0.f, 0.f}; acc[i][1] = (f32x4){0.f, 0.f, 0.f, 0.f}; }
#pragma unroll 2
        for (int k = 0; k < K; k += 32) {
            bf16x8 a[4], b[2];
#pragma unroll
            for (int i = 0; i < 4; ++i) a[i] = *(const bf16x8*)(ap + (size_t)i * 16 * K + k);
#pragma unroll
            for (int j = 0; j < 2; ++j) b[j] = *(const bf16x8*)(bp + (size_t)j * 4 * K + k);
#pragma unroll
            for (int i = 0; i < 4; ++i)
#pragma unroll
                for (int j = 0; j < 2; ++j) acc[i][j] = __builtin_amdgcn_mfma_f32_16x16x32_bf16(b[j], a[i], acc[i][j], 0, 0, 0);
        }
#pragma unroll
        for (int i = 0; i < 4; ++i) {
            const float v[8] = {acc[i][0][0], acc[i][0][1], acc[i][0][2], acc[i][0][3], acc[i][1][0], acc[i][1][1], acc[i][1][2], acc[i][1][3]};
            E.store8(m0 + 16 * i + fr, n0 + 8 * fq, v);
        }
    }
}

struct EpiZ { bf16* z;
    __device__ __forceinline__ void store8(int row, int col, const float (&v)[8]) const { if (col < NIN) *(u32x4*)(z + (size_t)row * ZLD + col) = pack8(v); } };
struct EpiQ { bf16* qm; const float* rope;
    __device__ __forceinline__ void store8(int row, int col, const float (&v)[8]) const {
        const int h = col / 192, w = col - h * 192, b = row >> 11, s = row & 2047;
        float o[8];
        if (w < 128) {
#pragma unroll
            for (int j = 0; j < 8; ++j) o[j] = v[j];
        } else {
            const float* t = rope + ((size_t)(16 + s + 1) * 32 + ((w - 128) >> 1)) * 2;
#pragma unroll
            for (int j = 0; j < 4; ++j) { const float c = t[2 * j], sn = t[2 * j + 1], x1 = v[2 * j], x2 = v[2 * j + 1]; o[2 * j] = x1 * c - x2 * sn; o[2 * j + 1] = x1 * sn + x2 * c; }
        }
        *(u32x4*)(qm + ((size_t)(b * 4 + h) * 2048 + s) * 192 + w) = pack8(o);
    } };
struct EpiKV { bf16* km; bf16* vm;
    __device__ __forceinline__ void store8(int row, int col, const float (&v)[8]) const {
        if (row >= MROWS) return;
        const int h = col >> 8, w = col & 255; const u32x4 pk = pack8(v);
        if (row < NTOK) { const int b = row >> 11, key = row & 2047; const size_t r = (size_t)(b * 4 + h) * LKP + key;
            if (w < 128) *(u32x4*)(km + r * 192 + w) = pk; else *(u32x4*)(vm + r * 128 + (w - 128)) = pk;
        } else { const int key = 2048 + (row - NTOK);
            for (int b = 0; b < NB; ++b) { const size_t r = (size_t)(b * 4 + h) * LKP + key;
                if (w < 128) *(u32x4*)(km + r * 192 + w) = pk; else *(u32x4*)(vm + r * 128 + (w - 128)) = pk; } }
    } };
struct EpiO { float* y1; const bf16* h0;
    __device__ __forceinline__ void store8(int row, int col, const float (&v)[8]) const {
        float h[8]; unpack8(*(const u32x4*)(h0 + (size_t)row * DM + col), h);
        float* y = y1 + (size_t)row * DM + col;
        *(f32x4*)y = (f32x4){ALPHA * h[0] + v[0], ALPHA * h[1] + v[1], ALPHA * h[2] + v[2], ALPHA * h[3] + v[3]};
        *(f32x4*)(y + 4) = (f32x4){ALPHA * h[4] + v[4], ALPHA * h[5] + v[5], ALPHA * h[6] + v[6], ALPHA * h[7] + v[7]};
    } };
struct EpiLogit { float* logits; const float* bias;
    __device__ __forceinline__ void store8(int row, int col, const float (&v)[8]) const {
        float* y = logits + (size_t)row * NE + col;
        *(f32x4*)y = (f32x4){v[0] + bias[col], v[1] + bias[col + 1], v[2] + bias[col + 2], v[3] + bias[col + 3]};
        *(f32x4*)(y + 4) = (f32x4){v[4] + bias[col + 4], v[5] + bias[col + 5], v[6] + bias[col + 6], v[7] + bias[col + 7]};
    } };
struct EpiGU { bf16* act; const float* bgu; const int* tile_expert;
    __device__ __forceinline__ void store8(int row, int col, const float (&v)[8]) const {
        const int e = tile_expert[row >> 8], ac = col >> 1;
        const float* bb = bgu + (size_t)e * 2048 + 2 * ac;
        const f32x4 b0 = *(const f32x4*)bb, b1 = *(const f32x4*)(bb + 4);
        const float bg[4] = {b0[0], b0[2], b1[0], b1[2]}, bl[4] = {b0[1], b0[3], b1[1], b1[3]};
        float o[4];
#pragma unroll
        for (int j = 0; j < 4; ++j) {
            const float xg = fminf(v[j] + bg[j], 7.f), xl = fminf(fmaxf(v[4 + j] + bl[j], -7.f), 7.f);
            const float sg = __builtin_amdgcn_rcpf(1.f + __builtin_amdgcn_exp2f(-1.702f * 1.4426950408889634f * xg));
            o[j] = xg * sg * (xl + 1.f);
        }
        *(u32x2*)(act + (size_t)row * DM + ac) = (u32x2){cvtpk(o[0], o[1]), cvtpk(o[2], o[3])};
    } };
struct EpiDN { bf16* out2; const float* bdn; const float* row_gate; const int* tile_expert;
    __device__ __forceinline__ void store8(int row, int col, const float (&v)[8]) const {
        const int e = tile_expert[row >> 8]; const float g = row_gate[row];
        const float* bb = bdn + (size_t)e * DM + col; const f32x4 b0 = *(const f32x4*)bb, b1 = *(const f32x4*)(bb + 4);
        const float o[8] = {(v[0] + b0[0]) * g, (v[1] + b0[1]) * g, (v[2] + b0[2]) * g, (v[3] + b0[3]) * g, (v[4] + b1[0]) * g, (v[5] + b1[1]) * g, (v[6] + b1[2]) * g, (v[7] + b1[3]) * g};
        *(u32x4*)(out2 + (size_t)row * DM + col) = pack8(o);
    } };

struct MapId { __device__ __forceinline__ int operator()(int n) const { return n; } };
struct MapIn { __device__ __forceinline__ int operator()(int n) const {
    if (n >= 384 && n < 448) { const int l = n - 384; return 384 + 2 * (l & 31) + (l >> 5); }
    if (n >= 448 && n < 1216) { const int l = n - 448, hd = l >> 7, d = l & 127; return 448 + hd * 128 + (d >> 6) * 64 + 2 * (d & 31) + ((d >> 5) & 1); }
    return n; } };
struct MapQ { __device__ __forceinline__ int operator()(int n) const { const int h = n / 192, w = n - h * 192; if (w < 128) return n; const int l = w - 128; return h * 192 + 128 + 2 * (l & 31) + (l >> 5); } };
struct MapGU { __device__ __forceinline__ int operator()(int n) const { const int a = n >> 1; return 8 * (a >> 2) + (a & 3) + 4 * (n & 1); } };
template <class Map>
__device__ __forceinline__ void transpose_item(const float* __restrict__ W, int K, int N, bf16* __restrict__ WT, LAS float* scr, int item, int lane, const Map& map) {
    const int nblk = N / 32, kb = item / nblk, nb = item - kb * nblk, k0 = 64 * kb, n0 = 32 * nb;
#pragma unroll 8
    for (int i = 0; i < 32; ++i) { const int kk = 2 * i + (lane >> 5); scr[kk * 33 + (lane & 31)] = W[(size_t)(k0 + kk) * N + n0 + (lane & 31)]; }
    LDS_WAIT(); asm volatile("" ::: "memory");
    const int c = lane & 7;
#pragma unroll
    for (int j = 0; j < 4; ++j) { const int n = (lane >> 3) + 8 * j; const LAS float* s = scr + (8 * c) * 33 + n;
        u32x4 o; o.x = cvtpk(s[0 * 33], s[1 * 33]); o.y = cvtpk(s[2 * 33], s[3 * 33]); o.z = cvtpk(s[4 * 33], s[5 * 33]); o.w = cvtpk(s[6 * 33], s[7 * 33]);
        *(u32x4*)(WT + (size_t)map(n0 + n) * K + k0 + 8 * c) = o; }
    LDS_WAIT(); asm volatile("" ::: "memory");
}
__device__ __forceinline__ void ln_row_f32_to_bf16(const float* __restrict__ xrow, const float* __restrict__ g, const float* __restrict__ bta, bf16* __restrict__ orow, int lane) {
    f32x4 v[4]; float s = 0.f;
#pragma unroll
    for (int j = 0; j < 4; ++j) { v[j] = ((const f32x4*)xrow)[lane + 64 * j]; s += (v[j].x + v[j].y) + (v[j].z + v[j].w); }
    const float mean = wave_sum(s) * (1.f / DM); float s2 = 0.f;
#pragma unroll
    for (int j = 0; j < 4; ++j) { v[j] = v[j] - mean; s2 += (v[j].x * v[j].x + v[j].y * v[j].y) + (v[j].z * v[j].z + v[j].w * v[j].w); }
    const float rstd = rsq(wave_sum(s2) * (1.f / DM) + LN_EPS);
#pragma unroll
    for (int j = 0; j < 4; ++j) { const f32x4 gg = ((const f32x4*)g)[lane + 64 * j], bb = ((const f32x4*)bta)[lane + 64 * j]; const f32x4 o = v[j] * rstd * gg + bb;
        ((u32x2*)orow)[lane + 64 * j] = (u32x2){cvtpk(o.x, o.y), cvtpk(o.z, o.w)}; }
}
__device__ __forceinline__ void zero_bytes(void* p, size_t bytes, int gtid, int ngt) {
    u32x4* q = (u32x4*)p; const size_t n = bytes / 16;
    for (size_t i = gtid; i < n; i += ngt) q[i] = (u32x4){0u, 0u, 0u, 0u};
}
__device__ __forceinline__ void sincos_d(float angf, float& sn, float& cs) {
    const double x = (double)angf; const double q = __builtin_rint(x * 0.63661977236758134308);
    const double r = (x - q * 1.57079632679489655800) - q * 6.123233995736766036e-17, r2 = r * r;
    const double sp = r * (1.0 + r2 * (-1.0 / 6 + r2 * (1.0 / 120 + r2 * (-1.0 / 5040 + r2 * (1.0 / 362880 + r2 * (-1.0 / 39916800 + r2 * (1.0 / 6227020800.0)))))));
    const double cp = 1.0 + r2 * (-0.5 + r2 * (1.0 / 24 + r2 * (-1.0 / 720 + r2 * (1.0 / 40320 + r2 * (-1.0 / 3628800 + r2 * (1.0 / 479001600.0))))));
    const int qi = ((int)q) & 3;
    const double s_ = (qi == 0) ? sp : (qi == 1) ? cp : (qi == 2) ? -sp : -cp;
    const double c_ = (qi == 0) ? cp : (qi == 1) ? -sp : (qi == 2) ? -cp : sp;
    sn = (float)s_; cs = (float)c_;
}

__device__ __forceinline__ void p2a_row(int row, const bf16* __restrict__ z, const float* __restrict__ rope, const float* __restrict__ g_q_a, const float* __restrict__ g_kv_a,
                                        const float* __restrict__ g_q_gqa, const float* __restrict__ g_k_gqa, bf16* qan, bf16* kvan, bf16* km, bf16* qg, bf16* kg, bf16* vg, int lane) {
    const bf16* zr = z + (size_t)row * ZLD;
    const bool meta = row >= NTOK;
    const int b = row >> 11, s = row & 2047, m = row - NTOK;
    const int pos1 = meta ? m : 16 + s, prow = meta ? -1 : (s >> 6), pcol = meta ? m : (s & 63), key = meta ? 2048 + m : s;
    {
        float f[8]; u32x4 w = {0u, 0u, 0u, 0u}; if (lane < 56) w = *(const u32x4*)(zr + 8 * lane); unpack8(w, f);
        float ss = 0.f;
#pragma unroll
        for (int j = 0; j < 8; ++j) ss += f[j] * f[j];
        ss += __shfl_xor(ss, 1); ss += __shfl_xor(ss, 2); ss += __shfl_xor(ss, 4); ss += __shfl_xor(ss, 8);
        const float s16 = ss, s32 = ss + __shfl_xor(ss, 16);
        if (lane < 32) { const float rs = rsq(s32 * (1.f / 256) + RMS_EPS); float o[8];
#pragma unroll
            for (int j = 0; j < 8; ++j) o[j] = f[j] * rs * g_q_a[8 * lane + j];
            *(u32x4*)(qan + (size_t)row * 256 + 8 * lane) = pack8(o);
        } else if (lane < 48) { const float rs = rsq(s16 * (1.f / 128) + RMS_EPS); float o[8];
#pragma unroll
            for (int j = 0; j < 8; ++j) o[j] = f[j] * rs * g_kv_a[8 * (lane - 32) + j];
            *(u32x4*)(kvan + (size_t)row * 128 + 8 * (lane - 32)) = pack8(o);
        } else if (lane < 56) { const int i0 = 4 * (lane - 48); const float* t = rope + ((size_t)(pos1 + 1) * 32 + i0) * 2; float o[8];
#pragma unroll
            for (int j = 0; j < 4; ++j) { const float c = t[2 * j], sn = t[2 * j + 1], x1 = f[2 * j], x2 = f[2 * j + 1]; o[2 * j] = x1 * c - x2 * sn; o[2 * j + 1] = x1 * sn + x2 * c; }
            const u32x4 pk = pack8(o);
            if (!meta) { for (int h = 0; h < 4; ++h) *(u32x4*)(km + ((size_t)(b * 4 + h) * LKP + key) * 192 + 128 + 8 * (lane - 48)) = pk; }
            else { for (int bb = 0; bb < NB; ++bb) for (int h = 0; h < 4; ++h) *(u32x4*)(km + ((size_t)(bb * 4 + h) * LKP + key) * 192 + 128 + 8 * (lane - 48)) = pk; }
        }
    }
    const int p0 = (lane & 15) * 8, half = p0 >> 6, i0 = (p0 & 63) >> 1;
    const int apos = half ? pcol : prow; const float* t = rope + ((size_t)(apos + 1) * 32 + i0) * 2;
    if (!meta) {
        float f[8]; unpack8(*(const u32x4*)(zr + 448 + 8 * lane), f);
        float ss = 0.f;
#pragma unroll
        for (int j = 0; j < 8; ++j) ss += f[j] * f[j];
        ss += __shfl_xor(ss, 1); ss += __shfl_xor(ss, 2); ss += __shfl_xor(ss, 4); ss += __shfl_xor(ss, 8);
        const float rs = rsq(ss * (1.f / 128) + RMS_EPS); float o[8];
#pragma unroll
        for (int j = 0; j < 4; ++j) { const int d1 = half * 64 + i0 + j, d2 = d1 + 32;
            const float x1 = f[2 * j] * rs * g_q_gqa[d1], x2 = f[2 * j + 1] * rs * g_q_gqa[d2], c = t[2 * j], sn = t[2 * j + 1];
            o[2 * j] = x1 * c - x2 * sn; o[2 * j + 1] = x1 * sn + x2 * c; }
        *(u32x4*)(qg + ((size_t)(b * 4 + (lane >> 4)) * 2048 + s) * 128 + p0) = pack8(o);
    }
    {
        float f[8]; unpack8(*(const u32x4*)(zr + 960 + 8 * lane), f);
        float ss = 0.f;
#pragma unroll
        for (int j = 0; j < 8; ++j) ss += f[j] * f[j];
        ss += __shfl_xor(ss, 1); ss += __shfl_xor(ss, 2); ss += __shfl_xor(ss, 4); ss += __shfl_xor(ss, 8);
        float o[8];
        if (lane < 32) { const float rs = rsq(ss * (1.f / 128) + RMS_EPS);
#pragma unroll
            for (int j = 0; j < 4; ++j) { const int d1 = half * 64 + i0 + j, d2 = d1 + 32;
                const float x1 = f[2 * j] * rs * g_k_gqa[d1], x2 = f[2 * j + 1] * rs * g_k_gqa[d2], c = t[2 * j], sn = t[2 * j + 1];
                o[2 * j] = x1 * c - x2 * sn; o[2 * j + 1] = x1 * sn + x2 * c; }
        } else {
#pragma unroll
            for (int j = 0; j < 8; ++j) o[j] = f[j];
        }
        const u32x4 pk = pack8(o); bf16* dst = lane < 32 ? kg : vg; const int hk = (lane >> 4) & 1;
        if (!meta) *(u32x4*)(dst + ((size_t)(b * 2 + hk) * LKP + key) * 128 + p0) = pk;
        else for (int bb = 0; bb < NB; ++bb) *(u32x4*)(dst + ((size_t)(bb * 2 + hk) * LKP + key) * 128 + p0) = pk;
    }
}

__device__ __forceinline__ int crow(int r, int hi) { return (r & 3) + 8 * (r >> 2) + 4 * hi; }
__device__ __forceinline__ int v_st(int k, int c) { const int kk = (k & ~0xC) | ((k & 4) << 1) | ((k & 8) >> 1); return ((kk >> 3) * 4 + (c >> 5)) * 512 + ((kk & 7) * 32 + (c & 31)) * 2; }
__device__ __forceinline__ int v_rd_base(int lane) { return ((lane & 3) << 3) | (((lane >> 2) & 3) << 6) | (((lane >> 4) & 1) << 5) | (((lane >> 5) & 1) << 8); }
constexpr int v_rd_off(int d0, int ks, int half) { return d0 * 512 + ks * 4096 + half * 2048; }
template <int OFF> __device__ __forceinline__ s16x4 tr_read(int vb) {
    s16x4 r; asm volatile("ds_read_b64_tr_b16 %0, %1 offset:%2" : "=&v"(r) : "v"(vb), "i"(OFF) : "memory"); return r;
}
template <int D0> __device__ __forceinline__ void pv_one(f32x16& od, int vb, bf16x8 pa0, bf16x8 pa1, bf16x8 pa2, bf16x8 pa3) {
    const s16x4 l0 = tr_read<v_rd_off(D0, 0, 0)>(vb), h0 = tr_read<v_rd_off(D0, 0, 1)>(vb), l1 = tr_read<v_rd_off(D0, 1, 0)>(vb), h1 = tr_read<v_rd_off(D0, 1, 1)>(vb);
    const s16x4 l2 = tr_read<v_rd_off(D0, 2, 0)>(vb), h2 = tr_read<v_rd_off(D0, 2, 1)>(vb), l3 = tr_read<v_rd_off(D0, 3, 0)>(vb), h3 = tr_read<v_rd_off(D0, 3, 1)>(vb);
    asm volatile("s_waitcnt lgkmcnt(0)" ::: "memory"); SBAR();
#define PK(L, H) (bf16x8){L[0], L[1], L[2], L[3], H[0], H[1], H[2], H[3]}
    od = __builtin_amdgcn_mfma_f32_32x32x16_bf16(pa0, PK(l0, h0), od, 0, 0, 0);
    od = __builtin_amdgcn_mfma_f32_32x32x16_bf16(pa1, PK(l1, h1), od, 0, 0, 0);
    od = __builtin_amdgcn_mfma_f32_32x32x16_bf16(pa2, PK(l2, h2), od, 0, 0, 0);
    od = __builtin_amdgcn_mfma_f32_32x32x16_bf16(pa3, PK(l3, h3), od, 0, 0, 0);
#undef PK
}
__device__ __forceinline__ void pv_d0(f32x16* o, int vb, bf16x8 pa0, bf16x8 pa1, bf16x8 pa2, bf16x8 pa3) {
    pv_one<0>(o[0], vb, pa0, pa1, pa2, pa3); pv_one<1>(o[1], vb, pa0, pa1, pa2, pa3); pv_one<2>(o[2], vb, pa0, pa1, pa2, pa3); pv_one<3>(o[3], vb, pa0, pa1, pa2, pa3);
}
template <int DQK> struct AttnC {
    static constexpr float SCALE = DQK == 192 ? 0.07216878364870322f : 0.08838834764831845f;
    static constexpr float C = SCALE * 1.4426950408889634f, THRS = 8.f / SCALE;
};
template <int DQK>
__device__ __forceinline__ void partialSM(f32x16& p0, f32x16& p1, float& m_reg, float& mn, float& alpha) {
    constexpr float C = AttnC<DQK>::C;
    float pmax = p0[0];
#pragma unroll
    for (int r = 1; r < 16; ++r) pmax = fmaxf(pmax, p0[r]);
#pragma unroll
    for (int r = 0; r < 16; ++r) pmax = fmaxf(pmax, p1[r]);
    { auto rr = __builtin_amdgcn_permlane32_swap(__float_as_uint(pmax), __float_as_uint(pmax), false, false);
      pmax = fmaxf(__uint_as_float(rr[0]), __uint_as_float(rr[1])); }
    if (__builtin_expect(__all(pmax - m_reg <= AttnC<DQK>::THRS), 1)) { mn = m_reg; alpha = 1.f; }
    else { mn = fmaxf(m_reg, pmax); alpha = __builtin_amdgcn_exp2f((m_reg - mn) * C); m_reg = mn; }
    const float mnC = -mn * C;
#pragma unroll
    for (int r = 0; r < 16; ++r) p0[r] = fmaf(p0[r], C, mnC);
#pragma unroll
    for (int r = 0; r < 16; ++r) p1[r] = fmaf(p1[r], C, mnC);
#pragma unroll
    for (int r = 0; r < 16; ++r) p0[r] = __builtin_amdgcn_exp2f(p0[r]);
}
__device__ __forceinline__ void finishSM(f32x16& p0, f32x16& p1, float alpha, float& l_reg, bf16x8& pa0, bf16x8& pa1, bf16x8& pa2, bf16x8& pa3) {
#pragma unroll
    for (int r = 0; r < 16; ++r) p1[r] = __builtin_amdgcn_exp2f(p1[r]);
    float ps = 0;
#pragma unroll
    for (int r = 0; r < 16; ++r) ps += p0[r];
#pragma unroll
    for (int r = 0; r < 16; ++r) ps += p1[r];
    { auto rr = __builtin_amdgcn_permlane32_swap(__float_as_uint(ps), __float_as_uint(ps), false, false);
      ps = __uint_as_float(rr[0]) + __uint_as_float(rr[1]); }
    l_reg = l_reg * alpha + ps;
#define PK4(P, BASE, OUT) do { unsigned a0 = cvtpk(P[BASE + 0], P[BASE + 1]), a1 = cvtpk(P[BASE + 2], P[BASE + 3]);   \
    unsigned b0 = cvtpk(P[BASE + 4], P[BASE + 5]), b1 = cvtpk(P[BASE + 6], P[BASE + 7]);                              \
    auto r0 = __builtin_amdgcn_permlane32_swap(a0, b0, false, false); auto r1 = __builtin_amdgcn_permlane32_swap(a1, b1, false, false); \
    u32x4 w = {r0[0], r1[0], r0[1], r1[1]}; OUT = *reinterpret_cast<bf16x8*>(&w); } while (0)
    PK4(p0, 0, pa0); PK4(p0, 8, pa1); PK4(p1, 0, pa2); PK4(p1, 8, pa3);
#undef PK4
}
template <int DQK>
__device__ __forceinline__ void qkt(f32x16& p0, f32x16& p1, const LAS char* Ks, const bf16x8* qr, const LAS char* ql, const int (&ko)[4]) {
    constexpr int KRB = DQK * 2;
    p0 = f32x16{}; p1 = f32x16{};
#pragma unroll
    for (int d0 = 0; d0 < DQK / 16; ++d0) { const LAS char* kp = Ks + ko[d0 & 3] + (d0 >> 2) * 128;
        const bf16x8 b0 = *(const LAS bf16x8*)(kp);
        const bf16x8 b1 = *(const LAS bf16x8*)(kp + 32 * KRB);
        bf16x8 q; if (d0 < 8) q = qr[d0]; else q = *(const LAS bf16x8*)(ql + (d0 - 8) * 1024);
        p0 = __builtin_amdgcn_mfma_f32_32x32x16_bf16(b0, q, p0, 0, 0, 0);
        p1 = __builtin_amdgcn_mfma_f32_32x32x16_bf16(b1, q, p1, 0, 0, 0); }
}
template <int DQK, int SD>
__device__ __forceinline__ void attn_body(const bf16* __restrict__ Qb, const bf16* __restrict__ Kh, const bf16* __restrict__ Vh, bf16* __restrict__ Ob, LAS char* lds) {
    constexpr int ND0 = DQK / 16, KRB = DQK * 2, SHM_K = 64 * KRB, SHM_V = 64 * 128 * 2, NKC = DQK / 64, CPR = DQK / 8, NT = LKP / 64;
    static_assert(NT % 2 == 1, "odd tile count: the tail below takes tiles NT-2 and NT-1");
    int tid = threadIdx.x; asm volatile("" : "+v"(tid));
    const int wid = tid >> 6, lane = tid & 63, r32 = lane & 31, hi = lane >> 5;
    LAS char* V_lds = lds; LAS char* K_lds = lds + 2 * SHM_V;
    __syncthreads();
    float m_reg = -1e30f, l_reg = 0; f32x16 o[4] = {}; bf16x8 qr[8];
    const bf16* Qw = Qb + (size_t)(wid * 32 + r32) * DQK + hi * 8;
#pragma unroll
    for (int d0 = 0; d0 < 8; ++d0) qr[d0] = *reinterpret_cast<const bf16x8*>(Qw + d0 * 16);
    LAS char* ql = lds + 2 * SHM_V + 2 * SHM_K + 2048 + wid * 4096 + lane * 16;
#pragma unroll
    for (int d0 = 8; d0 < ND0; ++d0) *(LAS bf16x8*)(ql + (d0 - 8) * 1024) = *reinterpret_cast<const bf16x8*>(Qw + d0 * 16);
    const int sr = tid >> 4, sc = (tid & 15) * 8, vst0 = v_st(sr, sc), vst1 = v_st(32 + sr, sc);
    int kst[NKC];
#pragma unroll
    for (int c = 0; c < NKC; ++c) { const int id = tid + 512 * c, kr = id / CPR, kc = (id - kr * CPR) * 8; kst[c] = kr * KRB + ((kc * 2) ^ ((kr & 7) << 4)); }
    const int voff = tid * 16;
    int ko[4];
#pragma unroll
    for (int q = 0; q < 4; ++q) ko[q] = r32 * KRB + ((q * 32 + hi * 16) ^ ((r32 & 7) << 4));
    const __amdgpu_buffer_rsrc_t rK = __builtin_amdgcn_make_buffer_rsrc((void*)Kh, 0, LKP * KRB, 0x00020000);
    const __amdgpu_buffer_rsrc_t rV = __builtin_amdgcn_make_buffer_rsrc((void*)Vh, 0, LKP * 256, 0x00020000);
    const int vb0 = (int)(unsigned)(uintptr_t)V_lds + v_rd_base(lane);
    struct { bf16x8 vs0, vs1, ks[NKC]; } sr_[SD];
#define SLOAD(i, k0) do { sr_[i].vs0 = __builtin_bit_cast(bf16x8, __builtin_amdgcn_raw_buffer_load_b128(rV, voff, (k0) * 256, 0)); sr_[i].vs1 = __builtin_bit_cast(bf16x8, __builtin_amdgcn_raw_buffer_load_b128(rV, voff, (k0) * 256 + 8192, 0)); \
    _Pragma("unroll") for (int c_ = 0; c_ < NKC; ++c_) sr_[i].ks[c_] = __builtin_bit_cast(bf16x8, __builtin_amdgcn_raw_buffer_load_b128(rK, voff, (k0) * KRB + c_ * 8192, 0)); } while (0)
#define SWRITE(b, i) do { *(LAS bf16x8*)(V_lds + (b) * SHM_V + vst0) = sr_[i].vs0; *(LAS bf16x8*)(V_lds + (b) * SHM_V + vst1) = sr_[i].vs1; \
    _Pragma("unroll") for (int c_ = 0; c_ < NKC; ++c_) *(LAS bf16x8*)(K_lds + (b) * SHM_K + kst[c_]) = sr_[i].ks[c_]; } while (0)
#define SWAIT() do { if constexpr (SD == 2) { if constexpr (NKC == 2) asm volatile("s_waitcnt vmcnt(4)" ::: "memory"); else asm volatile("s_waitcnt vmcnt(5)" ::: "memory"); } \
    else asm volatile("s_waitcnt vmcnt(0)" ::: "memory"); } while (0)
#define RESC(a) do { if (__any((a) < 1.f)) { int t_ = threadIdx.x; asm volatile("" : "+v"(t_)); const int r32_ = t_ & 31, hi_2 = (t_ >> 5) & 1; \
    LAS float* al_ = (LAS float*)(lds + 2 * SHM_V + 2 * SHM_K) + (t_ >> 6) * 64 + 32; if (hi_2 == 0) al_[r32_] = (a); asm volatile("s_waitcnt lgkmcnt(0)" ::: "memory"); \
    _Pragma("unroll") for (int d = 0; d < 4; ++d) _Pragma("unroll") for (int r = 0; r < 16; ++r) o[d][r] *= al_[crow(r, hi_2)]; } } while (0)
    f32x16 pA0, pA1, pB0, pB1; float mnA, mnB, alA, alB; bf16x8 pa0, pa1, pa2, pa3;
    constexpr int SE = 0, SO = SD - 1;
    SLOAD(SE, 0); asm volatile("s_waitcnt vmcnt(0)" ::: "memory"); SWRITE(0, SE); __syncthreads();
    qkt<DQK>(pA0, pA1, K_lds, qr, ql, ko); partialSM<DQK>(pA0, pA1, m_reg, mnA, alA);
    SLOAD(SO, 64); if constexpr (SD == 2) { SLOAD(SE, 128); }
    SWAIT(); SWRITE(1, SO); __syncthreads();
#pragma unroll 1
    for (int j = 1; j + 2 < NT; j += 2) {
        SBAR(); qkt<DQK>(pB0, pB1, K_lds + SHM_K, qr, ql, ko);
        finishSM(pA0, pA1, alA, l_reg, pa0, pa1, pa2, pa3); SBAR();
        SLOAD(SO, (j + SD) * 64); SBAR();
        pv_d0(o, vb0, pa0, pa1, pa2, pa3); partialSM<DQK>(pB0, pB1, m_reg, mnB, alB);
        __syncthreads(); SWAIT(); SWRITE(0, SE);
        RESC(alB); __syncthreads();
        SBAR(); qkt<DQK>(pA0, pA1, K_lds, qr, ql, ko);
        finishSM(pB0, pB1, alB, l_reg, pa0, pa1, pa2, pa3); SBAR();
        SLOAD(SE, (j + 1 + SD) * 64); SBAR();
        pv_d0(o, vb0 + SHM_V, pa0, pa1, pa2, pa3); partialSM<DQK>(pA0, pA1, m_reg, mnA, alA);
        __syncthreads(); SWAIT(); SWRITE(1, SO);
        RESC(alA); __syncthreads();
    }
    SBAR(); qkt<DQK>(pB0, pB1, K_lds + SHM_K, qr, ql, ko);
    finishSM(pA0, pA1, alA, l_reg, pa0, pa1, pa2, pa3); SBAR();
    if constexpr (SD == 1) { SLOAD(SE, (NT - 1) * 64); } SBAR();
    pv_d0(o, vb0, pa0, pa1, pa2, pa3); partialSM<DQK>(pB0, pB1, m_reg, mnB, alB);
    __syncthreads(); asm volatile("s_waitcnt vmcnt(0)" ::: "memory"); SWRITE(0, SE);
    RESC(alB); __syncthreads();
    SBAR(); qkt<DQK>(pA0, pA1, K_lds, qr, ql, ko);
#pragma unroll
    for (int r = 8; r < 16; ++r) pA0[r] = -1e30f;
#pragma unroll
    for (int r = 0; r < 16; ++r) pA1[r] = -1e30f;
    finishSM(pB0, pB1, alB, l_reg, pa0, pa1, pa2, pa3); SBAR();
    pv_d0(o, vb0 + SHM_V, pa0, pa1, pa2, pa3); partialSM<DQK>(pA0, pA1, m_reg, mnA, alA);
    RESC(alA);
    finishSM(pA0, pA1, alA, l_reg, pa0, pa1, pa2, pa3); SBAR();
    pv_d0(o, vb0, pa0, pa1, pa2, pa3);
    { int t_ = threadIdx.x; asm volatile("" : "+v"(t_)); const int r32_ = t_ & 31, hi_2 = (t_ >> 5) & 1, wid_ = t_ >> 6;
      LAS float* li_ = (LAS float*)(lds + 2 * SHM_V + 2 * SHM_K) + wid_ * 64;
      if (hi_2 == 0) li_[r32_] = l_reg; asm volatile("s_waitcnt lgkmcnt(0)" ::: "memory");
      float rli[16];
#pragma unroll
      for (int r = 0; r < 16; ++r) rli[r] = __builtin_amdgcn_rcpf(li_[crow(r, hi_2)]);
      bf16* Ow = Ob + (size_t)(wid_ * 32) * DM;
#pragma unroll
      for (int r = 0; r < 16; ++r) { const int orow = crow(r, hi_2);
#pragma unroll
          for (int d0 = 0; d0 < 4; ++d0) Ow[(size_t)orow * DM + d0 * 32 + r32_] = (bf16)(cvtpk(o[d0][r] * rli[r], 0.f) & 0xffffu); } }
#undef SLOAD
#undef SWRITE
#undef SWAIT
#undef RESC
}

constexpr int NPHASE = 14;
struct Args { const float* in[24]; float* out; unsigned char* ws; int ph_lo, ph_hi; };
__global__ void __launch_bounds__(NWAVES * 64, 2) hymba_fwd(Args args) {
    extern __shared__ __attribute__((aligned(16))) unsigned char lds[];
    const int tid = threadIdx.x, lane = tid & 63, wave = __builtin_amdgcn_readfirstlane(tid >> 6);
    const int G = gridDim.x, bx = blockIdx.x, vcu = (G % 8 == 0) ? (bx % 8) * (G / 8) + bx / 8 : bx;
    const int gw = vcu * NWAVES + wave, ngw = G * NWAVES, gtid = vcu * (NWAVES * 64) + tid, ngt = G * NWAVES * 64;
    unsigned char* ws = args.ws;
    volatile LAS unsigned* MISC = (volatile LAS unsigned*)((LAS unsigned char*)lds + LDSCTL_OFF);
    for (int u = tid; u < 1024; u += NWAVES * 64) ((LAS unsigned*)((LAS unsigned char*)lds + LDSCTL_OFF))[u] = 0u;
    __syncthreads();
#if !MK_SPLIT
    XcdBarrier bar = xcd_barrier_post((unsigned*)(ws + WS_CTL) + CW_BAR, MISC + 8);
#define GRID_BAR() xcd_barrier(bar)
#else
#define GRID_BAR() do {} while (0)
#endif
    const int lo = args.ph_lo, hi_ = args.ph_hi;
#define IN(k) (lo <= (k) && (k) < hi_)
#define SEAM(k) do { if (IN(k) && IN((k) + 1)) GRID_BAR(); } while (0)

    const float* x = args.in[0]; const float* meta_tok = args.in[1];
    float* rope = (float*)(ws + WS_ROPE);
    bf16* w_in_t = (bf16*)(ws + WS_WIN); bf16* w_qb_t = (bf16*)(ws + WS_WQB); bf16* w_kvb_t = (bf16*)(ws + WS_WKVB); bf16* w_o_t = (bf16*)(ws + WS_WO);
    bf16* w_r_t = (bf16*)(ws + WS_WR); bf16* w_gu_t = (bf16*)(ws + WS_WGU); bf16* w_dn_t = (bf16*)(ws + WS_WDN);
    bf16* h0 = (bf16*)(ws + WS_H0); bf16* h1 = (bf16*)(ws + WS_H1); bf16* qan = (bf16*)(ws + WS_QAN); bf16* kvan = (bf16*)(ws + WS_KVAN); bf16* z = (bf16*)(ws + WS_Z);
    bf16* qm = (bf16*)(ws + WS_QM); bf16* km = (bf16*)(ws + WS_KM); bf16* vm = (bf16*)(ws + WS_VM); bf16* qg = (bf16*)(ws + WS_QG); bf16* kg = (bf16*)(ws + WS_KG); bf16* vg = (bf16*)(ws + WS_VG);
    bf16* ob = (bf16*)(ws + WS_O); float* y1 = (float*)(ws + WS_Y1); float* logits = (float*)(ws + WS_LOGITS);
    int* topk = (int*)(ws + WS_TOPK); float* gate = (float*)(ws + WS_GATE); int* pair_pos = (int*)(ws + WS_PAIRPOS); float* row_gate = (float*)(ws + WS_ROWGATE);
    int* hist = (int*)(ws + WS_HIST); int* moetab = (int*)(ws + WS_MOETAB); int* tile_expert = moetab + 256;
    bf16* xs = (bf16*)(ws + WS_XS); bf16* act = (bf16*)(ws + WS_ACT); bf16* out2 = (bf16*)(ws + WS_OUT2);

    if (IN(0)) {
        LAS float* scr = (LAS float*)((LAS unsigned char*)lds + wave * 16384);
        constexpr int I_IN = 16 * 46, I_QB = 4 * 24, I_KVB = 2 * 32, I_O = 16 * 32, I_R = 16, I_GU1 = 16 * 64, I_DN1 = 16 * 32;
        constexpr int NITEMS = I_IN + I_QB + I_KVB + I_O + I_R + NE * I_GU1 + NE * I_DN1;
        for (int it = gw; it < NITEMS; it += ngw) {
            int r = it;
            if (r < I_IN) { transpose_item(args.in[4], 1024, NIN, w_in_t, scr, r, lane, MapIn()); continue; } r -= I_IN;
            if (r < I_QB) { transpose_item(args.in[6], 256, 768, w_qb_t, scr, r, lane, MapQ()); continue; } r -= I_QB;
            if (r < I_KVB) { transpose_item(args.in[8], 128, 1024, w_kvb_t, scr, r, lane, MapId()); continue; } r -= I_KVB;
            if (r < I_O) { transpose_item(args.in[13], 1024, 1024, w_o_t, scr, r, lane, MapId()); continue; } r -= I_O;
            if (r < I_R) { transpose_item(args.in[16], 1024, 32, w_r_t, scr, r, lane, MapId()); continue; } r -= I_R;
            if (r < NE * I_GU1) { const int e = r / I_GU1; transpose_item(args.in[18] + (size_t)e * 1024 * 2048, 1024, 2048, w_gu_t + (size_t)e * 2048 * 1024, scr, r - e * I_GU1, lane, MapGU()); continue; } r -= NE * I_GU1;
            { const int e = r / I_DN1; transpose_item(args.in[20] + (size_t)e * 1024 * 1024, 1024, 1024, w_dn_t + (size_t)e * 1024 * 1024, scr, r - e * I_DN1, lane, MapId()); }
        }
        for (int m = gw; m < MROWS; m += ngw) ln_row_f32_to_bf16(m < NTOK ? x + (size_t)m * DM : meta_tok + (size_t)(m - NTOK) * DM, args.in[2], args.in[3], h0 + (size_t)m * DM, lane);
        zero_bytes(h0 + (size_t)MROWS * DM, (size_t)(MPAD - MROWS) * DM * 2, gtid, ngt);
        zero_bytes(w_in_t + (size_t)NIN * 1024, (size_t)(ZLD - NIN) * 1024 * 2, gtid, ngt);
        for (int i = gw; i < 64 + 64 + 32 + 32; i += ngw) {
            bf16* p; size_t rb;
            if (i < 64) { p = km + ((size_t)i * LKP + 2064) * 192; rb = 48 * 192 * 2; }
            else if (i < 128) { p = vm + ((size_t)(i - 64) * LKP + 2064) * 128; rb = 48 * 128 * 2; }
            else if (i < 160) { p = kg + ((size_t)(i - 128) * LKP + 2064) * 128; rb = 48 * 128 * 2; }
            else { p = vg + ((size_t)(i - 160) * LKP + 2064) * 128; rb = 48 * 128 * 2; }
            zero_bytes(p, rb, lane, 64);
        }
        for (int i = gtid; i < 2065 * 32; i += ngt) {
            const int p = i / 32 - 1, f = i & 31; double inv = 1.0;
            for (int q = 0; q < f; ++q) inv *= 0.74989420933245582730;
            const float ang = (float)p * (float)inv; float sn, cs; sincos_d(fabsf(ang), sn, cs); if (ang < 0.f) sn = -sn;
            rope[2 * i] = cs; rope[2 * i + 1] = sn;
        }
    }
    SEAM(0);
    if (IN(1)) { EpiZ E{z}; simple_gemm(h0, w_in_t, 1024, 0, NTOK + 64, ZLD, E, BSelNone(), gw, ngw, lane); }
    SEAM(1);
    if (IN(2)) { for (int m = gw; m < MROWS; m += ngw) p2a_row(m, z, rope, args.in[5], args.in[7], args.in[9], args.in[10], qan, kvan, km, qg, kg, vg, lane); }
    SEAM(2);
    if (IN(3)) {
        { EpiQ E{qm, rope}; simple_gemm(qan, w_qb_t, 256, 0, NTOK, 768, E, BSelNone(), gw, ngw, lane); }
        { EpiKV E{km, vm}; simple_gemm(kvan, w_kvb_t, 128, 0, NTOK + 64, 1024, E, BSelNone(), gw, ngw, lane); }
    }
    SEAM(3);
    if (IN(4)) {
        for (int u = vcu; u < 1024; u += G) {
            if (u < 512) { const int b = u >> 5, h = (u >> 3) & 3, qb = u & 7, bh = b * 4 + h;
                attn_body<192, 1>(qm + ((size_t)bh * 2048 + qb * 256) * 192, km + (size_t)bh * LKP * 192, vm + (size_t)bh * LKP * 128, ob + ((size_t)b * 2048 + qb * 256) * DM + h * 128, (LAS char*)lds);
            } else { const int v = u - 512, b = v >> 5, h = (v >> 3) & 3, qb = v & 7, bh = b * 4 + h, bk = b * 2 + (h >> 1);
                attn_body<128, 2>(qg + ((size_t)bh * 2048 + qb * 256) * 128, kg + (size_t)bk * LKP * 128, vg + (size_t)bk * LKP * 128, ob + ((size_t)b * 2048 + qb * 256) * DM + 512 + h * 128, (LAS char*)lds);
            }
        }
    }
    SEAM(4);
    if (IN(5)) {
        for (int m = gw; m < NTOK; m += ngw) {
#pragma unroll
            for (int g = 0; g < 2; ++g) { bf16* p = ob + (size_t)m * DM + g * 512 + 8 * lane; float f[8]; unpack8(*(const u32x4*)p, f);
                float ss = 0.f;
#pragma unroll
                for (int j = 0; j < 8; ++j) ss += f[j] * f[j];
                const float rs = rsq(wave_sum(ss) * (1.f / 512) + RMS_EPS); const float* gg = (g ? args.in[12] : args.in[11]) + 8 * lane;
#pragma unroll
                for (int j = 0; j < 8; ++j) f[j] = f[j] * rs * gg[j];
                *(u32x4*)p = pack8(f); }
        }
    }
    SEAM(5);
    if (IN(6)) { EpiO E{y1, h0}; simple_gemm(ob, w_o_t, 1024, 0, NTOK, 1024, E, BSelNone(), gw, ngw, lane); }
    SEAM(6);
    if (IN(7)) { for (int m = gw; m < NTOK; m += ngw) ln_row_f32_to_bf16(y1 + (size_t)m * DM, args.in[14], args.in[15], h1 + (size_t)m * DM, lane); }
    SEAM(7);
    if (IN(8)) { EpiLogit E{logits, args.in[17]}; simple_gemm(h1, w_r_t, 1024, 0, NTOK, 32, E, BSelNone(), gw, ngw, lane); }
    SEAM(8);
    const int tpb = (NTOK + G - 1) / G, tok_lo = bx * tpb, tok_hi = (tok_lo + tpb < NTOK) ? tok_lo + tpb : NTOK;
    LAS int* L_hist = (LAS int*)((LAS unsigned char*)lds + LDSCTL_OFF + 256);
    LAS int* L_n = L_hist + 32; LAS int* L_base = L_hist + 64; LAS int* L_off = L_hist + 96;
    if (IN(9)) {
        if (tid < 32) L_hist[tid] = 0;
        __syncthreads();
        for (int t = tok_lo + wave; t < tok_hi; t += NWAVES) {
            float v = lane < 32 ? logits[(size_t)t * NE + lane] : -INFINITY; float tv[4]; int ti[4];
#pragma unroll
            for (int r = 0; r < 4; ++r) { float bv = v; int bi = lane;
#pragma unroll
                for (int off = 32; off >= 1; off >>= 1) { const float ov = __shfl_xor(bv, off); const int oi = __shfl_xor(bi, off); if (ov > bv || (ov == bv && oi < bi)) { bv = ov; bi = oi; } }
                tv[r] = bv; ti[r] = bi; if (lane == bi) v = -INFINITY; }
            const float e1 = __expf(tv[1] - tv[0]), e2 = __expf(tv[2] - tv[0]), e3 = __expf(tv[3] - tv[0]), inv = 1.f / (1.f + e1 + e2 + e3);
            if (lane == 0) { *(int4*)(topk + (size_t)t * 4) = make_int4(ti[0], ti[1], ti[2], ti[3]); *(f32x4*)(gate + (size_t)t * 4) = (f32x4){inv, e1 * inv, e2 * inv, e3 * inv};
                atomicAdd((int*)(L_hist + ti[0]), 1); atomicAdd((int*)(L_hist + ti[1]), 1); atomicAdd((int*)(L_hist + ti[2]), 1); atomicAdd((int*)(L_hist + ti[3]), 1); }
        }
        __syncthreads();
        if (tid < 32) hist[bx * 32 + tid] = L_hist[tid];
    }
    SEAM(9);
    if (IN(10)) {
        if (tid < 32) { int tot = 0, before = 0; for (int b = 0; b < G; ++b) { const int h = hist[b * 32 + tid]; tot += h; if (b < bx) before += h; } L_n[tid] = tot; L_base[tid] = before; L_hist[tid] = 0; }
        __syncthreads();
        if (tid == 0) { int off = 0; for (int e = 0; e < NE; ++e) { L_off[e] = off; off += (L_n[e] + 255) & ~255; } L_off[NE] = off; }
        __syncthreads();
        LAS int* L_pos = (LAS int*)((LAS unsigned char*)lds);
        for (int p = tok_lo * 4 + tid; p < tok_hi * 4; p += NWAVES * 64) { const int e = topk[p]; const int r = atomicAdd((int*)(L_hist + e), 1); const int pos = L_off[e] + L_base[e] + r;
            row_gate[pos] = gate[p]; pair_pos[p] = pos; L_pos[p - tok_lo * 4] = pos; }
        __syncthreads();
        for (int p = tok_lo * 4 + wave; p < tok_hi * 4; p += NWAVES) { const int pos = L_pos[p - tok_lo * 4]; const u32x4* src = (const u32x4*)(h1 + (size_t)(p >> 2) * DM); u32x4* dst = (u32x4*)(xs + (size_t)pos * DM);
            dst[lane] = src[lane]; dst[lane + 64] = src[lane + 64]; }
        if (bx == 0) { if (tid == 0) moetab[0] = L_off[NE];
            if (tid < 32) { moetab[64 + tid] = L_n[tid]; moetab[128 + tid] = L_off[tid]; for (int t = L_off[tid] >> 8; t < (L_off[tid + 1] >> 8); ++t) tile_expert[t] = tid; } }
        __syncthreads();
    }
    SEAM(10);
    if (IN(11)) { const int rows = moetab[0]; EpiGU E{act, args.in[19], tile_expert}; simple_gemm(xs, w_gu_t, 1024, 0, rows, 2048, E, BSelExpert{tile_expert, (size_t)2048 * 1024}, gw, ngw, lane); }
    SEAM(11);
    if (IN(12)) { const int rows = moetab[0]; EpiDN E{out2, args.in[21], row_gate, tile_expert}; simple_gemm(act, w_dn_t, 1024, 0, rows, 1024, E, BSelExpert{tile_expert, (size_t)1024 * 1024}, gw, ngw, lane); }
    SEAM(12);
    if (IN(13)) {
        for (int t = gw; t < NTOK; t += ngw) {
            const int4 pp = *(const int4*)(pair_pos + (size_t)t * 4); const int ps[4] = {pp.x, pp.y, pp.z, pp.w};
            float v[16];
#pragma unroll
            for (int hf = 0; hf < 2; ++hf) { float f[8]; unpack8(*(const u32x4*)(h1 + (size_t)t * DM + hf * 512 + 8 * lane), f);
#pragma unroll
                for (int j = 0; j < 8; ++j) v[hf * 8 + j] = ALPHA * f[j];
#pragma unroll
                for (int s4 = 0; s4 < 4; ++s4) { float g[8]; unpack8(*(const u32x4*)(out2 + (size_t)ps[s4] * DM + hf * 512 + 8 * lane), g);
#pragma unroll
                    for (int j = 0; j < 8; ++j) v[hf * 8 + j] += g[j]; } }
            float s = 0.f;
#pragma unroll
            for (int j = 0; j < 16; ++j) s += v[j];
            const float mean = wave_sum(s) * (1.f / DM); float s2 = 0.f;
#pragma unroll
            for (int j = 0; j < 16; ++j) { v[j] -= mean; s2 += v[j] * v[j]; }
            const float rstd = rsq(wave_sum(s2) * (1.f / DM) + LN_EPS);
#pragma unroll
            for (int hf = 0; hf < 2; ++hf) { const int c = hf * 512 + 8 * lane; const float* gg = args.in[22] + c; const float* bb = args.in[23] + c; float* o = args.out + (size_t)t * DM + c;
                *(f32x4*)o = (f32x4){v[hf * 8 + 0] * rstd * gg[0] + bb[0], v[hf * 8 + 1] * rstd * gg[1] + bb[1], v[hf * 8 + 2] * rstd * gg[2] + bb[2], v[hf * 8 + 3] * rstd * gg[3] + bb[3]};
                *(f32x4*)(o + 4) = (f32x4){v[hf * 8 + 4] * rstd * gg[4] + bb[4], v[hf * 8 + 5] * rstd * gg[5] + bb[5], v[hf * 8 + 6] * rstd * gg[6] + bb[6], v[hf * 8 + 7] * rstd * gg[7] + bb[7]}; }
        }
    }
#undef IN
#undef SEAM
}

extern "C" void kernel_launch(void* const* d_in, const int* in_sizes, int n_in, void* d_out, int out_size, void* d_ws, size_t ws_size, hipStream_t stream) {
    static int grid = 0;
    if (grid == 0) {
        if (n_in != 24 || in_sizes[0] != NTOK * DM || out_size != NTOK * DM || ws_size < WS_END) { fprintf(stderr, "kernel_launch: shape/workspace mismatch (n_in %d, ws %zu)\n", n_in, ws_size); grid = -1; return; }
        int dev = 0, cus = 0, per_cu = 0;
        if (hipGetDevice(&dev) != hipSuccess || hipDeviceGetAttribute(&cus, hipDeviceAttributeMultiprocessorCount, dev) != hipSuccess) { grid = -1; return; }
        if (hipFuncSetAttribute((const void*)hymba_fwd, hipFuncAttributeMaxDynamicSharedMemorySize, LDS_BYTES) != hipSuccess) { fprintf(stderr, "kernel_launch: hipFuncSetAttribute failed\n"); grid = -1; return; }
        if (hipOccupancyMaxActiveBlocksPerMultiprocessor(&per_cu, (const void*)hymba_fwd, NWAVES * 64, LDS_BYTES) != hipSuccess || per_cu < 1) fprintf(stderr, "kernel_launch: occupancy query says %d\n", per_cu);
        (void)hipGetLastError();
        grid = cus;
    }
    if (grid < 0) return;
    (void)hipMemsetAsync((char*)d_ws + WS_CTL, 0, CTL_ZERO_BYTES, stream);
    Args a{};
    for (int i = 0; i < 24; ++i) a.in[i] = (const float*)d_in[i];
    a.out = (float*)d_out; a.ws = (unsigned char*)d_ws;
#if MK_SPLIT
    for (int p = 0; p < NPHASE; ++p) { a.ph_lo = p; a.ph_hi = p + 1; hipLaunchKernelGGL(hymba_fwd, dim3(grid), dim3(NWAVES * 64), LDS_BYTES, stream, a); }
#else
    a.ph_lo = 0; a.ph_hi = NPHASE; hipLaunchKernelGGL(hymba_fwd, dim3(grid), dim3(NWAVES * 64), LDS_BYTES, stream, a);
#endif
}
```

```cpp
#include <hip/hip_runtime.h>
#include <cstdio>
#include <cstdint>

#ifndef MK_SPLIT
#define MK_SPLIT 0
#endif

#define LAS __attribute__((address_space(3)))
typedef unsigned short bf16;
typedef short bf16x8 __attribute__((ext_vector_type(8)));
typedef short s16x4 __attribute__((ext_vector_type(4)));
typedef float f32x2 __attribute__((ext_vector_type(2)));
typedef float f32x4 __attribute__((ext_vector_type(4)));
typedef float f32x16 __attribute__((ext_vector_type(16)));
typedef unsigned u32x2 __attribute__((ext_vector_type(2)));
typedef unsigned u32x4 __attribute__((ext_vector_type(4)));
typedef __bf16 bf16x2_t __attribute__((ext_vector_type(2)));

constexpr int NB = 16, SEQ = 2048, DM = 1024, NMETA = 16;
constexpr int NTOK = NB * SEQ;
constexpr int MROWS = NTOK + NMETA;
constexpr int MPAD = 33024;
constexpr int LKP = 2112;
constexpr int NIN = 1472, ZLD = 1536;
constexpr int NE = 32, NPAIR = NTOK * 4, MOE_TILES_MAX = 544, MOE_ROWS_MAX = MOE_TILES_MAX * 256;
constexpr float ALPHA = 1.189207115002721f;
constexpr float RMS_EPS = 1e-6f, LN_EPS = 1e-5f;

constexpr size_t MiB = 1u << 20;
constexpr size_t WS_CTL = 0, CTL_ZERO_BYTES = 1 * MiB;
constexpr size_t WS_ROPE = 1 * MiB;
constexpr size_t WS_WQB = 2 * MiB;
constexpr size_t WS_WKVB = 2 * MiB + 512 * 1024;
constexpr size_t WS_WR = 3 * MiB;
constexpr size_t WS_LOGITS = 4 * MiB;
constexpr size_t WS_TOPK = 8 * MiB;
constexpr size_t WS_GATE = 8 * MiB + 512 * 1024;
constexpr size_t WS_PAIRPOS = 9 * MiB;
constexpr size_t WS_ROWGATE = 9 * MiB + 512 * 1024;
constexpr size_t WS_HIST = 10 * MiB + 512 * 1024;
constexpr size_t WS_MOETAB = 10 * MiB + 768 * 1024;
constexpr size_t WS_WIN = 12 * MiB;
constexpr size_t WS_WO = 15 * MiB;
constexpr size_t WS_WGU = 32 * MiB;
constexpr size_t WS_WDN = 96 * MiB;
constexpr size_t WS_H1F8 = 128 * MiB;
constexpr size_t WS_H0 = 224 * MiB;
constexpr size_t WS_H1 = 289 * MiB;
constexpr size_t WS_QAN = 353 * MiB;
constexpr size_t WS_KVAN = 370 * MiB;
constexpr size_t WS_Z = 380 * MiB;
constexpr size_t WS_QM = 477 * MiB;
constexpr size_t WS_KM = 525 * MiB;
constexpr size_t WS_VM = 575 * MiB;
constexpr size_t WS_QG = 608 * MiB;
constexpr size_t WS_KG = 640 * MiB;
constexpr size_t WS_VG = 657 * MiB;
constexpr size_t WS_O = 674 * MiB;
constexpr size_t WS_Y1 = 738 * MiB;
constexpr size_t WS_XS = 380 * MiB;
constexpr size_t WS_ACT = 516 * MiB;
constexpr size_t WS_OUT2 = 652 * MiB;
constexpr size_t WS_END = 924 * MiB;
static_assert(WS_Z + (size_t)MPAD * ZLD * 2 <= WS_QM && WS_QM + (size_t)64 * 2048 * 192 * 2 <= WS_KM && WS_KM + (size_t)64 * LKP * 192 * 2 <= WS_VM && WS_VM + (size_t)64 * LKP * 128 * 2 <= WS_QG, "ws map 1");
static_assert(WS_QG + (size_t)64 * 2048 * 128 * 2 <= WS_KG && WS_KG + (size_t)32 * LKP * 128 * 2 <= WS_VG && WS_VG + (size_t)32 * LKP * 128 * 2 <= WS_O && WS_O + (size_t)NTOK * DM * 2 <= WS_Y1 && WS_Y1 + (size_t)NTOK * DM * 4 <= WS_END, "ws map 2");
static_assert(WS_XS + (size_t)MOE_ROWS_MAX * DM <= WS_ACT && WS_ACT + (size_t)MOE_ROWS_MAX * DM <= WS_OUT2 && WS_OUT2 + (size_t)MOE_ROWS_MAX * DM * 2 <= WS_END && WS_WGU + (size_t)NE * 2048 * 1024 <= WS_WDN && WS_WDN + (size_t)NE * 1024 * 1024 <= WS_H1F8 && WS_H1F8 + (size_t)NTOK * DM <= WS_H0, "ws map 3");
static_assert(WS_H0 + (size_t)MPAD * DM * 2 <= WS_H1 && WS_H1 + (size_t)NTOK * DM * 2 <= WS_QAN && WS_QAN + (size_t)MPAD * 256 * 2 <= WS_KVAN && WS_KVAN + (size_t)MPAD * 128 * 2 <= WS_Z, "ws map 4");
constexpr int CW_BAR = 4096;

constexpr int RING_BYTES = 131072;
constexpr int LDSCTL_OFF = RING_BYTES;
constexpr int LDS_BYTES = 147456;
constexpr int NWAVES = 8;

#define LDS_WAIT() asm volatile("s_waitcnt lgkmcnt(0)" ::: "memory")
#define SBAR() __builtin_amdgcn_sched_barrier(0)
__device__ __forceinline__ unsigned cvtpk(float lo, float hi) { f32x2 v = {lo, hi}; bf16x2_t b = __builtin_convertvector(v, bf16x2_t); return __builtin_bit_cast(unsigned, b); }
__device__ __forceinline__ u32x4 pack8(const float (&v)[8]) { u32x4 r = {cvtpk(v[0], v[1]), cvtpk(v[2], v[3]), cvtpk(v[4], v[5]), cvtpk(v[6], v[7])}; return r; }
__device__ __forceinline__ void unpack8(u32x4 w, float (&v)[8]) {
    v[0] = __uint_as_float(w.x << 16); v[1] = __uint_as_float(w.x & 0xffff0000u); v[2] = __uint_as_float(w.y << 16); v[3] = __uint_as_float(w.y & 0xffff0000u);
    v[4] = __uint_as_float(w.z << 16); v[5] = __uint_as_float(w.z & 0xffff0000u); v[6] = __uint_as_float(w.w << 16); v[7] = __uint_as_float(w.w & 0xffff0000u);
}
__device__ __forceinline__ float wave_sum(float v) {
#pragma unroll
    for (int o = 1; o < 64; o <<= 1) v += __shfl_xor(v, o);
    return v;
}
__device__ __forceinline__ float rsq(float x) { return __builtin_amdgcn_rsqf(x); }
typedef int v8i __attribute__((ext_vector_type(8)));
__device__ __forceinline__ unsigned pack4_f8(float a, float b, float c, float d) { int w = 0; w = __builtin_amdgcn_cvt_pk_fp8_f32(a, b, w, false); w = __builtin_amdgcn_cvt_pk_fp8_f32(c, d, w, true); return (unsigned)w; }
constexpr float W8_SCALE = 32.f, W8_INV = 1.f / 32.f;

#define XB_TMO      128
#define XB_XCNT(j)  (256  + 64 * (j))
#define XB_XSUB(j)  (1280 + 64 * (j))
#define XB_XGEN(j)  (2304 + 64 * (j))
#define XB_TOP      3328
#define XB_TOPGEN   3392
#define XCD_BAR_WORDS 3456
#define XB_SPIN_CAP (1u << 18)
__device__ __forceinline__ unsigned xb_ld(unsigned* p)              { return __hip_atomic_load(p, __ATOMIC_RELAXED, __HIP_MEMORY_SCOPE_AGENT); }
__device__ __forceinline__ unsigned xb_add(unsigned* p, unsigned v) { return __hip_atomic_fetch_add(p, v, __ATOMIC_RELAXED, __HIP_MEMORY_SCOPE_AGENT); }
__device__ __forceinline__ unsigned xb_xcc_id() { return (unsigned)__builtin_amdgcn_s_getreg((3 << 11) | 20) & 0xFu; }
#define XB_SPIN(cond, bar) do { unsigned _sp = 0; while (cond) { __builtin_amdgcn_s_sleep(1); \
    if ((++_sp & 255u) == 0u) { if (xb_ld(&(bar)[XB_TMO])) break; if (_sp > XB_SPIN_CAP) { atomicAdd(&(bar)[XB_TMO], 1u); break; } } } } while (0)
struct XcdBarrier { unsigned* bar; unsigned x; volatile LAS unsigned* st; };
__device__ __forceinline__ XcdBarrier xcd_barrier_post(unsigned* bar, volatile LAS unsigned* st) {
    XcdBarrier b; b.bar = bar; b.x = xb_xcc_id(); b.st = st;
    if (threadIdx.x == 0) (void)xb_add(&bar[XB_XCNT(b.x)], 1u);
    return b;
}
__device__ __forceinline__ void xcd_barrier_complete(unsigned* bar, unsigned x, unsigned& nloc, unsigned& nx) {
    const unsigned G = gridDim.x * gridDim.y * gridDim.z;
    unsigned sum, cnt, mine, sp = 0u;
    for (;;) {
        sum = 0u; cnt = 0u; mine = 0u;
#pragma unroll
        for (unsigned j = 0; j < 16; ++j) { const unsigned c = xb_ld(&bar[XB_XCNT(j)]); sum += c; cnt += (c > 0u) ? 1u : 0u; mine = (j == x) ? c : mine; }
        if (sum == G) break;
        __builtin_amdgcn_s_sleep(1);
        if ((++sp & 255u) == 0u) { if (xb_ld(&bar[XB_TMO])) break; if (sp > XB_SPIN_CAP) { atomicAdd(&bar[XB_TMO], 1u); break; } }
    }
    nloc = mine > 0u ? mine : 1u; nx = cnt > 0u ? cnt : 1u;
}
__device__ __forceinline__ void xcd_barrier(const XcdBarrier& b) {
    asm volatile("s_waitcnt vmcnt(0)" ::: "memory");
    __syncthreads();
    if (threadIdx.x == 0) {
        unsigned* bar = b.bar;
        __builtin_amdgcn_s_waitcnt(0);
        unsigned nloc = b.st[0], nx = b.st[1];
        if (nloc == 0u) { xcd_barrier_complete(bar, b.x, nloc, nx); b.st[0] = nloc; b.st[1] = nx; }
        const unsigned old = xb_add(&bar[XB_XSUB(b.x)], 1u);
        const unsigned gen = old / nloc;
        if (old + 1u == (gen + 1u) * nloc) {
            __builtin_amdgcn_fence(__ATOMIC_RELEASE, "agent");
            asm volatile("s_waitcnt vmcnt(0)" ::: "memory");
            const unsigned og = xb_add(&bar[XB_TOP], 1u);
            const unsigned tg = og / nx;
            if (og + 1u == (tg + 1u) * nx) xb_add(&bar[XB_TOPGEN], 1u);
            else XB_SPIN(xb_ld(&bar[XB_TOPGEN]) == tg, bar);
            __builtin_amdgcn_fence(__ATOMIC_ACQUIRE, "agent");
            xb_add(&bar[XB_XGEN(b.x)], 1u);
            asm volatile("s_waitcnt vmcnt(0)" ::: "memory");
        } else {
            XB_SPIN(xb_ld(&bar[XB_XGEN(b.x)]) == gen, bar);
            __builtin_amdgcn_fence(__ATOMIC_ACQUIRE, "agent");
            asm volatile("s_waitcnt vmcnt(0)" ::: "memory");
        }
    }
    __syncthreads();
}

struct BSelNone { __device__ __forceinline__ size_t operator()(int) const { return 0; } };
struct BSelExpert { const int* tile_expert; size_t per; __device__ __forceinline__ size_t operator()(int m0) const { return (size_t)tile_expert[m0 >> 8] * per; } };
template <class Epi, class BSel>
__device__ __forceinline__ void simple_gemm(const bf16* __restrict__ A, const bf16* __restrict__ Bt, int K, int m_lo, int m_hi, int N, const Epi& E, const BSel& bsel, int gw, int ngw, int lane) {
    const int fr = lane & 15, fq = lane >> 4;
    const int mt = (m_hi - m_lo) / 64, nt = N / 32;
    for (int u = gw; u < mt * nt; u += ngw) {
        const int m0 = m_lo + (u / nt) * 64, n0 = (u % nt) * 32;
        const bf16* ap = A + (size_t)(m0 + fr) * K + fq * 8;
        const bf16* bp = Bt + bsel(m0) + (size_t)(n0 + 8 * (fr >> 2) + (fr & 3)) * K + fq * 8;
        f32x4 acc[4][2];
#pragma unroll
        for (int i = 0; i < 4; ++i) { acc[i][0] = (f32x4){0.f, 0.f, 0.f, 0.f}; acc[i][1] = (f32x4){0.f, 0.f, 0.f, 0.f}; }
#pragma unroll 2
        for (int k = 0; k < K; k += 32) {
            bf16x8 a[4], b[2];
#pragma unroll
            for (int i = 0; i < 4; ++i) a[i] = *(const bf16x8*)(ap + (size_t)i * 16 * K + k);
#pragma unroll
            for (int j = 0; j < 2; ++j) b[j] = *(const bf16x8*)(bp + (size_t)j * 4 * K + k);
#pragma unroll
            for (int i = 0; i < 4; ++i)
#pragma unroll
                for (int j = 0; j < 2; ++j) acc[i][j] = __builtin_amdgcn_mfma_f32_16x16x32_bf16(b[j], a[i], acc[i][j], 0, 0, 0);
        }
#pragma unroll
        for (int i = 0; i < 4; ++i) {
            const float v[8] = {acc[i][0][0], acc[i][0][1], acc[i][0][2], acc[i][0][3], acc[i][1][0], acc[i][1][1], acc[i][1][2], acc[i][1][3]};
            E.store8(m0 + 16 * i + fr, n0 + 8 * fq, v);
        }
    }
}

struct EpiZ { bf16* z;
    __device__ __forceinline__ void store8(int row, int col, const float (&v)[8]) const { if (col < NIN) *(u32x4*)(z + (size_t)row * ZLD + col) = pack8(v); } };
struct EpiQ { bf16* qm; const float* rope;
    __device__ __forceinline__ void store8(int row, int col, const float (&v)[8]) const {
        const int h = col / 192, w = col - h * 192, b = row >> 11, s = row & 2047;
        float o[8];
        if (w < 128) {
#pragma unroll
            for (int j = 0; j < 8; ++j) o[j] = v[j];
        } else {
            const float* t = rope + ((size_t)(16 + s + 1) * 32 + ((w - 128) >> 1)) * 2;
#pragma unroll
            for (int j = 0; j < 4; ++j) { const float c = t[2 * j], sn = t[2 * j + 1], x1 = v[2 * j], x2 = v[2 * j + 1]; o[2 * j] = x1 * c - x2 * sn; o[2 * j + 1] = x1 * sn + x2 * c; }
        }
        *(u32x4*)(qm + ((size_t)(b * 4 + h) * 2048 + s) * 192 + w) = pack8(o);
    } };
struct EpiKV { bf16* km; bf16* vm;
    __device__ __forceinline__ void store8(int row, int col, const float (&v)[8]) const {
        if (row >= MROWS) return;
        const int h = col >> 8, w = col & 255; const u32x4 pk = pack8(v);
        if (row < NTOK) { const int b = row >> 11, key = row & 2047; const size_t r = (size_t)(b * 4 + h) * LKP + key;
            if (w < 128) *(u32x4*)(km + r * 192 + w) = pk; else *(u32x4*)(vm + r * 128 + (w - 128)) = pk;
        } else { const int key = 2048 + (row - NTOK);
            for (int b = 0; b < NB; ++b) { const size_t r = (size_t)(b * 4 + h) * LKP + key;
                if (w < 128) *(u32x4*)(km + r * 192 + w) = pk; else *(u32x4*)(vm + r * 128 + (w - 128)) = pk; } }
    } };
struct EpiO { float* y1; const bf16* h0;
    __device__ __forceinline__ void store8(int row, int col, const float (&v)[8]) const {
        float h[8]; unpack8(*(const u32x4*)(h0 + (size_t)row * DM + col), h);
        float* y = y1 + (size_t)row * DM + col;
        *(f32x4*)y = (f32x4){ALPHA * h[0] + v[0], ALPHA * h[1] + v[1], ALPHA * h[2] + v[2], ALPHA * h[3] + v[3]};
        *(f32x4*)(y + 4) = (f32x4){ALPHA * h[4] + v[4], ALPHA * h[5] + v[5], ALPHA * h[6] + v[6], ALPHA * h[7] + v[7]};
    } };
struct EpiLogit { float* logits; const float* bias;
    __device__ __forceinline__ void store8(int row, int col, const float (&v)[8]) const {
        float* y = logits + (size_t)row * NE + col;
        *(f32x4*)y = (f32x4){v[0] + bias[col], v[1] + bias[col + 1], v[2] + bias[col + 2], v[3] + bias[col + 3]};
        *(f32x4*)(y + 4) = (f32x4){v[4] + bias[col + 4], v[5] + bias[col + 5], v[6] + bias[col + 6], v[7] + bias[col + 7]};
    } };
namespace pg8 {
#define PG8_LAS __attribute__((address_space(3)))
typedef unsigned short bf16_t;
constexpr int BM = 256, BK = 64, HALF = 128, HTB = HALF * BK * 2, STAGE_BYTES = 8 * HTB, NXCD = 8, WGM = 8;
__host__ __device__ __forceinline__ int lds_byte(int r, int c) { const int st = (r >> 4) * 2 + (c >> 5), rr = r & 15, cc = c & 31, ob = rr * 64 + cc * 2; return st * 1024 + (ob ^ (((ob >> 9) & 1) << 5)); }
__host__ __device__ __forceinline__ void stage_rc(int b, int& R, int& C) { const int st = b / 1024, sb = b % 1024, swz = sb ^ (((sb >> 9) & 1) << 5); R = (st >> 1) * 16 + swz / 64; C = (st & 1) * 32 + (swz % 64) / 2; }
__host__ __device__ __forceinline__ int perm32(int rho) { const int n = rho >> 4, i = rho & 15; return 8 * (i >> 2) + 4 * n + (i & 3); }
struct Unit { int pm, pn; };
struct Gemm { const bf16_t* A; const bf16_t* Bt; int M, N, K; };
struct StaticOrder {
    int nM, nN, nwg, G, c;
    __host__ __device__ void init(int M, int N, int G_, int c_) { nM = M / BM; nN = N / BM; nwg = nM * nN; G = G_; c = c_; }
    __host__ __device__ bool next(int i, Unit& u) const {
        const long L = (long)i * G + c; if (L >= nwg) return false;
        int wgid = (int)L; { const int q = nwg / NXCD, r = nwg % NXCD, xcd = wgid % NXCD, off = wgid / NXCD; wgid = (xcd < r ? xcd * (q + 1) : r * (q + 1) + (xcd - r) * q) + off; }
        const int nig = WGM * nN, gid = wgid / nig, fm = gid * WGM, gsz = (nM - fm) < WGM ? (nM - fm) : WGM;
        u.pm = fm + ((wgid % nig) % gsz); u.pn = (wgid % nig) / gsz; return true;
    }
    __device__ __forceinline__ void a_ready(const Unit&) const {}
    __device__ __forceinline__ void done(const Unit&) const {}
};
struct MoeOrder {
    StaticOrder so; const int* tile_expert;
    __device__ void init(int tiles, int nN, int G_, int c_, const int* te) { so.nM = tiles; so.nN = nN; so.nwg = tiles * nN; so.G = G_; so.c = c_; tile_expert = te; }
    __device__ bool next(int i, Unit& u) const { if (!so.next(i, u)) return false; u.pn += tile_expert[u.pm] * so.nN; return true; }
    __device__ __forceinline__ void a_ready(const Unit&) const {}
    __device__ __forceinline__ void done(const Unit&) const {}
};
template <class E8> struct EpiAdapt {
    static constexpr bool PERM = true, AFTER_DRAIN = false;
    E8 e; int ncols_mod;
    __device__ __forceinline__ void operator()(const f32x4 (&acc)[2][2][4][2], const Unit& u, int wr, int wc, int fr, int fq) const {
        const int row0 = u.pm * BM + wr * 64 + fr; int colt = u.pn * BM; if (ncols_mod) colt %= ncols_mod;
        const int col0 = colt + wc * 32 + 8 * fq;
#pragma unroll
        for (int ai = 0; ai < 2; ++ai)
#pragma unroll
            for (int m = 0; m < 4; ++m)
#pragma unroll
                for (int bj = 0; bj < 2; ++bj) {
                    const float v[8] = {acc[ai][bj][m][0][0], acc[ai][bj][m][0][1], acc[ai][bj][m][0][2], acc[ai][bj][m][0][3], acc[ai][bj][m][1][0], acc[ai][bj][m][1][1], acc[ai][bj][m][1][2], acc[ai][bj][m][1][3]};
                    e.store8(row0 + ai * HALF + m * 16, col0 + bj * HALF, v); }
    }
};
template <class Epi, class Sched, bool ALIGN_EPI = false, bool SP2 = false, bool F8 = false>
__device__ __forceinline__ void gemm_phase(PG8_LAS unsigned char* lds, const Gemm g, const Sched& S, const Epi& E) {
    const int tid = threadIdx.x, wid = __builtin_amdgcn_readfirstlane(tid >> 6), lane = tid & 63, wr = wid >> 2, wc = wid & 3, fr = lane & 15, fq = lane >> 4;
    const int K = g.K, nt = K / BK;
    unsigned voffA[2], voffB[2];
#pragma unroll
    for (int i = 0; i < 2; ++i) { int R, C; stage_rc(tid * 16 + i * 8192, R, C); const int Rb = Epi::PERM ? ((R & ~31) + perm32(R & 31)) : R;
        voffA[i] = (unsigned)(R * K + C) * 2u; voffB[i] = (unsigned)(Rb * K + C) * 2u; }
    const size_t kstep = (size_t)(BK * 2);
    const size_t hstep = (size_t)HALF * K * 2;
    const size_t tstep = 2 * hstep;
    const unsigned ldsw = (unsigned)wid * 1024u;
    const int aoff = lds_byte(wr * 64 + fr, fq * 8), boff = lds_byte(wc * 32 + fr, fq * 8);
#define PG8_SA(b, h) (((b) * 2 + (h)) * HTB)
#define PG8_SB(b, h) ((4 + (b) * 2 + (h)) * HTB)
#define PG8_STAGE(bufoff, gbase, voff) do { _Pragma("unroll") for (int _i = 0; _i < 2; ++_i) \
        __builtin_amdgcn_global_load_lds((const unsigned*)((const char*)(gbase) + (voff)[_i]), (PG8_LAS unsigned*)(lds + (bufoff) + ldsw + _i * 8192), 16, 0, 0); } while (0)
#define PG8_LDA(dst, b, h) do { _Pragma("unroll") for (int m = 0; m < 4; ++m) _Pragma("unroll") for (int k = 0; k < 2; ++k) dst[m][k] = *(const PG8_LAS bf16x8*)(lds + PG8_SA(b, h) + aoff + m * 2048 + k * 1024); } while (0)
#define PG8_LDB(dst, b, h) do { _Pragma("unroll") for (int n = 0; n < 2; ++n) _Pragma("unroll") for (int k = 0; k < 2; ++k) dst[n][k] = *(const PG8_LAS bf16x8*)(lds + PG8_SB(b, h) + boff + n * 2048 + k * 1024); } while (0)
#define PG8_F8CAT(x) __builtin_shufflevector(__builtin_bit_cast(u32x4, (x)[0]), __builtin_bit_cast(u32x4, (x)[1]), 0, 1, 2, 3, 4, 5, 6, 7)
#define PG8_MMA(ai, bj, At, Bt) do { __builtin_amdgcn_s_setprio(1); if constexpr (F8) { _Pragma("unroll") for (int m = 0; m < 4; ++m) _Pragma("unroll") for (int n = 0; n < 2; ++n) \
        acc[ai][bj][m][n] = __builtin_amdgcn_mfma_scale_f32_16x16x128_f8f6f4(__builtin_bit_cast(v8i, PG8_F8CAT(Bt[n])), __builtin_bit_cast(v8i, PG8_F8CAT(At[m])), acc[ai][bj][m][n], 0, 0, 0, 0x7f7f7f7f, 0, 0x7f7f7f7f); \
        _Pragma("unroll") for (int m = 0; m < 4; ++m) _Pragma("unroll") for (int n = 0; n < 2; ++n) asm volatile("" : "+v"(acc[ai][bj][m][n])); } \
    else { _Pragma("unroll") for (int m = 0; m < 4; ++m) _Pragma("unroll") for (int n = 0; n < 2; ++n) _Pragma("unroll") for (int k = 0; k < 2; ++k) \
        acc[ai][bj][m][n] = __builtin_amdgcn_mfma_f32_16x16x32_bf16(Bt[n][k], At[m][k], acc[ai][bj][m][n], 0, 0, 0); } __builtin_amdgcn_s_setprio(0); } while (0)
#define PG8_WAIT_V(n) asm volatile("s_waitcnt vmcnt(" #n ")" ::: "memory")
#define PG8_WAIT_L(n) asm volatile("s_waitcnt lgkmcnt(" #n ")" ::: "memory")
#define PG8_BAR __builtin_amdgcn_s_barrier()
#define PG8_SCHED __builtin_amdgcn_sched_barrier(0)
    Unit cur, nxt; int ui = 0;
    if (!S.next(0, cur)) return;
    f32x4 acc[2][2][4][2];
#pragma unroll
    for (int a = 0; a < 2; ++a)
#pragma unroll
        for (int b = 0; b < 2; ++b)
#pragma unroll
            for (int m = 0; m < 4; ++m)
#pragma unroll
                for (int n = 0; n < 2; ++n) acc[a][b][m][n] = (f32x4){0.f, 0.f, 0.f, 0.f};
    bf16x8 At[4][2], B0[2][2], B1[2][2];
    const char* cA = (const char*)g.A + (size_t)cur.pm * tstep; const char* cB = (const char*)g.Bt + (size_t)cur.pn * tstep;
    S.a_ready(cur);
    if constexpr (SP2) {
        PG8_STAGE(PG8_SB(0, 0), cB, voffB); PG8_STAGE(PG8_SB(0, 1), cB + hstep, voffB); PG8_STAGE(PG8_SA(0, 0), cA, voffA); PG8_STAGE(PG8_SA(0, 1), cA + hstep, voffA);
        if (wr == 1) PG8_BAR;
        PG8_WAIT_V(2); PG8_BAR;
        PG8_STAGE(PG8_SB(1, 0), cB + kstep, voffB); PG8_STAGE(PG8_SA(1, 0), cA + kstep, voffA); PG8_STAGE(PG8_SB(1, 1), cB + hstep + kstep, voffB);
        PG8_WAIT_V(6); PG8_BAR;
    } else {
        PG8_STAGE(PG8_SB(0, 0), cB, voffB); PG8_STAGE(PG8_SA(0, 0), cA, voffA); PG8_STAGE(PG8_SB(0, 1), cB + hstep, voffB); PG8_STAGE(PG8_SA(0, 1), cA + hstep, voffA);
        if (wr == 1) PG8_BAR;
        PG8_WAIT_V(4); PG8_BAR;
        PG8_STAGE(PG8_SB(1, 0), cB + kstep, voffB); PG8_STAGE(PG8_SA(1, 0), cA + kstep, voffA); PG8_STAGE(PG8_SB(1, 1), cB + hstep + kstep, voffB);
        PG8_WAIT_V(6); PG8_BAR;
    }
    for (;;) {
        const bool has_next = S.next(ui + 1, nxt);
        const char* nA = has_next ? (const char*)g.A + (size_t)nxt.pm * tstep : cA; const char* nB = has_next ? (const char*)g.Bt + (size_t)nxt.pn * tstep : cB;
        for (int t = 0; t < nt; t += 2) {
            const bool last = (t == nt - 2);
            const char* a1 = cA + (size_t)(t + 1) * kstep;
            const char* a2 = last ? nA : cA + (size_t)(t + 2) * kstep; const char* b2 = last ? nB : cB + (size_t)(t + 2) * kstep;
            const char* a3 = a2 + kstep; const char* b3 = b2 + kstep;
            if (last && has_next) S.a_ready(nxt);
            if constexpr (SP2) {
            PG8_LDB(B0, 0, 0); PG8_LDB(B1, 0, 1); PG8_SCHED; PG8_LDA(At, 0, 0); PG8_STAGE(PG8_SA(1, 1), a1 + hstep, voffA);
            PG8_WAIT_V(8); PG8_WAIT_L(0); PG8_BAR; PG8_MMA(0, 0, At, B0); PG8_MMA(0, 1, At, B1); PG8_BAR; PG8_SCHED;
            PG8_LDA(At, 0, 1); PG8_STAGE(PG8_SB(0, 0), b2, voffB); PG8_STAGE(PG8_SB(0, 1), b2 + hstep, voffB); PG8_STAGE(PG8_SA(0, 0), a2, voffA);
            PG8_WAIT_V(8); PG8_WAIT_L(0); PG8_BAR; PG8_MMA(1, 0, At, B0); PG8_MMA(1, 1, At, B1); PG8_BAR; PG8_SCHED;
            PG8_LDB(B0, 1, 0); PG8_LDB(B1, 1, 1); PG8_SCHED; PG8_LDA(At, 1, 0); PG8_STAGE(PG8_SA(0, 1), a2 + hstep, voffA);
            PG8_WAIT_V(8); PG8_WAIT_L(0); PG8_BAR; PG8_MMA(0, 0, At, B0); PG8_MMA(0, 1, At, B1); PG8_BAR; PG8_SCHED;
            PG8_LDA(At, 1, 1); PG8_STAGE(PG8_SB(1, 0), b3, voffB); PG8_STAGE(PG8_SB(1, 1), b3 + hstep, voffB); PG8_STAGE(PG8_SA(1, 0), a3, voffA);
            PG8_WAIT_V(8); PG8_WAIT_L(0); PG8_BAR; PG8_MMA(1, 0, At, B0); PG8_MMA(1, 1, At, B1); PG8_BAR; PG8_SCHED;
            } else {
            PG8_LDB(B0, 0, 0); PG8_SCHED; PG8_LDA(At, 0, 0); PG8_STAGE(PG8_SA(1, 1), a1 + hstep, voffA);
            PG8_WAIT_L(8); PG8_BAR; PG8_WAIT_L(0); PG8_MMA(0, 0, At, B0); PG8_BAR; PG8_SCHED;
            PG8_LDB(B1, 0, 1); PG8_STAGE(PG8_SB(0, 0), b2, voffB);
            PG8_BAR; PG8_WAIT_L(0); PG8_MMA(0, 1, At, B1); PG8_BAR;
            PG8_LDA(At, 0, 1); PG8_STAGE(PG8_SA(0, 0), a2, voffA);
            PG8_BAR; PG8_WAIT_L(0); PG8_MMA(1, 0, At, B0); PG8_BAR; PG8_SCHED;
            PG8_STAGE(PG8_SB(0, 1), b2 + hstep, voffB);
            PG8_WAIT_V(6); PG8_BAR; PG8_MMA(1, 1, At, B1); PG8_BAR;
            PG8_LDB(B0, 1, 0); PG8_SCHED; PG8_LDA(At, 1, 0); PG8_STAGE(PG8_SA(0, 1), a2 + hstep, voffA);
            PG8_WAIT_L(8); PG8_BAR; PG8_WAIT_L(0); PG8_MMA(0, 0, At, B0); PG8_BAR; PG8_SCHED;
            PG8_LDB(B1, 1, 1); PG8_STAGE(PG8_SB(1, 0), b3, voffB);
            PG8_BAR; PG8_WAIT_L(0); PG8_MMA(0, 1, At, B1); PG8_BAR;
            PG8_LDA(At, 1, 1); PG8_STAGE(PG8_SA(1, 0), a3, voffA);
            PG8_BAR; PG8_WAIT_L(0); PG8_MMA(1, 0, At, B0); PG8_BAR; PG8_SCHED;
            PG8_STAGE(PG8_SB(1, 1), b3 + hstep, voffB);
            PG8_WAIT_V(6); PG8_BAR; PG8_MMA(1, 1, At, B1); PG8_BAR;
            }
        }
        if constexpr (ALIGN_EPI) { if (wr == 0) PG8_BAR; }
        if constexpr (!Epi::AFTER_DRAIN) { E(acc, cur, wr, wc, fr, fq); S.done(cur); }
        if (!has_next) break;
#pragma unroll
        for (int a = 0; a < 2; ++a)
#pragma unroll
            for (int b = 0; b < 2; ++b)
#pragma unroll
                for (int m = 0; m < 4; ++m)
#pragma unroll
                    for (int n = 0; n < 2; ++n) acc[a][b][m][n] = (f32x4){0.f, 0.f, 0.f, 0.f};
        cur = nxt; cA = nA; cB = nB; ++ui;
        if constexpr (ALIGN_EPI) { if (wr == 1) PG8_BAR; }
    }
    PG8_WAIT_V(0);
    if constexpr (!ALIGN_EPI) { if (wr == 0) PG8_BAR; }
    PG8_BAR;
#undef PG8_SA
#undef PG8_SB
#undef PG8_STAGE
#undef PG8_LDA
#undef PG8_LDB
#undef PG8_MMA
#undef PG8_F8CAT
#undef PG8_WAIT_V
#undef PG8_WAIT_L
#undef PG8_BAR
#undef PG8_SCHED
}
}

struct EpiGU8 { static constexpr bool PERM = true, AFTER_DRAIN = false;
    unsigned char* act8; const float* bgu;
    __device__ __forceinline__ void operator()(const f32x4 (&acc)[2][2][4][2], const pg8::Unit& u, int wr, int wc, int fr, int fq) const {
        const int e = u.pn >> 3, ac0 = 128 * (u.pn & 7) + wc * 32 + 8 * fq;
        const float* bb = bgu + (size_t)e * 2048 + 2 * ac0;
        const f32x4 q0 = *(const f32x4*)bb, q1 = *(const f32x4*)(bb + 4), q2 = *(const f32x4*)(bb + 8), q3 = *(const f32x4*)(bb + 12);
        const float bg[8] = {q0[0], q0[2], q1[0], q1[2], q2[0], q2[2], q3[0], q3[2]}, bl[8] = {q0[1], q0[3], q1[1], q1[3], q2[1], q2[3], q3[1], q3[3]};
#pragma unroll
        for (int ai = 0; ai < 2; ++ai)
#pragma unroll
            for (int m = 0; m < 4; ++m) { const int row = u.pm * 256 + ai * 128 + wr * 64 + m * 16 + fr; float o[8];
#pragma unroll
                for (int t = 0; t < 8; ++t) {
                    const float xg = fminf(acc[ai][0][m][t >> 2][t & 3] * W8_INV + bg[t], 7.f), xl = fminf(fmaxf(acc[ai][1][m][t >> 2][t & 3] * W8_INV + bl[t], -7.f), 7.f);
                    const float sg = __builtin_amdgcn_rcpf(1.f + __builtin_amdgcn_exp2f(-1.702f * 1.4426950408889634f * xg));
                    o[t] = xg * sg * (xl + 1.f); }
                *(u32x2*)(act8 + (size_t)row * DM + ac0) = (u32x2){pack4_f8(o[0], o[1], o[2], o[3]), pack4_f8(o[4], o[5], o[6], o[7])}; }
    } };
struct EpiDN8 { static constexpr bool PERM = true, AFTER_DRAIN = false;
    bf16* out2; const float* bdn; const float* row_gate;
    __device__ __forceinline__ void operator()(const f32x4 (&acc)[2][2][4][2], const pg8::Unit& u, int wr, int wc, int fr, int fq) const {
        const int e = u.pn >> 2, c0 = 256 * (u.pn & 3) + wc * 32 + 8 * fq;
        f32x4 bv[2][2];
#pragma unroll
        for (int bj = 0; bj < 2; ++bj) { bv[bj][0] = *(const f32x4*)(bdn + (size_t)e * DM + c0 + bj * 128); bv[bj][1] = *(const f32x4*)(bdn + (size_t)e * DM + c0 + bj * 128 + 4); }
#pragma unroll
        for (int ai = 0; ai < 2; ++ai)
#pragma unroll
            for (int m = 0; m < 4; ++m) { const int row = u.pm * 256 + ai * 128 + wr * 64 + m * 16 + fr; const float g = row_gate[row];
#pragma unroll
                for (int bj = 0; bj < 2; ++bj) { const f32x4 v0 = (acc[ai][bj][m][0] * W8_INV + bv[bj][0]) * g, v1 = (acc[ai][bj][m][1] * W8_INV + bv[bj][1]) * g;
                    *(u32x4*)(out2 + (size_t)row * DM + c0 + bj * 128) = (u32x4){cvtpk(v0[0], v0[1]), cvtpk(v0[2], v0[3]), cvtpk(v1[0], v1[1]), cvtpk(v1[2], v1[3])}; } }
    } };
#ifndef FAST_Z
#define FAST_Z 1
#endif
#ifndef FAST_O
#define FAST_O 1
#endif

struct MapId { __device__ __forceinline__ int operator()(int n) const { return n; } };
struct MapIn { __device__ __forceinline__ int operator()(int n) const {
    if (n >= 384 && n < 448) { const int l = n - 384; return 384 + 2 * (l & 31) + (l >> 5); }
    if (n >= 448 && n < 1216) { const int l = n - 448, hd = l >> 7, d = l & 127; return 448 + hd * 128 + (d >> 6) * 64 + 2 * (d & 31) + ((d >> 5) & 1); }
    return n; } };
struct MapQ { __device__ __forceinline__ int operator()(int n) const { const int h = n / 192, w = n - h * 192; if (w < 128) return n; const int l = w - 128; return h * 192 + 128 + 2 * (l & 31) + (l >> 5); } };
struct MapGU { __device__ __forceinline__ int operator()(int n) const { const int a = n >> 1; return 256 * (a >> 7) + 128 * (n & 1) + (a & 127); } };
template <class Map>
__device__ __forceinline__ void transpose_item(const float* __restrict__ W, int K, int N, bf16* __restrict__ WT, LAS float* scr, int item, int lane, const Map& map) {
    const int nblk = N / 32, kb = item / nblk, nb = item - kb * nblk, k0 = 64 * kb, n0 = 32 * nb;
#pragma unroll 8
    for (int i = 0; i < 32; ++i) { const int kk = 2 * i + (lane >> 5); scr[kk * 33 + (lane & 31)] = W[(size_t)(k0 + kk) * N + n0 + (lane & 31)]; }
    LDS_WAIT(); asm volatile("" ::: "memory");
    const int c = lane & 7;
#pragma unroll
    for (int j = 0; j < 4; ++j) { const int n = (lane >> 3) + 8 * j; const LAS float* s = scr + (8 * c) * 33 + n;
        u32x4 o; o.x = cvtpk(s[0 * 33], s[1 * 33]); o.y = cvtpk(s[2 * 33], s[3 * 33]); o.z = cvtpk(s[4 * 33], s[5 * 33]); o.w = cvtpk(s[6 * 33], s[7 * 33]);
        *(u32x4*)(WT + (size_t)map(n0 + n) * K + k0 + 8 * c) = o; }
    LDS_WAIT(); asm volatile("" ::: "memory");
}

template <class Map>
__device__ __forceinline__ void transpose_item_f8(const float* __restrict__ W, int K, int N, unsigned char* __restrict__ WT, LAS float* scr, int item, int lane, const Map& map, float scale) {
    const int nblk = N / 32, kb = item / nblk, nb = item - kb * nblk, k0 = 64 * kb, n0 = 32 * nb;
#pragma unroll 8
    for (int i = 0; i < 32; ++i) { const int kk = 2 * i + (lane >> 5); scr[kk * 33 + (lane & 31)] = W[(size_t)(k0 + kk) * N + n0 + (lane & 31)] * scale; }
    LDS_WAIT(); asm volatile("" ::: "memory");
    const int n = lane >> 1;
#pragma unroll
    for (int j = 0; j < 2; ++j) { const int c = 2 * (lane & 1) + j; const LAS float* s_ = scr + (16 * c) * 33 + n;
        u32x4 o; o.x = pack4_f8(s_[0 * 33], s_[1 * 33], s_[2 * 33], s_[3 * 33]); o.y = pack4_f8(s_[4 * 33], s_[5 * 33], s_[6 * 33], s_[7 * 33]);
        o.z = pack4_f8(s_[8 * 33], s_[9 * 33], s_[10 * 33], s_[11 * 33]); o.w = pack4_f8(s_[12 * 33], s_[13 * 33], s_[14 * 33], s_[15 * 33]);
        *(u32x4*)(WT + (size_t)map(n0 + n) * K + k0 + 16 * c) = o; }
    LDS_WAIT(); asm volatile("" ::: "memory");
}
__device__ __forceinline__ void ln_row_f32_to_bf16(const float* __restrict__ xrow, const float* __restrict__ g, const float* __restrict__ bta, bf16* __restrict__ orow, int lane, unsigned char* __restrict__ o8 = nullptr) {
    f32x4 v[4]; float s = 0.f;
#pragma unroll
    for (int j = 0; j < 4; ++j) { v[j] = ((const f32x4*)xrow)[lane + 64 * j]; s += (v[j].x + v[j].y) + (v[j].z + v[j].w); }
    const float mean = wave_sum(s) * (1.f / DM); float s2 = 0.f;
#pragma unroll
    for (int j = 0; j < 4; ++j) { v[j] = v[j] - mean; s2 += (v[j].x * v[j].x + v[j].y * v[j].y) + (v[j].z * v[j].z + v[j].w * v[j].w); }
    const float rstd = rsq(wave_sum(s2) * (1.f / DM) + LN_EPS);
#pragma unroll
    for (int j = 0; j < 4; ++j) { const f32x4 gg = ((const f32x4*)g)[lane + 64 * j], bb = ((const f32x4*)bta)[lane + 64 * j]; const f32x4 o = v[j] * rstd * gg + bb;
        ((u32x2*)orow)[lane + 64 * j] = (u32x2){cvtpk(o.x, o.y), cvtpk(o.z, o.w)};
        if (o8) ((unsigned*)o8)[lane + 64 * j] = pack4_f8(o.x, o.y, o.z, o.w); }
}
__device__ __forceinline__ void zero_bytes(void* p, size_t bytes, int gtid, int ngt) {
    u32x4* q = (u32x4*)p; const size_t n = bytes / 16;
    for (size_t i = gtid; i < n; i += ngt) q[i] = (u32x4){0u, 0u, 0u, 0u};
}
__device__ __forceinline__ void sincos_d(float angf, float& sn, float& cs) {
    const double x = (double)angf; const double q = __builtin_rint(x * 0.63661977236758134308);
    const double r = (x - q * 1.57079632679489655800) - q * 6.123233995736766036e-17, r2 = r * r;
    const double sp = r * (1.0 + r2 * (-1.0 / 6 + r2 * (1.0 / 120 + r2 * (-1.0 / 5040 + r2 * (1.0 / 362880 + r2 * (-1.0 / 39916800 + r2 * (1.0 / 6227020800.0)))))));
    const double cp = 1.0 + r2 * (-0.5 + r2 * (1.0 / 24 + r2 * (-1.0 / 720 + r2 * (1.0 / 40320 + r2 * (-1.0 / 3628800 + r2 * (1.0 / 479001600.0))))));
    const int qi = ((int)q) & 3;
    const double s_ = (qi == 0) ? sp : (qi == 1) ? cp : (qi == 2) ? -sp : -cp;
    const double c_ = (qi == 0) ? cp : (qi == 1) ? -sp : (qi == 2) ? -cp : sp;
    sn = (float)s_; cs = (float)c_;
}

__device__ __forceinline__ void p2a_row(int row, const bf16* __restrict__ z, const float* __restrict__ rope, const float* __restrict__ g_q_a, const float* __restrict__ g_kv_a,
                                        const float* __restrict__ g_q_gqa, const float* __restrict__ g_k_gqa, bf16* qan, bf16* kvan, bf16* km, bf16* qg, bf16* kg, bf16* vg, int lane) {
    const bf16* zr = z + (size_t)row * ZLD;
    const bool meta = row >= NTOK;
    const int b = row >> 11, s = row & 2047, m = row - NTOK;
    const int pos1 = meta ? m : 16 + s, prow = meta ? -1 : (s >> 6), pcol = meta ? m : (s & 63), key = meta ? 2048 + m : s;
    {
        float f[8]; u32x4 w = {0u, 0u, 0u, 0u}; if (lane < 56) w = *(const u32x4*)(zr + 8 * lane); unpack8(w, f);
        float ss = 0.f;
#pragma unroll
        for (int j = 0; j < 8; ++j) ss += f[j] * f[j];
        ss += __shfl_xor(ss, 1); ss += __shfl_xor(ss, 2); ss += __shfl_xor(ss, 4); ss += __shfl_xor(ss, 8);
        const float s16 = ss, s32 = ss + __shfl_xor(ss, 16);
        if (lane < 32) { const float rs = rsq(s32 * (1.f / 256) + RMS_EPS); float o[8];
#pragma unroll
            for (int j = 0; j < 8; ++j) o[j] = f[j] * rs * g_q_a[8 * lane + j];
            *(u32x4*)(qan + (size_t)row * 256 + 8 * lane) = pack8(o);
        } else if (lane < 48) { const float rs = rsq(s16 * (1.f / 128) + RMS_EPS); float o[8];
#pragma unroll
            for (int j = 0; j < 8; ++j) o[j] = f[j] * rs * g_kv_a[8 * (lane - 32) + j];
            *(u32x4*)(kvan + (size_t)row * 128 + 8 * (lane - 32)) = pack8(o);
        } else if (lane < 56) { const int i0 = 4 * (lane - 48); const float* t = rope + ((size_t)(pos1 + 1) * 32 + i0) * 2; float o[8];
#pragma unroll
            for (int j = 0; j < 4; ++j) { const float c = t[2 * j], sn = t[2 * j + 1], x1 = f[2 * j], x2 = f[2 * j + 1]; o[2 * j] = x1 * c - x2 * sn; o[2 * j + 1] = x1 * sn + x2 * c; }
            const u32x4 pk = pack8(o);
            if (!meta) { for (int h = 0; h < 4; ++h) *(u32x4*)(km + ((size_t)(b * 4 + h) * LKP + key) * 192 + 128 + 8 * (lane - 48)) = pk; }
            else { for (int bb = 0; bb < NB; ++bb) for (int h = 0; h < 4; ++h) *(u32x4*)(km + ((size_t)(bb * 4 + h) * LKP + key) * 192 + 128 + 8 * (lane - 48)) = pk; }
        }
    }
    const int p0 = (lane & 15) * 8, half = p0 >> 6, i0 = (p0 & 63) >> 1;
    const int apos = half ? pcol : prow; const float* t = rope + ((size_t)(apos + 1) * 32 + i0) * 2;
    if (!meta) {
        float f[8]; unpack8(*(const u32x4*)(zr + 448 + 8 * lane), f);
        float ss = 0.f;
#pragma unroll
        for (int j = 0; j < 8; ++j) ss += f[j] * f[j];
        ss += __shfl_xor(ss, 1); ss += __shfl_xor(ss, 2); ss += __shfl_xor(ss, 4); ss += __shfl_xor(ss, 8);
        const float rs = rsq(ss * (1.f / 128) + RMS_EPS); float o[8];
#pragma unroll
        for (int j = 0; j < 4; ++j) { const int d1 = half * 64 + i0 + j, d2 = d1 + 32;
            const float x1 = f[2 * j] * rs * g_q_gqa[d1], x2 = f[2 * j + 1] * rs * g_q_gqa[d2], c = t[2 * j], sn = t[2 * j + 1];
            o[2 * j] = x1 * c - x2 * sn; o[2 * j + 1] = x1 * sn + x2 * c; }
        *(u32x4*)(qg + ((size_t)(b * 4 + (lane >> 4)) * 2048 + s) * 128 + p0) = pack8(o);
    }
    {
        float f[8]; unpack8(*(const u32x4*)(zr + 960 + 8 * lane), f);
        float ss = 0.f;
#pragma unroll
        for (int j = 0; j < 8; ++j) ss += f[j] * f[j];
        ss += __shfl_xor(ss, 1); ss += __shfl_xor(ss, 2); ss += __shfl_xor(ss, 4); ss += __shfl_xor(ss, 8);
        float o[8];
        if (lane < 32) { const float rs = rsq(ss * (1.f / 128) + RMS_EPS);
#pragma unroll
            for (int j = 0; j < 4; ++j) { const int d1 = half * 64 + i0 + j, d2 = d1 + 32;
                const float x1 = f[2 * j] * rs * g_k_gqa[d1], x2 = f[2 * j + 1] * rs * g_k_gqa[d2], c = t[2 * j], sn = t[2 * j + 1];
                o[2 * j] = x1 * c - x2 * sn; o[2 * j + 1] = x1 * sn + x2 * c; }
        } else {
#pragma unroll
            for (int j = 0; j < 8; ++j) o[j] = f[j];
        }
        const u32x4 pk = pack8(o); bf16* dst = lane < 32 ? kg : vg; const int hk = (lane >> 4) & 1;
        if (!meta) *(u32x4*)(dst + ((size_t)(b * 2 + hk) * LKP + key) * 128 + p0) = pk;
        else for (int bb = 0; bb < NB; ++bb) *(u32x4*)(dst + ((size_t)(bb * 2 + hk) * LKP + key) * 128 + p0) = pk;
    }
}

__device__ __forceinline__ int crow(int r, int hi) { return (r & 3) + 8 * (r >> 2) + 4 * hi; }
__device__ __forceinline__ int v_st(int k, int c) { const int kk = (k & ~0xC) | ((k & 4) << 1) | ((k & 8) >> 1); return ((kk >> 3) * 4 + (c >> 5)) * 512 + ((kk & 7) * 32 + (c & 31)) * 2; }
__device__ __forceinline__ int v_rd_base(int lane) { return ((lane & 3) << 3) | (((lane >> 2) & 3) << 6) | (((lane >> 4) & 1) << 5) | (((lane >> 5) & 1) << 8); }
constexpr int v_rd_off(int d0, int ks, int half) { return d0 * 512 + ks * 4096 + half * 2048; }
template <int OFF> __device__ __forceinline__ s16x4 tr_read(int vb) {
    s16x4 r; asm volatile("ds_read_b64_tr_b16 %0, %1 offset:%2" : "=&v"(r) : "v"(vb), "i"(OFF) : "memory"); return r;
}
template <int D0> __device__ __forceinline__ void pv_one(f32x16& od, int vb, bf16x8 pa0, bf16x8 pa1, bf16x8 pa2, bf16x8 pa3) {
    const s16x4 l0 = tr_read<v_rd_off(D0, 0, 0)>(vb), h0 = tr_read<v_rd_off(D0, 0, 1)>(vb), l1 = tr_read<v_rd_off(D0, 1, 0)>(vb), h1 = tr_read<v_rd_off(D0, 1, 1)>(vb);
    const s16x4 l2 = tr_read<v_rd_off(D0, 2, 0)>(vb), h2 = tr_read<v_rd_off(D0, 2, 1)>(vb), l3 = tr_read<v_rd_off(D0, 3, 0)>(vb), h3 = tr_read<v_rd_off(D0, 3, 1)>(vb);
    asm volatile("s_waitcnt lgkmcnt(0)" ::: "memory"); SBAR();
#define PK(L, H) (bf16x8){L[0], L[1], L[2], L[3], H[0], H[1], H[2], H[3]}
    od = __builtin_amdgcn_mfma_f32_32x32x16_bf16(pa0, PK(l0, h0), od, 0, 0, 0);
    od = __builtin_amdgcn_mfma_f32_32x32x16_bf16(pa1, PK(l1, h1), od, 0, 0, 0);
    od = __builtin_amdgcn_mfma_f32_32x32x16_bf16(pa2, PK(l2, h2), od, 0, 0, 0);
    od = __builtin_amdgcn_mfma_f32_32x32x16_bf16(pa3, PK(l3, h3), od, 0, 0, 0);
#undef PK
}
__device__ __forceinline__ void pv_d0(f32x16* o, int vb, bf16x8 pa0, bf16x8 pa1, bf16x8 pa2, bf16x8 pa3) {
    pv_one<0>(o[0], vb, pa0, pa1, pa2, pa3); pv_one<1>(o[1], vb, pa0, pa1, pa2, pa3); pv_one<2>(o[2], vb, pa0, pa1, pa2, pa3); pv_one<3>(o[3], vb, pa0, pa1, pa2, pa3);
}
template <int DQK> struct AttnC {
    static constexpr float SCALE = DQK == 192 ? 0.07216878364870322f : 0.08838834764831845f;
    static constexpr float C = SCALE * 1.4426950408889634f, THRS = 8.f / SCALE;
};
template <int DQK>
__device__ __forceinline__ void partialSM(f32x16& p0, f32x16& p1, float& m_reg, float& mn, float& alpha) {
    constexpr float C = AttnC<DQK>::C;
    float pmax = p0[0];
#pragma unroll
    for (int r = 1; r < 16; ++r) pmax = fmaxf(pmax, p0[r]);
#pragma unroll
    for (int r = 0; r < 16; ++r) pmax = fmaxf(pmax, p1[r]);
    { auto rr = __builtin_amdgcn_permlane32_swap(__float_as_uint(pmax), __float_as_uint(pmax), false, false);
      pmax = fmaxf(__uint_as_float(rr[0]), __uint_as_float(rr[1])); }
    if (__builtin_expect(__all(pmax - m_reg <= AttnC<DQK>::THRS), 1)) { mn = m_reg; alpha = 1.f; }
    else { mn = fmaxf(m_reg, pmax); alpha = __builtin_amdgcn_exp2f((m_reg - mn) * C); m_reg = mn; }
    const float mnC = -mn * C;
#pragma unroll
    for (int r = 0; r < 16; ++r) p0[r] = fmaf(p0[r], C, mnC);
#pragma unroll
    for (int r = 0; r < 16; ++r) p1[r] = fmaf(p1[r], C, mnC);
#pragma unroll
    for (int r = 0; r < 16; ++r) p0[r] = __builtin_amdgcn_exp2f(p0[r]);
}
__device__ __forceinline__ void finishSM(f32x16& p0, f32x16& p1, float alpha, float& l_reg, bf16x8& pa0, bf16x8& pa1, bf16x8& pa2, bf16x8& pa3) {
#pragma unroll
    for (int r = 0; r < 16; ++r) p1[r] = __builtin_amdgcn_exp2f(p1[r]);
    float ps = 0;
#pragma unroll
    for (int r = 0; r < 16; ++r) ps += p0[r];
#pragma unroll
    for (int r = 0; r < 16; ++r) ps += p1[r];
    { auto rr = __builtin_amdgcn_permlane32_swap(__float_as_uint(ps), __float_as_uint(ps), false, false);
      ps = __uint_as_float(rr[0]) + __uint_as_float(rr[1]); }
    l_reg = l_reg * alpha + ps;
#define PK4(P, BASE, OUT) do { unsigned a0 = cvtpk(P[BASE + 0], P[BASE + 1]), a1 = cvtpk(P[BASE + 2], P[BASE + 3]);   \
    unsigned b0 = cvtpk(P[BASE + 4], P[BASE + 5]), b1 = cvtpk(P[BASE + 6], P[BASE + 7]);                              \
    auto r0 = __builtin_amdgcn_permlane32_swap(a0, b0, false, false); auto r1 = __builtin_amdgcn_permlane32_swap(a1, b1, false, false); \
    u32x4 w = {r0[0], r1[0], r0[1], r1[1]}; OUT = *reinterpret_cast<bf16x8*>(&w); } while (0)
    PK4(p0, 0, pa0); PK4(p0, 8, pa1); PK4(p1, 0, pa2); PK4(p1, 8, pa3);
#undef PK4
}
template <int DQK>
__device__ __forceinline__ void qkt(f32x16& p0, f32x16& p1, const LAS char* Ks, const bf16x8* qr, const LAS char* ql, const int (&ko)[4]) {
    constexpr int KRB = DQK * 2;
    p0 = f32x16{}; p1 = f32x16{};
#pragma unroll
    for (int d0 = 0; d0 < DQK / 16; ++d0) { const LAS char* kp = Ks + ko[d0 & 3] + (d0 >> 2) * 128;
        const bf16x8 b0 = *(const LAS bf16x8*)(kp);
        const bf16x8 b1 = *(const LAS bf16x8*)(kp + 32 * KRB);
        bf16x8 q; if (d0 < 8) q = qr[d0]; else q = *(const LAS bf16x8*)(ql + (d0 - 8) * 1024);
        p0 = __builtin_amdgcn_mfma_f32_32x32x16_bf16(b0, q, p0, 0, 0, 0);
        p1 = __builtin_amdgcn_mfma_f32_32x32x16_bf16(b1, q, p1, 0, 0, 0); }
}
template <int DQK, int SD>
__device__ __forceinline__ void attn_body(const bf16* __restrict__ Qb, const bf16* __restrict__ Kh, const bf16* __restrict__ Vh, bf16* __restrict__ Ob, LAS char* lds) {
    constexpr int ND0 = DQK / 16, KRB = DQK * 2, SHM_K = 64 * KRB, SHM_V = 64 * 128 * 2, NKC = DQK / 64, CPR = DQK / 8, NT = LKP / 64;
    static_assert(NT % 2 == 1, "odd tile count: the tail below takes tiles NT-2 and NT-1");
    int tid = threadIdx.x; asm volatile("" : "+v"(tid));
    const int wid = tid >> 6, lane = tid & 63, r32 = lane & 31, hi = lane >> 5;
    LAS char* V_lds = lds; LAS char* K_lds = lds + 2 * SHM_V;
    __syncthreads();
    float m_reg = -1e30f, l_reg = 0; f32x16 o[4] = {}; bf16x8 qr[8];
    const bf16* Qw = Qb + (size_t)(wid * 32 + r32) * DQK + hi * 8;
#pragma unroll
    for (int d0 = 0; d0 < 8; ++d0) qr[d0] = *reinterpret_cast<const bf16x8*>(Qw + d0 * 16);
    LAS char* ql = lds + 2 * SHM_V + 2 * SHM_K + 2048 + wid * 4096 + lane * 16;
#pragma unroll
    for (int d0 = 8; d0 < ND0; ++d0) *(LAS bf16x8*)(ql + (d0 - 8) * 1024) = *reinterpret_cast<const bf16x8*>(Qw + d0 * 16);
    const int sr = tid >> 4, sc = (tid & 15) * 8, vst0 = v_st(sr, sc), vst1 = v_st(32 + sr, sc);
    int kst[NKC];
#pragma unroll
    for (int c = 0; c < NKC; ++c) { const int id = tid + 512 * c, kr = id / CPR, kc = (id - kr * CPR) * 8; kst[c] = kr * KRB + ((kc * 2) ^ ((kr & 7) << 4)); }
    const int voff = tid * 16;
    int ko[4];
#pragma unroll
    for (int q = 0; q < 4; ++q) ko[q] = r32 * KRB + ((q * 32 + hi * 16) ^ ((r32 & 7) << 4));
    const __amdgpu_buffer_rsrc_t rK = __builtin_amdgcn_make_buffer_rsrc((void*)Kh, 0, LKP * KRB, 0x00020000);
    const __amdgpu_buffer_rsrc_t rV = __builtin_amdgcn_make_buffer_rsrc((void*)Vh, 0, LKP * 256, 0x00020000);
    const int vb0 = (int)(unsigned)(uintptr_t)V_lds + v_rd_base(lane);
    struct { bf16x8 vs0, vs1, ks[NKC]; } sr_[SD];
#define SLOAD(i, k0) do { sr_[i].vs0 = __builtin_bit_cast(bf16x8, __builtin_amdgcn_raw_buffer_load_b128(rV, voff, (k0) * 256, 0)); sr_[i].vs1 = __builtin_bit_cast(bf16x8, __builtin_amdgcn_raw_buffer_load_b128(rV, voff, (k0) * 256 + 8192, 0)); \
    _Pragma("unroll") for (int c_ = 0; c_ < NKC; ++c_) sr_[i].ks[c_] = __builtin_bit_cast(bf16x8, __builtin_amdgcn_raw_buffer_load_b128(rK, voff, (k0) * KRB + c_ * 8192, 0)); } while (0)
#define SWRITE(b, i) do { *(LAS bf16x8*)(V_lds + (b) * SHM_V + vst0) = sr_[i].vs0; *(LAS bf16x8*)(V_lds + (b) * SHM_V + vst1) = sr_[i].vs1; \
    _Pragma("unroll") for (int c_ = 0; c_ < NKC; ++c_) *(LAS bf16x8*)(K_lds + (b) * SHM_K + kst[c_]) = sr_[i].ks[c_]; } while (0)
#define SWAIT() do { if constexpr (SD == 2) { if constexpr (NKC == 2) asm volatile("s_waitcnt vmcnt(4)" ::: "memory"); else asm volatile("s_waitcnt vmcnt(5)" ::: "memory"); } \
    else asm volatile("s_waitcnt vmcnt(0)" ::: "memory"); } while (0)
#define RESC(a) do { if (__any((a) < 1.f)) { int t_ = threadIdx.x; asm volatile("" : "+v"(t_)); const int r32_ = t_ & 31, hi_2 = (t_ >> 5) & 1; \
    LAS float* al_ = (LAS float*)(lds + 2 * SHM_V + 2 * SHM_K) + (t_ >> 6) * 64 + 32; if (hi_2 == 0) al_[r32_] = (a); asm volatile("s_waitcnt lgkmcnt(0)" ::: "memory"); \
    _Pragma("unroll") for (int d = 0; d < 4; ++d) _Pragma("unroll") for (int r = 0; r < 16; ++r) o[d][r] *= al_[crow(r, hi_2)]; } } while (0)
    f32x16 pA0, pA1, pB0, pB1; float mnA, mnB, alA, alB; bf16x8 pa0, pa1, pa2, pa3;
    constexpr int SE = 0, SO = SD - 1;
    SLOAD(SE, 0); asm volatile("s_waitcnt vmcnt(0)" ::: "memory"); SWRITE(0, SE); __syncthreads();
    qkt<DQK>(pA0, pA1, K_lds, qr, ql, ko); partialSM<DQK>(pA0, pA1, m_reg, mnA, alA);
    SLOAD(SO, 64); if constexpr (SD == 2) { SLOAD(SE, 128); }
    SWAIT(); SWRITE(1, SO); __syncthreads();
#pragma unroll 1
    for (int j = 1; j + 2 < NT; j += 2) {
        SBAR(); qkt<DQK>(pB0, pB1, K_lds + SHM_K, qr, ql, ko);
        finishSM(pA0, pA1, alA, l_reg, pa0, pa1, pa2, pa3); SBAR();
        SLOAD(SO, (j + SD) * 64); SBAR();
        pv_d0(o, vb0, pa0, pa1, pa2, pa3); partialSM<DQK>(pB0, pB1, m_reg, mnB, alB);
        __syncthreads(); SWAIT(); SWRITE(0, SE);
        RESC(alB); __syncthreads();
        SBAR(); qkt<DQK>(pA0, pA1, K_lds, qr, ql, ko);
        finishSM(pB0, pB1, alB, l_reg, pa0, pa1, pa2, pa3); SBAR();
        SLOAD(SE, (j + 1 + SD) * 64); SBAR();
        pv_d0(o, vb0 + SHM_V, pa0, pa1, pa2, pa3); partialSM<DQK>(pA0, pA1, m_reg, mnA, alA);
        __syncthreads(); SWAIT(); SWRITE(1, SO);
        RESC(alA); __syncthreads();
    }
    SBAR(); qkt<DQK>(pB0, pB1, K_lds + SHM_K, qr, ql, ko);
    finishSM(pA0, pA1, alA, l_reg, pa0, pa1, pa2, pa3); SBAR();
    if constexpr (SD == 1) { SLOAD(SE, (NT - 1) * 64); } SBAR();
    pv_d0(o, vb0, pa0, pa1, pa2, pa3); partialSM<DQK>(pB0, pB1, m_reg, mnB, alB);
    __syncthreads(); asm volatile("s_waitcnt vmcnt(0)" ::: "memory"); SWRITE(0, SE);
    RESC(alB); __syncthreads();
    SBAR(); qkt<DQK>(pA0, pA1, K_lds, qr, ql, ko);
#pragma unroll
    for (int r = 8; r < 16; ++r) pA0[r] = -1e30f;
#pragma unroll
    for (int r = 0; r < 16; ++r) pA1[r] = -1e30f;
    finishSM(pB0, pB1, alB, l_reg, pa0, pa1, pa2, pa3); SBAR();
    pv_d0(o, vb0 + SHM_V, pa0, pa1, pa2, pa3); partialSM<DQK>(pA0, pA1, m_reg, mnA, alA);
    RESC(alA);
    finishSM(pA0, pA1, alA, l_reg, pa0, pa1, pa2, pa3); SBAR();
    pv_d0(o, vb0, pa0, pa1, pa2, pa3);
    { int t_ = threadIdx.x; asm volatile("" : "+v"(t_)); const int r32_ = t_ & 31, hi_2 = (t_ >> 5) & 1, wid_ = t_ >> 6;
      LAS float* li_ = (LAS float*)(lds + 2 * SHM_V + 2 * SHM_K) + wid_ * 64;
      if (hi_2 == 0) li_[r32_] = l_reg; asm volatile("s_waitcnt lgkmcnt(0)" ::: "memory");
      float rli[16];
#pragma unroll
      for (int r = 0; r < 16; ++r) rli[r] = __builtin_amdgcn_rcpf(li_[crow(r, hi_2)]);
      bf16* Ow = Ob + (size_t)(wid_ * 32) * DM;
#pragma unroll
      for (int r = 0; r < 16; ++r) { const int orow = crow(r, hi_2);
#pragma unroll
          for (int d0 = 0; d0 < 4; ++d0) Ow[(size_t)orow * DM + d0 * 32 + r32_] = (bf16)(cvtpk(o[d0][r] * rli[r], 0.f) & 0xffffu); } }
#undef SLOAD
#undef SWRITE
#undef SWAIT
#undef RESC
}

constexpr int NPHASE = 14;
struct Args { const float* in[24]; float* out; unsigned char* ws; int ph_lo, ph_hi; };
__global__ void __launch_bounds__(NWAVES * 64, 2) hymba_fwd(Args args) {
    extern __shared__ __attribute__((aligned(16))) unsigned char lds[];
    const int tid = threadIdx.x, lane = tid & 63, wave = __builtin_amdgcn_readfirstlane(tid >> 6);
    const int G = gridDim.x, bx = blockIdx.x, vcu = (G % 8 == 0) ? (bx % 8) * (G / 8) + bx / 8 : bx;
    const int gw = vcu * NWAVES + wave, ngw = G * NWAVES, gtid = vcu * (NWAVES * 64) + tid, ngt = G * NWAVES * 64;
    unsigned char* ws = args.ws;
    volatile LAS unsigned* MISC = (volatile LAS unsigned*)((LAS unsigned char*)lds + LDSCTL_OFF);
    for (int u = tid; u < 1024; u += NWAVES * 64) ((LAS unsigned*)((LAS unsigned char*)lds + LDSCTL_OFF))[u] = 0u;
    __syncthreads();
#if !MK_SPLIT
    XcdBarrier bar = xcd_barrier_post((unsigned*)(ws + WS_CTL) + CW_BAR, MISC + 8);
#define GRID_BAR() xcd_barrier(bar)
#else
#define GRID_BAR() do {} while (0)
#endif
    const int lo = args.ph_lo, hi_ = args.ph_hi;
#ifndef REP_MASK
#define REP_MASK 0
#endif
#define IN(k) (lo <= (k) && (k) < hi_)
#define REPS(k) (((REP_MASK >> (k)) & 1) ? 2 : 1)
#define SEAM(k) do { if (IN(k) && IN((k) + 1)) GRID_BAR(); } while (0)

    const float* x = args.in[0]; const float* meta_tok = args.in[1];
    float* rope = (float*)(ws + WS_ROPE);
    bf16* w_in_t = (bf16*)(ws + WS_WIN); bf16* w_qb_t = (bf16*)(ws + WS_WQB); bf16* w_kvb_t = (bf16*)(ws + WS_WKVB); bf16* w_o_t = (bf16*)(ws + WS_WO);
    bf16* w_r_t = (bf16*)(ws + WS_WR); unsigned char* w_gu8 = ws + WS_WGU; unsigned char* w_dn8 = ws + WS_WDN; unsigned char* h1f8 = ws + WS_H1F8;
    bf16* h0 = (bf16*)(ws + WS_H0); bf16* h1 = (bf16*)(ws + WS_H1); bf16* qan = (bf16*)(ws + WS_QAN); bf16* kvan = (bf16*)(ws + WS_KVAN); bf16* z = (bf16*)(ws + WS_Z);
    bf16* qm = (bf16*)(ws + WS_QM); bf16* km = (bf16*)(ws + WS_KM); bf16* vm = (bf16*)(ws + WS_VM); bf16* qg = (bf16*)(ws + WS_QG); bf16* kg = (bf16*)(ws + WS_KG); bf16* vg = (bf16*)(ws + WS_VG);
    bf16* ob = (bf16*)(ws + WS_O); float* y1 = (float*)(ws + WS_Y1); float* logits = (float*)(ws + WS_LOGITS);
    int* topk = (int*)(ws + WS_TOPK); float* gate = (float*)(ws + WS_GATE); int* pair_pos = (int*)(ws + WS_PAIRPOS); float* row_gate = (float*)(ws + WS_ROWGATE);
    int* hist = (int*)(ws + WS_HIST); int* moetab = (int*)(ws + WS_MOETAB); int* tile_expert = moetab + 256;
    unsigned char* xs8 = ws + WS_XS; unsigned char* act8 = ws + WS_ACT; bf16* out2 = (bf16*)(ws + WS_OUT2);

    for (int rep_ = 0; rep_ < (IN(0) ? REPS(0) : 0); ++rep_) { if (rep_) GRID_BAR();
        LAS float* scr = (LAS float*)((LAS unsigned char*)lds + wave * 16384);
        constexpr int I_IN = 16 * 46, I_QB = 4 * 24, I_KVB = 2 * 32, I_O = 16 * 32, I_R = 16, I_GU1 = 16 * 64, I_DN1 = 16 * 32;
        constexpr int NITEMS = I_IN + I_QB + I_KVB + I_O + I_R + NE * I_GU1 + NE * I_DN1;
        for (int it = gw; it < NITEMS; it += ngw) {
            int r = it;
            if (r < I_IN) { transpose_item(args.in[4], 1024, NIN, w_in_t, scr, r, lane, MapIn()); continue; } r -= I_IN;
            if (r < I_QB) { transpose_item(args.in[6], 256, 768, w_qb_t, scr, r, lane, MapQ()); continue; } r -= I_QB;
            if (r < I_KVB) { transpose_item(args.in[8], 128, 1024, w_kvb_t, scr, r, lane, MapId()); continue; } r -= I_KVB;
            if (r < I_O) { transpose_item(args.in[13], 1024, 1024, w_o_t, scr, r, lane, MapId()); continue; } r -= I_O;
            if (r < I_R) { transpose_item(args.in[16], 1024, 32, w_r_t, scr, r, lane, MapId()); continue; } r -= I_R;
            if (r < NE * I_GU1) { const int e = r / I_GU1; transpose_item_f8(args.in[18] + (size_t)e * 1024 * 2048, 1024, 2048, w_gu8 + (size_t)e * 2048 * 1024, scr, r - e * I_GU1, lane, MapGU(), W8_SCALE); continue; } r -= NE * I_GU1;
            { const int e = r / I_DN1; transpose_item_f8(args.in[20] + (size_t)e * 1024 * 1024, 1024, 1024, w_dn8 + (size_t)e * 1024 * 1024, scr, r - e * I_DN1, lane, MapId(), W8_SCALE); }
        }
        for (int m = gw; m < MROWS; m += ngw) ln_row_f32_to_bf16(m < NTOK ? x + (size_t)m * DM : meta_tok + (size_t)(m - NTOK) * DM, args.in[2], args.in[3], h0 + (size_t)m * DM, lane);
        zero_bytes(h0 + (size_t)MROWS * DM, (size_t)(MPAD - MROWS) * DM * 2, gtid, ngt);
        zero_bytes(w_in_t + (size_t)NIN * 1024, (size_t)(ZLD - NIN) * 1024 * 2, gtid, ngt);
        for (int i = gw; i < 64 + 64 + 32 + 32; i += ngw) {
            bf16* p; size_t rb;
            if (i < 64) { p = km + ((size_t)i * LKP + 2064) * 192; rb = 48 * 192 * 2; }
            else if (i < 128) { p = vm + ((size_t)(i - 64) * LKP + 2064) * 128; rb = 48 * 128 * 2; }
            else if (i < 160) { p = kg + ((size_t)(i - 128) * LKP + 2064) * 128; rb = 48 * 128 * 2; }
            else { p = vg + ((size_t)(i - 160) * LKP + 2064) * 128; rb = 48 * 128 * 2; }
            zero_bytes(p, rb, lane, 64);
        }
        for (int i = gtid; i < 2065 * 32; i += ngt) {
            const int p = i / 32 - 1, f = i & 31; double inv = 1.0;
            for (int q = 0; q < f; ++q) inv *= 0.74989420933245582730;
            const float ang = (float)p * (float)inv; float sn, cs; sincos_d(fabsf(ang), sn, cs); if (ang < 0.f) sn = -sn;
            rope[2 * i] = cs; rope[2 * i + 1] = sn;
        }
    }
    SEAM(0);
    for (int rep_ = 0; rep_ < (IN(1) ? REPS(1) : 0); ++rep_) { if (rep_) GRID_BAR(); EpiZ E{z};
#if FAST_Z
        { pg8::Gemm g{h0, w_in_t, NTOK, ZLD, 1024}; pg8::StaticOrder S; S.init(NTOK, ZLD, G, bx); pg8::EpiAdapt<EpiZ> EA{E, 0};
          pg8::gemm_phase<pg8::EpiAdapt<EpiZ>, pg8::StaticOrder, true, true>((LAS unsigned char*)lds, g, S, EA); }
        simple_gemm(h0, w_in_t, 1024, NTOK, NTOK + 64, ZLD, E, BSelNone(), gw, ngw, lane);
#else
        simple_gemm(h0, w_in_t, 1024, 0, NTOK + 64, ZLD, E, BSelNone(), gw, ngw, lane);
#endif
    }
    SEAM(1);
    for (int rep_ = 0; rep_ < (IN(2) ? REPS(2) : 0); ++rep_) { if (rep_) GRID_BAR(); for (int m = gw; m < MROWS; m += ngw) p2a_row(m, z, rope, args.in[5], args.in[7], args.in[9], args.in[10], qan, kvan, km, qg, kg, vg, lane); }
    SEAM(2);
    for (int rep_ = 0; rep_ < (IN(3) ? REPS(3) : 0); ++rep_) { if (rep_) GRID_BAR();
        { EpiQ E{qm, rope}; simple_gemm(qan, w_qb_t, 256, 0, NTOK, 768, E, BSelNone(), gw, ngw, lane); }
        { EpiKV E{km, vm}; simple_gemm(kvan, w_kvb_t, 128, 0, NTOK + 64, 1024, E, BSelNone(), gw, ngw, lane); }
    }
    SEAM(3);
    for (int rep_ = 0; rep_ < (IN(4) ? REPS(4) : 0); ++rep_) { if (rep_) GRID_BAR();
        for (int u = vcu; u < 1024; u += G) {
            if (u < 512) { const int b = u >> 5, h = (u >> 3) & 3, qb = u & 7, bh = b * 4 + h;
                attn_body<192, 1>(qm + ((size_t)bh * 2048 + qb * 256) * 192, km + (size_t)bh * LKP * 192, vm + (size_t)bh * LKP * 128, ob + ((size_t)b * 2048 + qb * 256) * DM + h * 128, (LAS char*)lds);
            } else { const int v = u - 512, b = v >> 5, h = (v >> 3) & 3, qb = v & 7, bh = b * 4 + h, bk = b * 2 + (h >> 1);
                attn_body<128, 2>(qg + ((size_t)bh * 2048 + qb * 256) * 128, kg + (size_t)bk * LKP * 128, vg + (size_t)bk * LKP * 128, ob + ((size_t)b * 2048 + qb * 256) * DM + 512 + h * 128, (LAS char*)lds);
            }
        }
    }
    SEAM(4);
    for (int rep_ = 0; rep_ < (IN(5) ? REPS(5) : 0); ++rep_) { if (rep_) GRID_BAR();
        for (int m = gw; m < NTOK; m += ngw) {
#pragma unroll
            for (int g = 0; g < 2; ++g) { bf16* p = ob + (size_t)m * DM + g * 512 + 8 * lane; float f[8]; unpack8(*(const u32x4*)p, f);
                float ss = 0.f;
#pragma unroll
                for (int j = 0; j < 8; ++j) ss += f[j] * f[j];
                const float rs = rsq(wave_sum(ss) * (1.f / 512) + RMS_EPS); const float* gg = (g ? args.in[12] : args.in[11]) + 8 * lane;
#pragma unroll
                for (int j = 0; j < 8; ++j) f[j] = f[j] * rs * gg[j];
                *(u32x4*)p = pack8(f); }
        }
    }
    SEAM(5);
    for (int rep_ = 0; rep_ < (IN(6) ? REPS(6) : 0); ++rep_) { if (rep_) GRID_BAR(); EpiO E{y1, h0};
#if FAST_O
        pg8::Gemm g{ob, w_o_t, NTOK, 1024, 1024}; pg8::StaticOrder S; S.init(NTOK, 1024, G, bx); pg8::EpiAdapt<EpiO> EA{E, 0};
        pg8::gemm_phase<pg8::EpiAdapt<EpiO>, pg8::StaticOrder, true, true>((LAS unsigned char*)lds, g, S, EA);
#else
        simple_gemm(ob, w_o_t, 1024, 0, NTOK, 1024, E, BSelNone(), gw, ngw, lane);
#endif
    }
    SEAM(6);
    for (int rep_ = 0; rep_ < (IN(7) ? REPS(7) : 0); ++rep_) { if (rep_) GRID_BAR(); for (int m = gw; m < NTOK; m += ngw) ln_row_f32_to_bf16(y1 + (size_t)m * DM, args.in[14], args.in[15], h1 + (size_t)m * DM, lane, h1f8 + (size_t)m * DM); }
    SEAM(7);
    for (int rep_ = 0; rep_ < (IN(8) ? REPS(8) : 0); ++rep_) { if (rep_) GRID_BAR(); EpiLogit E{logits, args.in[17]}; simple_gemm(h1, w_r_t, 1024, 0, NTOK, 32, E, BSelNone(), gw, ngw, lane); }
    SEAM(8);
    const int tpb = (NTOK + G - 1) / G, tok_lo = bx * tpb, tok_hi = (tok_lo + tpb < NTOK) ? tok_lo + tpb : NTOK;
    LAS int* L_hist = (LAS int*)((LAS unsigned char*)lds + LDSCTL_OFF + 256);
    LAS int* L_n = L_hist + 32; LAS int* L_base = L_hist + 64; LAS int* L_off = L_hist + 96;
    for (int rep_ = 0; rep_ < (IN(9) ? REPS(9) : 0); ++rep_) { if (rep_) GRID_BAR();
        if (tid < 32) L_hist[tid] = 0;
        __syncthreads();
        for (int t = tok_lo + wave; t < tok_hi; t += NWAVES) {
            float v = lane < 32 ? logits[(size_t)t * NE + lane] : -INFINITY; float tv[4]; int ti[4];
#pragma unroll
            for (int r = 0; r < 4; ++r) { float bv = v; int bi = lane;
#pragma unroll
                for (int off = 32; off >= 1; off >>= 1) { const float ov = __shfl_xor(bv, off); const int oi = __shfl_xor(bi, off); if (ov > bv || (ov == bv && oi < bi)) { bv = ov; bi = oi; } }
                tv[r] = bv; ti[r] = bi; if (lane == bi) v = -INFINITY; }
            const float e1 = __expf(tv[1] - tv[0]), e2 = __expf(tv[2] - tv[0]), e3 = __expf(tv[3] - tv[0]), inv = 1.f / (1.f + e1 + e2 + e3);
            if (lane == 0) { *(int4*)(topk + (size_t)t * 4) = make_int4(ti[0], ti[1], ti[2], ti[3]); *(f32x4*)(gate + (size_t)t * 4) = (f32x4){inv, e1 * inv, e2 * inv, e3 * inv};
                atomicAdd((int*)(L_hist + ti[0]), 1); atomicAdd((int*)(L_hist + ti[1]), 1); atomicAdd((int*)(L_hist + ti[2]), 1); atomicAdd((int*)(L_hist + ti[3]), 1); }
        }
        __syncthreads();
        if (tid < 32) hist[bx * 32 + tid] = L_hist[tid];
    }
    SEAM(9);
    for (int rep_ = 0; rep_ < (IN(10) ? REPS(10) : 0); ++rep_) { if (rep_) GRID_BAR();
        if (tid < 32) { int tot = 0, before = 0; for (int b = 0; b < G; ++b) { const int h = hist[b * 32 + tid]; tot += h; if (b < bx) before += h; } L_n[tid] = tot; L_base[tid] = before; L_hist[tid] = 0; }
        __syncthreads();
        if (tid == 0) { int off = 0; for (int e = 0; e < NE; ++e) { L_off[e] = off; off += (L_n[e] + 255) & ~255; } L_off[NE] = off; }
        __syncthreads();
        LAS int* L_pos = (LAS int*)((LAS unsigned char*)lds);
        for (int p = tok_lo * 4 + tid; p < tok_hi * 4; p += NWAVES * 64) { const int e = topk[p]; const int r = atomicAdd((int*)(L_hist + e), 1); const int pos = L_off[e] + L_base[e] + r;
            row_gate[pos] = gate[p]; pair_pos[p] = pos; L_pos[p - tok_lo * 4] = pos; }
        __syncthreads();
        for (int p = tok_lo * 4 + wave; p < tok_hi * 4; p += NWAVES) { const int pos = L_pos[p - tok_lo * 4]; const u32x4* src = (const u32x4*)(h1f8 + (size_t)(p >> 2) * DM); u32x4* dst = (u32x4*)(xs8 + (size_t)pos * DM);
            dst[lane] = src[lane]; }
        if (bx == 0) { if (tid == 0) moetab[0] = L_off[NE];
            if (tid < 32) { moetab[64 + tid] = L_n[tid]; moetab[128 + tid] = L_off[tid]; for (int t = L_off[tid] >> 8; t < (L_off[tid + 1] >> 8); ++t) tile_expert[t] = tid; } }
        __syncthreads();
    }
    SEAM(10);
    for (int rep_ = 0; rep_ < (IN(11) ? REPS(11) : 0); ++rep_) { if (rep_) GRID_BAR(); const int rows = moetab[0]; EpiGU8 E{act8, args.in[19]};
        pg8::Gemm g{(const bf16*)xs8, (const bf16*)w_gu8, rows, 2048, 512}; pg8::MoeOrder S; S.init(rows >> 8, 8, G, bx, tile_expert);
        pg8::gemm_phase<EpiGU8, pg8::MoeOrder, true, true, true>((LAS unsigned char*)lds, g, S, E);
    }
    SEAM(11);
    for (int rep_ = 0; rep_ < (IN(12) ? REPS(12) : 0); ++rep_) { if (rep_) GRID_BAR(); const int rows = moetab[0]; EpiDN8 E{out2, args.in[21], row_gate};
        pg8::Gemm g{(const bf16*)act8, (const bf16*)w_dn8, rows, 1024, 512}; pg8::MoeOrder S; S.init(rows >> 8, 4, G, bx, tile_expert);
        pg8::gemm_phase<EpiDN8, pg8::MoeOrder, true, true, true>((LAS unsigned char*)lds, g, S, E);
    }
    SEAM(12);
    for (int rep_ = 0; rep_ < (IN(13) ? REPS(13) : 0); ++rep_) { if (rep_) GRID_BAR();
        for (int t = gw; t < NTOK; t += ngw) {
            const int4 pp = *(const int4*)(pair_pos + (size_t)t * 4); const int ps[4] = {pp.x, pp.y, pp.z, pp.w};
            float v[16];
#pragma unroll
            for (int hf = 0; hf < 2; ++hf) { float f[8]; unpack8(*(const u32x4*)(h1 + (size_t)t * DM + hf * 512 + 8 * lane), f);
#pragma unroll
                for (int j = 0; j < 8; ++j) v[hf * 8 + j] = ALPHA * f[j];
#pragma unroll
                for (int s4 = 0; s4 < 4; ++s4) { float g[8]; unpack8(*(const u32x4*)(out2 + (size_t)ps[s4] * DM + hf * 512 + 8 * lane), g);
#pragma unroll
                    for (int j = 0; j < 8; ++j) v[hf * 8 + j] += g[j]; } }
            float s = 0.f;
#pragma unroll
            for (int j = 0; j < 16; ++j) s += v[j];
            const float mean = wave_sum(s) * (1.f / DM); float s2 = 0.f;
#pragma unroll
            for (int j = 0; j < 16; ++j) { v[j] -= mean; s2 += v[j] * v[j]; }
            const float rstd = rsq(wave_sum(s2) * (1.f / DM) + LN_EPS);
#pragma unroll
            for (int hf = 0; hf < 2; ++hf) { const int c = hf * 512 + 8 * lane; const float* gg = args.in[22] + c; const float* bb = args.in[23] + c; float* o = args.out + (size_t)t * DM + c;
                *(f32x4*)o = (f32x4){v[hf * 8 + 0] * rstd * gg[0] + bb[0], v[hf * 8 + 1] * rstd * gg[1] + bb[1], v[hf * 8 + 2] * rstd * gg[2] + bb[2], v[hf * 8 + 3] * rstd * gg[3] + bb[3]};
                *(f32x4*)(o + 4) = (f32x4){v[hf * 8 + 4] * rstd * gg[4] + bb[4], v[hf * 8 + 5] * rstd * gg[5] + bb[5], v[hf * 8 + 6] * rstd * gg[6] + bb[6], v[hf * 8 + 7] * rstd * gg[7] + bb[7]}; }
        }
    }
#undef IN
#undef SEAM
}

extern "C" void kernel_launch(void* const* d_in, const int* in_sizes, int n_in, void* d_out, int out_size, void* d_ws, size_t ws_size, hipStream_t stream) {
    static int grid = 0;
    if (grid == 0) {
        if (n_in != 24 || in_sizes[0] != NTOK * DM || out_size != NTOK * DM || ws_size < WS_END) { fprintf(stderr, "kernel_launch: shape/workspace mismatch (n_in %d, ws %zu)\n", n_in, ws_size); grid = -1; return; }
        int dev = 0, cus = 0, per_cu = 0;
        if (hipGetDevice(&dev) != hipSuccess || hipDeviceGetAttribute(&cus, hipDeviceAttributeMultiprocessorCount, dev) != hipSuccess) { grid = -1; return; }
        if (hipFuncSetAttribute((const void*)hymba_fwd, hipFuncAttributeMaxDynamicSharedMemorySize, LDS_BYTES) != hipSuccess) { fprintf(stderr, "kernel_launch: hipFuncSetAttribute failed\n"); grid = -1; return; }
        if (hipOccupancyMaxActiveBlocksPerMultiprocessor(&per_cu, (const void*)hymba_fwd, NWAVES * 64, LDS_BYTES) != hipSuccess || per_cu < 1) fprintf(stderr, "kernel_launch: occupancy query says %d\n", per_cu);
        (void)hipGetLastError();
        grid = cus;
    }
    if (grid < 0) return;
    (void)hipMemsetAsync((char*)d_ws + WS_CTL, 0, CTL_ZERO_BYTES, stream);
    Args a{};
    for (int i = 0; i < 24; ++i) a.in[i] = (const float*)d_in[i];
    a.out = (float*)d_out; a.ws = (unsigned char*)d_ws;
#if MK_SPLIT
    for (int p = 0; p < NPHASE; ++p) { a.ph_lo = p; a.ph_hi = p + 1; hipLaunchKernelGGL(hymba_fwd, dim3(grid), dim3(NWAVES * 64), LDS_BYTES, stream, a); }
#else
    a.ph_lo = 0; a.ph_hi = NPHASE; hipLaunchKernelGGL(hymba_fwd, dim3(grid), dim3(NWAVES * 64), LDS_BYTES, stream, a);
#endif
}
```

```cpp
#include <hip/hip_runtime.h>
#include <cstdio>
#include <cstdint>

#ifndef MK_SPLIT
#define MK_SPLIT 0
#endif

#define LAS __attribute__((address_space(3)))
#define CAS __attribute__((address_space(4)))
typedef unsigned short bf16;
typedef short bf16x8 __attribute__((ext_vector_type(8)));
typedef short s16x4 __attribute__((ext_vector_type(4)));
typedef float f32x2 __attribute__((ext_vector_type(2)));
typedef float f32x4 __attribute__((ext_vector_type(4)));
typedef float f32x16 __attribute__((ext_vector_type(16)));
typedef unsigned u32x2 __attribute__((ext_vector_type(2)));
typedef unsigned u32x4 __attribute__((ext_vector_type(4)));
typedef __bf16 bf16x2_t __attribute__((ext_vector_type(2)));

constexpr int NB = 16, SEQ = 2048, DM = 1024, NMETA = 16;
constexpr int NTOK = NB * SEQ;
constexpr int MROWS = NTOK + NMETA;
constexpr int MPAD = 33024;
constexpr int LKP = 2112;
constexpr int NIN = 1472, ZLD = 1536;
constexpr int NE = 32, NPAIR = NTOK * 4, MOE_TILES_MAX = 544, MOE_ROWS_MAX = MOE_TILES_MAX * 256;
constexpr float ALPHA = 1.189207115002721f;
constexpr float RMS_EPS = 1e-6f, LN_EPS = 1e-5f;

constexpr size_t MiB = 1u << 20;
constexpr size_t WS_CTL = 0, CTL_ZERO_BYTES = 1 * MiB;
constexpr size_t WS_ROPE = 1 * MiB;
constexpr size_t WS_WQB = 2 * MiB;
constexpr size_t WS_WKVB = 2 * MiB + 512 * 1024;
constexpr size_t WS_WR = 3 * MiB;
constexpr size_t WS_LOGITS = 4 * MiB;
constexpr size_t WS_TOPK = 8 * MiB;
constexpr size_t WS_GATE = 8 * MiB + 512 * 1024;
constexpr size_t WS_PAIRPOS = 9 * MiB;
constexpr size_t WS_ROWGATE = 9 * MiB + 512 * 1024;
constexpr size_t WS_HIST = 10 * MiB + 512 * 1024;
constexpr size_t WS_MOETAB = 10 * MiB + 768 * 1024;
constexpr size_t WS_WIN = 12 * MiB;
constexpr size_t WS_WO = 15 * MiB;
constexpr size_t WS_WGU = 32 * MiB;
constexpr size_t WS_WDN = 96 * MiB;
constexpr size_t WS_H1F8 = 128 * MiB;
constexpr size_t WS_H0 = 224 * MiB;
constexpr size_t WS_H1 = 289 * MiB;
constexpr size_t WS_QAN = 353 * MiB;
constexpr size_t WS_KVAN = 370 * MiB;
constexpr size_t WS_Z = 380 * MiB;
constexpr size_t WS_QM = 477 * MiB;
constexpr size_t WS_KM = 525 * MiB;
constexpr size_t WS_VM = 575 * MiB;
constexpr size_t WS_QG = 608 * MiB;
constexpr size_t WS_KG = 640 * MiB;
constexpr size_t WS_VG = 657 * MiB;
constexpr size_t WS_O = 674 * MiB;
constexpr size_t WS_Y1 = 738 * MiB;
constexpr size_t WS_XS = 380 * MiB;
constexpr size_t WS_ACT = 516 * MiB;
constexpr size_t WS_OUT2 = 652 * MiB;
constexpr size_t WS_END = 924 * MiB;
static_assert(WS_Z + (size_t)MPAD * ZLD * 2 <= WS_QM && WS_QM + (size_t)64 * 2048 * 192 * 2 <= WS_KM && WS_KM + (size_t)64 * LKP * 192 * 2 <= WS_VM && WS_VM + (size_t)64 * LKP * 128 * 2 <= WS_QG, "ws map 1");
static_assert(WS_QG + (size_t)64 * 2048 * 128 * 2 <= WS_KG && WS_KG + (size_t)32 * LKP * 128 * 2 <= WS_VG && WS_VG + (size_t)32 * LKP * 128 * 2 <= WS_O && WS_O + (size_t)NTOK * DM * 2 <= WS_Y1 && WS_Y1 + (size_t)NTOK * DM * 4 <= WS_END, "ws map 2");
static_assert(WS_XS + (size_t)MOE_ROWS_MAX * DM <= WS_ACT && WS_ACT + (size_t)MOE_ROWS_MAX * DM <= WS_OUT2 && WS_OUT2 + (size_t)MOE_ROWS_MAX * DM * 2 <= WS_END && WS_WGU + (size_t)NE * 2048 * 1024 <= WS_WDN && WS_WDN + (size_t)NE * 1024 * 1024 <= WS_H1F8 && WS_H1F8 + (size_t)NTOK * DM <= WS_H0, "ws map 3");
static_assert(WS_H0 + (size_t)MPAD * DM * 2 <= WS_H1 && WS_H1 + (size_t)NTOK * DM * 2 <= WS_QAN && WS_QAN + (size_t)MPAD * 256 * 2 <= WS_KVAN && WS_KVAN + (size_t)MPAD * 128 * 2 <= WS_Z, "ws map 4");
constexpr int CW_BAR = 4096;

constexpr int RING_BYTES = 131072;
constexpr int LDSCTL_OFF = RING_BYTES;
constexpr int LDS_BYTES = 147456;
constexpr int NWAVES = 8;

#define LDS_WAIT() asm volatile("s_waitcnt lgkmcnt(0)" ::: "memory")
#define SBAR() __builtin_amdgcn_sched_barrier(0)
__device__ __forceinline__ unsigned cvtpk(float lo, float hi) { f32x2 v = {lo, hi}; bf16x2_t b = __builtin_convertvector(v, bf16x2_t); return __builtin_bit_cast(unsigned, b); }
__device__ __forceinline__ u32x4 pack8(const float (&v)[8]) { u32x4 r = {cvtpk(v[0], v[1]), cvtpk(v[2], v[3]), cvtpk(v[4], v[5]), cvtpk(v[6], v[7])}; return r; }
__device__ __forceinline__ void unpack8(u32x4 w, float (&v)[8]) {
    v[0] = __uint_as_float(w.x << 16); v[1] = __uint_as_float(w.x & 0xffff0000u); v[2] = __uint_as_float(w.y << 16); v[3] = __uint_as_float(w.y & 0xffff0000u);
    v[4] = __uint_as_float(w.z << 16); v[5] = __uint_as_float(w.z & 0xffff0000u); v[6] = __uint_as_float(w.w << 16); v[7] = __uint_as_float(w.w & 0xffff0000u);
}
__device__ __forceinline__ float wave_sum(float v) {
#pragma unroll
    for (int o = 1; o < 64; o <<= 1) v += __shfl_xor(v, o);
    return v;
}
__device__ __forceinline__ float rsq(float x) { return __builtin_amdgcn_rsqf(x); }
typedef int v8i __attribute__((ext_vector_type(8)));
__device__ __forceinline__ unsigned pack4_f8(float a, float b, float c, float d) { int w = 0; w = __builtin_amdgcn_cvt_pk_fp8_f32(a, b, w, false); w = __builtin_amdgcn_cvt_pk_fp8_f32(c, d, w, true); return (unsigned)w; }
constexpr float W8_SCALE = 32.f, W8_INV = 1.f / 32.f;

#define XB_TMO      128
#define XB_XCNT(j)  (256  + 64 * (j))
#define XB_XSUB(j)  (1280 + 64 * (j))
#define XB_XGEN(j)  (2304 + 64 * (j))
#define XB_TOP      3328
#define XB_TOPGEN   3392
#define XCD_BAR_WORDS 3456
#define XB_SPIN_CAP (1u << 18)
__device__ __forceinline__ unsigned xb_ld(unsigned* p)              { return __hip_atomic_load(p, __ATOMIC_RELAXED, __HIP_MEMORY_SCOPE_AGENT); }
__device__ __forceinline__ unsigned xb_add(unsigned* p, unsigned v) { return __hip_atomic_fetch_add(p, v, __ATOMIC_RELAXED, __HIP_MEMORY_SCOPE_AGENT); }
__device__ __forceinline__ unsigned xb_xcc_id() { return (unsigned)__builtin_amdgcn_s_getreg((3 << 11) | 20) & 0xFu; }
#define XB_SPIN(cond, bar) do { unsigned _sp = 0; while (cond) { __builtin_amdgcn_s_sleep(1); \
    if ((++_sp & 255u) == 0u) { if (xb_ld(&(bar)[XB_TMO])) break; if (_sp > XB_SPIN_CAP) { atomicAdd(&(bar)[XB_TMO], 1u); break; } } } } while (0)
struct XcdBarrier { unsigned* bar; unsigned x; volatile LAS unsigned* st; };
__device__ __forceinline__ XcdBarrier xcd_barrier_post(unsigned* bar, volatile LAS unsigned* st) {
    XcdBarrier b; b.bar = bar; b.x = xb_xcc_id(); b.st = st;
    if (threadIdx.x == 0) (void)xb_add(&bar[XB_XCNT(b.x)], 1u);
    return b;
}
__device__ __forceinline__ void xcd_barrier_complete(unsigned* bar, unsigned x, unsigned& nloc, unsigned& nx) {
    const unsigned G = gridDim.x * gridDim.y * gridDim.z;
    unsigned sum, cnt, mine, sp = 0u;
    for (;;) {
        sum = 0u; cnt = 0u; mine = 0u;
#pragma unroll
        for (unsigned j = 0; j < 16; ++j) { const unsigned c = xb_ld(&bar[XB_XCNT(j)]); sum += c; cnt += (c > 0u) ? 1u : 0u; mine = (j == x) ? c : mine; }
        if (sum == G) break;
        __builtin_amdgcn_s_sleep(1);
        if ((++sp & 255u) == 0u) { if (xb_ld(&bar[XB_TMO])) break; if (sp > XB_SPIN_CAP) { atomicAdd(&bar[XB_TMO], 1u); break; } }
    }
    nloc = mine > 0u ? mine : 1u; nx = cnt > 0u ? cnt : 1u;
}
__device__ __forceinline__ void xcd_barrier(const XcdBarrier& b) {
    asm volatile("s_waitcnt vmcnt(0)" ::: "memory");
    __syncthreads();
    if (threadIdx.x == 0) {
        unsigned* bar = b.bar;
        __builtin_amdgcn_s_waitcnt(0);
        unsigned nloc = b.st[0], nx = b.st[1];
        if (nloc == 0u) { xcd_barrier_complete(bar, b.x, nloc, nx); b.st[0] = nloc; b.st[1] = nx; }
        const unsigned old = xb_add(&bar[XB_XSUB(b.x)], 1u);
        const unsigned gen = old / nloc;
        if (old + 1u == (gen + 1u) * nloc) {
            __builtin_amdgcn_fence(__ATOMIC_RELEASE, "agent");
            asm volatile("s_waitcnt vmcnt(0)" ::: "memory");
            const unsigned og = xb_add(&bar[XB_TOP], 1u);
            const unsigned tg = og / nx;
            if (og + 1u == (tg + 1u) * nx) xb_add(&bar[XB_TOPGEN], 1u);
            else XB_SPIN(xb_ld(&bar[XB_TOPGEN]) == tg, bar);
            __builtin_amdgcn_fence(__ATOMIC_ACQUIRE, "agent");
            xb_add(&bar[XB_XGEN(b.x)], 1u);
            asm volatile("s_waitcnt vmcnt(0)" ::: "memory");
        } else {
            XB_SPIN(xb_ld(&bar[XB_XGEN(b.x)]) == gen, bar);
            __builtin_amdgcn_fence(__ATOMIC_ACQUIRE, "agent");
            asm volatile("s_waitcnt vmcnt(0)" ::: "memory");
        }
    }
    __syncthreads();
}

struct BSelNone { __device__ __forceinline__ size_t operator()(int) const { return 0; } };
struct BSelExpert { const int* tile_expert; size_t per; __device__ __forceinline__ size_t operator()(int m0) const { return (size_t)tile_expert[m0 >> 8] * per; } };
template <class Epi, class BSel>
__device__ __forceinline__ void simple_gemm(const bf16* __restrict__ A, const bf16* __restrict__ Bt, int K, int m_lo, int m_hi, int N, const Epi& E, const BSel& bsel, int gw, int ngw, int lane, int lda = 0) {
    if (lda == 0) lda = K;
    const int fr = lane & 15, fq = lane >> 4;
    const int mt = (m_hi - m_lo) / 64, nt = N / 32;
    for (int u = gw; u < mt * nt; u += ngw) {
        const int m0 = m_lo + (u / nt) * 64, n0 = (u % nt) * 32;
        const bf16* ap = A + (size_t)(m0 + fr) * lda + fq * 8;
        const bf16* bp = Bt + bsel(m0) + (size_t)(n0 + 8 * (fr >> 2) + (fr & 3)) * K + fq * 8;
        f32x4 acc[4][2];
#pragma unroll
        for (int i = 0; i < 4; ++i) { acc[i][0] = (f32x4){0.f, 0.f, 0.f, 0.f}; acc[i][1] = (f32x4){0.f, 0.f, 0.f, 0.f}; }
#pragma unroll 2
        for (int k = 0; k < K; k += 32) {
            bf16x8 a[4], b[2];
#pragma unroll
            for (int i = 0; i < 4; ++i) a[i] = *(const bf16x8*)(ap + (size_t)i * 16 * lda + k);
#pragma unroll
            for (int j = 0; j < 2; ++j) b[j] = *(const bf16x8*)(bp + (size_t)j * 4 * K + k);
#pragma unroll
            for (int i = 0; i < 4; ++i)
#pragma unroll
                for (int j = 0; j < 2; ++j) acc[i][j] = __builtin_amdgcn_mfma_f32_16x16x32_bf16(b[j], a[i], acc[i][j], 0, 0, 0);
        }
#pragma unroll
        for (int i = 0; i < 4; ++i) {
            const float v[8] = {acc[i][0][0], acc[i][0][1], acc[i][0][2], acc[i][0][3], acc[i][1][0], acc[i][1][1], acc[i][1][2], acc[i][1][3]};
            E.store8(m0 + 16 * i + fr, n0 + 8 * fq, v);
        }
    }
}


template <int K, class Epi>
__device__ __forceinline__ void smallk_task(const bf16* __restrict__ A, const bf16* __restrict__ Bt, int m0, int ng_lo, int ng_hi, const Epi& E, int lane) {
    constexpr int KS = K / 32;
    const int fr = lane & 15, fq = lane >> 4;
    bf16x8 a[4][KS];
#pragma unroll
    for (int i = 0; i < 4; ++i)
#pragma unroll
        for (int ks = 0; ks < KS; ++ks) a[i][ks] = *(const bf16x8*)(A + (size_t)(m0 + 16 * i + fr) * K + ks * 32 + fq * 8);
#pragma unroll 1
    for (int ng = ng_lo; ng < ng_hi; ++ng) {
        const int n0 = ng * 32;
        const bf16* bp = Bt + (size_t)(n0 + 8 * (fr >> 2) + (fr & 3)) * K + fq * 8;
        bf16x8 b[2][KS];
#pragma unroll
        for (int ks = 0; ks < KS; ++ks) { b[0][ks] = *(const bf16x8*)(bp + ks * 32); b[1][ks] = *(const bf16x8*)(bp + 4 * K + ks * 32); }
        f32x4 acc[4][2];
#pragma unroll
        for (int i = 0; i < 4; ++i) { acc[i][0] = (f32x4){0.f, 0.f, 0.f, 0.f}; acc[i][1] = (f32x4){0.f, 0.f, 0.f, 0.f}; }
#pragma unroll
        for (int ks = 0; ks < KS; ++ks)
#pragma unroll
            for (int i = 0; i < 4; ++i) { acc[i][0] = __builtin_amdgcn_mfma_f32_16x16x32_bf16(b[0][ks], a[i][ks], acc[i][0], 0, 0, 0); acc[i][1] = __builtin_amdgcn_mfma_f32_16x16x32_bf16(b[1][ks], a[i][ks], acc[i][1], 0, 0, 0); }
#pragma unroll
        for (int i = 0; i < 4; ++i) {
            const float v[8] = {acc[i][0][0], acc[i][0][1], acc[i][0][2], acc[i][0][3], acc[i][1][0], acc[i][1][1], acc[i][1][2], acc[i][1][3]};
            E.store8(m0 + 16 * i + fr, n0 + 8 * fq, v);
        }
    }
}

struct EpiZ { bf16* z;
    __device__ __forceinline__ void store8(int row, int col, const float (&v)[8]) const { if (col < NIN) *(u32x4*)(z + (size_t)row * ZLD + col) = pack8(v); } };
struct EpiQ { bf16* qm; const float* rs;
    __device__ __forceinline__ void store8(int row, int col, const float (&v_)[8]) const {
        const int h = col / 192, w = col - h * 192, b = row >> 11, s = row & 2047; const float r_ = rs[row];
        const float o[8] = {v_[0] * r_, v_[1] * r_, v_[2] * r_, v_[3] * r_, v_[4] * r_, v_[5] * r_, v_[6] * r_, v_[7] * r_};
        *(u32x4*)(qm + ((size_t)(b * 4 + h) * 2048 + s) * 192 + w) = pack8(o);
    } };
template <bool META> struct EpiKV { bf16* km; bf16* vm; const float* rs;
    __device__ __forceinline__ void store8(int row, int col, const float (&v_)[8]) const {
        if (META && row >= MROWS) return;
        const float r_ = rs[row]; const float v[8] = {v_[0] * r_, v_[1] * r_, v_[2] * r_, v_[3] * r_, v_[4] * r_, v_[5] * r_, v_[6] * r_, v_[7] * r_};
        const int h = col >> 8, w = col & 255; const u32x4 pk = pack8(v);
        if (!META) { const int b = row >> 11, key = row & 2047; const size_t r = (size_t)(b * 4 + h) * LKP + key;
            if (w < 128) *(u32x4*)(km + r * 192 + w) = pk; else *(u32x4*)(vm + r * 128 + (w - 128)) = pk;
        } else { const int key = 2048 + (row - NTOK);
            for (int b = 0; b < NB; ++b) { const size_t r = (size_t)(b * 4 + h) * LKP + key;
                if (w < 128) *(u32x4*)(km + r * 192 + w) = pk; else *(u32x4*)(vm + r * 128 + (w - 128)) = pk; } }
    } };
struct EpiO { float* y1; const bf16* h0;
    __device__ __forceinline__ void store8(int row, int col, const float (&v)[8]) const {
        float h[8]; unpack8(*(const u32x4*)(h0 + (size_t)row * DM + col), h);
        float* y = y1 + (size_t)row * DM + col;
        *(f32x4*)y = (f32x4){ALPHA * h[0] + v[0], ALPHA * h[1] + v[1], ALPHA * h[2] + v[2], ALPHA * h[3] + v[3]};
        *(f32x4*)(y + 4) = (f32x4){ALPHA * h[4] + v[4], ALPHA * h[5] + v[5], ALPHA * h[6] + v[6], ALPHA * h[7] + v[7]};
    } };
struct EpiLogit { float* logits; const float* bias;
    __device__ __forceinline__ void store8(int row, int col, const float (&v)[8]) const {
        float* y = logits + (size_t)row * NE + col;
        *(f32x4*)y = (f32x4){v[0] + bias[col], v[1] + bias[col + 1], v[2] + bias[col + 2], v[3] + bias[col + 3]};
        *(f32x4*)(y + 4) = (f32x4){v[4] + bias[col + 4], v[5] + bias[col + 5], v[6] + bias[col + 6], v[7] + bias[col + 7]};
    } };
namespace pg8 {
#define PG8_LAS __attribute__((address_space(3)))
typedef unsigned short bf16_t;
constexpr int BM = 256, BK = 64, HALF = 128, HTB = HALF * BK * 2, STAGE_BYTES = 8 * HTB, NXCD = 8, WGM = 8;
__host__ __device__ __forceinline__ int lds_byte(int r, int c) { const int st = (r >> 4) * 2 + (c >> 5), rr = r & 15, cc = c & 31, ob = rr * 64 + cc * 2; return st * 1024 + (ob ^ (((ob >> 9) & 1) << 5)); }
__host__ __device__ __forceinline__ void stage_rc(int b, int& R, int& C) { const int st = b / 1024, sb = b % 1024, swz = sb ^ (((sb >> 9) & 1) << 5); R = (st >> 1) * 16 + swz / 64; C = (st & 1) * 32 + (swz % 64) / 2; }
__host__ __device__ __forceinline__ int perm32(int rho) { const int n = rho >> 4, i = rho & 15; return 8 * (i >> 2) + 4 * n + (i & 3); }
struct Unit { int pm, pn; };
struct Gemm { const bf16_t* A; const bf16_t* Bt; int M, N, K, lda; };
struct StaticOrder {
    int nM, nN, nwg, G, c;
    __host__ __device__ void init(int M, int N, int G_, int c_) { nM = M / BM; nN = N / BM; nwg = nM * nN; G = G_; c = c_; }
    __host__ __device__ bool next(int i, Unit& u) const {
        const long L = (long)i * G + c; if (L >= nwg) return false;
        int wgid = (int)L; { const int q = nwg / NXCD, r = nwg % NXCD, xcd = wgid % NXCD, off = wgid / NXCD; wgid = (xcd < r ? xcd * (q + 1) : r * (q + 1) + (xcd - r) * q) + off; }
        const int nig = WGM * nN, gid = wgid / nig, fm = gid * WGM, gsz = (nM - fm) < WGM ? (nM - fm) : WGM;
        u.pm = fm + ((wgid % nig) % gsz); u.pn = (wgid % nig) / gsz; return true;
    }
    __device__ __forceinline__ void a_ready(const Unit&) const {}
    __device__ __forceinline__ void done(const Unit&) const {}
};
struct MoeOrder {
    StaticOrder so; const int* tile_expert;
    __device__ void init(int tiles, int nN, int G_, int c_, const int* te) { so.nM = tiles; so.nN = nN; so.nwg = tiles * nN; so.G = G_; so.c = c_; tile_expert = te; }
    __device__ bool next(int i, Unit& u) const { if (!so.next(i, u)) return false; u.pn += tile_expert[u.pm] * so.nN; return true; }
    __device__ __forceinline__ void a_ready(const Unit&) const {}
    __device__ __forceinline__ void done(const Unit&) const {}
};
template <class E8> struct EpiAdapt {
    static constexpr bool PERM = true, AFTER_DRAIN = false;
    E8 e; int ncols_mod;
    __device__ __forceinline__ void operator()(const f32x4 (&acc)[2][2][4][2], const Unit& u, int wr, int wc, int fr, int fq) const {
        const int row0 = u.pm * BM + wr * 64 + fr; int colt = u.pn * BM; if (ncols_mod) colt %= ncols_mod;
        const int col0 = colt + wc * 32 + 8 * fq;
#pragma unroll
        for (int ai = 0; ai < 2; ++ai)
#pragma unroll
            for (int m = 0; m < 4; ++m)
#pragma unroll
                for (int bj = 0; bj < 2; ++bj) {
                    const float v[8] = {acc[ai][bj][m][0][0], acc[ai][bj][m][0][1], acc[ai][bj][m][0][2], acc[ai][bj][m][0][3], acc[ai][bj][m][1][0], acc[ai][bj][m][1][1], acc[ai][bj][m][1][2], acc[ai][bj][m][1][3]};
                    e.store8(row0 + ai * HALF + m * 16, col0 + bj * HALF, v); }
    }
};
template <class Epi, class Sched, bool ALIGN_EPI = false, bool SP2 = false, bool F8 = false>
__device__ __forceinline__ void gemm_phase(PG8_LAS unsigned char* lds, const Gemm g, const Sched& S, const Epi& E) {
    const int tid = threadIdx.x, wid = __builtin_amdgcn_readfirstlane(tid >> 6), lane = tid & 63, wr = wid >> 2, wc = wid & 3, fr = lane & 15, fq = lane >> 4;
    const int K = g.K, nt = K / BK;
    unsigned voffA[2], voffB[2];
#pragma unroll
    for (int i = 0; i < 2; ++i) { int R, C; stage_rc(tid * 16 + i * 8192, R, C); const int Rb = Epi::PERM ? ((R & ~31) + perm32(R & 31)) : R;
        voffA[i] = (unsigned)(R * g.lda + C) * 2u; voffB[i] = (unsigned)(Rb * K + C) * 2u; }
    const size_t kstep = (size_t)(BK * 2);
    const size_t hstep = (size_t)HALF * K * 2, hstepA = (size_t)HALF * g.lda * 2;
    const size_t tstep = 2 * hstep, tstepA = 2 * hstepA;
    const unsigned ldsw = (unsigned)wid * 1024u;
    const int aoff = lds_byte(wr * 64 + fr, fq * 8), boff = lds_byte(wc * 32 + fr, fq * 8);
#define PG8_SA(b, h) (((b) * 2 + (h)) * HTB)
#define PG8_SB(b, h) ((4 + (b) * 2 + (h)) * HTB)
#define PG8_STAGE(bufoff, gbase, voff) do { _Pragma("unroll") for (int _i = 0; _i < 2; ++_i) \
        __builtin_amdgcn_global_load_lds((const unsigned*)((const char*)(gbase) + (voff)[_i]), (PG8_LAS unsigned*)(lds + (bufoff) + ldsw + _i * 8192), 16, 0, 0); } while (0)
#define PG8_LDA(dst, b, h) do { _Pragma("unroll") for (int m = 0; m < 4; ++m) _Pragma("unroll") for (int k = 0; k < 2; ++k) dst[m][k] = *(const PG8_LAS bf16x8*)(lds + PG8_SA(b, h) + aoff + m * 2048 + k * 1024); } while (0)
#define PG8_LDB(dst, b, h) do { _Pragma("unroll") for (int n = 0; n < 2; ++n) _Pragma("unroll") for (int k = 0; k < 2; ++k) dst[n][k] = *(const PG8_LAS bf16x8*)(lds + PG8_SB(b, h) + boff + n * 2048 + k * 1024); } while (0)
#define PG8_F8CAT(x) __builtin_shufflevector(__builtin_bit_cast(u32x4, (x)[0]), __builtin_bit_cast(u32x4, (x)[1]), 0, 1, 2, 3, 4, 5, 6, 7)
#define PG8_MMA(ai, bj, At, Bt) do { __builtin_amdgcn_s_setprio(1); if constexpr (F8) { _Pragma("unroll") for (int m = 0; m < 4; ++m) _Pragma("unroll") for (int n = 0; n < 2; ++n) \
        acc[ai][bj][m][n] = __builtin_amdgcn_mfma_scale_f32_16x16x128_f8f6f4(__builtin_bit_cast(v8i, PG8_F8CAT(Bt[n])), __builtin_bit_cast(v8i, PG8_F8CAT(At[m])), acc[ai][bj][m][n], 0, 0, 0, 0x7f7f7f7f, 0, 0x7f7f7f7f); \
        _Pragma("unroll") for (int m = 0; m < 4; ++m) _Pragma("unroll") for (int n = 0; n < 2; ++n) asm volatile("" : "+v"(acc[ai][bj][m][n])); } \
    else { _Pragma("unroll") for (int m = 0; m < 4; ++m) _Pragma("unroll") for (int n = 0; n < 2; ++n) _Pragma("unroll") for (int k = 0; k < 2; ++k) \
        acc[ai][bj][m][n] = __builtin_amdgcn_mfma_f32_16x16x32_bf16(Bt[n][k], At[m][k], acc[ai][bj][m][n], 0, 0, 0); } __builtin_amdgcn_s_setprio(0); } while (0)
#define PG8_WAIT_V(n) asm volatile("s_waitcnt vmcnt(" #n ")" ::: "memory")
#define PG8_WAIT_L(n) asm volatile("s_waitcnt lgkmcnt(" #n ")" ::: "memory")
#define PG8_BAR __builtin_amdgcn_s_barrier()
#define PG8_SCHED __builtin_amdgcn_sched_barrier(0)
    Unit cur, nxt; int ui = 0;
    if (!S.next(0, cur)) return;
    f32x4 acc[2][2][4][2];
#pragma unroll
    for (int a = 0; a < 2; ++a)
#pragma unroll
        for (int b = 0; b < 2; ++b)
#pragma unroll
            for (int m = 0; m < 4; ++m)
#pragma unroll
                for (int n = 0; n < 2; ++n) acc[a][b][m][n] = (f32x4){0.f, 0.f, 0.f, 0.f};
    bf16x8 At[4][2], B0[2][2], B1[2][2];
    const char* cA = (const char*)g.A + (size_t)cur.pm * tstepA; const char* cB = (const char*)g.Bt + (size_t)cur.pn * tstep;
    S.a_ready(cur);
    if constexpr (SP2) {
        PG8_STAGE(PG8_SB(0, 0), cB, voffB); PG8_STAGE(PG8_SB(0, 1), cB + hstep, voffB); PG8_STAGE(PG8_SA(0, 0), cA, voffA); PG8_STAGE(PG8_SA(0, 1), cA + hstepA, voffA);
        if (wr == 1) PG8_BAR;
        PG8_WAIT_V(2); PG8_BAR;
        PG8_STAGE(PG8_SB(1, 0), cB + kstep, voffB); PG8_STAGE(PG8_SA(1, 0), cA + kstep, voffA); PG8_STAGE(PG8_SB(1, 1), cB + hstep + kstep, voffB);
        PG8_WAIT_V(6); PG8_BAR;
    } else {
        PG8_STAGE(PG8_SB(0, 0), cB, voffB); PG8_STAGE(PG8_SA(0, 0), cA, voffA); PG8_STAGE(PG8_SB(0, 1), cB + hstep, voffB); PG8_STAGE(PG8_SA(0, 1), cA + hstepA, voffA);
        if (wr == 1) PG8_BAR;
        PG8_WAIT_V(4); PG8_BAR;
        PG8_STAGE(PG8_SB(1, 0), cB + kstep, voffB); PG8_STAGE(PG8_SA(1, 0), cA + kstep, voffA); PG8_STAGE(PG8_SB(1, 1), cB + hstep + kstep, voffB);
        PG8_WAIT_V(6); PG8_BAR;
    }
    for (;;) {
        const bool has_next = S.next(ui + 1, nxt);
        const char* nA = has_next ? (const char*)g.A + (size_t)nxt.pm * tstepA : cA; const char* nB = has_next ? (const char*)g.Bt + (size_t)nxt.pn * tstep : cB;
        for (int t = 0; t < nt; t += 2) {
            const bool last = (t == nt - 2);
            const char* a1 = cA + (size_t)(t + 1) * kstep;
            const char* a2 = last ? nA : cA + (size_t)(t + 2) * kstep; const char* b2 = last ? nB : cB + (size_t)(t + 2) * kstep;
            const char* a3 = a2 + kstep; const char* b3 = b2 + kstep;
            if (last && has_next) S.a_ready(nxt);
            if constexpr (SP2) {
            PG8_LDB(B0, 0, 0); PG8_LDB(B1, 0, 1); PG8_SCHED; PG8_LDA(At, 0, 0); PG8_STAGE(PG8_SA(1, 1), a1 + hstepA, voffA);
            PG8_WAIT_V(8); PG8_WAIT_L(0); PG8_BAR; PG8_MMA(0, 0, At, B0); PG8_MMA(0, 1, At, B1); PG8_BAR; PG8_SCHED;
            PG8_LDA(At, 0, 1); PG8_STAGE(PG8_SB(0, 0), b2, voffB); PG8_STAGE(PG8_SB(0, 1), b2 + hstep, voffB); PG8_STAGE(PG8_SA(0, 0), a2, voffA);
            PG8_WAIT_V(8); PG8_WAIT_L(0); PG8_BAR; PG8_MMA(1, 0, At, B0); PG8_MMA(1, 1, At, B1); PG8_BAR; PG8_SCHED;
            PG8_LDB(B0, 1, 0); PG8_LDB(B1, 1, 1); PG8_SCHED; PG8_LDA(At, 1, 0); PG8_STAGE(PG8_SA(0, 1), a2 + hstepA, voffA);
            PG8_WAIT_V(8); PG8_WAIT_L(0); PG8_BAR; PG8_MMA(0, 0, At, B0); PG8_MMA(0, 1, At, B1); PG8_BAR; PG8_SCHED;
            PG8_LDA(At, 1, 1); PG8_STAGE(PG8_SB(1, 0), b3, voffB); PG8_STAGE(PG8_SB(1, 1), b3 + hstep, voffB); PG8_STAGE(PG8_SA(1, 0), a3, voffA);
            PG8_WAIT_V(8); PG8_WAIT_L(0); PG8_BAR; PG8_MMA(1, 0, At, B0); PG8_MMA(1, 1, At, B1); PG8_BAR; PG8_SCHED;
            } else {
            PG8_LDB(B0, 0, 0); PG8_SCHED; PG8_LDA(At, 0, 0); PG8_STAGE(PG8_SA(1, 1), a1 + hstepA, voffA);
            PG8_WAIT_L(8); PG8_BAR; PG8_WAIT_L(0); PG8_MMA(0, 0, At, B0); PG8_BAR; PG8_SCHED;
            PG8_LDB(B1, 0, 1); PG8_STAGE(PG8_SB(0, 0), b2, voffB);
            PG8_BAR; PG8_WAIT_L(0); PG8_MMA(0, 1, At, B1); PG8_BAR;
            PG8_LDA(At, 0, 1); PG8_STAGE(PG8_SA(0, 0), a2, voffA);
            PG8_BAR; PG8_WAIT_L(0); PG8_MMA(1, 0, At, B0); PG8_BAR; PG8_SCHED;
            PG8_STAGE(PG8_SB(0, 1), b2 + hstep, voffB);
            PG8_WAIT_V(6); PG8_BAR; PG8_MMA(1, 1, At, B1); PG8_BAR;
            PG8_LDB(B0, 1, 0); PG8_SCHED; PG8_LDA(At, 1, 0); PG8_STAGE(PG8_SA(0, 1), a2 + hstepA, voffA);
            PG8_WAIT_L(8); PG8_BAR; PG8_WAIT_L(0); PG8_MMA(0, 0, At, B0); PG8_BAR; PG8_SCHED;
            PG8_LDB(B1, 1, 1); PG8_STAGE(PG8_SB(1, 0), b3, voffB);
            PG8_BAR; PG8_WAIT_L(0); PG8_MMA(0, 1, At, B1); PG8_BAR;
            PG8_LDA(At, 1, 1); PG8_STAGE(PG8_SA(1, 0), a3, voffA);
            PG8_BAR; PG8_WAIT_L(0); PG8_MMA(1, 0, At, B0); PG8_BAR; PG8_SCHED;
            PG8_STAGE(PG8_SB(1, 1), b3 + hstep, voffB);
            PG8_WAIT_V(6); PG8_BAR; PG8_MMA(1, 1, At, B1); PG8_BAR;
            }
        }
        if constexpr (ALIGN_EPI) { if (wr == 0) PG8_BAR; }
        if constexpr (!Epi::AFTER_DRAIN) { E(acc, cur, wr, wc, fr, fq); S.done(cur); }
        if (!has_next) break;
#pragma unroll
        for (int a = 0; a < 2; ++a)
#pragma unroll
            for (int b = 0; b < 2; ++b)
#pragma unroll
                for (int m = 0; m < 4; ++m)
#pragma unroll
                    for (int n = 0; n < 2; ++n) acc[a][b][m][n] = (f32x4){0.f, 0.f, 0.f, 0.f};
        cur = nxt; cA = nA; cB = nB; ++ui;
        if constexpr (ALIGN_EPI) { if (wr == 1) PG8_BAR; }
    }
    PG8_WAIT_V(0);
    if constexpr (!ALIGN_EPI) { if (wr == 0) PG8_BAR; }
    PG8_BAR;
#undef PG8_SA
#undef PG8_SB
#undef PG8_STAGE
#undef PG8_LDA
#undef PG8_LDB
#undef PG8_MMA
#undef PG8_F8CAT
#undef PG8_WAIT_V
#undef PG8_WAIT_L
#undef PG8_BAR
#undef PG8_SCHED
}
}

struct EpiGU8 { static constexpr bool PERM = true, AFTER_DRAIN = false;
    unsigned char* act8; const float* bgu;
    __device__ __forceinline__ void operator()(const f32x4 (&acc)[2][2][4][2], const pg8::Unit& u, int wr, int wc, int fr, int fq) const {
        const int e = u.pn >> 3, ac0 = 128 * (u.pn & 7) + wc * 32 + 8 * fq;
        const float* bb = bgu + (size_t)e * 2048 + 2 * ac0;
        const f32x4 q0 = *(const f32x4*)bb, q1 = *(const f32x4*)(bb + 4), q2 = *(const f32x4*)(bb + 8), q3 = *(const f32x4*)(bb + 12);
        const float bg[8] = {q0[0], q0[2], q1[0], q1[2], q2[0], q2[2], q3[0], q3[2]}, bl[8] = {q0[1], q0[3], q1[1], q1[3], q2[1], q2[3], q3[1], q3[3]};
#pragma unroll
        for (int ai = 0; ai < 2; ++ai)
#pragma unroll
            for (int m = 0; m < 4; ++m) { const int row = u.pm * 256 + ai * 128 + wr * 64 + m * 16 + fr; float o[8];
#pragma unroll
                for (int t = 0; t < 8; ++t) {
                    const float xg = fminf(acc[ai][0][m][t >> 2][t & 3] * W8_INV + bg[t], 7.f), xl = fminf(fmaxf(acc[ai][1][m][t >> 2][t & 3] * W8_INV + bl[t], -7.f), 7.f);
                    const float sg = __builtin_amdgcn_rcpf(1.f + __builtin_amdgcn_exp2f(-1.702f * 1.4426950408889634f * xg));
                    o[t] = xg * sg * (xl + 1.f); }
                *(u32x2*)(act8 + (size_t)row * DM + ac0) = (u32x2){pack4_f8(o[0], o[1], o[2], o[3]), pack4_f8(o[4], o[5], o[6], o[7])}; }
    } };
struct EpiDN8 { static constexpr bool PERM = true, AFTER_DRAIN = false;
    bf16* out2; const float* bdn; const float* row_gate;
    __device__ __forceinline__ void operator()(const f32x4 (&acc)[2][2][4][2], const pg8::Unit& u, int wr, int wc, int fr, int fq) const {
        const int e = u.pn >> 2, c0 = 256 * (u.pn & 3) + wc * 32 + 8 * fq;
        f32x4 bv[2][2];
#pragma unroll
        for (int bj = 0; bj < 2; ++bj) { bv[bj][0] = *(const f32x4*)(bdn + (size_t)e * DM + c0 + bj * 128); bv[bj][1] = *(const f32x4*)(bdn + (size_t)e * DM + c0 + bj * 128 + 4); }
#pragma unroll
        for (int ai = 0; ai < 2; ++ai)
#pragma unroll
            for (int m = 0; m < 4; ++m) { const int row = u.pm * 256 + ai * 128 + wr * 64 + m * 16 + fr; const float g = row_gate[row];
#pragma unroll
                for (int bj = 0; bj < 2; ++bj) { const f32x4 v0 = (acc[ai][bj][m][0] * W8_INV + bv[bj][0]) * g, v1 = (acc[ai][bj][m][1] * W8_INV + bv[bj][1]) * g;
                    *(u32x4*)(out2 + (size_t)row * DM + c0 + bj * 128) = (u32x4){cvtpk(v0[0], v0[1]), cvtpk(v0[2], v0[3]), cvtpk(v1[0], v1[1]), cvtpk(v1[2], v1[3])}; } }
    } };
#ifndef FAST_Z
#define FAST_Z 1
#endif
#ifndef FAST_O
#define FAST_O 1
#endif

struct MapId { __device__ __forceinline__ int operator()(int n) const { return n; } };
struct MapIn { __device__ __forceinline__ int operator()(int n) const {
    if (n >= 384 && n < 448) { const int l = n - 384; return 384 + 2 * (l & 31) + (l >> 5); }
    if (n >= 448 && n < 1216) { const int l = n - 448, hd = l >> 7, d = l & 127; return 448 + hd * 128 + (d >> 6) * 64 + 2 * (d & 31) + ((d >> 5) & 1); }
    return n; } };
struct MapQ { __device__ __forceinline__ int operator()(int n) const { const int h = n / 192, w = n - h * 192; if (w < 128) return n; const int l = w - 128; return h * 192 + 128 + 2 * (l & 31) + (l >> 5); } };
struct MapGU { __device__ __forceinline__ int operator()(int n) const { const int a = n >> 1; return 256 * (a >> 7) + 128 * (n & 1) + (a & 127); } };
template <class Map>
__device__ __forceinline__ void transpose_item(const float* __restrict__ W, int K, int N, bf16* __restrict__ WT, LAS float* scr, int item, int lane, const Map& map, const float* __restrict__ kscale = nullptr, int ldo = 0) {
    if (ldo == 0) ldo = K;
    const int nblk = N / 32, kb = item / nblk, nb = item - kb * nblk, k0 = 64 * kb, n0 = 32 * nb;
#pragma unroll 8
    for (int i = 0; i < 32; ++i) { const int kk = 2 * i + (lane >> 5); scr[kk * 33 + (lane & 31)] = (k0 < K) ? W[(size_t)(k0 + kk) * N + n0 + (lane & 31)] * (kscale ? kscale[k0 + kk] : 1.f) : 0.f; }
    LDS_WAIT(); asm volatile("" ::: "memory");
    const int c = lane & 7;
#pragma unroll
    for (int j = 0; j < 4; ++j) { const int n = (lane >> 3) + 8 * j; const LAS float* s = scr + (8 * c) * 33 + n;
        u32x4 o; o.x = cvtpk(s[0 * 33], s[1 * 33]); o.y = cvtpk(s[2 * 33], s[3 * 33]); o.z = cvtpk(s[4 * 33], s[5 * 33]); o.w = cvtpk(s[6 * 33], s[7 * 33]);
        *(u32x4*)(WT + (size_t)map(n0 + n) * ldo + k0 + 8 * c) = o; }
    LDS_WAIT(); asm volatile("" ::: "memory");
}

template <class Map>
__device__ __forceinline__ void transpose_item_f8(const float* __restrict__ W, int K, int N, unsigned char* __restrict__ WT, LAS float* scr, int item, int lane, const Map& map, float scale) {
    const int nblk = N / 32, kb = item / nblk, nb = item - kb * nblk, k0 = 64 * kb, n0 = 32 * nb;
#pragma unroll 8
    for (int i = 0; i < 32; ++i) { const int kk = 2 * i + (lane >> 5); scr[kk * 33 + (lane & 31)] = W[(size_t)(k0 + kk) * N + n0 + (lane & 31)] * scale; }
    LDS_WAIT(); asm volatile("" ::: "memory");
    const int n = lane >> 1;
#pragma unroll
    for (int j = 0; j < 2; ++j) { const int c = 2 * (lane & 1) + j; const LAS float* s_ = scr + (16 * c) * 33 + n;
        u32x4 o; o.x = pack4_f8(s_[0 * 33], s_[1 * 33], s_[2 * 33], s_[3 * 33]); o.y = pack4_f8(s_[4 * 33], s_[5 * 33], s_[6 * 33], s_[7 * 33]);
        o.z = pack4_f8(s_[8 * 33], s_[9 * 33], s_[10 * 33], s_[11 * 33]); o.w = pack4_f8(s_[12 * 33], s_[13 * 33], s_[14 * 33], s_[15 * 33]);
        *(u32x4*)(WT + (size_t)map(n0 + n) * K + k0 + 16 * c) = o; }
    LDS_WAIT(); asm volatile("" ::: "memory");
}
__device__ __forceinline__ void ln_row_f32_to_bf16(const float* __restrict__ xrow, const float* __restrict__ g, const float* __restrict__ bta, bf16* __restrict__ orow, int lane, unsigned char* __restrict__ o8 = nullptr) {
    f32x4 v[4]; float s = 0.f;
#pragma unroll
    for (int j = 0; j < 4; ++j) { v[j] = ((const f32x4*)xrow)[lane + 64 * j]; s += (v[j].x + v[j].y) + (v[j].z + v[j].w); }
    const float mean = wave_sum(s) * (1.f / DM); float s2 = 0.f;
#pragma unroll
    for (int j = 0; j < 4; ++j) { v[j] = v[j] - mean; s2 += (v[j].x * v[j].x + v[j].y * v[j].y) + (v[j].z * v[j].z + v[j].w * v[j].w); }
    const float rstd = rsq(wave_sum(s2) * (1.f / DM) + LN_EPS);
#pragma unroll
    for (int j = 0; j < 4; ++j) { const f32x4 gg = ((const f32x4*)g)[lane + 64 * j], bb = ((const f32x4*)bta)[lane + 64 * j]; const f32x4 o = v[j] * rstd * gg + bb;
        ((u32x2*)orow)[lane + 64 * j] = (u32x2){cvtpk(o.x, o.y), cvtpk(o.z, o.w)};
        if (o8) ((unsigned*)o8)[lane + 64 * j] = pack4_f8(o.x, o.y, o.z, o.w); }
}
__device__ __forceinline__ void zero_bytes(void* p, size_t bytes, int gtid, int ngt) {
    u32x4* q = (u32x4*)p; const size_t n = bytes / 16;
    for (size_t i = gtid; i < n; i += ngt) q[i] = (u32x4){0u, 0u, 0u, 0u};
}
__device__ __forceinline__ void sincos_d(float angf, float& sn, float& cs) {
    const double x = (double)angf; const double q = __builtin_rint(x * 0.63661977236758134308);
    const double r = (x - q * 1.57079632679489655800) - q * 6.123233995736766036e-17, r2 = r * r;
    const double sp = r * (1.0 + r2 * (-1.0 / 6 + r2 * (1.0 / 120 + r2 * (-1.0 / 5040 + r2 * (1.0 / 362880 + r2 * (-1.0 / 39916800 + r2 * (1.0 / 6227020800.0)))))));
    const double cp = 1.0 + r2 * (-0.5 + r2 * (1.0 / 24 + r2 * (-1.0 / 720 + r2 * (1.0 / 40320 + r2 * (-1.0 / 3628800 + r2 * (1.0 / 479001600.0))))));
    const int qi = ((int)q) & 3;
    const double s_ = (qi == 0) ? sp : (qi == 1) ? cp : (qi == 2) ? -sp : -cp;
    const double c_ = (qi == 0) ? cp : (qi == 1) ? -sp : (qi == 2) ? -cp : sp;
    sn = (float)s_; cs = (float)c_;
}

__device__ __forceinline__ void p2a_row(int row, const bf16* __restrict__ z, const float* __restrict__ rope, const float* __restrict__ g_q_a, const float* __restrict__ g_kv_a,
                                        const float* __restrict__ g_q_gqa, const float* __restrict__ g_k_gqa, float* rs_q, float* rs_kv, bf16* km, bf16* qg, bf16* kg, bf16* vg, int lane) {
    const bf16* zr = z + (size_t)row * ZLD;
    const bool meta = row >= NTOK;
    const int b = row >> 11, s = row & 2047, m = row - NTOK;
    const int pos1 = meta ? m : 16 + s, prow = meta ? -1 : (s >> 6), pcol = meta ? m : (s & 63), key = meta ? 2048 + m : s;
    {
        float f[8]; u32x4 w = {0u, 0u, 0u, 0u}; if (lane < 56) w = *(const u32x4*)(zr + 8 * lane); unpack8(w, f);
        float ss = 0.f;
#pragma unroll
        for (int j = 0; j < 8; ++j) ss += f[j] * f[j];
        ss += __shfl_xor(ss, 1); ss += __shfl_xor(ss, 2); ss += __shfl_xor(ss, 4); ss += __shfl_xor(ss, 8);
        const float s16 = ss, s32 = ss + __shfl_xor(ss, 16);
        if (lane == 0) rs_q[row] = rsq(s32 * (1.f / 256) + RMS_EPS);
        if (lane == 32) rs_kv[row] = rsq(s16 * (1.f / 128) + RMS_EPS);
        if (lane < 48) {
        } else if (lane < 56) { const int i0 = 4 * (lane - 48); const float* t = rope + ((size_t)(pos1 + 1) * 32 + i0) * 2; float o[8];
#pragma unroll
            for (int j = 0; j < 4; ++j) { const float c = t[2 * j], sn = t[2 * j + 1], x1 = f[2 * j], x2 = f[2 * j + 1]; o[2 * j] = x1 * c - x2 * sn; o[2 * j + 1] = x1 * sn + x2 * c; }
            const u32x4 pk = pack8(o);
            if (!meta) { for (int h = 0; h < 4; ++h) *(u32x4*)(km + ((size_t)(b * 4 + h) * LKP + key) * 192 + 128 + 8 * (lane - 48)) = pk; }
            else { for (int bb = 0; bb < NB; ++bb) for (int h = 0; h < 4; ++h) *(u32x4*)(km + ((size_t)(bb * 4 + h) * LKP + key) * 192 + 128 + 8 * (lane - 48)) = pk; }
        }
    }
    const int p0 = (lane & 15) * 8, half = p0 >> 6, i0 = (p0 & 63) >> 1;
    const int apos = half ? pcol : prow; const float* t = rope + ((size_t)(apos + 1) * 32 + i0) * 2;
    if (!meta) {
        float f[8]; unpack8(*(const u32x4*)(zr + 448 + 8 * lane), f);
        float ss = 0.f;
#pragma unroll
        for (int j = 0; j < 8; ++j) ss += f[j] * f[j];
        ss += __shfl_xor(ss, 1); ss += __shfl_xor(ss, 2); ss += __shfl_xor(ss, 4); ss += __shfl_xor(ss, 8);
        const float rs = rsq(ss * (1.f / 128) + RMS_EPS); float o[8];
#pragma unroll
        for (int j = 0; j < 4; ++j) { const int d1 = half * 64 + i0 + j, d2 = d1 + 32;
            const float x1 = f[2 * j] * rs * g_q_gqa[d1], x2 = f[2 * j + 1] * rs * g_q_gqa[d2], c = t[2 * j], sn = t[2 * j + 1];
            o[2 * j] = x1 * c - x2 * sn; o[2 * j + 1] = x1 * sn + x2 * c; }
        *(u32x4*)(qg + ((size_t)(b * 4 + (lane >> 4)) * 2048 + s) * 128 + p0) = pack8(o);
    }
    {
        float f[8]; unpack8(*(const u32x4*)(zr + 960 + 8 * lane), f);
        float ss = 0.f;
#pragma unroll
        for (int j = 0; j < 8; ++j) ss += f[j] * f[j];
        ss += __shfl_xor(ss, 1); ss += __shfl_xor(ss, 2); ss += __shfl_xor(ss, 4); ss += __shfl_xor(ss, 8);
        float o[8];
        if (lane < 32) { const float rs = rsq(ss * (1.f / 128) + RMS_EPS);
#pragma unroll
            for (int j = 0; j < 4; ++j) { const int d1 = half * 64 + i0 + j, d2 = d1 + 32;
                const float x1 = f[2 * j] * rs * g_k_gqa[d1], x2 = f[2 * j + 1] * rs * g_k_gqa[d2], c = t[2 * j], sn = t[2 * j + 1];
                o[2 * j] = x1 * c - x2 * sn; o[2 * j + 1] = x1 * sn + x2 * c; }
        } else {
#pragma unroll
            for (int j = 0; j < 8; ++j) o[j] = f[j];
        }
        const u32x4 pk = pack8(o); bf16* dst = lane < 32 ? kg : vg; const int hk = (lane >> 4) & 1;
        if (!meta) *(u32x4*)(dst + ((size_t)(b * 2 + hk) * LKP + key) * 128 + p0) = pk;
        else for (int bb = 0; bb < NB; ++bb) *(u32x4*)(dst + ((size_t)(bb * 2 + hk) * LKP + key) * 128 + p0) = pk;
    }
}

__device__ __forceinline__ int crow(int r, int hi) { return (r & 3) + 8 * (r >> 2) + 4 * hi; }
__device__ __forceinline__ int v_st(int k, int c) { const int kk = (k & ~0xC) | ((k & 4) << 1) | ((k & 8) >> 1); return ((kk >> 3) * 4 + (c >> 5)) * 512 + ((kk & 7) * 32 + (c & 31)) * 2; }
__device__ __forceinline__ int v_rd_base(int lane) { return ((lane & 3) << 3) | (((lane >> 2) & 3) << 6) | (((lane >> 4) & 1) << 5) | (((lane >> 5) & 1) << 8); }
constexpr int v_rd_off(int d0, int ks, int half) { return d0 * 512 + ks * 4096 + half * 2048; }
template <int OFF> __device__ __forceinline__ s16x4 tr_read(int vb) {
    s16x4 r; asm volatile("ds_read_b64_tr_b16 %0, %1 offset:%2" : "=&v"(r) : "v"(vb), "i"(OFF) : "memory"); return r;
}
template <int D0> __device__ __forceinline__ void pv_one(f32x16& od, int vb, bf16x8 pa0, bf16x8 pa1, bf16x8 pa2, bf16x8 pa3) {
    const s16x4 l0 = tr_read<v_rd_off(D0, 0, 0)>(vb), h0 = tr_read<v_rd_off(D0, 0, 1)>(vb), l1 = tr_read<v_rd_off(D0, 1, 0)>(vb), h1 = tr_read<v_rd_off(D0, 1, 1)>(vb);
    const s16x4 l2 = tr_read<v_rd_off(D0, 2, 0)>(vb), h2 = tr_read<v_rd_off(D0, 2, 1)>(vb), l3 = tr_read<v_rd_off(D0, 3, 0)>(vb), h3 = tr_read<v_rd_off(D0, 3, 1)>(vb);
    asm volatile("s_waitcnt lgkmcnt(0)" ::: "memory"); SBAR();
#define PK(L, H) (bf16x8){L[0], L[1], L[2], L[3], H[0], H[1], H[2], H[3]}
    od = __builtin_amdgcn_mfma_f32_32x32x16_bf16(pa0, PK(l0, h0), od, 0, 0, 0);
    od = __builtin_amdgcn_mfma_f32_32x32x16_bf16(pa1, PK(l1, h1), od, 0, 0, 0);
    od = __builtin_amdgcn_mfma_f32_32x32x16_bf16(pa2, PK(l2, h2), od, 0, 0, 0);
    od = __builtin_amdgcn_mfma_f32_32x32x16_bf16(pa3, PK(l3, h3), od, 0, 0, 0);
#undef PK
}
__device__ __forceinline__ void pv_d0(f32x16* o, int vb, bf16x8 pa0, bf16x8 pa1, bf16x8 pa2, bf16x8 pa3) {
    pv_one<0>(o[0], vb, pa0, pa1, pa2, pa3); pv_one<1>(o[1], vb, pa0, pa1, pa2, pa3); pv_one<2>(o[2], vb, pa0, pa1, pa2, pa3); pv_one<3>(o[3], vb, pa0, pa1, pa2, pa3);
}
template <int DQK> struct AttnC {
    static constexpr float SCALE = DQK == 192 ? 0.07216878364870322f : 0.08838834764831845f;
    static constexpr float C = SCALE * 1.4426950408889634f, THRS = 8.f / SCALE;
};
template <int DQK>
__device__ __forceinline__ void partialSM(f32x16& p0, f32x16& p1, float& m_reg, float& mn, float& alpha) {
    constexpr float C = AttnC<DQK>::C;
    float pmax = p0[0];
#pragma unroll
    for (int r = 1; r < 16; ++r) pmax = fmaxf(pmax, p0[r]);
#pragma unroll
    for (int r = 0; r < 16; ++r) pmax = fmaxf(pmax, p1[r]);
    { auto rr = __builtin_amdgcn_permlane32_swap(__float_as_uint(pmax), __float_as_uint(pmax), false, false);
      pmax = fmaxf(__uint_as_float(rr[0]), __uint_as_float(rr[1])); }
    if (__builtin_expect(__all(pmax - m_reg <= AttnC<DQK>::THRS), 1)) { mn = m_reg; alpha = 1.f; }
    else { mn = fmaxf(m_reg, pmax); alpha = __builtin_amdgcn_exp2f((m_reg - mn) * C); m_reg = mn; }
    const float mnC = -mn * C;
#pragma unroll
    for (int r = 0; r < 16; ++r) p0[r] = fmaf(p0[r], C, mnC);
#pragma unroll
    for (int r = 0; r < 16; ++r) p1[r] = fmaf(p1[r], C, mnC);
#pragma unroll
    for (int r = 0; r < 16; ++r) p0[r] = __builtin_amdgcn_exp2f(p0[r]);
}
__device__ __forceinline__ void finishSM(f32x16& p0, f32x16& p1, float alpha, float& l_reg, bf16x8& pa0, bf16x8& pa1, bf16x8& pa2, bf16x8& pa3) {
#pragma unroll
    for (int r = 0; r < 16; ++r) p1[r] = __builtin_amdgcn_exp2f(p1[r]);
    float ps = 0;
#pragma unroll
    for (int r = 0; r < 16; ++r) ps += p0[r];
#pragma unroll
    for (int r = 0; r < 16; ++r) ps += p1[r];
    { auto rr = __builtin_amdgcn_permlane32_swap(__float_as_uint(ps), __float_as_uint(ps), false, false);
      ps = __uint_as_float(rr[0]) + __uint_as_float(rr[1]); }
    l_reg = l_reg * alpha + ps;
#define PK4(P, BASE, OUT) do { unsigned a0 = cvtpk(P[BASE + 0], P[BASE + 1]), a1 = cvtpk(P[BASE + 2], P[BASE + 3]);   \
    unsigned b0 = cvtpk(P[BASE + 4], P[BASE + 5]), b1 = cvtpk(P[BASE + 6], P[BASE + 7]);                              \
    auto r0 = __builtin_amdgcn_permlane32_swap(a0, b0, false, false); auto r1 = __builtin_amdgcn_permlane32_swap(a1, b1, false, false); \
    u32x4 w = {r0[0], r1[0], r0[1], r1[1]}; OUT = *reinterpret_cast<bf16x8*>(&w); } while (0)
    PK4(p0, 0, pa0); PK4(p0, 8, pa1); PK4(p1, 0, pa2); PK4(p1, 8, pa3);
#undef PK4
}
template <int DQK>
__device__ __forceinline__ void qkt(f32x16& p0, f32x16& p1, const LAS char* Ks, const bf16x8* qr, const LAS char* ql, const int (&ko)[4]) {
    constexpr int KRB = DQK * 2;
    p0 = f32x16{}; p1 = f32x16{};
#pragma unroll
    for (int d0 = 0; d0 < DQK / 16; ++d0) { const LAS char* kp = Ks + ko[d0 & 3] + (d0 >> 2) * 128;
        const bf16x8 b0 = *(const LAS bf16x8*)(kp);
        const bf16x8 b1 = *(const LAS bf16x8*)(kp + 32 * KRB);
        bf16x8 q; if (d0 < 8) q = qr[d0]; else q = *(const LAS bf16x8*)(ql + (d0 - 8) * 1024);
        p0 = __builtin_amdgcn_mfma_f32_32x32x16_bf16(b0, q, p0, 0, 0, 0);
        p1 = __builtin_amdgcn_mfma_f32_32x32x16_bf16(b1, q, p1, 0, 0, 0); }
}
template <int DQK, int SD>
__device__ __forceinline__ void attn_body(const bf16* __restrict__ Qb, const bf16* __restrict__ Kh, const bf16* __restrict__ Vh, bf16* __restrict__ Ob, LAS char* lds, const float* __restrict__ rope, int pos0) {
    constexpr int ND0 = DQK / 16, KRB = DQK * 2, SHM_K = 64 * KRB, SHM_V = 64 * 128 * 2, NKC = DQK / 64, CPR = DQK / 8, NT = LKP / 64;
    static_assert(NT % 2 == 1, "odd tile count: the tail below takes tiles NT-2 and NT-1");
    int tid = threadIdx.x; asm volatile("" : "+v"(tid));
    const int wid = tid >> 6, lane = tid & 63, r32 = lane & 31, hi = lane >> 5;
    LAS char* V_lds = lds; LAS char* K_lds = lds + 2 * SHM_V;
    __syncthreads();
    float m_reg = -1e30f, l_reg = 0; f32x16 o[4] = {}; bf16x8 qr[8];
    const bf16* Qw = Qb + (size_t)(wid * 32 + r32) * DQK + hi * 8;
#pragma unroll
    for (int d0 = 0; d0 < 8; ++d0) qr[d0] = *reinterpret_cast<const bf16x8*>(Qw + d0 * 16);
    LAS char* ql = lds + 2 * SHM_V + 2 * SHM_K + 2048 + wid * 4096 + lane * 16;
#pragma unroll
    for (int d0 = 8; d0 < ND0; ++d0) {
        float x[8], y[8]; unpack8(*reinterpret_cast<const u32x4*>(Qw + d0 * 16), x);
        const float* t = rope + ((size_t)(pos0 + wid * 32 + r32 + 1) * 32 + (d0 - 8) * 8 + hi * 4) * 2; const f32x4 t0 = *(const f32x4*)t, t1 = *(const f32x4*)(t + 4);
        const float cs[4] = {t0[0], t0[2], t1[0], t1[2]}, sn[4] = {t0[1], t0[3], t1[1], t1[3]};
#pragma unroll
        for (int j = 0; j < 4; ++j) { y[2 * j] = x[2 * j] * cs[j] - x[2 * j + 1] * sn[j]; y[2 * j + 1] = x[2 * j] * sn[j] + x[2 * j + 1] * cs[j]; }
        *(LAS u32x4*)(ql + (d0 - 8) * 1024) = pack8(y); }
    const int sr = tid >> 4, sc = (tid & 15) * 8, vst0 = v_st(sr, sc), vst1 = v_st(32 + sr, sc);
    int kst[NKC];
#pragma unroll
    for (int c = 0; c < NKC; ++c) { const int id = tid + 512 * c, kr = id / CPR, kc = (id - kr * CPR) * 8; kst[c] = kr * KRB + ((kc * 2) ^ ((kr & 7) << 4)); }
    const int voff = tid * 16;
    int ko[4];
#pragma unroll
    for (int q = 0; q < 4; ++q) ko[q] = r32 * KRB + ((q * 32 + hi * 16) ^ ((r32 & 7) << 4));
    const __amdgpu_buffer_rsrc_t rK = __builtin_amdgcn_make_buffer_rsrc((void*)Kh, 0, LKP * KRB, 0x00020000);
    const __amdgpu_buffer_rsrc_t rV = __builtin_amdgcn_make_buffer_rsrc((void*)Vh, 0, LKP * 256, 0x00020000);
    const int vb0 = (int)(unsigned)(uintptr_t)V_lds + v_rd_base(lane);
    struct { bf16x8 vs0, vs1, ks[NKC]; } sr_[SD];
#define SLOAD(i, k0) do { sr_[i].vs0 = __builtin_bit_cast(bf16x8, __builtin_amdgcn_raw_buffer_load_b128(rV, voff, (k0) * 256, 0)); sr_[i].vs1 = __builtin_bit_cast(bf16x8, __builtin_amdgcn_raw_buffer_load_b128(rV, voff, (k0) * 256 + 8192, 0)); \
    _Pragma("unroll") for (int c_ = 0; c_ < NKC; ++c_) sr_[i].ks[c_] = __builtin_bit_cast(bf16x8, __builtin_amdgcn_raw_buffer_load_b128(rK, voff, (k0) * KRB + c_ * 8192, 0)); } while (0)
#define SWRITE(b, i) do { *(LAS bf16x8*)(V_lds + (b) * SHM_V + vst0) = sr_[i].vs0; *(LAS bf16x8*)(V_lds + (b) * SHM_V + vst1) = sr_[i].vs1; \
    _Pragma("unroll") for (int c_ = 0; c_ < NKC; ++c_) *(LAS bf16x8*)(K_lds + (b) * SHM_K + kst[c_]) = sr_[i].ks[c_]; } while (0)
#define SWAIT() do { if constexpr (SD == 2) { if constexpr (NKC == 2) asm volatile("s_waitcnt vmcnt(4)" ::: "memory"); else asm volatile("s_waitcnt vmcnt(5)" ::: "memory"); } \
    else asm volatile("s_waitcnt vmcnt(0)" ::: "memory"); } while (0)
#define RESC(a) do { if (__any((a) < 1.f)) { int t_ = threadIdx.x; asm volatile("" : "+v"(t_)); const int r32_ = t_ & 31, hi_2 = (t_ >> 5) & 1; \
    LAS float* al_ = (LAS float*)(lds + 2 * SHM_V + 2 * SHM_K) + (t_ >> 6) * 64 + 32; if (hi_2 == 0) al_[r32_] = (a); asm volatile("s_waitcnt lgkmcnt(0)" ::: "memory"); \
    _Pragma("unroll") for (int d = 0; d < 4; ++d) _Pragma("unroll") for (int r = 0; r < 16; ++r) o[d][r] *= al_[crow(r, hi_2)]; } } while (0)
    f32x16 pA0, pA1, pB0, pB1; float mnA, mnB, alA, alB; bf16x8 pa0, pa1, pa2, pa3;
    constexpr int SE = 0, SO = SD - 1;
    SLOAD(SE, 0); asm volatile("s_waitcnt vmcnt(0)" ::: "memory"); SWRITE(0, SE); __syncthreads();
    qkt<DQK>(pA0, pA1, K_lds, qr, ql, ko); partialSM<DQK>(pA0, pA1, m_reg, mnA, alA);
    SLOAD(SO, 64); if constexpr (SD == 2) { SLOAD(SE, 128); }
    SWAIT(); SWRITE(1, SO); __syncthreads();
#pragma unroll 1
    for (int j = 1; j + 2 < NT; j += 2) {
        SBAR(); qkt<DQK>(pB0, pB1, K_lds + SHM_K, qr, ql, ko);
        finishSM(pA0, pA1, alA, l_reg, pa0, pa1, pa2, pa3); SBAR();
        SLOAD(SO, (j + SD) * 64); SBAR();
        pv_d0(o, vb0, pa0, pa1, pa2, pa3); partialSM<DQK>(pB0, pB1, m_reg, mnB, alB);
        __syncthreads(); SWAIT(); SWRITE(0, SE);
        RESC(alB); __syncthreads();
        SBAR(); qkt<DQK>(pA0, pA1, K_lds, qr, ql, ko);
        finishSM(pB0, pB1, alB, l_reg, pa0, pa1, pa2, pa3); SBAR();
        SLOAD(SE, (j + 1 + SD) * 64); SBAR();
        pv_d0(o, vb0 + SHM_V, pa0, pa1, pa2, pa3); partialSM<DQK>(pA0, pA1, m_reg, mnA, alA);
        __syncthreads(); SWAIT(); SWRITE(1, SO);
        RESC(alA); __syncthreads();
    }
    SBAR(); qkt<DQK>(pB0, pB1, K_lds + SHM_K, qr, ql, ko);
    finishSM(pA0, pA1, alA, l_reg, pa0, pa1, pa2, pa3); SBAR();
    if constexpr (SD == 1) { SLOAD(SE, (NT - 1) * 64); } SBAR();
    pv_d0(o, vb0, pa0, pa1, pa2, pa3); partialSM<DQK>(pB0, pB1, m_reg, mnB, alB);
    __syncthreads(); asm volatile("s_waitcnt vmcnt(0)" ::: "memory"); SWRITE(0, SE);
    RESC(alB); __syncthreads();
    SBAR(); qkt<DQK>(pA0, pA1, K_lds, qr, ql, ko);
#pragma unroll
    for (int r = 8; r < 16; ++r) pA0[r] = -1e30f;
#pragma unroll
    for (int r = 0; r < 16; ++r) pA1[r] = -1e30f;
    finishSM(pB0, pB1, alB, l_reg, pa0, pa1, pa2, pa3); SBAR();
    pv_d0(o, vb0 + SHM_V, pa0, pa1, pa2, pa3); partialSM<DQK>(pA0, pA1, m_reg, mnA, alA);
    RESC(alA);
    finishSM(pA0, pA1, alA, l_reg, pa0, pa1, pa2, pa3); SBAR();
    pv_d0(o, vb0, pa0, pa1, pa2, pa3);
    { int t_ = threadIdx.x; asm volatile("" : "+v"(t_)); const int r32_ = t_ & 31, hi_2 = (t_ >> 5) & 1, wid_ = t_ >> 6;
      LAS float* li_ = (LAS float*)(lds + 2 * SHM_V + 2 * SHM_K) + wid_ * 64;
      if (hi_2 == 0) li_[r32_] = l_reg; asm volatile("s_waitcnt lgkmcnt(0)" ::: "memory");
      float rli[16];
#pragma unroll
      for (int r = 0; r < 16; ++r) rli[r] = __builtin_amdgcn_rcpf(li_[crow(r, hi_2)]);
      bf16* Ow = Ob + (size_t)(wid_ * 32) * DM;
#pragma unroll
      for (int r = 0; r < 16; ++r) { const int orow = crow(r, hi_2);
#pragma unroll
          for (int d0 = 0; d0 < 4; ++d0) Ow[(size_t)orow * DM + d0 * 32 + r32_] = (bf16)(cvtpk(o[d0][r] * rli[r], 0.f) & 0xffffu); } }
#undef SLOAD
#undef SWRITE
#undef SWAIT
#undef RESC
}

constexpr int NPHASE = 14;
struct Args { const float* in[24]; float* out; unsigned char* ws; int ph_lo, ph_hi; };
__global__ void __launch_bounds__(NWAVES * 64, 2) hymba_fwd(Args args) {
    extern __shared__ __attribute__((aligned(16))) unsigned char lds[];
    { int t0 = threadIdx.x; asm volatile("" : "+v"(t0)); for (int u = t0; u < 1024; u += NWAVES * 64) ((LAS unsigned*)((LAS unsigned char*)lds + LDSCTL_OFF))[u] = 0u; }
    __syncthreads();
#define XB_OBJ(b_) XcdBarrier b_; { const CAS unsigned char* kq_ = (const CAS unsigned char*)__builtin_amdgcn_kernarg_segment_ptr(); asm volatile("" : "+s"(kq_)); \
    b_.bar = (unsigned*)(*(unsigned char* const CAS*)(kq_ + 200) + WS_CTL) + CW_BAR; b_.x = xb_xcc_id(); b_.st = (volatile LAS unsigned*)((LAS unsigned char*)lds + LDSCTL_OFF) + 8; }
#if !MK_SPLIT
    { XB_OBJ(b0_); (void)xcd_barrier_post(b0_.bar, b0_.st); }
#define GRID_BAR() do { XB_OBJ(bb_); xcd_barrier(bb_); } while (0)
#else
#define GRID_BAR() do {} while (0)
#endif
    const int lo = args.ph_lo, hi_ = args.ph_hi;
#ifndef REP_MASK
#define REP_MASK 0
#endif
#define IN(k) (lo <= (k) && (k) < hi_)
#define REPS(k) (((REP_MASK >> (k)) & 1) ? 2 : 1)
#define SEAM(k) do { if (IN(k) && IN((k) + 1)) GRID_BAR(); } while (0)

#define PTRS \
    int bx = blockIdx.x; asm volatile("" : "+s"(bx)); const int G = gridDim.x, vcu = (G % 8 == 0) ? (bx % 8) * (G / 8) + bx / 8 : bx; \
    const int tid = threadIdx.x, lane = tid & 63, wave = __builtin_amdgcn_readfirstlane(tid >> 6); \
    const int gw = vcu * NWAVES + wave, ngw = G * NWAVES, gtid = vcu * (NWAVES * 64) + tid, ngt = G * NWAVES * 64; (void)gw; (void)ngw; (void)gtid; (void)ngt; (void)lane; \
    const CAS unsigned char* kp_ = (const CAS unsigned char*)__builtin_amdgcn_kernarg_segment_ptr(); asm volatile("" : "+s"(kp_)); \
    const float* const CAS* kin = (const float* const CAS*)kp_; unsigned char* ws = *(unsigned char* const CAS*)(kp_ + 200); float* outp = *(float* const CAS*)(kp_ + 192); (void)outp; (void)kin; \
    const float* x = kin[0]; const float* meta_tok = kin[1]; \
    float* rope = (float*)(ws + WS_ROPE); \
    bf16* w_in_t = (bf16*)(ws + WS_WIN); bf16* w_qb_t = (bf16*)(ws + WS_WQB); bf16* w_kvb_t = (bf16*)(ws + WS_WKVB); bf16* w_o_t = (bf16*)(ws + WS_WO); \
    bf16* w_r_t = (bf16*)(ws + WS_WR); unsigned char* w_gu8 = ws + WS_WGU; unsigned char* w_dn8 = ws + WS_WDN; unsigned char* h1f8 = ws + WS_H1F8; \
    bf16* h0 = (bf16*)(ws + WS_H0); bf16* h1 = (bf16*)(ws + WS_H1); float* rs_q = (float*)(ws + WS_QAN); float* rs_kv = rs_q + MPAD; bf16* z = (bf16*)(ws + WS_Z); \
    bf16* qm = (bf16*)(ws + WS_QM); bf16* km = (bf16*)(ws + WS_KM); bf16* vm = (bf16*)(ws + WS_VM); bf16* qg = (bf16*)(ws + WS_QG); bf16* kg = (bf16*)(ws + WS_KG); bf16* vg = (bf16*)(ws + WS_VG); \
    bf16* ob = (bf16*)(ws + WS_O); float* y1 = (float*)(ws + WS_Y1); float* logits = (float*)(ws + WS_LOGITS); \
    int* topk = (int*)(ws + WS_TOPK); float* gate = (float*)(ws + WS_GATE); int* pair_pos = (int*)(ws + WS_PAIRPOS); float* row_gate = (float*)(ws + WS_ROWGATE); \
    int* hist = (int*)(ws + WS_HIST); int* moetab = (int*)(ws + WS_MOETAB); int* tile_expert = moetab + 256; \
    unsigned char* xs8 = ws + WS_XS; unsigned char* act8 = ws + WS_ACT; bf16* out2 = (bf16*)(ws + WS_OUT2);


    for (int rep_ = 0; rep_ < (IN(0) ? REPS(0) : 0); ++rep_) { if (rep_) GRID_BAR(); PTRS;
        LAS float* scr = (LAS float*)((LAS unsigned char*)lds + wave * 16384);
        constexpr int I_IN = 16 * 46, I_QB = 4 * 24, I_KVB = 4 * 32, I_O = 16 * 32, I_R = 16, I_GU1 = 16 * 64, I_DN1 = 16 * 32;
        constexpr int NITEMS = I_IN + I_QB + I_KVB + I_O + I_R + NE * I_GU1 + NE * I_DN1;
        for (int it = gw; it < NITEMS; it += ngw) {
            int r = it;
            if (r < I_IN) { transpose_item(kin[4], 1024, NIN, w_in_t, scr, r, lane, MapIn()); continue; } r -= I_IN;
            if (r < I_QB) { transpose_item(kin[6], 256, 768, w_qb_t, scr, r, lane, MapQ(), kin[5]); continue; } r -= I_QB;
            if (r < I_KVB) { transpose_item(kin[8], 128, 1024, w_kvb_t, scr, r, lane, MapId(), kin[7], 256); continue; } r -= I_KVB;
            if (r < I_O) { transpose_item(kin[13], 1024, 1024, w_o_t, scr, r, lane, MapId()); continue; } r -= I_O;
            if (r < I_R) { transpose_item(kin[16], 1024, 32, w_r_t, scr, r, lane, MapId()); continue; } r -= I_R;
            if (r < NE * I_GU1) { const int e = r / I_GU1; transpose_item_f8(kin[18] + (size_t)e * 1024 * 2048, 1024, 2048, w_gu8 + (size_t)e * 2048 * 1024, scr, r - e * I_GU1, lane, MapGU(), W8_SCALE); continue; } r -= NE * I_GU1;
            { const int e = r / I_DN1; transpose_item_f8(kin[20] + (size_t)e * 1024 * 1024, 1024, 1024, w_dn8 + (size_t)e * 1024 * 1024, scr, r - e * I_DN1, lane, MapId(), W8_SCALE); }
        }
        for (int m = gw; m < MROWS; m += ngw) ln_row_f32_to_bf16(m < NTOK ? x + (size_t)m * DM : meta_tok + (size_t)(m - NTOK) * DM, kin[2], kin[3], h0 + (size_t)m * DM, lane);
        zero_bytes(h0 + (size_t)MROWS * DM, (size_t)(MPAD - MROWS) * DM * 2, gtid, ngt);
        zero_bytes(w_in_t + (size_t)NIN * 1024, (size_t)(ZLD - NIN) * 1024 * 2, gtid, ngt);
        for (int i = gw; i < 64 + 64 + 32 + 32; i += ngw) {
            bf16* p; size_t rb;
            if (i < 64) { p = km + ((size_t)i * LKP + 2064) * 192; rb = 48 * 192 * 2; }
            else if (i < 128) { p = vm + ((size_t)(i - 64) * LKP + 2064) * 128; rb = 48 * 128 * 2; }
            else if (i < 160) { p = kg + ((size_t)(i - 128) * LKP + 2064) * 128; rb = 48 * 128 * 2; }
            else { p = vg + ((size_t)(i - 160) * LKP + 2064) * 128; rb = 48 * 128 * 2; }
            zero_bytes(p, rb, lane, 64);
        }
        for (int i = gtid; i < 2065 * 32; i += ngt) {
            const int p = i / 32 - 1, f = i & 31; double inv = 1.0;
            for (int q = 0; q < f; ++q) inv *= 0.74989420933245582730;
            const float ang = (float)p * (float)inv; float sn, cs; sincos_d(fabsf(ang), sn, cs); if (ang < 0.f) sn = -sn;
            rope[2 * i] = cs; rope[2 * i + 1] = sn;
        }
    }
    SEAM(0);
    for (int rep_ = 0; rep_ < (IN(1) ? REPS(1) : 0); ++rep_) { if (rep_) GRID_BAR(); PTRS; EpiZ E{z};
#if FAST_Z
        { pg8::Gemm g{h0, w_in_t, NTOK, ZLD, 1024, 1024}; pg8::StaticOrder S; S.init(NTOK, ZLD, G, bx); pg8::EpiAdapt<EpiZ> EA{E, 0};
          pg8::gemm_phase<pg8::EpiAdapt<EpiZ>, pg8::StaticOrder, true, true>((LAS unsigned char*)lds, g, S, EA); }
        simple_gemm(h0, w_in_t, 1024, NTOK, NTOK + 64, ZLD, E, BSelNone(), gw, ngw, lane);
#else
        simple_gemm(h0, w_in_t, 1024, 0, NTOK + 64, ZLD, E, BSelNone(), gw, ngw, lane);
#endif
    }
    SEAM(1);
    for (int rep_ = 0; rep_ < (IN(2) ? REPS(2) : 0); ++rep_) { if (rep_) GRID_BAR(); PTRS; for (int m = gw; m < MROWS; m += ngw) p2a_row(m, z, rope, kin[5], kin[7], kin[9], kin[10], rs_q, rs_kv, km, qg, kg, vg, lane); }
    SEAM(2);
    for (int rep_ = 0; rep_ < (IN(3) ? REPS(3) : 0); ++rep_) { if (rep_) GRID_BAR(); PTRS;
        { EpiQ E{qm, rs_q}; pg8::Gemm g{z, w_qb_t, NTOK, 768, 256, ZLD}; pg8::StaticOrder S; S.init(NTOK, 768, G, bx); pg8::EpiAdapt<EpiQ> EA{E, 0};
          pg8::gemm_phase<pg8::EpiAdapt<EpiQ>, pg8::StaticOrder, true, true>((LAS unsigned char*)lds, g, S, EA); }
        { EpiKV<false> E{km, vm, rs_kv}; pg8::Gemm g{z + 256, w_kvb_t, NTOK, 1024, 256, ZLD}; pg8::StaticOrder S; S.init(NTOK, 1024, G, bx); pg8::EpiAdapt<EpiKV<false>> EA{E, 0};
          pg8::gemm_phase<pg8::EpiAdapt<EpiKV<false>>, pg8::StaticOrder, true, true>((LAS unsigned char*)lds, g, S, EA);
          EpiKV<true> EM{km, vm, rs_kv}; simple_gemm(z + 256, w_kvb_t, 256, NTOK, NTOK + 64, 1024, EM, BSelNone(), gw, ngw, lane, ZLD); }
    }
    SEAM(3);
    for (int rep_ = 0; rep_ < (IN(4) ? REPS(4) : 0); ++rep_) { if (rep_) GRID_BAR(); PTRS;
        for (int u = vcu; u < 1024; u += G) {
            if (u < 512) { const int b = u >> 5, h = (u >> 3) & 3, qb = u & 7, bh = b * 4 + h;
                attn_body<192, 1>(qm + ((size_t)bh * 2048 + qb * 256) * 192, km + (size_t)bh * LKP * 192, vm + (size_t)bh * LKP * 128, ob + ((size_t)b * 2048 + qb * 256) * DM + h * 128, (LAS char*)lds, rope, 16 + qb * 256);
            } else { const int v = u - 512, b = v >> 5, h = (v >> 3) & 3, qb = v & 7, bh = b * 4 + h, bk = b * 2 + (h >> 1);
                attn_body<128, 2>(qg + ((size_t)bh * 2048 + qb * 256) * 128, kg + (size_t)bk * LKP * 128, vg + (size_t)bk * LKP * 128, ob + ((size_t)b * 2048 + qb * 256) * DM + 512 + h * 128, (LAS char*)lds, rope, 0);
            }
        }
    }
    SEAM(4);
    for (int rep_ = 0; rep_ < (IN(5) ? REPS(5) : 0); ++rep_) { if (rep_) GRID_BAR(); PTRS;
        for (int m = gw; m < NTOK; m += ngw) {
#pragma unroll
            for (int g = 0; g < 2; ++g) { bf16* p = ob + (size_t)m * DM + g * 512 + 8 * lane; float f[8]; unpack8(*(const u32x4*)p, f);
                float ss = 0.f;
#pragma unroll
                for (int j = 0; j < 8; ++j) ss += f[j] * f[j];
                const float rs = rsq(wave_sum(ss) * (1.f / 512) + RMS_EPS); const float* gg = (g ? kin[12] : kin[11]) + 8 * lane;
#pragma unroll
                for (int j = 0; j < 8; ++j) f[j] = f[j] * rs * gg[j];
                *(u32x4*)p = pack8(f); }
        }
    }
    SEAM(5);
    for (int rep_ = 0; rep_ < (IN(6) ? REPS(6) : 0); ++rep_) { if (rep_) GRID_BAR(); PTRS; EpiO E{y1, h0};
#if FAST_O
        pg8::Gemm g{ob, w_o_t, NTOK, 1024, 1024, 1024}; pg8::StaticOrder S; S.init(NTOK, 1024, G, bx); pg8::EpiAdapt<EpiO> EA{E, 0};
        pg8::gemm_phase<pg8::EpiAdapt<EpiO>, pg8::StaticOrder, true, true>((LAS unsigned char*)lds, g, S, EA);
#else
        simple_gemm(ob, w_o_t, 1024, 0, NTOK, 1024, E, BSelNone(), gw, ngw, lane);
#endif
    }
    SEAM(6);
    for (int rep_ = 0; rep_ < (IN(7) ? REPS(7) : 0); ++rep_) { if (rep_) GRID_BAR(); PTRS; for (int m = gw; m < NTOK; m += ngw) ln_row_f32_to_bf16(y1 + (size_t)m * DM, kin[14], kin[15], h1 + (size_t)m * DM, lane, h1f8 + (size_t)m * DM); }
    SEAM(7);
#define ROUTE_VARS const int tpb = (NTOK + G - 1) / G, tok_lo = bx * tpb, tok_hi = (tok_lo + tpb < NTOK) ? tok_lo + tpb : NTOK; \
    LAS int* L_hist = (LAS int*)((LAS unsigned char*)lds + LDSCTL_OFF + 256); LAS int* L_n = L_hist + 32; LAS int* L_base = L_hist + 64; LAS int* L_off = L_hist + 96; (void)L_n; (void)L_base; (void)L_off;
    for (int rep_ = 0; rep_ < (IN(8) ? REPS(8) : 0); ++rep_) { if (rep_) GRID_BAR(); PTRS; ROUTE_VARS;
        constexpr int WRP = 2064;
        LAS unsigned char* L_wr = (LAS unsigned char*)lds;
        for (int i = tid; i < 32 * 128; i += NWAVES * 64) { const int r = i >> 7, c = i & 127; *(LAS u32x4*)(L_wr + r * WRP + c * 16) = *(const u32x4*)(w_r_t + (size_t)r * 1024 + c * 8); }
        if (tid < 32) L_hist[tid] = 0;
        __syncthreads();
        const int fr = lane & 15, fq = lane >> 4;
        for (int rb = tok_lo + wave * 16; rb < tok_hi; rb += NWAVES * 16) {
            const int row = rb + fr < NTOK ? rb + fr : NTOK - 1;
            const bf16* ap = h1 + (size_t)row * DM + fq * 8;
            bf16x8 a[32];
#pragma unroll
            for (int ks = 0; ks < 32; ++ks) a[ks] = *(const bf16x8*)(ap + ks * 32);
            f32x4 acc0 = {0.f, 0.f, 0.f, 0.f}, acc1 = {0.f, 0.f, 0.f, 0.f};
            const LAS unsigned char* bp = L_wr + (8 * (fr >> 2) + (fr & 3)) * WRP + fq * 16;
#pragma unroll
            for (int ks = 0; ks < 32; ++ks) { const bf16x8 b0 = *(const LAS bf16x8*)(bp + ks * 64), b1 = *(const LAS bf16x8*)(bp + 4 * WRP + ks * 64);
                acc0 = __builtin_amdgcn_mfma_f32_16x16x32_bf16(b0, a[ks], acc0, 0, 0, 0); acc1 = __builtin_amdgcn_mfma_f32_16x16x32_bf16(b1, a[ks], acc1, 0, 0, 0); }
            const float* br = kin[17] + 8 * fq; const f32x4 bb0 = *(const f32x4*)br, bb1 = *(const f32x4*)(br + 4);
            float v[8] = {acc0[0] + bb0[0], acc0[1] + bb0[1], acc0[2] + bb0[2], acc0[3] + bb0[3], acc1[0] + bb1[0], acc1[1] + bb1[1], acc1[2] + bb1[2], acc1[3] + bb1[3]};
            float tv[4]; int ti[4];
#pragma unroll
            for (int r = 0; r < 4; ++r) { float bv = v[0]; int bi = 8 * fq;
#pragma unroll
                for (int j = 1; j < 8; ++j) if (v[j] > bv) { bv = v[j]; bi = 8 * fq + j; }
#pragma unroll
                for (int off = 16; off <= 32; off <<= 1) { const float ov = __shfl_xor(bv, off); const int oi = __shfl_xor(bi, off); if (ov > bv || (ov == bv && oi < bi)) { bv = ov; bi = oi; } }
                tv[r] = bv; ti[r] = bi;
#pragma unroll
                for (int j = 0; j < 8; ++j) if (bi == 8 * fq + j) v[j] = -INFINITY; }
            const float e1 = __expf(tv[1] - tv[0]), e2 = __expf(tv[2] - tv[0]), e3 = __expf(tv[3] - tv[0]), inv = 1.f / (1.f + e1 + e2 + e3);
            if (fq == 0 && rb + fr < tok_hi) { const int t = rb + fr; *(int4*)(topk + (size_t)t * 4) = make_int4(ti[0], ti[1], ti[2], ti[3]); *(f32x4*)(gate + (size_t)t * 4) = (f32x4){inv, e1 * inv, e2 * inv, e3 * inv};
                atomicAdd((int*)(L_hist + ti[0]), 1); atomicAdd((int*)(L_hist + ti[1]), 1); atomicAdd((int*)(L_hist + ti[2]), 1); atomicAdd((int*)(L_hist + ti[3]), 1); }
        }
        __syncthreads();
        if (tid < 32) hist[bx * 32 + tid] = L_hist[tid];
    }
    SEAM(8);
    for (int rep_ = 0; rep_ < (IN(10) ? REPS(10) : 0); ++rep_) { if (rep_) GRID_BAR(); PTRS; ROUTE_VARS;
        if (tid < 32) { int tot = 0, before = 0; for (int b = 0; b < G; ++b) { const int h = hist[b * 32 + tid]; tot += h; if (b < bx) before += h; } L_n[tid] = tot; L_base[tid] = before; L_hist[tid] = 0; }
        __syncthreads();
        if (tid == 0) { int off = 0; for (int e = 0; e < NE; ++e) { L_off[e] = off; off += (L_n[e] + 255) & ~255; } L_off[NE] = off; }
        __syncthreads();
        LAS int* L_pos = (LAS int*)((LAS unsigned char*)lds);
        for (int p = tok_lo * 4 + tid; p < tok_hi * 4; p += NWAVES * 64) { const int e = topk[p]; const int r = atomicAdd((int*)(L_hist + e), 1); const int pos = L_off[e] + L_base[e] + r;
            row_gate[pos] = gate[p]; pair_pos[p] = pos; L_pos[p - tok_lo * 4] = pos; }
        __syncthreads();
        for (int p0 = tok_lo * 4 + wave; p0 < tok_hi * 4; p0 += NWAVES * 8) {
            u32x4 v[8]; int pos[8];
#pragma unroll
            for (int j = 0; j < 8; ++j) { const int p = p0 + j * NWAVES; pos[j] = p < tok_hi * 4 ? L_pos[p - tok_lo * 4] : -1; if (pos[j] >= 0) v[j] = ((const u32x4*)(h1f8 + (size_t)(p >> 2) * DM))[lane]; }
#pragma unroll
            for (int j = 0; j < 8; ++j) if (pos[j] >= 0) ((u32x4*)(xs8 + (size_t)pos[j] * DM))[lane] = v[j];
        }
        if (bx == 0) { if (tid == 0) moetab[0] = L_off[NE];
            if (tid < 32) { moetab[64 + tid] = L_n[tid]; moetab[128 + tid] = L_off[tid]; for (int t = L_off[tid] >> 8; t < (L_off[tid + 1] >> 8); ++t) tile_expert[t] = tid; } }
        __syncthreads();
    }
    SEAM(10);
    for (int rep_ = 0; rep_ < (IN(11) ? REPS(11) : 0); ++rep_) { if (rep_) GRID_BAR(); PTRS; const int rows = moetab[0]; EpiGU8 E{act8, kin[19]};
        pg8::Gemm g{(const bf16*)xs8, (const bf16*)w_gu8, rows, 2048, 512, 512}; pg8::MoeOrder S; S.init(rows >> 8, 8, G, bx, tile_expert);
        pg8::gemm_phase<EpiGU8, pg8::MoeOrder, true, true, true>((LAS unsigned char*)lds, g, S, E);
    }
    SEAM(11);
    for (int rep_ = 0; rep_ < (IN(12) ? REPS(12) : 0); ++rep_) { if (rep_) GRID_BAR(); PTRS; const int rows = moetab[0]; EpiDN8 E{out2, kin[21], row_gate};
        pg8::Gemm g{(const bf16*)act8, (const bf16*)w_dn8, rows, 1024, 512, 512}; pg8::MoeOrder S; S.init(rows >> 8, 4, G, bx, tile_expert);
        pg8::gemm_phase<EpiDN8, pg8::MoeOrder, true, true, true>((LAS unsigned char*)lds, g, S, E);
    }
    SEAM(12);
    for (int rep_ = 0; rep_ < (IN(13) ? REPS(13) : 0); ++rep_) { if (rep_) GRID_BAR(); PTRS;
        for (int t = gw; t < NTOK; t += ngw) {
            const int4 pp = *(const int4*)(pair_pos + (size_t)t * 4); const int ps[4] = {pp.x, pp.y, pp.z, pp.w};
            float v[16];
#pragma unroll
            for (int hf = 0; hf < 2; ++hf) { float f[8]; unpack8(*(const u32x4*)(h1 + (size_t)t * DM + hf * 512 + 8 * lane), f);
#pragma unroll
                for (int j = 0; j < 8; ++j) v[hf * 8 + j] = ALPHA * f[j];
#pragma unroll
                for (int s4 = 0; s4 < 4; ++s4) { float g[8]; unpack8(*(const u32x4*)(out2 + (size_t)ps[s4] * DM + hf * 512 + 8 * lane), g);
#pragma unroll
                    for (int j = 0; j < 8; ++j) v[hf * 8 + j] += g[j]; } }
            float s = 0.f;
#pragma unroll
            for (int j = 0; j < 16; ++j) s += v[j];
            const float mean = wave_sum(s) * (1.f / DM); float s2 = 0.f;
#pragma unroll
            for (int j = 0; j < 16; ++j) { v[j] -= mean; s2 += v[j] * v[j]; }
            const float rstd = rsq(wave_sum(s2) * (1.f / DM) + LN_EPS);
#pragma unroll
            for (int hf = 0; hf < 2; ++hf) { const int c = hf * 512 + 8 * lane; const float* gg = kin[22] + c; const float* bb = kin[23] + c; float* o = outp + (size_t)t * DM + c;
                *(f32x4*)o = (f32x4){v[hf * 8 + 0] * rstd * gg[0] + bb[0], v[hf * 8 + 1] * rstd * gg[1] + bb[1], v[hf * 8 + 2] * rstd * gg[2] + bb[2], v[hf * 8 + 3] * rstd * gg[3] + bb[3]};
                *(f32x4*)(o + 4) = (f32x4){v[hf * 8 + 4] * rstd * gg[4] + bb[4], v[hf * 8 + 5] * rstd * gg[5] + bb[5], v[hf * 8 + 6] * rstd * gg[6] + bb[6], v[hf * 8 + 7] * rstd * gg[7] + bb[7]}; }
        }
    }
#undef IN
#undef SEAM
}

extern "C" void kernel_launch(void* const* d_in, const int* in_sizes, int n_in, void* d_out, int out_size, void* d_ws, size_t ws_size, hipStream_t stream) {
    static int grid = 0;
    if (grid == 0) {
        if (n_in != 24 || in_sizes[0] != NTOK * DM || out_size != NTOK * DM || ws_size < WS_END) { fprintf(stderr, "kernel_launch: shape/workspace mismatch (n_in %d, ws %zu)\n", n_in, ws_size); grid = -1; return; }
        int dev = 0, cus = 0, per_cu = 0;
        if (hipGetDevice(&dev) != hipSuccess || hipDeviceGetAttribute(&cus, hipDeviceAttributeMultiprocessorCount, dev) != hipSuccess) { grid = -1; return; }
        if (hipFuncSetAttribute((const void*)hymba_fwd, hipFuncAttributeMaxDynamicSharedMemorySize, LDS_BYTES) != hipSuccess) { fprintf(stderr, "kernel_launch: hipFuncSetAttribute failed\n"); grid = -1; return; }
        if (hipOccupancyMaxActiveBlocksPerMultiprocessor(&per_cu, (const void*)hymba_fwd, NWAVES * 64, LDS_BYTES) != hipSuccess || per_cu < 1) fprintf(stderr, "kernel_launch: occupancy query says %d\n", per_cu);
        (void)hipGetLastError();
        grid = cus;
    }
    if (grid < 0) return;
    (void)hipMemsetAsync((char*)d_ws + WS_CTL, 0, CTL_ZERO_BYTES, stream);
    Args a{};
    for (int i = 0; i < 24; ++i) a.in[i] = (const float*)d_in[i];
    a.out = (float*)d_out; a.ws = (unsigned char*)d_ws;
#if MK_SPLIT
    for (int p = 0; p < NPHASE; ++p) { a.ph_lo = p; a.ph_hi = p + 1; hipLaunchKernelGGL(hymba_fwd, dim3(grid), dim3(NWAVES * 64), LDS_BYTES, stream, a); }
#else
    a.ph_lo = 0; a.ph_hi = NPHASE; hipLaunchKernelGGL(hymba_fwd, dim3(grid), dim3(NWAVES * 64), LDS_BYTES, stream, a);
#endif
}
```

```cpp
#include <hip/hip_runtime.h>
#include <cstdio>
#include <cstdint>

#ifndef MK_SPLIT
#define MK_SPLIT 0
#endif

#define LAS __attribute__((address_space(3)))
#define CAS __attribute__((address_space(4)))
typedef unsigned short bf16;
typedef short bf16x8 __attribute__((ext_vector_type(8)));
typedef short s16x4 __attribute__((ext_vector_type(4)));
typedef float f32x2 __attribute__((ext_vector_type(2)));
typedef float f32x4 __attribute__((ext_vector_type(4)));
typedef float f32x16 __attribute__((ext_vector_type(16)));
typedef unsigned u32x2 __attribute__((ext_vector_type(2)));
typedef unsigned u32x4 __attribute__((ext_vector_type(4)));
typedef __bf16 bf16x2_t __attribute__((ext_vector_type(2)));

constexpr int NB = 16, SEQ = 2048, DM = 1024, NMETA = 16;
constexpr int NTOK = NB * SEQ;
constexpr int MROWS = NTOK + NMETA;
constexpr int MPAD = 33024;
constexpr int LKP = 2112;
constexpr int NIN = 1472, ZLD = 1536;
constexpr int NE = 32, NPAIR = NTOK * 4, MOE_TILES_MAX = 544, MOE_ROWS_MAX = MOE_TILES_MAX * 256;
constexpr float ALPHA = 1.189207115002721f;
constexpr float RMS_EPS = 1e-6f, LN_EPS = 1e-5f;

constexpr size_t MiB = 1u << 20;
constexpr size_t WS_CTL = 0, CTL_ZERO_BYTES = 1 * MiB;
constexpr size_t WS_ROPE = 1 * MiB;
constexpr size_t WS_WQB = 2 * MiB;
constexpr size_t WS_WKVB = 2 * MiB + 512 * 1024;
constexpr size_t WS_WR = 3 * MiB;
constexpr size_t WS_LOGITS = 4 * MiB;
constexpr size_t WS_TOPK = 8 * MiB;
constexpr size_t WS_GATE = 8 * MiB + 512 * 1024;
constexpr size_t WS_PAIRPOS = 9 * MiB;
constexpr size_t WS_ROWGATE = 9 * MiB + 512 * 1024;
constexpr size_t WS_HIST = 10 * MiB + 512 * 1024;
constexpr size_t WS_MOETAB = 10 * MiB + 768 * 1024;
constexpr size_t WS_WIN = 12 * MiB;
constexpr size_t WS_WO = 15 * MiB;
constexpr size_t WS_WGU = 32 * MiB;
constexpr size_t WS_WDN = 96 * MiB;
constexpr size_t WS_H1F8 = 128 * MiB;
constexpr size_t WS_H0 = 224 * MiB;
constexpr size_t WS_H1 = 289 * MiB;
constexpr size_t WS_QAN = 353 * MiB;
constexpr size_t WS_KVAN = 370 * MiB;
constexpr size_t WS_Z = 380 * MiB;
constexpr size_t WS_QM = 477 * MiB;
constexpr size_t WS_KM = 525 * MiB;
constexpr size_t WS_VM = 575 * MiB;
constexpr size_t WS_QG = 608 * MiB;
constexpr size_t WS_KG = 640 * MiB;
constexpr size_t WS_VG = 657 * MiB;
constexpr size_t WS_O = 674 * MiB;
constexpr size_t WS_Y1 = 738 * MiB;
constexpr size_t WS_XS = 380 * MiB;
constexpr size_t WS_ACT = 516 * MiB;
constexpr size_t WS_OUT2 = 652 * MiB;
constexpr size_t WS_END = 924 * MiB;
static_assert(WS_Z + (size_t)MPAD * ZLD * 2 <= WS_QM && WS_QM + (size_t)64 * 2048 * 192 * 2 <= WS_KM && WS_KM + (size_t)64 * LKP * 192 * 2 <= WS_VM && WS_VM + (size_t)64 * LKP * 128 * 2 <= WS_QG, "ws map 1");
static_assert(WS_QG + (size_t)64 * 2048 * 128 * 2 <= WS_KG && WS_KG + (size_t)32 * LKP * 128 * 2 <= WS_VG && WS_VG + (size_t)32 * LKP * 128 * 2 <= WS_O && WS_O + (size_t)NTOK * DM * 2 <= WS_Y1 && WS_Y1 + (size_t)NTOK * DM * 4 <= WS_END, "ws map 2");
static_assert(WS_XS + (size_t)MOE_ROWS_MAX * DM <= WS_ACT && WS_ACT + (size_t)MOE_ROWS_MAX * DM <= WS_OUT2 && WS_OUT2 + (size_t)MOE_ROWS_MAX * DM * 2 <= WS_END && WS_WGU + (size_t)NE * 2048 * 1024 <= WS_WDN && WS_WDN + (size_t)NE * 1024 * 1024 <= WS_H1F8 && WS_H1F8 + (size_t)NTOK * DM <= WS_H0, "ws map 3");
static_assert(WS_H0 + (size_t)MPAD * DM * 2 <= WS_H1 && WS_H1 + (size_t)NTOK * DM * 2 <= WS_QAN && WS_QAN + (size_t)MPAD * 256 * 2 <= WS_KVAN && WS_KVAN + (size_t)MPAD * 128 * 2 <= WS_Z, "ws map 4");
constexpr int CW_BAR = 4096;

constexpr int RING_BYTES = 131072;
constexpr int LDSCTL_OFF = RING_BYTES;
constexpr int LDS_BYTES = 147456;
constexpr int NWAVES = 8;

#define LDS_WAIT() asm volatile("s_waitcnt lgkmcnt(0)" ::: "memory")
#define SBAR() __builtin_amdgcn_sched_barrier(0)
__device__ __forceinline__ unsigned cvtpk(float lo, float hi) { f32x2 v = {lo, hi}; bf16x2_t b = __builtin_convertvector(v, bf16x2_t); return __builtin_bit_cast(unsigned, b); }
__device__ __forceinline__ u32x4 pack8(const float (&v)[8]) { u32x4 r = {cvtpk(v[0], v[1]), cvtpk(v[2], v[3]), cvtpk(v[4], v[5]), cvtpk(v[6], v[7])}; return r; }
__device__ __forceinline__ void unpack8(u32x4 w, float (&v)[8]) {
    v[0] = __uint_as_float(w.x << 16); v[1] = __uint_as_float(w.x & 0xffff0000u); v[2] = __uint_as_float(w.y << 16); v[3] = __uint_as_float(w.y & 0xffff0000u);
    v[4] = __uint_as_float(w.z << 16); v[5] = __uint_as_float(w.z & 0xffff0000u); v[6] = __uint_as_float(w.w << 16); v[7] = __uint_as_float(w.w & 0xffff0000u);
}
__device__ __forceinline__ float wave_sum(float v) {
#pragma unroll
    for (int o = 1; o < 64; o <<= 1) v += __shfl_xor(v, o);
    return v;
}
__device__ __forceinline__ float rsq(float x) { return __builtin_amdgcn_rsqf(x); }
typedef int v8i __attribute__((ext_vector_type(8)));
__device__ __forceinline__ unsigned pack4_f8(float a, float b, float c, float d) { int w = 0; w = __builtin_amdgcn_cvt_pk_fp8_f32(a, b, w, false); w = __builtin_amdgcn_cvt_pk_fp8_f32(c, d, w, true); return (unsigned)w; }
constexpr float W8_SCALE = 32.f, W8_INV = 1.f / 32.f;

#define XB_TMO      128
#define XB_XCNT(j)  (256  + 64 * (j))
#define XB_XSUB(j)  (1280 + 64 * (j))
#define XB_XGEN(j)  (2304 + 64 * (j))
#define XB_TOP      3328
#define XB_TOPGEN   3392
#define XCD_BAR_WORDS 3456
#define XB_SPIN_CAP (1u << 18)
__device__ __forceinline__ unsigned xb_ld(unsigned* p)              { return __hip_atomic_load(p, __ATOMIC_RELAXED, __HIP_MEMORY_SCOPE_AGENT); }
__device__ __forceinline__ unsigned xb_add(unsigned* p, unsigned v) { return __hip_atomic_fetch_add(p, v, __ATOMIC_RELAXED, __HIP_MEMORY_SCOPE_AGENT); }
__device__ __forceinline__ unsigned xb_xcc_id() { return (unsigned)__builtin_amdgcn_s_getreg((3 << 11) | 20) & 0xFu; }
#define XB_SPIN(cond, bar) do { unsigned _sp = 0; while (cond) { __builtin_amdgcn_s_sleep(1); \
    if ((++_sp & 255u) == 0u) { if (xb_ld(&(bar)[XB_TMO])) break; if (_sp > XB_SPIN_CAP) { atomicAdd(&(bar)[XB_TMO], 1u); break; } } } } while (0)
struct XcdBarrier { unsigned* bar; unsigned x; volatile LAS unsigned* st; };
__device__ __forceinline__ XcdBarrier xcd_barrier_post(unsigned* bar, volatile LAS unsigned* st) {
    XcdBarrier b; b.bar = bar; b.x = xb_xcc_id(); b.st = st;
    if (threadIdx.x == 0) (void)xb_add(&bar[XB_XCNT(b.x)], 1u);
    return b;
}
__device__ __forceinline__ void xcd_barrier_complete(unsigned* bar, unsigned x, unsigned& nloc, unsigned& nx) {
    const unsigned G = gridDim.x * gridDim.y * gridDim.z;
    unsigned sum, cnt, mine, sp = 0u;
    for (;;) {
        sum = 0u; cnt = 0u; mine = 0u;
#pragma unroll
        for (unsigned j = 0; j < 16; ++j) { const unsigned c = xb_ld(&bar[XB_XCNT(j)]); sum += c; cnt += (c > 0u) ? 1u : 0u; mine = (j == x) ? c : mine; }
        if (sum == G) break;
        __builtin_amdgcn_s_sleep(1);
        if ((++sp & 255u) == 0u) { if (xb_ld(&bar[XB_TMO])) break; if (sp > XB_SPIN_CAP) { atomicAdd(&bar[XB_TMO], 1u); break; } }
    }
    nloc = mine > 0u ? mine : 1u; nx = cnt > 0u ? cnt : 1u;
}
__device__ __forceinline__ void xcd_barrier(const XcdBarrier& b) {
    asm volatile("s_waitcnt vmcnt(0)" ::: "memory");
    __syncthreads();
    if (threadIdx.x == 0) {
        unsigned* bar = b.bar;
        __builtin_amdgcn_s_waitcnt(0);
        unsigned nloc = b.st[0], nx = b.st[1];
        if (nloc == 0u) { xcd_barrier_complete(bar, b.x, nloc, nx); b.st[0] = nloc; b.st[1] = nx; }
        const unsigned old = xb_add(&bar[XB_XSUB(b.x)], 1u);
        const unsigned gen = old / nloc;
        if (old + 1u == (gen + 1u) * nloc) {
            __builtin_amdgcn_fence(__ATOMIC_RELEASE, "agent");
            asm volatile("s_waitcnt vmcnt(0)" ::: "memory");
            const unsigned og = xb_add(&bar[XB_TOP], 1u);
            const unsigned tg = og / nx;
            if (og + 1u == (tg + 1u) * nx) xb_add(&bar[XB_TOPGEN], 1u);
            else XB_SPIN(xb_ld(&bar[XB_TOPGEN]) == tg, bar);
            __builtin_amdgcn_fence(__ATOMIC_ACQUIRE, "agent");
            xb_add(&bar[XB_XGEN(b.x)], 1u);
            asm volatile("s_waitcnt vmcnt(0)" ::: "memory");
        } else {
            XB_SPIN(xb_ld(&bar[XB_XGEN(b.x)]) == gen, bar);
            __builtin_amdgcn_fence(__ATOMIC_ACQUIRE, "agent");
            asm volatile("s_waitcnt vmcnt(0)" ::: "memory");
        }
    }
    __syncthreads();
}

struct BSelNone { __device__ __forceinline__ size_t operator()(int) const { return 0; } };
struct BSelExpert { const int* tile_expert; size_t per; __device__ __forceinline__ size_t operator()(int m0) const { return (size_t)tile_expert[m0 >> 8] * per; } };
template <class Epi, class BSel>
__device__ __forceinline__ void simple_gemm(const bf16* __restrict__ A, const bf16* __restrict__ Bt, int K, int m_lo, int m_hi, int N, const Epi& E, const BSel& bsel, int gw, int ngw, int lane, int lda = 0) {
    if (lda == 0) lda = K;
    const int fr = lane & 15, fq = lane >> 4;
    const int mt = (m_hi - m_lo) / 64, nt = N / 32;
    for (int u = gw; u < mt * nt; u += ngw) {
        const int m0 = m_lo + (u / nt) * 64, n0 = (u % nt) * 32;
        const bf16* ap = A + (size_t)(m0 + fr) * lda + fq * 8;
        const bf16* bp = Bt + bsel(m0) + (size_t)(n0 + 8 * (fr >> 2) + (fr & 3)) * K + fq * 8;
        f32x4 acc[4][2];
#pragma unroll
        for (int i = 0; i < 4; ++i) { acc[i][0] = (f32x4){0.f, 0.f, 0.f, 0.f}; acc[i][1] = (f32x4){0.f, 0.f, 0.f, 0.f}; }
#pragma unroll 2
        for (int k = 0; k < K; k += 32) {
            bf16x8 a[4], b[2];
#pragma unroll
            for (int i = 0; i < 4; ++i) a[i] = *(const bf16x8*)(ap + (size_t)i * 16 * lda + k);
#pragma unroll
            for (int j = 0; j < 2; ++j) b[j] = *(const bf16x8*)(bp + (size_t)j * 4 * K + k);
#pragma unroll
            for (int i = 0; i < 4; ++i)
#pragma unroll
                for (int j = 0; j < 2; ++j) acc[i][j] = __builtin_amdgcn_mfma_f32_16x16x32_bf16(b[j], a[i], acc[i][j], 0, 0, 0);
        }
#pragma unroll
        for (int i = 0; i < 4; ++i) {
            const float v[8] = {acc[i][0][0], acc[i][0][1], acc[i][0][2], acc[i][0][3], acc[i][1][0], acc[i][1][1], acc[i][1][2], acc[i][1][3]};
            E.store8(m0 + 16 * i + fr, n0 + 8 * fq, v);
        }
    }
}


template <int K, class Epi>
__device__ __forceinline__ void smallk_task(const bf16* __restrict__ A, const bf16* __restrict__ Bt, int m0, int ng_lo, int ng_hi, const Epi& E, int lane) {
    constexpr int KS = K / 32;
    const int fr = lane & 15, fq = lane >> 4;
    bf16x8 a[4][KS];
#pragma unroll
    for (int i = 0; i < 4; ++i)
#pragma unroll
        for (int ks = 0; ks < KS; ++ks) a[i][ks] = *(const bf16x8*)(A + (size_t)(m0 + 16 * i + fr) * K + ks * 32 + fq * 8);
#pragma unroll 1
    for (int ng = ng_lo; ng < ng_hi; ++ng) {
        const int n0 = ng * 32;
        const bf16* bp = Bt + (size_t)(n0 + 8 * (fr >> 2) + (fr & 3)) * K + fq * 8;
        bf16x8 b[2][KS];
#pragma unroll
        for (int ks = 0; ks < KS; ++ks) { b[0][ks] = *(const bf16x8*)(bp + ks * 32); b[1][ks] = *(const bf16x8*)(bp + 4 * K + ks * 32); }
        f32x4 acc[4][2];
#pragma unroll
        for (int i = 0; i < 4; ++i) { acc[i][0] = (f32x4){0.f, 0.f, 0.f, 0.f}; acc[i][1] = (f32x4){0.f, 0.f, 0.f, 0.f}; }
#pragma unroll
        for (int ks = 0; ks < KS; ++ks)
#pragma unroll
            for (int i = 0; i < 4; ++i) { acc[i][0] = __builtin_amdgcn_mfma_f32_16x16x32_bf16(b[0][ks], a[i][ks], acc[i][0], 0, 0, 0); acc[i][1] = __builtin_amdgcn_mfma_f32_16x16x32_bf16(b[1][ks], a[i][ks], acc[i][1], 0, 0, 0); }
#pragma unroll
        for (int i = 0; i < 4; ++i) {
            const float v[8] = {acc[i][0][0], acc[i][0][1], acc[i][0][2], acc[i][0][3], acc[i][1][0], acc[i][1][1], acc[i][1][2], acc[i][1][3]};
            E.store8(m0 + 16 * i + fr, n0 + 8 * fq, v);
        }
    }
}


template <int K, class Epi>
__device__ __forceinline__ void meta_gemm16(const bf16* __restrict__ A, int lda, const bf16* __restrict__ Bt, int m0, int N, const Epi& E, int gw, int ngw, int lane) {
    const int fr = lane & 15, fq = lane >> 4;
    for (int ng = gw; ng < N / 32; ng += ngw) {
        const int n0 = ng * 32;
        const bf16* ap = A + (size_t)(m0 + fr) * lda + fq * 8;
        const bf16* bp = Bt + (size_t)(n0 + 8 * (fr >> 2) + (fr & 3)) * K + fq * 8;
        f32x4 acc0 = {0.f, 0.f, 0.f, 0.f}, acc1 = {0.f, 0.f, 0.f, 0.f};
#pragma unroll 8
        for (int k = 0; k < K; k += 32) { const bf16x8 a = *(const bf16x8*)(ap + k), b0 = *(const bf16x8*)(bp + k), b1 = *(const bf16x8*)(bp + 4 * K + k);
            acc0 = __builtin_amdgcn_mfma_f32_16x16x32_bf16(b0, a, acc0, 0, 0, 0); acc1 = __builtin_amdgcn_mfma_f32_16x16x32_bf16(b1, a, acc1, 0, 0, 0); }
        const float v[8] = {acc0[0], acc0[1], acc0[2], acc0[3], acc1[0], acc1[1], acc1[2], acc1[3]};
        E.store8(m0 + fr, n0 + 8 * fq, v);
    }
}

struct EpiZ { bf16* z;
    __device__ __forceinline__ void store8(int row, int col, const float (&v)[8]) const { if (col < NIN) *(u32x4*)(z + (size_t)row * ZLD + col) = pack8(v); } };
struct EpiQ { bf16* qm; const float* rs;
    __device__ __forceinline__ void store8(int row, int col, const float (&v_)[8]) const {
        const int h = col / 192, w = col - h * 192, b = row >> 11, s = row & 2047; const float r_ = rs[row];
        const float o[8] = {v_[0] * r_, v_[1] * r_, v_[2] * r_, v_[3] * r_, v_[4] * r_, v_[5] * r_, v_[6] * r_, v_[7] * r_};
        *(u32x4*)(qm + ((size_t)(b * 4 + h) * 2048 + s) * 192 + w) = pack8(o);
    } };
template <bool META> struct EpiKV { bf16* km; bf16* vm; const float* rs;
    __device__ __forceinline__ void store8(int row, int col, const float (&v_)[8]) const {
        if (META && row >= MROWS) return;
        const float r_ = rs[row]; const float v[8] = {v_[0] * r_, v_[1] * r_, v_[2] * r_, v_[3] * r_, v_[4] * r_, v_[5] * r_, v_[6] * r_, v_[7] * r_};
        const int h = col >> 8, w = col & 255; const u32x4 pk = pack8(v);
        if (!META) { const int b = row >> 11, key = row & 2047; const size_t r = (size_t)(b * 4 + h) * LKP + key;
            if (w < 128) *(u32x4*)(km + r * 192 + w) = pk; else *(u32x4*)(vm + r * 128 + (w - 128)) = pk;
        } else { const int key = 2048 + (row - NTOK);
            for (int b = 0; b < NB; ++b) { const size_t r = (size_t)(b * 4 + h) * LKP + key;
                if (w < 128) *(u32x4*)(km + r * 192 + w) = pk; else *(u32x4*)(vm + r * 128 + (w - 128)) = pk; } }
    } };
struct EpiO { bf16* y1; const bf16* h0;
    __device__ __forceinline__ void store8(int row, int col, const float (&v)[8]) const {
        float h[8]; unpack8(*(const u32x4*)(h0 + (size_t)row * DM + col), h);
        const float o[8] = {ALPHA * h[0] + v[0], ALPHA * h[1] + v[1], ALPHA * h[2] + v[2], ALPHA * h[3] + v[3], ALPHA * h[4] + v[4], ALPHA * h[5] + v[5], ALPHA * h[6] + v[6], ALPHA * h[7] + v[7]};
        *(u32x4*)(y1 + (size_t)row * DM + col) = pack8(o);
    } };
struct EpiLogit { float* logits; const float* bias;
    __device__ __forceinline__ void store8(int row, int col, const float (&v)[8]) const {
        float* y = logits + (size_t)row * NE + col;
        *(f32x4*)y = (f32x4){v[0] + bias[col], v[1] + bias[col + 1], v[2] + bias[col + 2], v[3] + bias[col + 3]};
        *(f32x4*)(y + 4) = (f32x4){v[4] + bias[col + 4], v[5] + bias[col + 5], v[6] + bias[col + 6], v[7] + bias[col + 7]};
    } };
namespace pg8 {
#define PG8_LAS __attribute__((address_space(3)))
typedef unsigned short bf16_t;
constexpr int BM = 256, BK = 64, HALF = 128, HTB = HALF * BK * 2, STAGE_BYTES = 8 * HTB, NXCD = 8, WGM = 8;
__host__ __device__ __forceinline__ int lds_byte(int r, int c) { const int st = (r >> 4) * 2 + (c >> 5), rr = r & 15, cc = c & 31, ob = rr * 64 + cc * 2; return st * 1024 + (ob ^ (((ob >> 9) & 1) << 5)); }
__host__ __device__ __forceinline__ void stage_rc(int b, int& R, int& C) { const int st = b / 1024, sb = b % 1024, swz = sb ^ (((sb >> 9) & 1) << 5); R = (st >> 1) * 16 + swz / 64; C = (st & 1) * 32 + (swz % 64) / 2; }
__host__ __device__ __forceinline__ int perm32(int rho) { const int n = rho >> 4, i = rho & 15; return 8 * (i >> 2) + 4 * n + (i & 3); }
struct Unit { int pm, pn; };
struct Gemm { const bf16_t* A; const bf16_t* Bt; int M, N, K, lda; };
struct StaticOrder {
    int nM, nN, nwg, G, c;
    __host__ __device__ void init(int M, int N, int G_, int c_) { nM = M / BM; nN = N / BM; nwg = nM * nN; G = G_; c = c_; }
    __host__ __device__ bool next(int i, Unit& u) const {
        const long L = (long)i * G + c; if (L >= nwg) return false;
        int wgid = (int)L; { const int q = nwg / NXCD, r = nwg % NXCD, xcd = wgid % NXCD, off = wgid / NXCD; wgid = (xcd < r ? xcd * (q + 1) : r * (q + 1) + (xcd - r) * q) + off; }
        const int nig = WGM * nN, gid = wgid / nig, fm = gid * WGM, gsz = (nM - fm) < WGM ? (nM - fm) : WGM;
        u.pm = fm + ((wgid % nig) % gsz); u.pn = (wgid % nig) / gsz; return true;
    }
    __device__ __forceinline__ void a_ready(const Unit&) const {}
    __device__ __forceinline__ void done(const Unit&) const {}
};
struct MoeOrder {
    StaticOrder so; const int* tile_expert;
    __device__ void init(int tiles, int nN, int G_, int c_, const int* te) { so.nM = tiles; so.nN = nN; so.nwg = tiles * nN; so.G = G_; so.c = c_; tile_expert = te; }
    __device__ bool next(int i, Unit& u) const { if (!so.next(i, u)) return false; u.pn += tile_expert[u.pm] * so.nN; return true; }
    __device__ __forceinline__ void a_ready(const Unit&) const {}
    __device__ __forceinline__ void done(const Unit&) const {}
};
template <class E8> struct EpiAdapt {
    static constexpr bool PERM = true, AFTER_DRAIN = false;
    E8 e; int ncols_mod;
    __device__ __forceinline__ void operator()(const f32x4 (&acc)[2][2][4][2], const Unit& u, int wr, int wc, int fr, int fq) const {
        const int row0 = u.pm * BM + wr * 64 + fr; int colt = u.pn * BM; if (ncols_mod) colt %= ncols_mod;
        const int col0 = colt + wc * 32 + 8 * fq;
#pragma unroll
        for (int ai = 0; ai < 2; ++ai)
#pragma unroll
            for (int m = 0; m < 4; ++m)
#pragma unroll
                for (int bj = 0; bj < 2; ++bj) {
                    const float v[8] = {acc[ai][bj][m][0][0], acc[ai][bj][m][0][1], acc[ai][bj][m][0][2], acc[ai][bj][m][0][3], acc[ai][bj][m][1][0], acc[ai][bj][m][1][1], acc[ai][bj][m][1][2], acc[ai][bj][m][1][3]};
                    e.store8(row0 + ai * HALF + m * 16, col0 + bj * HALF, v); }
    }
};
template <class Epi, class Sched, bool ALIGN_EPI = false, bool SP2 = false, bool F8 = false>
__device__ __forceinline__ void gemm_phase(PG8_LAS unsigned char* lds, const Gemm g, const Sched& S, const Epi& E) {
    const int tid = threadIdx.x, wid = __builtin_amdgcn_readfirstlane(tid >> 6), lane = tid & 63, wr = wid >> 2, wc = wid & 3, fr = lane & 15, fq = lane >> 4;
    const int K = g.K, nt = K / BK;
    unsigned voffA[2], voffB[2];
#pragma unroll
    for (int i = 0; i < 2; ++i) { int R, C; stage_rc(tid * 16 + i * 8192, R, C); const int Rb = Epi::PERM ? ((R & ~31) + perm32(R & 31)) : R;
        voffA[i] = (unsigned)(R * g.lda + C) * 2u; voffB[i] = (unsigned)(Rb * K + C) * 2u; }
    const size_t kstep = (size_t)(BK * 2);
    const size_t hstep = (size_t)HALF * K * 2, hstepA = (size_t)HALF * g.lda * 2;
    const size_t tstep = 2 * hstep, tstepA = 2 * hstepA;
    const unsigned ldsw = (unsigned)wid * 1024u;
    const int aoff = lds_byte(wr * 64 + fr, fq * 8), boff = lds_byte(wc * 32 + fr, fq * 8);
#define PG8_SA(b, h) (((b) * 2 + (h)) * HTB)
#define PG8_SB(b, h) ((4 + (b) * 2 + (h)) * HTB)
#define PG8_STAGE(bufoff, gbase, voff) do { _Pragma("unroll") for (int _i = 0; _i < 2; ++_i) \
        __builtin_amdgcn_global_load_lds((const unsigned*)((const char*)(gbase) + (voff)[_i]), (PG8_LAS unsigned*)(lds + (bufoff) + ldsw + _i * 8192), 16, 0, 0); } while (0)
#define PG8_LDA(dst, b, h) do { _Pragma("unroll") for (int m = 0; m < 4; ++m) _Pragma("unroll") for (int k = 0; k < 2; ++k) dst[m][k] = *(const PG8_LAS bf16x8*)(lds + PG8_SA(b, h) + aoff + m * 2048 + k * 1024); } while (0)
#define PG8_LDB(dst, b, h) do { _Pragma("unroll") for (int n = 0; n < 2; ++n) _Pragma("unroll") for (int k = 0; k < 2; ++k) dst[n][k] = *(const PG8_LAS bf16x8*)(lds + PG8_SB(b, h) + boff + n * 2048 + k * 1024); } while (0)
#define PG8_F8CAT(x) __builtin_shufflevector(__builtin_bit_cast(u32x4, (x)[0]), __builtin_bit_cast(u32x4, (x)[1]), 0, 1, 2, 3, 4, 5, 6, 7)
#define PG8_MMA(ai, bj, At, Bt) do { __builtin_amdgcn_s_setprio(1); if constexpr (F8) { _Pragma("unroll") for (int m = 0; m < 4; ++m) _Pragma("unroll") for (int n = 0; n < 2; ++n) \
        acc[ai][bj][m][n] = __builtin_amdgcn_mfma_scale_f32_16x16x128_f8f6f4(__builtin_bit_cast(v8i, PG8_F8CAT(Bt[n])), __builtin_bit_cast(v8i, PG8_F8CAT(At[m])), acc[ai][bj][m][n], 0, 0, 0, 0x7f7f7f7f, 0, 0x7f7f7f7f); \
        _Pragma("unroll") for (int m = 0; m < 4; ++m) _Pragma("unroll") for (int n = 0; n < 2; ++n) asm volatile("" : "+v"(acc[ai][bj][m][n])); } \
    else { _Pragma("unroll") for (int m = 0; m < 4; ++m) _Pragma("unroll") for (int n = 0; n < 2; ++n) _Pragma("unroll") for (int k = 0; k < 2; ++k) \
        acc[ai][bj][m][n] = __builtin_amdgcn_mfma_f32_16x16x32_bf16(Bt[n][k], At[m][k], acc[ai][bj][m][n], 0, 0, 0); } __builtin_amdgcn_s_setprio(0); } while (0)
#define PG8_WAIT_V(n) asm volatile("s_waitcnt vmcnt(" #n ")" ::: "memory")
#define PG8_WAIT_L(n) asm volatile("s_waitcnt lgkmcnt(" #n ")" ::: "memory")
#define PG8_BAR __builtin_amdgcn_s_barrier()
#define PG8_SCHED __builtin_amdgcn_sched_barrier(0)
    Unit cur, nxt; int ui = 0;
    if (!S.next(0, cur)) return;
    f32x4 acc[2][2][4][2];
#pragma unroll
    for (int a = 0; a < 2; ++a)
#pragma unroll
        for (int b = 0; b < 2; ++b)
#pragma unroll
            for (int m = 0; m < 4; ++m)
#pragma unroll
                for (int n = 0; n < 2; ++n) acc[a][b][m][n] = (f32x4){0.f, 0.f, 0.f, 0.f};
    bf16x8 At[4][2], B0[2][2], B1[2][2];
    const char* cA = (const char*)g.A + (size_t)cur.pm * tstepA; const char* cB = (const char*)g.Bt + (size_t)cur.pn * tstep;
    S.a_ready(cur);
    if constexpr (SP2) {
        PG8_STAGE(PG8_SB(0, 0), cB, voffB); PG8_STAGE(PG8_SB(0, 1), cB + hstep, voffB); PG8_STAGE(PG8_SA(0, 0), cA, voffA); PG8_STAGE(PG8_SA(0, 1), cA + hstepA, voffA);
        if (wr == 1) PG8_BAR;
        PG8_WAIT_V(2); PG8_BAR;
        PG8_STAGE(PG8_SB(1, 0), cB + kstep, voffB); PG8_STAGE(PG8_SA(1, 0), cA + kstep, voffA); PG8_STAGE(PG8_SB(1, 1), cB + hstep + kstep, voffB);
        PG8_WAIT_V(6); PG8_BAR;
    } else {
        PG8_STAGE(PG8_SB(0, 0), cB, voffB); PG8_STAGE(PG8_SA(0, 0), cA, voffA); PG8_STAGE(PG8_SB(0, 1), cB + hstep, voffB); PG8_STAGE(PG8_SA(0, 1), cA + hstepA, voffA);
        if (wr == 1) PG8_BAR;
        PG8_WAIT_V(4); PG8_BAR;
        PG8_STAGE(PG8_SB(1, 0), cB + kstep, voffB); PG8_STAGE(PG8_SA(1, 0), cA + kstep, voffA); PG8_STAGE(PG8_SB(1, 1), cB + hstep + kstep, voffB);
        PG8_WAIT_V(6); PG8_BAR;
    }
    for (;;) {
        const bool has_next = S.next(ui + 1, nxt);
        const char* nA = has_next ? (const char*)g.A + (size_t)nxt.pm * tstepA : cA; const char* nB = has_next ? (const char*)g.Bt + (size_t)nxt.pn * tstep : cB;
        for (int t = 0; t < nt; t += 2) {
            const bool last = (t == nt - 2);
            const char* a1 = cA + (size_t)(t + 1) * kstep;
            const char* a2 = last ? nA : cA + (size_t)(t + 2) * kstep; const char* b2 = last ? nB : cB + (size_t)(t + 2) * kstep;
            const char* a3 = a2 + kstep; const char* b3 = b2 + kstep;
            if (last && has_next) S.a_ready(nxt);
            if constexpr (SP2) {
            PG8_LDB(B0, 0, 0); PG8_LDB(B1, 0, 1); PG8_SCHED; PG8_LDA(At, 0, 0); PG8_STAGE(PG8_SA(1, 1), a1 + hstepA, voffA);
            PG8_WAIT_V(8); PG8_WAIT_L(0); PG8_BAR; PG8_MMA(0, 0, At, B0); PG8_MMA(0, 1, At, B1); PG8_BAR; PG8_SCHED;
            PG8_LDA(At, 0, 1); PG8_STAGE(PG8_SB(0, 0), b2, voffB); PG8_STAGE(PG8_SB(0, 1), b2 + hstep, voffB); PG8_STAGE(PG8_SA(0, 0), a2, voffA);
            PG8_WAIT_V(8); PG8_WAIT_L(0); PG8_BAR; PG8_MMA(1, 0, At, B0); PG8_MMA(1, 1, At, B1); PG8_BAR; PG8_SCHED;
            PG8_LDB(B0, 1, 0); PG8_LDB(B1, 1, 1); PG8_SCHED; PG8_LDA(At, 1, 0); PG8_STAGE(PG8_SA(0, 1), a2 + hstepA, voffA);
            PG8_WAIT_V(8); PG8_WAIT_L(0); PG8_BAR; PG8_MMA(0, 0, At, B0); PG8_MMA(0, 1, At, B1); PG8_BAR; PG8_SCHED;
            PG8_LDA(At, 1, 1); PG8_STAGE(PG8_SB(1, 0), b3, voffB); PG8_STAGE(PG8_SB(1, 1), b3 + hstep, voffB); PG8_STAGE(PG8_SA(1, 0), a3, voffA);
            PG8_WAIT_V(8); PG8_WAIT_L(0); PG8_BAR; PG8_MMA(1, 0, At, B0); PG8_MMA(1, 1, At, B1); PG8_BAR; PG8_SCHED;
            } else {
            PG8_LDB(B0, 0, 0); PG8_SCHED; PG8_LDA(At, 0, 0); PG8_STAGE(PG8_SA(1, 1), a1 + hstepA, voffA);
            PG8_WAIT_L(8); PG8_BAR; PG8_WAIT_L(0); PG8_MMA(0, 0, At, B0); PG8_BAR; PG8_SCHED;
            PG8_LDB(B1, 0, 1); PG8_STAGE(PG8_SB(0, 0), b2, voffB);
            PG8_BAR; PG8_WAIT_L(0); PG8_MMA(0, 1, At, B1); PG8_BAR;
            PG8_LDA(At, 0, 1); PG8_STAGE(PG8_SA(0, 0), a2, voffA);
            PG8_BAR; PG8_WAIT_L(0); PG8_MMA(1, 0, At, B0); PG8_BAR; PG8_SCHED;
            PG8_STAGE(PG8_SB(0, 1), b2 + hstep, voffB);
            PG8_WAIT_V(6); PG8_BAR; PG8_MMA(1, 1, At, B1); PG8_BAR;
            PG8_LDB(B0, 1, 0); PG8_SCHED; PG8_LDA(At, 1, 0); PG8_STAGE(PG8_SA(0, 1), a2 + hstepA, voffA);
            PG8_WAIT_L(8); PG8_BAR; PG8_WAIT_L(0); PG8_MMA(0, 0, At, B0); PG8_BAR; PG8_SCHED;
            PG8_LDB(B1, 1, 1); PG8_STAGE(PG8_SB(1, 0), b3, voffB);
            PG8_BAR; PG8_WAIT_L(0); PG8_MMA(0, 1, At, B1); PG8_BAR;
            PG8_LDA(At, 1, 1); PG8_STAGE(PG8_SA(1, 0), a3, voffA);
            PG8_BAR; PG8_WAIT_L(0); PG8_MMA(1, 0, At, B0); PG8_BAR; PG8_SCHED;
            PG8_STAGE(PG8_SB(1, 1), b3 + hstep, voffB);
            PG8_WAIT_V(6); PG8_BAR; PG8_MMA(1, 1, At, B1); PG8_BAR;
            }
        }
        if constexpr (ALIGN_EPI) { if (wr == 0) PG8_BAR; }
        if constexpr (!Epi::AFTER_DRAIN) { E(acc, cur, wr, wc, fr, fq); S.done(cur); }
        if (!has_next) break;
#pragma unroll
        for (int a = 0; a < 2; ++a)
#pragma unroll
            for (int b = 0; b < 2; ++b)
#pragma unroll
                for (int m = 0; m < 4; ++m)
#pragma unroll
                    for (int n = 0; n < 2; ++n) acc[a][b][m][n] = (f32x4){0.f, 0.f, 0.f, 0.f};
        cur = nxt; cA = nA; cB = nB; ++ui;
        if constexpr (ALIGN_EPI) { if (wr == 1) PG8_BAR; }
    }
    PG8_WAIT_V(0);
    if constexpr (!ALIGN_EPI) { if (wr == 0) PG8_BAR; }
    PG8_BAR;
#undef PG8_SA
#undef PG8_SB
#undef PG8_STAGE
#undef PG8_LDA
#undef PG8_LDB
#undef PG8_MMA
#undef PG8_F8CAT
#undef PG8_WAIT_V
#undef PG8_WAIT_L
#undef PG8_BAR
#undef PG8_SCHED
}
}

struct EpiGU8 { static constexpr bool PERM = true, AFTER_DRAIN = false;
    unsigned char* act8; const float* bgu;
    __device__ __forceinline__ void operator()(const f32x4 (&acc)[2][2][4][2], const pg8::Unit& u, int wr, int wc, int fr, int fq) const {
        const int e = u.pn >> 3, ac0 = 128 * (u.pn & 7) + wc * 32 + 8 * fq;
        const float* bb = bgu + (size_t)e * 2048 + 2 * ac0;
        const f32x4 q0 = *(const f32x4*)bb, q1 = *(const f32x4*)(bb + 4), q2 = *(const f32x4*)(bb + 8), q3 = *(const f32x4*)(bb + 12);
        const float bg[8] = {q0[0], q0[2], q1[0], q1[2], q2[0], q2[2], q3[0], q3[2]}, bl[8] = {q0[1], q0[3], q1[1], q1[3], q2[1], q2[3], q3[1], q3[3]};
#pragma unroll
        for (int ai = 0; ai < 2; ++ai)
#pragma unroll
            for (int m = 0; m < 4; ++m) { const int row = u.pm * 256 + ai * 128 + wr * 64 + m * 16 + fr; float o[8];
#pragma unroll
                for (int t = 0; t < 8; ++t) {
                    const float xg = fminf(acc[ai][0][m][t >> 2][t & 3] * W8_INV + bg[t], 7.f), xl = fminf(fmaxf(acc[ai][1][m][t >> 2][t & 3] * W8_INV + bl[t], -7.f), 7.f);
                    const float sg = __builtin_amdgcn_rcpf(1.f + __builtin_amdgcn_exp2f(-1.702f * 1.4426950408889634f * xg));
                    o[t] = xg * sg * (xl + 1.f); }
                *(u32x2*)(act8 + (size_t)row * DM + ac0) = (u32x2){pack4_f8(o[0], o[1], o[2], o[3]), pack4_f8(o[4], o[5], o[6], o[7])}; }
    } };
struct EpiDN8 { static constexpr bool PERM = true, AFTER_DRAIN = false;
    bf16* out2; const float* bdn; const float* row_gate;
    __device__ __forceinline__ void operator()(const f32x4 (&acc)[2][2][4][2], const pg8::Unit& u, int wr, int wc, int fr, int fq) const {
        const int e = u.pn >> 2, c0 = 256 * (u.pn & 3) + wc * 32 + 8 * fq;
        f32x4 bv[2][2];
#pragma unroll
        for (int bj = 0; bj < 2; ++bj) { bv[bj][0] = *(const f32x4*)(bdn + (size_t)e * DM + c0 + bj * 128); bv[bj][1] = *(const f32x4*)(bdn + (size_t)e * DM + c0 + bj * 128 + 4); }
#pragma unroll
        for (int ai = 0; ai < 2; ++ai)
#pragma unroll
            for (int m = 0; m < 4; ++m) { const int row = u.pm * 256 + ai * 128 + wr * 64 + m * 16 + fr; const float g = row_gate[row];
#pragma unroll
                for (int bj = 0; bj < 2; ++bj) { const f32x4 v0 = (acc[ai][bj][m][0] * W8_INV + bv[bj][0]) * g, v1 = (acc[ai][bj][m][1] * W8_INV + bv[bj][1]) * g;
                    *(u32x4*)(out2 + (size_t)row * DM + c0 + bj * 128) = (u32x4){cvtpk(v0[0], v0[1]), cvtpk(v0[2], v0[3]), cvtpk(v1[0], v1[1]), cvtpk(v1[2], v1[3])}; } }
    } };
#ifndef FAST_Z
#define FAST_Z 1
#endif
#ifndef FAST_O
#define FAST_O 1
#endif

struct MapId { __device__ __forceinline__ int operator()(int n) const { return n; } };
struct MapIn { __device__ __forceinline__ int operator()(int n) const {
    if (n >= 384 && n < 448) { const int l = n - 384; return 384 + 2 * (l & 31) + (l >> 5); }
    if (n >= 448 && n < 1216) { const int l = n - 448, hd = l >> 7, d = l & 127; return 448 + hd * 128 + (d >> 6) * 64 + 2 * (d & 31) + ((d >> 5) & 1); }
    return n; } };
struct MapQ { __device__ __forceinline__ int operator()(int n) const { const int h = n / 192, w = n - h * 192; if (w < 128) return n; const int l = w - 128; return h * 192 + 128 + 2 * (l & 31) + (l >> 5); } };
struct MapGU { __device__ __forceinline__ int operator()(int n) const { const int a = n >> 1; return 256 * (a >> 7) + 128 * (n & 1) + (a & 127); } };
template <class Map>
__device__ __forceinline__ void transpose_item(const float* __restrict__ W, int K, int N, bf16* __restrict__ WT, LAS float* scr, int item, int lane, const Map& map, const float* __restrict__ kscale = nullptr, int ldo = 0) {
    if (ldo == 0) ldo = K;
    const int nblk = N / 32, kb = item / nblk, nb = item - kb * nblk, k0 = 64 * kb, n0 = 32 * nb;
#pragma unroll 8
    for (int i = 0; i < 32; ++i) { const int kk = 2 * i + (lane >> 5); scr[kk * 33 + (lane & 31)] = (k0 < K) ? W[(size_t)(k0 + kk) * N + n0 + (lane & 31)] * (kscale ? kscale[k0 + kk] : 1.f) : 0.f; }
    LDS_WAIT(); asm volatile("" ::: "memory");
    const int c = lane & 7;
#pragma unroll
    for (int j = 0; j < 4; ++j) { const int n = (lane >> 3) + 8 * j; const LAS float* s = scr + (8 * c) * 33 + n;
        u32x4 o; o.x = cvtpk(s[0 * 33], s[1 * 33]); o.y = cvtpk(s[2 * 33], s[3 * 33]); o.z = cvtpk(s[4 * 33], s[5 * 33]); o.w = cvtpk(s[6 * 33], s[7 * 33]);
        *(u32x4*)(WT + (size_t)map(n0 + n) * ldo + k0 + 8 * c) = o; }
    LDS_WAIT(); asm volatile("" ::: "memory");
}

template <class Map>
__device__ __forceinline__ void transpose_item_f8(const float* __restrict__ W, int K, int N, unsigned char* __restrict__ WT, LAS float* scr, int item, int lane, const Map& map, float scale) {
    const int nblk = N / 32, kb = item / nblk, nb = item - kb * nblk, k0 = 64 * kb, n0 = 32 * nb;
#pragma unroll 8
    for (int i = 0; i < 8; ++i) { const int kk = 8 * i + (lane >> 3), c4 = (lane & 7) * 4; const f32x4 w4 = *(const f32x4*)(W + (size_t)(k0 + kk) * N + n0 + c4) * scale;
        LAS float* d_ = scr + kk * 33 + c4; d_[0] = w4[0]; d_[1] = w4[1]; d_[2] = w4[2]; d_[3] = w4[3]; }
    LDS_WAIT(); asm volatile("" ::: "memory");
    const int n = lane >> 1;
#pragma unroll
    for (int j = 0; j < 2; ++j) { const int c = 2 * (lane & 1) + j; const LAS float* s_ = scr + (16 * c) * 33 + n;
        u32x4 o; o.x = pack4_f8(s_[0 * 33], s_[1 * 33], s_[2 * 33], s_[3 * 33]); o.y = pack4_f8(s_[4 * 33], s_[5 * 33], s_[6 * 33], s_[7 * 33]);
        o.z = pack4_f8(s_[8 * 33], s_[9 * 33], s_[10 * 33], s_[11 * 33]); o.w = pack4_f8(s_[12 * 33], s_[13 * 33], s_[14 * 33], s_[15 * 33]);
        *(u32x4*)(WT + (size_t)map(n0 + n) * K + k0 + 16 * c) = o; }
    LDS_WAIT(); asm volatile("" ::: "memory");
}

template <class Map>
__device__ __forceinline__ void transpose_f8_stream(const float* __restrict__ Wall, int N, unsigned char* __restrict__ WTall, LAS float* scr, int gw, int ngw, int lane, const Map& map, float scale) {
    const int nblk = N / 32, per = 16 * nblk, n_items = NE * per;
#define T8_LOAD(dst, it_) do { const int e_ = (it_) / per, r_ = (it_) - e_ * per, kb_ = r_ / nblk, nb_ = r_ - kb_ * nblk; \
        const float* wp_ = Wall + ((size_t)e_ * 1024 + 64 * kb_ + (lane >> 3)) * N + 32 * nb_ + (lane & 7) * 4; \
        _Pragma("unroll") for (int i = 0; i < 8; ++i) dst[i] = *(const f32x4*)(wp_ + (size_t)(8 * i) * N); } while (0)
    f32x4 cur[8], nxt[8];
    int it = gw; if (it < n_items) T8_LOAD(cur, it);
    for (; it < n_items; it += ngw) {
        const int itn = it + ngw; if (itn < n_items) T8_LOAD(nxt, itn);
        const int e = it / per, r = it - e * per, kb = r / nblk, nb = r - kb * nblk, k0 = 64 * kb, n0 = 32 * nb;
#pragma unroll
        for (int i = 0; i < 8; ++i) { LAS float* d_ = scr + (8 * i + (lane >> 3)) * 33 + (lane & 7) * 4; const f32x4 w4 = cur[i] * scale; d_[0] = w4[0]; d_[1] = w4[1]; d_[2] = w4[2]; d_[3] = w4[3]; }
        LDS_WAIT(); asm volatile("" ::: "memory");
        const int n = lane >> 1;
#pragma unroll
        for (int j = 0; j < 2; ++j) { const int c = 2 * (lane & 1) + j; const LAS float* s_ = scr + (16 * c) * 33 + n;
            u32x4 o; o.x = pack4_f8(s_[0 * 33], s_[1 * 33], s_[2 * 33], s_[3 * 33]); o.y = pack4_f8(s_[4 * 33], s_[5 * 33], s_[6 * 33], s_[7 * 33]);
            o.z = pack4_f8(s_[8 * 33], s_[9 * 33], s_[10 * 33], s_[11 * 33]); o.w = pack4_f8(s_[12 * 33], s_[13 * 33], s_[14 * 33], s_[15 * 33]);
            *(u32x4*)(WTall + ((size_t)e * N + map(n0 + n)) * 1024 + k0 + 16 * c) = o; }
        LDS_WAIT(); asm volatile("" ::: "memory");
#pragma unroll
        for (int i = 0; i < 8; ++i) cur[i] = nxt[i];
    }
#undef T8_LOAD
}
__device__ __forceinline__ void ln_row_f32_to_bf16(f32x4 (&v)[4], const f32x4 (&gg)[4], const f32x4 (&bb)[4], bf16* __restrict__ orow, int lane) {
    float s = 0.f;
#pragma unroll
    for (int j = 0; j < 4; ++j) s += (v[j].x + v[j].y) + (v[j].z + v[j].w);
    const float mean = wave_sum(s) * (1.f / DM); float s2 = 0.f;
#pragma unroll
    for (int j = 0; j < 4; ++j) { v[j] = v[j] - mean; s2 += (v[j].x * v[j].x + v[j].y * v[j].y) + (v[j].z * v[j].z + v[j].w * v[j].w); }
    const float rstd = rsq(wave_sum(s2) * (1.f / DM) + LN_EPS);
#pragma unroll
    for (int j = 0; j < 4; ++j) { const f32x4 o = v[j] * rstd * gg[j] + bb[j]; ((u32x2*)orow)[lane + 64 * j] = (u32x2){cvtpk(o.x, o.y), cvtpk(o.z, o.w)}; }
}

__device__ __forceinline__ void ln_row_bf16(const bf16* __restrict__ yrow, const f32x4 (&G4)[4], const f32x4 (&B4)[4], bf16* __restrict__ orow, unsigned char* __restrict__ o8, int lane) {
    float v[16]; unpack8(*(const u32x4*)(yrow + 8 * lane), *(float(*)[8])&v[0]); unpack8(*(const u32x4*)(yrow + 512 + 8 * lane), *(float(*)[8])&v[8]);
    float s = 0.f;
#pragma unroll
    for (int j = 0; j < 16; ++j) s += v[j];
    const float mean = wave_sum(s) * (1.f / DM); float s2 = 0.f;
#pragma unroll
    for (int j = 0; j < 16; ++j) { v[j] -= mean; s2 += v[j] * v[j]; }
    const float rstd = rsq(wave_sum(s2) * (1.f / DM) + LN_EPS);
#pragma unroll
    for (int hf = 0; hf < 2; ++hf) { const f32x4 a = (f32x4){v[hf * 8 + 0], v[hf * 8 + 1], v[hf * 8 + 2], v[hf * 8 + 3]} * rstd * G4[2 * hf] + B4[2 * hf], b = (f32x4){v[hf * 8 + 4], v[hf * 8 + 5], v[hf * 8 + 6], v[hf * 8 + 7]} * rstd * G4[2 * hf + 1] + B4[2 * hf + 1];
        *(u32x4*)(orow + hf * 512 + 8 * lane) = (u32x4){cvtpk(a[0], a[1]), cvtpk(a[2], a[3]), cvtpk(b[0], b[1]), cvtpk(b[2], b[3])};
        *(u32x2*)(o8 + hf * 512 + 8 * lane) = (u32x2){pack4_f8(a[0], a[1], a[2], a[3]), pack4_f8(b[0], b[1], b[2], b[3])}; }
}
__device__ __forceinline__ void zero_bytes(void* p, size_t bytes, int gtid, int ngt) {
    u32x4* q = (u32x4*)p; const size_t n = bytes / 16;
    for (size_t i = gtid; i < n; i += ngt) q[i] = (u32x4){0u, 0u, 0u, 0u};
}
__device__ __forceinline__ void sincos_d(float angf, float& sn, float& cs) {
    const double x = (double)angf; const double q = __builtin_rint(x * 0.63661977236758134308);
    const double r = (x - q * 1.57079632679489655800) - q * 6.123233995736766036e-17, r2 = r * r;
    const double sp = r * (1.0 + r2 * (-1.0 / 6 + r2 * (1.0 / 120 + r2 * (-1.0 / 5040 + r2 * (1.0 / 362880 + r2 * (-1.0 / 39916800 + r2 * (1.0 / 6227020800.0)))))));
    const double cp = 1.0 + r2 * (-0.5 + r2 * (1.0 / 24 + r2 * (-1.0 / 720 + r2 * (1.0 / 40320 + r2 * (-1.0 / 3628800 + r2 * (1.0 / 479001600.0))))));
    const int qi = ((int)q) & 3;
    const double s_ = (qi == 0) ? sp : (qi == 1) ? cp : (qi == 2) ? -sp : -cp;
    const double c_ = (qi == 0) ? cp : (qi == 1) ? -sp : (qi == 2) ? -cp : sp;
    sn = (float)s_; cs = (float)c_;
}

__device__ __forceinline__ void p2a_row(int row, u32x4 wA, u32x4 wB, u32x4 wC, const float* __restrict__ rope, const float* __restrict__ g_q_a, const float* __restrict__ g_kv_a,
                                        const float* __restrict__ g_q_gqa, const float* __restrict__ g_k_gqa, float* rs_q, float* rs_kv, bf16* km, bf16* qg, bf16* kg, bf16* vg, int lane) {
    const bool meta = row >= NTOK;
    const int b = row >> 11, s = row & 2047, m = row - NTOK;
    const int pos1 = meta ? m : 16 + s, prow = meta ? -1 : (s >> 6), pcol = meta ? m : (s & 63), key = meta ? 2048 + m : s;
    {
        float f[8]; unpack8(wA, f);
        float ss = 0.f;
#pragma unroll
        for (int j = 0; j < 8; ++j) ss += f[j] * f[j];
        ss += __shfl_xor(ss, 1); ss += __shfl_xor(ss, 2); ss += __shfl_xor(ss, 4); ss += __shfl_xor(ss, 8);
        const float s16 = ss, s32 = ss + __shfl_xor(ss, 16);
        if (lane == 0) rs_q[row] = rsq(s32 * (1.f / 256) + RMS_EPS);
        if (lane == 32) rs_kv[row] = rsq(s16 * (1.f / 128) + RMS_EPS);
        if (lane < 48) {
        } else if (lane < 56) { const int i0 = 4 * (lane - 48); const float* t = rope + ((size_t)(pos1 + 1) * 32 + i0) * 2; float o[8];
#pragma unroll
            for (int j = 0; j < 4; ++j) { const float c = t[2 * j], sn = t[2 * j + 1], x1 = f[2 * j], x2 = f[2 * j + 1]; o[2 * j] = x1 * c - x2 * sn; o[2 * j + 1] = x1 * sn + x2 * c; }
            const u32x4 pk = pack8(o);
            if (!meta) { for (int h = 0; h < 4; ++h) *(u32x4*)(km + ((size_t)(b * 4 + h) * LKP + key) * 192 + 128 + 8 * (lane - 48)) = pk; }
            else { for (int bb = 0; bb < NB; ++bb) for (int h = 0; h < 4; ++h) *(u32x4*)(km + ((size_t)(bb * 4 + h) * LKP + key) * 192 + 128 + 8 * (lane - 48)) = pk; }
        }
    }
    const int p0 = (lane & 15) * 8, half = p0 >> 6, i0 = (p0 & 63) >> 1;
    const int apos = half ? pcol : prow; const float* t = rope + ((size_t)(apos + 1) * 32 + i0) * 2;
    if (!meta) {
        float f[8]; unpack8(wB, f);
        float ss = 0.f;
#pragma unroll
        for (int j = 0; j < 8; ++j) ss += f[j] * f[j];
        ss += __shfl_xor(ss, 1); ss += __shfl_xor(ss, 2); ss += __shfl_xor(ss, 4); ss += __shfl_xor(ss, 8);
        const float rs = rsq(ss * (1.f / 128) + RMS_EPS); float o[8];
#pragma unroll
        for (int j = 0; j < 4; ++j) { const int d1 = half * 64 + i0 + j, d2 = d1 + 32;
            const float x1 = f[2 * j] * rs * g_q_gqa[d1], x2 = f[2 * j + 1] * rs * g_q_gqa[d2], c = t[2 * j], sn = t[2 * j + 1];
            o[2 * j] = x1 * c - x2 * sn; o[2 * j + 1] = x1 * sn + x2 * c; }
        *(u32x4*)(qg + ((size_t)(b * 4 + (lane >> 4)) * 2048 + s) * 128 + p0) = pack8(o);
    }
    {
        float f[8]; unpack8(wC, f);
        float ss = 0.f;
#pragma unroll
        for (int j = 0; j < 8; ++j) ss += f[j] * f[j];
        ss += __shfl_xor(ss, 1); ss += __shfl_xor(ss, 2); ss += __shfl_xor(ss, 4); ss += __shfl_xor(ss, 8);
        float o[8];
        if (lane < 32) { const float rs = rsq(ss * (1.f / 128) + RMS_EPS);
#pragma unroll
            for (int j = 0; j < 4; ++j) { const int d1 = half * 64 + i0 + j, d2 = d1 + 32;
                const float x1 = f[2 * j] * rs * g_k_gqa[d1], x2 = f[2 * j + 1] * rs * g_k_gqa[d2], c = t[2 * j], sn = t[2 * j + 1];
                o[2 * j] = x1 * c - x2 * sn; o[2 * j + 1] = x1 * sn + x2 * c; }
        } else {
#pragma unroll
            for (int j = 0; j < 8; ++j) o[j] = f[j];
        }
        const u32x4 pk = pack8(o); bf16* dst = lane < 32 ? kg : vg; const int hk = (lane >> 4) & 1;
        if (!meta) *(u32x4*)(dst + ((size_t)(b * 2 + hk) * LKP + key) * 128 + p0) = pk;
        else for (int bb = 0; bb < NB; ++bb) *(u32x4*)(dst + ((size_t)(bb * 2 + hk) * LKP + key) * 128 + p0) = pk;
    }
}

__device__ __forceinline__ int crow(int r, int hi) { return (r & 3) + 8 * (r >> 2) + 4 * hi; }
__device__ __forceinline__ int v_st(int k, int c) { const int kk = (k & ~0xC) | ((k & 4) << 1) | ((k & 8) >> 1); return ((kk >> 3) * 4 + (c >> 5)) * 512 + ((kk & 7) * 32 + (c & 31)) * 2; }
__device__ __forceinline__ int v_rd_base(int lane) { return ((lane & 3) << 3) | (((lane >> 2) & 3) << 6) | (((lane >> 4) & 1) << 5) | (((lane >> 5) & 1) << 8); }
constexpr int v_rd_off(int d0, int ks, int half) { return d0 * 512 + ks * 4096 + half * 2048; }
template <int OFF> __device__ __forceinline__ s16x4 tr_read(int vb) {
    s16x4 r; asm volatile("ds_read_b64_tr_b16 %0, %1 offset:%2" : "=&v"(r) : "v"(vb), "i"(OFF) : "memory"); return r;
}
template <int D0> __device__ __forceinline__ void pv_one(f32x16& od, int vb, bf16x8 pa0, bf16x8 pa1, bf16x8 pa2, bf16x8 pa3) {
    const s16x4 l0 = tr_read<v_rd_off(D0, 0, 0)>(vb), h0 = tr_read<v_rd_off(D0, 0, 1)>(vb), l1 = tr_read<v_rd_off(D0, 1, 0)>(vb), h1 = tr_read<v_rd_off(D0, 1, 1)>(vb);
    const s16x4 l2 = tr_read<v_rd_off(D0, 2, 0)>(vb), h2 = tr_read<v_rd_off(D0, 2, 1)>(vb), l3 = tr_read<v_rd_off(D0, 3, 0)>(vb), h3 = tr_read<v_rd_off(D0, 3, 1)>(vb);
    asm volatile("s_waitcnt lgkmcnt(0)" ::: "memory"); SBAR();
#define PK(L, H) (bf16x8){L[0], L[1], L[2], L[3], H[0], H[1], H[2], H[3]}
    od = __builtin_amdgcn_mfma_f32_32x32x16_bf16(pa0, PK(l0, h0), od, 0, 0, 0);
    od = __builtin_amdgcn_mfma_f32_32x32x16_bf16(pa1, PK(l1, h1), od, 0, 0, 0);
    od = __builtin_amdgcn_mfma_f32_32x32x16_bf16(pa2, PK(l2, h2), od, 0, 0, 0);
    od = __builtin_amdgcn_mfma_f32_32x32x16_bf16(pa3, PK(l3, h3), od, 0, 0, 0);
#undef PK
}
__device__ __forceinline__ void pv_d0(f32x16* o, int vb, bf16x8 pa0, bf16x8 pa1, bf16x8 pa2, bf16x8 pa3) {
    pv_one<0>(o[0], vb, pa0, pa1, pa2, pa3); pv_one<1>(o[1], vb, pa0, pa1, pa2, pa3); pv_one<2>(o[2], vb, pa0, pa1, pa2, pa3); pv_one<3>(o[3], vb, pa0, pa1, pa2, pa3);
}
template <int DQK> struct AttnC {
    static constexpr float SCALE = DQK == 192 ? 0.07216878364870322f : 0.08838834764831845f;
    static constexpr float C = SCALE * 1.4426950408889634f, THRS = 8.f / SCALE;
};
template <int DQK>
__device__ __forceinline__ void partialSM(f32x16& p0, f32x16& p1, float& m_reg, float& mn, float& alpha) {
    constexpr float C = AttnC<DQK>::C;
    float pmax = p0[0];
#pragma unroll
    for (int r = 1; r < 16; ++r) pmax = fmaxf(pmax, p0[r]);
#pragma unroll
    for (int r = 0; r < 16; ++r) pmax = fmaxf(pmax, p1[r]);
    { auto rr = __builtin_amdgcn_permlane32_swap(__float_as_uint(pmax), __float_as_uint(pmax), false, false);
      pmax = fmaxf(__uint_as_float(rr[0]), __uint_as_float(rr[1])); }
    if (__builtin_expect(__all(pmax - m_reg <= AttnC<DQK>::THRS), 1)) { mn = m_reg; alpha = 1.f; }
    else { mn = fmaxf(m_reg, pmax); alpha = __builtin_amdgcn_exp2f((m_reg - mn) * C); m_reg = mn; }
    const float mnC = -mn * C;
#pragma unroll
    for (int r = 0; r < 16; ++r) p0[r] = fmaf(p0[r], C, mnC);
#pragma unroll
    for (int r = 0; r < 16; ++r) p1[r] = fmaf(p1[r], C, mnC);
#pragma unroll
    for (int r = 0; r < 16; ++r) p0[r] = __builtin_amdgcn_exp2f(p0[r]);
}
__device__ __forceinline__ void finishSM(f32x16& p0, f32x16& p1, float alpha, float& l_reg, bf16x8& pa0, bf16x8& pa1, bf16x8& pa2, bf16x8& pa3) {
#pragma unroll
    for (int r = 0; r < 16; ++r) p1[r] = __builtin_amdgcn_exp2f(p1[r]);
    float ps = 0;
#pragma unroll
    for (int r = 0; r < 16; ++r) ps += p0[r];
#pragma unroll
    for (int r = 0; r < 16; ++r) ps += p1[r];
    { auto rr = __builtin_amdgcn_permlane32_swap(__float_as_uint(ps), __float_as_uint(ps), false, false);
      ps = __uint_as_float(rr[0]) + __uint_as_float(rr[1]); }
    l_reg = l_reg * alpha + ps;
#define PK4(P, BASE, OUT) do { unsigned a0 = cvtpk(P[BASE + 0], P[BASE + 1]), a1 = cvtpk(P[BASE + 2], P[BASE + 3]);   \
    unsigned b0 = cvtpk(P[BASE + 4], P[BASE + 5]), b1 = cvtpk(P[BASE + 6], P[BASE + 7]);                              \
    auto r0 = __builtin_amdgcn_permlane32_swap(a0, b0, false, false); auto r1 = __builtin_amdgcn_permlane32_swap(a1, b1, false, false); \
    u32x4 w = {r0[0], r1[0], r0[1], r1[1]}; OUT = *reinterpret_cast<bf16x8*>(&w); } while (0)
    PK4(p0, 0, pa0); PK4(p0, 8, pa1); PK4(p1, 0, pa2); PK4(p1, 8, pa3);
#undef PK4
}
template <int DQK>
__device__ __forceinline__ void qkt(f32x16& p0, f32x16& p1, const LAS char* Ks, const bf16x8* qr, const LAS char* ql, const int (&ko)[4]) {
    constexpr int KRB = DQK * 2;
    p0 = f32x16{}; p1 = f32x16{};
#pragma unroll
    for (int d0 = 0; d0 < DQK / 16; ++d0) { const LAS char* kp = Ks + ko[d0 & 3] + (d0 >> 2) * 128;
        const bf16x8 b0 = *(const LAS bf16x8*)(kp);
        const bf16x8 b1 = *(const LAS bf16x8*)(kp + 32 * KRB);
        bf16x8 q; if (d0 < 8) q = qr[d0]; else q = *(const LAS bf16x8*)(ql + (d0 - 8) * 1024);
        p0 = __builtin_amdgcn_mfma_f32_32x32x16_bf16(b0, q, p0, 0, 0, 0);
        p1 = __builtin_amdgcn_mfma_f32_32x32x16_bf16(b1, q, p1, 0, 0, 0); }
}
template <int DQK, int SD>
__device__ __forceinline__ void attn_body(const bf16* __restrict__ Qb, const bf16* __restrict__ Kh, const bf16* __restrict__ Vh, bf16* __restrict__ Ob, LAS char* lds, const float* __restrict__ rope, int pos0) {
    constexpr int ND0 = DQK / 16, KRB = DQK * 2, SHM_K = 64 * KRB, SHM_V = 64 * 128 * 2, NKC = DQK / 64, CPR = DQK / 8, NT = LKP / 64;
    static_assert(NT % 2 == 1, "odd tile count: the tail below takes tiles NT-2 and NT-1");
    int tid = threadIdx.x; asm volatile("" : "+v"(tid));
    const int wid = tid >> 6, lane = tid & 63, r32 = lane & 31, hi = lane >> 5;
    LAS char* V_lds = lds; LAS char* K_lds = lds + 2 * SHM_V;
    __syncthreads();
    float m_reg = -1e30f, l_reg = 0; f32x16 o[4] = {}; bf16x8 qr[8];
    const bf16* Qw = Qb + (size_t)(wid * 32 + r32) * DQK + hi * 8;
#pragma unroll
    for (int d0 = 0; d0 < 8; ++d0) qr[d0] = *reinterpret_cast<const bf16x8*>(Qw + d0 * 16);
    LAS char* ql = lds + 2 * SHM_V + 2 * SHM_K + 2048 + wid * 4096 + lane * 16;
#pragma unroll
    for (int d0 = 8; d0 < ND0; ++d0) {
        float x[8], y[8]; unpack8(*reinterpret_cast<const u32x4*>(Qw + d0 * 16), x);
        const float* t = rope + ((size_t)(pos0 + wid * 32 + r32 + 1) * 32 + (d0 - 8) * 8 + hi * 4) * 2; const f32x4 t0 = *(const f32x4*)t, t1 = *(const f32x4*)(t + 4);
        const float cs[4] = {t0[0], t0[2], t1[0], t1[2]}, sn[4] = {t0[1], t0[3], t1[1], t1[3]};
#pragma unroll
        for (int j = 0; j < 4; ++j) { y[2 * j] = x[2 * j] * cs[j] - x[2 * j + 1] * sn[j]; y[2 * j + 1] = x[2 * j] * sn[j] + x[2 * j + 1] * cs[j]; }
        *(LAS u32x4*)(ql + (d0 - 8) * 1024) = pack8(y); }
    const int sr = tid >> 4, sc = (tid & 15) * 8, vst0 = v_st(sr, sc), vst1 = v_st(32 + sr, sc);
    int kst[NKC];
#pragma unroll
    for (int c = 0; c < NKC; ++c) { const int id = tid + 512 * c, kr = id / CPR, kc = (id - kr * CPR) * 8; kst[c] = kr * KRB + ((kc * 2) ^ ((kr & 7) << 4)); }
    const int voff = tid * 16;
    int ko[4];
#pragma unroll
    for (int q = 0; q < 4; ++q) ko[q] = r32 * KRB + ((q * 32 + hi * 16) ^ ((r32 & 7) << 4));
    const __amdgpu_buffer_rsrc_t rK = __builtin_amdgcn_make_buffer_rsrc((void*)Kh, 0, LKP * KRB, 0x00020000);
    const __amdgpu_buffer_rsrc_t rV = __builtin_amdgcn_make_buffer_rsrc((void*)Vh, 0, LKP * 256, 0x00020000);
    const int vb0 = (int)(unsigned)(uintptr_t)V_lds + v_rd_base(lane);
    struct { bf16x8 vs0, vs1, ks[NKC]; } sr_[SD];
#define SLOAD(i, k0) do { sr_[i].vs0 = __builtin_bit_cast(bf16x8, __builtin_amdgcn_raw_buffer_load_b128(rV, voff, (k0) * 256, 0)); sr_[i].vs1 = __builtin_bit_cast(bf16x8, __builtin_amdgcn_raw_buffer_load_b128(rV, voff, (k0) * 256 + 8192, 0)); \
    _Pragma("unroll") for (int c_ = 0; c_ < NKC; ++c_) sr_[i].ks[c_] = __builtin_bit_cast(bf16x8, __builtin_amdgcn_raw_buffer_load_b128(rK, voff, (k0) * KRB + c_ * 8192, 0)); } while (0)
#define SWRITE(b, i) do { *(LAS bf16x8*)(V_lds + (b) * SHM_V + vst0) = sr_[i].vs0; *(LAS bf16x8*)(V_lds + (b) * SHM_V + vst1) = sr_[i].vs1; \
    _Pragma("unroll") for (int c_ = 0; c_ < NKC; ++c_) *(LAS bf16x8*)(K_lds + (b) * SHM_K + kst[c_]) = sr_[i].ks[c_]; } while (0)
#define SWAIT() do { if constexpr (SD == 2) { if constexpr (NKC == 2) asm volatile("s_waitcnt vmcnt(4)" ::: "memory"); else asm volatile("s_waitcnt vmcnt(5)" ::: "memory"); } \
    else asm volatile("s_waitcnt vmcnt(0)" ::: "memory"); } while (0)
#define RESC(a) do { if (__any((a) < 1.f)) { int t_ = threadIdx.x; asm volatile("" : "+v"(t_)); const int r32_ = t_ & 31, hi_2 = (t_ >> 5) & 1; \
    LAS float* al_ = (LAS float*)(lds + 2 * SHM_V + 2 * SHM_K) + (t_ >> 6) * 64 + 32; if (hi_2 == 0) al_[r32_] = (a); asm volatile("s_waitcnt lgkmcnt(0)" ::: "memory"); \
    _Pragma("unroll") for (int d = 0; d < 4; ++d) _Pragma("unroll") for (int r = 0; r < 16; ++r) o[d][r] *= al_[crow(r, hi_2)]; } } while (0)
    f32x16 pA0, pA1, pB0, pB1; float mnA, mnB, alA, alB; bf16x8 pa0, pa1, pa2, pa3;
    constexpr int SE = 0, SO = SD - 1;
    SLOAD(SE, 0); asm volatile("s_waitcnt vmcnt(0)" ::: "memory"); SWRITE(0, SE); __syncthreads();
    qkt<DQK>(pA0, pA1, K_lds, qr, ql, ko); partialSM<DQK>(pA0, pA1, m_reg, mnA, alA);
    SLOAD(SO, 64); if constexpr (SD == 2) { SLOAD(SE, 128); }
    SWAIT(); SWRITE(1, SO); __syncthreads();
#pragma unroll 1
    for (int j = 1; j + 2 < NT; j += 2) {
        SBAR(); qkt<DQK>(pB0, pB1, K_lds + SHM_K, qr, ql, ko);
        finishSM(pA0, pA1, alA, l_reg, pa0, pa1, pa2, pa3); SBAR();
        SLOAD(SO, (j + SD) * 64); SBAR();
        pv_d0(o, vb0, pa0, pa1, pa2, pa3); partialSM<DQK>(pB0, pB1, m_reg, mnB, alB);
        __syncthreads(); SWAIT(); SWRITE(0, SE);
        RESC(alB); __syncthreads();
        SBAR(); qkt<DQK>(pA0, pA1, K_lds, qr, ql, ko);
        finishSM(pB0, pB1, alB, l_reg, pa0, pa1, pa2, pa3); SBAR();
        SLOAD(SE, (j + 1 + SD) * 64); SBAR();
        pv_d0(o, vb0 + SHM_V, pa0, pa1, pa2, pa3); partialSM<DQK>(pA0, pA1, m_reg, mnA, alA);
        __syncthreads(); SWAIT(); SWRITE(1, SO);
        RESC(alA); __syncthreads();
    }
    SBAR(); qkt<DQK>(pB0, pB1, K_lds + SHM_K, qr, ql, ko);
    finishSM(pA0, pA1, alA, l_reg, pa0, pa1, pa2, pa3); SBAR();
    if constexpr (SD == 1) { SLOAD(SE, (NT - 1) * 64); } SBAR();
    pv_d0(o, vb0, pa0, pa1, pa2, pa3); partialSM<DQK>(pB0, pB1, m_reg, mnB, alB);
    __syncthreads(); asm volatile("s_waitcnt vmcnt(0)" ::: "memory"); SWRITE(0, SE);
    RESC(alB); __syncthreads();
    SBAR(); qkt<DQK>(pA0, pA1, K_lds, qr, ql, ko);
#pragma unroll
    for (int r = 8; r < 16; ++r) pA0[r] = -1e30f;
#pragma unroll
    for (int r = 0; r < 16; ++r) pA1[r] = -1e30f;
    finishSM(pB0, pB1, alB, l_reg, pa0, pa1, pa2, pa3); SBAR();
    pv_d0(o, vb0 + SHM_V, pa0, pa1, pa2, pa3); partialSM<DQK>(pA0, pA1, m_reg, mnA, alA);
    RESC(alA);
    finishSM(pA0, pA1, alA, l_reg, pa0, pa1, pa2, pa3); SBAR();
    pv_d0(o, vb0, pa0, pa1, pa2, pa3);
    { int t_ = threadIdx.x; asm volatile("" : "+v"(t_)); const int r32_ = t_ & 31, hi_2 = (t_ >> 5) & 1, wid_ = t_ >> 6;
      LAS float* li_ = (LAS float*)(lds + 2 * SHM_V + 2 * SHM_K) + wid_ * 64;
      if (hi_2 == 0) li_[r32_] = l_reg; asm volatile("s_waitcnt lgkmcnt(0)" ::: "memory");
      float rli[16];
#pragma unroll
      for (int r = 0; r < 16; ++r) rli[r] = __builtin_amdgcn_rcpf(li_[crow(r, hi_2)]);
      bf16* Ow = Ob + (size_t)(wid_ * 32) * DM;
#pragma unroll
      for (int r = 0; r < 16; ++r) { const int orow = crow(r, hi_2);
#pragma unroll
          for (int d0 = 0; d0 < 4; ++d0) Ow[(size_t)orow * DM + d0 * 32 + r32_] = (bf16)(cvtpk(o[d0][r] * rli[r], 0.f) & 0xffffu); } }
#undef SLOAD
#undef SWRITE
#undef SWAIT
#undef RESC
}

constexpr int NPHASE = 14;
struct Args { const float* in[24]; float* out; unsigned char* ws; int ph_lo, ph_hi; };
__global__ void __launch_bounds__(NWAVES * 64, 2) hymba_fwd(Args args) {
    extern __shared__ __attribute__((aligned(16))) unsigned char lds[];
    { int t0 = threadIdx.x; asm volatile("" : "+v"(t0)); for (int u = t0; u < 1024; u += NWAVES * 64) ((LAS unsigned*)((LAS unsigned char*)lds + LDSCTL_OFF))[u] = 0u; }
    __syncthreads();
#define XB_OBJ(b_) XcdBarrier b_; { const CAS unsigned char* kq_ = (const CAS unsigned char*)__builtin_amdgcn_kernarg_segment_ptr(); asm volatile("" : "+s"(kq_)); \
    b_.bar = (unsigned*)(*(unsigned char* const CAS*)(kq_ + 200) + WS_CTL) + CW_BAR; b_.x = xb_xcc_id(); b_.st = (volatile LAS unsigned*)((LAS unsigned char*)lds + LDSCTL_OFF) + 8; }
#if !MK_SPLIT
    { XB_OBJ(b0_); (void)xcd_barrier_post(b0_.bar, b0_.st); }
#define GRID_BAR() do { XB_OBJ(bb_); xcd_barrier(bb_); } while (0)
#else
#define GRID_BAR() do {} while (0)
#endif
    const int lo = args.ph_lo, hi_ = args.ph_hi;
#ifndef REP_MASK
#define REP_MASK 0
#endif
#define IN(k) (lo <= (k) && (k) < hi_)
#define REPS(k) (((REP_MASK >> (k)) & 1) ? 2 : 1)
#define SEAM(k) do { if (IN(k) && IN((k) + 1)) GRID_BAR(); } while (0)

#define PTRS \
    int bx = blockIdx.x; asm volatile("" : "+s"(bx)); const int G = gridDim.x, vcu = (G % 8 == 0) ? (bx % 8) * (G / 8) + bx / 8 : bx; \
    const int tid = threadIdx.x, lane = tid & 63, wave = __builtin_amdgcn_readfirstlane(tid >> 6); \
    const int gw = vcu * NWAVES + wave, ngw = G * NWAVES, gtid = vcu * (NWAVES * 64) + tid, ngt = G * NWAVES * 64; (void)gw; (void)ngw; (void)gtid; (void)ngt; (void)lane; \
    const CAS unsigned char* kp_ = (const CAS unsigned char*)__builtin_amdgcn_kernarg_segment_ptr(); asm volatile("" : "+s"(kp_)); \
    const float* const CAS* kin = (const float* const CAS*)kp_; unsigned char* ws = *(unsigned char* const CAS*)(kp_ + 200); float* outp = *(float* const CAS*)(kp_ + 192); (void)outp; (void)kin; \
    const float* x = kin[0]; const float* meta_tok = kin[1]; \
    float* rope = (float*)(ws + WS_ROPE); \
    bf16* w_in_t = (bf16*)(ws + WS_WIN); bf16* w_qb_t = (bf16*)(ws + WS_WQB); bf16* w_kvb_t = (bf16*)(ws + WS_WKVB); bf16* w_o_t = (bf16*)(ws + WS_WO); \
    bf16* w_r_t = (bf16*)(ws + WS_WR); unsigned char* w_gu8 = ws + WS_WGU; unsigned char* w_dn8 = ws + WS_WDN; unsigned char* h1f8 = ws + WS_H1F8; \
    bf16* h0 = (bf16*)(ws + WS_H0); bf16* h1 = (bf16*)(ws + WS_H1); float* rs_q = (float*)(ws + WS_QAN); float* rs_kv = rs_q + MPAD; bf16* z = (bf16*)(ws + WS_Z); \
    bf16* qm = (bf16*)(ws + WS_QM); bf16* km = (bf16*)(ws + WS_KM); bf16* vm = (bf16*)(ws + WS_VM); bf16* qg = (bf16*)(ws + WS_QG); bf16* kg = (bf16*)(ws + WS_KG); bf16* vg = (bf16*)(ws + WS_VG); \
    bf16* ob = (bf16*)(ws + WS_O); bf16* y1 = (bf16*)(ws + WS_Y1); float* logits = (float*)(ws + WS_LOGITS); \
    int* topk = (int*)(ws + WS_TOPK); float* gate = (float*)(ws + WS_GATE); int* pair_pos = (int*)(ws + WS_PAIRPOS); float* row_gate = (float*)(ws + WS_ROWGATE); \
    int* hist = (int*)(ws + WS_HIST); int* moetab = (int*)(ws + WS_MOETAB); int* tile_expert = moetab + 256; \
    unsigned char* xs8 = ws + WS_XS; unsigned char* act8 = ws + WS_ACT; bf16* out2 = (bf16*)(ws + WS_OUT2);


    for (int rep_ = 0; rep_ < (IN(0) ? REPS(0) : 0); ++rep_) { if (rep_) GRID_BAR(); PTRS;
        LAS float* scr = (LAS float*)((LAS unsigned char*)lds + wave * 16384);
        constexpr int I_IN = 16 * 46, I_QB = 4 * 24, I_KVB = 4 * 32, I_O = 16 * 32, I_R = 16;
        constexpr int NITEMS = I_IN + I_QB + I_KVB + I_O + I_R;
        for (int it = gw; it < NITEMS; it += ngw) {
            int r = it;
            if (r < I_IN) { transpose_item(kin[4], 1024, NIN, w_in_t, scr, r, lane, MapIn()); continue; } r -= I_IN;
            if (r < I_QB) { transpose_item(kin[6], 256, 768, w_qb_t, scr, r, lane, MapQ(), kin[5]); continue; } r -= I_QB;
            if (r < I_KVB) { transpose_item(kin[8], 128, 1024, w_kvb_t, scr, r, lane, MapId(), kin[7], 256); continue; } r -= I_KVB;
            if (r < I_O) { transpose_item(kin[13], 1024, 1024, w_o_t, scr, r, lane, MapId()); continue; } r -= I_O;
            transpose_item(kin[16], 1024, 32, w_r_t, scr, r, lane, MapId());
        }
        transpose_f8_stream(kin[18], 2048, w_gu8, scr, gw, ngw, lane, MapGU(), W8_SCALE);
        transpose_f8_stream(kin[20], 1024, w_dn8, scr, gw, ngw, lane, MapId(), W8_SCALE);
        { f32x4 gg[4], bb[4], cv[4], nv[4];
#pragma unroll
          for (int j = 0; j < 4; ++j) { gg[j] = ((const f32x4*)kin[2])[lane + 64 * j]; bb[j] = ((const f32x4*)kin[3])[lane + 64 * j]; }
#define LN_LOAD(dst, m_) do { const float* xr_ = (m_) < NTOK ? x + (size_t)(m_) * DM : meta_tok + (size_t)((m_) - NTOK) * DM; _Pragma("unroll") for (int j = 0; j < 4; ++j) dst[j] = ((const f32x4*)xr_)[lane + 64 * j]; } while (0)
          if (gw < MROWS) LN_LOAD(cv, gw);
          for (int m = gw; m < MROWS; m += ngw) { const int mn = m + ngw < MROWS ? m + ngw : m; LN_LOAD(nv, mn);
              ln_row_f32_to_bf16(cv, gg, bb, h0 + (size_t)m * DM, lane);
#pragma unroll
              for (int j = 0; j < 4; ++j) cv[j] = nv[j]; }
#undef LN_LOAD
        }
        zero_bytes(h0 + (size_t)MROWS * DM, (size_t)(MPAD - MROWS) * DM * 2, gtid, ngt);
        zero_bytes(w_in_t + (size_t)NIN * 1024, (size_t)(ZLD - NIN) * 1024 * 2, gtid, ngt);
        for (int i = gw; i < 64 + 64 + 32 + 32; i += ngw) {
            bf16* p; size_t rb;
            if (i < 64) { p = km + ((size_t)i * LKP + 2064) * 192; rb = 48 * 192 * 2; }
            else if (i < 128) { p = vm + ((size_t)(i - 64) * LKP + 2064) * 128; rb = 48 * 128 * 2; }
            else if (i < 160) { p = kg + ((size_t)(i - 128) * LKP + 2064) * 128; rb = 48 * 128 * 2; }
            else { p = vg + ((size_t)(i - 160) * LKP + 2064) * 128; rb = 48 * 128 * 2; }
            zero_bytes(p, rb, lane, 64);
        }
        for (int i = gtid; i < 2065 * 32; i += ngt) {
            const int p = i / 32 - 1, f = i & 31; double inv = 1.0;
            for (int q = 0; q < f; ++q) inv *= 0.74989420933245582730;
            const float ang = (float)p * (float)inv; float sn, cs; sincos_d(fabsf(ang), sn, cs); if (ang < 0.f) sn = -sn;
            rope[2 * i] = cs; rope[2 * i + 1] = sn;
        }
    }
    SEAM(0);
    for (int rep_ = 0; rep_ < (IN(1) ? REPS(1) : 0); ++rep_) { if (rep_) GRID_BAR(); PTRS; EpiZ E{z};
#if FAST_Z
        { pg8::Gemm g{h0, w_in_t, NTOK, ZLD, 1024, 1024}; pg8::StaticOrder S; S.init(NTOK, ZLD, G, bx); pg8::EpiAdapt<EpiZ> EA{E, 0};
          pg8::gemm_phase<pg8::EpiAdapt<EpiZ>, pg8::StaticOrder, true, true>((LAS unsigned char*)lds, g, S, EA); }
        meta_gemm16<1024>(h0, 1024, w_in_t, NTOK, ZLD, E, gw, ngw, lane);
#else
        simple_gemm(h0, w_in_t, 1024, 0, NTOK + 64, ZLD, E, BSelNone(), gw, ngw, lane);
#endif
    }
    SEAM(1);
    for (int rep_ = 0; rep_ < (IN(2) ? REPS(2) : 0); ++rep_) { if (rep_) GRID_BAR(); PTRS;
#define P2_LOAD(m_, a_, b_, c_) do { const bf16* zr_ = z + (size_t)(m_) * ZLD; a_ = (u32x4){0u, 0u, 0u, 0u}; if (lane < 56) a_ = *(const u32x4*)(zr_ + 8 * lane); b_ = *(const u32x4*)(zr_ + 448 + 8 * lane); c_ = *(const u32x4*)(zr_ + 960 + 8 * lane); } while (0)
        u32x4 wa, wb, wc, na, nb, nc; if (gw < MROWS) P2_LOAD(gw, wa, wb, wc);
        for (int m = gw; m < MROWS; m += ngw) { const int mn = m + ngw < MROWS ? m + ngw : m; P2_LOAD(mn, na, nb, nc);
            p2a_row(m, wa, wb, wc, rope, kin[5], kin[7], kin[9], kin[10], rs_q, rs_kv, km, qg, kg, vg, lane); wa = na; wb = nb; wc = nc; }
#undef P2_LOAD
    }
    SEAM(2);
    for (int rep_ = 0; rep_ < (IN(3) ? REPS(3) : 0); ++rep_) { if (rep_) GRID_BAR(); PTRS;
        { EpiQ E{qm, rs_q}; pg8::Gemm g{z, w_qb_t, NTOK, 768, 256, ZLD}; pg8::StaticOrder S; S.init(NTOK, 768, G, bx); pg8::EpiAdapt<EpiQ> EA{E, 0};
          pg8::gemm_phase<pg8::EpiAdapt<EpiQ>, pg8::StaticOrder, true, true>((LAS unsigned char*)lds, g, S, EA); }
        { EpiKV<false> E{km, vm, rs_kv}; pg8::Gemm g{z + 256, w_kvb_t, NTOK, 1024, 256, ZLD}; pg8::StaticOrder S; S.init(NTOK, 1024, G, bx); pg8::EpiAdapt<EpiKV<false>> EA{E, 0};
          pg8::gemm_phase<pg8::EpiAdapt<EpiKV<false>>, pg8::StaticOrder, true, true>((LAS unsigned char*)lds, g, S, EA);
          EpiKV<true> EM{km, vm, rs_kv}; meta_gemm16<256>(z + 256, ZLD, w_kvb_t, NTOK, 1024, EM, gw, ngw, lane); }
    }
    SEAM(3);
    for (int rep_ = 0; rep_ < (IN(4) ? REPS(4) : 0); ++rep_) { if (rep_) GRID_BAR(); PTRS;
        for (int u = vcu; u < 1024; u += G) {
            if (u < 512) { const int b = u >> 5, h = (u >> 3) & 3, qb = u & 7, bh = b * 4 + h;
                attn_body<192, 1>(qm + ((size_t)bh * 2048 + qb * 256) * 192, km + (size_t)bh * LKP * 192, vm + (size_t)bh * LKP * 128, ob + ((size_t)b * 2048 + qb * 256) * DM + h * 128, (LAS char*)lds, rope, 16 + qb * 256);
            } else { const int v = u - 512, b = v >> 5, h = (v >> 3) & 3, qb = v & 7, bh = b * 4 + h, bk = b * 2 + (h >> 1);
                attn_body<128, 2>(qg + ((size_t)bh * 2048 + qb * 256) * 128, kg + (size_t)bk * LKP * 128, vg + (size_t)bk * LKP * 128, ob + ((size_t)b * 2048 + qb * 256) * DM + 512 + h * 128, (LAS char*)lds, rope, 0);
            }
        }
    }
    SEAM(4);
    for (int rep_ = 0; rep_ < (IN(5) ? REPS(5) : 0); ++rep_) { if (rep_) GRID_BAR(); PTRS;
        for (int m = gw; m < NTOK; m += ngw) {
#pragma unroll
            for (int g = 0; g < 2; ++g) { bf16* p = ob + (size_t)m * DM + g * 512 + 8 * lane; float f[8]; unpack8(*(const u32x4*)p, f);
                float ss = 0.f;
#pragma unroll
                for (int j = 0; j < 8; ++j) ss += f[j] * f[j];
                const float rs = rsq(wave_sum(ss) * (1.f / 512) + RMS_EPS); const float* gg = (g ? kin[12] : kin[11]) + 8 * lane;
#pragma unroll
                for (int j = 0; j < 8; ++j) f[j] = f[j] * rs * gg[j];
                *(u32x4*)p = pack8(f); }
        }
    }
    SEAM(5);
    for (int rep_ = 0; rep_ < (IN(6) ? REPS(6) : 0); ++rep_) { if (rep_) GRID_BAR(); PTRS; EpiO E{y1, h0};
#if FAST_O
        pg8::Gemm g{ob, w_o_t, NTOK, 1024, 1024, 1024}; pg8::StaticOrder S; S.init(NTOK, 1024, G, bx); pg8::EpiAdapt<EpiO> EA{E, 0};
        pg8::gemm_phase<pg8::EpiAdapt<EpiO>, pg8::StaticOrder, true, true>((LAS unsigned char*)lds, g, S, EA);
#else
        simple_gemm(ob, w_o_t, 1024, 0, NTOK, 1024, E, BSelNone(), gw, ngw, lane);
#endif
    }
    SEAM(6);
    for (int rep_ = 0; rep_ < (IN(7) ? REPS(7) : 0); ++rep_) { if (rep_) GRID_BAR(); PTRS; f32x4 G4[4], B4[4];
#pragma unroll
        for (int hf = 0; hf < 2; ++hf) { const int c = hf * 512 + 8 * lane; G4[2 * hf] = *(const f32x4*)(kin[14] + c); G4[2 * hf + 1] = *(const f32x4*)(kin[14] + c + 4); B4[2 * hf] = *(const f32x4*)(kin[15] + c); B4[2 * hf + 1] = *(const f32x4*)(kin[15] + c + 4); }
        for (int m = gw; m < NTOK; m += ngw) ln_row_bf16(y1 + (size_t)m * DM, G4, B4, h1 + (size_t)m * DM, h1f8 + (size_t)m * DM, lane); }
    SEAM(7);
#ifndef MOE_SKEW_TICKS
#define MOE_SKEW_TICKS 0
#endif
#define MOE_STAGGER(nunits) do { const int rem_ = (nunits) % G; if (MOE_SKEW_TICKS > 0 && rem_ != 0 && bx >= rem_) { const unsigned long long t0_ = __builtin_amdgcn_s_memrealtime(), w_ = (unsigned long long)(MOE_SKEW_TICKS * ((bx - rem_) % 3 + 1)); \
    while (__builtin_amdgcn_s_memrealtime() - t0_ < w_) __builtin_amdgcn_s_sleep(16); } } while (0)
#define ROUTE_VARS const int tpb = (NTOK + G - 1) / G, tok_lo = bx * tpb, tok_hi = (tok_lo + tpb < NTOK) ? tok_lo + tpb : NTOK; \
    LAS int* L_hist = (LAS int*)((LAS unsigned char*)lds + LDSCTL_OFF + 256); LAS int* L_n = L_hist + 32; LAS int* L_base = L_hist + 64; LAS int* L_off = L_hist + 96; (void)L_n; (void)L_base; (void)L_off;
    for (int rep_ = 0; rep_ < (IN(8) ? REPS(8) : 0); ++rep_) { if (rep_) GRID_BAR(); PTRS; ROUTE_VARS;
        constexpr int WRP = 2064;
        LAS unsigned char* L_wr = (LAS unsigned char*)lds;
        for (int i = tid; i < 32 * 128; i += NWAVES * 64) { const int r = i >> 7, c = i & 127; *(LAS u32x4*)(L_wr + r * WRP + c * 16) = *(const u32x4*)(w_r_t + (size_t)r * 1024 + c * 8); }
        if (tid < 32) L_hist[tid] = 0;
        __syncthreads();
        const int fr = lane & 15, fq = lane >> 4;
        for (int rb = tok_lo + wave * 16; rb < tok_hi; rb += NWAVES * 16) {
            const int row = rb + fr < NTOK ? rb + fr : NTOK - 1;
            const bf16* ap = h1 + (size_t)row * DM + fq * 8;
            bf16x8 a[32];
#pragma unroll
            for (int ks = 0; ks < 32; ++ks) a[ks] = *(const bf16x8*)(ap + ks * 32);
            f32x4 acc0 = {0.f, 0.f, 0.f, 0.f}, acc1 = {0.f, 0.f, 0.f, 0.f};
            const LAS unsigned char* bp = L_wr + (8 * (fr >> 2) + (fr & 3)) * WRP + fq * 16;
#pragma unroll
            for (int ks = 0; ks < 32; ++ks) { const bf16x8 b0 = *(const LAS bf16x8*)(bp + ks * 64), b1 = *(const LAS bf16x8*)(bp + 4 * WRP + ks * 64);
                acc0 = __builtin_amdgcn_mfma_f32_16x16x32_bf16(b0, a[ks], acc0, 0, 0, 0); acc1 = __builtin_amdgcn_mfma_f32_16x16x32_bf16(b1, a[ks], acc1, 0, 0, 0); }
            const float* br = kin[17] + 8 * fq; const f32x4 bb0 = *(const f32x4*)br, bb1 = *(const f32x4*)(br + 4);
            float v[8] = {acc0[0] + bb0[0], acc0[1] + bb0[1], acc0[2] + bb0[2], acc0[3] + bb0[3], acc1[0] + bb1[0], acc1[1] + bb1[1], acc1[2] + bb1[2], acc1[3] + bb1[3]};
            float tv[4]; int ti[4];
#pragma unroll
            for (int r = 0; r < 4; ++r) { float bv = v[0]; int bi = 8 * fq;
#pragma unroll
                for (int j = 1; j < 8; ++j) if (v[j] > bv) { bv = v[j]; bi = 8 * fq + j; }
#pragma unroll
                for (int off = 16; off <= 32; off <<= 1) { const float ov = __shfl_xor(bv, off); const int oi = __shfl_xor(bi, off); if (ov > bv || (ov == bv && oi < bi)) { bv = ov; bi = oi; } }
                tv[r] = bv; ti[r] = bi;
#pragma unroll
                for (int j = 0; j < 8; ++j) if (bi == 8 * fq + j) v[j] = -INFINITY; }
            const float e1 = __expf(tv[1] - tv[0]), e2 = __expf(tv[2] - tv[0]), e3 = __expf(tv[3] - tv[0]), inv = 1.f / (1.f + e1 + e2 + e3);
            if (fq == 0 && rb + fr < tok_hi) { const int t = rb + fr; *(int4*)(topk + (size_t)t * 4) = make_int4(ti[0], ti[1], ti[2], ti[3]); *(f32x4*)(gate + (size_t)t * 4) = (f32x4){inv, e1 * inv, e2 * inv, e3 * inv};
                atomicAdd((int*)(L_hist + ti[0]), 1); atomicAdd((int*)(L_hist + ti[1]), 1); atomicAdd((int*)(L_hist + ti[2]), 1); atomicAdd((int*)(L_hist + ti[3]), 1); }
        }
        __syncthreads();
        if (tid < 32) hist[bx * 32 + tid] = L_hist[tid];
    }
    SEAM(8);
    for (int rep_ = 0; rep_ < (IN(10) ? REPS(10) : 0); ++rep_) { if (rep_) GRID_BAR(); PTRS; ROUTE_VARS;
        if (tid < 32) { int tot = 0, before = 0; for (int b = 0; b < G; ++b) { const int h = hist[b * 32 + tid]; tot += h; if (b < bx) before += h; } L_n[tid] = tot; L_base[tid] = before; L_hist[tid] = 0; }
        __syncthreads();
        if (tid == 0) { int off = 0; for (int e = 0; e < NE; ++e) { L_off[e] = off; off += (L_n[e] + 255) & ~255; } L_off[NE] = off; }
        __syncthreads();
        LAS int* L_pos = (LAS int*)((LAS unsigned char*)lds);
        for (int p = tok_lo * 4 + tid; p < tok_hi * 4; p += NWAVES * 64) { const int e = topk[p]; const int r = atomicAdd((int*)(L_hist + e), 1); const int pos = L_off[e] + L_base[e] + r;
            row_gate[pos] = gate[p]; pair_pos[p] = pos; L_pos[p - tok_lo * 4] = pos; }
        __syncthreads();
        for (int p0 = tok_lo * 4 + wave; p0 < tok_hi * 4; p0 += NWAVES * 8) {
            u32x4 v[8]; int pos[8];
#pragma unroll
            for (int j = 0; j < 8; ++j) { const int p = p0 + j * NWAVES; pos[j] = p < tok_hi * 4 ? L_pos[p - tok_lo * 4] : -1; if (pos[j] >= 0) v[j] = ((const u32x4*)(h1f8 + (size_t)(p >> 2) * DM))[lane]; }
#pragma unroll
            for (int j = 0; j < 8; ++j) if (pos[j] >= 0) ((u32x4*)(xs8 + (size_t)pos[j] * DM))[lane] = v[j];
        }
        if (bx == 0) { if (tid == 0) moetab[0] = L_off[NE];
            if (tid < 32) { moetab[64 + tid] = L_n[tid]; moetab[128 + tid] = L_off[tid]; for (int t = L_off[tid] >> 8; t < (L_off[tid + 1] >> 8); ++t) tile_expert[t] = tid; } }
        __syncthreads();
    }
    SEAM(10);
    for (int rep_ = 0; rep_ < (IN(11) ? REPS(11) : 0); ++rep_) { if (rep_) GRID_BAR(); PTRS; const int rows = moetab[0]; EpiGU8 E{act8, kin[19]};
        pg8::Gemm g{(const bf16*)xs8, (const bf16*)w_gu8, rows, 2048, 512, 512}; pg8::MoeOrder S; S.init(rows >> 8, 8, G, bx, tile_expert);
        MOE_STAGGER((rows >> 8) * 8);
        pg8::gemm_phase<EpiGU8, pg8::MoeOrder, true, true, true>((LAS unsigned char*)lds, g, S, E);
    }
    SEAM(11);
    for (int rep_ = 0; rep_ < (IN(12) ? REPS(12) : 0); ++rep_) { if (rep_) GRID_BAR(); PTRS; const int rows = moetab[0]; EpiDN8 E{out2, kin[21], row_gate};
        pg8::Gemm g{(const bf16*)act8, (const bf16*)w_dn8, rows, 1024, 512, 512}; pg8::MoeOrder S; S.init(rows >> 8, 4, G, bx, tile_expert);
        MOE_STAGGER((rows >> 8) * 4);
        pg8::gemm_phase<EpiDN8, pg8::MoeOrder, true, true, true>((LAS unsigned char*)lds, g, S, E);
    }
    SEAM(12);
    for (int rep_ = 0; rep_ < (IN(13) ? REPS(13) : 0); ++rep_) { if (rep_) GRID_BAR(); PTRS;
        f32x4 G4[4], B4[4];
#pragma unroll
        for (int hf = 0; hf < 2; ++hf) { const int c = hf * 512 + 8 * lane; G4[2 * hf] = *(const f32x4*)(kin[22] + c); G4[2 * hf + 1] = *(const f32x4*)(kin[22] + c + 4); B4[2 * hf] = *(const f32x4*)(kin[23] + c); B4[2 * hf + 1] = *(const f32x4*)(kin[23] + c + 4); }
        int4 pp = gw < NTOK ? *(const int4*)(pair_pos + (size_t)gw * 4) : make_int4(0, 0, 0, 0);
        for (int t = gw; t < NTOK; t += ngw) {
            const int ps[4] = {pp.x, pp.y, pp.z, pp.w};
            u32x4 hv[2], ov[4][2];
#pragma unroll
            for (int hf = 0; hf < 2; ++hf) { hv[hf] = *(const u32x4*)(h1 + (size_t)t * DM + hf * 512 + 8 * lane);
#pragma unroll
                for (int s4 = 0; s4 < 4; ++s4) ov[s4][hf] = *(const u32x4*)(out2 + (size_t)ps[s4] * DM + hf * 512 + 8 * lane); }
            if (t + ngw < NTOK) pp = *(const int4*)(pair_pos + (size_t)(t + ngw) * 4);
            float v[16];
#pragma unroll
            for (int hf = 0; hf < 2; ++hf) { float f[8]; unpack8(hv[hf], f);
#pragma unroll
                for (int j = 0; j < 8; ++j) v[hf * 8 + j] = ALPHA * f[j];
#pragma unroll
                for (int s4 = 0; s4 < 4; ++s4) { float g[8]; unpack8(ov[s4][hf], g);
#pragma unroll
                    for (int j = 0; j < 8; ++j) v[hf * 8 + j] += g[j]; } }
            float s = 0.f;
#pragma unroll
            for (int j = 0; j < 16; ++j) s += v[j];
            const float mean = wave_sum(s) * (1.f / DM); float s2 = 0.f;
#pragma unroll
            for (int j = 0; j < 16; ++j) { v[j] -= mean; s2 += v[j] * v[j]; }
            const float rstd = rsq(wave_sum(s2) * (1.f / DM) + LN_EPS);
#pragma unroll
            for (int hf = 0; hf < 2; ++hf) { float* o = outp + (size_t)t * DM + hf * 512 + 8 * lane;
                *(f32x4*)o = (f32x4){v[hf * 8 + 0], v[hf * 8 + 1], v[hf * 8 + 2], v[hf * 8 + 3]} * rstd * G4[2 * hf] + B4[2 * hf];
                *(f32x4*)(o + 4) = (f32x4){v[hf * 8 + 4], v[hf * 8 + 5], v[hf * 8 + 6], v[hf * 8 + 7]} * rstd * G4[2 * hf + 1] + B4[2 * hf + 1]; }
        }
    }
#undef IN
#undef SEAM
}

extern "C" void kernel_launch(void* const* d_in, const int* in_sizes, int n_in, void* d_out, int out_size, void* d_ws, size_t ws_size, hipStream_t stream) {
    static int grid = 0;
    if (grid == 0) {
        if (n_in != 24 || in_sizes[0] != NTOK * DM || out_size != NTOK * DM || ws_size < WS_END) { fprintf(stderr, "kernel_launch: shape/workspace mismatch (n_in %d, ws %zu)\n", n_in, ws_size); grid = -1; return; }
        int dev = 0, cus = 0, per_cu = 0;
        if (hipGetDevice(&dev) != hipSuccess || hipDeviceGetAttribute(&cus, hipDeviceAttributeMultiprocessorCount, dev) != hipSuccess) { grid = -1; return; }
        if (hipFuncSetAttribute((const void*)hymba_fwd, hipFuncAttributeMaxDynamicSharedMemorySize, LDS_BYTES) != hipSuccess) { fprintf(stderr, "kernel_launch: hipFuncSetAttribute failed\n"); grid = -1; return; }
        if (hipOccupancyMaxActiveBlocksPerMultiprocessor(&per_cu, (const void*)hymba_fwd, NWAVES * 64, LDS_BYTES) != hipSuccess || per_cu < 1) fprintf(stderr, "kernel_launch: occupancy query says %d\n", per_cu);
        (void)hipGetLastError();
        grid = cus;
    }
    if (grid < 0) return;
    (void)hipMemsetAsync((char*)d_ws + WS_CTL, 0, CTL_ZERO_BYTES, stream);
    Args a{};
    for (int i = 0; i < 24; ++i) a.in[i] = (const float*)d_in[i];
    a.out = (float*)d_out; a.ws = (unsigned char*)d_ws;
#if MK_SPLIT
    for (int p = 0; p < NPHASE; ++p) { a.ph_lo = p; a.ph_hi = p + 1; hipLaunchKernelGGL(hymba_fwd, dim3(grid), dim3(NWAVES * 64), LDS_BYTES, stream, a); }
#else
    a.ph_lo = 0; a.ph_hi = NPHASE; hipLaunchKernelGGL(hymba_fwd, dim3(grid), dim3(NWAVES * 64), LDS_BYTES, stream, a);
#endif
}
```

```cpp
#include <hip/hip_runtime.h>
#include <cstdio>
#include <cstdint>

#ifndef MK_SPLIT
#define MK_SPLIT 0
#endif

#define LAS __attribute__((address_space(3)))
#define CAS __attribute__((address_space(4)))
typedef unsigned short bf16;
typedef short bf16x8 __attribute__((ext_vector_type(8)));
typedef short s16x4 __attribute__((ext_vector_type(4)));
typedef float f32x2 __attribute__((ext_vector_type(2)));
typedef float f32x4 __attribute__((ext_vector_type(4)));
typedef float f32x16 __attribute__((ext_vector_type(16)));
typedef unsigned u32x2 __attribute__((ext_vector_type(2)));
typedef unsigned u32x4 __attribute__((ext_vector_type(4)));
typedef __bf16 bf16x2_t __attribute__((ext_vector_type(2)));

constexpr int NB = 16, SEQ = 2048, DM = 1024, NMETA = 16;
constexpr int NTOK = NB * SEQ;
constexpr int MROWS = NTOK + NMETA;
constexpr int MPAD = 33024;
constexpr int LKP = 2112;
constexpr int NIN = 1472, ZLD = 1536;
constexpr int NE = 32, NPAIR = NTOK * 4, MOE_TILES_MAX = 544, MOE_ROWS_MAX = MOE_TILES_MAX * 256;
constexpr float ALPHA = 1.189207115002721f;
constexpr float RMS_EPS = 1e-6f, LN_EPS = 1e-5f;

constexpr size_t MiB = 1u << 20;
constexpr size_t WS_CTL = 0, CTL_ZERO_BYTES = 1 * MiB;
constexpr size_t WS_ROPE = 1 * MiB;
constexpr size_t WS_WQB = 2 * MiB;
constexpr size_t WS_WKVB = 2 * MiB + 512 * 1024;
constexpr size_t WS_WR = 3 * MiB;
constexpr size_t WS_LOGITS = 4 * MiB;
constexpr size_t WS_TOPK = 8 * MiB;
constexpr size_t WS_GATE = 8 * MiB + 512 * 1024;
constexpr size_t WS_PAIRPOS = 9 * MiB;
constexpr size_t WS_ROWGATE = 9 * MiB + 512 * 1024;
constexpr size_t WS_HIST = 10 * MiB + 512 * 1024;
constexpr size_t WS_MOETAB = 10 * MiB + 768 * 1024;
constexpr size_t WS_WIN = 12 * MiB;
constexpr size_t WS_WO = 15 * MiB;
constexpr size_t WS_WGU = 32 * MiB;
constexpr size_t WS_WDN = 96 * MiB;
constexpr size_t WS_H1F8 = 128 * MiB;
constexpr size_t WS_H0 = 224 * MiB;
constexpr size_t WS_H1 = 289 * MiB;
constexpr size_t WS_QAN = 353 * MiB;
constexpr size_t WS_KVAN = 370 * MiB;
constexpr size_t WS_Z = 380 * MiB;
constexpr size_t WS_QM = 477 * MiB;
constexpr size_t WS_KM = 525 * MiB;
constexpr size_t WS_VM = 575 * MiB;
constexpr size_t WS_QG = 608 * MiB;
constexpr size_t WS_KG = 640 * MiB;
constexpr size_t WS_VG = 657 * MiB;
constexpr size_t WS_O = 674 * MiB;
constexpr size_t WS_Y1 = 738 * MiB;
constexpr size_t WS_XS = 380 * MiB;
constexpr size_t WS_ACT = 516 * MiB;
constexpr size_t WS_OUT2 = 652 * MiB;
constexpr size_t WS_END = 924 * MiB;
static_assert(WS_Z + (size_t)MPAD * ZLD * 2 <= WS_QM && WS_QM + (size_t)64 * 2048 * 192 * 2 <= WS_KM && WS_KM + (size_t)64 * LKP * 192 * 2 <= WS_VM && WS_VM + (size_t)64 * LKP * 128 * 2 <= WS_QG, "ws map 1");
static_assert(WS_QG + (size_t)64 * 2048 * 128 * 2 <= WS_KG && WS_KG + (size_t)32 * LKP * 128 * 2 <= WS_VG && WS_VG + (size_t)32 * LKP * 128 * 2 <= WS_O && WS_O + (size_t)NTOK * DM * 2 <= WS_Y1 && WS_Y1 + (size_t)NTOK * DM * 4 <= WS_END, "ws map 2");
static_assert(WS_XS + (size_t)MOE_ROWS_MAX * DM <= WS_ACT && WS_ACT + (size_t)MOE_ROWS_MAX * DM <= WS_OUT2 && WS_OUT2 + (size_t)MOE_ROWS_MAX * DM * 2 <= WS_END && WS_WGU + (size_t)NE * 2048 * 1024 <= WS_WDN && WS_WDN + (size_t)NE * 1024 * 1024 <= WS_H1F8 && WS_H1F8 + (size_t)NTOK * DM <= WS_H0, "ws map 3");
static_assert(WS_H0 + (size_t)MPAD * DM * 2 <= WS_H1 && WS_H1 + (size_t)NTOK * DM * 2 <= WS_QAN && WS_QAN + (size_t)MPAD * 256 * 2 <= WS_KVAN && WS_KVAN + (size_t)MPAD * 128 * 2 <= WS_Z, "ws map 4");
constexpr int CW_BAR = 4096;

constexpr int RING_BYTES = 131072;
constexpr int LDSCTL_OFF = RING_BYTES;
constexpr int LDS_BYTES = 147456;
constexpr int NWAVES = 8;

#define LDS_WAIT() asm volatile("s_waitcnt lgkmcnt(0)" ::: "memory")
#define SBAR() __builtin_amdgcn_sched_barrier(0)
__device__ __forceinline__ unsigned cvtpk(float lo, float hi) { f32x2 v = {lo, hi}; bf16x2_t b = __builtin_convertvector(v, bf16x2_t); return __builtin_bit_cast(unsigned, b); }
__device__ __forceinline__ u32x4 pack8(const float (&v)[8]) { u32x4 r = {cvtpk(v[0], v[1]), cvtpk(v[2], v[3]), cvtpk(v[4], v[5]), cvtpk(v[6], v[7])}; return r; }
__device__ __forceinline__ void unpack8(u32x4 w, float (&v)[8]) {
    v[0] = __uint_as_float(w.x << 16); v[1] = __uint_as_float(w.x & 0xffff0000u); v[2] = __uint_as_float(w.y << 16); v[3] = __uint_as_float(w.y & 0xffff0000u);
    v[4] = __uint_as_float(w.z << 16); v[5] = __uint_as_float(w.z & 0xffff0000u); v[6] = __uint_as_float(w.w << 16); v[7] = __uint_as_float(w.w & 0xffff0000u);
}
__device__ __forceinline__ float wave_sum(float v) {
#pragma unroll
    for (int o = 1; o < 64; o <<= 1) v += __shfl_xor(v, o);
    return v;
}
__device__ __forceinline__ float rsq(float x) { return __builtin_amdgcn_rsqf(x); }
typedef int v8i __attribute__((ext_vector_type(8)));
__device__ __forceinline__ unsigned pack4_f8(float a, float b, float c, float d) { int w = 0; w = __builtin_amdgcn_cvt_pk_fp8_f32(a, b, w, false); w = __builtin_amdgcn_cvt_pk_fp8_f32(c, d, w, true); return (unsigned)w; }
constexpr float W8_SCALE = 32.f, W8_INV = 1.f / 32.f;

#define XB_TMO      128
#define XB_XCNT(j)  (256  + 64 * (j))
#define XB_XSUB(j)  (1280 + 64 * (j))
#define XB_XGEN(j)  (2304 + 64 * (j))
#define XB_TOP      3328
#define XB_TOPGEN   3392
#define XCD_BAR_WORDS 3456
#define XB_SPIN_CAP (1u << 18)
__device__ __forceinline__ unsigned xb_ld(unsigned* p)              { return __hip_atomic_load(p, __ATOMIC_RELAXED, __HIP_MEMORY_SCOPE_AGENT); }
__device__ __forceinline__ unsigned xb_add(unsigned* p, unsigned v) { return __hip_atomic_fetch_add(p, v, __ATOMIC_RELAXED, __HIP_MEMORY_SCOPE_AGENT); }
__device__ __forceinline__ unsigned xb_xcc_id() { return (unsigned)__builtin_amdgcn_s_getreg((3 << 11) | 20) & 0xFu; }
#define XB_SPIN(cond, bar) do { unsigned _sp = 0; while (cond) { __builtin_amdgcn_s_sleep(1); \
    if ((++_sp & 255u) == 0u) { if (xb_ld(&(bar)[XB_TMO])) break; if (_sp > XB_SPIN_CAP) { atomicAdd(&(bar)[XB_TMO], 1u); break; } } } } while (0)
struct XcdBarrier { unsigned* bar; unsigned x; volatile LAS unsigned* st; };
__device__ __forceinline__ XcdBarrier xcd_barrier_post(unsigned* bar, volatile LAS unsigned* st) {
    XcdBarrier b; b.bar = bar; b.x = xb_xcc_id(); b.st = st;
    if (threadIdx.x == 0) (void)xb_add(&bar[XB_XCNT(b.x)], 1u);
    return b;
}
__device__ __forceinline__ void xcd_barrier_complete(unsigned* bar, unsigned x, unsigned& nloc, unsigned& nx) {
    const unsigned G = gridDim.x * gridDim.y * gridDim.z;
    unsigned sum, cnt, mine, sp = 0u;
    for (;;) {
        sum = 0u; cnt = 0u; mine = 0u;
#pragma unroll
        for (unsigned j = 0; j < 16; ++j) { const unsigned c = xb_ld(&bar[XB_XCNT(j)]); sum += c; cnt += (c > 0u) ? 1u : 0u; mine = (j == x) ? c : mine; }
        if (sum == G) break;
        __builtin_amdgcn_s_sleep(1);
        if ((++sp & 255u) == 0u) { if (xb_ld(&bar[XB_TMO])) break; if (sp > XB_SPIN_CAP) { atomicAdd(&bar[XB_TMO], 1u); break; } }
    }
    nloc = mine > 0u ? mine : 1u; nx = cnt > 0u ? cnt : 1u;
}
__device__ __forceinline__ void xcd_barrier(const XcdBarrier& b) {
    asm volatile("s_waitcnt vmcnt(0)" ::: "memory");
    __syncthreads();
    if (threadIdx.x == 0) {
        unsigned* bar = b.bar;
        __builtin_amdgcn_s_waitcnt(0);
        unsigned nloc = b.st[0], nx = b.st[1];
        if (nloc == 0u) { xcd_barrier_complete(bar, b.x, nloc, nx); b.st[0] = nloc; b.st[1] = nx; }
        const unsigned old = xb_add(&bar[XB_XSUB(b.x)], 1u);
        const unsigned gen = old / nloc;
        if (old + 1u == (gen + 1u) * nloc) {
            __builtin_amdgcn_fence(__ATOMIC_RELEASE, "agent");
            asm volatile("s_waitcnt vmcnt(0)" ::: "memory");
            const unsigned og = xb_add(&bar[XB_TOP], 1u);
            const unsigned tg = og / nx;
            if (og + 1u == (tg + 1u) * nx) xb_add(&bar[XB_TOPGEN], 1u);
            else XB_SPIN(xb_ld(&bar[XB_TOPGEN]) == tg, bar);
            __builtin_amdgcn_fence(__ATOMIC_ACQUIRE, "agent");
            xb_add(&bar[XB_XGEN(b.x)], 1u);
            asm volatile("s_waitcnt vmcnt(0)" ::: "memory");
        } else {
            XB_SPIN(xb_ld(&bar[XB_XGEN(b.x)]) == gen, bar);
            __builtin_amdgcn_fence(__ATOMIC_ACQUIRE, "agent");
            asm volatile("s_waitcnt vmcnt(0)" ::: "memory");
        }
    }
    __syncthreads();
}

struct BSelNone { __device__ __forceinline__ size_t operator()(int) const { return 0; } };
struct BSelExpert { const int* tile_expert; size_t per; __device__ __forceinline__ size_t operator()(int m0) const { return (size_t)tile_expert[m0 >> 8] * per; } };
template <class Epi, class BSel>
__device__ __forceinline__ void simple_gemm(const bf16* __restrict__ A, const bf16* __restrict__ Bt, int K, int m_lo, int m_hi, int N, const Epi& E, const BSel& bsel, int gw, int ngw, int lane, int lda = 0) {
    if (lda == 0) lda = K;
    const int fr = lane & 15, fq = lane >> 4;
    const int mt = (m_hi - m_lo) / 64, nt = N / 32;
    for (int u = gw; u < mt * nt; u += ngw) {
        const int m0 = m_lo + (u / nt) * 64, n0 = (u % nt) * 32;
        const bf16* ap = A + (size_t)(m0 + fr) * lda + fq * 8;
        const bf16* bp = Bt + bsel(m0) + (size_t)(n0 + 8 * (fr >> 2) + (fr & 3)) * K + fq * 8;
        f32x4 acc[4][2];
#pragma unroll
        for (int i = 0; i < 4; ++i) { acc[i][0] = (f32x4){0.f, 0.f, 0.f, 0.f}; acc[i][1] = (f32x4){0.f, 0.f, 0.f, 0.f}; }
#pragma unroll 2
        for (int k = 0; k < K; k += 32) {
            bf16x8 a[4], b[2];
#pragma unroll
            for (int i = 0; i < 4; ++i) a[i] = *(const bf16x8*)(ap + (size_t)i * 16 * lda + k);
#pragma unroll
            for (int j = 0; j < 2; ++j) b[j] = *(const bf16x8*)(bp + (size_t)j * 4 * K + k);
#pragma unroll
            for (int i = 0; i < 4; ++i)
#pragma unroll
                for (int j = 0; j < 2; ++j) acc[i][j] = __builtin_amdgcn_mfma_f32_16x16x32_bf16(b[j], a[i], acc[i][j], 0, 0, 0);
        }
#pragma unroll
        for (int i = 0; i < 4; ++i) {
            const float v[8] = {acc[i][0][0], acc[i][0][1], acc[i][0][2], acc[i][0][3], acc[i][1][0], acc[i][1][1], acc[i][1][2], acc[i][1][3]};
            E.store8(m0 + 16 * i + fr, n0 + 8 * fq, v);
        }
    }
}


template <int K, class Epi>
__device__ __forceinline__ void smallk_task(const bf16* __restrict__ A, const bf16* __restrict__ Bt, int m0, int ng_lo, int ng_hi, const Epi& E, int lane) {
    constexpr int KS = K / 32;
    const int fr = lane & 15, fq = lane >> 4;
    bf16x8 a[4][KS];
#pragma unroll
    for (int i = 0; i < 4; ++i)
#pragma unroll
        for (int ks = 0; ks < KS; ++ks) a[i][ks] = *(const bf16x8*)(A + (size_t)(m0 + 16 * i + fr) * K + ks * 32 + fq * 8);
#pragma unroll 1
    for (int ng = ng_lo; ng < ng_hi; ++ng) {
        const int n0 = ng * 32;
        const bf16* bp = Bt + (size_t)(n0 + 8 * (fr >> 2) + (fr & 3)) * K + fq * 8;
        bf16x8 b[2][KS];
#pragma unroll
        for (int ks = 0; ks < KS; ++ks) { b[0][ks] = *(const bf16x8*)(bp + ks * 32); b[1][ks] = *(const bf16x8*)(bp + 4 * K + ks * 32); }
        f32x4 acc[4][2];
#pragma unroll
        for (int i = 0; i < 4; ++i) { acc[i][0] = (f32x4){0.f, 0.f, 0.f, 0.f}; acc[i][1] = (f32x4){0.f, 0.f, 0.f, 0.f}; }
#pragma unroll
        for (int ks = 0; ks < KS; ++ks)
#pragma unroll
            for (int i = 0; i < 4; ++i) { acc[i][0] = __builtin_amdgcn_mfma_f32_16x16x32_bf16(b[0][ks], a[i][ks], acc[i][0], 0, 0, 0); acc[i][1] = __builtin_amdgcn_mfma_f32_16x16x32_bf16(b[1][ks], a[i][ks], acc[i][1], 0, 0, 0); }
#pragma unroll
        for (int i = 0; i < 4; ++i) {
            const float v[8] = {acc[i][0][0], acc[i][0][1], acc[i][0][2], acc[i][0][3], acc[i][1][0], acc[i][1][1], acc[i][1][2], acc[i][1][3]};
            E.store8(m0 + 16 * i + fr, n0 + 8 * fq, v);
        }
    }
}


template <int K, class Epi>
__device__ __forceinline__ void meta_gemm16(const bf16* __restrict__ A, int lda, const bf16* __restrict__ Bt, int m0, int N, const Epi& E, int gw, int ngw, int lane) {
    const int fr = lane & 15, fq = lane >> 4;
    for (int ng = gw; ng < N / 32; ng += ngw) {
        const int n0 = ng * 32;
        const bf16* ap = A + (size_t)(m0 + fr) * lda + fq * 8;
        const bf16* bp = Bt + (size_t)(n0 + 8 * (fr >> 2) + (fr & 3)) * K + fq * 8;
        f32x4 acc0 = {0.f, 0.f, 0.f, 0.f}, acc1 = {0.f, 0.f, 0.f, 0.f};
#pragma unroll 8
        for (int k = 0; k < K; k += 32) { const bf16x8 a = *(const bf16x8*)(ap + k), b0 = *(const bf16x8*)(bp + k), b1 = *(const bf16x8*)(bp + 4 * K + k);
            acc0 = __builtin_amdgcn_mfma_f32_16x16x32_bf16(b0, a, acc0, 0, 0, 0); acc1 = __builtin_amdgcn_mfma_f32_16x16x32_bf16(b1, a, acc1, 0, 0, 0); }
        const float v[8] = {acc0[0], acc0[1], acc0[2], acc0[3], acc1[0], acc1[1], acc1[2], acc1[3]};
        E.store8(m0 + fr, n0 + 8 * fq, v);
    }
}

struct EpiZ { bf16* z;
    __device__ __forceinline__ void store8(int row, int col, const float (&v)[8]) const { if (col < NIN) *(u32x4*)(z + (size_t)row * ZLD + col) = pack8(v); } };
struct EpiQ { bf16* qm; const float* rs;
    __device__ __forceinline__ void store8(int row, int col, const float (&v_)[8]) const {
        const int h = col / 192, w = col - h * 192, b = row >> 11, s = row & 2047; const float r_ = rs[row];
        const float o[8] = {v_[0] * r_, v_[1] * r_, v_[2] * r_, v_[3] * r_, v_[4] * r_, v_[5] * r_, v_[6] * r_, v_[7] * r_};
        *(u32x4*)(qm + ((size_t)(b * 4 + h) * 2048 + s) * 192 + w) = pack8(o);
    } };
template <bool META> struct EpiKV { bf16* km; bf16* vm; const float* rs;
    __device__ __forceinline__ void store8(int row, int col, const float (&v_)[8]) const {
        if (META && row >= MROWS) return;
        const float r_ = rs[row]; const float v[8] = {v_[0] * r_, v_[1] * r_, v_[2] * r_, v_[3] * r_, v_[4] * r_, v_[5] * r_, v_[6] * r_, v_[7] * r_};
        const int h = col >> 8, w = col & 255; const u32x4 pk = pack8(v);
        if (!META) { const int b = row >> 11, key = row & 2047; const size_t r = (size_t)(b * 4 + h) * LKP + key;
            if (w < 128) *(u32x4*)(km + r * 192 + w) = pk; else *(u32x4*)(vm + r * 128 + (w - 128)) = pk;
        } else { const int key = 2048 + (row - NTOK);
            for (int b = 0; b < NB; ++b) { const size_t r = (size_t)(b * 4 + h) * LKP + key;
                if (w < 128) *(u32x4*)(km + r * 192 + w) = pk; else *(u32x4*)(vm + r * 128 + (w - 128)) = pk; } }
    } };
struct EpiO { bf16* y1; const bf16* h0;
    __device__ __forceinline__ void store8(int row, int col, const float (&v)[8]) const {
        float h[8]; unpack8(*(const u32x4*)(h0 + (size_t)row * DM + col), h);
        const float o[8] = {ALPHA * h[0] + v[0], ALPHA * h[1] + v[1], ALPHA * h[2] + v[2], ALPHA * h[3] + v[3], ALPHA * h[4] + v[4], ALPHA * h[5] + v[5], ALPHA * h[6] + v[6], ALPHA * h[7] + v[7]};
        *(u32x4*)(y1 + (size_t)row * DM + col) = pack8(o);
    } };
struct EpiLogit { float* logits; const float* bias;
    __device__ __forceinline__ void store8(int row, int col, const float (&v)[8]) const {
        float* y = logits + (size_t)row * NE + col;
        *(f32x4*)y = (f32x4){v[0] + bias[col], v[1] + bias[col + 1], v[2] + bias[col + 2], v[3] + bias[col + 3]};
        *(f32x4*)(y + 4) = (f32x4){v[4] + bias[col + 4], v[5] + bias[col + 5], v[6] + bias[col + 6], v[7] + bias[col + 7]};
    } };
namespace pg8 {
#define PG8_LAS __attribute__((address_space(3)))
typedef unsigned short bf16_t;
constexpr int BM = 256, BK = 64, HALF = 128, HTB = HALF * BK * 2, STAGE_BYTES = 8 * HTB, NXCD = 8, WGM = 8;
__host__ __device__ __forceinline__ int lds_byte(int r, int c) { const int st = (r >> 4) * 2 + (c >> 5), rr = r & 15, cc = c & 31, ob = rr * 64 + cc * 2; return st * 1024 + (ob ^ (((ob >> 9) & 1) << 5)); }
__host__ __device__ __forceinline__ void stage_rc(int b, int& R, int& C) { const int st = b / 1024, sb = b % 1024, swz = sb ^ (((sb >> 9) & 1) << 5); R = (st >> 1) * 16 + swz / 64; C = (st & 1) * 32 + (swz % 64) / 2; }
__host__ __device__ __forceinline__ int perm32(int rho) { const int n = rho >> 4, i = rho & 15; return 8 * (i >> 2) + 4 * n + (i & 3); }
struct Unit { int pm, pn; };
struct Gemm { const bf16_t* A; const bf16_t* Bt; int M, N, K, lda; };
struct StaticOrder {
    int nM, nN, nwg, G, c;
    __host__ __device__ void init(int M, int N, int G_, int c_) { nM = M / BM; nN = N / BM; nwg = nM * nN; G = G_; c = c_; }
    __host__ __device__ bool next(int i, Unit& u) const {
        const long L = (long)i * G + c; if (L >= nwg) return false;
        int wgid = (int)L; { const int q = nwg / NXCD, r = nwg % NXCD, xcd = wgid % NXCD, off = wgid / NXCD; wgid = (xcd < r ? xcd * (q + 1) : r * (q + 1) + (xcd - r) * q) + off; }
        const int nig = WGM * nN, gid = wgid / nig, fm = gid * WGM, gsz = (nM - fm) < WGM ? (nM - fm) : WGM;
        u.pm = fm + ((wgid % nig) % gsz); u.pn = (wgid % nig) / gsz; return true;
    }
    __device__ __forceinline__ void a_ready(const Unit&) const {}
    __device__ __forceinline__ void done(const Unit&) const {}
};
struct MoeOrder {
    StaticOrder so; const int* tile_expert;
    __device__ void init(int tiles, int nN, int G_, int c_, const int* te) { so.nM = tiles; so.nN = nN; so.nwg = tiles * nN; so.G = G_; so.c = c_; tile_expert = te; }
    __device__ bool next(int i, Unit& u) const { if (!so.next(i, u)) return false; u.pn += tile_expert[u.pm] * so.nN; return true; }
    __device__ __forceinline__ void a_ready(const Unit&) const {}
    __device__ __forceinline__ void done(const Unit&) const {}
};
template <class E8> struct EpiAdapt {
    static constexpr bool PERM = true, AFTER_DRAIN = false;
    E8 e; int ncols_mod;
    __device__ __forceinline__ void operator()(const f32x4 (&acc)[2][2][4][2], const Unit& u, int wr, int wc, int fr, int fq) const {
        const int row0 = u.pm * BM + wr * 64 + fr; int colt = u.pn * BM; if (ncols_mod) colt %= ncols_mod;
        const int col0 = colt + wc * 32 + 8 * fq;
#pragma unroll
        for (int ai = 0; ai < 2; ++ai)
#pragma unroll
            for (int m = 0; m < 4; ++m)
#pragma unroll
                for (int bj = 0; bj < 2; ++bj) {
                    const float v[8] = {acc[ai][bj][m][0][0], acc[ai][bj][m][0][1], acc[ai][bj][m][0][2], acc[ai][bj][m][0][3], acc[ai][bj][m][1][0], acc[ai][bj][m][1][1], acc[ai][bj][m][1][2], acc[ai][bj][m][1][3]};
                    e.store8(row0 + ai * HALF + m * 16, col0 + bj * HALF, v); }
    }
};
template <class Epi, class Sched, bool ALIGN_EPI = false, bool SP2 = false, bool F8 = false>
__device__ __forceinline__ void gemm_phase(PG8_LAS unsigned char* lds, const Gemm g, const Sched& S, const Epi& E) {
    const int tid = threadIdx.x, wid = __builtin_amdgcn_readfirstlane(tid >> 6), lane = tid & 63, wr = wid >> 2, wc = wid & 3, fr = lane & 15, fq = lane >> 4;
    const int K = g.K, nt = K / BK;
    unsigned voffA[2], voffB[2];
#pragma unroll
    for (int i = 0; i < 2; ++i) { int R, C; stage_rc(tid * 16 + i * 8192, R, C); const int Rb = Epi::PERM ? ((R & ~31) + perm32(R & 31)) : R;
        voffA[i] = (unsigned)(R * g.lda + C) * 2u; voffB[i] = (unsigned)(Rb * K + C) * 2u; }
    const size_t kstep = (size_t)(BK * 2);
    const size_t hstep = (size_t)HALF * K * 2, hstepA = (size_t)HALF * g.lda * 2;
    const size_t tstep = 2 * hstep, tstepA = 2 * hstepA;
    const unsigned ldsw = (unsigned)wid * 1024u;
    const int aoff = lds_byte(wr * 64 + fr, fq * 8), boff = lds_byte(wc * 32 + fr, fq * 8);
#define PG8_SA(b, h) (((b) * 2 + (h)) * HTB)
#define PG8_SB(b, h) ((4 + (b) * 2 + (h)) * HTB)
#define PG8_STAGE(bufoff, gbase, voff) do { _Pragma("unroll") for (int _i = 0; _i < 2; ++_i) \
        __builtin_amdgcn_global_load_lds((const unsigned*)((const char*)(gbase) + (voff)[_i]), (PG8_LAS unsigned*)(lds + (bufoff) + ldsw + _i * 8192), 16, 0, 0); } while (0)
#define PG8_LDA(dst, b, h) do { _Pragma("unroll") for (int m = 0; m < 4; ++m) _Pragma("unroll") for (int k = 0; k < 2; ++k) dst[m][k] = *(const PG8_LAS bf16x8*)(lds + PG8_SA(b, h) + aoff + m * 2048 + k * 1024); } while (0)
#define PG8_LDB(dst, b, h) do { _Pragma("unroll") for (int n = 0; n < 2; ++n) _Pragma("unroll") for (int k = 0; k < 2; ++k) dst[n][k] = *(const PG8_LAS bf16x8*)(lds + PG8_SB(b, h) + boff + n * 2048 + k * 1024); } while (0)
#define PG8_F8CAT(x) __builtin_shufflevector(__builtin_bit_cast(u32x4, (x)[0]), __builtin_bit_cast(u32x4, (x)[1]), 0, 1, 2, 3, 4, 5, 6, 7)
#define PG8_MMA(ai, bj, At, Bt) do { __builtin_amdgcn_s_setprio(1); if constexpr (F8) { _Pragma("unroll") for (int m = 0; m < 4; ++m) _Pragma("unroll") for (int n = 0; n < 2; ++n) \
        acc[ai][bj][m][n] = __builtin_amdgcn_mfma_scale_f32_16x16x128_f8f6f4(__builtin_bit_cast(v8i, PG8_F8CAT(Bt[n])), __builtin_bit_cast(v8i, PG8_F8CAT(At[m])), acc[ai][bj][m][n], 0, 0, 0, 0x7f7f7f7f, 0, 0x7f7f7f7f); \
        _Pragma("unroll") for (int m = 0; m < 4; ++m) _Pragma("unroll") for (int n = 0; n < 2; ++n) asm volatile("" : "+v"(acc[ai][bj][m][n])); } \
    else { _Pragma("unroll") for (int m = 0; m < 4; ++m) _Pragma("unroll") for (int n = 0; n < 2; ++n) _Pragma("unroll") for (int k = 0; k < 2; ++k) \
        acc[ai][bj][m][n] = __builtin_amdgcn_mfma_f32_16x16x32_bf16(Bt[n][k], At[m][k], acc[ai][bj][m][n], 0, 0, 0); } __builtin_amdgcn_s_setprio(0); } while (0)
#define PG8_WAIT_V(n) asm volatile("s_waitcnt vmcnt(" #n ")" ::: "memory")
#define PG8_WAIT_L(n) asm volatile("s_waitcnt lgkmcnt(" #n ")" ::: "memory")
#define PG8_BAR __builtin_amdgcn_s_barrier()
#define PG8_SCHED __builtin_amdgcn_sched_barrier(0)
    Unit cur, nxt; int ui = 0;
    if (!S.next(0, cur)) return;
    f32x4 acc[2][2][4][2];
#pragma unroll
    for (int a = 0; a < 2; ++a)
#pragma unroll
        for (int b = 0; b < 2; ++b)
#pragma unroll
            for (int m = 0; m < 4; ++m)
#pragma unroll
                for (int n = 0; n < 2; ++n) acc[a][b][m][n] = (f32x4){0.f, 0.f, 0.f, 0.f};
    bf16x8 At[4][2], B0[2][2], B1[2][2];
    const char* cA = (const char*)g.A + (size_t)cur.pm * tstepA; const char* cB = (const char*)g.Bt + (size_t)cur.pn * tstep;
    S.a_ready(cur);
    if constexpr (SP2) {
        PG8_STAGE(PG8_SB(0, 0), cB, voffB); PG8_STAGE(PG8_SB(0, 1), cB + hstep, voffB); PG8_STAGE(PG8_SA(0, 0), cA, voffA); PG8_STAGE(PG8_SA(0, 1), cA + hstepA, voffA);
        if (wr == 1) PG8_BAR;
        PG8_WAIT_V(2); PG8_BAR;
        PG8_STAGE(PG8_SB(1, 0), cB + kstep, voffB); PG8_STAGE(PG8_SA(1, 0), cA + kstep, voffA); PG8_STAGE(PG8_SB(1, 1), cB + hstep + kstep, voffB);
        PG8_WAIT_V(6); PG8_BAR;
    } else {
        PG8_STAGE(PG8_SB(0, 0), cB, voffB); PG8_STAGE(PG8_SA(0, 0), cA, voffA); PG8_STAGE(PG8_SB(0, 1), cB + hstep, voffB); PG8_STAGE(PG8_SA(0, 1), cA + hstepA, voffA);
        if (wr == 1) PG8_BAR;
        PG8_WAIT_V(4); PG8_BAR;
        PG8_STAGE(PG8_SB(1, 0), cB + kstep, voffB); PG8_STAGE(PG8_SA(1, 0), cA + kstep, voffA); PG8_STAGE(PG8_SB(1, 1), cB + hstep + kstep, voffB);
        PG8_WAIT_V(6); PG8_BAR;
    }
    for (;;) {
        const bool has_next = S.next(ui + 1, nxt);
        const char* nA = has_next ? (const char*)g.A + (size_t)nxt.pm * tstepA : cA; const char* nB = has_next ? (const char*)g.Bt + (size_t)nxt.pn * tstep : cB;
        for (int t = 0; t < nt; t += 2) {
            const bool last = (t == nt - 2);
            const char* a1 = cA + (size_t)(t + 1) * kstep;
            const char* a2 = last ? nA : cA + (size_t)(t + 2) * kstep; const char* b2 = last ? nB : cB + (size_t)(t + 2) * kstep;
            const char* a3 = a2 + kstep; const char* b3 = b2 + kstep;
            if (last && has_next) S.a_ready(nxt);
            if constexpr (SP2) {
            PG8_LDB(B0, 0, 0); PG8_LDB(B1, 0, 1); PG8_SCHED; PG8_LDA(At, 0, 0); PG8_STAGE(PG8_SA(1, 1), a1 + hstepA, voffA);
            PG8_WAIT_V(8); PG8_WAIT_L(0); PG8_BAR; PG8_MMA(0, 0, At, B0); PG8_MMA(0, 1, At, B1); PG8_BAR; PG8_SCHED;
            PG8_LDA(At, 0, 1); PG8_STAGE(PG8_SB(0, 0), b2, voffB); PG8_STAGE(PG8_SB(0, 1), b2 + hstep, voffB); PG8_STAGE(PG8_SA(0, 0), a2, voffA);
            PG8_WAIT_V(8); PG8_WAIT_L(0); PG8_BAR; PG8_MMA(1, 0, At, B0); PG8_MMA(1, 1, At, B1); PG8_BAR; PG8_SCHED;
            PG8_LDB(B0, 1, 0); PG8_LDB(B1, 1, 1); PG8_SCHED; PG8_LDA(At, 1, 0); PG8_STAGE(PG8_SA(0, 1), a2 + hstepA, voffA);
            PG8_WAIT_V(8); PG8_WAIT_L(0); PG8_BAR; PG8_MMA(0, 0, At, B0); PG8_MMA(0, 1, At, B1); PG8_BAR; PG8_SCHED;
            PG8_LDA(At, 1, 1); PG8_STAGE(PG8_SB(1, 0), b3, voffB); PG8_STAGE(PG8_SB(1, 1), b3 + hstep, voffB); PG8_STAGE(PG8_SA(1, 0), a3, voffA);
            PG8_WAIT_V(8); PG8_WAIT_L(0); PG8_BAR; PG8_MMA(1, 0, At, B0); PG8_MMA(1, 1, At, B1); PG8_BAR; PG8_SCHED;
            } else {
            PG8_LDB(B0, 0, 0); PG8_SCHED; PG8_LDA(At, 0, 0); PG8_STAGE(PG8_SA(1, 1), a1 + hstepA, voffA);
            PG8_WAIT_L(8); PG8_BAR; PG8_WAIT_L(0); PG8_MMA(0, 0, At, B0); PG8_BAR; PG8_SCHED;
            PG8_LDB(B1, 0, 1); PG8_STAGE(PG8_SB(0, 0), b2, voffB);
            PG8_BAR; PG8_WAIT_L(0); PG8_MMA(0, 1, At, B1); PG8_BAR;
            PG8_LDA(At, 0, 1); PG8_STAGE(PG8_SA(0, 0), a2, voffA);
            PG8_BAR; PG8_WAIT_L(0); PG8_MMA(1, 0, At, B0); PG8_BAR; PG8_SCHED;
            PG8_STAGE(PG8_SB(0, 1), b2 + hstep, voffB);
            PG8_WAIT_V(6); PG8_BAR; PG8_MMA(1, 1, At, B1); PG8_BAR;
            PG8_LDB(B0, 1, 0); PG8_SCHED; PG8_LDA(At, 1, 0); PG8_STAGE(PG8_SA(0, 1), a2 + hstepA, voffA);
            PG8_WAIT_L(8); PG8_BAR; PG8_WAIT_L(0); PG8_MMA(0, 0, At, B0); PG8_BAR; PG8_SCHED;
            PG8_LDB(B1, 1, 1); PG8_STAGE(PG8_SB(1, 0), b3, voffB);
            PG8_BAR; PG8_WAIT_L(0); PG8_MMA(0, 1, At, B1); PG8_BAR;
            PG8_LDA(At, 1, 1); PG8_STAGE(PG8_SA(1, 0), a3, voffA);
            PG8_BAR; PG8_WAIT_L(0); PG8_MMA(1, 0, At, B0); PG8_BAR; PG8_SCHED;
            PG8_STAGE(PG8_SB(1, 1), b3 + hstep, voffB);
            PG8_WAIT_V(6); PG8_BAR; PG8_MMA(1, 1, At, B1); PG8_BAR;
            }
        }
        if constexpr (ALIGN_EPI) { if (wr == 0) PG8_BAR; }
        if constexpr (!Epi::AFTER_DRAIN) { E(acc, cur, wr, wc, fr, fq); S.done(cur); }
        if (!has_next) break;
#pragma unroll
        for (int a = 0; a < 2; ++a)
#pragma unroll
            for (int b = 0; b < 2; ++b)
#pragma unroll
                for (int m = 0; m < 4; ++m)
#pragma unroll
                    for (int n = 0; n < 2; ++n) acc[a][b][m][n] = (f32x4){0.f, 0.f, 0.f, 0.f};
        cur = nxt; cA = nA; cB = nB; ++ui;
        if constexpr (ALIGN_EPI) { if (wr == 1) PG8_BAR; }
    }
    PG8_WAIT_V(0);
    if constexpr (!ALIGN_EPI) { if (wr == 0) PG8_BAR; }
    PG8_BAR;
#undef PG8_SA
#undef PG8_SB
#undef PG8_STAGE
#undef PG8_LDA
#undef PG8_LDB
#undef PG8_MMA
#undef PG8_F8CAT
#undef PG8_WAIT_V
#undef PG8_WAIT_L
#undef PG8_BAR
#undef PG8_SCHED
}
}

__device__ __forceinline__ u32x4 f8_pair16(u32x2 rowA, u32x2 rowB) {
    const auto s0 = __builtin_amdgcn_permlane16_swap(rowA.x, rowB.x, false, false), s1 = __builtin_amdgcn_permlane16_swap(rowA.y, rowB.y, false, false);
    return (u32x4){s0[0], s1[0], s0[1], s1[1]};
}
struct EpiGU8 { static constexpr bool PERM = true, AFTER_DRAIN = false;
    unsigned char* act8; const float* bgu;
    __device__ __forceinline__ void operator()(const f32x4 (&acc)[2][2][4][2], const pg8::Unit& u, int wr, int wc, int fr, int fq) const {
        const int e = u.pn >> 3, ac0 = 128 * (u.pn & 7) + wc * 32 + 8 * fq;
        const float* bb = bgu + (size_t)e * 2048 + 2 * ac0;
        const f32x4 q0 = *(const f32x4*)bb, q1 = *(const f32x4*)(bb + 4), q2 = *(const f32x4*)(bb + 8), q3 = *(const f32x4*)(bb + 12);
        const float bg[8] = {q0[0], q0[2], q1[0], q1[2], q2[0], q2[2], q3[0], q3[2]}, bl[8] = {q0[1], q0[3], q1[1], q1[3], q2[1], q2[3], q3[1], q3[3]};
        const int odd = fq & 1, acs = ac0 - 8 * odd;
#pragma unroll
        for (int ai = 0; ai < 2; ++ai)
#pragma unroll
            for (int mp = 0; mp < 2; ++mp) { u32x2 pk[2];
#pragma unroll
                for (int h = 0; h < 2; ++h) { const int m = 2 * mp + h; float o[8];
#pragma unroll
                    for (int t = 0; t < 8; ++t) {
                        const float xg = fminf(fmaf(acc[ai][0][m][t >> 2][t & 3], W8_INV, bg[t]), 7.f), xl = fminf(fmaxf(fmaf(acc[ai][1][m][t >> 2][t & 3], W8_INV, bl[t]), -7.f), 7.f);
                        const float sg = __builtin_amdgcn_rcpf(1.f + __builtin_amdgcn_exp2f(-1.702f * 1.4426950408889634f * xg));
                        o[t] = xg * sg * (xl + 1.f); }
                    pk[h] = (u32x2){pack4_f8(o[0], o[1], o[2], o[3]), pack4_f8(o[4], o[5], o[6], o[7])}; }
                const int row = u.pm * 256 + ai * 128 + wr * 64 + (2 * mp + odd) * 16 + fr;
                *(u32x4*)(act8 + (size_t)row * DM + acs) = f8_pair16(pk[0], pk[1]); }
    } };
constexpr float O2_SCALE = 8.f, O2_INV = 1.f / 8.f;
struct EpiDN8 { static constexpr bool PERM = true, AFTER_DRAIN = false;
    unsigned char* out2; const float* bdn; const float* row_gate;
    __device__ __forceinline__ void operator()(const f32x4 (&acc)[2][2][4][2], const pg8::Unit& u, int wr, int wc, int fr, int fq) const {
        const int e = u.pn >> 2, c0 = 256 * (u.pn & 3) + wc * 32 + 8 * fq;
        f32x4 bv[2][2];
#pragma unroll
        for (int bj = 0; bj < 2; ++bj) { bv[bj][0] = *(const f32x4*)(bdn + (size_t)e * DM + c0 + bj * 128); bv[bj][1] = *(const f32x4*)(bdn + (size_t)e * DM + c0 + bj * 128 + 4); }
        const int odd = fq & 1, cs = c0 - 8 * odd;
#pragma unroll
        for (int ai = 0; ai < 2; ++ai)
#pragma unroll
            for (int mp = 0; mp < 2; ++mp) { u32x2 pk[2][2];
#pragma unroll
                for (int h = 0; h < 2; ++h) { const int m = 2 * mp + h; const float g = row_gate[u.pm * 256 + ai * 128 + wr * 64 + m * 16 + fr] * O2_SCALE;
#pragma unroll
                    for (int bj = 0; bj < 2; ++bj) { const f32x4 v0 = (acc[ai][bj][m][0] * W8_INV + bv[bj][0]) * g, v1 = (acc[ai][bj][m][1] * W8_INV + bv[bj][1]) * g;
                        pk[bj][h] = (u32x2){pack4_f8(v0[0], v0[1], v0[2], v0[3]), pack4_f8(v1[0], v1[1], v1[2], v1[3])}; } }
                const int row = u.pm * 256 + ai * 128 + wr * 64 + (2 * mp + odd) * 16 + fr;
#pragma unroll
                for (int bj = 0; bj < 2; ++bj) *(u32x4*)(out2 + (size_t)row * DM + cs + bj * 128) = f8_pair16(pk[bj][0], pk[bj][1]); }
    } };
#ifndef FAST_Z
#define FAST_Z 1
#endif
#ifndef FAST_O
#define FAST_O 1
#endif

struct MapId { __device__ __forceinline__ int operator()(int n) const { return n; } };
struct MapIn { __device__ __forceinline__ int operator()(int n) const {
    if (n >= 384 && n < 448) { const int l = n - 384; return 384 + 2 * (l & 31) + (l >> 5); }
    if (n >= 448 && n < 1216) { const int l = n - 448, hd = l >> 7, d = l & 127; return 448 + hd * 128 + (d >> 6) * 64 + 2 * (d & 31) + ((d >> 5) & 1); }
    return n; } };
struct MapQ { __device__ __forceinline__ int operator()(int n) const { const int h = n / 192, w = n - h * 192; if (w < 128) return n; const int l = w - 128; return h * 192 + 128 + 2 * (l & 31) + (l >> 5); } };
struct MapGU { __device__ __forceinline__ int operator()(int n) const { const int a = n >> 1; return 256 * (a >> 7) + 128 * (n & 1) + (a & 127); } };
template <class Map>
__device__ __forceinline__ void transpose_item(const float* __restrict__ W, int K, int N, bf16* __restrict__ WT, LAS float* scr, int item, int lane, const Map& map, const float* __restrict__ kscale = nullptr, int ldo = 0) {
    if (ldo == 0) ldo = K;
    const int nblk = N / 32, kb = item / nblk, nb = item - kb * nblk, k0 = 64 * kb, n0 = 32 * nb;
#pragma unroll 8
    for (int i = 0; i < 32; ++i) { const int kk = 2 * i + (lane >> 5); scr[kk * 33 + (lane & 31)] = (k0 < K) ? W[(size_t)(k0 + kk) * N + n0 + (lane & 31)] * (kscale ? kscale[k0 + kk] : 1.f) : 0.f; }
    LDS_WAIT(); asm volatile("" ::: "memory");
    const int c = lane & 7;
#pragma unroll
    for (int j = 0; j < 4; ++j) { const int n = (lane >> 3) + 8 * j; const LAS float* s = scr + (8 * c) * 33 + n;
        u32x4 o; o.x = cvtpk(s[0 * 33], s[1 * 33]); o.y = cvtpk(s[2 * 33], s[3 * 33]); o.z = cvtpk(s[4 * 33], s[5 * 33]); o.w = cvtpk(s[6 * 33], s[7 * 33]);
        *(u32x4*)(WT + (size_t)map(n0 + n) * ldo + k0 + 8 * c) = o; }
    LDS_WAIT(); asm volatile("" ::: "memory");
}

template <class Map>
__device__ __forceinline__ void transpose_item_f8(const float* __restrict__ W, int K, int N, unsigned char* __restrict__ WT, LAS float* scr, int item, int lane, const Map& map, float scale) {
    const int nblk = N / 32, kb = item / nblk, nb = item - kb * nblk, k0 = 64 * kb, n0 = 32 * nb;
#pragma unroll 8
    for (int i = 0; i < 8; ++i) { const int kk = 8 * i + (lane >> 3), c4 = (lane & 7) * 4; const f32x4 w4 = *(const f32x4*)(W + (size_t)(k0 + kk) * N + n0 + c4) * scale;
        LAS float* d_ = scr + kk * 33 + c4; d_[0] = w4[0]; d_[1] = w4[1]; d_[2] = w4[2]; d_[3] = w4[3]; }
    LDS_WAIT(); asm volatile("" ::: "memory");
    const int n = lane >> 1;
#pragma unroll
    for (int j = 0; j < 2; ++j) { const int c = 2 * (lane & 1) + j; const LAS float* s_ = scr + (16 * c) * 33 + n;
        u32x4 o; o.x = pack4_f8(s_[0 * 33], s_[1 * 33], s_[2 * 33], s_[3 * 33]); o.y = pack4_f8(s_[4 * 33], s_[5 * 33], s_[6 * 33], s_[7 * 33]);
        o.z = pack4_f8(s_[8 * 33], s_[9 * 33], s_[10 * 33], s_[11 * 33]); o.w = pack4_f8(s_[12 * 33], s_[13 * 33], s_[14 * 33], s_[15 * 33]);
        *(u32x4*)(WT + (size_t)map(n0 + n) * K + k0 + 16 * c) = o; }
    LDS_WAIT(); asm volatile("" ::: "memory");
}

template <class Map>
__device__ __forceinline__ void transpose_f8_stream(const float* __restrict__ Wall, int N, unsigned char* __restrict__ WTall, LAS float* scr, int gw, int ngw, int lane, const Map& map, float scale) {
    const int nblk = N / 32, per = 16 * nblk, n_items = NE * per;
#define T8_LOAD(dst, it_) do { const int e_ = (it_) / per, r_ = (it_) - e_ * per, kb_ = r_ / nblk, nb_ = r_ - kb_ * nblk; \
        const float* wp_ = Wall + ((size_t)e_ * 1024 + 64 * kb_ + (lane >> 3)) * N + 32 * nb_ + (lane & 7) * 4; \
        _Pragma("unroll") for (int i = 0; i < 8; ++i) dst[i] = *(const f32x4*)(wp_ + (size_t)(8 * i) * N); } while (0)
    f32x4 cur[8], nxt[8];
    int it = gw; if (it < n_items) T8_LOAD(cur, it);
    for (; it < n_items; it += ngw) {
        const int itn = it + ngw; if (itn < n_items) T8_LOAD(nxt, itn);
        const int e = it / per, r = it - e * per, kb = r / nblk, nb = r - kb * nblk, k0 = 64 * kb, n0 = 32 * nb;
#pragma unroll
        for (int i = 0; i < 8; ++i) { LAS float* d_ = scr + (8 * i + (lane >> 3)) * 33 + (lane & 7) * 4; const f32x4 w4 = cur[i] * scale; d_[0] = w4[0]; d_[1] = w4[1]; d_[2] = w4[2]; d_[3] = w4[3]; }
        LDS_WAIT(); asm volatile("" ::: "memory");
        const int n = lane >> 1;
#pragma unroll
        for (int j = 0; j < 2; ++j) { const int c = 2 * (lane & 1) + j; const LAS float* s_ = scr + (16 * c) * 33 + n;
            u32x4 o; o.x = pack4_f8(s_[0 * 33], s_[1 * 33], s_[2 * 33], s_[3 * 33]); o.y = pack4_f8(s_[4 * 33], s_[5 * 33], s_[6 * 33], s_[7 * 33]);
            o.z = pack4_f8(s_[8 * 33], s_[9 * 33], s_[10 * 33], s_[11 * 33]); o.w = pack4_f8(s_[12 * 33], s_[13 * 33], s_[14 * 33], s_[15 * 33]);
            *(u32x4*)(WTall + ((size_t)e * N + map(n0 + n)) * 1024 + k0 + 16 * c) = o; }
        LDS_WAIT(); asm volatile("" ::: "memory");
#pragma unroll
        for (int i = 0; i < 8; ++i) cur[i] = nxt[i];
    }
#undef T8_LOAD
}
__device__ __forceinline__ void ln_row_f32_to_bf16(f32x4 (&v)[4], const f32x4 (&gg)[4], const f32x4 (&bb)[4], bf16* __restrict__ orow, int lane) {
    float s = 0.f;
#pragma unroll
    for (int j = 0; j < 4; ++j) s += (v[j].x + v[j].y) + (v[j].z + v[j].w);
    const float mean = wave_sum(s) * (1.f / DM); float s2 = 0.f;
#pragma unroll
    for (int j = 0; j < 4; ++j) { v[j] = v[j] - mean; s2 += (v[j].x * v[j].x + v[j].y * v[j].y) + (v[j].z * v[j].z + v[j].w * v[j].w); }
    const float rstd = rsq(wave_sum(s2) * (1.f / DM) + LN_EPS);
#pragma unroll
    for (int j = 0; j < 4; ++j) { const f32x4 o = v[j] * rstd * gg[j] + bb[j]; ((u32x2*)orow)[lane + 64 * j] = (u32x2){cvtpk(o.x, o.y), cvtpk(o.z, o.w)}; }
}

__device__ __forceinline__ void ln_row_bf16(const bf16* __restrict__ yrow, const f32x4 (&G4)[4], const f32x4 (&B4)[4], bf16* __restrict__ orow, unsigned char* __restrict__ o8, int lane) {
    float v[16]; unpack8(*(const u32x4*)(yrow + 8 * lane), *(float(*)[8])&v[0]); unpack8(*(const u32x4*)(yrow + 512 + 8 * lane), *(float(*)[8])&v[8]);
    float s = 0.f;
#pragma unroll
    for (int j = 0; j < 16; ++j) s += v[j];
    const float mean = wave_sum(s) * (1.f / DM); float s2 = 0.f;
#pragma unroll
    for (int j = 0; j < 16; ++j) { v[j] -= mean; s2 += v[j] * v[j]; }
    const float rstd = rsq(wave_sum(s2) * (1.f / DM) + LN_EPS);
#pragma unroll
    for (int hf = 0; hf < 2; ++hf) { const f32x4 a = (f32x4){v[hf * 8 + 0], v[hf * 8 + 1], v[hf * 8 + 2], v[hf * 8 + 3]} * rstd * G4[2 * hf] + B4[2 * hf], b = (f32x4){v[hf * 8 + 4], v[hf * 8 + 5], v[hf * 8 + 6], v[hf * 8 + 7]} * rstd * G4[2 * hf + 1] + B4[2 * hf + 1];
        *(u32x4*)(orow + hf * 512 + 8 * lane) = (u32x4){cvtpk(a[0], a[1]), cvtpk(a[2], a[3]), cvtpk(b[0], b[1]), cvtpk(b[2], b[3])};
        *(u32x2*)(o8 + hf * 512 + 8 * lane) = (u32x2){pack4_f8(a[0], a[1], a[2], a[3]), pack4_f8(b[0], b[1], b[2], b[3])}; }
}
__device__ __forceinline__ void zero_bytes(void* p, size_t bytes, int gtid, int ngt) {
    u32x4* q = (u32x4*)p; const size_t n = bytes / 16;
    for (size_t i = gtid; i < n; i += ngt) q[i] = (u32x4){0u, 0u, 0u, 0u};
}
__device__ __forceinline__ void sincos_d(float angf, float& sn, float& cs) {
    const double x = (double)angf; const double q = __builtin_rint(x * 0.63661977236758134308);
    const double r = (x - q * 1.57079632679489655800) - q * 6.123233995736766036e-17, r2 = r * r;
    const double sp = r * (1.0 + r2 * (-1.0 / 6 + r2 * (1.0 / 120 + r2 * (-1.0 / 5040 + r2 * (1.0 / 362880 + r2 * (-1.0 / 39916800 + r2 * (1.0 / 6227020800.0)))))));
    const double cp = 1.0 + r2 * (-0.5 + r2 * (1.0 / 24 + r2 * (-1.0 / 720 + r2 * (1.0 / 40320 + r2 * (-1.0 / 3628800 + r2 * (1.0 / 479001600.0))))));
    const int qi = ((int)q) & 3;
    const double s_ = (qi == 0) ? sp : (qi == 1) ? cp : (qi == 2) ? -sp : -cp;
    const double c_ = (qi == 0) ? cp : (qi == 1) ? -sp : (qi == 2) ? -cp : sp;
    sn = (float)s_; cs = (float)c_;
}

__device__ __forceinline__ void p2a_row(int row, u32x4 wA, u32x4 wB, u32x4 wC, const float* __restrict__ rope, const float* __restrict__ g_q_a, const float* __restrict__ g_kv_a,
                                        const float* __restrict__ g_q_gqa, const float* __restrict__ g_k_gqa, float* rs_q, float* rs_kv, bf16* km, bf16* qg, bf16* kg, bf16* vg, int lane) {
    const bool meta = row >= NTOK;
    const int b = row >> 11, s = row & 2047, m = row - NTOK;
    const int pos1 = meta ? m : 16 + s, prow = meta ? -1 : (s >> 6), pcol = meta ? m : (s & 63), key = meta ? 2048 + m : s;
    {
        float f[8]; unpack8(wA, f);
        float ss = 0.f;
#pragma unroll
        for (int j = 0; j < 8; ++j) ss += f[j] * f[j];
        ss += __shfl_xor(ss, 1); ss += __shfl_xor(ss, 2); ss += __shfl_xor(ss, 4); ss += __shfl_xor(ss, 8);
        const float s16 = ss, s32 = ss + __shfl_xor(ss, 16);
        if (lane == 0) rs_q[row] = rsq(s32 * (1.f / 256) + RMS_EPS);
        if (lane == 32) rs_kv[row] = rsq(s16 * (1.f / 128) + RMS_EPS);
        if (lane < 48) {
        } else if (lane < 56) { const int i0 = 4 * (lane - 48); const float* t = rope + ((size_t)(pos1 + 1) * 32 + i0) * 2; float o[8];
#pragma unroll
            for (int j = 0; j < 4; ++j) { const float c = t[2 * j], sn = t[2 * j + 1], x1 = f[2 * j], x2 = f[2 * j + 1]; o[2 * j] = x1 * c - x2 * sn; o[2 * j + 1] = x1 * sn + x2 * c; }
            const u32x4 pk = pack8(o);
            if (!meta) { for (int h = 0; h < 4; ++h) *(u32x4*)(km + ((size_t)(b * 4 + h) * LKP + key) * 192 + 128 + 8 * (lane - 48)) = pk; }
            else { for (int bb = 0; bb < NB; ++bb) for (int h = 0; h < 4; ++h) *(u32x4*)(km + ((size_t)(bb * 4 + h) * LKP + key) * 192 + 128 + 8 * (lane - 48)) = pk; }
        }
    }
    const int p0 = (lane & 15) * 8, half = p0 >> 6, i0 = (p0 & 63) >> 1;
    const int apos = half ? pcol : prow; const float* t = rope + ((size_t)(apos + 1) * 32 + i0) * 2;
    if (!meta) {
        float f[8]; unpack8(wB, f);
        float ss = 0.f;
#pragma unroll
        for (int j = 0; j < 8; ++j) ss += f[j] * f[j];
        ss += __shfl_xor(ss, 1); ss += __shfl_xor(ss, 2); ss += __shfl_xor(ss, 4); ss += __shfl_xor(ss, 8);
        const float rs = rsq(ss * (1.f / 128) + RMS_EPS); float o[8];
#pragma unroll
        for (int j = 0; j < 4; ++j) { const int d1 = half * 64 + i0 + j, d2 = d1 + 32;
            const float x1 = f[2 * j] * rs * g_q_gqa[d1], x2 = f[2 * j + 1] * rs * g_q_gqa[d2], c = t[2 * j], sn = t[2 * j + 1];
            o[2 * j] = x1 * c - x2 * sn; o[2 * j + 1] = x1 * sn + x2 * c; }
        *(u32x4*)(qg + ((size_t)(b * 4 + (lane >> 4)) * 2048 + s) * 128 + p0) = pack8(o);
    }
    {
        float f[8]; unpack8(wC, f);
        float ss = 0.f;
#pragma unroll
        for (int j = 0; j < 8; ++j) ss += f[j] * f[j];
        ss += __shfl_xor(ss, 1); ss += __shfl_xor(ss, 2); ss += __shfl_xor(ss, 4); ss += __shfl_xor(ss, 8);
        float o[8];
        if (lane < 32) { const float rs = rsq(ss * (1.f / 128) + RMS_EPS);
#pragma unroll
            for (int j = 0; j < 4; ++j) { const int d1 = half * 64 + i0 + j, d2 = d1 + 32;
                const float x1 = f[2 * j] * rs * g_k_gqa[d1], x2 = f[2 * j + 1] * rs * g_k_gqa[d2], c = t[2 * j], sn = t[2 * j + 1];
                o[2 * j] = x1 * c - x2 * sn; o[2 * j + 1] = x1 * sn + x2 * c; }
        } else {
#pragma unroll
            for (int j = 0; j < 8; ++j) o[j] = f[j];
        }
        const u32x4 pk = pack8(o); bf16* dst = lane < 32 ? kg : vg; const int hk = (lane >> 4) & 1;
        if (!meta) *(u32x4*)(dst + ((size_t)(b * 2 + hk) * LKP + key) * 128 + p0) = pk;
        else for (int bb = 0; bb < NB; ++bb) *(u32x4*)(dst + ((size_t)(bb * 2 + hk) * LKP + key) * 128 + p0) = pk;
    }
}

__device__ __forceinline__ int crow(int r, int hi) { return (r & 3) + 8 * (r >> 2) + 4 * hi; }
__device__ __forceinline__ int v_st(int k, int c) { const int kk = (k & ~0xC) | ((k & 4) << 1) | ((k & 8) >> 1); return ((kk >> 3) * 4 + (c >> 5)) * 512 + ((kk & 7) * 32 + (c & 31)) * 2; }
__device__ __forceinline__ int v_rd_base(int lane) { return ((lane & 3) << 3) | (((lane >> 2) & 3) << 6) | (((lane >> 4) & 1) << 5) | (((lane >> 5) & 1) << 8); }
constexpr int v_rd_off(int d0, int ks, int half) { return d0 * 512 + ks * 4096 + half * 2048; }
template <int OFF> __device__ __forceinline__ s16x4 tr_read(int vb) {
    s16x4 r; asm volatile("ds_read_b64_tr_b16 %0, %1 offset:%2" : "=&v"(r) : "v"(vb), "i"(OFF) : "memory"); return r;
}
template <int D0> __device__ __forceinline__ void pv_one(f32x16& od, int vb, bf16x8 pa0, bf16x8 pa1, bf16x8 pa2, bf16x8 pa3) {
    const s16x4 l0 = tr_read<v_rd_off(D0, 0, 0)>(vb), h0 = tr_read<v_rd_off(D0, 0, 1)>(vb), l1 = tr_read<v_rd_off(D0, 1, 0)>(vb), h1 = tr_read<v_rd_off(D0, 1, 1)>(vb);
    const s16x4 l2 = tr_read<v_rd_off(D0, 2, 0)>(vb), h2 = tr_read<v_rd_off(D0, 2, 1)>(vb), l3 = tr_read<v_rd_off(D0, 3, 0)>(vb), h3 = tr_read<v_rd_off(D0, 3, 1)>(vb);
    asm volatile("s_waitcnt lgkmcnt(0)" ::: "memory"); SBAR();
#define PK(L, H) (bf16x8){L[0], L[1], L[2], L[3], H[0], H[1], H[2], H[3]}
    od = __builtin_amdgcn_mfma_f32_32x32x16_bf16(pa0, PK(l0, h0), od, 0, 0, 0);
    od = __builtin_amdgcn_mfma_f32_32x32x16_bf16(pa1, PK(l1, h1), od, 0, 0, 0);
    od = __builtin_amdgcn_mfma_f32_32x32x16_bf16(pa2, PK(l2, h2), od, 0, 0, 0);
    od = __builtin_amdgcn_mfma_f32_32x32x16_bf16(pa3, PK(l3, h3), od, 0, 0, 0);
#undef PK
}
__device__ __forceinline__ void pv_d0(f32x16* o, int vb, bf16x8 pa0, bf16x8 pa1, bf16x8 pa2, bf16x8 pa3) {
    pv_one<0>(o[0], vb, pa0, pa1, pa2, pa3); pv_one<1>(o[1], vb, pa0, pa1, pa2, pa3); pv_one<2>(o[2], vb, pa0, pa1, pa2, pa3); pv_one<3>(o[3], vb, pa0, pa1, pa2, pa3);
}
template <int DQK> struct AttnC {
    static constexpr float SCALE = DQK == 192 ? 0.07216878364870322f : 0.08838834764831845f;
    static constexpr float C = SCALE * 1.4426950408889634f, THRS = 8.f / SCALE;
};
template <int DQK>
__device__ __forceinline__ void partialSM(f32x16& p0, f32x16& p1, float& m_reg, float& mn, float& alpha) {
    constexpr float C = AttnC<DQK>::C;
    float pmax = p0[0];
#pragma unroll
    for (int r = 1; r < 16; ++r) pmax = fmaxf(pmax, p0[r]);
#pragma unroll
    for (int r = 0; r < 16; ++r) pmax = fmaxf(pmax, p1[r]);
    { auto rr = __builtin_amdgcn_permlane32_swap(__float_as_uint(pmax), __float_as_uint(pmax), false, false);
      pmax = fmaxf(__uint_as_float(rr[0]), __uint_as_float(rr[1])); }
    if (__builtin_expect(__all(pmax - m_reg <= AttnC<DQK>::THRS), 1)) { mn = m_reg; alpha = 1.f; }
    else { mn = fmaxf(m_reg, pmax); alpha = __builtin_amdgcn_exp2f((m_reg - mn) * C); m_reg = mn; }
    const float mnC = -mn * C;
#pragma unroll
    for (int r = 0; r < 16; ++r) p0[r] = fmaf(p0[r], C, mnC);
#pragma unroll
    for (int r = 0; r < 16; ++r) p1[r] = fmaf(p1[r], C, mnC);
#pragma unroll
    for (int r = 0; r < 16; ++r) p0[r] = __builtin_amdgcn_exp2f(p0[r]);
}
__device__ __forceinline__ void finishSM(f32x16& p0, f32x16& p1, float alpha, float& l_reg, bf16x8& pa0, bf16x8& pa1, bf16x8& pa2, bf16x8& pa3) {
#pragma unroll
    for (int r = 0; r < 16; ++r) p1[r] = __builtin_amdgcn_exp2f(p1[r]);
    float ps = 0;
#pragma unroll
    for (int r = 0; r < 16; ++r) ps += p0[r];
#pragma unroll
    for (int r = 0; r < 16; ++r) ps += p1[r];
    { auto rr = __builtin_amdgcn_permlane32_swap(__float_as_uint(ps), __float_as_uint(ps), false, false);
      ps = __uint_as_float(rr[0]) + __uint_as_float(rr[1]); }
    l_reg = l_reg * alpha + ps;
#define PK4(P, BASE, OUT) do { unsigned a0 = cvtpk(P[BASE + 0], P[BASE + 1]), a1 = cvtpk(P[BASE + 2], P[BASE + 3]);   \
    unsigned b0 = cvtpk(P[BASE + 4], P[BASE + 5]), b1 = cvtpk(P[BASE + 6], P[BASE + 7]);                              \
    auto r0 = __builtin_amdgcn_permlane32_swap(a0, b0, false, false); auto r1 = __builtin_amdgcn_permlane32_swap(a1, b1, false, false); \
    u32x4 w = {r0[0], r1[0], r0[1], r1[1]}; OUT = *reinterpret_cast<bf16x8*>(&w); } while (0)
    PK4(p0, 0, pa0); PK4(p0, 8, pa1); PK4(p1, 0, pa2); PK4(p1, 8, pa3);
#undef PK4
}
template <int DQK>
__device__ __forceinline__ void qkt(f32x16& p0, f32x16& p1, const LAS char* Ks, const bf16x8* qr, const LAS char* ql, const int (&ko)[4]) {
    constexpr int KRB = DQK * 2;
    p0 = f32x16{}; p1 = f32x16{};
#pragma unroll
    for (int d0 = 0; d0 < DQK / 16; ++d0) { const LAS char* kp = Ks + ko[d0 & 3] + (d0 >> 2) * 128;
        const bf16x8 b0 = *(const LAS bf16x8*)(kp);
        const bf16x8 b1 = *(const LAS bf16x8*)(kp + 32 * KRB);
        bf16x8 q; if (d0 < 8) q = qr[d0]; else q = *(const LAS bf16x8*)(ql + (d0 - 8) * 1024);
        p0 = __builtin_amdgcn_mfma_f32_32x32x16_bf16(b0, q, p0, 0, 0, 0);
        p1 = __builtin_amdgcn_mfma_f32_32x32x16_bf16(b1, q, p1, 0, 0, 0); }
}
template <int DQK, int SD>
__device__ __forceinline__ void attn_body(const bf16* __restrict__ Qb, const bf16* __restrict__ Kh, const bf16* __restrict__ Vh, bf16* __restrict__ Ob, LAS char* lds, const float* __restrict__ rope, int pos0) {
    constexpr int ND0 = DQK / 16, KRB = DQK * 2, SHM_K = 64 * KRB, SHM_V = 64 * 128 * 2, NKC = DQK / 64, CPR = DQK / 8, NT = LKP / 64;
    static_assert(NT % 2 == 1, "odd tile count: the tail below takes tiles NT-2 and NT-1");
    int tid = threadIdx.x; asm volatile("" : "+v"(tid));
    const int wid = tid >> 6, lane = tid & 63, r32 = lane & 31, hi = lane >> 5;
    LAS char* V_lds = lds; LAS char* K_lds = lds + 2 * SHM_V;
    __syncthreads();
    float m_reg = -1e30f, l_reg = 0; f32x16 o[4] = {}; bf16x8 qr[8];
    const bf16* Qw = Qb + (size_t)(wid * 32 + r32) * DQK + hi * 8;
#pragma unroll
    for (int d0 = 0; d0 < 8; ++d0) qr[d0] = *reinterpret_cast<const bf16x8*>(Qw + d0 * 16);
    LAS char* ql = lds + 2 * SHM_V + 2 * SHM_K + 2048 + wid * 4096 + lane * 16;
#pragma unroll
    for (int d0 = 8; d0 < ND0; ++d0) {
        float x[8], y[8]; unpack8(*reinterpret_cast<const u32x4*>(Qw + d0 * 16), x);
        const float* t = rope + ((size_t)(pos0 + wid * 32 + r32 + 1) * 32 + (d0 - 8) * 8 + hi * 4) * 2; const f32x4 t0 = *(const f32x4*)t, t1 = *(const f32x4*)(t + 4);
        const float cs[4] = {t0[0], t0[2], t1[0], t1[2]}, sn[4] = {t0[1], t0[3], t1[1], t1[3]};
#pragma unroll
        for (int j = 0; j < 4; ++j) { y[2 * j] = x[2 * j] * cs[j] - x[2 * j + 1] * sn[j]; y[2 * j + 1] = x[2 * j] * sn[j] + x[2 * j + 1] * cs[j]; }
        *(LAS u32x4*)(ql + (d0 - 8) * 1024) = pack8(y); }
    const int sr = tid >> 4, sc = (tid & 15) * 8, vst0 = v_st(sr, sc), vst1 = v_st(32 + sr, sc);
    int kst[NKC];
#pragma unroll
    for (int c = 0; c < NKC; ++c) { const int id = tid + 512 * c, kr = id / CPR, kc = (id - kr * CPR) * 8; kst[c] = kr * KRB + ((kc * 2) ^ ((kr & 7) << 4)); }
    const int voff = tid * 16;
    int ko[4];
#pragma unroll
    for (int q = 0; q < 4; ++q) ko[q] = r32 * KRB + ((q * 32 + hi * 16) ^ ((r32 & 7) << 4));
    const __amdgpu_buffer_rsrc_t rK = __builtin_amdgcn_make_buffer_rsrc((void*)Kh, 0, LKP * KRB, 0x00020000);
    const __amdgpu_buffer_rsrc_t rV = __builtin_amdgcn_make_buffer_rsrc((void*)Vh, 0, LKP * 256, 0x00020000);
    const int vb0 = (int)(unsigned)(uintptr_t)V_lds + v_rd_base(lane);
    struct { bf16x8 vs0, vs1, ks[NKC]; } sr_[SD];
#define SLOAD(i, k0) do { sr_[i].vs0 = __builtin_bit_cast(bf16x8, __builtin_amdgcn_raw_buffer_load_b128(rV, voff, (k0) * 256, 0)); sr_[i].vs1 = __builtin_bit_cast(bf16x8, __builtin_amdgcn_raw_buffer_load_b128(rV, voff, (k0) * 256 + 8192, 0)); \
    _Pragma("unroll") for (int c_ = 0; c_ < NKC; ++c_) sr_[i].ks[c_] = __builtin_bit_cast(bf16x8, __builtin_amdgcn_raw_buffer_load_b128(rK, voff, (k0) * KRB + c_ * 8192, 0)); } while (0)
#define SWRITE(b, i) do { *(LAS bf16x8*)(V_lds + (b) * SHM_V + vst0) = sr_[i].vs0; *(LAS bf16x8*)(V_lds + (b) * SHM_V + vst1) = sr_[i].vs1; \
    _Pragma("unroll") for (int c_ = 0; c_ < NKC; ++c_) *(LAS bf16x8*)(K_lds + (b) * SHM_K + kst[c_]) = sr_[i].ks[c_]; } while (0)
#define SWAIT() do { if constexpr (SD == 2) { if constexpr (NKC == 2) asm volatile("s_waitcnt vmcnt(4)" ::: "memory"); else asm volatile("s_waitcnt vmcnt(5)" ::: "memory"); } \
    else asm volatile("s_waitcnt vmcnt(0)" ::: "memory"); } while (0)
#define RESC(a) do { if (__any((a) < 1.f)) { int t_ = threadIdx.x; asm volatile("" : "+v"(t_)); const int r32_ = t_ & 31, hi_2 = (t_ >> 5) & 1; \
    LAS float* al_ = (LAS float*)(lds + 2 * SHM_V + 2 * SHM_K) + (t_ >> 6) * 64 + 32; if (hi_2 == 0) al_[r32_] = (a); asm volatile("s_waitcnt lgkmcnt(0)" ::: "memory"); \
    _Pragma("unroll") for (int d = 0; d < 4; ++d) _Pragma("unroll") for (int r = 0; r < 16; ++r) o[d][r] *= al_[crow(r, hi_2)]; } } while (0)
    f32x16 pA0, pA1, pB0, pB1; float mnA, mnB, alA, alB; bf16x8 pa0, pa1, pa2, pa3;
    constexpr int SE = 0, SO = SD - 1;
    SLOAD(SE, 0); asm volatile("s_waitcnt vmcnt(0)" ::: "memory"); SWRITE(0, SE); __syncthreads();
    qkt<DQK>(pA0, pA1, K_lds, qr, ql, ko); partialSM<DQK>(pA0, pA1, m_reg, mnA, alA);
    SLOAD(SO, 64); if constexpr (SD == 2) { SLOAD(SE, 128); }
    SWAIT(); SWRITE(1, SO); __syncthreads();
#pragma unroll 1
    for (int j = 1; j + 2 < NT; j += 2) {
        SBAR(); qkt<DQK>(pB0, pB1, K_lds + SHM_K, qr, ql, ko);
        finishSM(pA0, pA1, alA, l_reg, pa0, pa1, pa2, pa3); SBAR();
        SLOAD(SO, (j + SD) * 64); SBAR();
        pv_d0(o, vb0, pa0, pa1, pa2, pa3); partialSM<DQK>(pB0, pB1, m_reg, mnB, alB);
        __syncthreads(); SWAIT(); SWRITE(0, SE);
        RESC(alB); __syncthreads();
        SBAR(); qkt<DQK>(pA0, pA1, K_lds, qr, ql, ko);
        finishSM(pB0, pB1, alB, l_reg, pa0, pa1, pa2, pa3); SBAR();
        SLOAD(SE, (j + 1 + SD) * 64); SBAR();
        pv_d0(o, vb0 + SHM_V, pa0, pa1, pa2, pa3); partialSM<DQK>(pA0, pA1, m_reg, mnA, alA);
        __syncthreads(); SWAIT(); SWRITE(1, SO);
        RESC(alA); __syncthreads();
    }
    SBAR(); qkt<DQK>(pB0, pB1, K_lds + SHM_K, qr, ql, ko);
    finishSM(pA0, pA1, alA, l_reg, pa0, pa1, pa2, pa3); SBAR();
    if constexpr (SD == 1) { SLOAD(SE, (NT - 1) * 64); } SBAR();
    pv_d0(o, vb0, pa0, pa1, pa2, pa3); partialSM<DQK>(pB0, pB1, m_reg, mnB, alB);
    __syncthreads(); asm volatile("s_waitcnt vmcnt(0)" ::: "memory"); SWRITE(0, SE);
    RESC(alB); __syncthreads();
    SBAR(); qkt<DQK>(pA0, pA1, K_lds, qr, ql, ko);
#pragma unroll
    for (int r = 8; r < 16; ++r) pA0[r] = -1e30f;
#pragma unroll
    for (int r = 0; r < 16; ++r) pA1[r] = -1e30f;
    finishSM(pB0, pB1, alB, l_reg, pa0, pa1, pa2, pa3); SBAR();
    pv_d0(o, vb0 + SHM_V, pa0, pa1, pa2, pa3); partialSM<DQK>(pA0, pA1, m_reg, mnA, alA);
    RESC(alA);
    finishSM(pA0, pA1, alA, l_reg, pa0, pa1, pa2, pa3); SBAR();
    pv_d0(o, vb0, pa0, pa1, pa2, pa3);
    { int t_ = threadIdx.x; asm volatile("" : "+v"(t_)); const int r32_ = t_ & 31, hi_2 = (t_ >> 5) & 1, wid_ = t_ >> 6;
      LAS float* li_ = (LAS float*)(lds + 2 * SHM_V + 2 * SHM_K) + wid_ * 64;
      if (hi_2 == 0) li_[r32_] = l_reg; asm volatile("s_waitcnt lgkmcnt(0)" ::: "memory");
      float rli[16];
#pragma unroll
      for (int r = 0; r < 16; ++r) rli[r] = __builtin_amdgcn_rcpf(li_[crow(r, hi_2)]);
      bf16* Ow = Ob + (size_t)(wid_ * 32) * DM;
#pragma unroll
      for (int r = 0; r < 16; ++r) { const int orow = crow(r, hi_2);
#pragma unroll
          for (int d0 = 0; d0 < 4; ++d0) Ow[(size_t)orow * DM + d0 * 32 + r32_] = (bf16)(cvtpk(o[d0][r] * rli[r], 0.f) & 0xffffu); } }
#undef SLOAD
#undef SWRITE
#undef SWAIT
#undef RESC
}

constexpr int NPHASE = 14;
struct Args { const float* in[24]; float* out; unsigned char* ws; int ph_lo, ph_hi; };
__global__ void __launch_bounds__(NWAVES * 64, 2) hymba_fwd(Args args) {
    extern __shared__ __attribute__((aligned(16))) unsigned char lds[];
    { int t0 = threadIdx.x; asm volatile("" : "+v"(t0)); for (int u = t0; u < 1024; u += NWAVES * 64) ((LAS unsigned*)((LAS unsigned char*)lds + LDSCTL_OFF))[u] = 0u; }
    __syncthreads();
#define XB_OBJ(b_) XcdBarrier b_; { const CAS unsigned char* kq_ = (const CAS unsigned char*)__builtin_amdgcn_kernarg_segment_ptr(); asm volatile("" : "+s"(kq_)); \
    b_.bar = (unsigned*)(*(unsigned char* const CAS*)(kq_ + 200) + WS_CTL) + CW_BAR; b_.x = xb_xcc_id(); b_.st = (volatile LAS unsigned*)((LAS unsigned char*)lds + LDSCTL_OFF) + 8; }
#if !MK_SPLIT
    { XB_OBJ(b0_); (void)xcd_barrier_post(b0_.bar, b0_.st); }
#define GRID_BAR() do { XB_OBJ(bb_); xcd_barrier(bb_); } while (0)
#else
#define GRID_BAR() do {} while (0)
#endif
    const int lo = args.ph_lo, hi_ = args.ph_hi;
#ifndef REP_MASK
#define REP_MASK 0
#endif
#define IN(k) (lo <= (k) && (k) < hi_)
#define REPS(k) (((REP_MASK >> (k)) & 1) ? 2 : 1)
#define SEAM(k) do { if (IN(k) && IN((k) + 1)) GRID_BAR(); } while (0)

#define PTRS \
    int bx = blockIdx.x; asm volatile("" : "+s"(bx)); const int G = gridDim.x, vcu = (G % 8 == 0) ? (bx % 8) * (G / 8) + bx / 8 : bx; \
    const int tid = threadIdx.x, lane = tid & 63, wave = __builtin_amdgcn_readfirstlane(tid >> 6); \
    const int gw = vcu * NWAVES + wave, ngw = G * NWAVES, gtid = vcu * (NWAVES * 64) + tid, ngt = G * NWAVES * 64; (void)gw; (void)ngw; (void)gtid; (void)ngt; (void)lane; \
    const CAS unsigned char* kp_ = (const CAS unsigned char*)__builtin_amdgcn_kernarg_segment_ptr(); asm volatile("" : "+s"(kp_)); \
    const float* const CAS* kin = (const float* const CAS*)kp_; unsigned char* ws = *(unsigned char* const CAS*)(kp_ + 200); float* outp = *(float* const CAS*)(kp_ + 192); (void)outp; (void)kin; \
    const float* x = kin[0]; const float* meta_tok = kin[1]; \
    float* rope = (float*)(ws + WS_ROPE); \
    bf16* w_in_t = (bf16*)(ws + WS_WIN); bf16* w_qb_t = (bf16*)(ws + WS_WQB); bf16* w_kvb_t = (bf16*)(ws + WS_WKVB); bf16* w_o_t = (bf16*)(ws + WS_WO); \
    bf16* w_r_t = (bf16*)(ws + WS_WR); unsigned char* w_gu8 = ws + WS_WGU; unsigned char* w_dn8 = ws + WS_WDN; unsigned char* h1f8 = ws + WS_H1F8; \
    bf16* h0 = (bf16*)(ws + WS_H0); bf16* h1 = (bf16*)(ws + WS_H1); float* rs_q = (float*)(ws + WS_QAN); float* rs_kv = rs_q + MPAD; bf16* z = (bf16*)(ws + WS_Z); \
    bf16* qm = (bf16*)(ws + WS_QM); bf16* km = (bf16*)(ws + WS_KM); bf16* vm = (bf16*)(ws + WS_VM); bf16* qg = (bf16*)(ws + WS_QG); bf16* kg = (bf16*)(ws + WS_KG); bf16* vg = (bf16*)(ws + WS_VG); \
    bf16* ob = (bf16*)(ws + WS_O); bf16* y1 = (bf16*)(ws + WS_Y1); float* logits = (float*)(ws + WS_LOGITS); \
    int* topk = (int*)(ws + WS_TOPK); float* gate = (float*)(ws + WS_GATE); int* pair_pos = (int*)(ws + WS_PAIRPOS); float* row_gate = (float*)(ws + WS_ROWGATE); \
    int* hist = (int*)(ws + WS_HIST); int* moetab = (int*)(ws + WS_MOETAB); int* tile_expert = moetab + 256; \
    unsigned char* xs8 = ws + WS_XS; unsigned char* act8 = ws + WS_ACT; unsigned char* out2 = ws + WS_OUT2;


    for (int rep_ = 0; rep_ < (IN(0) ? REPS(0) : 0); ++rep_) { if (rep_) GRID_BAR(); PTRS;
        LAS float* scr = (LAS float*)((LAS unsigned char*)lds + wave * 16384);
        constexpr int I_IN = 16 * 46, I_QB = 4 * 24, I_KVB = 4 * 32, I_O = 16 * 32, I_R = 16;
        constexpr int NITEMS = I_IN + I_QB + I_KVB + I_O + I_R;
        for (int it = gw; it < NITEMS; it += ngw) {
            int r = it;
            if (r < I_IN) { transpose_item(kin[4], 1024, NIN, w_in_t, scr, r, lane, MapIn()); continue; } r -= I_IN;
            if (r < I_QB) { transpose_item(kin[6], 256, 768, w_qb_t, scr, r, lane, MapQ(), kin[5]); continue; } r -= I_QB;
            if (r < I_KVB) { transpose_item(kin[8], 128, 1024, w_kvb_t, scr, r, lane, MapId(), kin[7], 256); continue; } r -= I_KVB;
            if (r < I_O) { transpose_item(kin[13], 1024, 1024, w_o_t, scr, r, lane, MapId()); continue; } r -= I_O;
            transpose_item(kin[16], 1024, 32, w_r_t, scr, r, lane, MapId());
        }
        transpose_f8_stream(kin[18], 2048, w_gu8, scr, gw, ngw, lane, MapGU(), W8_SCALE);
        transpose_f8_stream(kin[20], 1024, w_dn8, scr, gw, ngw, lane, MapId(), W8_SCALE);
        { f32x4 gg[4], bb[4], cv[4], nv[4];
#pragma unroll
          for (int j = 0; j < 4; ++j) { gg[j] = ((const f32x4*)kin[2])[lane + 64 * j]; bb[j] = ((const f32x4*)kin[3])[lane + 64 * j]; }
#define LN_LOAD(dst, m_) do { const float* xr_ = (m_) < NTOK ? x + (size_t)(m_) * DM : meta_tok + (size_t)((m_) - NTOK) * DM; _Pragma("unroll") for (int j = 0; j < 4; ++j) dst[j] = ((const f32x4*)xr_)[lane + 64 * j]; } while (0)
          if (gw < MROWS) LN_LOAD(cv, gw);
          for (int m = gw; m < MROWS; m += ngw) { const int mn = m + ngw < MROWS ? m + ngw : m; LN_LOAD(nv, mn);
              ln_row_f32_to_bf16(cv, gg, bb, h0 + (size_t)m * DM, lane);
#pragma unroll
              for (int j = 0; j < 4; ++j) cv[j] = nv[j]; }
#undef LN_LOAD
        }
        zero_bytes(h0 + (size_t)MROWS * DM, (size_t)(MPAD - MROWS) * DM * 2, gtid, ngt);
        zero_bytes(w_in_t + (size_t)NIN * 1024, (size_t)(ZLD - NIN) * 1024 * 2, gtid, ngt);
        for (int i = gw; i < 64 + 64 + 32 + 32; i += ngw) {
            bf16* p; size_t rb;
            if (i < 64) { p = km + ((size_t)i * LKP + 2064) * 192; rb = 48 * 192 * 2; }
            else if (i < 128) { p = vm + ((size_t)(i - 64) * LKP + 2064) * 128; rb = 48 * 128 * 2; }
            else if (i < 160) { p = kg + ((size_t)(i - 128) * LKP + 2064) * 128; rb = 48 * 128 * 2; }
            else { p = vg + ((size_t)(i - 160) * LKP + 2064) * 128; rb = 48 * 128 * 2; }
            zero_bytes(p, rb, lane, 64);
        }
        for (int i = gtid; i < 2065 * 32; i += ngt) {
            const int p = i / 32 - 1, f = i & 31; double inv = 1.0;
            for (int q = 0; q < f; ++q) inv *= 0.74989420933245582730;
            const float ang = (float)p * (float)inv; float sn, cs; sincos_d(fabsf(ang), sn, cs); if (ang < 0.f) sn = -sn;
            rope[2 * i] = cs; rope[2 * i + 1] = sn;
        }
    }
    SEAM(0);
    for (int rep_ = 0; rep_ < (IN(1) ? REPS(1) : 0); ++rep_) { if (rep_) GRID_BAR(); PTRS; EpiZ E{z};
#if FAST_Z
        { pg8::Gemm g{h0, w_in_t, NTOK, ZLD, 1024, 1024}; pg8::StaticOrder S; S.init(NTOK, ZLD, G, bx); pg8::EpiAdapt<EpiZ> EA{E, 0};
          pg8::gemm_phase<pg8::EpiAdapt<EpiZ>, pg8::StaticOrder, true, true>((LAS unsigned char*)lds, g, S, EA); }
        meta_gemm16<1024>(h0, 1024, w_in_t, NTOK, ZLD, E, gw, ngw, lane);
#else
        simple_gemm(h0, w_in_t, 1024, 0, NTOK + 64, ZLD, E, BSelNone(), gw, ngw, lane);
#endif
    }
    SEAM(1);
    for (int rep_ = 0; rep_ < (IN(2) ? REPS(2) : 0); ++rep_) { if (rep_) GRID_BAR(); PTRS;
#define P2_LOAD(m_, a_, b_, c_) do { const bf16* zr_ = z + (size_t)(m_) * ZLD; a_ = (u32x4){0u, 0u, 0u, 0u}; if (lane < 56) a_ = *(const u32x4*)(zr_ + 8 * lane); b_ = *(const u32x4*)(zr_ + 448 + 8 * lane); c_ = *(const u32x4*)(zr_ + 960 + 8 * lane); } while (0)
        u32x4 wa, wb, wc, na, nb, nc; if (gw < MROWS) P2_LOAD(gw, wa, wb, wc);
        for (int m = gw; m < MROWS; m += ngw) { const int mn = m + ngw < MROWS ? m + ngw : m; P2_LOAD(mn, na, nb, nc);
            p2a_row(m, wa, wb, wc, rope, kin[5], kin[7], kin[9], kin[10], rs_q, rs_kv, km, qg, kg, vg, lane); wa = na; wb = nb; wc = nc; }
#undef P2_LOAD
    }
    SEAM(2);
    for (int rep_ = 0; rep_ < (IN(3) ? REPS(3) : 0); ++rep_) { if (rep_) GRID_BAR(); PTRS;
        { EpiQ E{qm, rs_q}; pg8::Gemm g{z, w_qb_t, NTOK, 768, 256, ZLD}; pg8::StaticOrder S; S.init(NTOK, 768, G, bx); pg8::EpiAdapt<EpiQ> EA{E, 0};
          pg8::gemm_phase<pg8::EpiAdapt<EpiQ>, pg8::StaticOrder, true, true>((LAS unsigned char*)lds, g, S, EA); }
        { EpiKV<false> E{km, vm, rs_kv}; pg8::Gemm g{z + 256, w_kvb_t, NTOK, 1024, 256, ZLD}; pg8::StaticOrder S; S.init(NTOK, 1024, G, bx); pg8::EpiAdapt<EpiKV<false>> EA{E, 0};
          pg8::gemm_phase<pg8::EpiAdapt<EpiKV<false>>, pg8::StaticOrder, true, true>((LAS unsigned char*)lds, g, S, EA);
          EpiKV<true> EM{km, vm, rs_kv}; meta_gemm16<256>(z + 256, ZLD, w_kvb_t, NTOK, 1024, EM, gw, ngw, lane); }
    }
    SEAM(3);
    for (int rep_ = 0; rep_ < (IN(4) ? REPS(4) : 0); ++rep_) { if (rep_) GRID_BAR(); PTRS;
        for (int u = vcu; u < 1024; u += G) {
            if (u < 512) { const int b = u >> 5, h = (u >> 3) & 3, qb = u & 7, bh = b * 4 + h;
                attn_body<192, 1>(qm + ((size_t)bh * 2048 + qb * 256) * 192, km + (size_t)bh * LKP * 192, vm + (size_t)bh * LKP * 128, ob + ((size_t)b * 2048 + qb * 256) * DM + h * 128, (LAS char*)lds, rope, 16 + qb * 256);
            } else { const int v = u - 512, b = v >> 5, h = (v >> 3) & 3, qb = v & 7, bh = b * 4 + h, bk = b * 2 + (h >> 1);
                attn_body<128, 2>(qg + ((size_t)bh * 2048 + qb * 256) * 128, kg + (size_t)bk * LKP * 128, vg + (size_t)bk * LKP * 128, ob + ((size_t)b * 2048 + qb * 256) * DM + 512 + h * 128, (LAS char*)lds, rope, 0);
            }
        }
    }
    SEAM(4);
    for (int rep_ = 0; rep_ < (IN(5) ? REPS(5) : 0); ++rep_) { if (rep_) GRID_BAR(); PTRS;
        for (int m = gw; m < NTOK; m += ngw) {
#pragma unroll
            for (int g = 0; g < 2; ++g) { bf16* p = ob + (size_t)m * DM + g * 512 + 8 * lane; float f[8]; unpack8(*(const u32x4*)p, f);
                float ss = 0.f;
#pragma unroll
                for (int j = 0; j < 8; ++j) ss += f[j] * f[j];
                const float rs = rsq(wave_sum(ss) * (1.f / 512) + RMS_EPS); const float* gg = (g ? kin[12] : kin[11]) + 8 * lane;
#pragma unroll
                for (int j = 0; j < 8; ++j) f[j] = f[j] * rs * gg[j];
                *(u32x4*)p = pack8(f); }
        }
    }
    SEAM(5);
    for (int rep_ = 0; rep_ < (IN(6) ? REPS(6) : 0); ++rep_) { if (rep_) GRID_BAR(); PTRS; EpiO E{y1, h0};
#if FAST_O
        pg8::Gemm g{ob, w_o_t, NTOK, 1024, 1024, 1024}; pg8::StaticOrder S; S.init(NTOK, 1024, G, bx); pg8::EpiAdapt<EpiO> EA{E, 0};
        pg8::gemm_phase<pg8::EpiAdapt<EpiO>, pg8::StaticOrder, true, true>((LAS unsigned char*)lds, g, S, EA);
#else
        simple_gemm(ob, w_o_t, 1024, 0, NTOK, 1024, E, BSelNone(), gw, ngw, lane);
#endif
    }
    SEAM(6);
#ifndef MOE_SKEW_TICKS
#define MOE_SKEW_TICKS 0
#endif
#define MOE_STAGGER(nunits) do { const int rem_ = (nunits) % G; if (MOE_SKEW_TICKS > 0 && rem_ != 0 && bx >= rem_) { const unsigned long long t0_ = __builtin_amdgcn_s_memrealtime(), w_ = (unsigned long long)(MOE_SKEW_TICKS * ((bx - rem_) % 3 + 1)); \
    while (__builtin_amdgcn_s_memrealtime() - t0_ < w_) __builtin_amdgcn_s_sleep(16); } } while (0)
#define ROUTE_VARS const int tpb = (NTOK + G - 1) / G, tok_lo = bx * tpb, tok_hi = (tok_lo + tpb < NTOK) ? tok_lo + tpb : NTOK; \
    LAS int* L_hist = (LAS int*)((LAS unsigned char*)lds + LDSCTL_OFF + 256); LAS int* L_n = L_hist + 32; LAS int* L_base = L_hist + 64; LAS int* L_off = L_hist + 96; (void)L_n; (void)L_base; (void)L_off;
    for (int rep_ = 0; rep_ < (IN(8) ? REPS(8) : 0); ++rep_) { if (rep_) GRID_BAR(); PTRS; ROUTE_VARS;
        constexpr int WRP = 2064;
        LAS unsigned char* L_wr = (LAS unsigned char*)lds;
        for (int i = tid; i < 32 * 128; i += NWAVES * 64) { const int r = i >> 7, c = i & 127; *(LAS u32x4*)(L_wr + r * WRP + c * 16) = *(const u32x4*)(w_r_t + (size_t)r * 1024 + c * 8); }
        if (tid < 32) L_hist[tid] = 0;
        __syncthreads();
        const int fr = lane & 15, fq = lane >> 4;
        f32x4 G4[4], B4[4];
#pragma unroll
        for (int hf = 0; hf < 2; ++hf) { const int c = hf * 512 + 8 * lane; G4[2 * hf] = *(const f32x4*)(kin[14] + c); G4[2 * hf + 1] = *(const f32x4*)(kin[14] + c + 4); B4[2 * hf] = *(const f32x4*)(kin[15] + c); B4[2 * hf + 1] = *(const f32x4*)(kin[15] + c + 4); }
        for (int rb = tok_lo + wave * 16; rb < tok_hi; rb += NWAVES * 16) {
            for (int i = 0; i < 16 && rb + i < tok_hi; ++i) ln_row_bf16(y1 + (size_t)(rb + i) * DM, G4, B4, h1 + (size_t)(rb + i) * DM, h1f8 + (size_t)(rb + i) * DM, lane);
            asm volatile("s_waitcnt vmcnt(0)" ::: "memory");
            const int row = rb + fr < NTOK ? rb + fr : NTOK - 1;
            const bf16* ap = h1 + (size_t)row * DM + fq * 8;
            bf16x8 a[32];
#pragma unroll
            for (int ks = 0; ks < 32; ++ks) a[ks] = *(const bf16x8*)(ap + ks * 32);
            f32x4 acc0 = {0.f, 0.f, 0.f, 0.f}, acc1 = {0.f, 0.f, 0.f, 0.f};
            const LAS unsigned char* bp = L_wr + (8 * (fr >> 2) + (fr & 3)) * WRP + fq * 16;
#pragma unroll
            for (int ks = 0; ks < 32; ++ks) { const bf16x8 b0 = *(const LAS bf16x8*)(bp + ks * 64), b1 = *(const LAS bf16x8*)(bp + 4 * WRP + ks * 64);
                acc0 = __builtin_amdgcn_mfma_f32_16x16x32_bf16(b0, a[ks], acc0, 0, 0, 0); acc1 = __builtin_amdgcn_mfma_f32_16x16x32_bf16(b1, a[ks], acc1, 0, 0, 0); }
            const float* br = kin[17] + 8 * fq; const f32x4 bb0 = *(const f32x4*)br, bb1 = *(const f32x4*)(br + 4);
            float v[8] = {acc0[0] + bb0[0], acc0[1] + bb0[1], acc0[2] + bb0[2], acc0[3] + bb0[3], acc1[0] + bb1[0], acc1[1] + bb1[1], acc1[2] + bb1[2], acc1[3] + bb1[3]};
            float tv[4]; int ti[4];
#pragma unroll
            for (int r = 0; r < 4; ++r) { float bv = v[0]; int bi = 8 * fq;
#pragma unroll
                for (int j = 1; j < 8; ++j) if (v[j] > bv) { bv = v[j]; bi = 8 * fq + j; }
#pragma unroll
                for (int off = 16; off <= 32; off <<= 1) { const float ov = __shfl_xor(bv, off); const int oi = __shfl_xor(bi, off); if (ov > bv || (ov == bv && oi < bi)) { bv = ov; bi = oi; } }
                tv[r] = bv; ti[r] = bi;
#pragma unroll
                for (int j = 0; j < 8; ++j) if (bi == 8 * fq + j) v[j] = -INFINITY; }
            const float e1 = __expf(tv[1] - tv[0]), e2 = __expf(tv[2] - tv[0]), e3 = __expf(tv[3] - tv[0]), inv = 1.f / (1.f + e1 + e2 + e3);
            if (fq == 0 && rb + fr < tok_hi) { const int t = rb + fr; *(int4*)(topk + (size_t)t * 4) = make_int4(ti[0], ti[1], ti[2], ti[3]); *(f32x4*)(gate + (size_t)t * 4) = (f32x4){inv, e1 * inv, e2 * inv, e3 * inv};
                atomicAdd((int*)(L_hist + ti[0]), 1); atomicAdd((int*)(L_hist + ti[1]), 1); atomicAdd((int*)(L_hist + ti[2]), 1); atomicAdd((int*)(L_hist + ti[3]), 1); }
        }
        __syncthreads();
        if (tid < 32) hist[bx * 32 + tid] = L_hist[tid];
    }
    SEAM(8);
    for (int rep_ = 0; rep_ < (IN(10) ? REPS(10) : 0); ++rep_) { if (rep_) GRID_BAR(); PTRS; ROUTE_VARS;
        if (tid < 32) { int tot = 0, before = 0; for (int b = 0; b < G; ++b) { const int h = hist[b * 32 + tid]; tot += h; if (b < bx) before += h; } L_n[tid] = tot; L_base[tid] = before; L_hist[tid] = 0; }
        __syncthreads();
        if (tid == 0) { int off = 0; for (int e = 0; e < NE; ++e) { L_off[e] = off; off += (L_n[e] + 255) & ~255; } L_off[NE] = off; }
        __syncthreads();
        LAS int* L_pos = (LAS int*)((LAS unsigned char*)lds);
        for (int p = tok_lo * 4 + tid; p < tok_hi * 4; p += NWAVES * 64) { const int e = topk[p]; const int r = atomicAdd((int*)(L_hist + e), 1); const int pos = L_off[e] + L_base[e] + r;
            row_gate[pos] = gate[p]; pair_pos[p] = pos; L_pos[p - tok_lo * 4] = pos; }
        __syncthreads();
        for (int p0 = tok_lo * 4 + wave; p0 < tok_hi * 4; p0 += NWAVES * 8) {
            u32x4 v[8]; int pos[8];
#pragma unroll
            for (int j = 0; j < 8; ++j) { const int p = p0 + j * NWAVES; pos[j] = p < tok_hi * 4 ? L_pos[p - tok_lo * 4] : -1; if (pos[j] >= 0) v[j] = ((const u32x4*)(h1f8 + (size_t)(p >> 2) * DM))[lane]; }
#pragma unroll
            for (int j = 0; j < 8; ++j) if (pos[j] >= 0) ((u32x4*)(xs8 + (size_t)pos[j] * DM))[lane] = v[j];
        }
        if (bx == 0) { if (tid == 0) moetab[0] = L_off[NE];
            if (tid < 32) { moetab[64 + tid] = L_n[tid]; moetab[128 + tid] = L_off[tid]; for (int t = L_off[tid] >> 8; t < (L_off[tid + 1] >> 8); ++t) tile_expert[t] = tid; } }
        __syncthreads();
    }
    SEAM(10);
    for (int rep_ = 0; rep_ < (IN(11) ? REPS(11) : 0); ++rep_) { if (rep_) GRID_BAR(); PTRS; const int rows = moetab[0]; EpiGU8 E{act8, kin[19]};
        pg8::Gemm g{(const bf16*)xs8, (const bf16*)w_gu8, rows, 2048, 512, 512}; pg8::MoeOrder S; S.init(rows >> 8, 8, G, bx, tile_expert);
        MOE_STAGGER((rows >> 8) * 8);
        pg8::gemm_phase<EpiGU8, pg8::MoeOrder, true, true, true>((LAS unsigned char*)lds, g, S, E);
    }
    SEAM(11);
    for (int rep_ = 0; rep_ < (IN(12) ? REPS(12) : 0); ++rep_) { if (rep_) GRID_BAR(); PTRS; const int rows = moetab[0]; EpiDN8 E{out2, kin[21], row_gate};
        pg8::Gemm g{(const bf16*)act8, (const bf16*)w_dn8, rows, 1024, 512, 512}; pg8::MoeOrder S; S.init(rows >> 8, 4, G, bx, tile_expert);
        MOE_STAGGER((rows >> 8) * 4);
        pg8::gemm_phase<EpiDN8, pg8::MoeOrder, true, true, true>((LAS unsigned char*)lds, g, S, E);
    }
    SEAM(12);
    for (int rep_ = 0; rep_ < (IN(13) ? REPS(13) : 0); ++rep_) { if (rep_) GRID_BAR(); PTRS;
        f32x4 G4[4], B4[4];
#pragma unroll
        for (int hf = 0; hf < 2; ++hf) { const int c = hf * 512 + 8 * lane; G4[2 * hf] = *(const f32x4*)(kin[22] + c); G4[2 * hf + 1] = *(const f32x4*)(kin[22] + c + 4); B4[2 * hf] = *(const f32x4*)(kin[23] + c); B4[2 * hf + 1] = *(const f32x4*)(kin[23] + c + 4); }
        int4 pp = gw < NTOK ? *(const int4*)(pair_pos + (size_t)gw * 4) : make_int4(0, 0, 0, 0);
        for (int t = gw; t < NTOK; t += ngw) {
            const int ps[4] = {pp.x, pp.y, pp.z, pp.w};
            u32x4 hv[2]; u32x2 ov[4][2];
#pragma unroll
            for (int hf = 0; hf < 2; ++hf) { hv[hf] = *(const u32x4*)(h1 + (size_t)t * DM + hf * 512 + 8 * lane);
#pragma unroll
                for (int s4 = 0; s4 < 4; ++s4) ov[s4][hf] = *(const u32x2*)(out2 + (size_t)ps[s4] * DM + hf * 512 + 8 * lane); }
            if (t + ngw < NTOK) pp = *(const int4*)(pair_pos + (size_t)(t + ngw) * 4);
            float v[16];
#pragma unroll
            for (int hf = 0; hf < 2; ++hf) { float f[8]; unpack8(hv[hf], f);
                float acc8[8] = {0.f, 0.f, 0.f, 0.f, 0.f, 0.f, 0.f, 0.f};
#pragma unroll
                for (int s4 = 0; s4 < 4; ++s4) {
#pragma unroll
                    for (int w = 0; w < 2; ++w) { const unsigned d = w ? ov[s4][hf].y : ov[s4][hf].x;
                        const f32x2 lo = __builtin_amdgcn_cvt_pk_f32_fp8((int)d, false), hi2 = __builtin_amdgcn_cvt_pk_f32_fp8((int)d, true);
                        acc8[4 * w + 0] += lo[0]; acc8[4 * w + 1] += lo[1]; acc8[4 * w + 2] += hi2[0]; acc8[4 * w + 3] += hi2[1]; } }
#pragma unroll
                for (int j = 0; j < 8; ++j) v[hf * 8 + j] = ALPHA * f[j] + O2_INV * acc8[j]; }
            float s = 0.f;
#pragma unroll
            for (int j = 0; j < 16; ++j) s += v[j];
            const float mean = wave_sum(s) * (1.f / DM); float s2 = 0.f;
#pragma unroll
            for (int j = 0; j < 16; ++j) { v[j] -= mean; s2 += v[j] * v[j]; }
            const float rstd = rsq(wave_sum(s2) * (1.f / DM) + LN_EPS);
#pragma unroll
            for (int hf = 0; hf < 2; ++hf) { float* o = outp + (size_t)t * DM + hf * 512 + 8 * lane;
                *(f32x4*)o = (f32x4){v[hf * 8 + 0], v[hf * 8 + 1], v[hf * 8 + 2], v[hf * 8 + 3]} * rstd * G4[2 * hf] + B4[2 * hf];
                *(f32x4*)(o + 4) = (f32x4){v[hf * 8 + 4], v[hf * 8 + 5], v[hf * 8 + 6], v[hf * 8 + 7]} * rstd * G4[2 * hf + 1] + B4[2 * hf + 1]; }
        }
    }
#undef IN
#undef SEAM
}

extern "C" void kernel_launch(void* const* d_in, const int* in_sizes, int n_in, void* d_out, int out_size, void* d_ws, size_t ws_size, hipStream_t stream) {
    static int grid = 0;
    if (grid == 0) {
        if (n_in != 24 || in_sizes[0] != NTOK * DM || out_size != NTOK * DM || ws_size < WS_END) { fprintf(stderr, "kernel_launch: shape/workspace mismatch (n_in %d, ws %zu)\n", n_in, ws_size); grid = -1; return; }
        int dev = 0, cus = 0, per_cu = 0;
        if (hipGetDevice(&dev) != hipSuccess || hipDeviceGetAttribute(&cus, hipDeviceAttributeMultiprocessorCount, dev) != hipSuccess) { grid = -1; return; }
        if (hipFuncSetAttribute((const void*)hymba_fwd, hipFuncAttributeMaxDynamicSharedMemorySize, LDS_BYTES) != hipSuccess) { fprintf(stderr, "kernel_launch: hipFuncSetAttribute failed\n"); grid = -1; return; }
        if (hipOccupancyMaxActiveBlocksPerMultiprocessor(&per_cu, (const void*)hymba_fwd, NWAVES * 64, LDS_BYTES) != hipSuccess || per_cu < 1) fprintf(stderr, "kernel_launch: occupancy query says %d\n", per_cu);
        (void)hipGetLastError();
        grid = cus;
    }
    if (grid < 0) return;
    (void)hipMemsetAsync((char*)d_ws + WS_CTL, 0, CTL_ZERO_BYTES, stream);
    Args a{};
    for (int i = 0; i < 24; ++i) a.in[i] = (const float*)d_in[i];
    a.out = (float*)d_out; a.ws = (unsigned char*)d_ws;
#if MK_SPLIT
    for (int p = 0; p < NPHASE; ++p) { a.ph_lo = p; a.ph_hi = p + 1; hipLaunchKernelGGL(hymba_fwd, dim3(grid), dim3(NWAVES * 64), LDS_BYTES, stream, a); }
#else
    a.ph_lo = 0; a.ph_hi = NPHASE; hipLaunchKernelGGL(hymba_fwd, dim3(grid), dim3(NWAVES * 64), LDS_BYTES, stream, a);
#endif
}
```

```cpp
#include <hip/hip_runtime.h>
#include <cstdio>
#include <cstdint>

#ifndef MK_SPLIT
#define MK_SPLIT 0
#endif

#define LAS __attribute__((address_space(3)))
#define CAS __attribute__((address_space(4)))
typedef unsigned short bf16;
typedef short bf16x8 __attribute__((ext_vector_type(8)));
typedef short s16x4 __attribute__((ext_vector_type(4)));
typedef float f32x2 __attribute__((ext_vector_type(2)));
typedef float f32x4 __attribute__((ext_vector_type(4)));
typedef float f32x16 __attribute__((ext_vector_type(16)));
typedef unsigned u32x2 __attribute__((ext_vector_type(2)));
typedef unsigned u32x4 __attribute__((ext_vector_type(4)));
typedef __bf16 bf16x2_t __attribute__((ext_vector_type(2)));

constexpr int NB = 16, SEQ = 2048, DM = 1024, NMETA = 16;
constexpr int NTOK = NB * SEQ;
constexpr int MROWS = NTOK + NMETA;
constexpr int MPAD = 33024;
constexpr int LKP = 2112;
constexpr int NIN = 1472, ZLD = 1536;
constexpr int NE = 32, NPAIR = NTOK * 4, MOE_TILES_MAX = 544, MOE_ROWS_MAX = MOE_TILES_MAX * 256;
constexpr float ALPHA = 1.189207115002721f;
constexpr float RMS_EPS = 1e-6f, LN_EPS = 1e-5f;

constexpr size_t MiB = 1u << 20;
constexpr size_t WS_CTL = 0, CTL_ZERO_BYTES = 1 * MiB;
constexpr size_t WS_ROPE = 1 * MiB;
constexpr size_t WS_WQB = 2 * MiB;
constexpr size_t WS_WKVB = 2 * MiB + 512 * 1024;
constexpr size_t WS_WR = 3 * MiB;
constexpr size_t WS_LOGITS = 4 * MiB;
constexpr size_t WS_TOPK = 8 * MiB;
constexpr size_t WS_GATE = 8 * MiB + 512 * 1024;
constexpr size_t WS_PAIRPOS = 9 * MiB;
constexpr size_t WS_ROWGATE = 9 * MiB + 512 * 1024;
constexpr size_t WS_HIST = 10 * MiB + 512 * 1024;
constexpr size_t WS_MOETAB = 10 * MiB + 768 * 1024;
constexpr size_t WS_WIN = 12 * MiB;
constexpr size_t WS_WO = 15 * MiB;
constexpr size_t WS_WGU = 32 * MiB;
constexpr size_t WS_WDN = 96 * MiB;
constexpr size_t WS_H1F8 = 128 * MiB;
constexpr size_t WS_H0 = 224 * MiB;
constexpr size_t WS_H1 = 289 * MiB;
constexpr size_t WS_QAN = 353 * MiB;
constexpr size_t WS_KVAN = 370 * MiB;
constexpr size_t WS_Z = 380 * MiB;
constexpr size_t WS_QM = 477 * MiB;
constexpr size_t WS_KM = 525 * MiB;
constexpr size_t WS_VM = 575 * MiB;
constexpr size_t WS_QG = 608 * MiB;
constexpr size_t WS_KG = 640 * MiB;
constexpr size_t WS_VG = 657 * MiB;
constexpr size_t WS_O = 674 * MiB;
constexpr size_t WS_Y1 = 738 * MiB;
constexpr size_t WS_XS = 380 * MiB;
constexpr size_t WS_ACT = 516 * MiB;
constexpr size_t WS_OUT2 = 652 * MiB;
constexpr size_t WS_END = 924 * MiB;
static_assert(WS_Z + (size_t)MPAD * ZLD * 2 <= WS_QM && WS_QM + (size_t)64 * 2048 * 192 * 2 <= WS_KM && WS_KM + (size_t)64 * LKP * 192 * 2 <= WS_VM && WS_VM + (size_t)64 * LKP * 128 * 2 <= WS_QG, "ws map 1");
static_assert(WS_QG + (size_t)64 * 2048 * 128 * 2 <= WS_KG && WS_KG + (size_t)32 * LKP * 128 * 2 <= WS_VG && WS_VG + (size_t)32 * LKP * 128 * 2 <= WS_O && WS_O + (size_t)NTOK * DM * 2 <= WS_Y1 && WS_Y1 + (size_t)NTOK * DM * 4 <= WS_END, "ws map 2");
static_assert(WS_XS + (size_t)MOE_ROWS_MAX * DM <= WS_ACT && WS_ACT + (size_t)MOE_ROWS_MAX * DM <= WS_OUT2 && WS_OUT2 + (size_t)MOE_ROWS_MAX * DM * 2 <= WS_END && WS_WGU + (size_t)NE * 2048 * 1024 <= WS_WDN && WS_WDN + (size_t)NE * 1024 * 1024 <= WS_H1F8 && WS_H1F8 + (size_t)NTOK * DM <= WS_H0, "ws map 3");
static_assert(WS_H0 + (size_t)MPAD * DM * 2 <= WS_H1 && WS_H1 + (size_t)NTOK * DM * 2 <= WS_QAN && WS_QAN + (size_t)MPAD * 256 * 2 <= WS_KVAN && WS_KVAN + (size_t)MPAD * 128 * 2 <= WS_Z, "ws map 4");
constexpr int CW_BAR = 4096;

constexpr int RING_BYTES = 131072;
constexpr int LDSCTL_OFF = RING_BYTES;
constexpr int LDS_BYTES = 147456;
constexpr int NWAVES = 8;

#define LDS_WAIT() asm volatile("s_waitcnt lgkmcnt(0)" ::: "memory")
#define SBAR() __builtin_amdgcn_sched_barrier(0)
__device__ __forceinline__ unsigned cvtpk(float lo, float hi) { f32x2 v = {lo, hi}; bf16x2_t b = __builtin_convertvector(v, bf16x2_t); return __builtin_bit_cast(unsigned, b); }
__device__ __forceinline__ u32x4 pack8(const float (&v)[8]) { u32x4 r = {cvtpk(v[0], v[1]), cvtpk(v[2], v[3]), cvtpk(v[4], v[5]), cvtpk(v[6], v[7])}; return r; }
__device__ __forceinline__ void unpack8(u32x4 w, float (&v)[8]) {
    v[0] = __uint_as_float(w.x << 16); v[1] = __uint_as_float(w.x & 0xffff0000u); v[2] = __uint_as_float(w.y << 16); v[3] = __uint_as_float(w.y & 0xffff0000u);
    v[4] = __uint_as_float(w.z << 16); v[5] = __uint_as_float(w.z & 0xffff0000u); v[6] = __uint_as_float(w.w << 16); v[7] = __uint_as_float(w.w & 0xffff0000u);
}
__device__ __forceinline__ float wave_sum(float v) {
#pragma unroll
    for (int o = 1; o < 64; o <<= 1) v += __shfl_xor(v, o);
    return v;
}
__device__ __forceinline__ float rsq(float x) { return __builtin_amdgcn_rsqf(x); }
typedef int v8i __attribute__((ext_vector_type(8)));
__device__ __forceinline__ unsigned pack4_f8(float a, float b, float c, float d) { int w = 0; w = __builtin_amdgcn_cvt_pk_fp8_f32(a, b, w, false); w = __builtin_amdgcn_cvt_pk_fp8_f32(c, d, w, true); return (unsigned)w; }
constexpr float W8_SCALE = 32.f, W8_INV = 1.f / 32.f;

#define XB_TMO      128
#define XB_XCNT(j)  (256  + 64 * (j))
#define XB_XSUB(j)  (1280 + 64 * (j))
#define XB_XGEN(j)  (2304 + 64 * (j))
#define XB_TOP      3328
#define XB_TOPGEN   3392
#define XCD_BAR_WORDS 3456
#define XB_SPIN_CAP (1u << 18)
__device__ __forceinline__ unsigned xb_ld(unsigned* p)              { return __hip_atomic_load(p, __ATOMIC_RELAXED, __HIP_MEMORY_SCOPE_AGENT); }
__device__ __forceinline__ unsigned xb_add(unsigned* p, unsigned v) { return __hip_atomic_fetch_add(p, v, __ATOMIC_RELAXED, __HIP_MEMORY_SCOPE_AGENT); }
__device__ __forceinline__ unsigned xb_xcc_id() { return (unsigned)__builtin_amdgcn_s_getreg((3 << 11) | 20) & 0xFu; }
#define XB_SPIN(cond, bar) do { unsigned _sp = 0; while (cond) { __builtin_amdgcn_s_sleep(1); \
    if ((++_sp & 255u) == 0u) { if (xb_ld(&(bar)[XB_TMO])) break; if (_sp > XB_SPIN_CAP) { atomicAdd(&(bar)[XB_TMO], 1u); break; } } } } while (0)
struct XcdBarrier { unsigned* bar; unsigned x; volatile LAS unsigned* st; };
__device__ __forceinline__ XcdBarrier xcd_barrier_post(unsigned* bar, volatile LAS unsigned* st) {
    XcdBarrier b; b.bar = bar; b.x = xb_xcc_id(); b.st = st;
    if (threadIdx.x == 0) (void)xb_add(&bar[XB_XCNT(b.x)], 1u);
    return b;
}
__device__ __forceinline__ void xcd_barrier_complete(unsigned* bar, unsigned x, unsigned& nloc, unsigned& nx) {
    const unsigned G = gridDim.x * gridDim.y * gridDim.z;
    unsigned sum, cnt, mine, sp = 0u;
    for (;;) {
        sum = 0u; cnt = 0u; mine = 0u;
#pragma unroll
        for (unsigned j = 0; j < 16; ++j) { const unsigned c = xb_ld(&bar[XB_XCNT(j)]); sum += c; cnt += (c > 0u) ? 1u : 0u; mine = (j == x) ? c : mine; }
        if (sum == G) break;
        __builtin_amdgcn_s_sleep(1);
        if ((++sp & 255u) == 0u) { if (xb_ld(&bar[XB_TMO])) break; if (sp > XB_SPIN_CAP) { atomicAdd(&bar[XB_TMO], 1u); break; } }
    }
    nloc = mine > 0u ? mine : 1u; nx = cnt > 0u ? cnt : 1u;
}
__device__ __forceinline__ void xcd_barrier(const XcdBarrier& b) {
    asm volatile("s_waitcnt vmcnt(0)" ::: "memory");
    __syncthreads();
    if (threadIdx.x == 0) {
        unsigned* bar = b.bar;
        __builtin_amdgcn_s_waitcnt(0);
        unsigned nloc = b.st[0], nx = b.st[1];
        if (nloc == 0u) { xcd_barrier_complete(bar, b.x, nloc, nx); b.st[0] = nloc; b.st[1] = nx; }
        const unsigned old = xb_add(&bar[XB_XSUB(b.x)], 1u);
        const unsigned gen = old / nloc;
        if (old + 1u == (gen + 1u) * nloc) {
            __builtin_amdgcn_fence(__ATOMIC_RELEASE, "agent");
            asm volatile("s_waitcnt vmcnt(0)" ::: "memory");
            const unsigned og = xb_add(&bar[XB_TOP], 1u);
            const unsigned tg = og / nx;
            if (og + 1u == (tg + 1u) * nx) xb_add(&bar[XB_TOPGEN], 1u);
            else XB_SPIN(xb_ld(&bar[XB_TOPGEN]) == tg, bar);
            __builtin_amdgcn_fence(__ATOMIC_ACQUIRE, "agent");
            xb_add(&bar[XB_XGEN(b.x)], 1u);
            asm volatile("s_waitcnt vmcnt(0)" ::: "memory");
        } else {
            XB_SPIN(xb_ld(&bar[XB_XGEN(b.x)]) == gen, bar);
            __builtin_amdgcn_fence(__ATOMIC_ACQUIRE, "agent");
            asm volatile("s_waitcnt vmcnt(0)" ::: "memory");
        }
    }
    __syncthreads();
}

struct BSelNone { __device__ __forceinline__ size_t operator()(int) const { return 0; } };
struct BSelExpert { const int* tile_expert; size_t per; __device__ __forceinline__ size_t operator()(int m0) const { return (size_t)tile_expert[m0 >> 8] * per; } };
template <class Epi, class BSel>
__device__ __forceinline__ void simple_gemm(const bf16* __restrict__ A, const bf16* __restrict__ Bt, int K, int m_lo, int m_hi, int N, const Epi& E, const BSel& bsel, int gw, int ngw, int lane, int lda = 0) {
    if (lda == 0) lda = K;
    const int fr = lane & 15, fq = lane >> 4;
    const int mt = (m_hi - m_lo) / 64, nt = N / 32;
    for (int u = gw; u < mt * nt; u += ngw) {
        const int m0 = m_lo + (u / nt) * 64, n0 = (u % nt) * 32;
        const bf16* ap = A + (size_t)(m0 + fr) * lda + fq * 8;
        const bf16* bp = Bt + bsel(m0) + (size_t)(n0 + 8 * (fr >> 2) + (fr & 3)) * K + fq * 8;
        f32x4 acc[4][2];
#pragma unroll
        for (int i = 0; i < 4; ++i) { acc[i][0] = (f32x4){0.f, 0.f, 0.f, 0.f}; acc[i][1] = (f32x4){0.f, 0.f, 0.f, 0.f}; }
#pragma unroll 2
        for (int k = 0; k < K; k += 32) {
            bf16x8 a[4], b[2];
#pragma unroll
            for (int i = 0; i < 4; ++i) a[i] = *(const bf16x8*)(ap + (size_t)i * 16 * lda + k);
#pragma unroll
            for (int j = 0; j < 2; ++j) b[j] = *(const bf16x8*)(bp + (size_t)j * 4 * K + k);
#pragma unroll
            for (int i = 0; i < 4; ++i)
#pragma unroll
                for (int j = 0; j < 2; ++j) acc[i][j] = __builtin_amdgcn_mfma_f32_16x16x32_bf16(b[j], a[i], acc[i][j], 0, 0, 0);
        }
#pragma unroll
        for (int i = 0; i < 4; ++i) {
            const float v[8] = {acc[i][0][0], acc[i][0][1], acc[i][0][2], acc[i][0][3], acc[i][1][0], acc[i][1][1], acc[i][1][2], acc[i][1][3]};
            E.store8(m0 + 16 * i + fr, n0 + 8 * fq, v);
        }
    }
}


template <int K, class Epi>
__device__ __forceinline__ void smallk_task(const bf16* __restrict__ A, const bf16* __restrict__ Bt, int m0, int ng_lo, int ng_hi, const Epi& E, int lane) {
    constexpr int KS = K / 32;
    const int fr = lane & 15, fq = lane >> 4;
    bf16x8 a[4][KS];
#pragma unroll
    for (int i = 0; i < 4; ++i)
#pragma unroll
        for (int ks = 0; ks < KS; ++ks) a[i][ks] = *(const bf16x8*)(A + (size_t)(m0 + 16 * i + fr) * K + ks * 32 + fq * 8);
#pragma unroll 1
    for (int ng = ng_lo; ng < ng_hi; ++ng) {
        const int n0 = ng * 32;
        const bf16* bp = Bt + (size_t)(n0 + 8 * (fr >> 2) + (fr & 3)) * K + fq * 8;
        bf16x8 b[2][KS];
#pragma unroll
        for (int ks = 0; ks < KS; ++ks) { b[0][ks] = *(const bf16x8*)(bp + ks * 32); b[1][ks] = *(const bf16x8*)(bp + 4 * K + ks * 32); }
        f32x4 acc[4][2];
#pragma unroll
        for (int i = 0; i < 4; ++i) { acc[i][0] = (f32x4){0.f, 0.f, 0.f, 0.f}; acc[i][1] = (f32x4){0.f, 0.f, 0.f, 0.f}; }
#pragma unroll
        for (int ks = 0; ks < KS; ++ks)
#pragma unroll
            for (int i = 0; i < 4; ++i) { acc[i][0] = __builtin_amdgcn_mfma_f32_16x16x32_bf16(b[0][ks], a[i][ks], acc[i][0], 0, 0, 0); acc[i][1] = __builtin_amdgcn_mfma_f32_16x16x32_bf16(b[1][ks], a[i][ks], acc[i][1], 0, 0, 0); }
#pragma unroll
        for (int i = 0; i < 4; ++i) {
            const float v[8] = {acc[i][0][0], acc[i][0][1], acc[i][0][2], acc[i][0][3], acc[i][1][0], acc[i][1][1], acc[i][1][2], acc[i][1][3]};
            E.store8(m0 + 16 * i + fr, n0 + 8 * fq, v);
        }
    }
}


template <int K, class Epi>
__device__ __forceinline__ void meta_gemm16(const bf16* __restrict__ A, int lda, const bf16* __restrict__ Bt, int m0, int N, const Epi& E, int gw, int ngw, int lane) {
    const int fr = lane & 15, fq = lane >> 4;
    for (int ng = gw; ng < N / 32; ng += ngw) {
        const int n0 = ng * 32;
        const bf16* ap = A + (size_t)(m0 + fr) * lda + fq * 8;
        const bf16* bp = Bt + (size_t)(n0 + 8 * (fr >> 2) + (fr & 3)) * K + fq * 8;
        f32x4 acc0 = {0.f, 0.f, 0.f, 0.f}, acc1 = {0.f, 0.f, 0.f, 0.f};
#pragma unroll 8
        for (int k = 0; k < K; k += 32) { const bf16x8 a = *(const bf16x8*)(ap + k), b0 = *(const bf16x8*)(bp + k), b1 = *(const bf16x8*)(bp + 4 * K + k);
            acc0 = __builtin_amdgcn_mfma_f32_16x16x32_bf16(b0, a, acc0, 0, 0, 0); acc1 = __builtin_amdgcn_mfma_f32_16x16x32_bf16(b1, a, acc1, 0, 0, 0); }
        const float v[8] = {acc0[0], acc0[1], acc0[2], acc0[3], acc1[0], acc1[1], acc1[2], acc1[3]};
        E.store8(m0 + fr, n0 + 8 * fq, v);
    }
}

struct EpiZ { bf16* z;
    __device__ __forceinline__ void store8(int row, int col, const float (&v)[8]) const { if (col < NIN) *(u32x4*)(z + (size_t)row * ZLD + col) = pack8(v); } };
struct EpiQ { bf16* qm; const float* rs;
    __device__ __forceinline__ void store8(int row, int col, const float (&v_)[8]) const {
        const int h = col / 192, w = col - h * 192, b = row >> 11, s = row & 2047; const float r_ = rs[row];
        const float o[8] = {v_[0] * r_, v_[1] * r_, v_[2] * r_, v_[3] * r_, v_[4] * r_, v_[5] * r_, v_[6] * r_, v_[7] * r_};
        *(u32x4*)(qm + ((size_t)(b * 4 + h) * 2048 + s) * 192 + w) = pack8(o);
    } };
template <bool META> struct EpiKV { bf16* km; bf16* vm; const float* rs;
    __device__ __forceinline__ void store8(int row, int col, const float (&v_)[8]) const {
        if (META && row >= MROWS) return;
        const float r_ = rs[row]; const float v[8] = {v_[0] * r_, v_[1] * r_, v_[2] * r_, v_[3] * r_, v_[4] * r_, v_[5] * r_, v_[6] * r_, v_[7] * r_};
        const int h = col >> 8, w = col & 255; const u32x4 pk = pack8(v);
        if (!META) { const int b = row >> 11, key = row & 2047; const size_t r = (size_t)(b * 4 + h) * LKP + key;
            if (w < 128) *(u32x4*)(km + r * 192 + w) = pk; else *(u32x4*)(vm + r * 128 + (w - 128)) = pk;
        } else { const int key = 2048 + (row - NTOK);
            for (int b = 0; b < NB; ++b) { const size_t r = (size_t)(b * 4 + h) * LKP + key;
                if (w < 128) *(u32x4*)(km + r * 192 + w) = pk; else *(u32x4*)(vm + r * 128 + (w - 128)) = pk; } }
    } };
struct EpiO { bf16* y1; const bf16* h0;
    __device__ __forceinline__ void store8(int row, int col, const float (&v)[8]) const {
        float h[8]; unpack8(*(const u32x4*)(h0 + (size_t)row * DM + col), h);
        const float o[8] = {ALPHA * h[0] + v[0], ALPHA * h[1] + v[1], ALPHA * h[2] + v[2], ALPHA * h[3] + v[3], ALPHA * h[4] + v[4], ALPHA * h[5] + v[5], ALPHA * h[6] + v[6], ALPHA * h[7] + v[7]};
        *(u32x4*)(y1 + (size_t)row * DM + col) = pack8(o);
    } };
struct EpiLogit { float* logits; const float* bias;
    __device__ __forceinline__ void store8(int row, int col, const float (&v)[8]) const {
        float* y = logits + (size_t)row * NE + col;
        *(f32x4*)y = (f32x4){v[0] + bias[col], v[1] + bias[col + 1], v[2] + bias[col + 2], v[3] + bias[col + 3]};
        *(f32x4*)(y + 4) = (f32x4){v[4] + bias[col + 4], v[5] + bias[col + 5], v[6] + bias[col + 6], v[7] + bias[col + 7]};
    } };
namespace pg8 {
#define PG8_LAS __attribute__((address_space(3)))
typedef unsigned short bf16_t;
constexpr int BM = 256, BK = 64, HALF = 128, HTB = HALF * BK * 2, STAGE_BYTES = 8 * HTB, NXCD = 8, WGM = 8;
__host__ __device__ __forceinline__ int lds_byte(int r, int c) { const int st = (r >> 4) * 2 + (c >> 5), rr = r & 15, cc = c & 31, ob = rr * 64 + cc * 2; return st * 1024 + (ob ^ (((ob >> 9) & 1) << 5)); }
__host__ __device__ __forceinline__ void stage_rc(int b, int& R, int& C) { const int st = b / 1024, sb = b % 1024, swz = sb ^ (((sb >> 9) & 1) << 5); R = (st >> 1) * 16 + swz / 64; C = (st & 1) * 32 + (swz % 64) / 2; }
__host__ __device__ __forceinline__ int perm32(int rho) { const int n = rho >> 4, i = rho & 15; return 8 * (i >> 2) + 4 * n + (i & 3); }
struct Unit { int pm, pn; };
struct Gemm { const bf16_t* A; const bf16_t* Bt; int M, N, K, lda; const int* row_tok; };
struct StaticOrder {
    int nM, nN, nwg, G, c;
    __host__ __device__ void init(int M, int N, int G_, int c_) { nM = M / BM; nN = N / BM; nwg = nM * nN; G = G_; c = c_; }
    __host__ __device__ bool next(int i, Unit& u) const {
        const long L = (long)i * G + c; if (L >= nwg) return false;
        int wgid = (int)L; { const int q = nwg / NXCD, r = nwg % NXCD, xcd = wgid % NXCD, off = wgid / NXCD; wgid = (xcd < r ? xcd * (q + 1) : r * (q + 1) + (xcd - r) * q) + off; }
        const int nig = WGM * nN, gid = wgid / nig, fm = gid * WGM, gsz = (nM - fm) < WGM ? (nM - fm) : WGM;
        u.pm = fm + ((wgid % nig) % gsz); u.pn = (wgid % nig) / gsz; return true;
    }
    __device__ __forceinline__ void a_ready(const Unit&) const {}
    __device__ __forceinline__ void done(const Unit&) const {}
};
struct MoeOrder {
    StaticOrder so; const int* tile_expert;
    __device__ void init(int tiles, int nN, int G_, int c_, const int* te) { so.nM = tiles; so.nN = nN; so.nwg = tiles * nN; so.G = G_; so.c = c_; tile_expert = te; }
    __device__ bool next(int i, Unit& u) const { if (!so.next(i, u)) return false; u.pn += tile_expert[u.pm] * so.nN; return true; }
    __device__ __forceinline__ void a_ready(const Unit&) const {}
    __device__ __forceinline__ void done(const Unit&) const {}
};
template <class E8> struct EpiAdapt {
    static constexpr bool PERM = true, AFTER_DRAIN = false;
    E8 e; int ncols_mod;
    __device__ __forceinline__ void operator()(const f32x4 (&acc)[2][2][4][2], const Unit& u, int wr, int wc, int fr, int fq) const {
        const int row0 = u.pm * BM + wr * 64 + fr; int colt = u.pn * BM; if (ncols_mod) colt %= ncols_mod;
        const int col0 = colt + wc * 32 + 8 * fq;
#pragma unroll
        for (int ai = 0; ai < 2; ++ai)
#pragma unroll
            for (int m = 0; m < 4; ++m)
#pragma unroll
                for (int bj = 0; bj < 2; ++bj) {
                    const float v[8] = {acc[ai][bj][m][0][0], acc[ai][bj][m][0][1], acc[ai][bj][m][0][2], acc[ai][bj][m][0][3], acc[ai][bj][m][1][0], acc[ai][bj][m][1][1], acc[ai][bj][m][1][2], acc[ai][bj][m][1][3]};
                    e.store8(row0 + ai * HALF + m * 16, col0 + bj * HALF, v); }
    }
};
template <class Epi, class Sched, bool ALIGN_EPI = false, bool SP2 = false, bool F8 = false, bool GATHER = false>
__device__ __forceinline__ void gemm_phase(PG8_LAS unsigned char* lds, const Gemm g, const Sched& S, const Epi& E) {
    const int tid = threadIdx.x, wid = __builtin_amdgcn_readfirstlane(tid >> 6), lane = tid & 63, wr = wid >> 2, wc = wid & 3, fr = lane & 15, fq = lane >> 4;
    const int K = g.K, nt = K / BK;
    unsigned voffA[2], voffB[2];
#pragma unroll
    for (int i = 0; i < 2; ++i) { int R, C; stage_rc(tid * 16 + i * 8192, R, C); const int Rb = Epi::PERM ? ((R & ~31) + perm32(R & 31)) : R;
        voffA[i] = (unsigned)(R * g.lda + C) * 2u; voffB[i] = (unsigned)(Rb * K + C) * 2u; }
    int gR[2]; unsigned gC[2];
#pragma unroll
    for (int i = 0; i < 2; ++i) { int R, C; stage_rc(tid * 16 + i * 8192, R, C); gR[i] = R; gC[i] = (unsigned)C * 2u; }
    const unsigned lda2 = (unsigned)g.lda * 2u;
    unsigned vC[2][2], vN[2][2]; int tkn[2][2];
    static_assert(!GATHER || SP2, "GATHER is written for the SP2 loop");
#define PG8_TOKLD(dst, pm_) do { _Pragma("unroll") for (int h_ = 0; h_ < 2; ++h_) _Pragma("unroll") for (int i_ = 0; i_ < 2; ++i_) dst[h_][i_] = g.row_tok[(pm_) * 256 + h_ * 128 + gR[i_]]; } while (0)
#define PG8_TOKOFF(dst, src) do { _Pragma("unroll") for (int h_ = 0; h_ < 2; ++h_) _Pragma("unroll") for (int i_ = 0; i_ < 2; ++i_) dst[h_][i_] = (unsigned)src[h_][i_] * lda2 + gC[i_]; } while (0)
    const size_t kstep = (size_t)(BK * 2);
    const size_t hstep = (size_t)HALF * K * 2, hstepA = (size_t)HALF * g.lda * 2;
    const size_t tstep = 2 * hstep, tstepA = 2 * hstepA;
    const unsigned ldsw = (unsigned)wid * 1024u;
    const int aoff = lds_byte(wr * 64 + fr, fq * 8), boff = lds_byte(wc * 32 + fr, fq * 8);
#define PG8_SA(b, h) (((b) * 2 + (h)) * HTB)
#define PG8_SB(b, h) ((4 + (b) * 2 + (h)) * HTB)
#define PG8_STAGE(bufoff, gbase, voff) do { _Pragma("unroll") for (int _i = 0; _i < 2; ++_i) \
        __builtin_amdgcn_global_load_lds((const unsigned*)((const char*)(gbase) + (voff)[_i]), (PG8_LAS unsigned*)(lds + (bufoff) + ldsw + _i * 8192), 16, 0, 0); } while (0)
#define PG8_LDA(dst, b, h) do { _Pragma("unroll") for (int m = 0; m < 4; ++m) _Pragma("unroll") for (int k = 0; k < 2; ++k) dst[m][k] = *(const PG8_LAS bf16x8*)(lds + PG8_SA(b, h) + aoff + m * 2048 + k * 1024); } while (0)
#define PG8_LDB(dst, b, h) do { _Pragma("unroll") for (int n = 0; n < 2; ++n) _Pragma("unroll") for (int k = 0; k < 2; ++k) dst[n][k] = *(const PG8_LAS bf16x8*)(lds + PG8_SB(b, h) + boff + n * 2048 + k * 1024); } while (0)
#define PG8_F8CAT(x) __builtin_shufflevector(__builtin_bit_cast(u32x4, (x)[0]), __builtin_bit_cast(u32x4, (x)[1]), 0, 1, 2, 3, 4, 5, 6, 7)
#define PG8_MMA(ai, bj, At, Bt) do { __builtin_amdgcn_s_setprio(1); if constexpr (F8) { _Pragma("unroll") for (int m = 0; m < 4; ++m) _Pragma("unroll") for (int n = 0; n < 2; ++n) \
        acc[ai][bj][m][n] = __builtin_amdgcn_mfma_scale_f32_16x16x128_f8f6f4(__builtin_bit_cast(v8i, PG8_F8CAT(Bt[n])), __builtin_bit_cast(v8i, PG8_F8CAT(At[m])), acc[ai][bj][m][n], 0, 0, 0, 0x7f7f7f7f, 0, 0x7f7f7f7f); \
        _Pragma("unroll") for (int m = 0; m < 4; ++m) _Pragma("unroll") for (int n = 0; n < 2; ++n) asm volatile("" : "+v"(acc[ai][bj][m][n])); } \
    else { _Pragma("unroll") for (int m = 0; m < 4; ++m) _Pragma("unroll") for (int n = 0; n < 2; ++n) _Pragma("unroll") for (int k = 0; k < 2; ++k) \
        acc[ai][bj][m][n] = __builtin_amdgcn_mfma_f32_16x16x32_bf16(Bt[n][k], At[m][k], acc[ai][bj][m][n], 0, 0, 0); } __builtin_amdgcn_s_setprio(0); } while (0)
#define PG8_WAIT_V(n) asm volatile("s_waitcnt vmcnt(" #n ")" ::: "memory")
#define PG8_WAIT_L(n) asm volatile("s_waitcnt lgkmcnt(" #n ")" ::: "memory")
#define PG8_BAR __builtin_amdgcn_s_barrier()
#define PG8_SCHED __builtin_amdgcn_sched_barrier(0)
    Unit cur, nxt; int ui = 0;
    if (!S.next(0, cur)) return;
    f32x4 acc[2][2][4][2];
#pragma unroll
    for (int a = 0; a < 2; ++a)
#pragma unroll
        for (int b = 0; b < 2; ++b)
#pragma unroll
            for (int m = 0; m < 4; ++m)
#pragma unroll
                for (int n = 0; n < 2; ++n) acc[a][b][m][n] = (f32x4){0.f, 0.f, 0.f, 0.f};
    bf16x8 At[4][2], B0[2][2], B1[2][2];
    const char* const gA = (const char*)g.A;
    const char* cA = (const char*)g.A + (size_t)cur.pm * tstepA; const char* cB = (const char*)g.Bt + (size_t)cur.pn * tstep;
    S.a_ready(cur);
    if constexpr (SP2) {
        if constexpr (GATHER) { PG8_TOKLD(tkn, cur.pm); PG8_TOKOFF(vC, tkn); Unit u1_; if (S.next(1, u1_)) { PG8_TOKLD(tkn, u1_.pm); PG8_TOKOFF(vN, tkn); } else { PG8_TOKOFF(vN, tkn); } }
        PG8_STAGE(PG8_SB(0, 0), cB, voffB); PG8_STAGE(PG8_SB(0, 1), cB + hstep, voffB);
        if constexpr (GATHER) { PG8_STAGE(PG8_SA(0, 0), gA, vC[0]); PG8_STAGE(PG8_SA(0, 1), gA, vC[1]); } else { PG8_STAGE(PG8_SA(0, 0), cA, voffA); PG8_STAGE(PG8_SA(0, 1), cA + hstepA, voffA); }
        if (wr == 1) PG8_BAR;
        PG8_WAIT_V(2); PG8_BAR;
        PG8_STAGE(PG8_SB(1, 0), cB + kstep, voffB); if constexpr (GATHER) { PG8_STAGE(PG8_SA(1, 0), gA + kstep, vC[0]); } else { PG8_STAGE(PG8_SA(1, 0), cA + kstep, voffA); } PG8_STAGE(PG8_SB(1, 1), cB + hstep + kstep, voffB);
        PG8_WAIT_V(6); PG8_BAR;
    } else {
        PG8_STAGE(PG8_SB(0, 0), cB, voffB); PG8_STAGE(PG8_SA(0, 0), cA, voffA); PG8_STAGE(PG8_SB(0, 1), cB + hstep, voffB); PG8_STAGE(PG8_SA(0, 1), cA + hstepA, voffA);
        if (wr == 1) PG8_BAR;
        PG8_WAIT_V(4); PG8_BAR;
        PG8_STAGE(PG8_SB(1, 0), cB + kstep, voffB); PG8_STAGE(PG8_SA(1, 0), cA + kstep, voffA); PG8_STAGE(PG8_SB(1, 1), cB + hstep + kstep, voffB);
        PG8_WAIT_V(6); PG8_BAR;
    }
    for (;;) {
        const bool has_next = S.next(ui + 1, nxt);
        const char* nA = has_next ? (const char*)g.A + (size_t)nxt.pm * tstepA : cA; const char* nB = has_next ? (const char*)g.Bt + (size_t)nxt.pn * tstep : cB;
        for (int t = 0; t < nt; t += 2) {
            const bool last = (t == nt - 2);
            const char* a1 = cA + (size_t)(t + 1) * kstep;
            const char* a2 = last ? nA : cA + (size_t)(t + 2) * kstep; const char* b2 = last ? nB : cB + (size_t)(t + 2) * kstep;
            const char* a3 = a2 + kstep; const char* b3 = b2 + kstep;
            if (last && has_next) S.a_ready(nxt);
            if constexpr (SP2) {
            const char* ga1 = gA + (size_t)(t + 1) * kstep; const char* ga2 = gA + (last ? (size_t)0 : (size_t)(t + 2) * kstep); const char* ga3 = ga2 + kstep;
            unsigned v2[2][2];
            if constexpr (GATHER) { _Pragma("unroll") for (int h_ = 0; h_ < 2; ++h_) _Pragma("unroll") for (int i_ = 0; i_ < 2; ++i_) v2[h_][i_] = last ? vN[h_][i_] : vC[h_][i_]; }
            PG8_LDB(B0, 0, 0); PG8_LDB(B1, 0, 1); PG8_SCHED; PG8_LDA(At, 0, 0); if constexpr (GATHER) { PG8_STAGE(PG8_SA(1, 1), ga1, vC[1]); } else { PG8_STAGE(PG8_SA(1, 1), a1 + hstepA, voffA); }
            PG8_WAIT_V(8); PG8_WAIT_L(0); PG8_BAR; PG8_MMA(0, 0, At, B0); PG8_MMA(0, 1, At, B1); PG8_BAR; PG8_SCHED;
            PG8_LDA(At, 0, 1); PG8_STAGE(PG8_SB(0, 0), b2, voffB); PG8_STAGE(PG8_SB(0, 1), b2 + hstep, voffB); if constexpr (GATHER) { PG8_STAGE(PG8_SA(0, 0), ga2, v2[0]); } else { PG8_STAGE(PG8_SA(0, 0), a2, voffA); }
            PG8_WAIT_V(8); PG8_WAIT_L(0); PG8_BAR; PG8_MMA(1, 0, At, B0); PG8_MMA(1, 1, At, B1); PG8_BAR; PG8_SCHED;
            PG8_LDB(B0, 1, 0); PG8_LDB(B1, 1, 1); PG8_SCHED; PG8_LDA(At, 1, 0); if constexpr (GATHER) { PG8_STAGE(PG8_SA(0, 1), ga2, v2[1]); } else { PG8_STAGE(PG8_SA(0, 1), a2 + hstepA, voffA); }
            PG8_WAIT_V(8); PG8_WAIT_L(0); PG8_BAR; PG8_MMA(0, 0, At, B0); PG8_MMA(0, 1, At, B1); PG8_BAR; PG8_SCHED;
            PG8_LDA(At, 1, 1); PG8_STAGE(PG8_SB(1, 0), b3, voffB); PG8_STAGE(PG8_SB(1, 1), b3 + hstep, voffB); if constexpr (GATHER) { PG8_STAGE(PG8_SA(1, 0), ga3, v2[0]); } else { PG8_STAGE(PG8_SA(1, 0), a3, voffA); }
            PG8_WAIT_V(8); PG8_WAIT_L(0); PG8_BAR; PG8_MMA(1, 0, At, B0); PG8_MMA(1, 1, At, B1); PG8_BAR; PG8_SCHED;
            } else {
            PG8_LDB(B0, 0, 0); PG8_SCHED; PG8_LDA(At, 0, 0); PG8_STAGE(PG8_SA(1, 1), a1 + hstepA, voffA);
            PG8_WAIT_L(8); PG8_BAR; PG8_WAIT_L(0); PG8_MMA(0, 0, At, B0); PG8_BAR; PG8_SCHED;
            PG8_LDB(B1, 0, 1); PG8_STAGE(PG8_SB(0, 0), b2, voffB);
            PG8_BAR; PG8_WAIT_L(0); PG8_MMA(0, 1, At, B1); PG8_BAR;
            PG8_LDA(At, 0, 1); PG8_STAGE(PG8_SA(0, 0), a2, voffA);
            PG8_BAR; PG8_WAIT_L(0); PG8_MMA(1, 0, At, B0); PG8_BAR; PG8_SCHED;
            PG8_STAGE(PG8_SB(0, 1), b2 + hstep, voffB);
            PG8_WAIT_V(6); PG8_BAR; PG8_MMA(1, 1, At, B1); PG8_BAR;
            PG8_LDB(B0, 1, 0); PG8_SCHED; PG8_LDA(At, 1, 0); PG8_STAGE(PG8_SA(0, 1), a2 + hstepA, voffA);
            PG8_WAIT_L(8); PG8_BAR; PG8_WAIT_L(0); PG8_MMA(0, 0, At, B0); PG8_BAR; PG8_SCHED;
            PG8_LDB(B1, 1, 1); PG8_STAGE(PG8_SB(1, 0), b3, voffB);
            PG8_BAR; PG8_WAIT_L(0); PG8_MMA(0, 1, At, B1); PG8_BAR;
            PG8_LDA(At, 1, 1); PG8_STAGE(PG8_SA(1, 0), a3, voffA);
            PG8_BAR; PG8_WAIT_L(0); PG8_MMA(1, 0, At, B0); PG8_BAR; PG8_SCHED;
            PG8_STAGE(PG8_SB(1, 1), b3 + hstep, voffB);
            PG8_WAIT_V(6); PG8_BAR; PG8_MMA(1, 1, At, B1); PG8_BAR;
            }
        }
        if constexpr (ALIGN_EPI) { if (wr == 0) PG8_BAR; }
        bool has_nn = false;
        if constexpr (GATHER) { Unit nn_; has_nn = has_next && S.next(ui + 2, nn_); if (has_nn) PG8_TOKLD(tkn, nn_.pm); }
        if constexpr (!Epi::AFTER_DRAIN) { E(acc, cur, wr, wc, fr, fq); S.done(cur); }
        if (!has_next) break;
        if constexpr (GATHER) { _Pragma("unroll") for (int h_ = 0; h_ < 2; ++h_) _Pragma("unroll") for (int i_ = 0; i_ < 2; ++i_) vC[h_][i_] = vN[h_][i_]; if (has_nn) PG8_TOKOFF(vN, tkn); }
#pragma unroll
        for (int a = 0; a < 2; ++a)
#pragma unroll
            for (int b = 0; b < 2; ++b)
#pragma unroll
                for (int m = 0; m < 4; ++m)
#pragma unroll
                    for (int n = 0; n < 2; ++n) acc[a][b][m][n] = (f32x4){0.f, 0.f, 0.f, 0.f};
        cur = nxt; cA = nA; cB = nB; ++ui;
        if constexpr (ALIGN_EPI) { if (wr == 1) PG8_BAR; }
    }
    PG8_WAIT_V(0);
    if constexpr (!ALIGN_EPI) { if (wr == 0) PG8_BAR; }
    PG8_BAR;
#undef PG8_SA
#undef PG8_SB
#undef PG8_STAGE
#undef PG8_LDA
#undef PG8_LDB
#undef PG8_MMA
#undef PG8_F8CAT
#undef PG8_TOKLD
#undef PG8_TOKOFF
#undef PG8_WAIT_V
#undef PG8_WAIT_L
#undef PG8_BAR
#undef PG8_SCHED
}
}

__device__ __forceinline__ u32x4 f8_pair16(u32x2 rowA, u32x2 rowB) {
    const auto s0 = __builtin_amdgcn_permlane16_swap(rowA.x, rowB.x, false, false), s1 = __builtin_amdgcn_permlane16_swap(rowA.y, rowB.y, false, false);
    return (u32x4){s0[0], s1[0], s0[1], s1[1]};
}
struct EpiGU8 { static constexpr bool PERM = true, AFTER_DRAIN = false;
    unsigned char* act8; const float* bgu;
    __device__ __forceinline__ void operator()(const f32x4 (&acc)[2][2][4][2], const pg8::Unit& u, int wr, int wc, int fr, int fq) const {
        const int e = u.pn >> 3, ac0 = 128 * (u.pn & 7) + wc * 32 + 8 * fq;
        const float* bb = bgu + (size_t)e * 2048 + 2 * ac0;
        const f32x4 q0 = *(const f32x4*)bb, q1 = *(const f32x4*)(bb + 4), q2 = *(const f32x4*)(bb + 8), q3 = *(const f32x4*)(bb + 12);
        const float bg[8] = {q0[0], q0[2], q1[0], q1[2], q2[0], q2[2], q3[0], q3[2]}, bl[8] = {q0[1], q0[3], q1[1], q1[3], q2[1], q2[3], q3[1], q3[3]};
        const int odd = fq & 1, acs = ac0 - 8 * odd;
#pragma unroll
        for (int ai = 0; ai < 2; ++ai)
#pragma unroll
            for (int mp = 0; mp < 2; ++mp) { u32x2 pk[2];
#pragma unroll
                for (int h = 0; h < 2; ++h) { const int m = 2 * mp + h; float o[8];
#pragma unroll
                    for (int t = 0; t < 8; ++t) {
                        const float xg = fminf(fmaf(acc[ai][0][m][t >> 2][t & 3], W8_INV, bg[t]), 7.f), xl = fminf(fmaxf(fmaf(acc[ai][1][m][t >> 2][t & 3], W8_INV, bl[t]), -7.f), 7.f);
                        const float sg = __builtin_amdgcn_rcpf(1.f + __builtin_amdgcn_exp2f(-1.702f * 1.4426950408889634f * xg));
                        o[t] = xg * sg * (xl + 1.f); }
                    pk[h] = (u32x2){pack4_f8(o[0], o[1], o[2], o[3]), pack4_f8(o[4], o[5], o[6], o[7])}; }
                const int row = u.pm * 256 + ai * 128 + wr * 64 + (2 * mp + odd) * 16 + fr;
                *(u32x4*)(act8 + (size_t)row * DM + acs) = f8_pair16(pk[0], pk[1]); }
    } };
constexpr float O2_SCALE = 8.f, O2_INV = 1.f / 8.f;
struct EpiDN8 { static constexpr bool PERM = true, AFTER_DRAIN = false;
    unsigned char* out2; const float* bdn; const float* row_gate;
    __device__ __forceinline__ void operator()(const f32x4 (&acc)[2][2][4][2], const pg8::Unit& u, int wr, int wc, int fr, int fq) const {
        const int e = u.pn >> 2, c0 = 256 * (u.pn & 3) + wc * 32 + 8 * fq;
        f32x4 bv[2][2];
#pragma unroll
        for (int bj = 0; bj < 2; ++bj) { bv[bj][0] = *(const f32x4*)(bdn + (size_t)e * DM + c0 + bj * 128); bv[bj][1] = *(const f32x4*)(bdn + (size_t)e * DM + c0 + bj * 128 + 4); }
        const int odd = fq & 1, cs = c0 - 8 * odd;
#pragma unroll
        for (int ai = 0; ai < 2; ++ai)
#pragma unroll
            for (int mp = 0; mp < 2; ++mp) { u32x2 pk[2][2];
#pragma unroll
                for (int h = 0; h < 2; ++h) { const int m = 2 * mp + h; const float g = row_gate[u.pm * 256 + ai * 128 + wr * 64 + m * 16 + fr] * O2_SCALE;
#pragma unroll
                    for (int bj = 0; bj < 2; ++bj) { const f32x4 v0 = (acc[ai][bj][m][0] * W8_INV + bv[bj][0]) * g, v1 = (acc[ai][bj][m][1] * W8_INV + bv[bj][1]) * g;
                        pk[bj][h] = (u32x2){pack4_f8(v0[0], v0[1], v0[2], v0[3]), pack4_f8(v1[0], v1[1], v1[2], v1[3])}; } }
                const int row = u.pm * 256 + ai * 128 + wr * 64 + (2 * mp + odd) * 16 + fr;
#pragma unroll
                for (int bj = 0; bj < 2; ++bj) *(u32x4*)(out2 + (size_t)row * DM + cs + bj * 128) = f8_pair16(pk[bj][0], pk[bj][1]); }
    } };
#ifndef FAST_Z
#define FAST_Z 1
#endif
#ifndef FAST_O
#define FAST_O 1
#endif

struct MapId { __device__ __forceinline__ int operator()(int n) const { return n; } };
struct MapIn { __device__ __forceinline__ int operator()(int n) const {
    if (n >= 384 && n < 448) { const int l = n - 384; return 384 + 2 * (l & 31) + (l >> 5); }
    if (n >= 448 && n < 1216) { const int l = n - 448, hd = l >> 7, d = l & 127; return 448 + hd * 128 + (d >> 6) * 64 + 2 * (d & 31) + ((d >> 5) & 1); }
    return n; } };
struct MapQ { __device__ __forceinline__ int operator()(int n) const { const int h = n / 192, w = n - h * 192; if (w < 128) return n; const int l = w - 128; return h * 192 + 128 + 2 * (l & 31) + (l >> 5); } };
struct MapGU { __device__ __forceinline__ int operator()(int n) const { const int a = n >> 1; return 256 * (a >> 7) + 128 * (n & 1) + (a & 127); } };
template <class Map>
__device__ __forceinline__ void transpose_item(const float* __restrict__ W, int K, int N, bf16* __restrict__ WT, LAS float* scr, int item, int lane, const Map& map, const float* __restrict__ kscale = nullptr, int ldo = 0) {
    if (ldo == 0) ldo = K;
    const int nblk = N / 32, kb = item / nblk, nb = item - kb * nblk, k0 = 64 * kb, n0 = 32 * nb;
#pragma unroll 8
    for (int i = 0; i < 32; ++i) { const int kk = 2 * i + (lane >> 5); scr[kk * 33 + (lane & 31)] = (k0 < K) ? W[(size_t)(k0 + kk) * N + n0 + (lane & 31)] * (kscale ? kscale[k0 + kk] : 1.f) : 0.f; }
    LDS_WAIT(); asm volatile("" ::: "memory");
    const int c = lane & 7;
#pragma unroll
    for (int j = 0; j < 4; ++j) { const int n = (lane >> 3) + 8 * j; const LAS float* s = scr + (8 * c) * 33 + n;
        u32x4 o; o.x = cvtpk(s[0 * 33], s[1 * 33]); o.y = cvtpk(s[2 * 33], s[3 * 33]); o.z = cvtpk(s[4 * 33], s[5 * 33]); o.w = cvtpk(s[6 * 33], s[7 * 33]);
        *(u32x4*)(WT + (size_t)map(n0 + n) * ldo + k0 + 8 * c) = o; }
    LDS_WAIT(); asm volatile("" ::: "memory");
}

template <class Map>
__device__ __forceinline__ void transpose_item_f8(const float* __restrict__ W, int K, int N, unsigned char* __restrict__ WT, LAS float* scr, int item, int lane, const Map& map, float scale) {
    const int nblk = N / 32, kb = item / nblk, nb = item - kb * nblk, k0 = 64 * kb, n0 = 32 * nb;
#pragma unroll 8
    for (int i = 0; i < 8; ++i) { const int kk = 8 * i + (lane >> 3), c4 = (lane & 7) * 4; const f32x4 w4 = *(const f32x4*)(W + (size_t)(k0 + kk) * N + n0 + c4) * scale;
        LAS float* d_ = scr + kk * 33 + c4; d_[0] = w4[0]; d_[1] = w4[1]; d_[2] = w4[2]; d_[3] = w4[3]; }
    LDS_WAIT(); asm volatile("" ::: "memory");
    const int n = lane >> 1;
#pragma unroll
    for (int j = 0; j < 2; ++j) { const int c = 2 * (lane & 1) + j; const LAS float* s_ = scr + (16 * c) * 33 + n;
        u32x4 o; o.x = pack4_f8(s_[0 * 33], s_[1 * 33], s_[2 * 33], s_[3 * 33]); o.y = pack4_f8(s_[4 * 33], s_[5 * 33], s_[6 * 33], s_[7 * 33]);
        o.z = pack4_f8(s_[8 * 33], s_[9 * 33], s_[10 * 33], s_[11 * 33]); o.w = pack4_f8(s_[12 * 33], s_[13 * 33], s_[14 * 33], s_[15 * 33]);
        *(u32x4*)(WT + (size_t)map(n0 + n) * K + k0 + 16 * c) = o; }
    LDS_WAIT(); asm volatile("" ::: "memory");
}

template <class Map>
__device__ __forceinline__ void transpose_f8_stream(const float* __restrict__ Wall, int N, unsigned char* __restrict__ WTall, LAS float* scr, int gw, int ngw, int lane, const Map& map, float scale) {
    const int nblk = N / 32, per = 16 * nblk, n_items = NE * per;
#define T8_LOAD(dst, it_) do { const int e_ = (it_) / per, r_ = (it_) - e_ * per, kb_ = r_ / nblk, nb_ = r_ - kb_ * nblk; \
        const float* wp_ = Wall + ((size_t)e_ * 1024 + 64 * kb_ + (lane >> 3)) * N + 32 * nb_ + (lane & 7) * 4; \
        _Pragma("unroll") for (int i = 0; i < 8; ++i) dst[i] = *(const f32x4*)(wp_ + (size_t)(8 * i) * N); } while (0)
    f32x4 cur[8], nxt[8];
    int it = gw; if (it < n_items) T8_LOAD(cur, it);
    for (; it < n_items; it += ngw) {
        const int itn = it + ngw; if (itn < n_items) T8_LOAD(nxt, itn);
        const int e = it / per, r = it - e * per, kb = r / nblk, nb = r - kb * nblk, k0 = 64 * kb, n0 = 32 * nb;
#pragma unroll
        for (int i = 0; i < 8; ++i) { LAS float* d_ = scr + (8 * i + (lane >> 3)) * 33 + (lane & 7) * 4; const f32x4 w4 = cur[i] * scale; d_[0] = w4[0]; d_[1] = w4[1]; d_[2] = w4[2]; d_[3] = w4[3]; }
        LDS_WAIT(); asm volatile("" ::: "memory");
        const int n = lane >> 1;
#pragma unroll
        for (int j = 0; j < 2; ++j) { const int c = 2 * (lane & 1) + j; const LAS float* s_ = scr + (16 * c) * 33 + n;
            u32x4 o; o.x = pack4_f8(s_[0 * 33], s_[1 * 33], s_[2 * 33], s_[3 * 33]); o.y = pack4_f8(s_[4 * 33], s_[5 * 33], s_[6 * 33], s_[7 * 33]);
            o.z = pack4_f8(s_[8 * 33], s_[9 * 33], s_[10 * 33], s_[11 * 33]); o.w = pack4_f8(s_[12 * 33], s_[13 * 33], s_[14 * 33], s_[15 * 33]);
            *(u32x4*)(WTall + ((size_t)e * N + map(n0 + n)) * 1024 + k0 + 16 * c) = o; }
        LDS_WAIT(); asm volatile("" ::: "memory");
#pragma unroll
        for (int i = 0; i < 8; ++i) cur[i] = nxt[i];
    }
#undef T8_LOAD
}
__device__ __forceinline__ void ln_row_f32_to_bf16(f32x4 (&v)[4], const f32x4 (&gg)[4], const f32x4 (&bb)[4], bf16* __restrict__ orow, int lane) {
    float s = 0.f;
#pragma unroll
    for (int j = 0; j < 4; ++j) s += (v[j].x + v[j].y) + (v[j].z + v[j].w);
    const float mean = wave_sum(s) * (1.f / DM); float s2 = 0.f;
#pragma unroll
    for (int j = 0; j < 4; ++j) { v[j] = v[j] - mean; s2 += (v[j].x * v[j].x + v[j].y * v[j].y) + (v[j].z * v[j].z + v[j].w * v[j].w); }
    const float rstd = rsq(wave_sum(s2) * (1.f / DM) + LN_EPS);
#pragma unroll
    for (int j = 0; j < 4; ++j) { const f32x4 o = v[j] * rstd * gg[j] + bb[j]; ((u32x2*)orow)[lane + 64 * j] = (u32x2){cvtpk(o.x, o.y), cvtpk(o.z, o.w)}; }
}

__device__ __forceinline__ void ln_row_bf16(const bf16* __restrict__ yrow, const f32x4 (&G4)[4], const f32x4 (&B4)[4], bf16* __restrict__ orow, unsigned char* __restrict__ o8, int lane) {
    float v[16]; unpack8(*(const u32x4*)(yrow + 8 * lane), *(float(*)[8])&v[0]); unpack8(*(const u32x4*)(yrow + 512 + 8 * lane), *(float(*)[8])&v[8]);
    float s = 0.f;
#pragma unroll
    for (int j = 0; j < 16; ++j) s += v[j];
    const float mean = wave_sum(s) * (1.f / DM); float s2 = 0.f;
#pragma unroll
    for (int j = 0; j < 16; ++j) { v[j] -= mean; s2 += v[j] * v[j]; }
    const float rstd = rsq(wave_sum(s2) * (1.f / DM) + LN_EPS);
#pragma unroll
    for (int hf = 0; hf < 2; ++hf) { const f32x4 a = (f32x4){v[hf * 8 + 0], v[hf * 8 + 1], v[hf * 8 + 2], v[hf * 8 + 3]} * rstd * G4[2 * hf] + B4[2 * hf], b = (f32x4){v[hf * 8 + 4], v[hf * 8 + 5], v[hf * 8 + 6], v[hf * 8 + 7]} * rstd * G4[2 * hf + 1] + B4[2 * hf + 1];
        *(u32x4*)(orow + hf * 512 + 8 * lane) = (u32x4){cvtpk(a[0], a[1]), cvtpk(a[2], a[3]), cvtpk(b[0], b[1]), cvtpk(b[2], b[3])};
        *(u32x2*)(o8 + hf * 512 + 8 * lane) = (u32x2){pack4_f8(a[0], a[1], a[2], a[3]), pack4_f8(b[0], b[1], b[2], b[3])}; }
}
__device__ __forceinline__ void zero_bytes(void* p, size_t bytes, int gtid, int ngt) {
    u32x4* q = (u32x4*)p; const size_t n = bytes / 16;
    for (size_t i = gtid; i < n; i += ngt) q[i] = (u32x4){0u, 0u, 0u, 0u};
}
__device__ __forceinline__ void sincos_d(float angf, float& sn, float& cs) {
    const double x = (double)angf; const double q = __builtin_rint(x * 0.63661977236758134308);
    const double r = (x - q * 1.57079632679489655800) - q * 6.123233995736766036e-17, r2 = r * r;
    const double sp = r * (1.0 + r2 * (-1.0 / 6 + r2 * (1.0 / 120 + r2 * (-1.0 / 5040 + r2 * (1.0 / 362880 + r2 * (-1.0 / 39916800 + r2 * (1.0 / 6227020800.0)))))));
    const double cp = 1.0 + r2 * (-0.5 + r2 * (1.0 / 24 + r2 * (-1.0 / 720 + r2 * (1.0 / 40320 + r2 * (-1.0 / 3628800 + r2 * (1.0 / 479001600.0))))));
    const int qi = ((int)q) & 3;
    const double s_ = (qi == 0) ? sp : (qi == 1) ? cp : (qi == 2) ? -sp : -cp;
    const double c_ = (qi == 0) ? cp : (qi == 1) ? -sp : (qi == 2) ? -cp : sp;
    sn = (float)s_; cs = (float)c_;
}

__device__ __forceinline__ void p2a_row(int row, u32x4 wA, u32x4 wB, u32x4 wC, const float* __restrict__ rope, const float* __restrict__ g_q_a, const float* __restrict__ g_kv_a,
                                        const float* __restrict__ g_q_gqa, const float* __restrict__ g_k_gqa, float* rs_q, float* rs_kv, bf16* km, bf16* qg, bf16* kg, bf16* vg, int lane) {
    const bool meta = row >= NTOK;
    const int b = row >> 11, s = row & 2047, m = row - NTOK;
    const int pos1 = meta ? m : 16 + s, prow = meta ? -1 : (s >> 6), pcol = meta ? m : (s & 63), key = meta ? 2048 + m : s;
    {
        float f[8]; unpack8(wA, f);
        float ss = 0.f;
#pragma unroll
        for (int j = 0; j < 8; ++j) ss += f[j] * f[j];
        ss += __shfl_xor(ss, 1); ss += __shfl_xor(ss, 2); ss += __shfl_xor(ss, 4); ss += __shfl_xor(ss, 8);
        const float s16 = ss, s32 = ss + __shfl_xor(ss, 16);
        if (lane == 0) rs_q[row] = rsq(s32 * (1.f / 256) + RMS_EPS);
        if (lane == 32) rs_kv[row] = rsq(s16 * (1.f / 128) + RMS_EPS);
        if (lane < 48) {
        } else if (lane < 56) { const int i0 = 4 * (lane - 48); const float* t = rope + ((size_t)(pos1 + 1) * 32 + i0) * 2; float o[8];
#pragma unroll
            for (int j = 0; j < 4; ++j) { const float c = t[2 * j], sn = t[2 * j + 1], x1 = f[2 * j], x2 = f[2 * j + 1]; o[2 * j] = x1 * c - x2 * sn; o[2 * j + 1] = x1 * sn + x2 * c; }
            const u32x4 pk = pack8(o);
            if (!meta) { for (int h = 0; h < 4; ++h) *(u32x4*)(km + ((size_t)(b * 4 + h) * LKP + key) * 192 + 128 + 8 * (lane - 48)) = pk; }
            else { for (int bb = 0; bb < NB; ++bb) for (int h = 0; h < 4; ++h) *(u32x4*)(km + ((size_t)(bb * 4 + h) * LKP + key) * 192 + 128 + 8 * (lane - 48)) = pk; }
        }
    }
    const int p0 = (lane & 15) * 8, half = p0 >> 6, i0 = (p0 & 63) >> 1;
    const int apos = half ? pcol : prow; const float* t = rope + ((size_t)(apos + 1) * 32 + i0) * 2;
    if (!meta) {
        float f[8]; unpack8(wB, f);
        float ss = 0.f;
#pragma unroll
        for (int j = 0; j < 8; ++j) ss += f[j] * f[j];
        ss += __shfl_xor(ss, 1); ss += __shfl_xor(ss, 2); ss += __shfl_xor(ss, 4); ss += __shfl_xor(ss, 8);
        const float rs = rsq(ss * (1.f / 128) + RMS_EPS); float o[8];
#pragma unroll
        for (int j = 0; j < 4; ++j) { const int d1 = half * 64 + i0 + j, d2 = d1 + 32;
            const float x1 = f[2 * j] * rs * g_q_gqa[d1], x2 = f[2 * j + 1] * rs * g_q_gqa[d2], c = t[2 * j], sn = t[2 * j + 1];
            o[2 * j] = x1 * c - x2 * sn; o[2 * j + 1] = x1 * sn + x2 * c; }
        *(u32x4*)(qg + ((size_t)(b * 4 + (lane >> 4)) * 2048 + s) * 128 + p0) = pack8(o);
    }
    {
        float f[8]; unpack8(wC, f);
        float ss = 0.f;
#pragma unroll
        for (int j = 0; j < 8; ++j) ss += f[j] * f[j];
        ss += __shfl_xor(ss, 1); ss += __shfl_xor(ss, 2); ss += __shfl_xor(ss, 4); ss += __shfl_xor(ss, 8);
        float o[8];
        if (lane < 32) { const float rs = rsq(ss * (1.f / 128) + RMS_EPS);
#pragma unroll
            for (int j = 0; j < 4; ++j) { const int d1 = half * 64 + i0 + j, d2 = d1 + 32;
                const float x1 = f[2 * j] * rs * g_k_gqa[d1], x2 = f[2 * j + 1] * rs * g_k_gqa[d2], c = t[2 * j], sn = t[2 * j + 1];
                o[2 * j] = x1 * c - x2 * sn; o[2 * j + 1] = x1 * sn + x2 * c; }
        } else {
#pragma unroll
            for (int j = 0; j < 8; ++j) o[j] = f[j];
        }
        const u32x4 pk = pack8(o); bf16* dst = lane < 32 ? kg : vg; const int hk = (lane >> 4) & 1;
        if (!meta) *(u32x4*)(dst + ((size_t)(b * 2 + hk) * LKP + key) * 128 + p0) = pk;
        else for (int bb = 0; bb < NB; ++bb) *(u32x4*)(dst + ((size_t)(bb * 2 + hk) * LKP + key) * 128 + p0) = pk;
    }
}

__device__ __forceinline__ int crow(int r, int hi) { return (r & 3) + 8 * (r >> 2) + 4 * hi; }
__device__ __forceinline__ int v_st(int k, int c) { const int kk = (k & ~0xC) | ((k & 4) << 1) | ((k & 8) >> 1); return ((kk >> 3) * 4 + (c >> 5)) * 512 + ((kk & 7) * 32 + (c & 31)) * 2; }
__device__ __forceinline__ int v_rd_base(int lane) { return ((lane & 3) << 3) | (((lane >> 2) & 3) << 6) | (((lane >> 4) & 1) << 5) | (((lane >> 5) & 1) << 8); }
constexpr int v_rd_off(int d0, int ks, int half) { return d0 * 512 + ks * 4096 + half * 2048; }
template <int OFF> __device__ __forceinline__ s16x4 tr_read(int vb) {
    s16x4 r; asm volatile("ds_read_b64_tr_b16 %0, %1 offset:%2" : "=&v"(r) : "v"(vb), "i"(OFF) : "memory"); return r;
}
template <int D0> __device__ __forceinline__ void pv_one(f32x16& od, int vb, bf16x8 pa0, bf16x8 pa1, bf16x8 pa2, bf16x8 pa3) {
    const s16x4 l0 = tr_read<v_rd_off(D0, 0, 0)>(vb), h0 = tr_read<v_rd_off(D0, 0, 1)>(vb), l1 = tr_read<v_rd_off(D0, 1, 0)>(vb), h1 = tr_read<v_rd_off(D0, 1, 1)>(vb);
    const s16x4 l2 = tr_read<v_rd_off(D0, 2, 0)>(vb), h2 = tr_read<v_rd_off(D0, 2, 1)>(vb), l3 = tr_read<v_rd_off(D0, 3, 0)>(vb), h3 = tr_read<v_rd_off(D0, 3, 1)>(vb);
    asm volatile("s_waitcnt lgkmcnt(0)" ::: "memory"); SBAR();
#define PK(L, H) (bf16x8){L[0], L[1], L[2], L[3], H[0], H[1], H[2], H[3]}
    od = __builtin_amdgcn_mfma_f32_32x32x16_bf16(pa0, PK(l0, h0), od, 0, 0, 0);
    od = __builtin_amdgcn_mfma_f32_32x32x16_bf16(pa1, PK(l1, h1), od, 0, 0, 0);
    od = __builtin_amdgcn_mfma_f32_32x32x16_bf16(pa2, PK(l2, h2), od, 0, 0, 0);
    od = __builtin_amdgcn_mfma_f32_32x32x16_bf16(pa3, PK(l3, h3), od, 0, 0, 0);
#undef PK
}
__device__ __forceinline__ void pv_d0(f32x16* o, int vb, bf16x8 pa0, bf16x8 pa1, bf16x8 pa2, bf16x8 pa3) {
    pv_one<0>(o[0], vb, pa0, pa1, pa2, pa3); pv_one<1>(o[1], vb, pa0, pa1, pa2, pa3); pv_one<2>(o[2], vb, pa0, pa1, pa2, pa3); pv_one<3>(o[3], vb, pa0, pa1, pa2, pa3);
}
template <int DQK> struct AttnC {
    static constexpr float SCALE = DQK == 192 ? 0.07216878364870322f : 0.08838834764831845f;
    static constexpr float C = SCALE * 1.4426950408889634f, THRS = 8.f / SCALE;
};
template <int DQK>
__device__ __forceinline__ void partialSM(f32x16& p0, f32x16& p1, float& m_reg, float& mn, float& alpha) {
    constexpr float C = AttnC<DQK>::C;
    float pmax = p0[0];
#pragma unroll
    for (int r = 1; r < 16; ++r) pmax = fmaxf(pmax, p0[r]);
#pragma unroll
    for (int r = 0; r < 16; ++r) pmax = fmaxf(pmax, p1[r]);
    { auto rr = __builtin_amdgcn_permlane32_swap(__float_as_uint(pmax), __float_as_uint(pmax), false, false);
      pmax = fmaxf(__uint_as_float(rr[0]), __uint_as_float(rr[1])); }
    if (__builtin_expect(__all(pmax - m_reg <= AttnC<DQK>::THRS), 1)) { mn = m_reg; alpha = 1.f; }
    else { mn = fmaxf(m_reg, pmax); alpha = __builtin_amdgcn_exp2f((m_reg - mn) * C); m_reg = mn; }
    const float mnC = -mn * C;
#pragma unroll
    for (int r = 0; r < 16; ++r) p0[r] = fmaf(p0[r], C, mnC);
#pragma unroll
    for (int r = 0; r < 16; ++r) p1[r] = fmaf(p1[r], C, mnC);
#pragma unroll
    for (int r = 0; r < 16; ++r) p0[r] = __builtin_amdgcn_exp2f(p0[r]);
}
__device__ __forceinline__ void finishSM(f32x16& p0, f32x16& p1, float alpha, float& l_reg, bf16x8& pa0, bf16x8& pa1, bf16x8& pa2, bf16x8& pa3) {
#pragma unroll
    for (int r = 0; r < 16; ++r) p1[r] = __builtin_amdgcn_exp2f(p1[r]);
    float ps = 0;
#pragma unroll
    for (int r = 0; r < 16; ++r) ps += p0[r];
#pragma unroll
    for (int r = 0; r < 16; ++r) ps += p1[r];
    { auto rr = __builtin_amdgcn_permlane32_swap(__float_as_uint(ps), __float_as_uint(ps), false, false);
      ps = __uint_as_float(rr[0]) + __uint_as_float(rr[1]); }
    l_reg = l_reg * alpha + ps;
#define PK4(P, BASE, OUT) do { unsigned a0 = cvtpk(P[BASE + 0], P[BASE + 1]), a1 = cvtpk(P[BASE + 2], P[BASE + 3]);   \
    unsigned b0 = cvtpk(P[BASE + 4], P[BASE + 5]), b1 = cvtpk(P[BASE + 6], P[BASE + 7]);                              \
    auto r0 = __builtin_amdgcn_permlane32_swap(a0, b0, false, false); auto r1 = __builtin_amdgcn_permlane32_swap(a1, b1, false, false); \
    u32x4 w = {r0[0], r1[0], r0[1], r1[1]}; OUT = *reinterpret_cast<bf16x8*>(&w); } while (0)
    PK4(p0, 0, pa0); PK4(p0, 8, pa1); PK4(p1, 0, pa2); PK4(p1, 8, pa3);
#undef PK4
}
template <int DQK>
__device__ __forceinline__ void qkt(f32x16& p0, f32x16& p1, const LAS char* Ks, const bf16x8* qr, const LAS char* ql, const int (&ko)[4]) {
    constexpr int KRB = DQK * 2;
    p0 = f32x16{}; p1 = f32x16{};
#pragma unroll
    for (int d0 = 0; d0 < DQK / 16; ++d0) { const LAS char* kp = Ks + ko[d0 & 3] + (d0 >> 2) * 128;
        const bf16x8 b0 = *(const LAS bf16x8*)(kp);
        const bf16x8 b1 = *(const LAS bf16x8*)(kp + 32 * KRB);
        bf16x8 q; if (d0 < 8) q = qr[d0]; else q = *(const LAS bf16x8*)(ql + (d0 - 8) * 1024);
        p0 = __builtin_amdgcn_mfma_f32_32x32x16_bf16(b0, q, p0, 0, 0, 0);
        p1 = __builtin_amdgcn_mfma_f32_32x32x16_bf16(b1, q, p1, 0, 0, 0); }
}
template <int DQK, int SD>
__device__ __forceinline__ void attn_body(const bf16* __restrict__ Qb, const bf16* __restrict__ Kh, const bf16* __restrict__ Vh, bf16* __restrict__ Ob, LAS char* lds, const float* __restrict__ rope, int pos0) {
    constexpr int ND0 = DQK / 16, KRB = DQK * 2, SHM_K = 64 * KRB, SHM_V = 64 * 128 * 2, NKC = DQK / 64, CPR = DQK / 8, NT = LKP / 64;
    static_assert(NT % 2 == 1, "odd tile count: the tail below takes tiles NT-2 and NT-1");
    int tid = threadIdx.x; asm volatile("" : "+v"(tid));
    const int wid = tid >> 6, lane = tid & 63, r32 = lane & 31, hi = lane >> 5;
    LAS char* V_lds = lds; LAS char* K_lds = lds + 2 * SHM_V;
    __syncthreads();
    float m_reg = -1e30f, l_reg = 0; f32x16 o[4] = {}; bf16x8 qr[8];
    const bf16* Qw = Qb + (size_t)(wid * 32 + r32) * DQK + hi * 8;
#pragma unroll
    for (int d0 = 0; d0 < 8; ++d0) qr[d0] = *reinterpret_cast<const bf16x8*>(Qw + d0 * 16);
    LAS char* ql = lds + 2 * SHM_V + 2 * SHM_K + 2048 + wid * 4096 + lane * 16;
#pragma unroll
    for (int d0 = 8; d0 < ND0; ++d0) {
        float x[8], y[8]; unpack8(*reinterpret_cast<const u32x4*>(Qw + d0 * 16), x);
        const float* t = rope + ((size_t)(pos0 + wid * 32 + r32 + 1) * 32 + (d0 - 8) * 8 + hi * 4) * 2; const f32x4 t0 = *(const f32x4*)t, t1 = *(const f32x4*)(t + 4);
        const float cs[4] = {t0[0], t0[2], t1[0], t1[2]}, sn[4] = {t0[1], t0[3], t1[1], t1[3]};
#pragma unroll
        for (int j = 0; j < 4; ++j) { y[2 * j] = x[2 * j] * cs[j] - x[2 * j + 1] * sn[j]; y[2 * j + 1] = x[2 * j] * sn[j] + x[2 * j + 1] * cs[j]; }
        *(LAS u32x4*)(ql + (d0 - 8) * 1024) = pack8(y); }
    const int sr = tid >> 4, sc = (tid & 15) * 8, vst0 = v_st(sr, sc), vst1 = v_st(32 + sr, sc);
    int kst[NKC];
#pragma unroll
    for (int c = 0; c < NKC; ++c) { const int id = tid + 512 * c, kr = id / CPR, kc = (id - kr * CPR) * 8; kst[c] = kr * KRB + ((kc * 2) ^ ((kr & 7) << 4)); }
    const int voff = tid * 16;
    int ko[4];
#pragma unroll
    for (int q = 0; q < 4; ++q) ko[q] = r32 * KRB + ((q * 32 + hi * 16) ^ ((r32 & 7) << 4));
    const __amdgpu_buffer_rsrc_t rK = __builtin_amdgcn_make_buffer_rsrc((void*)Kh, 0, LKP * KRB, 0x00020000);
    const __amdgpu_buffer_rsrc_t rV = __builtin_amdgcn_make_buffer_rsrc((void*)Vh, 0, LKP * 256, 0x00020000);
    const int vb0 = (int)(unsigned)(uintptr_t)V_lds + v_rd_base(lane);
    struct { bf16x8 vs0, vs1, ks[NKC]; } sr_[SD];
#define SLOAD(i, k0) do { sr_[i].vs0 = __builtin_bit_cast(bf16x8, __builtin_amdgcn_raw_buffer_load_b128(rV, voff, (k0) * 256, 0)); sr_[i].vs1 = __builtin_bit_cast(bf16x8, __builtin_amdgcn_raw_buffer_load_b128(rV, voff, (k0) * 256 + 8192, 0)); \
    _Pragma("unroll") for (int c_ = 0; c_ < NKC; ++c_) sr_[i].ks[c_] = __builtin_bit_cast(bf16x8, __builtin_amdgcn_raw_buffer_load_b128(rK, voff, (k0) * KRB + c_ * 8192, 0)); } while (0)
#define SWRITE(b, i) do { *(LAS bf16x8*)(V_lds + (b) * SHM_V + vst0) = sr_[i].vs0; *(LAS bf16x8*)(V_lds + (b) * SHM_V + vst1) = sr_[i].vs1; \
    _Pragma("unroll") for (int c_ = 0; c_ < NKC; ++c_) *(LAS bf16x8*)(K_lds + (b) * SHM_K + kst[c_]) = sr_[i].ks[c_]; } while (0)
#define SWAIT() do { if constexpr (SD == 2) { if constexpr (NKC == 2) asm volatile("s_waitcnt vmcnt(4)" ::: "memory"); else asm volatile("s_waitcnt vmcnt(5)" ::: "memory"); } \
    else asm volatile("s_waitcnt vmcnt(0)" ::: "memory"); } while (0)
#define RESC(a) do { if (__any((a) < 1.f)) { int t_ = threadIdx.x; asm volatile("" : "+v"(t_)); const int r32_ = t_ & 31, hi_2 = (t_ >> 5) & 1; \
    LAS float* al_ = (LAS float*)(lds + 2 * SHM_V + 2 * SHM_K) + (t_ >> 6) * 64 + 32; if (hi_2 == 0) al_[r32_] = (a); asm volatile("s_waitcnt lgkmcnt(0)" ::: "memory"); \
    _Pragma("unroll") for (int d = 0; d < 4; ++d) _Pragma("unroll") for (int r = 0; r < 16; ++r) o[d][r] *= al_[crow(r, hi_2)]; } } while (0)
    f32x16 pA0, pA1, pB0, pB1; float mnA, mnB, alA, alB; bf16x8 pa0, pa1, pa2, pa3;
    constexpr int SE = 0, SO = SD - 1;
    SLOAD(SE, 0); asm volatile("s_waitcnt vmcnt(0)" ::: "memory"); SWRITE(0, SE); __syncthreads();
    qkt<DQK>(pA0, pA1, K_lds, qr, ql, ko); partialSM<DQK>(pA0, pA1, m_reg, mnA, alA);
    SLOAD(SO, 64); if constexpr (SD == 2) { SLOAD(SE, 128); }
    SWAIT(); SWRITE(1, SO); __syncthreads();
#pragma unroll 1
    for (int j = 1; j + 2 < NT; j += 2) {
        SBAR(); qkt<DQK>(pB0, pB1, K_lds + SHM_K, qr, ql, ko);
        finishSM(pA0, pA1, alA, l_reg, pa0, pa1, pa2, pa3); SBAR();
        SLOAD(SO, (j + SD) * 64); SBAR();
        pv_d0(o, vb0, pa0, pa1, pa2, pa3); partialSM<DQK>(pB0, pB1, m_reg, mnB, alB);
        __syncthreads(); SWAIT(); SWRITE(0, SE);
        RESC(alB); __syncthreads();
        SBAR(); qkt<DQK>(pA0, pA1, K_lds, qr, ql, ko);
        finishSM(pB0, pB1, alB, l_reg, pa0, pa1, pa2, pa3); SBAR();
        SLOAD(SE, (j + 1 + SD) * 64); SBAR();
        pv_d0(o, vb0 + SHM_V, pa0, pa1, pa2, pa3); partialSM<DQK>(pA0, pA1, m_reg, mnA, alA);
        __syncthreads(); SWAIT(); SWRITE(1, SO);
        RESC(alA); __syncthreads();
    }
    SBAR(); qkt<DQK>(pB0, pB1, K_lds + SHM_K, qr, ql, ko);
    finishSM(pA0, pA1, alA, l_reg, pa0, pa1, pa2, pa3); SBAR();
    if constexpr (SD == 1) { SLOAD(SE, (NT - 1) * 64); } SBAR();
    pv_d0(o, vb0, pa0, pa1, pa2, pa3); partialSM<DQK>(pB0, pB1, m_reg, mnB, alB);
    __syncthreads(); asm volatile("s_waitcnt vmcnt(0)" ::: "memory"); SWRITE(0, SE);
    RESC(alB); __syncthreads();
    SBAR(); qkt<DQK>(pA0, pA1, K_lds, qr, ql, ko);
#pragma unroll
    for (int r = 8; r < 16; ++r) pA0[r] = -1e30f;
#pragma unroll
    for (int r = 0; r < 16; ++r) pA1[r] = -1e30f;
    finishSM(pB0, pB1, alB, l_reg, pa0, pa1, pa2, pa3); SBAR();
    pv_d0(o, vb0 + SHM_V, pa0, pa1, pa2, pa3); partialSM<DQK>(pA0, pA1, m_reg, mnA, alA);
    RESC(alA);
    finishSM(pA0, pA1, alA, l_reg, pa0, pa1, pa2, pa3); SBAR();
    pv_d0(o, vb0, pa0, pa1, pa2, pa3);
    { int t_ = threadIdx.x; asm volatile("" : "+v"(t_)); const int r32_ = t_ & 31, hi_2 = (t_ >> 5) & 1, wid_ = t_ >> 6;
      LAS float* li_ = (LAS float*)(lds + 2 * SHM_V + 2 * SHM_K) + wid_ * 64;
      if (hi_2 == 0) li_[r32_] = l_reg; asm volatile("s_waitcnt lgkmcnt(0)" ::: "memory");
      float rli[16];
#pragma unroll
      for (int r = 0; r < 16; ++r) rli[r] = __builtin_amdgcn_rcpf(li_[crow(r, hi_2)]);
      bf16* Ow = Ob + (size_t)(wid_ * 32) * DM;
#pragma unroll
      for (int r = 0; r < 16; ++r) { const int orow = crow(r, hi_2);
#pragma unroll
          for (int d0 = 0; d0 < 4; ++d0) Ow[(size_t)orow * DM + d0 * 32 + r32_] = (bf16)(cvtpk(o[d0][r] * rli[r], 0.f) & 0xffffu); } }
#undef SLOAD
#undef SWRITE
#undef SWAIT
#undef RESC
}

constexpr int NPHASE = 14;
struct Args { const float* in[24]; float* out; unsigned char* ws; int ph_lo, ph_hi; };
__global__ void __launch_bounds__(NWAVES * 64, 2) hymba_fwd(Args args) {
    extern __shared__ __attribute__((aligned(16))) unsigned char lds[];
    { int t0 = threadIdx.x; asm volatile("" : "+v"(t0)); for (int u = t0; u < 1024; u += NWAVES * 64) ((LAS unsigned*)((LAS unsigned char*)lds + LDSCTL_OFF))[u] = 0u; }
    __syncthreads();
#define XB_OBJ(b_) XcdBarrier b_; { const CAS unsigned char* kq_ = (const CAS unsigned char*)__builtin_amdgcn_kernarg_segment_ptr(); asm volatile("" : "+s"(kq_)); \
    b_.bar = (unsigned*)(*(unsigned char* const CAS*)(kq_ + 200) + WS_CTL) + CW_BAR; b_.x = xb_xcc_id(); b_.st = (volatile LAS unsigned*)((LAS unsigned char*)lds + LDSCTL_OFF) + 8; }
#if !MK_SPLIT
    { XB_OBJ(b0_); (void)xcd_barrier_post(b0_.bar, b0_.st); }
#define GRID_BAR() do { XB_OBJ(bb_); xcd_barrier(bb_); } while (0)
#else
#define GRID_BAR() do {} while (0)
#endif
    const int lo = args.ph_lo, hi_ = args.ph_hi;
#ifndef REP_MASK
#define REP_MASK 0
#endif
#define IN(k) (lo <= (k) && (k) < hi_)
#define REPS(k) (((REP_MASK >> (k)) & 1) ? 2 : 1)
#define SEAM(k) do { if (IN(k) && IN((k) + 1)) GRID_BAR(); } while (0)

#define PTRS \
    int bx = blockIdx.x; asm volatile("" : "+s"(bx)); const int G = gridDim.x, vcu = (G % 8 == 0) ? (bx % 8) * (G / 8) + bx / 8 : bx; \
    const int tid = threadIdx.x, lane = tid & 63, wave = __builtin_amdgcn_readfirstlane(tid >> 6); \
    const int gw = vcu * NWAVES + wave, ngw = G * NWAVES, gtid = vcu * (NWAVES * 64) + tid, ngt = G * NWAVES * 64; (void)gw; (void)ngw; (void)gtid; (void)ngt; (void)lane; \
    const CAS unsigned char* kp_ = (const CAS unsigned char*)__builtin_amdgcn_kernarg_segment_ptr(); asm volatile("" : "+s"(kp_)); \
    const float* const CAS* kin = (const float* const CAS*)kp_; unsigned char* ws = *(unsigned char* const CAS*)(kp_ + 200); float* outp = *(float* const CAS*)(kp_ + 192); (void)outp; (void)kin; \
    const float* x = kin[0]; const float* meta_tok = kin[1]; \
    float* rope = (float*)(ws + WS_ROPE); \
    bf16* w_in_t = (bf16*)(ws + WS_WIN); bf16* w_qb_t = (bf16*)(ws + WS_WQB); bf16* w_kvb_t = (bf16*)(ws + WS_WKVB); bf16* w_o_t = (bf16*)(ws + WS_WO); \
    bf16* w_r_t = (bf16*)(ws + WS_WR); unsigned char* w_gu8 = ws + WS_WGU; unsigned char* w_dn8 = ws + WS_WDN; unsigned char* h1f8 = ws + WS_H1F8; \
    bf16* h0 = (bf16*)(ws + WS_H0); bf16* h1 = (bf16*)(ws + WS_H1); float* rs_q = (float*)(ws + WS_QAN); float* rs_kv = rs_q + MPAD; bf16* z = (bf16*)(ws + WS_Z); \
    bf16* qm = (bf16*)(ws + WS_QM); bf16* km = (bf16*)(ws + WS_KM); bf16* vm = (bf16*)(ws + WS_VM); bf16* qg = (bf16*)(ws + WS_QG); bf16* kg = (bf16*)(ws + WS_KG); bf16* vg = (bf16*)(ws + WS_VG); \
    bf16* ob = (bf16*)(ws + WS_O); bf16* y1 = (bf16*)(ws + WS_Y1); float* logits = (float*)(ws + WS_LOGITS); \
    int* topk = (int*)(ws + WS_TOPK); float* gate = (float*)(ws + WS_GATE); int* pair_pos = (int*)(ws + WS_PAIRPOS); float* row_gate = (float*)(ws + WS_ROWGATE); \
    int* hist = (int*)(ws + WS_HIST); int* moetab = (int*)(ws + WS_MOETAB); int* tile_expert = moetab + 256; \
    int* row_tok = (int*)(ws + WS_XS); unsigned char* act8 = ws + WS_ACT; unsigned char* out2 = ws + WS_OUT2;


    for (int rep_ = 0; rep_ < (IN(0) ? REPS(0) : 0); ++rep_) { if (rep_) GRID_BAR(); PTRS;
        LAS float* scr = (LAS float*)((LAS unsigned char*)lds + wave * 16384);
        constexpr int I_IN = 16 * 46, I_QB = 4 * 24, I_KVB = 4 * 32, I_O = 16 * 32, I_R = 16;
        constexpr int NITEMS = I_IN + I_QB + I_KVB + I_O + I_R;
        for (int it = gw; it < NITEMS; it += ngw) {
            int r = it;
            if (r < I_IN) { transpose_item(kin[4], 1024, NIN, w_in_t, scr, r, lane, MapIn()); continue; } r -= I_IN;
            if (r < I_QB) { transpose_item(kin[6], 256, 768, w_qb_t, scr, r, lane, MapQ(), kin[5]); continue; } r -= I_QB;
            if (r < I_KVB) { transpose_item(kin[8], 128, 1024, w_kvb_t, scr, r, lane, MapId(), kin[7], 256); continue; } r -= I_KVB;
            if (r < I_O) { transpose_item(kin[13], 1024, 1024, w_o_t, scr, r, lane, MapId()); continue; } r -= I_O;
            transpose_item(kin[16], 1024, 32, w_r_t, scr, r, lane, MapId());
        }
        transpose_f8_stream(kin[18], 2048, w_gu8, scr, gw, ngw, lane, MapGU(), W8_SCALE);
        transpose_f8_stream(kin[20], 1024, w_dn8, scr, gw, ngw, lane, MapId(), W8_SCALE);
        { f32x4 gg[4], bb[4], cv[4], nv[4];
#pragma unroll
          for (int j = 0; j < 4; ++j) { gg[j] = ((const f32x4*)kin[2])[lane + 64 * j]; bb[j] = ((const f32x4*)kin[3])[lane + 64 * j]; }
#define LN_LOAD(dst, m_) do { const float* xr_ = (m_) < NTOK ? x + (size_t)(m_) * DM : meta_tok + (size_t)((m_) - NTOK) * DM; _Pragma("unroll") for (int j = 0; j < 4; ++j) dst[j] = ((const f32x4*)xr_)[lane + 64 * j]; } while (0)
          if (gw < MROWS) LN_LOAD(cv, gw);
          for (int m = gw; m < MROWS; m += ngw) { const int mn = m + ngw < MROWS ? m + ngw : m; LN_LOAD(nv, mn);
              ln_row_f32_to_bf16(cv, gg, bb, h0 + (size_t)m * DM, lane);
#pragma unroll
              for (int j = 0; j < 4; ++j) cv[j] = nv[j]; }
#undef LN_LOAD
        }
        zero_bytes(h0 + (size_t)MROWS * DM, (size_t)(MPAD - MROWS) * DM * 2, gtid, ngt);
        zero_bytes(w_in_t + (size_t)NIN * 1024, (size_t)(ZLD - NIN) * 1024 * 2, gtid, ngt);
        for (int i = gw; i < 64 + 64 + 32 + 32; i += ngw) {
            bf16* p; size_t rb;
            if (i < 64) { p = km + ((size_t)i * LKP + 2064) * 192; rb = 48 * 192 * 2; }
            else if (i < 128) { p = vm + ((size_t)(i - 64) * LKP + 2064) * 128; rb = 48 * 128 * 2; }
            else if (i < 160) { p = kg + ((size_t)(i - 128) * LKP + 2064) * 128; rb = 48 * 128 * 2; }
            else { p = vg + ((size_t)(i - 160) * LKP + 2064) * 128; rb = 48 * 128 * 2; }
            zero_bytes(p, rb, lane, 64);
        }
        for (int i = gtid; i < 2065 * 32; i += ngt) {
            const int p = i / 32 - 1, f = i & 31; double inv = 1.0;
            for (int q = 0; q < f; ++q) inv *= 0.74989420933245582730;
            const float ang = (float)p * (float)inv; float sn, cs; sincos_d(fabsf(ang), sn, cs); if (ang < 0.f) sn = -sn;
            rope[2 * i] = cs; rope[2 * i + 1] = sn;
        }
    }
    SEAM(0);
    for (int rep_ = 0; rep_ < (IN(1) ? REPS(1) : 0); ++rep_) { if (rep_) GRID_BAR(); PTRS; EpiZ E{z};
#if FAST_Z
        { pg8::Gemm g{h0, w_in_t, NTOK, ZLD, 1024, 1024, nullptr}; pg8::StaticOrder S; S.init(NTOK, ZLD, G, bx); pg8::EpiAdapt<EpiZ> EA{E, 0};
          pg8::gemm_phase<pg8::EpiAdapt<EpiZ>, pg8::StaticOrder, true, true>((LAS unsigned char*)lds, g, S, EA); }
        meta_gemm16<1024>(h0, 1024, w_in_t, NTOK, ZLD, E, gw, ngw, lane);
#else
        simple_gemm(h0, w_in_t, 1024, 0, NTOK + 64, ZLD, E, BSelNone(), gw, ngw, lane);
#endif
    }
    SEAM(1);
    for (int rep_ = 0; rep_ < (IN(2) ? REPS(2) : 0); ++rep_) { if (rep_) GRID_BAR(); PTRS;
#define P2_LOAD(m_, a_, b_, c_) do { const bf16* zr_ = z + (size_t)(m_) * ZLD; a_ = (u32x4){0u, 0u, 0u, 0u}; if (lane < 56) a_ = *(const u32x4*)(zr_ + 8 * lane); b_ = *(const u32x4*)(zr_ + 448 + 8 * lane); c_ = *(const u32x4*)(zr_ + 960 + 8 * lane); } while (0)
        u32x4 wa, wb, wc, na, nb, nc; if (gw < MROWS) P2_LOAD(gw, wa, wb, wc);
        for (int m = gw; m < MROWS; m += ngw) { const int mn = m + ngw < MROWS ? m + ngw : m; P2_LOAD(mn, na, nb, nc);
            p2a_row(m, wa, wb, wc, rope, kin[5], kin[7], kin[9], kin[10], rs_q, rs_kv, km, qg, kg, vg, lane); wa = na; wb = nb; wc = nc; }
#undef P2_LOAD
    }
    SEAM(2);
    for (int rep_ = 0; rep_ < (IN(3) ? REPS(3) : 0); ++rep_) { if (rep_) GRID_BAR(); PTRS;
        { EpiQ E{qm, rs_q}; pg8::Gemm g{z, w_qb_t, NTOK, 768, 256, ZLD, nullptr}; pg8::StaticOrder S; S.init(NTOK, 768, G, bx); pg8::EpiAdapt<EpiQ> EA{E, 0};
          pg8::gemm_phase<pg8::EpiAdapt<EpiQ>, pg8::StaticOrder, true, true>((LAS unsigned char*)lds, g, S, EA); }
        { EpiKV<false> E{km, vm, rs_kv}; pg8::Gemm g{z + 256, w_kvb_t, NTOK, 1024, 256, ZLD, nullptr}; pg8::StaticOrder S; S.init(NTOK, 1024, G, bx); pg8::EpiAdapt<EpiKV<false>> EA{E, 0};
          pg8::gemm_phase<pg8::EpiAdapt<EpiKV<false>>, pg8::StaticOrder, true, true>((LAS unsigned char*)lds, g, S, EA);
          EpiKV<true> EM{km, vm, rs_kv}; meta_gemm16<256>(z + 256, ZLD, w_kvb_t, NTOK, 1024, EM, gw, ngw, lane); }
    }
    SEAM(3);
    for (int rep_ = 0; rep_ < (IN(4) ? REPS(4) : 0); ++rep_) { if (rep_) GRID_BAR(); PTRS;
        for (int u = vcu; u < 1024; u += G) {
            if (u < 512) { const int b = u >> 5, h = (u >> 3) & 3, qb = u & 7, bh = b * 4 + h;
                attn_body<192, 1>(qm + ((size_t)bh * 2048 + qb * 256) * 192, km + (size_t)bh * LKP * 192, vm + (size_t)bh * LKP * 128, ob + ((size_t)b * 2048 + qb * 256) * DM + h * 128, (LAS char*)lds, rope, 16 + qb * 256);
            } else { const int v = u - 512, b = v >> 5, h = (v >> 3) & 3, qb = v & 7, bh = b * 4 + h, bk = b * 2 + (h >> 1);
                attn_body<128, 2>(qg + ((size_t)bh * 2048 + qb * 256) * 128, kg + (size_t)bk * LKP * 128, vg + (size_t)bk * LKP * 128, ob + ((size_t)b * 2048 + qb * 256) * DM + 512 + h * 128, (LAS char*)lds, rope, 0);
            }
        }
    }
    SEAM(4);
    for (int rep_ = 0; rep_ < (IN(5) ? REPS(5) : 0); ++rep_) { if (rep_) GRID_BAR(); PTRS;
        for (int m = gw; m < NTOK; m += ngw) {
#pragma unroll
            for (int g = 0; g < 2; ++g) { bf16* p = ob + (size_t)m * DM + g * 512 + 8 * lane; float f[8]; unpack8(*(const u32x4*)p, f);
                float ss = 0.f;
#pragma unroll
                for (int j = 0; j < 8; ++j) ss += f[j] * f[j];
                const float rs = rsq(wave_sum(ss) * (1.f / 512) + RMS_EPS); const float* gg = (g ? kin[12] : kin[11]) + 8 * lane;
#pragma unroll
                for (int j = 0; j < 8; ++j) f[j] = f[j] * rs * gg[j];
                *(u32x4*)p = pack8(f); }
        }
    }
    SEAM(5);
    for (int rep_ = 0; rep_ < (IN(6) ? REPS(6) : 0); ++rep_) { if (rep_) GRID_BAR(); PTRS; EpiO E{y1, h0};
#if FAST_O
        pg8::Gemm g{ob, w_o_t, NTOK, 1024, 1024, 1024, nullptr}; pg8::StaticOrder S; S.init(NTOK, 1024, G, bx); pg8::EpiAdapt<EpiO> EA{E, 0};
        pg8::gemm_phase<pg8::EpiAdapt<EpiO>, pg8::StaticOrder, true, true>((LAS unsigned char*)lds, g, S, EA);
#else
        simple_gemm(ob, w_o_t, 1024, 0, NTOK, 1024, E, BSelNone(), gw, ngw, lane);
#endif
    }
    SEAM(6);
#ifndef MOE_SKEW_TICKS
#define MOE_SKEW_TICKS 0
#endif
#define MOE_STAGGER(nunits) do { const int rem_ = (nunits) % G; if (MOE_SKEW_TICKS > 0 && rem_ != 0 && bx >= rem_) { const unsigned long long t0_ = __builtin_amdgcn_s_memrealtime(), w_ = (unsigned long long)(MOE_SKEW_TICKS * ((bx - rem_) % 3 + 1)); \
    while (__builtin_amdgcn_s_memrealtime() - t0_ < w_) __builtin_amdgcn_s_sleep(16); } } while (0)
#define ROUTE_VARS const int tpb = (NTOK + G - 1) / G, tok_lo = bx * tpb, tok_hi = (tok_lo + tpb < NTOK) ? tok_lo + tpb : NTOK; \
    LAS int* L_hist = (LAS int*)((LAS unsigned char*)lds + LDSCTL_OFF + 256); LAS int* L_n = L_hist + 32; LAS int* L_base = L_hist + 64; LAS int* L_off = L_hist + 96; (void)L_n; (void)L_base; (void)L_off;
    for (int rep_ = 0; rep_ < (IN(8) ? REPS(8) : 0); ++rep_) { if (rep_) GRID_BAR(); PTRS; ROUTE_VARS;
        constexpr int WRP = 2064;
        LAS unsigned char* L_wr = (LAS unsigned char*)lds;
        for (int i = tid; i < 32 * 128; i += NWAVES * 64) { const int r = i >> 7, c = i & 127; *(LAS u32x4*)(L_wr + r * WRP + c * 16) = *(const u32x4*)(w_r_t + (size_t)r * 1024 + c * 8); }
        if (tid < 32) L_hist[tid] = 0;
        zero_bytes(row_tok, (size_t)MOE_ROWS_MAX * 4, gtid, ngt);
        __syncthreads();
        const int fr = lane & 15, fq = lane >> 4;
        f32x4 G4[4], B4[4];
#pragma unroll
        for (int hf = 0; hf < 2; ++hf) { const int c = hf * 512 + 8 * lane; G4[2 * hf] = *(const f32x4*)(kin[14] + c); G4[2 * hf + 1] = *(const f32x4*)(kin[14] + c + 4); B4[2 * hf] = *(const f32x4*)(kin[15] + c); B4[2 * hf + 1] = *(const f32x4*)(kin[15] + c + 4); }
        for (int rb = tok_lo + wave * 16; rb < tok_hi; rb += NWAVES * 16) {
            for (int i = 0; i < 16 && rb + i < tok_hi; ++i) ln_row_bf16(y1 + (size_t)(rb + i) * DM, G4, B4, h1 + (size_t)(rb + i) * DM, h1f8 + (size_t)(rb + i) * DM, lane);
            asm volatile("s_waitcnt vmcnt(0)" ::: "memory");
            const int row = rb + fr < NTOK ? rb + fr : NTOK - 1;
            const bf16* ap = h1 + (size_t)row * DM + fq * 8;
            bf16x8 a[32];
#pragma unroll
            for (int ks = 0; ks < 32; ++ks) a[ks] = *(const bf16x8*)(ap + ks * 32);
            f32x4 acc0 = {0.f, 0.f, 0.f, 0.f}, acc1 = {0.f, 0.f, 0.f, 0.f};
            const LAS unsigned char* bp = L_wr + (8 * (fr >> 2) + (fr & 3)) * WRP + fq * 16;
#pragma unroll
            for (int ks = 0; ks < 32; ++ks) { const bf16x8 b0 = *(const LAS bf16x8*)(bp + ks * 64), b1 = *(const LAS bf16x8*)(bp + 4 * WRP + ks * 64);
                acc0 = __builtin_amdgcn_mfma_f32_16x16x32_bf16(b0, a[ks], acc0, 0, 0, 0); acc1 = __builtin_amdgcn_mfma_f32_16x16x32_bf16(b1, a[ks], acc1, 0, 0, 0); }
            const float* br = kin[17] + 8 * fq; const f32x4 bb0 = *(const f32x4*)br, bb1 = *(const f32x4*)(br + 4);
            float v[8] = {acc0[0] + bb0[0], acc0[1] + bb0[1], acc0[2] + bb0[2], acc0[3] + bb0[3], acc1[0] + bb1[0], acc1[1] + bb1[1], acc1[2] + bb1[2], acc1[3] + bb1[3]};
            float tv[4]; int ti[4];
#pragma unroll
            for (int r = 0; r < 4; ++r) { float bv = v[0]; int bi = 8 * fq;
#pragma unroll
                for (int j = 1; j < 8; ++j) if (v[j] > bv) { bv = v[j]; bi = 8 * fq + j; }
#pragma unroll
                for (int off = 16; off <= 32; off <<= 1) { const float ov = __shfl_xor(bv, off); const int oi = __shfl_xor(bi, off); if (ov > bv || (ov == bv && oi < bi)) { bv = ov; bi = oi; } }
                tv[r] = bv; ti[r] = bi;
#pragma unroll
                for (int j = 0; j < 8; ++j) if (bi == 8 * fq + j) v[j] = -INFINITY; }
            const float e1 = __expf(tv[1] - tv[0]), e2 = __expf(tv[2] - tv[0]), e3 = __expf(tv[3] - tv[0]), inv = 1.f / (1.f + e1 + e2 + e3);
            if (fq == 0 && rb + fr < tok_hi) { const int t = rb + fr; *(int4*)(topk + (size_t)t * 4) = make_int4(ti[0], ti[1], ti[2], ti[3]); *(f32x4*)(gate + (size_t)t * 4) = (f32x4){inv, e1 * inv, e2 * inv, e3 * inv};
                atomicAdd((int*)(L_hist + ti[0]), 1); atomicAdd((int*)(L_hist + ti[1]), 1); atomicAdd((int*)(L_hist + ti[2]), 1); atomicAdd((int*)(L_hist + ti[3]), 1); }
        }
        __syncthreads();
        if (tid < 32) hist[bx * 32 + tid] = L_hist[tid];
    }
    SEAM(8);
    for (int rep_ = 0; rep_ < (IN(10) ? REPS(10) : 0); ++rep_) { if (rep_) GRID_BAR(); PTRS; ROUTE_VARS;
        if (tid < 32) { int tot = 0, before = 0; for (int b = 0; b < G; ++b) { const int h = hist[b * 32 + tid]; tot += h; if (b < bx) before += h; } L_n[tid] = tot; L_base[tid] = before; L_hist[tid] = 0; }
        __syncthreads();
        if (tid == 0) { int off = 0; for (int e = 0; e < NE; ++e) { L_off[e] = off; off += (L_n[e] + 255) & ~255; } L_off[NE] = off; }
        __syncthreads();
        for (int p = tok_lo * 4 + tid; p < tok_hi * 4; p += NWAVES * 64) { const int e = topk[p]; const int r = atomicAdd((int*)(L_hist + e), 1); const int pos = L_off[e] + L_base[e] + r;
            row_gate[pos] = gate[p]; pair_pos[p] = pos; row_tok[pos] = p >> 2; }
        __syncthreads();
        if (bx == 0) { if (tid == 0) moetab[0] = L_off[NE];
            if (tid < 32) { moetab[64 + tid] = L_n[tid]; moetab[128 + tid] = L_off[tid]; for (int t = L_off[tid] >> 8; t < (L_off[tid + 1] >> 8); ++t) tile_expert[t] = tid; } }
        __syncthreads();
    }
    SEAM(10);
    for (int rep_ = 0; rep_ < (IN(11) ? REPS(11) : 0); ++rep_) { if (rep_) GRID_BAR(); PTRS; const int rows = moetab[0]; EpiGU8 E{act8, kin[19]};
        pg8::Gemm g{(const bf16*)h1f8, (const bf16*)w_gu8, rows, 2048, 512, 512, row_tok}; pg8::MoeOrder S; S.init(rows >> 8, 8, G, bx, tile_expert);
        MOE_STAGGER((rows >> 8) * 8);
        pg8::gemm_phase<EpiGU8, pg8::MoeOrder, true, true, true, true>((LAS unsigned char*)lds, g, S, E);
    }
    SEAM(11);
    for (int rep_ = 0; rep_ < (IN(12) ? REPS(12) : 0); ++rep_) { if (rep_) GRID_BAR(); PTRS; const int rows = moetab[0]; EpiDN8 E{out2, kin[21], row_gate};
        pg8::Gemm g{(const bf16*)act8, (const bf16*)w_dn8, rows, 1024, 512, 512, nullptr}; pg8::MoeOrder S; S.init(rows >> 8, 4, G, bx, tile_expert);
        MOE_STAGGER((rows >> 8) * 4);
        pg8::gemm_phase<EpiDN8, pg8::MoeOrder, true, true, true>((LAS unsigned char*)lds, g, S, E);
    }
    SEAM(12);
    for (int rep_ = 0; rep_ < (IN(13) ? REPS(13) : 0); ++rep_) { if (rep_) GRID_BAR(); PTRS;
        f32x4 G4[4], B4[4];
#pragma unroll
        for (int hf = 0; hf < 2; ++hf) { const int c = hf * 512 + 8 * lane; G4[2 * hf] = *(const f32x4*)(kin[22] + c); G4[2 * hf + 1] = *(const f32x4*)(kin[22] + c + 4); B4[2 * hf] = *(const f32x4*)(kin[23] + c); B4[2 * hf + 1] = *(const f32x4*)(kin[23] + c + 4); }
        int4 pp = gw < NTOK ? *(const int4*)(pair_pos + (size_t)gw * 4) : make_int4(0, 0, 0, 0);
        for (int t = gw; t < NTOK; t += ngw) {
            const int ps[4] = {pp.x, pp.y, pp.z, pp.w};
            u32x4 hv[2]; u32x2 ov[4][2];
#pragma unroll
            for (int hf = 0; hf < 2; ++hf) { hv[hf] = *(const u32x4*)(h1 + (size_t)t * DM + hf * 512 + 8 * lane);
#pragma unroll
                for (int s4 = 0; s4 < 4; ++s4) ov[s4][hf] = *(const u32x2*)(out2 + (size_t)ps[s4] * DM + hf * 512 + 8 * lane); }
            if (t + ngw < NTOK) pp = *(const int4*)(pair_pos + (size_t)(t + ngw) * 4);
            float v[16];
#pragma unroll
            for (int hf = 0; hf < 2; ++hf) { float f[8]; unpack8(hv[hf], f);
                float acc8[8] = {0.f, 0.f, 0.f, 0.f, 0.f, 0.f, 0.f, 0.f};
#pragma unroll
                for (int s4 = 0; s4 < 4; ++s4) {
#pragma unroll
                    for (int w = 0; w < 2; ++w) { const unsigned d = w ? ov[s4][hf].y : ov[s4][hf].x;
                        const f32x2 lo = __builtin_amdgcn_cvt_pk_f32_fp8((int)d, false), hi2 = __builtin_amdgcn_cvt_pk_f32_fp8((int)d, true);
                        acc8[4 * w + 0] += lo[0]; acc8[4 * w + 1] += lo[1]; acc8[4 * w + 2] += hi2[0]; acc8[4 * w + 3] += hi2[1]; } }
#pragma unroll
                for (int j = 0; j < 8; ++j) v[hf * 8 + j] = ALPHA * f[j] + O2_INV * acc8[j]; }
            float s = 0.f;
#pragma unroll
            for (int j = 0; j < 16; ++j) s += v[j];
            const float mean = wave_sum(s) * (1.f / DM); float s2 = 0.f;
#pragma unroll
            for (int j = 0; j < 16; ++j) { v[j] -= mean; s2 += v[j] * v[j]; }
            const float rstd = rsq(wave_sum(s2) * (1.f / DM) + LN_EPS);
#pragma unroll
            for (int hf = 0; hf < 2; ++hf) { float* o = outp + (size_t)t * DM + hf * 512 + 8 * lane;
                *(f32x4*)o = (f32x4){v[hf * 8 + 0], v[hf * 8 + 1], v[hf * 8 + 2], v[hf * 8 + 3]} * rstd * G4[2 * hf] + B4[2 * hf];
                *(f32x4*)(o + 4) = (f32x4){v[hf * 8 + 4], v[hf * 8 + 5], v[hf * 8 + 6], v[hf * 8 + 7]} * rstd * G4[2 * hf + 1] + B4[2 * hf + 1]; }
        }
    }
#undef IN
#undef SEAM
}

extern "C" void kernel_launch(void* const* d_in, const int* in_sizes, int n_in, void* d_out, int out_size, void* d_ws, size_t ws_size, hipStream_t stream) {
    static int grid = 0;
    if (grid == 0) {
        if (n_in != 24 || in_sizes[0] != NTOK * DM || out_size != NTOK * DM || ws_size < WS_END) { fprintf(stderr, "kernel_launch: shape/workspace mismatch (n_in %d, ws %zu)\n", n_in, ws_size); grid = -1; return; }
        int dev = 0, cus = 0, per_cu = 0;
        if (hipGetDevice(&dev) != hipSuccess || hipDeviceGetAttribute(&cus, hipDeviceAttributeMultiprocessorCount, dev) != hipSuccess) { grid = -1; return; }
        if (hipFuncSetAttribute((const void*)hymba_fwd, hipFuncAttributeMaxDynamicSharedMemorySize, LDS_BYTES) != hipSuccess) { fprintf(stderr, "kernel_launch: hipFuncSetAttribute failed\n"); grid = -1; return; }
        if (hipOccupancyMaxActiveBlocksPerMultiprocessor(&per_cu, (const void*)hymba_fwd, NWAVES * 64, LDS_BYTES) != hipSuccess || per_cu < 1) fprintf(stderr, "kernel_launch: occupancy query says %d\n", per_cu);
        (void)hipGetLastError();
        grid = cus;
    }
    if (grid < 0) return;
    (void)hipMemsetAsync((char*)d_ws + WS_CTL, 0, CTL_ZERO_BYTES, stream);
    Args a{};
    for (int i = 0; i < 24; ++i) a.in[i] = (const float*)d_in[i];
    a.out = (float*)d_out; a.ws = (unsigned char*)d_ws;
#if MK_SPLIT
    for (int p = 0; p < NPHASE; ++p) { a.ph_lo = p; a.ph_hi = p + 1; hipLaunchKernelGGL(hymba_fwd, dim3(grid), dim3(NWAVES * 64), LDS_BYTES, stream, a); }
#else
    a.ph_lo = 0; a.ph_hi = NPHASE; hipLaunchKernelGGL(hymba_fwd, dim3(grid), dim3(NWAVES * 64), LDS_BYTES, stream, a);
#endif
}
```

```cpp
#include <hip/hip_runtime.h>
#include <cstdio>
#include <cstdint>

#ifndef MK_SPLIT
#define MK_SPLIT 0
#endif

#define LAS __attribute__((address_space(3)))
#define CAS __attribute__((address_space(4)))
typedef unsigned short bf16;
typedef short bf16x8 __attribute__((ext_vector_type(8)));
typedef short s16x4 __attribute__((ext_vector_type(4)));
typedef float f32x2 __attribute__((ext_vector_type(2)));
typedef float f32x4 __attribute__((ext_vector_type(4)));
typedef float f32x16 __attribute__((ext_vector_type(16)));
typedef unsigned u32x2 __attribute__((ext_vector_type(2)));
typedef unsigned u32x4 __attribute__((ext_vector_type(4)));
typedef __bf16 bf16x2_t __attribute__((ext_vector_type(2)));

constexpr int NB = 16, SEQ = 2048, DM = 1024, NMETA = 16;
constexpr int NTOK = NB * SEQ;
constexpr int MROWS = NTOK + NMETA;
constexpr int MPAD = 33024;
constexpr int LKP = 2112;
constexpr int NIN = 1472, ZLD = 1536;
constexpr int NE = 32, NPAIR = NTOK * 4, MOE_TILES_MAX = 544, MOE_ROWS_MAX = MOE_TILES_MAX * 256;
constexpr float ALPHA = 1.189207115002721f;
constexpr float RMS_EPS = 1e-6f, LN_EPS = 1e-5f;

constexpr size_t MiB = 1u << 20;
constexpr size_t WS_CTL = 0, CTL_ZERO_BYTES = 1 * MiB;
constexpr size_t WS_ROPE = 1 * MiB;
constexpr size_t WS_WQB = 2 * MiB;
constexpr size_t WS_WKVB = 2 * MiB + 512 * 1024;
constexpr size_t WS_WR = 3 * MiB;
constexpr size_t WS_LOGITS = 4 * MiB;
constexpr size_t WS_TOPK = 8 * MiB;
constexpr size_t WS_GATE = 8 * MiB + 512 * 1024;
constexpr size_t WS_PAIRPOS = 9 * MiB;
constexpr size_t WS_ROWGATE = 9 * MiB + 512 * 1024;
constexpr size_t WS_HIST = 10 * MiB + 512 * 1024;
constexpr size_t WS_MOETAB = 10 * MiB + 768 * 1024;
constexpr size_t WS_WIN = 12 * MiB;
constexpr size_t WS_WO = 15 * MiB;
constexpr size_t WS_WGU = 32 * MiB;
constexpr size_t WS_WDN = 96 * MiB;
constexpr size_t WS_H1F8 = 128 * MiB;
constexpr size_t WS_H0 = 224 * MiB;
constexpr size_t WS_H1 = 289 * MiB;
constexpr size_t WS_QAN = 353 * MiB;
constexpr size_t WS_KVAN = 370 * MiB;
constexpr size_t WS_Z = 380 * MiB;
constexpr size_t WS_QM = 477 * MiB;
constexpr size_t WS_KM = 525 * MiB;
constexpr size_t WS_VM = 575 * MiB;
constexpr size_t WS_QG = 608 * MiB;
constexpr size_t WS_KG = 640 * MiB;
constexpr size_t WS_VG = 657 * MiB;
constexpr size_t WS_O = 674 * MiB;
constexpr size_t WS_Y1 = 738 * MiB;
constexpr size_t WS_XS = 380 * MiB;
constexpr size_t WS_ACT = 516 * MiB;
constexpr size_t WS_OUT2 = 652 * MiB;
constexpr size_t WS_END = 924 * MiB;
static_assert(WS_Z + (size_t)MPAD * ZLD * 2 <= WS_QM && WS_QM + (size_t)64 * 2048 * 192 * 2 <= WS_KM && WS_KM + (size_t)64 * LKP * 192 * 2 <= WS_VM && WS_VM + (size_t)64 * LKP * 128 * 2 <= WS_QG, "ws map 1");
static_assert(WS_QG + (size_t)64 * 2048 * 128 * 2 <= WS_KG && WS_KG + (size_t)32 * LKP * 128 * 2 <= WS_VG && WS_VG + (size_t)32 * LKP * 128 * 2 <= WS_O && WS_O + (size_t)NTOK * DM * 2 <= WS_Y1 && WS_Y1 + (size_t)NTOK * DM * 4 <= WS_END, "ws map 2");
static_assert(WS_XS + (size_t)MOE_ROWS_MAX * DM <= WS_ACT && WS_ACT + (size_t)MOE_ROWS_MAX * DM <= WS_OUT2 && WS_OUT2 + (size_t)MOE_ROWS_MAX * DM * 2 <= WS_END && WS_WGU + (size_t)NE * 2048 * 1024 <= WS_WDN && WS_WDN + (size_t)NE * 1024 * 1024 <= WS_H1F8 && WS_H1F8 + (size_t)NTOK * DM <= WS_H0, "ws map 3");
static_assert(WS_H0 + (size_t)MPAD * DM * 2 <= WS_H1 && WS_H1 + (size_t)NTOK * DM * 2 <= WS_QAN && WS_QAN + (size_t)MPAD * 256 * 2 <= WS_KVAN && WS_KVAN + (size_t)MPAD * 128 * 2 <= WS_Z, "ws map 4");
constexpr int CW_BAR = 4096;

constexpr int RING_BYTES = 131072;
constexpr int LDSCTL_OFF = RING_BYTES;
constexpr int LDS_BYTES = 147456;
constexpr int NWAVES = 8;

#define LDS_WAIT() asm volatile("s_waitcnt lgkmcnt(0)" ::: "memory")
#define SBAR() __builtin_amdgcn_sched_barrier(0)
__device__ __forceinline__ unsigned cvtpk(float lo, float hi) { f32x2 v = {lo, hi}; bf16x2_t b = __builtin_convertvector(v, bf16x2_t); return __builtin_bit_cast(unsigned, b); }
__device__ __forceinline__ u32x4 pack8(const float (&v)[8]) { u32x4 r = {cvtpk(v[0], v[1]), cvtpk(v[2], v[3]), cvtpk(v[4], v[5]), cvtpk(v[6], v[7])}; return r; }
__device__ __forceinline__ void unpack8(u32x4 w, float (&v)[8]) {
    v[0] = __uint_as_float(w.x << 16); v[1] = __uint_as_float(w.x & 0xffff0000u); v[2] = __uint_as_float(w.y << 16); v[3] = __uint_as_float(w.y & 0xffff0000u);
    v[4] = __uint_as_float(w.z << 16); v[5] = __uint_as_float(w.z & 0xffff0000u); v[6] = __uint_as_float(w.w << 16); v[7] = __uint_as_float(w.w & 0xffff0000u);
}
__device__ __forceinline__ float wave_sum(float v) {
#pragma unroll
    for (int o = 1; o < 64; o <<= 1) v += __shfl_xor(v, o);
    return v;
}
__device__ __forceinline__ float rsq(float x) { return __builtin_amdgcn_rsqf(x); }
typedef int v8i __attribute__((ext_vector_type(8)));
__device__ __forceinline__ unsigned pack4_f8(float a, float b, float c, float d) { int w = 0; w = __builtin_amdgcn_cvt_pk_fp8_f32(a, b, w, false); w = __builtin_amdgcn_cvt_pk_fp8_f32(c, d, w, true); return (unsigned)w; }
constexpr float W8_SCALE = 32.f, W8_INV = 1.f / 32.f;

#define XB_TMO      128
#define XB_XCNT(j)  (256  + 64 * (j))
#define XB_XSUB(j)  (1280 + 64 * (j))
#define XB_XGEN(j)  (2304 + 64 * (j))
#define XB_TOP      3328
#define XB_TOPGEN   3392
#define XCD_BAR_WORDS 3456
#define XB_SPIN_CAP (1u << 18)
__device__ __forceinline__ unsigned xb_ld(unsigned* p)              { return __hip_atomic_load(p, __ATOMIC_RELAXED, __HIP_MEMORY_SCOPE_AGENT); }
__device__ __forceinline__ unsigned xb_add(unsigned* p, unsigned v) { return __hip_atomic_fetch_add(p, v, __ATOMIC_RELAXED, __HIP_MEMORY_SCOPE_AGENT); }
__device__ __forceinline__ unsigned xb_xcc_id() { return (unsigned)__builtin_amdgcn_s_getreg((3 << 11) | 20) & 0xFu; }
#define XB_SPIN(cond, bar) do { unsigned _sp = 0; while (cond) { __builtin_amdgcn_s_sleep(1); \
    if ((++_sp & 255u) == 0u) { if (xb_ld(&(bar)[XB_TMO])) break; if (_sp > XB_SPIN_CAP) { atomicAdd(&(bar)[XB_TMO], 1u); break; } } } } while (0)
struct XcdBarrier { unsigned* bar; unsigned x; volatile LAS unsigned* st; };
__device__ __forceinline__ XcdBarrier xcd_barrier_post(unsigned* bar, volatile LAS unsigned* st) {
    XcdBarrier b; b.bar = bar; b.x = xb_xcc_id(); b.st = st;
    if (threadIdx.x == 0) (void)xb_add(&bar[XB_XCNT(b.x)], 1u);
    return b;
}
__device__ __forceinline__ void xcd_barrier_complete(unsigned* bar, unsigned x, unsigned& nloc, unsigned& nx) {
    const unsigned G = gridDim.x * gridDim.y * gridDim.z;
    unsigned sum, cnt, mine, sp = 0u;
    for (;;) {
        sum = 0u; cnt = 0u; mine = 0u;
#pragma unroll
        for (unsigned j = 0; j < 16; ++j) { const unsigned c = xb_ld(&bar[XB_XCNT(j)]); sum += c; cnt += (c > 0u) ? 1u : 0u; mine = (j == x) ? c : mine; }
        if (sum == G) break;
        __builtin_amdgcn_s_sleep(1);
        if ((++sp & 255u) == 0u) { if (xb_ld(&bar[XB_TMO])) break; if (sp > XB_SPIN_CAP) { atomicAdd(&bar[XB_TMO], 1u); break; } }
    }
    nloc = mine > 0u ? mine : 1u; nx = cnt > 0u ? cnt : 1u;
}
__device__ __forceinline__ void xcd_barrier(const XcdBarrier& b) {
    asm volatile("s_waitcnt vmcnt(0)" ::: "memory");
    __syncthreads();
    if (threadIdx.x == 0) {
        unsigned* bar = b.bar;
        __builtin_amdgcn_s_waitcnt(0);
        unsigned nloc = b.st[0], nx = b.st[1];
        if (nloc == 0u) { xcd_barrier_complete(bar, b.x, nloc, nx); b.st[0] = nloc; b.st[1] = nx; }
        const unsigned old = xb_add(&bar[XB_XSUB(b.x)], 1u);
        const unsigned gen = old / nloc;
        if (old + 1u == (gen + 1u) * nloc) {
            __builtin_amdgcn_fence(__ATOMIC_RELEASE, "agent");
            asm volatile("s_waitcnt vmcnt(0)" ::: "memory");
            const unsigned og = xb_add(&bar[XB_TOP], 1u);
            const unsigned tg = og / nx;
            if (og + 1u == (tg + 1u) * nx) xb_add(&bar[XB_TOPGEN], 1u);
            else XB_SPIN(xb_ld(&bar[XB_TOPGEN]) == tg, bar);
            __builtin_amdgcn_fence(__ATOMIC_ACQUIRE, "agent");
            xb_add(&bar[XB_XGEN(b.x)], 1u);
            asm volatile("s_waitcnt vmcnt(0)" ::: "memory");
        } else {
            XB_SPIN(xb_ld(&bar[XB_XGEN(b.x)]) == gen, bar);
            __builtin_amdgcn_fence(__ATOMIC_ACQUIRE, "agent");
            asm volatile("s_waitcnt vmcnt(0)" ::: "memory");
        }
    }
    __syncthreads();
}

struct BSelNone { __device__ __forceinline__ size_t operator()(int) const { return 0; } };
struct BSelExpert { const int* tile_expert; size_t per; __device__ __forceinline__ size_t operator()(int m0) const { return (size_t)tile_expert[m0 >> 8] * per; } };
template <class Epi, class BSel>
__device__ __forceinline__ void simple_gemm(const bf16* __restrict__ A, const bf16* __restrict__ Bt, int K, int m_lo, int m_hi, int N, const Epi& E, const BSel& bsel, int gw, int ngw, int lane, int lda = 0) {
    if (lda == 0) lda = K;
    const int fr = lane & 15, fq = lane >> 4;
    const int mt = (m_hi - m_lo) / 64, nt = N / 32;
    for (int u = gw; u < mt * nt; u += ngw) {
        const int m0 = m_lo + (u / nt) * 64, n0 = (u % nt) * 32;
        const bf16* ap = A + (size_t)(m0 + fr) * lda + fq * 8;
        const bf16* bp = Bt + bsel(m0) + (size_t)(n0 + 8 * (fr >> 2) + (fr & 3)) * K + fq * 8;
        f32x4 acc[4][2];
#pragma unroll
        for (int i = 0; i < 4; ++i) { acc[i][0] = (f32x4){0.f, 0.f, 0.f, 0.f}; acc[i][1] = (f32x4){0.f, 0.f, 0.f, 0.f}; }
#pragma unroll 2
        for (int k = 0; k < K; k += 32) {
            bf16x8 a[4], b[2];
#pragma unroll
            for (int i = 0; i < 4; ++i) a[i] = *(const bf16x8*)(ap + (size_t)i * 16 * lda + k);
#pragma unroll
            for (int j = 0; j < 2; ++j) b[j] = *(const bf16x8*)(bp + (size_t)j * 4 * K + k);
#pragma unroll
            for (int i = 0; i < 4; ++i)
#pragma unroll
                for (int j = 0; j < 2; ++j) acc[i][j] = __builtin_amdgcn_mfma_f32_16x16x32_bf16(b[j], a[i], acc[i][j], 0, 0, 0);
        }
#pragma unroll
        for (int i = 0; i < 4; ++i) {
            const float v[8] = {acc[i][0][0], acc[i][0][1], acc[i][0][2], acc[i][0][3], acc[i][1][0], acc[i][1][1], acc[i][1][2], acc[i][1][3]};
            E.store8(m0 + 16 * i + fr, n0 + 8 * fq, v);
        }
    }
}


template <int K, class Epi>
__device__ __forceinline__ void smallk_task(const bf16* __restrict__ A, const bf16* __restrict__ Bt, int m0, int ng_lo, int ng_hi, const Epi& E, int lane) {
    constexpr int KS = K / 32;
    const int fr = lane & 15, fq = lane >> 4;
    bf16x8 a[4][KS];
#pragma unroll
    for (int i = 0; i < 4; ++i)
#pragma unroll
        for (int ks = 0; ks < KS; ++ks) a[i][ks] = *(const bf16x8*)(A + (size_t)(m0 + 16 * i + fr) * K + ks * 32 + fq * 8);
#pragma unroll 1
    for (int ng = ng_lo; ng < ng_hi; ++ng) {
        const int n0 = ng * 32;
        const bf16* bp = Bt + (size_t)(n0 + 8 * (fr >> 2) + (fr & 3)) * K + fq * 8;
        bf16x8 b[2][KS];
#pragma unroll
        for (int ks = 0; ks < KS; ++ks) { b[0][ks] = *(const bf16x8*)(bp + ks * 32); b[1][ks] = *(const bf16x8*)(bp + 4 * K + ks * 32); }
        f32x4 acc[4][2];
#pragma unroll
        for (int i = 0; i < 4; ++i) { acc[i][0] = (f32x4){0.f, 0.f, 0.f, 0.f}; acc[i][1] = (f32x4){0.f, 0.f, 0.f, 0.f}; }
#pragma unroll
        for (int ks = 0; ks < KS; ++ks)
#pragma unroll
            for (int i = 0; i < 4; ++i) { acc[i][0] = __builtin_amdgcn_mfma_f32_16x16x32_bf16(b[0][ks], a[i][ks], acc[i][0], 0, 0, 0); acc[i][1] = __builtin_amdgcn_mfma_f32_16x16x32_bf16(b[1][ks], a[i][ks], acc[i][1], 0, 0, 0); }
#pragma unroll
        for (int i = 0; i < 4; ++i) {
            const float v[8] = {acc[i][0][0], acc[i][0][1], acc[i][0][2], acc[i][0][3], acc[i][1][0], acc[i][1][1], acc[i][1][2], acc[i][1][3]};
            E.store8(m0 + 16 * i + fr, n0 + 8 * fq, v);
        }
    }
}


template <int K, class Epi>
__device__ __forceinline__ void meta_gemm16(const bf16* __restrict__ A, int lda, const bf16* __restrict__ Bt, int m0, int N, const Epi& E, int gw, int ngw, int lane) {
    const int fr = lane & 15, fq = lane >> 4;
    for (int ng = gw; ng < N / 32; ng += ngw) {
        const int n0 = ng * 32;
        const bf16* ap = A + (size_t)(m0 + fr) * lda + fq * 8;
        const bf16* bp = Bt + (size_t)(n0 + 8 * (fr >> 2) + (fr & 3)) * K + fq * 8;
        f32x4 acc0 = {0.f, 0.f, 0.f, 0.f}, acc1 = {0.f, 0.f, 0.f, 0.f};
#pragma unroll 8
        for (int k = 0; k < K; k += 32) { const bf16x8 a = *(const bf16x8*)(ap + k), b0 = *(const bf16x8*)(bp + k), b1 = *(const bf16x8*)(bp + 4 * K + k);
            acc0 = __builtin_amdgcn_mfma_f32_16x16x32_bf16(b0, a, acc0, 0, 0, 0); acc1 = __builtin_amdgcn_mfma_f32_16x16x32_bf16(b1, a, acc1, 0, 0, 0); }
        const float v[8] = {acc0[0], acc0[1], acc0[2], acc0[3], acc1[0], acc1[1], acc1[2], acc1[3]};
        E.store8(m0 + fr, n0 + 8 * fq, v);
    }
}

struct EpiZ { bf16* z;
    __device__ __forceinline__ void store8(int row, int col, const float (&v)[8]) const { if (col < NIN) *(u32x4*)(z + (size_t)row * ZLD + col) = pack8(v); } };
struct EpiQ { bf16* qm; const float* rs;
    __device__ __forceinline__ void store8(int row, int col, const float (&v_)[8]) const {
        const int h = col / 192, w = col - h * 192, b = row >> 11, s = row & 2047; const float r_ = rs[row];
        const float o[8] = {v_[0] * r_, v_[1] * r_, v_[2] * r_, v_[3] * r_, v_[4] * r_, v_[5] * r_, v_[6] * r_, v_[7] * r_};
        *(u32x4*)(qm + ((size_t)(b * 4 + h) * 2048 + s) * 192 + w) = pack8(o);
    } };
template <bool META> struct EpiKV { bf16* km; bf16* vm; const float* rs;
    __device__ __forceinline__ void store8(int row, int col, const float (&v_)[8]) const {
        if (META && row >= MROWS) return;
        const float r_ = rs[row]; const float v[8] = {v_[0] * r_, v_[1] * r_, v_[2] * r_, v_[3] * r_, v_[4] * r_, v_[5] * r_, v_[6] * r_, v_[7] * r_};
        const int h = col >> 8, w = col & 255; const u32x4 pk = pack8(v);
        if (!META) { const int b = row >> 11, key = row & 2047; const size_t r = (size_t)(b * 4 + h) * LKP + key;
            if (w < 128) *(u32x4*)(km + r * 192 + w) = pk; else *(u32x4*)(vm + r * 128 + (w - 128)) = pk;
        } else { const int key = 2048 + (row - NTOK);
            for (int b = 0; b < NB; ++b) { const size_t r = (size_t)(b * 4 + h) * LKP + key;
                if (w < 128) *(u32x4*)(km + r * 192 + w) = pk; else *(u32x4*)(vm + r * 128 + (w - 128)) = pk; } }
    } };
struct EpiO { bf16* y1; const bf16* h0;
    __device__ __forceinline__ void store8(int row, int col, const float (&v)[8]) const {
        float h[8]; unpack8(*(const u32x4*)(h0 + (size_t)row * DM + col), h);
        const float o[8] = {ALPHA * h[0] + v[0], ALPHA * h[1] + v[1], ALPHA * h[2] + v[2], ALPHA * h[3] + v[3], ALPHA * h[4] + v[4], ALPHA * h[5] + v[5], ALPHA * h[6] + v[6], ALPHA * h[7] + v[7]};
        *(u32x4*)(y1 + (size_t)row * DM + col) = pack8(o);
    } };
struct EpiLogit { float* logits; const float* bias;
    __device__ __forceinline__ void store8(int row, int col, const float (&v)[8]) const {
        float* y = logits + (size_t)row * NE + col;
        *(f32x4*)y = (f32x4){v[0] + bias[col], v[1] + bias[col + 1], v[2] + bias[col + 2], v[3] + bias[col + 3]};
        *(f32x4*)(y + 4) = (f32x4){v[4] + bias[col + 4], v[5] + bias[col + 5], v[6] + bias[col + 6], v[7] + bias[col + 7]};
    } };
namespace pg8 {
#define PG8_LAS __attribute__((address_space(3)))
typedef unsigned short bf16_t;
constexpr int BM = 256, BK = 64, HALF = 128, HTB = HALF * BK * 2, STAGE_BYTES = 8 * HTB, NXCD = 8, WGM = 8;
__host__ __device__ __forceinline__ int lds_byte(int r, int c) { const int st = (r >> 4) * 2 + (c >> 5), rr = r & 15, cc = c & 31, ob = rr * 64 + cc * 2; return st * 1024 + (ob ^ (((ob >> 9) & 1) << 5)); }
__host__ __device__ __forceinline__ void stage_rc(int b, int& R, int& C) { const int st = b / 1024, sb = b % 1024, swz = sb ^ (((sb >> 9) & 1) << 5); R = (st >> 1) * 16 + swz / 64; C = (st & 1) * 32 + (swz % 64) / 2; }
__host__ __device__ __forceinline__ int perm32(int rho) { const int n = rho >> 4, i = rho & 15; return 8 * (i >> 2) + 4 * n + (i & 3); }
struct Unit { int pm, pn, ui; };
struct Gemm { const bf16_t* A; const bf16_t* Bt; int M, N, K, lda; const int* row_tok; };
struct StaticOrder {
    int nM, nN, nwg, G, c;
    __host__ __device__ void init(int M, int N, int G_, int c_) { nM = M / BM; nN = N / BM; nwg = nM * nN; G = G_; c = c_; }
    __host__ __device__ bool next(int i, Unit& u) const {
        const long L = (long)i * G + c; if (L >= nwg) return false;
        int wgid = (int)L; { const int q = nwg / NXCD, r = nwg % NXCD, xcd = wgid % NXCD, off = wgid / NXCD; wgid = (xcd < r ? xcd * (q + 1) : r * (q + 1) + (xcd - r) * q) + off; }
        const int nig = WGM * nN, gid = wgid / nig, fm = gid * WGM, gsz = (nM - fm) < WGM ? (nM - fm) : WGM;
        u.pm = fm + ((wgid % nig) % gsz); u.pn = (wgid % nig) / gsz; u.ui = i; return true;
    }
    __device__ __forceinline__ void a_ready(const Unit&) const {}
    __device__ __forceinline__ void done(const Unit&) const {}
};
struct MoeOrder {
    StaticOrder so; const int* tile_expert;
    __device__ void init(int tiles, int nN, int G_, int c_, const int* te) { so.nM = tiles; so.nN = nN; so.nwg = tiles * nN; so.G = G_; so.c = c_; tile_expert = te; }
    __device__ bool next(int i, Unit& u) const { if (!so.next(i, u)) return false; u.pn += tile_expert[u.pm] * so.nN; return true; }
    __device__ __forceinline__ void a_ready(const Unit&) const {}
    __device__ __forceinline__ void done(const Unit&) const {}
};
template <class E8> struct EpiAdapt {
    static constexpr bool PERM = true, AFTER_DRAIN = false;
    E8 e; int ncols_mod;
    __device__ __forceinline__ void operator()(const f32x4 (&acc)[2][2][4][2], const Unit& u, int wr, int wc, int fr, int fq) const {
        const int row0 = u.pm * BM + wr * 64 + fr; int colt = u.pn * BM; if (ncols_mod) colt %= ncols_mod;
        const int col0 = colt + wc * 32 + 8 * fq;
#pragma unroll
        for (int ai = 0; ai < 2; ++ai)
#pragma unroll
            for (int m = 0; m < 4; ++m)
#pragma unroll
                for (int bj = 0; bj < 2; ++bj) {
                    const float v[8] = {acc[ai][bj][m][0][0], acc[ai][bj][m][0][1], acc[ai][bj][m][0][2], acc[ai][bj][m][0][3], acc[ai][bj][m][1][0], acc[ai][bj][m][1][1], acc[ai][bj][m][1][2], acc[ai][bj][m][1][3]};
                    e.store8(row0 + ai * HALF + m * 16, col0 + bj * HALF, v); }
    }
};
struct NoHook { static constexpr bool ON = false; __device__ __forceinline__ void mid(f32x4 (&)[2][2][4][2], const Unit&, int, int) const {} };
template <class Epi, class Sched, bool ALIGN_EPI = false, bool SP2 = false, bool F8 = false, bool GATHER = false, class Hook = NoHook>
__device__ __forceinline__ void gemm_phase(PG8_LAS unsigned char* lds, const Gemm g, const Sched& S, const Epi& E, const Hook& H = Hook()) {
    const int tid = threadIdx.x, wid = __builtin_amdgcn_readfirstlane(tid >> 6), lane = tid & 63, wr = wid >> 2, wc = wid & 3, fr = lane & 15, fq = lane >> 4;
    const int K = g.K, nt = K / BK;
    unsigned voffA[2], voffB[2];
#pragma unroll
    for (int i = 0; i < 2; ++i) { int R, C; stage_rc(tid * 16 + i * 8192, R, C); const int Rb = Epi::PERM ? ((R & ~31) + perm32(R & 31)) : R;
        voffA[i] = (unsigned)(R * g.lda + C) * 2u; voffB[i] = (unsigned)(Rb * K + C) * 2u; }
    int gR[2]; unsigned gC[2];
#pragma unroll
    for (int i = 0; i < 2; ++i) { int R, C; stage_rc(tid * 16 + i * 8192, R, C); gR[i] = R; gC[i] = (unsigned)C * 2u; }
    const unsigned lda2 = (unsigned)g.lda * 2u;
    unsigned vC[2][2], vN[2][2]; int tkn[2][2];
    static_assert(!GATHER || SP2, "GATHER is written for the SP2 loop");
#define PG8_TOKLD(dst, pm_) do { _Pragma("unroll") for (int h_ = 0; h_ < 2; ++h_) _Pragma("unroll") for (int i_ = 0; i_ < 2; ++i_) dst[h_][i_] = g.row_tok[(pm_) * 256 + h_ * 128 + gR[i_]]; } while (0)
#define PG8_TOKOFF(dst, src) do { _Pragma("unroll") for (int h_ = 0; h_ < 2; ++h_) _Pragma("unroll") for (int i_ = 0; i_ < 2; ++i_) dst[h_][i_] = (unsigned)src[h_][i_] * lda2 + gC[i_]; } while (0)
    const size_t kstep = (size_t)(BK * 2);
    const size_t hstep = (size_t)HALF * K * 2, hstepA = (size_t)HALF * g.lda * 2;
    const size_t tstep = 2 * hstep, tstepA = 2 * hstepA;
    const unsigned ldsw = (unsigned)wid * 1024u;
    const int aoff = lds_byte(wr * 64 + fr, fq * 8), boff = lds_byte(wc * 32 + fr, fq * 8);
#define PG8_SA(b, h) (((b) * 2 + (h)) * HTB)
#define PG8_SB(b, h) ((4 + (b) * 2 + (h)) * HTB)
#define PG8_STAGE(bufoff, gbase, voff) do { _Pragma("unroll") for (int _i = 0; _i < 2; ++_i) \
        __builtin_amdgcn_global_load_lds((const unsigned*)((const char*)(gbase) + (voff)[_i]), (PG8_LAS unsigned*)(lds + (bufoff) + ldsw + _i * 8192), 16, 0, 0); } while (0)
#define PG8_LDA(dst, b, h) do { _Pragma("unroll") for (int m = 0; m < 4; ++m) _Pragma("unroll") for (int k = 0; k < 2; ++k) dst[m][k] = *(const PG8_LAS bf16x8*)(lds + PG8_SA(b, h) + aoff + m * 2048 + k * 1024); } while (0)
#define PG8_LDB(dst, b, h) do { _Pragma("unroll") for (int n = 0; n < 2; ++n) _Pragma("unroll") for (int k = 0; k < 2; ++k) dst[n][k] = *(const PG8_LAS bf16x8*)(lds + PG8_SB(b, h) + boff + n * 2048 + k * 1024); } while (0)
#define PG8_F8CAT(x) __builtin_shufflevector(__builtin_bit_cast(u32x4, (x)[0]), __builtin_bit_cast(u32x4, (x)[1]), 0, 1, 2, 3, 4, 5, 6, 7)
#define PG8_MMA(ai, bj, At, Bt) do { __builtin_amdgcn_s_setprio(1); if constexpr (F8) { _Pragma("unroll") for (int m = 0; m < 4; ++m) _Pragma("unroll") for (int n = 0; n < 2; ++n) \
        acc[ai][bj][m][n] = __builtin_amdgcn_mfma_scale_f32_16x16x128_f8f6f4(__builtin_bit_cast(v8i, PG8_F8CAT(Bt[n])), __builtin_bit_cast(v8i, PG8_F8CAT(At[m])), acc[ai][bj][m][n], 0, 0, 0, 0x7f7f7f7f, 0, 0x7f7f7f7f); \
        _Pragma("unroll") for (int m = 0; m < 4; ++m) _Pragma("unroll") for (int n = 0; n < 2; ++n) asm volatile("" : "+v"(acc[ai][bj][m][n])); } \
    else { _Pragma("unroll") for (int m = 0; m < 4; ++m) _Pragma("unroll") for (int n = 0; n < 2; ++n) _Pragma("unroll") for (int k = 0; k < 2; ++k) \
        acc[ai][bj][m][n] = __builtin_amdgcn_mfma_f32_16x16x32_bf16(Bt[n][k], At[m][k], acc[ai][bj][m][n], 0, 0, 0); } __builtin_amdgcn_s_setprio(0); } while (0)
#define PG8_WAIT_V(n) asm volatile("s_waitcnt vmcnt(" #n ")" ::: "memory")
#define PG8_WAIT_L(n) asm volatile("s_waitcnt lgkmcnt(" #n ")" ::: "memory")
#define PG8_BAR __builtin_amdgcn_s_barrier()
#define PG8_SCHED __builtin_amdgcn_sched_barrier(0)
    Unit cur, nxt; int ui = 0;
    if (!S.next(0, cur)) return;
    f32x4 acc[2][2][4][2];
#pragma unroll
    for (int a = 0; a < 2; ++a)
#pragma unroll
        for (int b = 0; b < 2; ++b)
#pragma unroll
            for (int m = 0; m < 4; ++m)
#pragma unroll
                for (int n = 0; n < 2; ++n) acc[a][b][m][n] = (f32x4){0.f, 0.f, 0.f, 0.f};
    bf16x8 At[4][2], B0[2][2], B1[2][2];
    const char* const gA = (const char*)g.A;
    const char* cA = (const char*)g.A + (size_t)cur.pm * tstepA; const char* cB = (const char*)g.Bt + (size_t)cur.pn * tstep;
    S.a_ready(cur);
    if constexpr (SP2) {
        if constexpr (GATHER) { PG8_TOKLD(tkn, cur.pm); PG8_TOKOFF(vC, tkn); Unit u1_; if (S.next(1, u1_)) { PG8_TOKLD(tkn, u1_.pm); PG8_TOKOFF(vN, tkn); } else { PG8_TOKOFF(vN, tkn); } }
        PG8_STAGE(PG8_SB(0, 0), cB, voffB); PG8_STAGE(PG8_SB(0, 1), cB + hstep, voffB);
        if constexpr (GATHER) { PG8_STAGE(PG8_SA(0, 0), gA, vC[0]); PG8_STAGE(PG8_SA(0, 1), gA, vC[1]); } else { PG8_STAGE(PG8_SA(0, 0), cA, voffA); PG8_STAGE(PG8_SA(0, 1), cA + hstepA, voffA); }
        if (wr == 1) PG8_BAR;
        PG8_WAIT_V(2); PG8_BAR;
        PG8_STAGE(PG8_SB(1, 0), cB + kstep, voffB); if constexpr (GATHER) { PG8_STAGE(PG8_SA(1, 0), gA + kstep, vC[0]); } else { PG8_STAGE(PG8_SA(1, 0), cA + kstep, voffA); } PG8_STAGE(PG8_SB(1, 1), cB + hstep + kstep, voffB);
        PG8_WAIT_V(6); PG8_BAR;
    } else {
        PG8_STAGE(PG8_SB(0, 0), cB, voffB); PG8_STAGE(PG8_SA(0, 0), cA, voffA); PG8_STAGE(PG8_SB(0, 1), cB + hstep, voffB); PG8_STAGE(PG8_SA(0, 1), cA + hstepA, voffA);
        if (wr == 1) PG8_BAR;
        PG8_WAIT_V(4); PG8_BAR;
        PG8_STAGE(PG8_SB(1, 0), cB + kstep, voffB); PG8_STAGE(PG8_SA(1, 0), cA + kstep, voffA); PG8_STAGE(PG8_SB(1, 1), cB + hstep + kstep, voffB);
        PG8_WAIT_V(6); PG8_BAR;
    }
    for (;;) {
        const bool has_next = S.next(ui + 1, nxt);
        const char* nA = has_next ? (const char*)g.A + (size_t)nxt.pm * tstepA : cA; const char* nB = has_next ? (const char*)g.Bt + (size_t)nxt.pn * tstep : cB;
        for (int t = 0; t < nt; t += 2) {
            const bool last = (t == nt - 2);
            const char* a1 = cA + (size_t)(t + 1) * kstep;
            const char* a2 = last ? nA : cA + (size_t)(t + 2) * kstep; const char* b2 = last ? nB : cB + (size_t)(t + 2) * kstep;
            const char* a3 = a2 + kstep; const char* b3 = b2 + kstep;
            if (last && has_next) S.a_ready(nxt);
            if constexpr (Hook::ON) { if (t == nt / 2) H.mid(acc, cur, wr, fr); }
            if constexpr (SP2) {
            const char* ga1 = gA + (size_t)(t + 1) * kstep; const char* ga2 = gA + (last ? (size_t)0 : (size_t)(t + 2) * kstep); const char* ga3 = ga2 + kstep;
            unsigned v2[2][2];
            if constexpr (GATHER) { _Pragma("unroll") for (int h_ = 0; h_ < 2; ++h_) _Pragma("unroll") for (int i_ = 0; i_ < 2; ++i_) v2[h_][i_] = last ? vN[h_][i_] : vC[h_][i_]; }
            PG8_LDB(B0, 0, 0); PG8_LDB(B1, 0, 1); PG8_SCHED; PG8_LDA(At, 0, 0); if constexpr (GATHER) { PG8_STAGE(PG8_SA(1, 1), ga1, vC[1]); } else { PG8_STAGE(PG8_SA(1, 1), a1 + hstepA, voffA); }
            PG8_WAIT_V(8); PG8_WAIT_L(0); PG8_BAR; PG8_MMA(0, 0, At, B0); PG8_MMA(0, 1, At, B1); PG8_BAR; PG8_SCHED;
            PG8_LDA(At, 0, 1); PG8_STAGE(PG8_SB(0, 0), b2, voffB); PG8_STAGE(PG8_SB(0, 1), b2 + hstep, voffB); if constexpr (GATHER) { PG8_STAGE(PG8_SA(0, 0), ga2, v2[0]); } else { PG8_STAGE(PG8_SA(0, 0), a2, voffA); }
            PG8_WAIT_V(8); PG8_WAIT_L(0); PG8_BAR; PG8_MMA(1, 0, At, B0); PG8_MMA(1, 1, At, B1); PG8_BAR; PG8_SCHED;
            PG8_LDB(B0, 1, 0); PG8_LDB(B1, 1, 1); PG8_SCHED; PG8_LDA(At, 1, 0); if constexpr (GATHER) { PG8_STAGE(PG8_SA(0, 1), ga2, v2[1]); } else { PG8_STAGE(PG8_SA(0, 1), a2 + hstepA, voffA); }
            PG8_WAIT_V(8); PG8_WAIT_L(0); PG8_BAR; PG8_MMA(0, 0, At, B0); PG8_MMA(0, 1, At, B1); PG8_BAR; PG8_SCHED;
            PG8_LDA(At, 1, 1); PG8_STAGE(PG8_SB(1, 0), b3, voffB); PG8_STAGE(PG8_SB(1, 1), b3 + hstep, voffB); if constexpr (GATHER) { PG8_STAGE(PG8_SA(1, 0), ga3, v2[0]); } else { PG8_STAGE(PG8_SA(1, 0), a3, voffA); }
            PG8_WAIT_V(8); PG8_WAIT_L(0); PG8_BAR; PG8_MMA(1, 0, At, B0); PG8_MMA(1, 1, At, B1); PG8_BAR; PG8_SCHED;
            } else {
            PG8_LDB(B0, 0, 0); PG8_SCHED; PG8_LDA(At, 0, 0); PG8_STAGE(PG8_SA(1, 1), a1 + hstepA, voffA);
            PG8_WAIT_L(8); PG8_BAR; PG8_WAIT_L(0); PG8_MMA(0, 0, At, B0); PG8_BAR; PG8_SCHED;
            PG8_LDB(B1, 0, 1); PG8_STAGE(PG8_SB(0, 0), b2, voffB);
            PG8_BAR; PG8_WAIT_L(0); PG8_MMA(0, 1, At, B1); PG8_BAR;
            PG8_LDA(At, 0, 1); PG8_STAGE(PG8_SA(0, 0), a2, voffA);
            PG8_BAR; PG8_WAIT_L(0); PG8_MMA(1, 0, At, B0); PG8_BAR; PG8_SCHED;
            PG8_STAGE(PG8_SB(0, 1), b2 + hstep, voffB);
            PG8_WAIT_V(6); PG8_BAR; PG8_MMA(1, 1, At, B1); PG8_BAR;
            PG8_LDB(B0, 1, 0); PG8_SCHED; PG8_LDA(At, 1, 0); PG8_STAGE(PG8_SA(0, 1), a2 + hstepA, voffA);
            PG8_WAIT_L(8); PG8_BAR; PG8_WAIT_L(0); PG8_MMA(0, 0, At, B0); PG8_BAR; PG8_SCHED;
            PG8_LDB(B1, 1, 1); PG8_STAGE(PG8_SB(1, 0), b3, voffB);
            PG8_BAR; PG8_WAIT_L(0); PG8_MMA(0, 1, At, B1); PG8_BAR;
            PG8_LDA(At, 1, 1); PG8_STAGE(PG8_SA(1, 0), a3, voffA);
            PG8_BAR; PG8_WAIT_L(0); PG8_MMA(1, 0, At, B0); PG8_BAR; PG8_SCHED;
            PG8_STAGE(PG8_SB(1, 1), b3 + hstep, voffB);
            PG8_WAIT_V(6); PG8_BAR; PG8_MMA(1, 1, At, B1); PG8_BAR;
            }
        }
        if constexpr (ALIGN_EPI) { if (wr == 0) PG8_BAR; }
        bool has_nn = false;
        if constexpr (GATHER) { Unit nn_; has_nn = has_next && S.next(ui + 2, nn_); if (has_nn) PG8_TOKLD(tkn, nn_.pm); }
        if constexpr (!Epi::AFTER_DRAIN) { E(acc, cur, wr, wc, fr, fq); S.done(cur); }
        if (!has_next) break;
        if constexpr (GATHER) { _Pragma("unroll") for (int h_ = 0; h_ < 2; ++h_) _Pragma("unroll") for (int i_ = 0; i_ < 2; ++i_) vC[h_][i_] = vN[h_][i_]; if (has_nn) PG8_TOKOFF(vN, tkn); }
#pragma unroll
        for (int a = 0; a < 2; ++a)
#pragma unroll
            for (int b = 0; b < 2; ++b)
#pragma unroll
                for (int m = 0; m < 4; ++m)
#pragma unroll
                    for (int n = 0; n < 2; ++n) acc[a][b][m][n] = (f32x4){0.f, 0.f, 0.f, 0.f};
        cur = nxt; cA = nA; cB = nB; ++ui;
        if constexpr (ALIGN_EPI) { if (wr == 1) PG8_BAR; }
    }
    PG8_WAIT_V(0);
    if constexpr (!ALIGN_EPI) { if (wr == 0) PG8_BAR; }
    PG8_BAR;
#undef PG8_SA
#undef PG8_SB
#undef PG8_STAGE
#undef PG8_LDA
#undef PG8_LDB
#undef PG8_MMA
#undef PG8_F8CAT
#undef PG8_TOKLD
#undef PG8_TOKOFF
#undef PG8_WAIT_V
#undef PG8_WAIT_L
#undef PG8_BAR
#undef PG8_SCHED
}
}

__device__ __forceinline__ u32x4 f8_pair16(u32x2 rowA, u32x2 rowB) {
    const auto s0 = __builtin_amdgcn_permlane16_swap(rowA.x, rowB.x, false, false), s1 = __builtin_amdgcn_permlane16_swap(rowA.y, rowB.y, false, false);
    return (u32x4){s0[0], s1[0], s0[1], s1[1]};
}
struct EpiGU8 { static constexpr bool PERM = true, AFTER_DRAIN = false;
    unsigned char* act8; const float* bgu;
    __device__ __forceinline__ void operator()(const f32x4 (&acc)[2][2][4][2], const pg8::Unit& u, int wr, int wc, int fr, int fq) const {
        const int e = u.pn >> 3, ac0 = 128 * (u.pn & 7) + wc * 32 + 8 * fq;
        const float* bb = bgu + (size_t)e * 2048 + 2 * ac0;
        const f32x4 q0 = *(const f32x4*)bb, q1 = *(const f32x4*)(bb + 4), q2 = *(const f32x4*)(bb + 8), q3 = *(const f32x4*)(bb + 12);
        const float bg[8] = {q0[0], q0[2], q1[0], q1[2], q2[0], q2[2], q3[0], q3[2]}, bl[8] = {q0[1], q0[3], q1[1], q1[3], q2[1], q2[3], q3[1], q3[3]};
        const int odd = fq & 1, acs = ac0 - 8 * odd;
#pragma unroll
        for (int ai = 0; ai < 2; ++ai)
#pragma unroll
            for (int mp = 0; mp < 2; ++mp) { u32x2 pk[2];
#pragma unroll
                for (int h = 0; h < 2; ++h) { const int m = 2 * mp + h; float o[8];
#pragma unroll
                    for (int t = 0; t < 8; t += 2) {
                        const f32x2 ag = {acc[ai][0][m][t >> 2][t & 3], acc[ai][0][m][(t + 1) >> 2][(t + 1) & 3]}, al = {acc[ai][1][m][t >> 2][t & 3], acc[ai][1][m][(t + 1) >> 2][(t + 1) & 3]};
                        f32x2 xg = ag * W8_INV + (f32x2){bg[t], bg[t + 1]}, xl = al * W8_INV + (f32x2){bl[t], bl[t + 1]};
                        xg.x = fminf(xg.x, 7.f); xg.y = fminf(xg.y, 7.f); xl.x = __builtin_amdgcn_fmed3f(xl.x, -7.f, 7.f); xl.y = __builtin_amdgcn_fmed3f(xl.y, -7.f, 7.f);
                        const f32x2 ex = xg * (-1.702f * 1.4426950408889634f); f32x2 dn; dn.x = __builtin_amdgcn_exp2f(ex.x); dn.y = __builtin_amdgcn_exp2f(ex.y); dn = dn + 1.f;
                        f32x2 sg; sg.x = __builtin_amdgcn_rcpf(dn.x); sg.y = __builtin_amdgcn_rcpf(dn.y);
                        const f32x2 pq = xg * sg, ov = pq * xl + pq; o[t] = ov.x; o[t + 1] = ov.y; }
                    pk[h] = (u32x2){pack4_f8(o[0], o[1], o[2], o[3]), pack4_f8(o[4], o[5], o[6], o[7])}; }
                const int row = u.pm * 256 + ai * 128 + wr * 64 + (2 * mp + odd) * 16 + fr;
                *(u32x4*)(act8 + (size_t)row * DM + acs) = f8_pair16(pk[0], pk[1]); }
    } };
constexpr float O2_SCALE = 8.f, O2_INV = 1.f / 8.f;
struct EpiDN8 { static constexpr bool PERM = true, AFTER_DRAIN = false;
    unsigned char* out2; const float* bdn; const float* row_gate;
    __device__ __forceinline__ void operator()(const f32x4 (&acc)[2][2][4][2], const pg8::Unit& u, int wr, int wc, int fr, int fq) const {
        const int e = u.pn >> 2, c0 = 256 * (u.pn & 3) + wc * 32 + 8 * fq;
        f32x4 bv[2][2];
#pragma unroll
        for (int bj = 0; bj < 2; ++bj) { bv[bj][0] = *(const f32x4*)(bdn + (size_t)e * DM + c0 + bj * 128); bv[bj][1] = *(const f32x4*)(bdn + (size_t)e * DM + c0 + bj * 128 + 4); }
        const int odd = fq & 1, cs = c0 - 8 * odd;
#pragma unroll
        for (int ai = 0; ai < 2; ++ai)
#pragma unroll
            for (int mp = 0; mp < 2; ++mp) { u32x2 pk[2][2];
#pragma unroll
                for (int h = 0; h < 2; ++h) { const int m = 2 * mp + h; const float g = row_gate[u.pm * 256 + ai * 128 + wr * 64 + m * 16 + fr] * O2_SCALE;
#pragma unroll
                    for (int bj = 0; bj < 2; ++bj) { const f32x4 v0 = (acc[ai][bj][m][0] * W8_INV + bv[bj][0]) * g, v1 = (acc[ai][bj][m][1] * W8_INV + bv[bj][1]) * g;
                        pk[bj][h] = (u32x2){pack4_f8(v0[0], v0[1], v0[2], v0[3]), pack4_f8(v1[0], v1[1], v1[2], v1[3])}; } }
                const int row = u.pm * 256 + ai * 128 + wr * 64 + (2 * mp + odd) * 16 + fr;
#pragma unroll
                for (int bj = 0; bj < 2; ++bj) *(u32x4*)(out2 + (size_t)row * DM + cs + bj * 128) = f8_pair16(pk[bj][0], pk[bj][1]); }
    } };

struct HookO { static constexpr bool ON = true; const LAS f32x2* T;
    __device__ __forceinline__ void mid(f32x4 (&acc)[2][2][4][2], const pg8::Unit& u, int wr, int fr) const {
#pragma unroll
        for (int ai = 0; ai < 2; ++ai)
#pragma unroll
            for (int m = 0; m < 4; ++m) { const float r = T[u.ui * 256 + ai * 128 + wr * 64 + m * 16 + fr].x;
#pragma unroll
                for (int bj = 0; bj < 2; ++bj) { acc[ai][bj][m][0] = acc[ai][bj][m][0] * r; acc[ai][bj][m][1] = acc[ai][bj][m][1] * r; } }
    } };
struct EpiOF { static constexpr bool PERM = true, AFTER_DRAIN = false;
    bf16* y1; const bf16* h0; const LAS f32x2* T;
    __device__ __forceinline__ void operator()(const f32x4 (&acc)[2][2][4][2], const pg8::Unit& u, int wr, int wc, int fr, int fq) const {
        const int c0 = u.pn * 256 + wc * 32 + 8 * fq;
#pragma unroll
        for (int ai = 0; ai < 2; ++ai)
#pragma unroll
            for (int m = 0; m < 4; ++m) { const int rl = ai * 128 + wr * 64 + m * 16 + fr, row = u.pm * 256 + rl; const float r = T[u.ui * 256 + rl].y;
#pragma unroll
                for (int bj = 0; bj < 2; ++bj) { float h[8]; unpack8(*(const u32x4*)(h0 + (size_t)row * DM + c0 + bj * 128), h);
                    const f32x4 a = acc[ai][bj][m][0] * r, b = acc[ai][bj][m][1] * r;
                    const float o[8] = {ALPHA * h[0] + a[0], ALPHA * h[1] + a[1], ALPHA * h[2] + a[2], ALPHA * h[3] + a[3], ALPHA * h[4] + b[0], ALPHA * h[5] + b[1], ALPHA * h[6] + b[2], ALPHA * h[7] + b[3]};
                    *(u32x4*)(y1 + (size_t)row * DM + c0 + bj * 128) = pack8(o); } }
    } };
#ifndef FAST_Z
#define FAST_Z 1
#endif
#ifndef FAST_O
#define FAST_O 1
#endif

struct MapId { __device__ __forceinline__ int operator()(int n) const { return n; } };
struct MapIn { __device__ __forceinline__ int operator()(int n) const {
    if (n >= 384 && n < 448) { const int l = n - 384; return 384 + 2 * (l & 31) + (l >> 5); }
    if (n >= 448 && n < 1216) { const int l = n - 448, hd = l >> 7, d = l & 127; return 448 + hd * 128 + (d >> 6) * 64 + 2 * (d & 31) + ((d >> 5) & 1); }
    return n; } };
struct MapQ { __device__ __forceinline__ int operator()(int n) const { const int h = n / 192, w = n - h * 192; if (w < 128) return n; const int l = w - 128; return h * 192 + 128 + 2 * (l & 31) + (l >> 5); } };
struct MapGU { __device__ __forceinline__ int operator()(int n) const { const int a = n >> 1; return 256 * (a >> 7) + 128 * (n & 1) + (a & 127); } };
template <class Map>
__device__ __forceinline__ void transpose_item(const float* __restrict__ W, int K, int N, bf16* __restrict__ WT, LAS float* scr, int item, int lane, const Map& map, const float* __restrict__ kscale = nullptr, int ldo = 0, const float* __restrict__ kscale2 = nullptr) {
    if (ldo == 0) ldo = K;
    const int nblk = N / 32, kb = item / nblk, nb = item - kb * nblk, k0 = 64 * kb, n0 = 32 * nb;
#pragma unroll 8
    for (int i = 0; i < 32; ++i) { const int kk = 2 * i + (lane >> 5); scr[kk * 33 + (lane & 31)] = (k0 < K) ? W[(size_t)(k0 + kk) * N + n0 + (lane & 31)] * (kscale ? ((kscale2 && k0 + kk >= 512) ? kscale2[k0 + kk - 512] : kscale[k0 + kk]) : 1.f) : 0.f; }
    LDS_WAIT(); asm volatile("" ::: "memory");
    const int c = lane & 7;
#pragma unroll
    for (int j = 0; j < 4; ++j) { const int n = (lane >> 3) + 8 * j; const LAS float* s = scr + (8 * c) * 33 + n;
        u32x4 o; o.x = cvtpk(s[0 * 33], s[1 * 33]); o.y = cvtpk(s[2 * 33], s[3 * 33]); o.z = cvtpk(s[4 * 33], s[5 * 33]); o.w = cvtpk(s[6 * 33], s[7 * 33]);
        *(u32x4*)(WT + (size_t)map(n0 + n) * ldo + k0 + 8 * c) = o; }
    LDS_WAIT(); asm volatile("" ::: "memory");
}

template <class Map>
__device__ __forceinline__ void transpose_item_f8(const float* __restrict__ W, int K, int N, unsigned char* __restrict__ WT, LAS float* scr, int item, int lane, const Map& map, float scale) {
    const int nblk = N / 32, kb = item / nblk, nb = item - kb * nblk, k0 = 64 * kb, n0 = 32 * nb;
#pragma unroll 8
    for (int i = 0; i < 8; ++i) { const int kk = 8 * i + (lane >> 3), c4 = (lane & 7) * 4; const f32x4 w4 = *(const f32x4*)(W + (size_t)(k0 + kk) * N + n0 + c4) * scale;
        LAS float* d_ = scr + kk * 33 + c4; d_[0] = w4[0]; d_[1] = w4[1]; d_[2] = w4[2]; d_[3] = w4[3]; }
    LDS_WAIT(); asm volatile("" ::: "memory");
    const int n = lane >> 1;
#pragma unroll
    for (int j = 0; j < 2; ++j) { const int c = 2 * (lane & 1) + j; const LAS float* s_ = scr + (16 * c) * 33 + n;
        u32x4 o; o.x = pack4_f8(s_[0 * 33], s_[1 * 33], s_[2 * 33], s_[3 * 33]); o.y = pack4_f8(s_[4 * 33], s_[5 * 33], s_[6 * 33], s_[7 * 33]);
        o.z = pack4_f8(s_[8 * 33], s_[9 * 33], s_[10 * 33], s_[11 * 33]); o.w = pack4_f8(s_[12 * 33], s_[13 * 33], s_[14 * 33], s_[15 * 33]);
        *(u32x4*)(WT + (size_t)map(n0 + n) * K + k0 + 16 * c) = o; }
    LDS_WAIT(); asm volatile("" ::: "memory");
}

template <class Map>
__device__ __forceinline__ void transpose_f8_stream(const float* __restrict__ Wall, int N, unsigned char* __restrict__ WTall, LAS float* scr, int gw, int ngw, int lane, const Map& map, float scale) {
    const int nblk = N / 32, per = 16 * nblk, n_items = NE * per;
#define T8_LOAD(dst, it_) do { const int e_ = (it_) / per, r_ = (it_) - e_ * per, kb_ = r_ / nblk, nb_ = r_ - kb_ * nblk; \
        const float* wp_ = Wall + ((size_t)e_ * 1024 + 64 * kb_ + (lane >> 3)) * N + 32 * nb_ + (lane & 7) * 4; \
        _Pragma("unroll") for (int i = 0; i < 8; ++i) dst[i] = *(const f32x4*)(wp_ + (size_t)(8 * i) * N); } while (0)
    f32x4 cur[8], nxt[8];
    int it = gw; if (it < n_items) T8_LOAD(cur, it);
    for (; it < n_items; it += ngw) {
        const int itn = it + ngw; if (itn < n_items) T8_LOAD(nxt, itn);
        const int e = it / per, r = it - e * per, kb = r / nblk, nb = r - kb * nblk, k0 = 64 * kb, n0 = 32 * nb;
#pragma unroll
        for (int i = 0; i < 8; ++i) { LAS float* d_ = scr + (8 * i + (lane >> 3)) * 33 + (lane & 7) * 4; const f32x4 w4 = cur[i] * scale; d_[0] = w4[0]; d_[1] = w4[1]; d_[2] = w4[2]; d_[3] = w4[3]; }
        LDS_WAIT(); asm volatile("" ::: "memory");
        const int n = lane >> 1;
#pragma unroll
        for (int j = 0; j < 2; ++j) { const int c = 2 * (lane & 1) + j; const LAS float* s_ = scr + (16 * c) * 33 + n;
            u32x4 o; o.x = pack4_f8(s_[0 * 33], s_[1 * 33], s_[2 * 33], s_[3 * 33]); o.y = pack4_f8(s_[4 * 33], s_[5 * 33], s_[6 * 33], s_[7 * 33]);
            o.z = pack4_f8(s_[8 * 33], s_[9 * 33], s_[10 * 33], s_[11 * 33]); o.w = pack4_f8(s_[12 * 33], s_[13 * 33], s_[14 * 33], s_[15 * 33]);
            *(u32x4*)(WTall + ((size_t)e * N + map(n0 + n)) * 1024 + k0 + 16 * c) = o; }
        LDS_WAIT(); asm volatile("" ::: "memory");
#pragma unroll
        for (int i = 0; i < 8; ++i) cur[i] = nxt[i];
    }
#undef T8_LOAD
}
__device__ __forceinline__ void ln_row_f32_to_bf16(f32x4 (&v)[4], const f32x4 (&gg)[4], const f32x4 (&bb)[4], bf16* __restrict__ orow, int lane) {
    float s = 0.f;
#pragma unroll
    for (int j = 0; j < 4; ++j) s += (v[j].x + v[j].y) + (v[j].z + v[j].w);
    const float mean = wave_sum(s) * (1.f / DM); float s2 = 0.f;
#pragma unroll
    for (int j = 0; j < 4; ++j) { v[j] = v[j] - mean; s2 += (v[j].x * v[j].x + v[j].y * v[j].y) + (v[j].z * v[j].z + v[j].w * v[j].w); }
    const float rstd = rsq(wave_sum(s2) * (1.f / DM) + LN_EPS);
#pragma unroll
    for (int j = 0; j < 4; ++j) { const f32x4 o = v[j] * rstd * gg[j] + bb[j]; ((u32x2*)orow)[lane + 64 * j] = (u32x2){cvtpk(o.x, o.y), cvtpk(o.z, o.w)}; }
}

__device__ __forceinline__ void ln_row_bf16(const bf16* __restrict__ yrow, const f32x4 (&G4)[4], const f32x4 (&B4)[4], bf16* __restrict__ orow, unsigned char* __restrict__ o8, int lane) {
    float v[16]; unpack8(*(const u32x4*)(yrow + 8 * lane), *(float(*)[8])&v[0]); unpack8(*(const u32x4*)(yrow + 512 + 8 * lane), *(float(*)[8])&v[8]);
    float s = 0.f;
#pragma unroll
    for (int j = 0; j < 16; ++j) s += v[j];
    const float mean = wave_sum(s) * (1.f / DM); float s2 = 0.f;
#pragma unroll
    for (int j = 0; j < 16; ++j) { v[j] -= mean; s2 += v[j] * v[j]; }
    const float rstd = rsq(wave_sum(s2) * (1.f / DM) + LN_EPS);
#pragma unroll
    for (int hf = 0; hf < 2; ++hf) { const f32x4 a = (f32x4){v[hf * 8 + 0], v[hf * 8 + 1], v[hf * 8 + 2], v[hf * 8 + 3]} * rstd * G4[2 * hf] + B4[2 * hf], b = (f32x4){v[hf * 8 + 4], v[hf * 8 + 5], v[hf * 8 + 6], v[hf * 8 + 7]} * rstd * G4[2 * hf + 1] + B4[2 * hf + 1];
        *(u32x4*)(orow + hf * 512 + 8 * lane) = (u32x4){cvtpk(a[0], a[1]), cvtpk(a[2], a[3]), cvtpk(b[0], b[1]), cvtpk(b[2], b[3])};
        *(u32x2*)(o8 + hf * 512 + 8 * lane) = (u32x2){pack4_f8(a[0], a[1], a[2], a[3]), pack4_f8(b[0], b[1], b[2], b[3])}; }
}
__device__ __forceinline__ void zero_bytes(void* p, size_t bytes, int gtid, int ngt) {
    u32x4* q = (u32x4*)p; const size_t n = bytes / 16;
    for (size_t i = gtid; i < n; i += ngt) q[i] = (u32x4){0u, 0u, 0u, 0u};
}
__device__ __forceinline__ void sincos_d(float angf, float& sn, float& cs) {
    const double x = (double)angf; const double q = __builtin_rint(x * 0.63661977236758134308);
    const double r = (x - q * 1.57079632679489655800) - q * 6.123233995736766036e-17, r2 = r * r;
    const double sp = r * (1.0 + r2 * (-1.0 / 6 + r2 * (1.0 / 120 + r2 * (-1.0 / 5040 + r2 * (1.0 / 362880 + r2 * (-1.0 / 39916800 + r2 * (1.0 / 6227020800.0)))))));
    const double cp = 1.0 + r2 * (-0.5 + r2 * (1.0 / 24 + r2 * (-1.0 / 720 + r2 * (1.0 / 40320 + r2 * (-1.0 / 3628800 + r2 * (1.0 / 479001600.0))))));
    const int qi = ((int)q) & 3;
    const double s_ = (qi == 0) ? sp : (qi == 1) ? cp : (qi == 2) ? -sp : -cp;
    const double c_ = (qi == 0) ? cp : (qi == 1) ? -sp : (qi == 2) ? -cp : sp;
    sn = (float)s_; cs = (float)c_;
}

__device__ __forceinline__ void p2a_row(int row, u32x4 wA, u32x4 wB, u32x4 wC, const float* __restrict__ rope, const float* __restrict__ g_q_a, const float* __restrict__ g_kv_a,
                                        const float* __restrict__ g_q_gqa, const float* __restrict__ g_k_gqa, float* rs_q, float* rs_kv, bf16* km, bf16* qg, bf16* kg, bf16* vg, int lane) {
    const bool meta = row >= NTOK;
    const int b = row >> 11, s = row & 2047, m = row - NTOK;
    const int pos1 = meta ? m : 16 + s, prow = meta ? -1 : (s >> 6), pcol = meta ? m : (s & 63), key = meta ? 2048 + m : s;
    {
        float f[8]; unpack8(wA, f);
        float ss = 0.f;
#pragma unroll
        for (int j = 0; j < 8; ++j) ss += f[j] * f[j];
        ss += __shfl_xor(ss, 1); ss += __shfl_xor(ss, 2); ss += __shfl_xor(ss, 4); ss += __shfl_xor(ss, 8);
        const float s16 = ss, s32 = ss + __shfl_xor(ss, 16);
        if (lane == 0) rs_q[row] = rsq(s32 * (1.f / 256) + RMS_EPS);
        if (lane == 32) rs_kv[row] = rsq(s16 * (1.f / 128) + RMS_EPS);
        if (lane < 48) {
        } else if (lane < 56) { const int i0 = 4 * (lane - 48); const float* t = rope + ((size_t)(pos1 + 1) * 32 + i0) * 2; float o[8];
#pragma unroll
            for (int j = 0; j < 4; ++j) { const float c = t[2 * j], sn = t[2 * j + 1], x1 = f[2 * j], x2 = f[2 * j + 1]; o[2 * j] = x1 * c - x2 * sn; o[2 * j + 1] = x1 * sn + x2 * c; }
            const u32x4 pk = pack8(o);
            if (!meta) { for (int h = 0; h < 4; ++h) *(u32x4*)(km + ((size_t)(b * 4 + h) * LKP + key) * 192 + 128 + 8 * (lane - 48)) = pk; }
            else { for (int bb = 0; bb < NB; ++bb) for (int h = 0; h < 4; ++h) *(u32x4*)(km + ((size_t)(bb * 4 + h) * LKP + key) * 192 + 128 + 8 * (lane - 48)) = pk; }
        }
    }
    const int p0 = (lane & 15) * 8, half = p0 >> 6, i0 = (p0 & 63) >> 1;
    const int apos = half ? pcol : prow; const float* t = rope + ((size_t)(apos + 1) * 32 + i0) * 2;
    if (!meta) {
        float f[8]; unpack8(wB, f);
        float ss = 0.f;
#pragma unroll
        for (int j = 0; j < 8; ++j) ss += f[j] * f[j];
        ss += __shfl_xor(ss, 1); ss += __shfl_xor(ss, 2); ss += __shfl_xor(ss, 4); ss += __shfl_xor(ss, 8);
        const float rs = rsq(ss * (1.f / 128) + RMS_EPS); float o[8];
#pragma unroll
        for (int j = 0; j < 4; ++j) { const int d1 = half * 64 + i0 + j, d2 = d1 + 32;
            const float x1 = f[2 * j] * rs * g_q_gqa[d1], x2 = f[2 * j + 1] * rs * g_q_gqa[d2], c = t[2 * j], sn = t[2 * j + 1];
            o[2 * j] = x1 * c - x2 * sn; o[2 * j + 1] = x1 * sn + x2 * c; }
        *(u32x4*)(qg + ((size_t)(b * 4 + (lane >> 4)) * 2048 + s) * 128 + p0) = pack8(o);
    }
    {
        float f[8]; unpack8(wC, f);
        float ss = 0.f;
#pragma unroll
        for (int j = 0; j < 8; ++j) ss += f[j] * f[j];
        ss += __shfl_xor(ss, 1); ss += __shfl_xor(ss, 2); ss += __shfl_xor(ss, 4); ss += __shfl_xor(ss, 8);
        float o[8];
        if (lane < 32) { const float rs = rsq(ss * (1.f / 128) + RMS_EPS);
#pragma unroll
            for (int j = 0; j < 4; ++j) { const int d1 = half * 64 + i0 + j, d2 = d1 + 32;
                const float x1 = f[2 * j] * rs * g_k_gqa[d1], x2 = f[2 * j + 1] * rs * g_k_gqa[d2], c = t[2 * j], sn = t[2 * j + 1];
                o[2 * j] = x1 * c - x2 * sn; o[2 * j + 1] = x1 * sn + x2 * c; }
        } else {
#pragma unroll
            for (int j = 0; j < 8; ++j) o[j] = f[j];
        }
        const u32x4 pk = pack8(o); bf16* dst = lane < 32 ? kg : vg; const int hk = (lane >> 4) & 1;
        if (!meta) *(u32x4*)(dst + ((size_t)(b * 2 + hk) * LKP + key) * 128 + p0) = pk;
        else for (int bb = 0; bb < NB; ++bb) *(u32x4*)(dst + ((size_t)(bb * 2 + hk) * LKP + key) * 128 + p0) = pk;
    }
}

__device__ __forceinline__ int crow(int r, int hi) { return (r & 3) + 8 * (r >> 2) + 4 * hi; }
__device__ __forceinline__ int v_st(int k, int c) { const int kk = (k & ~0xC) | ((k & 4) << 1) | ((k & 8) >> 1); return ((kk >> 3) * 4 + (c >> 5)) * 512 + ((kk & 7) * 32 + (c & 31)) * 2; }
__device__ __forceinline__ int v_rd_base(int lane) { return ((lane & 3) << 3) | (((lane >> 2) & 3) << 6) | (((lane >> 4) & 1) << 5) | (((lane >> 5) & 1) << 8); }
constexpr int v_rd_off(int d0, int ks, int half) { return d0 * 512 + ks * 4096 + half * 2048; }
template <int OFF> __device__ __forceinline__ s16x4 tr_read(int vb) {
    s16x4 r; asm volatile("ds_read_b64_tr_b16 %0, %1 offset:%2" : "=&v"(r) : "v"(vb), "i"(OFF) : "memory"); return r;
}
template <int D0> __device__ __forceinline__ void pv_one(f32x16& od, int vb, bf16x8 pa0, bf16x8 pa1, bf16x8 pa2, bf16x8 pa3) {
    const s16x4 l0 = tr_read<v_rd_off(D0, 0, 0)>(vb), h0 = tr_read<v_rd_off(D0, 0, 1)>(vb), l1 = tr_read<v_rd_off(D0, 1, 0)>(vb), h1 = tr_read<v_rd_off(D0, 1, 1)>(vb);
    const s16x4 l2 = tr_read<v_rd_off(D0, 2, 0)>(vb), h2 = tr_read<v_rd_off(D0, 2, 1)>(vb), l3 = tr_read<v_rd_off(D0, 3, 0)>(vb), h3 = tr_read<v_rd_off(D0, 3, 1)>(vb);
    asm volatile("s_waitcnt lgkmcnt(0)" ::: "memory"); SBAR();
#define PK(L, H) (bf16x8){L[0], L[1], L[2], L[3], H[0], H[1], H[2], H[3]}
    od = __builtin_amdgcn_mfma_f32_32x32x16_bf16(pa0, PK(l0, h0), od, 0, 0, 0);
    od = __builtin_amdgcn_mfma_f32_32x32x16_bf16(pa1, PK(l1, h1), od, 0, 0, 0);
    od = __builtin_amdgcn_mfma_f32_32x32x16_bf16(pa2, PK(l2, h2), od, 0, 0, 0);
    od = __builtin_amdgcn_mfma_f32_32x32x16_bf16(pa3, PK(l3, h3), od, 0, 0, 0);
#undef PK
}
__device__ __forceinline__ void pv_d0(f32x16* o, int vb, bf16x8 pa0, bf16x8 pa1, bf16x8 pa2, bf16x8 pa3) {
    pv_one<0>(o[0], vb, pa0, pa1, pa2, pa3); pv_one<1>(o[1], vb, pa0, pa1, pa2, pa3); pv_one<2>(o[2], vb, pa0, pa1, pa2, pa3); pv_one<3>(o[3], vb, pa0, pa1, pa2, pa3);
}
template <int DQK> struct AttnC {
    static constexpr float SCALE = DQK == 192 ? 0.07216878364870322f : 0.08838834764831845f;
    static constexpr float C = SCALE * 1.4426950408889634f, THRS = 8.f / SCALE;
};
template <int DQK>
__device__ __forceinline__ void partialSM(f32x16& p0, f32x16& p1, float& m_reg, float& mn, float& alpha) {
    constexpr float C = AttnC<DQK>::C;
    float pmax = p0[0];
#pragma unroll
    for (int r = 1; r < 16; ++r) pmax = fmaxf(pmax, p0[r]);
#pragma unroll
    for (int r = 0; r < 16; ++r) pmax = fmaxf(pmax, p1[r]);
    { auto rr = __builtin_amdgcn_permlane32_swap(__float_as_uint(pmax), __float_as_uint(pmax), false, false);
      pmax = fmaxf(__uint_as_float(rr[0]), __uint_as_float(rr[1])); }
    if (__builtin_expect(__all(pmax - m_reg <= AttnC<DQK>::THRS), 1)) { mn = m_reg; alpha = 1.f; }
    else { mn = fmaxf(m_reg, pmax); alpha = __builtin_amdgcn_exp2f((m_reg - mn) * C); m_reg = mn; }
    const float mnC = -mn * C;
#pragma unroll
    for (int r = 0; r < 16; ++r) p0[r] = fmaf(p0[r], C, mnC);
#pragma unroll
    for (int r = 0; r < 16; ++r) p1[r] = fmaf(p1[r], C, mnC);
#pragma unroll
    for (int r = 0; r < 16; ++r) p0[r] = __builtin_amdgcn_exp2f(p0[r]);
}
__device__ __forceinline__ void finishSM(f32x16& p0, f32x16& p1, float alpha, float& l_reg, bf16x8& pa0, bf16x8& pa1, bf16x8& pa2, bf16x8& pa3) {
#pragma unroll
    for (int r = 0; r < 16; ++r) p1[r] = __builtin_amdgcn_exp2f(p1[r]);
    float ps = 0;
#pragma unroll
    for (int r = 0; r < 16; ++r) ps += p0[r];
#pragma unroll
    for (int r = 0; r < 16; ++r) ps += p1[r];
    { auto rr = __builtin_amdgcn_permlane32_swap(__float_as_uint(ps), __float_as_uint(ps), false, false);
      ps = __uint_as_float(rr[0]) + __uint_as_float(rr[1]); }
    l_reg = l_reg * alpha + ps;
#define PK4(P, BASE, OUT) do { unsigned a0 = cvtpk(P[BASE + 0], P[BASE + 1]), a1 = cvtpk(P[BASE + 2], P[BASE + 3]);   \
    unsigned b0 = cvtpk(P[BASE + 4], P[BASE + 5]), b1 = cvtpk(P[BASE + 6], P[BASE + 7]);                              \
    auto r0 = __builtin_amdgcn_permlane32_swap(a0, b0, false, false); auto r1 = __builtin_amdgcn_permlane32_swap(a1, b1, false, false); \
    u32x4 w = {r0[0], r1[0], r0[1], r1[1]}; OUT = *reinterpret_cast<bf16x8*>(&w); } while (0)
    PK4(p0, 0, pa0); PK4(p0, 8, pa1); PK4(p1, 0, pa2); PK4(p1, 8, pa3);
#undef PK4
}
template <int DQK>
__device__ __forceinline__ void qkt(f32x16& p0, f32x16& p1, const LAS char* Ks, const bf16x8* qr, const LAS char* ql, const int (&ko)[4]) {
    constexpr int KRB = DQK * 2;
    p0 = f32x16{}; p1 = f32x16{};
#pragma unroll
    for (int d0 = 0; d0 < DQK / 16; ++d0) { const LAS char* kp = Ks + ko[d0 & 3] + (d0 >> 2) * 128;
        const bf16x8 b0 = *(const LAS bf16x8*)(kp);
        const bf16x8 b1 = *(const LAS bf16x8*)(kp + 32 * KRB);
        bf16x8 q; if (d0 < 8) q = qr[d0]; else q = *(const LAS bf16x8*)(ql + (d0 - 8) * 1024);
        p0 = __builtin_amdgcn_mfma_f32_32x32x16_bf16(b0, q, p0, 0, 0, 0);
        p1 = __builtin_amdgcn_mfma_f32_32x32x16_bf16(b1, q, p1, 0, 0, 0); }
}
template <int DQK, int SD>
__device__ __forceinline__ void attn_body(const bf16* __restrict__ Qb, const bf16* __restrict__ Kh, const bf16* __restrict__ Vh, bf16* __restrict__ Ob, LAS char* lds, const float* __restrict__ rope, int pos0, float* __restrict__ ssq) {
    constexpr int ND0 = DQK / 16, KRB = DQK * 2, SHM_K = 64 * KRB, SHM_V = 64 * 128 * 2, NKC = DQK / 64, CPR = DQK / 8, NT = LKP / 64;
    static_assert(NT % 2 == 1, "odd tile count: the tail below takes tiles NT-2 and NT-1");
    int tid = threadIdx.x; asm volatile("" : "+v"(tid));
    const int wid = tid >> 6, lane = tid & 63, r32 = lane & 31, hi = lane >> 5;
    LAS char* V_lds = lds; LAS char* K_lds = lds + 2 * SHM_V;
    __syncthreads();
    float m_reg = -1e30f, l_reg = 0; f32x16 o[4] = {}; bf16x8 qr[8];
    const bf16* Qw = Qb + (size_t)(wid * 32 + r32) * DQK + hi * 8;
#pragma unroll
    for (int d0 = 0; d0 < 8; ++d0) qr[d0] = *reinterpret_cast<const bf16x8*>(Qw + d0 * 16);
    LAS char* ql = lds + 2 * SHM_V + 2 * SHM_K + 2048 + wid * 4096 + lane * 16;
#pragma unroll
    for (int d0 = 8; d0 < ND0; ++d0) {
        float x[8], y[8]; unpack8(*reinterpret_cast<const u32x4*>(Qw + d0 * 16), x);
        const float* t = rope + ((size_t)(pos0 + wid * 32 + r32 + 1) * 32 + (d0 - 8) * 8 + hi * 4) * 2; const f32x4 t0 = *(const f32x4*)t, t1 = *(const f32x4*)(t + 4);
        const float cs[4] = {t0[0], t0[2], t1[0], t1[2]}, sn[4] = {t0[1], t0[3], t1[1], t1[3]};
#pragma unroll
        for (int j = 0; j < 4; ++j) { y[2 * j] = x[2 * j] * cs[j] - x[2 * j + 1] * sn[j]; y[2 * j + 1] = x[2 * j] * sn[j] + x[2 * j + 1] * cs[j]; }
        *(LAS u32x4*)(ql + (d0 - 8) * 1024) = pack8(y); }
    const int sr = tid >> 4, sc = (tid & 15) * 8, vst0 = v_st(sr, sc), vst1 = v_st(32 + sr, sc);
    int kst[NKC];
#pragma unroll
    for (int c = 0; c < NKC; ++c) { const int id = tid + 512 * c, kr = id / CPR, kc = (id - kr * CPR) * 8; kst[c] = kr * KRB + ((kc * 2) ^ ((kr & 7) << 4)); }
    const int voff = tid * 16;
    int ko[4];
#pragma unroll
    for (int q = 0; q < 4; ++q) ko[q] = r32 * KRB + ((q * 32 + hi * 16) ^ ((r32 & 7) << 4));
    const __amdgpu_buffer_rsrc_t rK = __builtin_amdgcn_make_buffer_rsrc((void*)Kh, 0, LKP * KRB, 0x00020000);
    const __amdgpu_buffer_rsrc_t rV = __builtin_amdgcn_make_buffer_rsrc((void*)Vh, 0, LKP * 256, 0x00020000);
    const int vb0 = (int)(unsigned)(uintptr_t)V_lds + v_rd_base(lane);
    struct { bf16x8 vs0, vs1, ks[NKC]; } sr_[SD];
#define SLOAD(i, k0) do { sr_[i].vs0 = __builtin_bit_cast(bf16x8, __builtin_amdgcn_raw_buffer_load_b128(rV, voff, (k0) * 256, 0)); sr_[i].vs1 = __builtin_bit_cast(bf16x8, __builtin_amdgcn_raw_buffer_load_b128(rV, voff, (k0) * 256 + 8192, 0)); \
    _Pragma("unroll") for (int c_ = 0; c_ < NKC; ++c_) sr_[i].ks[c_] = __builtin_bit_cast(bf16x8, __builtin_amdgcn_raw_buffer_load_b128(rK, voff, (k0) * KRB + c_ * 8192, 0)); } while (0)
#define SWRITE(b, i) do { *(LAS bf16x8*)(V_lds + (b) * SHM_V + vst0) = sr_[i].vs0; *(LAS bf16x8*)(V_lds + (b) * SHM_V + vst1) = sr_[i].vs1; \
    _Pragma("unroll") for (int c_ = 0; c_ < NKC; ++c_) *(LAS bf16x8*)(K_lds + (b) * SHM_K + kst[c_]) = sr_[i].ks[c_]; } while (0)
#define SWAIT() do { if constexpr (SD == 2) { if constexpr (NKC == 2) asm volatile("s_waitcnt vmcnt(4)" ::: "memory"); else asm volatile("s_waitcnt vmcnt(5)" ::: "memory"); } \
    else asm volatile("s_waitcnt vmcnt(0)" ::: "memory"); } while (0)
#define RESC(a) do { if (__any((a) < 1.f)) { int t_ = threadIdx.x; asm volatile("" : "+v"(t_)); const int r32_ = t_ & 31, hi_2 = (t_ >> 5) & 1; \
    LAS float* al_ = (LAS float*)(lds + 2 * SHM_V + 2 * SHM_K) + (t_ >> 6) * 64 + 32; if (hi_2 == 0) al_[r32_] = (a); asm volatile("s_waitcnt lgkmcnt(0)" ::: "memory"); \
    _Pragma("unroll") for (int d = 0; d < 4; ++d) _Pragma("unroll") for (int r = 0; r < 16; ++r) o[d][r] *= al_[crow(r, hi_2)]; } } while (0)
    f32x16 pA0, pA1, pB0, pB1; float mnA, mnB, alA, alB; bf16x8 pa0, pa1, pa2, pa3;
    constexpr int SE = 0, SO = SD - 1;
    SLOAD(SE, 0); asm volatile("s_waitcnt vmcnt(0)" ::: "memory"); SWRITE(0, SE); __syncthreads();
    qkt<DQK>(pA0, pA1, K_lds, qr, ql, ko); partialSM<DQK>(pA0, pA1, m_reg, mnA, alA);
    SLOAD(SO, 64); if constexpr (SD == 2) { SLOAD(SE, 128); }
    SWAIT(); SWRITE(1, SO); __syncthreads();
#pragma unroll 1
    for (int j = 1; j + 2 < NT; j += 2) {
        SBAR(); qkt<DQK>(pB0, pB1, K_lds + SHM_K, qr, ql, ko);
        finishSM(pA0, pA1, alA, l_reg, pa0, pa1, pa2, pa3); SBAR();
        SLOAD(SO, (j + SD) * 64); SBAR();
        pv_d0(o, vb0, pa0, pa1, pa2, pa3); partialSM<DQK>(pB0, pB1, m_reg, mnB, alB);
        __syncthreads(); SWAIT(); SWRITE(0, SE);
        RESC(alB); __syncthreads();
        SBAR(); qkt<DQK>(pA0, pA1, K_lds, qr, ql, ko);
        finishSM(pB0, pB1, alB, l_reg, pa0, pa1, pa2, pa3); SBAR();
        SLOAD(SE, (j + 1 + SD) * 64); SBAR();
        pv_d0(o, vb0 + SHM_V, pa0, pa1, pa2, pa3); partialSM<DQK>(pA0, pA1, m_reg, mnA, alA);
        __syncthreads(); SWAIT(); SWRITE(1, SO);
        RESC(alA); __syncthreads();
    }
    SBAR(); qkt<DQK>(pB0, pB1, K_lds + SHM_K, qr, ql, ko);
    finishSM(pA0, pA1, alA, l_reg, pa0, pa1, pa2, pa3); SBAR();
    if constexpr (SD == 1) { SLOAD(SE, (NT - 1) * 64); } SBAR();
    pv_d0(o, vb0, pa0, pa1, pa2, pa3); partialSM<DQK>(pB0, pB1, m_reg, mnB, alB);
    __syncthreads(); asm volatile("s_waitcnt vmcnt(0)" ::: "memory"); SWRITE(0, SE);
    RESC(alB); __syncthreads();
    SBAR(); qkt<DQK>(pA0, pA1, K_lds, qr, ql, ko);
#pragma unroll
    for (int r = 8; r < 16; ++r) pA0[r] = -1e30f;
#pragma unroll
    for (int r = 0; r < 16; ++r) pA1[r] = -1e30f;
    finishSM(pB0, pB1, alB, l_reg, pa0, pa1, pa2, pa3); SBAR();
    pv_d0(o, vb0 + SHM_V, pa0, pa1, pa2, pa3); partialSM<DQK>(pA0, pA1, m_reg, mnA, alA);
    RESC(alA);
    finishSM(pA0, pA1, alA, l_reg, pa0, pa1, pa2, pa3); SBAR();
    pv_d0(o, vb0, pa0, pa1, pa2, pa3);
    { int t_ = threadIdx.x; asm volatile("" : "+v"(t_)); const int r32_ = t_ & 31, hi_2 = (t_ >> 5) & 1, wid_ = t_ >> 6;
      LAS float* li_ = (LAS float*)(lds + 2 * SHM_V + 2 * SHM_K) + wid_ * 64;
      if (hi_2 == 0) li_[r32_] = l_reg; asm volatile("s_waitcnt lgkmcnt(0)" ::: "memory");
      float rli[16];
#pragma unroll
      for (int r = 0; r < 16; ++r) rli[r] = __builtin_amdgcn_rcpf(li_[crow(r, hi_2)]);
      { float ss[16];
#pragma unroll
        for (int r = 0; r < 16; ++r) { float a = 0.f;
#pragma unroll
            for (int d0 = 0; d0 < 4; ++d0) { const float x = o[d0][r] * rli[r]; a += x * x; }
            a += __shfl_xor(a, 1); a += __shfl_xor(a, 2); a += __shfl_xor(a, 4); a += __shfl_xor(a, 8); a += __shfl_xor(a, 16); ss[r] = a; }
        float mine = ss[0];
#pragma unroll
        for (int r = 1; r < 16; ++r) mine = (r32_ == r) ? ss[r] : mine;
        if (r32_ < 16) ssq[(size_t)(wid_ * 32 + crow(r32_, hi_2)) * 8] = mine; }
      bf16* Ow = Ob + (size_t)(wid_ * 32) * DM;
#pragma unroll
      for (int r = 0; r < 16; ++r) { const int orow = crow(r, hi_2);
#pragma unroll
          for (int d0 = 0; d0 < 4; ++d0) Ow[(size_t)orow * DM + d0 * 32 + r32_] = (bf16)(cvtpk(o[d0][r] * rli[r], 0.f) & 0xffffu); } }
#undef SLOAD
#undef SWRITE
#undef SWAIT
#undef RESC
}

constexpr int NPHASE = 14;
struct Args { const float* in[24]; float* out; unsigned char* ws; int ph_lo, ph_hi; };
__global__ void __launch_bounds__(NWAVES * 64, 2) hymba_fwd(Args args) {
    extern __shared__ __attribute__((aligned(16))) unsigned char lds[];
    { int t0 = threadIdx.x; asm volatile("" : "+v"(t0)); for (int u = t0; u < 1024; u += NWAVES * 64) ((LAS unsigned*)((LAS unsigned char*)lds + LDSCTL_OFF))[u] = 0u; }
    __syncthreads();
#define XB_OBJ(b_) XcdBarrier b_; { const CAS unsigned char* kq_ = (const CAS unsigned char*)__builtin_amdgcn_kernarg_segment_ptr(); asm volatile("" : "+s"(kq_)); \
    b_.bar = (unsigned*)(*(unsigned char* const CAS*)(kq_ + 200) + WS_CTL) + CW_BAR; b_.x = xb_xcc_id(); b_.st = (volatile LAS unsigned*)((LAS unsigned char*)lds + LDSCTL_OFF) + 8; }
#if !MK_SPLIT
    { XB_OBJ(b0_); (void)xcd_barrier_post(b0_.bar, b0_.st); }
#define GRID_BAR() do { XB_OBJ(bb_); xcd_barrier(bb_); } while (0)
#else
#define GRID_BAR() do {} while (0)
#endif
    const int lo = args.ph_lo, hi_ = args.ph_hi;
#ifndef REP_MASK
#define REP_MASK 0
#endif
#define IN(k) (lo <= (k) && (k) < hi_)
#define REPS(k) (((REP_MASK >> (k)) & 1) ? 2 : 1)
#define SEAM(k) do { if (IN(k) && IN((k) + 1)) GRID_BAR(); } while (0)

#define PTRS \
    int bx = blockIdx.x; asm volatile("" : "+s"(bx)); const int G = gridDim.x, vcu = (G % 8 == 0) ? (bx % 8) * (G / 8) + bx / 8 : bx; \
    const int tid = threadIdx.x, lane = tid & 63, wave = __builtin_amdgcn_readfirstlane(tid >> 6); \
    const int gw = vcu * NWAVES + wave, ngw = G * NWAVES, gtid = vcu * (NWAVES * 64) + tid, ngt = G * NWAVES * 64; (void)gw; (void)ngw; (void)gtid; (void)ngt; (void)lane; \
    const CAS unsigned char* kp_ = (const CAS unsigned char*)__builtin_amdgcn_kernarg_segment_ptr(); asm volatile("" : "+s"(kp_)); \
    const float* const CAS* kin = (const float* const CAS*)kp_; unsigned char* ws = *(unsigned char* const CAS*)(kp_ + 200); float* outp = *(float* const CAS*)(kp_ + 192); (void)outp; (void)kin; \
    const float* x = kin[0]; const float* meta_tok = kin[1]; \
    float* rope = (float*)(ws + WS_ROPE); \
    bf16* w_in_t = (bf16*)(ws + WS_WIN); bf16* w_qb_t = (bf16*)(ws + WS_WQB); bf16* w_kvb_t = (bf16*)(ws + WS_WKVB); bf16* w_o_t = (bf16*)(ws + WS_WO); \
    bf16* w_r_t = (bf16*)(ws + WS_WR); unsigned char* w_gu8 = ws + WS_WGU; unsigned char* w_dn8 = ws + WS_WDN; unsigned char* h1f8 = ws + WS_H1F8; \
    bf16* h0 = (bf16*)(ws + WS_H0); bf16* h1 = (bf16*)(ws + WS_H1); float* rs_q = (float*)(ws + WS_QAN); float* rs_kv = rs_q + MPAD; float* ssq = (float*)(ws + WS_KVAN); bf16* z = (bf16*)(ws + WS_Z); \
    bf16* qm = (bf16*)(ws + WS_QM); bf16* km = (bf16*)(ws + WS_KM); bf16* vm = (bf16*)(ws + WS_VM); bf16* qg = (bf16*)(ws + WS_QG); bf16* kg = (bf16*)(ws + WS_KG); bf16* vg = (bf16*)(ws + WS_VG); \
    bf16* ob = (bf16*)(ws + WS_O); bf16* y1 = (bf16*)(ws + WS_Y1); float* logits = (float*)(ws + WS_LOGITS); \
    int* topk = (int*)(ws + WS_TOPK); float* gate = (float*)(ws + WS_GATE); int* pair_pos = (int*)(ws + WS_PAIRPOS); float* row_gate = (float*)(ws + WS_ROWGATE); \
    int* hist = (int*)(ws + WS_HIST); int* moetab = (int*)(ws + WS_MOETAB); int* tile_expert = moetab + 256; \
    int* row_tok = (int*)(ws + WS_XS); unsigned char* act8 = ws + WS_ACT; unsigned char* out2 = ws + WS_OUT2;


    for (int rep_ = 0; rep_ < (IN(0) ? REPS(0) : 0); ++rep_) { if (rep_) GRID_BAR(); PTRS;
        LAS float* scr = (LAS float*)((LAS unsigned char*)lds + wave * 16384);
        constexpr int I_IN = 16 * 46, I_QB = 4 * 24, I_KVB = 4 * 32, I_O = 16 * 32, I_R = 16;
        constexpr int NITEMS = I_IN + I_QB + I_KVB + I_O + I_R;
        for (int it = gw; it < NITEMS; it += ngw) {
            int r = it;
            if (r < I_IN) { transpose_item(kin[4], 1024, NIN, w_in_t, scr, r, lane, MapIn()); continue; } r -= I_IN;
            if (r < I_QB) { transpose_item(kin[6], 256, 768, w_qb_t, scr, r, lane, MapQ(), kin[5]); continue; } r -= I_QB;
            if (r < I_KVB) { transpose_item(kin[8], 128, 1024, w_kvb_t, scr, r, lane, MapId(), kin[7], 256); continue; } r -= I_KVB;
            if (r < I_O) { transpose_item(kin[13], 1024, 1024, w_o_t, scr, r, lane, MapId(), kin[11], 0, kin[12]); continue; } r -= I_O;
            transpose_item(kin[16], 1024, 32, w_r_t, scr, r, lane, MapId());
        }
        transpose_f8_stream(kin[18], 2048, w_gu8, scr, gw, ngw, lane, MapGU(), W8_SCALE);
        transpose_f8_stream(kin[20], 1024, w_dn8, scr, gw, ngw, lane, MapId(), W8_SCALE);
        { f32x4 gg[4], bb[4], cv[4], nv[4];
#pragma unroll
          for (int j = 0; j < 4; ++j) { gg[j] = ((const f32x4*)kin[2])[lane + 64 * j]; bb[j] = ((const f32x4*)kin[3])[lane + 64 * j]; }
#define LN_LOAD(dst, m_) do { const float* xr_ = (m_) < NTOK ? x + (size_t)(m_) * DM : meta_tok + (size_t)((m_) - NTOK) * DM; _Pragma("unroll") for (int j = 0; j < 4; ++j) dst[j] = ((const f32x4*)xr_)[lane + 64 * j]; } while (0)
          if (gw < MROWS) LN_LOAD(cv, gw);
          for (int m = gw; m < MROWS; m += ngw) { const int mn = m + ngw < MROWS ? m + ngw : m; LN_LOAD(nv, mn);
              ln_row_f32_to_bf16(cv, gg, bb, h0 + (size_t)m * DM, lane);
#pragma unroll
              for (int j = 0; j < 4; ++j) cv[j] = nv[j]; }
#undef LN_LOAD
        }
        zero_bytes(h0 + (size_t)MROWS * DM, (size_t)(MPAD - MROWS) * DM * 2, gtid, ngt);
        zero_bytes(w_in_t + (size_t)NIN * 1024, (size_t)(ZLD - NIN) * 1024 * 2, gtid, ngt);
        for (int i = gw; i < 64 + 64 + 32 + 32; i += ngw) {
            bf16* p; size_t rb;
            if (i < 64) { p = km + ((size_t)i * LKP + 2064) * 192; rb = 48 * 192 * 2; }
            else if (i < 128) { p = vm + ((size_t)(i - 64) * LKP + 2064) * 128; rb = 48 * 128 * 2; }
            else if (i < 160) { p = kg + ((size_t)(i - 128) * LKP + 2064) * 128; rb = 48 * 128 * 2; }
            else { p = vg + ((size_t)(i - 160) * LKP + 2064) * 128; rb = 48 * 128 * 2; }
            zero_bytes(p, rb, lane, 64);
        }
        for (int i = gtid; i < 2065 * 32; i += ngt) {
            const int p = i / 32 - 1, f = i & 31; double inv = 1.0;
            for (int q = 0; q < f; ++q) inv *= 0.74989420933245582730;
            const float ang = (float)p * (float)inv; float sn, cs; sincos_d(fabsf(ang), sn, cs); if (ang < 0.f) sn = -sn;
            rope[2 * i] = cs; rope[2 * i + 1] = sn;
        }
    }
    SEAM(0);
    for (int rep_ = 0; rep_ < (IN(1) ? REPS(1) : 0); ++rep_) { if (rep_) GRID_BAR(); PTRS; EpiZ E{z};
#if FAST_Z
        { pg8::Gemm g{h0, w_in_t, NTOK, ZLD, 1024, 1024, nullptr}; pg8::StaticOrder S; S.init(NTOK, ZLD, G, bx); pg8::EpiAdapt<EpiZ> EA{E, 0};
          pg8::gemm_phase<pg8::EpiAdapt<EpiZ>, pg8::StaticOrder, true, true>((LAS unsigned char*)lds, g, S, EA); }
        meta_gemm16<1024>(h0, 1024, w_in_t, NTOK, ZLD, E, gw, ngw, lane);
#else
        simple_gemm(h0, w_in_t, 1024, 0, NTOK + 64, ZLD, E, BSelNone(), gw, ngw, lane);
#endif
    }
    SEAM(1);
    for (int rep_ = 0; rep_ < (IN(2) ? REPS(2) : 0); ++rep_) { if (rep_) GRID_BAR(); PTRS;
#define P2_LOAD(m_, a_, b_, c_) do { const bf16* zr_ = z + (size_t)(m_) * ZLD; a_ = (u32x4){0u, 0u, 0u, 0u}; if (lane < 56) a_ = *(const u32x4*)(zr_ + 8 * lane); b_ = *(const u32x4*)(zr_ + 448 + 8 * lane); c_ = *(const u32x4*)(zr_ + 960 + 8 * lane); } while (0)
        u32x4 wa, wb, wc, na, nb, nc; if (gw < MROWS) P2_LOAD(gw, wa, wb, wc);
        for (int m = gw; m < MROWS; m += ngw) { const int mn = m + ngw < MROWS ? m + ngw : m; P2_LOAD(mn, na, nb, nc);
            p2a_row(m, wa, wb, wc, rope, kin[5], kin[7], kin[9], kin[10], rs_q, rs_kv, km, qg, kg, vg, lane); wa = na; wb = nb; wc = nc; }
#undef P2_LOAD
    }
    SEAM(2);
    for (int rep_ = 0; rep_ < (IN(3) ? REPS(3) : 0); ++rep_) { if (rep_) GRID_BAR(); PTRS;
        { EpiQ E{qm, rs_q}; pg8::Gemm g{z, w_qb_t, NTOK, 768, 256, ZLD, nullptr}; pg8::StaticOrder S; S.init(NTOK, 768, G, bx); pg8::EpiAdapt<EpiQ> EA{E, 0};
          pg8::gemm_phase<pg8::EpiAdapt<EpiQ>, pg8::StaticOrder, true, true>((LAS unsigned char*)lds, g, S, EA); }
        { EpiKV<false> E{km, vm, rs_kv}; pg8::Gemm g{z + 256, w_kvb_t, NTOK, 1024, 256, ZLD, nullptr}; pg8::StaticOrder S; S.init(NTOK, 1024, G, bx); pg8::EpiAdapt<EpiKV<false>> EA{E, 0};
          pg8::gemm_phase<pg8::EpiAdapt<EpiKV<false>>, pg8::StaticOrder, true, true>((LAS unsigned char*)lds, g, S, EA);
          EpiKV<true> EM{km, vm, rs_kv}; meta_gemm16<256>(z + 256, ZLD, w_kvb_t, NTOK, 1024, EM, gw, ngw, lane); }
    }
    SEAM(3);
    for (int rep_ = 0; rep_ < (IN(4) ? REPS(4) : 0); ++rep_) { if (rep_) GRID_BAR(); PTRS;
        for (int u = vcu; u < 1024; u += G) {
            if (u < 512) { const int b = u >> 5, h = (u >> 3) & 3, qb = u & 7, bh = b * 4 + h;
                attn_body<192, 1>(qm + ((size_t)bh * 2048 + qb * 256) * 192, km + (size_t)bh * LKP * 192, vm + (size_t)bh * LKP * 128, ob + ((size_t)b * 2048 + qb * 256) * DM + h * 128, (LAS char*)lds, rope, 16 + qb * 256, ssq + ((size_t)b * 2048 + qb * 256) * 8 + h);
            } else { const int v = u - 512, b = v >> 5, h = (v >> 3) & 3, qb = v & 7, bh = b * 4 + h, bk = b * 2 + (h >> 1);
                attn_body<128, 2>(qg + ((size_t)bh * 2048 + qb * 256) * 128, kg + (size_t)bk * LKP * 128, vg + (size_t)bk * LKP * 128, ob + ((size_t)b * 2048 + qb * 256) * DM + 512 + h * 128, (LAS char*)lds, rope, 0, ssq + ((size_t)b * 2048 + qb * 256) * 8 + 4 + h);
            }
        }
    }
    SEAM(4);
    for (int rep_ = 0; rep_ < (IN(6) ? REPS(6) : 0); ++rep_) { if (rep_) GRID_BAR(); PTRS;
        pg8::Gemm g{ob, w_o_t, NTOK, 1024, 1024, 1024, nullptr}; pg8::StaticOrder S; S.init(NTOK, 1024, G, bx);
        LAS f32x2* T = (LAS f32x2*)((LAS unsigned char*)lds + LDSCTL_OFF + 2048);
        for (int i = tid >> 8; i < 6; i += 2) { pg8::Unit u; if (!S.next(i, u)) break; const int rl = tid & 255; const float* q = ssq + (size_t)(u.pm * 256 + rl) * 8;
            const f32x4 a = *(const f32x4*)q, b = *(const f32x4*)(q + 4);
            const float rm = rsq(((a[0] + a[1]) + (a[2] + a[3])) * (1.f / 512) + RMS_EPS), rg = rsq(((b[0] + b[1]) + (b[2] + b[3])) * (1.f / 512) + RMS_EPS);
            T[i * 256 + rl] = (f32x2){rm / rg, rg}; }
        __syncthreads();
        EpiOF E{y1, h0, T}; HookO H{T};
        pg8::gemm_phase<EpiOF, pg8::StaticOrder, true, true, false, false, HookO>((LAS unsigned char*)lds, g, S, E, H);
    }
    SEAM(6);
#ifndef MOE_SKEW_TICKS
#define MOE_SKEW_TICKS 0
#endif
#define MOE_STAGGER(nunits) do { const int rem_ = (nunits) % G; if (MOE_SKEW_TICKS > 0 && rem_ != 0 && bx >= rem_) { const unsigned long long t0_ = __builtin_amdgcn_s_memrealtime(), w_ = (unsigned long long)(MOE_SKEW_TICKS * ((bx - rem_) % 3 + 1)); \
    while (__builtin_amdgcn_s_memrealtime() - t0_ < w_) __builtin_amdgcn_s_sleep(16); } } while (0)
#define ROUTE_VARS const int tpb = (NTOK + G - 1) / G, tok_lo = bx * tpb, tok_hi = (tok_lo + tpb < NTOK) ? tok_lo + tpb : NTOK; \
    LAS int* L_hist = (LAS int*)((LAS unsigned char*)lds + LDSCTL_OFF + 256); LAS int* L_n = L_hist + 32; LAS int* L_base = L_hist + 64; LAS int* L_off = L_hist + 96; (void)L_n; (void)L_base; (void)L_off;
    for (int rep_ = 0; rep_ < (IN(8) ? REPS(8) : 0); ++rep_) { if (rep_) GRID_BAR(); PTRS; ROUTE_VARS;
        constexpr int WRP = 2064;
        LAS unsigned char* L_wr = (LAS unsigned char*)lds;
        for (int i = tid; i < 32 * 128; i += NWAVES * 64) { const int r = i >> 7, c = i & 127; *(LAS u32x4*)(L_wr + r * WRP + c * 16) = *(const u32x4*)(w_r_t + (size_t)r * 1024 + c * 8); }
        if (tid < 32) L_hist[tid] = 0;
        zero_bytes(row_tok, (size_t)MOE_ROWS_MAX * 4, gtid, ngt);
        __syncthreads();
        const int fr = lane & 15, fq = lane >> 4;
        f32x4 G4[4], B4[4];
#pragma unroll
        for (int hf = 0; hf < 2; ++hf) { const int c = hf * 512 + 8 * lane; G4[2 * hf] = *(const f32x4*)(kin[14] + c); G4[2 * hf + 1] = *(const f32x4*)(kin[14] + c + 4); B4[2 * hf] = *(const f32x4*)(kin[15] + c); B4[2 * hf + 1] = *(const f32x4*)(kin[15] + c + 4); }
        for (int rb = tok_lo + wave * 16; rb < tok_hi; rb += NWAVES * 16) {
            for (int i = 0; i < 16 && rb + i < tok_hi; ++i) ln_row_bf16(y1 + (size_t)(rb + i) * DM, G4, B4, h1 + (size_t)(rb + i) * DM, h1f8 + (size_t)(rb + i) * DM, lane);
            asm volatile("s_waitcnt vmcnt(0)" ::: "memory");
            const int row = rb + fr < NTOK ? rb + fr : NTOK - 1;
            const bf16* ap = h1 + (size_t)row * DM + fq * 8;
            bf16x8 a[32];
#pragma unroll
            for (int ks = 0; ks < 32; ++ks) a[ks] = *(const bf16x8*)(ap + ks * 32);
            f32x4 acc0 = {0.f, 0.f, 0.f, 0.f}, acc1 = {0.f, 0.f, 0.f, 0.f};
            const LAS unsigned char* bp = L_wr + (8 * (fr >> 2) + (fr & 3)) * WRP + fq * 16;
#pragma unroll
            for (int ks = 0; ks < 32; ++ks) { const bf16x8 b0 = *(const LAS bf16x8*)(bp + ks * 64), b1 = *(const LAS bf16x8*)(bp + 4 * WRP + ks * 64);
                acc0 = __builtin_amdgcn_mfma_f32_16x16x32_bf16(b0, a[ks], acc0, 0, 0, 0); acc1 = __builtin_amdgcn_mfma_f32_16x16x32_bf16(b1, a[ks], acc1, 0, 0, 0); }
            const float* br = kin[17] + 8 * fq; const f32x4 bb0 = *(const f32x4*)br, bb1 = *(const f32x4*)(br + 4);
            float v[8] = {acc0[0] + bb0[0], acc0[1] + bb0[1], acc0[2] + bb0[2], acc0[3] + bb0[3], acc1[0] + bb1[0], acc1[1] + bb1[1], acc1[2] + bb1[2], acc1[3] + bb1[3]};
            float tv[4]; int ti[4];
#pragma unroll
            for (int r = 0; r < 4; ++r) { float bv = v[0]; int bi = 8 * fq;
#pragma unroll
                for (int j = 1; j < 8; ++j) if (v[j] > bv) { bv = v[j]; bi = 8 * fq + j; }
#pragma unroll
                for (int off = 16; off <= 32; off <<= 1) { const float ov = __shfl_xor(bv, off); const int oi = __shfl_xor(bi, off); if (ov > bv || (ov == bv && oi < bi)) { bv = ov; bi = oi; } }
                tv[r] = bv; ti[r] = bi;
#pragma unroll
                for (int j = 0; j < 8; ++j) if (bi == 8 * fq + j) v[j] = -INFINITY; }
            const float e1 = __expf(tv[1] - tv[0]), e2 = __expf(tv[2] - tv[0]), e3 = __expf(tv[3] - tv[0]), inv = 1.f / (1.f + e1 + e2 + e3);
            if (fq == 0 && rb + fr < tok_hi) { const int t = rb + fr; *(int4*)(topk + (size_t)t * 4) = make_int4(ti[0], ti[1], ti[2], ti[3]); *(f32x4*)(gate + (size_t)t * 4) = (f32x4){inv, e1 * inv, e2 * inv, e3 * inv};
                atomicAdd((int*)(L_hist + ti[0]), 1); atomicAdd((int*)(L_hist + ti[1]), 1); atomicAdd((int*)(L_hist + ti[2]), 1); atomicAdd((int*)(L_hist + ti[3]), 1); }
        }
        __syncthreads();
        if (tid < 32) hist[bx * 32 + tid] = L_hist[tid];
    }
    SEAM(8);
    for (int rep_ = 0; rep_ < (IN(10) ? REPS(10) : 0); ++rep_) { if (rep_) GRID_BAR(); PTRS; ROUTE_VARS;
        if (tid < 32) { int tot = 0, before = 0; for (int b = 0; b < G; ++b) { const int h = hist[b * 32 + tid]; tot += h; if (b < bx) before += h; } L_n[tid] = tot; L_base[tid] = before; L_hist[tid] = 0; }
        __syncthreads();
        if (tid == 0) { int off = 0; for (int e = 0; e < NE; ++e) { L_off[e] = off; off += (L_n[e] + 255) & ~255; } L_off[NE] = off; }
        __syncthreads();
        for (int p = tok_lo * 4 + tid; p < tok_hi * 4; p += NWAVES * 64) { const int e = topk[p]; const int r = atomicAdd((int*)(L_hist + e), 1); const int pos = L_off[e] + L_base[e] + r;
            row_gate[pos] = gate[p]; pair_pos[p] = pos; row_tok[pos] = p >> 2; }
        __syncthreads();
        if (bx == 0) { if (tid == 0) moetab[0] = L_off[NE];
            if (tid < 32) { moetab[64 + tid] = L_n[tid]; moetab[128 + tid] = L_off[tid]; for (int t = L_off[tid] >> 8; t < (L_off[tid + 1] >> 8); ++t) tile_expert[t] = tid; } }
        __syncthreads();
    }
    SEAM(10);
    for (int rep_ = 0; rep_ < (IN(11) ? REPS(11) : 0); ++rep_) { if (rep_) GRID_BAR(); PTRS; const int rows = moetab[0]; EpiGU8 E{act8, kin[19]};
        pg8::Gemm g{(const bf16*)h1f8, (const bf16*)w_gu8, rows, 2048, 512, 512, row_tok}; pg8::MoeOrder S; S.init(rows >> 8, 8, G, bx, tile_expert);
        MOE_STAGGER((rows >> 8) * 8);
        pg8::gemm_phase<EpiGU8, pg8::MoeOrder, true, true, true, true>((LAS unsigned char*)lds, g, S, E);
    }
    SEAM(11);
    for (int rep_ = 0; rep_ < (IN(12) ? REPS(12) : 0); ++rep_) { if (rep_) GRID_BAR(); PTRS; const int rows = moetab[0]; EpiDN8 E{out2, kin[21], row_gate};
        pg8::Gemm g{(const bf16*)act8, (const bf16*)w_dn8, rows, 1024, 512, 512, nullptr}; pg8::MoeOrder S; S.init(rows >> 8, 4, G, bx, tile_expert);
        MOE_STAGGER((rows >> 8) * 4);
        pg8::gemm_phase<EpiDN8, pg8::MoeOrder, true, true, true>((LAS unsigned char*)lds, g, S, E);
    }
    SEAM(12);
    for (int rep_ = 0; rep_ < (IN(13) ? REPS(13) : 0); ++rep_) { if (rep_) GRID_BAR(); PTRS;
        f32x4 G4[4], B4[4];
#pragma unroll
        for (int hf = 0; hf < 2; ++hf) { const int c = hf * 512 + 8 * lane; G4[2 * hf] = *(const f32x4*)(kin[22] + c); G4[2 * hf + 1] = *(const f32x4*)(kin[22] + c + 4); B4[2 * hf] = *(const f32x4*)(kin[23] + c); B4[2 * hf + 1] = *(const f32x4*)(kin[23] + c + 4); }
        int4 pp = gw < NTOK ? *(const int4*)(pair_pos + (size_t)gw * 4) : make_int4(0, 0, 0, 0);
        for (int t = gw; t < NTOK; t += ngw) {
            const int ps[4] = {pp.x, pp.y, pp.z, pp.w};
            u32x4 hv[2]; u32x2 ov[4][2];
#pragma unroll
            for (int hf = 0; hf < 2; ++hf) { hv[hf] = *(const u32x4*)(h1 + (size_t)t * DM + hf * 512 + 8 * lane);
#pragma unroll
                for (int s4 = 0; s4 < 4; ++s4) ov[s4][hf] = *(const u32x2*)(out2 + (size_t)ps[s4] * DM + hf * 512 + 8 * lane); }
            if (t + ngw < NTOK) pp = *(const int4*)(pair_pos + (size_t)(t + ngw) * 4);
            float v[16];
#pragma unroll
            for (int hf = 0; hf < 2; ++hf) { float f[8]; unpack8(hv[hf], f);
                float acc8[8] = {0.f, 0.f, 0.f, 0.f, 0.f, 0.f, 0.f, 0.f};
#pragma unroll
                for (int s4 = 0; s4 < 4; ++s4) {
#pragma unroll
                    for (int w = 0; w < 2; ++w) { const unsigned d = w ? ov[s4][hf].y : ov[s4][hf].x;
                        const f32x2 lo = __builtin_amdgcn_cvt_pk_f32_fp8((int)d, false), hi2 = __builtin_amdgcn_cvt_pk_f32_fp8((int)d, true);
                        acc8[4 * w + 0] += lo[0]; acc8[4 * w + 1] += lo[1]; acc8[4 * w + 2] += hi2[0]; acc8[4 * w + 3] += hi2[1]; } }
#pragma unroll
                for (int j = 0; j < 8; ++j) v[hf * 8 + j] = ALPHA * f[j] + O2_INV * acc8[j]; }
            float s = 0.f;
#pragma unroll
            for (int j = 0; j < 16; ++j) s += v[j];
            const float mean = wave_sum(s) * (1.f / DM); float s2 = 0.f;
#pragma unroll
            for (int j = 0; j < 16; ++j) { v[j] -= mean; s2 += v[j] * v[j]; }
            const float rstd = rsq(wave_sum(s2) * (1.f / DM) + LN_EPS);
#pragma unroll
            for (int hf = 0; hf < 2; ++hf) { float* o = outp + (size_t)t * DM + hf * 512 + 8 * lane;
                *(f32x4*)o = (f32x4){v[hf * 8 + 0], v[hf * 8 + 1], v[hf * 8 + 2], v[hf * 8 + 3]} * rstd * G4[2 * hf] + B4[2 * hf];
                *(f32x4*)(o + 4) = (f32x4){v[hf * 8 + 4], v[hf * 8 + 5], v[hf * 8 + 6], v[hf * 8 + 7]} * rstd * G4[2 * hf + 1] + B4[2 * hf + 1]; }
        }
    }
#undef IN
#undef SEAM
}

extern "C" void kernel_launch(void* const* d_in, const int* in_sizes, int n_in, void* d_out, int out_size, void* d_ws, size_t ws_size, hipStream_t stream) {
    static int grid = 0;
    if (grid == 0) {
        if (n_in != 24 || in_sizes[0] != NTOK * DM || out_size != NTOK * DM || ws_size < WS_END) { fprintf(stderr, "kernel_launch: shape/workspace mismatch (n_in %d, ws %zu)\n", n_in, ws_size); grid = -1; return; }
        int dev = 0, cus = 0, per_cu = 0;
        if (hipGetDevice(&dev) != hipSuccess || hipDeviceGetAttribute(&cus, hipDeviceAttributeMultiprocessorCount, dev) != hipSuccess) { grid = -1; return; }
        if (hipFuncSetAttribute((const void*)hymba_fwd, hipFuncAttributeMaxDynamicSharedMemorySize, LDS_BYTES) != hipSuccess) { fprintf(stderr, "kernel_launch: hipFuncSetAttribute failed\n"); grid = -1; return; }
        if (hipOccupancyMaxActiveBlocksPerMultiprocessor(&per_cu, (const void*)hymba_fwd, NWAVES * 64, LDS_BYTES) != hipSuccess || per_cu < 1) fprintf(stderr, "kernel_launch: occupancy query says %d\n", per_cu);
        (void)hipGetLastError();
        grid = cus;
    }
    if (grid < 0) return;
    (void)hipMemsetAsync((char*)d_ws + WS_CTL, 0, CTL_ZERO_BYTES, stream);
    Args a{};
    for (int i = 0; i < 24; ++i) a.in[i] = (const float*)d_in[i];
    a.out = (float*)d_out; a.ws = (unsigned char*)d_ws;
#if MK_SPLIT
    for (int p = 0; p < NPHASE; ++p) { a.ph_lo = p; a.ph_hi = p + 1; hipLaunchKernelGGL(hymba_fwd, dim3(grid), dim3(NWAVES * 64), LDS_BYTES, stream, a); }
#else
    a.ph_lo = 0; a.ph_hi = NPHASE; hipLaunchKernelGGL(hymba_fwd, dim3(grid), dim3(NWAVES * 64), LDS_BYTES, stream, a);
#endif
}
```

```cpp
#include <hip/hip_runtime.h>
#include <cstdio>
#include <cstdint>

#ifndef MK_SPLIT
#define MK_SPLIT 0
#endif

#define LAS __attribute__((address_space(3)))
#define CAS __attribute__((address_space(4)))
typedef unsigned short bf16;
typedef short bf16x8 __attribute__((ext_vector_type(8)));
typedef short s16x4 __attribute__((ext_vector_type(4)));
typedef float f32x2 __attribute__((ext_vector_type(2)));
typedef float f32x4 __attribute__((ext_vector_type(4)));
typedef float f32x16 __attribute__((ext_vector_type(16)));
typedef unsigned u32x2 __attribute__((ext_vector_type(2)));
typedef unsigned u32x4 __attribute__((ext_vector_type(4)));
typedef __bf16 bf16x2_t __attribute__((ext_vector_type(2)));

constexpr int NB = 16, SEQ = 2048, DM = 1024, NMETA = 16;
constexpr int NTOK = NB * SEQ;
constexpr int MROWS = NTOK + NMETA;
constexpr int MPAD = 33024;
constexpr int LKP = 2112;
constexpr int NIN = 1472, ZLD = 1536;
constexpr int NE = 32, NPAIR = NTOK * 4, MOE_TILES_MAX = 544, MOE_ROWS_MAX = MOE_TILES_MAX * 256;
constexpr float ALPHA = 1.189207115002721f;
constexpr float RMS_EPS = 1e-6f, LN_EPS = 1e-5f;

constexpr size_t MiB = 1u << 20;
constexpr size_t WS_CTL = 0, CTL_ZERO_BYTES = 1 * MiB;
constexpr size_t WS_ROPE = 1 * MiB;
constexpr size_t WS_WQB = 2 * MiB;
constexpr size_t WS_WKVB = 2 * MiB + 512 * 1024;
constexpr size_t WS_WR = 3 * MiB;
constexpr size_t WS_LOGITS = 4 * MiB;
constexpr size_t WS_TOPK = 8 * MiB;
constexpr size_t WS_GATE = 8 * MiB + 512 * 1024;
constexpr size_t WS_PAIRPOS = 9 * MiB;
constexpr size_t WS_ROWGATE = 9 * MiB + 512 * 1024;
constexpr size_t WS_HIST = 10 * MiB + 512 * 1024;
constexpr size_t WS_MOETAB = 10 * MiB + 768 * 1024;
constexpr size_t WS_WIN = 12 * MiB;
constexpr size_t WS_WO = 15 * MiB;
constexpr size_t WS_WGU = 32 * MiB;
constexpr size_t WS_WDN = 96 * MiB;
constexpr size_t WS_H1F8 = 128 * MiB;
constexpr size_t WS_H0 = 224 * MiB;
constexpr size_t WS_H1 = 289 * MiB;
constexpr size_t WS_QAN = 353 * MiB;
constexpr size_t WS_KVAN = 370 * MiB;
constexpr size_t WS_Z = 380 * MiB;
constexpr size_t WS_QM = 477 * MiB;
constexpr size_t WS_KM = 525 * MiB;
constexpr size_t WS_VM = 575 * MiB;
constexpr size_t WS_QG = 608 * MiB;
constexpr size_t WS_KG = 640 * MiB;
constexpr size_t WS_VG = 657 * MiB;
constexpr size_t WS_O = 674 * MiB;
constexpr size_t WS_Y1 = 738 * MiB;
constexpr size_t WS_XS = 380 * MiB;
constexpr size_t WS_ACT = 516 * MiB;
constexpr size_t WS_OUT2 = 652 * MiB;
constexpr size_t WS_END = 924 * MiB;
static_assert(WS_Z + (size_t)MPAD * ZLD * 2 <= WS_QM && WS_QM + (size_t)64 * 2048 * 192 * 2 <= WS_KM && WS_KM + (size_t)64 * LKP * 192 * 2 <= WS_VM && WS_VM + (size_t)64 * LKP * 128 * 2 <= WS_QG, "ws map 1");
static_assert(WS_QG + (size_t)64 * 2048 * 128 * 2 <= WS_KG && WS_KG + (size_t)32 * LKP * 128 * 2 <= WS_VG && WS_VG + (size_t)32 * LKP * 128 * 2 <= WS_O && WS_O + (size_t)NTOK * DM * 2 <= WS_Y1 && WS_Y1 + (size_t)NTOK * DM * 4 <= WS_END, "ws map 2");
static_assert(WS_XS + (size_t)MOE_ROWS_MAX * DM <= WS_ACT && WS_ACT + (size_t)MOE_ROWS_MAX * DM <= WS_OUT2 && WS_OUT2 + (size_t)MOE_ROWS_MAX * DM * 2 <= WS_END && WS_WGU + (size_t)NE * 2048 * 1024 <= WS_WDN && WS_WDN + (size_t)NE * 1024 * 1024 <= WS_H1F8 && WS_H1F8 + (size_t)NTOK * DM <= WS_H0, "ws map 3");
static_assert(WS_H0 + (size_t)MPAD * DM * 2 <= WS_H1 && WS_H1 + (size_t)NTOK * DM * 2 <= WS_QAN && WS_QAN + (size_t)MPAD * 256 * 2 <= WS_KVAN && WS_KVAN + (size_t)MPAD * 128 * 2 <= WS_Z, "ws map 4");
constexpr int CW_BAR = 4096;

constexpr int RING_BYTES = 131072;
constexpr int LDSCTL_OFF = RING_BYTES;
constexpr int LDS_BYTES = 147456;
constexpr int NWAVES = 8;

#define LDS_WAIT() asm volatile("s_waitcnt lgkmcnt(0)" ::: "memory")
#define SBAR() __builtin_amdgcn_sched_barrier(0)
__device__ __forceinline__ unsigned cvtpk(float lo, float hi) { f32x2 v = {lo, hi}; bf16x2_t b = __builtin_convertvector(v, bf16x2_t); return __builtin_bit_cast(unsigned, b); }
__device__ __forceinline__ u32x4 pack8(const float (&v)[8]) { u32x4 r = {cvtpk(v[0], v[1]), cvtpk(v[2], v[3]), cvtpk(v[4], v[5]), cvtpk(v[6], v[7])}; return r; }
__device__ __forceinline__ void unpack8(u32x4 w, float (&v)[8]) {
    v[0] = __uint_as_float(w.x << 16); v[1] = __uint_as_float(w.x & 0xffff0000u); v[2] = __uint_as_float(w.y << 16); v[3] = __uint_as_float(w.y & 0xffff0000u);
    v[4] = __uint_as_float(w.z << 16); v[5] = __uint_as_float(w.z & 0xffff0000u); v[6] = __uint_as_float(w.w << 16); v[7] = __uint_as_float(w.w & 0xffff0000u);
}
__device__ __forceinline__ float wave_sum(float v) {
#pragma unroll
    for (int o = 1; o < 64; o <<= 1) v += __shfl_xor(v, o);
    return v;
}
__device__ __forceinline__ float rsq(float x) { return __builtin_amdgcn_rsqf(x); }
typedef int v8i __attribute__((ext_vector_type(8)));
__device__ __forceinline__ unsigned pack4_f8(float a, float b, float c, float d) { int w = 0; w = __builtin_amdgcn_cvt_pk_fp8_f32(a, b, w, false); w = __builtin_amdgcn_cvt_pk_fp8_f32(c, d, w, true); return (unsigned)w; }
constexpr float W8_SCALE = 32.f, W8_INV = 1.f / 32.f;

#define XB_TMO      128
#define XB_XCNT(j)  (256  + 64 * (j))
#define XB_XSUB(j)  (1280 + 64 * (j))
#define XB_XGEN(j)  (2304 + 64 * (j))
#define XB_TOP      3328
#define XB_TOPGEN   3392
#define XCD_BAR_WORDS 3456
#define XB_SPIN_CAP (1u << 18)
__device__ __forceinline__ unsigned xb_ld(unsigned* p)              { return __hip_atomic_load(p, __ATOMIC_RELAXED, __HIP_MEMORY_SCOPE_AGENT); }
__device__ __forceinline__ unsigned xb_add(unsigned* p, unsigned v) { return __hip_atomic_fetch_add(p, v, __ATOMIC_RELAXED, __HIP_MEMORY_SCOPE_AGENT); }
__device__ __forceinline__ unsigned xb_xcc_id() { return (unsigned)__builtin_amdgcn_s_getreg((3 << 11) | 20) & 0xFu; }
#define XB_SPIN(cond, bar) do { unsigned _sp = 0; while (cond) { __builtin_amdgcn_s_sleep(1); \
    if ((++_sp & 255u) == 0u) { if (xb_ld(&(bar)[XB_TMO])) break; if (_sp > XB_SPIN_CAP) { atomicAdd(&(bar)[XB_TMO], 1u); break; } } } } while (0)
struct XcdBarrier { unsigned* bar; unsigned x; volatile LAS unsigned* st; };
__device__ __forceinline__ XcdBarrier xcd_barrier_post(unsigned* bar, volatile LAS unsigned* st) {
    XcdBarrier b; b.bar = bar; b.x = xb_xcc_id(); b.st = st;
    if (threadIdx.x == 0) (void)xb_add(&bar[XB_XCNT(b.x)], 1u);
    return b;
}
__device__ __forceinline__ void xcd_barrier_complete(unsigned* bar, unsigned x, unsigned& nloc, unsigned& nx) {
    const unsigned G = gridDim.x * gridDim.y * gridDim.z;
    unsigned sum, cnt, mine, sp = 0u;
    for (;;) {
        sum = 0u; cnt = 0u; mine = 0u;
#pragma unroll
        for (unsigned j = 0; j < 16; ++j) { const unsigned c = xb_ld(&bar[XB_XCNT(j)]); sum += c; cnt += (c > 0u) ? 1u : 0u; mine = (j == x) ? c : mine; }
        if (sum == G) break;
        __builtin_amdgcn_s_sleep(1);
        if ((++sp & 255u) == 0u) { if (xb_ld(&bar[XB_TMO])) break; if (sp > XB_SPIN_CAP) { atomicAdd(&bar[XB_TMO], 1u); break; } }
    }
    nloc = mine > 0u ? mine : 1u; nx = cnt > 0u ? cnt : 1u;
}
__device__ __forceinline__ void xcd_barrier(const XcdBarrier& b) {
    asm volatile("s_waitcnt vmcnt(0)" ::: "memory");
    __syncthreads();
    if (threadIdx.x == 0) {
        unsigned* bar = b.bar;
        __builtin_amdgcn_s_waitcnt(0);
        unsigned nloc = b.st[0], nx = b.st[1];
        if (nloc == 0u) { xcd_barrier_complete(bar, b.x, nloc, nx); b.st[0] = nloc; b.st[1] = nx; }
        const unsigned old = xb_add(&bar[XB_XSUB(b.x)], 1u);
        const unsigned gen = old / nloc;
        if (old + 1u == (gen + 1u) * nloc) {
            __builtin_amdgcn_fence(__ATOMIC_RELEASE, "agent");
            asm volatile("s_waitcnt vmcnt(0)" ::: "memory");
            const unsigned og = xb_add(&bar[XB_TOP], 1u);
            const unsigned tg = og / nx;
            if (og + 1u == (tg + 1u) * nx) xb_add(&bar[XB_TOPGEN], 1u);
            else XB_SPIN(xb_ld(&bar[XB_TOPGEN]) == tg, bar);
            __builtin_amdgcn_fence(__ATOMIC_ACQUIRE, "agent");
            xb_add(&bar[XB_XGEN(b.x)], 1u);
            asm volatile("s_waitcnt vmcnt(0)" ::: "memory");
        } else {
            XB_SPIN(xb_ld(&bar[XB_XGEN(b.x)]) == gen, bar);
            __builtin_amdgcn_fence(__ATOMIC_ACQUIRE, "agent");
            asm volatile("s_waitcnt vmcnt(0)" ::: "memory");
        }
    }
    __syncthreads();
}

struct BSelNone { __device__ __forceinline__ size_t operator()(int) const { return 0; } };
struct BSelExpert { const int* tile_expert; size_t per; __device__ __forceinline__ size_t operator()(int m0) const { return (size_t)tile_expert[m0 >> 8] * per; } };
template <class Epi, class BSel>
__device__ __forceinline__ void simple_gemm(const bf16* __restrict__ A, const bf16* __restrict__ Bt, int K, int m_lo, int m_hi, int N, const Epi& E, const BSel& bsel, int gw, int ngw, int lane, int lda = 0) {
    if (lda == 0) lda = K;
    const int fr = lane & 15, fq = lane >> 4;
    const int mt = (m_hi - m_lo) / 64, nt = N / 32;
    for (int u = gw; u < mt * nt; u += ngw) {
        const int m0 = m_lo + (u / nt) * 64, n0 = (u % nt) * 32;
        const bf16* ap = A + (size_t)(m0 + fr) * lda + fq * 8;
        const bf16* bp = Bt + bsel(m0) + (size_t)(n0 + 8 * (fr >> 2) + (fr & 3)) * K + fq * 8;
        f32x4 acc[4][2];
#pragma unroll
        for (int i = 0; i < 4; ++i) { acc[i][0] = (f32x4){0.f, 0.f, 0.f, 0.f}; acc[i][1] = (f32x4){0.f, 0.f, 0.f, 0.f}; }
#pragma unroll 2
        for (int k = 0; k < K; k += 32) {
            bf16x8 a[4], b[2];
#pragma unroll
            for (int i = 0; i < 4; ++i) a[i] = *(const bf16x8*)(ap + (size_t)i * 16 * lda + k);
#pragma unroll
            for (int j = 0; j < 2; ++j) b[j] = *(const bf16x8*)(bp + (size_t)j * 4 * K + k);
#pragma unroll
            for (int i = 0; i < 4; ++i)
#pragma unroll
                for (int j = 0; j < 2; ++j) acc[i][j] = __builtin_amdgcn_mfma_f32_16x16x32_bf16(b[j], a[i], acc[i][j], 0, 0, 0);
        }
#pragma unroll
        for (int i = 0; i < 4; ++i) {
            const float v[8] = {acc[i][0][0], acc[i][0][1], acc[i][0][2], acc[i][0][3], acc[i][1][0], acc[i][1][1], acc[i][1][2], acc[i][1][3]};
            E.store8(m0 + 16 * i + fr, n0 + 8 * fq, v);
        }
    }
}


template <int K, class Epi>
__device__ __forceinline__ void smallk_task(const bf16* __restrict__ A, const bf16* __restrict__ Bt, int m0, int ng_lo, int ng_hi, const Epi& E, int lane) {
    constexpr int KS = K / 32;
    const int fr = lane & 15, fq = lane >> 4;
    bf16x8 a[4][KS];
#pragma unroll
    for (int i = 0; i < 4; ++i)
#pragma unroll
        for (int ks = 0; ks < KS; ++ks) a[i][ks] = *(const bf16x8*)(A + (size_t)(m0 + 16 * i + fr) * K + ks * 32 + fq * 8);
#pragma unroll 1
    for (int ng = ng_lo; ng < ng_hi; ++ng) {
        const int n0 = ng * 32;
        const bf16* bp = Bt + (size_t)(n0 + 8 * (fr >> 2) + (fr & 3)) * K + fq * 8;
        bf16x8 b[2][KS];
#pragma unroll
        for (int ks = 0; ks < KS; ++ks) { b[0][ks] = *(const bf16x8*)(bp + ks * 32); b[1][ks] = *(const bf16x8*)(bp + 4 * K + ks * 32); }
        f32x4 acc[4][2];
#pragma unroll
        for (int i = 0; i < 4; ++i) { acc[i][0] = (f32x4){0.f, 0.f, 0.f, 0.f}; acc[i][1] = (f32x4){0.f, 0.f, 0.f, 0.f}; }
#pragma unroll
        for (int ks = 0; ks < KS; ++ks)
#pragma unroll
            for (int i = 0; i < 4; ++i) { acc[i][0] = __builtin_amdgcn_mfma_f32_16x16x32_bf16(b[0][ks], a[i][ks], acc[i][0], 0, 0, 0); acc[i][1] = __builtin_amdgcn_mfma_f32_16x16x32_bf16(b[1][ks], a[i][ks], acc[i][1], 0, 0, 0); }
#pragma unroll
        for (int i = 0; i < 4; ++i) {
            const float v[8] = {acc[i][0][0], acc[i][0][1], acc[i][0][2], acc[i][0][3], acc[i][1][0], acc[i][1][1], acc[i][1][2], acc[i][1][3]};
            E.store8(m0 + 16 * i + fr, n0 + 8 * fq, v);
        }
    }
}


template <int K, class Epi>
__device__ __forceinline__ void meta_gemm16(const bf16* __restrict__ A, int lda, const bf16* __restrict__ Bt, int m0, int N, const Epi& E, int gw, int ngw, int lane) {
    const int fr = lane & 15, fq = lane >> 4;
    for (int ng = gw; ng < N / 32; ng += ngw) {
        const int n0 = ng * 32;
        const bf16* ap = A + (size_t)(m0 + fr) * lda + fq * 8;
        const bf16* bp = Bt + (size_t)(n0 + 8 * (fr >> 2) + (fr & 3)) * K + fq * 8;
        f32x4 acc0 = {0.f, 0.f, 0.f, 0.f}, acc1 = {0.f, 0.f, 0.f, 0.f};
#pragma unroll 8
        for (int k = 0; k < K; k += 32) { const bf16x8 a = *(const bf16x8*)(ap + k), b0 = *(const bf16x8*)(bp + k), b1 = *(const bf16x8*)(bp + 4 * K + k);
            acc0 = __builtin_amdgcn_mfma_f32_16x16x32_bf16(b0, a, acc0, 0, 0, 0); acc1 = __builtin_amdgcn_mfma_f32_16x16x32_bf16(b1, a, acc1, 0, 0, 0); }
        const float v[8] = {acc0[0], acc0[1], acc0[2], acc0[3], acc1[0], acc1[1], acc1[2], acc1[3]};
        E.store8(m0 + fr, n0 + 8 * fq, v);
    }
}

struct EpiZ { bf16* z;
    __device__ __forceinline__ void store8(int row, int col, const float (&v)[8]) const { if (col < NIN) *(u32x4*)(z + (size_t)row * ZLD + col) = pack8(v); } };
struct EpiQ { bf16* qm; const float* rs;
    __device__ __forceinline__ void store8(int row, int col, const float (&v_)[8]) const {
        const int h = col / 192, w = col - h * 192, b = row >> 11, s = row & 2047; const float r_ = rs[row];
        const float o[8] = {v_[0] * r_, v_[1] * r_, v_[2] * r_, v_[3] * r_, v_[4] * r_, v_[5] * r_, v_[6] * r_, v_[7] * r_};
        *(u32x4*)(qm + ((size_t)(b * 4 + h) * 2048 + s) * 192 + w) = pack8(o);
    } };
template <bool META> struct EpiKV { bf16* km; bf16* vm; const float* rs;
    __device__ __forceinline__ void store8(int row, int col, const float (&v_)[8]) const {
        if (META && row >= MROWS) return;
        const float r_ = rs[row]; const float v[8] = {v_[0] * r_, v_[1] * r_, v_[2] * r_, v_[3] * r_, v_[4] * r_, v_[5] * r_, v_[6] * r_, v_[7] * r_};
        const int h = col >> 8, w = col & 255; const u32x4 pk = pack8(v);
        if (!META) { const int b = row >> 11, key = row & 2047; const size_t r = (size_t)(b * 4 + h) * LKP + key;
            if (w < 128) *(u32x4*)(km + r * 192 + w) = pk; else *(u32x4*)(vm + r * 128 + (w - 128)) = pk;
        } else { const int key = 2048 + (row - NTOK);
            for (int b = 0; b < NB; ++b) { const size_t r = (size_t)(b * 4 + h) * LKP + key;
                if (w < 128) *(u32x4*)(km + r * 192 + w) = pk; else *(u32x4*)(vm + r * 128 + (w - 128)) = pk; } }
    } };
struct EpiO { bf16* y1; const bf16* h0;
    __device__ __forceinline__ void store8(int row, int col, const float (&v)[8]) const {
        float h[8]; unpack8(*(const u32x4*)(h0 + (size_t)row * DM + col), h);
        const float o[8] = {ALPHA * h[0] + v[0], ALPHA * h[1] + v[1], ALPHA * h[2] + v[2], ALPHA * h[3] + v[3], ALPHA * h[4] + v[4], ALPHA * h[5] + v[5], ALPHA * h[6] + v[6], ALPHA * h[7] + v[7]};
        *(u32x4*)(y1 + (size_t)row * DM + col) = pack8(o);
    } };
struct EpiLogit { float* logits; const float* bias;
    __device__ __forceinline__ void store8(int row, int col, const float (&v)[8]) const {
        float* y = logits + (size_t)row * NE + col;
        *(f32x4*)y = (f32x4){v[0] + bias[col], v[1] + bias[col + 1], v[2] + bias[col + 2], v[3] + bias[col + 3]};
        *(f32x4*)(y + 4) = (f32x4){v[4] + bias[col + 4], v[5] + bias[col + 5], v[6] + bias[col + 6], v[7] + bias[col + 7]};
    } };
namespace pg8 {
#define PG8_LAS __attribute__((address_space(3)))
typedef unsigned short bf16_t;
constexpr int BM = 256, BK = 64, HALF = 128, HTB = HALF * BK * 2, STAGE_BYTES = 8 * HTB, NXCD = 8, WGM = 8;
__host__ __device__ __forceinline__ int lds_byte(int r, int c) { const int st = (r >> 4) * 2 + (c >> 5), rr = r & 15, cc = c & 31, ob = rr * 64 + cc * 2; return st * 1024 + (ob ^ (((ob >> 9) & 1) << 5)); }
__host__ __device__ __forceinline__ void stage_rc(int b, int& R, int& C) { const int st = b / 1024, sb = b % 1024, swz = sb ^ (((sb >> 9) & 1) << 5); R = (st >> 1) * 16 + swz / 64; C = (st & 1) * 32 + (swz % 64) / 2; }
__host__ __device__ __forceinline__ int perm32(int rho) { const int n = rho >> 4, i = rho & 15; return 8 * (i >> 2) + 4 * n + (i & 3); }
struct Unit { int pm, pn, ui; };
struct Gemm { const bf16_t* A; const bf16_t* Bt; int M, N, K, lda; const int* row_tok; };
struct StaticOrder {
    int nM, nN, nwg, G, c;
    __host__ __device__ void init(int M, int N, int G_, int c_) { nM = M / BM; nN = N / BM; nwg = nM * nN; G = G_; c = c_; }
    __host__ __device__ bool next(int i, Unit& u) const {
        const long L = (long)i * G + c; if (L >= nwg) return false;
        int wgid = (int)L; { const int q = nwg / NXCD, r = nwg % NXCD, xcd = wgid % NXCD, off = wgid / NXCD; wgid = (xcd < r ? xcd * (q + 1) : r * (q + 1) + (xcd - r) * q) + off; }
        const int nig = WGM * nN, gid = wgid / nig, fm = gid * WGM, gsz = (nM - fm) < WGM ? (nM - fm) : WGM;
        u.pm = fm + ((wgid % nig) % gsz); u.pn = (wgid % nig) / gsz; u.ui = i; return true;
    }
    __device__ __forceinline__ void a_ready(const Unit&) const {}
    __device__ __forceinline__ void done(const Unit&) const {}
};
struct MoeOrder {
    StaticOrder so; const PG8_LAS int* tile_expert;
    __device__ void init(int tiles, int nN, int G_, int c_, const PG8_LAS int* te) { so.nM = tiles; so.nN = nN; so.nwg = tiles * nN; so.G = G_; so.c = c_; tile_expert = te; }
    __device__ bool next(int i, Unit& u) const { if (!so.next(i, u)) return false; u.pn += tile_expert[u.pm] * so.nN; return true; }
    __device__ __forceinline__ void a_ready(const Unit&) const {}
    __device__ __forceinline__ void done(const Unit&) const {}
};
template <class E8> struct EpiAdapt {
    static constexpr bool PERM = true, AFTER_DRAIN = false;
    E8 e; int ncols_mod;
    __device__ __forceinline__ void operator()(const f32x4 (&acc)[2][2][4][2], const Unit& u, int wr, int wc, int fr, int fq) const {
        const int row0 = u.pm * BM + wr * 64 + fr; int colt = u.pn * BM; if (ncols_mod) colt %= ncols_mod;
        const int col0 = colt + wc * 32 + 8 * fq;
#pragma unroll
        for (int ai = 0; ai < 2; ++ai)
#pragma unroll
            for (int m = 0; m < 4; ++m)
#pragma unroll
                for (int bj = 0; bj < 2; ++bj) {
                    const float v[8] = {acc[ai][bj][m][0][0], acc[ai][bj][m][0][1], acc[ai][bj][m][0][2], acc[ai][bj][m][0][3], acc[ai][bj][m][1][0], acc[ai][bj][m][1][1], acc[ai][bj][m][1][2], acc[ai][bj][m][1][3]};
                    e.store8(row0 + ai * HALF + m * 16, col0 + bj * HALF, v); }
    }
};
struct NoHook { static constexpr bool ON = false; __device__ __forceinline__ void mid(f32x4 (&)[2][2][4][2], const Unit&, int, int) const {} };
template <class Epi, class Sched, bool ALIGN_EPI = false, bool SP2 = false, bool F8 = false, bool GATHER = false, class Hook = NoHook>
__device__ __forceinline__ void gemm_phase(PG8_LAS unsigned char* lds, const Gemm g, const Sched& S, const Epi& E, const Hook& H = Hook()) {
    const int tid = threadIdx.x, wid = __builtin_amdgcn_readfirstlane(tid >> 6), lane = tid & 63, wr = wid >> 2, wc = wid & 3, fr = lane & 15, fq = lane >> 4;
    const int K = g.K, nt = K / BK;
    unsigned voffA[2], voffB[2];
#pragma unroll
    for (int i = 0; i < 2; ++i) { int R, C; stage_rc(tid * 16 + i * 8192, R, C); const int Rb = Epi::PERM ? ((R & ~31) + perm32(R & 31)) : R;
        voffA[i] = (unsigned)(R * g.lda + C) * 2u; voffB[i] = (unsigned)(Rb * K + C) * 2u; }
    int gR[2]; unsigned gC[2];
#pragma unroll
    for (int i = 0; i < 2; ++i) { int R, C; stage_rc(tid * 16 + i * 8192, R, C); gR[i] = R; gC[i] = (unsigned)C * 2u; }
    const unsigned lda2 = (unsigned)g.lda * 2u;
    unsigned vC[2][2], vN[2][2]; int tkn[2][2];
    static_assert(!GATHER || SP2, "GATHER is written for the SP2 loop");
#define PG8_TOKLD(dst, pm_) do { _Pragma("unroll") for (int h_ = 0; h_ < 2; ++h_) _Pragma("unroll") for (int i_ = 0; i_ < 2; ++i_) dst[h_][i_] = g.row_tok[(pm_) * 256 + h_ * 128 + gR[i_]]; } while (0)
#define PG8_TOKOFF(dst, src) do { _Pragma("unroll") for (int h_ = 0; h_ < 2; ++h_) _Pragma("unroll") for (int i_ = 0; i_ < 2; ++i_) dst[h_][i_] = (unsigned)src[h_][i_] * lda2 + gC[i_]; } while (0)
    const size_t kstep = (size_t)(BK * 2);
    const size_t hstep = (size_t)HALF * K * 2, hstepA = (size_t)HALF * g.lda * 2;
    const size_t tstep = 2 * hstep, tstepA = 2 * hstepA;
    const unsigned ldsw = (unsigned)wid * 1024u;
    const int aoff = lds_byte(wr * 64 + fr, fq * 8), boff = lds_byte(wc * 32 + fr, fq * 8);
#define PG8_SA(b, h) (((b) * 2 + (h)) * HTB)
#define PG8_SB(b, h) ((4 + (b) * 2 + (h)) * HTB)
#define PG8_STAGE(bufoff, gbase, voff) do { _Pragma("unroll") for (int _i = 0; _i < 2; ++_i) \
        __builtin_amdgcn_global_load_lds((const unsigned*)((const char*)(gbase) + (voff)[_i]), (PG8_LAS unsigned*)(lds + (bufoff) + ldsw + _i * 8192), 16, 0, 0); } while (0)
#define PG8_LDA(dst, b, h) do { _Pragma("unroll") for (int m = 0; m < 4; ++m) _Pragma("unroll") for (int k = 0; k < 2; ++k) dst[m][k] = *(const PG8_LAS bf16x8*)(lds + PG8_SA(b, h) + aoff + m * 2048 + k * 1024); } while (0)
#define PG8_LDB(dst, b, h) do { _Pragma("unroll") for (int n = 0; n < 2; ++n) _Pragma("unroll") for (int k = 0; k < 2; ++k) dst[n][k] = *(const PG8_LAS bf16x8*)(lds + PG8_SB(b, h) + boff + n * 2048 + k * 1024); } while (0)
#define PG8_F8CAT(x) __builtin_shufflevector(__builtin_bit_cast(u32x4, (x)[0]), __builtin_bit_cast(u32x4, (x)[1]), 0, 1, 2, 3, 4, 5, 6, 7)
#define PG8_MMA(ai, bj, At, Bt) do { __builtin_amdgcn_s_setprio(1); if constexpr (F8) { _Pragma("unroll") for (int m = 0; m < 4; ++m) _Pragma("unroll") for (int n = 0; n < 2; ++n) \
        acc[ai][bj][m][n] = __builtin_amdgcn_mfma_scale_f32_16x16x128_f8f6f4(__builtin_bit_cast(v8i, PG8_F8CAT(Bt[n])), __builtin_bit_cast(v8i, PG8_F8CAT(At[m])), acc[ai][bj][m][n], 0, 0, 0, 0x7f7f7f7f, 0, 0x7f7f7f7f); \
        _Pragma("unroll") for (int m = 0; m < 4; ++m) _Pragma("unroll") for (int n = 0; n < 2; ++n) asm volatile("" : "+v"(acc[ai][bj][m][n])); } \
    else { _Pragma("unroll") for (int m = 0; m < 4; ++m) _Pragma("unroll") for (int n = 0; n < 2; ++n) _Pragma("unroll") for (int k = 0; k < 2; ++k) \
        acc[ai][bj][m][n] = __builtin_amdgcn_mfma_f32_16x16x32_bf16(Bt[n][k], At[m][k], acc[ai][bj][m][n], 0, 0, 0); } __builtin_amdgcn_s_setprio(0); } while (0)
#define PG8_WAIT_V(n) asm volatile("s_waitcnt vmcnt(" #n ")" ::: "memory")
#define PG8_WAIT_L(n) asm volatile("s_waitcnt lgkmcnt(" #n ")" ::: "memory")
#define PG8_BAR __builtin_amdgcn_s_barrier()
#define PG8_SCHED __builtin_amdgcn_sched_barrier(0)
    Unit cur, nxt; int ui = 0;
    if (!S.next(0, cur)) return;
    f32x4 acc[2][2][4][2];
#pragma unroll
    for (int a = 0; a < 2; ++a)
#pragma unroll
        for (int b = 0; b < 2; ++b)
#pragma unroll
            for (int m = 0; m < 4; ++m)
#pragma unroll
                for (int n = 0; n < 2; ++n) acc[a][b][m][n] = (f32x4){0.f, 0.f, 0.f, 0.f};
    bf16x8 At[4][2], B0[2][2], B1[2][2];
    const char* const gA = (const char*)g.A;
    const char* cA = (const char*)g.A + (size_t)cur.pm * tstepA; const char* cB = (const char*)g.Bt + (size_t)cur.pn * tstep;
    S.a_ready(cur);
    if constexpr (SP2) {
        if constexpr (GATHER) { PG8_TOKLD(tkn, cur.pm); PG8_TOKOFF(vC, tkn); Unit u1_; if (S.next(1, u1_)) { PG8_TOKLD(tkn, u1_.pm); PG8_TOKOFF(vN, tkn); } else { PG8_TOKOFF(vN, tkn); } }
        PG8_STAGE(PG8_SB(0, 0), cB, voffB); PG8_STAGE(PG8_SB(0, 1), cB + hstep, voffB);
        if constexpr (GATHER) { PG8_STAGE(PG8_SA(0, 0), gA, vC[0]); PG8_STAGE(PG8_SA(0, 1), gA, vC[1]); } else { PG8_STAGE(PG8_SA(0, 0), cA, voffA); PG8_STAGE(PG8_SA(0, 1), cA + hstepA, voffA); }
        if (wr == 1) PG8_BAR;
        PG8_WAIT_V(2); PG8_BAR;
        PG8_STAGE(PG8_SB(1, 0), cB + kstep, voffB); if constexpr (GATHER) { PG8_STAGE(PG8_SA(1, 0), gA + kstep, vC[0]); } else { PG8_STAGE(PG8_SA(1, 0), cA + kstep, voffA); } PG8_STAGE(PG8_SB(1, 1), cB + hstep + kstep, voffB);
        PG8_WAIT_V(6); PG8_BAR;
    } else {
        PG8_STAGE(PG8_SB(0, 0), cB, voffB); PG8_STAGE(PG8_SA(0, 0), cA, voffA); PG8_STAGE(PG8_SB(0, 1), cB + hstep, voffB); PG8_STAGE(PG8_SA(0, 1), cA + hstepA, voffA);
        if (wr == 1) PG8_BAR;
        PG8_WAIT_V(4); PG8_BAR;
        PG8_STAGE(PG8_SB(1, 0), cB + kstep, voffB); PG8_STAGE(PG8_SA(1, 0), cA + kstep, voffA); PG8_STAGE(PG8_SB(1, 1), cB + hstep + kstep, voffB);
        PG8_WAIT_V(6); PG8_BAR;
    }
    for (;;) {
        const bool has_next = S.next(ui + 1, nxt);
        const char* nA = has_next ? (const char*)g.A + (size_t)nxt.pm * tstepA : cA; const char* nB = has_next ? (const char*)g.Bt + (size_t)nxt.pn * tstep : cB;
        for (int t = 0; t < nt; t += 2) {
            const bool last = (t == nt - 2);
            const char* a1 = cA + (size_t)(t + 1) * kstep;
            const char* a2 = last ? nA : cA + (size_t)(t + 2) * kstep; const char* b2 = last ? nB : cB + (size_t)(t + 2) * kstep;
            const char* a3 = a2 + kstep; const char* b3 = b2 + kstep;
            if (last && has_next) S.a_ready(nxt);
            if constexpr (Hook::ON) { if (t == nt / 2) H.mid(acc, cur, wr, fr); }
            if constexpr (SP2) {
            const char* ga1 = gA + (size_t)(t + 1) * kstep; const char* ga2 = gA + (last ? (size_t)0 : (size_t)(t + 2) * kstep); const char* ga3 = ga2 + kstep;
            unsigned v2[2][2];
            if constexpr (GATHER) { _Pragma("unroll") for (int h_ = 0; h_ < 2; ++h_) _Pragma("unroll") for (int i_ = 0; i_ < 2; ++i_) v2[h_][i_] = last ? vN[h_][i_] : vC[h_][i_]; }
            PG8_LDB(B0, 0, 0); PG8_LDB(B1, 0, 1); PG8_SCHED; PG8_LDA(At, 0, 0); if constexpr (GATHER) { PG8_STAGE(PG8_SA(1, 1), ga1, vC[1]); } else { PG8_STAGE(PG8_SA(1, 1), a1 + hstepA, voffA); }
            PG8_WAIT_V(8); PG8_WAIT_L(0); PG8_BAR; PG8_MMA(0, 0, At, B0); PG8_MMA(0, 1, At, B1); PG8_BAR; PG8_SCHED;
            PG8_LDA(At, 0, 1); PG8_STAGE(PG8_SB(0, 0), b2, voffB); PG8_STAGE(PG8_SB(0, 1), b2 + hstep, voffB); if constexpr (GATHER) { PG8_STAGE(PG8_SA(0, 0), ga2, v2[0]); } else { PG8_STAGE(PG8_SA(0, 0), a2, voffA); }
            PG8_WAIT_V(8); PG8_WAIT_L(0); PG8_BAR; PG8_MMA(1, 0, At, B0); PG8_MMA(1, 1, At, B1); PG8_BAR; PG8_SCHED;
            PG8_LDB(B0, 1, 0); PG8_LDB(B1, 1, 1); PG8_SCHED; PG8_LDA(At, 1, 0); if constexpr (GATHER) { PG8_STAGE(PG8_SA(0, 1), ga2, v2[1]); } else { PG8_STAGE(PG8_SA(0, 1), a2 + hstepA, voffA); }
            PG8_WAIT_V(8); PG8_WAIT_L(0); PG8_BAR; PG8_MMA(0, 0, At, B0); PG8_MMA(0, 1, At, B1); PG8_BAR; PG8_SCHED;
            PG8_LDA(At, 1, 1); PG8_STAGE(PG8_SB(1, 0), b3, voffB); PG8_STAGE(PG8_SB(1, 1), b3 + hstep, voffB); if constexpr (GATHER) { PG8_STAGE(PG8_SA(1, 0), ga3, v2[0]); } else { PG8_STAGE(PG8_SA(1, 0), a3, voffA); }
            PG8_WAIT_V(8); PG8_WAIT_L(0); PG8_BAR; PG8_MMA(1, 0, At, B0); PG8_MMA(1, 1, At, B1); PG8_BAR; PG8_SCHED;
            } else {
            PG8_LDB(B0, 0, 0); PG8_SCHED; PG8_LDA(At, 0, 0); PG8_STAGE(PG8_SA(1, 1), a1 + hstepA, voffA);
            PG8_WAIT_L(8); PG8_BAR; PG8_WAIT_L(0); PG8_MMA(0, 0, At, B0); PG8_BAR; PG8_SCHED;
            PG8_LDB(B1, 0, 1); PG8_STAGE(PG8_SB(0, 0), b2, voffB);
            PG8_BAR; PG8_WAIT_L(0); PG8_MMA(0, 1, At, B1); PG8_BAR;
            PG8_LDA(At, 0, 1); PG8_STAGE(PG8_SA(0, 0), a2, voffA);
            PG8_BAR; PG8_WAIT_L(0); PG8_MMA(1, 0, At, B0); PG8_BAR; PG8_SCHED;
            PG8_STAGE(PG8_SB(0, 1), b2 + hstep, voffB);
            PG8_WAIT_V(6); PG8_BAR; PG8_MMA(1, 1, At, B1); PG8_BAR;
            PG8_LDB(B0, 1, 0); PG8_SCHED; PG8_LDA(At, 1, 0); PG8_STAGE(PG8_SA(0, 1), a2 + hstepA, voffA);
            PG8_WAIT_L(8); PG8_BAR; PG8_WAIT_L(0); PG8_MMA(0, 0, At, B0); PG8_BAR; PG8_SCHED;
            PG8_LDB(B1, 1, 1); PG8_STAGE(PG8_SB(1, 0), b3, voffB);
            PG8_BAR; PG8_WAIT_L(0); PG8_MMA(0, 1, At, B1); PG8_BAR;
            PG8_LDA(At, 1, 1); PG8_STAGE(PG8_SA(1, 0), a3, voffA);
            PG8_BAR; PG8_WAIT_L(0); PG8_MMA(1, 0, At, B0); PG8_BAR; PG8_SCHED;
            PG8_STAGE(PG8_SB(1, 1), b3 + hstep, voffB);
            PG8_WAIT_V(6); PG8_BAR; PG8_MMA(1, 1, At, B1); PG8_BAR;
            }
        }
        if constexpr (ALIGN_EPI) { if (wr == 0) PG8_BAR; }
        bool has_nn = false;
        if constexpr (GATHER) { Unit nn_; has_nn = has_next && S.next(ui + 2, nn_); if (has_nn) PG8_TOKLD(tkn, nn_.pm); }
        if constexpr (!Epi::AFTER_DRAIN) { E(acc, cur, wr, wc, fr, fq); S.done(cur); }
        if (!has_next) break;
        if constexpr (GATHER) { _Pragma("unroll") for (int h_ = 0; h_ < 2; ++h_) _Pragma("unroll") for (int i_ = 0; i_ < 2; ++i_) vC[h_][i_] = vN[h_][i_]; if (has_nn) PG8_TOKOFF(vN, tkn); }
#pragma unroll
        for (int a = 0; a < 2; ++a)
#pragma unroll
            for (int b = 0; b < 2; ++b)
#pragma unroll
                for (int m = 0; m < 4; ++m)
#pragma unroll
                    for (int n = 0; n < 2; ++n) acc[a][b][m][n] = (f32x4){0.f, 0.f, 0.f, 0.f};
        cur = nxt; cA = nA; cB = nB; ++ui;
        if constexpr (ALIGN_EPI) { if (wr == 1) PG8_BAR; }
    }
    PG8_WAIT_V(0);
    if constexpr (!ALIGN_EPI) { if (wr == 0) PG8_BAR; }
    PG8_BAR;
#undef PG8_SA
#undef PG8_SB
#undef PG8_STAGE
#undef PG8_LDA
#undef PG8_LDB
#undef PG8_MMA
#undef PG8_F8CAT
#undef PG8_TOKLD
#undef PG8_TOKOFF
#undef PG8_WAIT_V
#undef PG8_WAIT_L
#undef PG8_BAR
#undef PG8_SCHED
}
}

__device__ __forceinline__ u32x4 f8_pair16(u32x2 rowA, u32x2 rowB) {
    const auto s0 = __builtin_amdgcn_permlane16_swap(rowA.x, rowB.x, false, false), s1 = __builtin_amdgcn_permlane16_swap(rowA.y, rowB.y, false, false);
    return (u32x4){s0[0], s1[0], s0[1], s1[1]};
}
struct EpiGU8 { static constexpr bool PERM = true, AFTER_DRAIN = false;
    unsigned char* act8; const float* bgu;
    __device__ __forceinline__ void operator()(const f32x4 (&acc)[2][2][4][2], const pg8::Unit& u, int wr, int wc, int fr, int fq) const {
        const int e = u.pn >> 3, ac0 = 128 * (u.pn & 7) + wc * 32 + 8 * fq;
        const float* bb = bgu + (size_t)e * 2048 + 2 * ac0;
        const f32x4 q0 = *(const f32x4*)bb, q1 = *(const f32x4*)(bb + 4), q2 = *(const f32x4*)(bb + 8), q3 = *(const f32x4*)(bb + 12);
        const float bg[8] = {q0[0], q0[2], q1[0], q1[2], q2[0], q2[2], q3[0], q3[2]}, bl[8] = {q0[1], q0[3], q1[1], q1[3], q2[1], q2[3], q3[1], q3[3]};
        const int odd = fq & 1, acs = ac0 - 8 * odd;
#pragma unroll
        for (int ai = 0; ai < 2; ++ai)
#pragma unroll
            for (int mp = 0; mp < 2; ++mp) { u32x2 pk[2];
#pragma unroll
                for (int h = 0; h < 2; ++h) { const int m = 2 * mp + h; float o[8];
#pragma unroll
                    for (int t = 0; t < 8; t += 2) {
                        const f32x2 ag = {acc[ai][0][m][t >> 2][t & 3], acc[ai][0][m][(t + 1) >> 2][(t + 1) & 3]}, al = {acc[ai][1][m][t >> 2][t & 3], acc[ai][1][m][(t + 1) >> 2][(t + 1) & 3]};
                        f32x2 xg = ag * W8_INV + (f32x2){bg[t], bg[t + 1]}, xl = al * W8_INV + (f32x2){bl[t], bl[t + 1]};
                        xg.x = fminf(xg.x, 7.f); xg.y = fminf(xg.y, 7.f); xl.x = __builtin_amdgcn_fmed3f(xl.x, -7.f, 7.f); xl.y = __builtin_amdgcn_fmed3f(xl.y, -7.f, 7.f);
                        const f32x2 ex = xg * (-1.702f * 1.4426950408889634f); f32x2 dn; dn.x = __builtin_amdgcn_exp2f(ex.x); dn.y = __builtin_amdgcn_exp2f(ex.y); dn = dn + 1.f;
                        f32x2 sg; sg.x = __builtin_amdgcn_rcpf(dn.x); sg.y = __builtin_amdgcn_rcpf(dn.y);
                        const f32x2 pq = xg * sg, ov = pq * xl + pq; o[t] = ov.x; o[t + 1] = ov.y; }
                    pk[h] = (u32x2){pack4_f8(o[0], o[1], o[2], o[3]), pack4_f8(o[4], o[5], o[6], o[7])}; }
                const int row = u.pm * 256 + ai * 128 + wr * 64 + (2 * mp + odd) * 16 + fr;
                *(u32x4*)(act8 + (size_t)row * DM + acs) = f8_pair16(pk[0], pk[1]); }
    } };
constexpr float O2_SCALE = 8.f, O2_INV = 1.f / 8.f;
struct EpiDN8 { static constexpr bool PERM = true, AFTER_DRAIN = false;
    unsigned char* out2; const float* bdn; const float* row_gate;
    __device__ __forceinline__ void operator()(const f32x4 (&acc)[2][2][4][2], const pg8::Unit& u, int wr, int wc, int fr, int fq) const {
        const int e = u.pn >> 2, c0 = 256 * (u.pn & 3) + wc * 32 + 8 * fq;
        f32x4 bv[2][2];
#pragma unroll
        for (int bj = 0; bj < 2; ++bj) { bv[bj][0] = *(const f32x4*)(bdn + (size_t)e * DM + c0 + bj * 128); bv[bj][1] = *(const f32x4*)(bdn + (size_t)e * DM + c0 + bj * 128 + 4); }
        const int odd = fq & 1, cs = c0 - 8 * odd;
#pragma unroll
        for (int ai = 0; ai < 2; ++ai)
#pragma unroll
            for (int mp = 0; mp < 2; ++mp) { u32x2 pk[2][2];
#pragma unroll
                for (int h = 0; h < 2; ++h) { const int m = 2 * mp + h; const float g = row_gate[u.pm * 256 + ai * 128 + wr * 64 + m * 16 + fr] * O2_SCALE;
#pragma unroll
                    for (int bj = 0; bj < 2; ++bj) { const f32x4 v0 = (acc[ai][bj][m][0] * W8_INV + bv[bj][0]) * g, v1 = (acc[ai][bj][m][1] * W8_INV + bv[bj][1]) * g;
                        pk[bj][h] = (u32x2){pack4_f8(v0[0], v0[1], v0[2], v0[3]), pack4_f8(v1[0], v1[1], v1[2], v1[3])}; } }
                const int row = u.pm * 256 + ai * 128 + wr * 64 + (2 * mp + odd) * 16 + fr;
#pragma unroll
                for (int bj = 0; bj < 2; ++bj) *(u32x4*)(out2 + (size_t)row * DM + cs + bj * 128) = f8_pair16(pk[bj][0], pk[bj][1]); }
    } };

struct HookO { static constexpr bool ON = true; const LAS f32x2* T;
    __device__ __forceinline__ void mid(f32x4 (&acc)[2][2][4][2], const pg8::Unit& u, int wr, int fr) const {
#pragma unroll
        for (int ai = 0; ai < 2; ++ai)
#pragma unroll
            for (int m = 0; m < 4; ++m) { const float r = T[u.ui * 256 + ai * 128 + wr * 64 + m * 16 + fr].x;
#pragma unroll
                for (int bj = 0; bj < 2; ++bj) { acc[ai][bj][m][0] = acc[ai][bj][m][0] * r; acc[ai][bj][m][1] = acc[ai][bj][m][1] * r; } }
    } };
struct EpiOF { static constexpr bool PERM = true, AFTER_DRAIN = false;
    bf16* y1; const bf16* h0; const LAS f32x2* T;
    __device__ __forceinline__ void operator()(const f32x4 (&acc)[2][2][4][2], const pg8::Unit& u, int wr, int wc, int fr, int fq) const {
        const int c0 = u.pn * 256 + wc * 32 + 8 * fq;
#pragma unroll
        for (int ai = 0; ai < 2; ++ai)
#pragma unroll
            for (int m = 0; m < 4; ++m) { const int rl = ai * 128 + wr * 64 + m * 16 + fr, row = u.pm * 256 + rl; const float r = T[u.ui * 256 + rl].y;
#pragma unroll
                for (int bj = 0; bj < 2; ++bj) { float h[8]; unpack8(*(const u32x4*)(h0 + (size_t)row * DM + c0 + bj * 128), h);
                    const f32x4 a = acc[ai][bj][m][0] * r, b = acc[ai][bj][m][1] * r;
                    const float o[8] = {ALPHA * h[0] + a[0], ALPHA * h[1] + a[1], ALPHA * h[2] + a[2], ALPHA * h[3] + a[3], ALPHA * h[4] + b[0], ALPHA * h[5] + b[1], ALPHA * h[6] + b[2], ALPHA * h[7] + b[3]};
                    *(u32x4*)(y1 + (size_t)row * DM + c0 + bj * 128) = pack8(o); } }
    } };
#ifndef FAST_Z
#define FAST_Z 1
#endif
#ifndef FAST_O
#define FAST_O 1
#endif

struct MapId { __device__ __forceinline__ int operator()(int n) const { return n; } };
struct MapIn { __device__ __forceinline__ int operator()(int n) const {
    if (n >= 384 && n < 448) { const int l = n - 384; return 384 + 2 * (l & 31) + (l >> 5); }
    if (n >= 448 && n < 1216) { const int l = n - 448, hd = l >> 7, d = l & 127; return 448 + hd * 128 + (d >> 6) * 64 + 2 * (d & 31) + ((d >> 5) & 1); }
    return n; } };
struct MapQ { __device__ __forceinline__ int operator()(int n) const { const int h = n / 192, w = n - h * 192; if (w < 128) return n; const int l = w - 128; return h * 192 + 128 + 2 * (l & 31) + (l >> 5); } };
struct MapGU { __device__ __forceinline__ int operator()(int n) const { const int a = n >> 1; return 256 * (a >> 7) + 128 * (n & 1) + (a & 127); } };
template <class Map>
__device__ __forceinline__ void transpose_item(const float* __restrict__ W, int K, int N, bf16* __restrict__ WT, LAS float* scr, int item, int lane, const Map& map, const float* __restrict__ kscale = nullptr, int ldo = 0, const float* __restrict__ kscale2 = nullptr) {
    if (ldo == 0) ldo = K;
    const int nblk = N / 32, kb = item / nblk, nb = item - kb * nblk, k0 = 64 * kb, n0 = 32 * nb;
#pragma unroll 8
    for (int i = 0; i < 32; ++i) { const int kk = 2 * i + (lane >> 5); scr[kk * 33 + (lane & 31)] = (k0 < K) ? W[(size_t)(k0 + kk) * N + n0 + (lane & 31)] * (kscale ? ((kscale2 && k0 + kk >= 512) ? kscale2[k0 + kk - 512] : kscale[k0 + kk]) : 1.f) : 0.f; }
    LDS_WAIT(); asm volatile("" ::: "memory");
    const int c = lane & 7;
#pragma unroll
    for (int j = 0; j < 4; ++j) { const int n = (lane >> 3) + 8 * j; const LAS float* s = scr + (8 * c) * 33 + n;
        u32x4 o; o.x = cvtpk(s[0 * 33], s[1 * 33]); o.y = cvtpk(s[2 * 33], s[3 * 33]); o.z = cvtpk(s[4 * 33], s[5 * 33]); o.w = cvtpk(s[6 * 33], s[7 * 33]);
        *(u32x4*)(WT + (size_t)map(n0 + n) * ldo + k0 + 8 * c) = o; }
    LDS_WAIT(); asm volatile("" ::: "memory");
}

template <class Map>
__device__ __forceinline__ void transpose_item_f8(const float* __restrict__ W, int K, int N, unsigned char* __restrict__ WT, LAS float* scr, int item, int lane, const Map& map, float scale) {
    const int nblk = N / 32, kb = item / nblk, nb = item - kb * nblk, k0 = 64 * kb, n0 = 32 * nb;
#pragma unroll 8
    for (int i = 0; i < 8; ++i) { const int kk = 8 * i + (lane >> 3), c4 = (lane & 7) * 4; const f32x4 w4 = *(const f32x4*)(W + (size_t)(k0 + kk) * N + n0 + c4) * scale;
        LAS float* d_ = scr + kk * 33 + c4; d_[0] = w4[0]; d_[1] = w4[1]; d_[2] = w4[2]; d_[3] = w4[3]; }
    LDS_WAIT(); asm volatile("" ::: "memory");
    const int n = lane >> 1;
#pragma unroll
    for (int j = 0; j < 2; ++j) { const int c = 2 * (lane & 1) + j; const LAS float* s_ = scr + (16 * c) * 33 + n;
        u32x4 o; o.x = pack4_f8(s_[0 * 33], s_[1 * 33], s_[2 * 33], s_[3 * 33]); o.y = pack4_f8(s_[4 * 33], s_[5 * 33], s_[6 * 33], s_[7 * 33]);
        o.z = pack4_f8(s_[8 * 33], s_[9 * 33], s_[10 * 33], s_[11 * 33]); o.w = pack4_f8(s_[12 * 33], s_[13 * 33], s_[14 * 33], s_[15 * 33]);
        *(u32x4*)(WT + (size_t)map(n0 + n) * K + k0 + 16 * c) = o; }
    LDS_WAIT(); asm volatile("" ::: "memory");
}

template <class Map>
__device__ __forceinline__ void transpose_f8_stream(const float* __restrict__ Wall, int N, unsigned char* __restrict__ WTall, LAS float* scr, int gw, int ngw, int lane, const Map& map, float scale) {
    const int nblk = N / 32, per = 16 * nblk, n_items = NE * per;
#define T8_LOAD(dst, it_) do { const int e_ = (it_) / per, r_ = (it_) - e_ * per, kb_ = r_ / nblk, nb_ = r_ - kb_ * nblk; \
        const float* wp_ = Wall + ((size_t)e_ * 1024 + 64 * kb_ + (lane >> 3)) * N + 32 * nb_ + (lane & 7) * 4; \
        _Pragma("unroll") for (int i = 0; i < 8; ++i) dst[i] = *(const f32x4*)(wp_ + (size_t)(8 * i) * N); } while (0)
    f32x4 cur[8], nxt[8];
    int it = gw; if (it < n_items) T8_LOAD(cur, it);
    for (; it < n_items; it += ngw) {
        const int itn = it + ngw; if (itn < n_items) T8_LOAD(nxt, itn);
        const int e = it / per, r = it - e * per, kb = r / nblk, nb = r - kb * nblk, k0 = 64 * kb, n0 = 32 * nb;
#pragma unroll
        for (int i = 0; i < 8; ++i) { LAS float* d_ = scr + (8 * i + (lane >> 3)) * 33 + (lane & 7) * 4; const f32x4 w4 = cur[i] * scale; d_[0] = w4[0]; d_[1] = w4[1]; d_[2] = w4[2]; d_[3] = w4[3]; }
        LDS_WAIT(); asm volatile("" ::: "memory");
        const int n = lane >> 1;
#pragma unroll
        for (int j = 0; j < 2; ++j) { const int c = 2 * (lane & 1) + j; const LAS float* s_ = scr + (16 * c) * 33 + n;
            u32x4 o; o.x = pack4_f8(s_[0 * 33], s_[1 * 33], s_[2 * 33], s_[3 * 33]); o.y = pack4_f8(s_[4 * 33], s_[5 * 33], s_[6 * 33], s_[7 * 33]);
            o.z = pack4_f8(s_[8 * 33], s_[9 * 33], s_[10 * 33], s_[11 * 33]); o.w = pack4_f8(s_[12 * 33], s_[13 * 33], s_[14 * 33], s_[15 * 33]);
            *(u32x4*)(WTall + ((size_t)e * N + map(n0 + n)) * 1024 + k0 + 16 * c) = o; }
        LDS_WAIT(); asm volatile("" ::: "memory");
#pragma unroll
        for (int i = 0; i < 8; ++i) cur[i] = nxt[i];
    }
#undef T8_LOAD
}
__device__ __forceinline__ void ln_row_f32_to_bf16(f32x4 (&v)[4], const f32x4 (&gg)[4], const f32x4 (&bb)[4], bf16* __restrict__ orow, int lane) {
    float s = 0.f;
#pragma unroll
    for (int j = 0; j < 4; ++j) s += (v[j].x + v[j].y) + (v[j].z + v[j].w);
    const float mean = wave_sum(s) * (1.f / DM); float s2 = 0.f;
#pragma unroll
    for (int j = 0; j < 4; ++j) { v[j] = v[j] - mean; s2 += (v[j].x * v[j].x + v[j].y * v[j].y) + (v[j].z * v[j].z + v[j].w * v[j].w); }
    const float rstd = rsq(wave_sum(s2) * (1.f / DM) + LN_EPS);
#pragma unroll
    for (int j = 0; j < 4; ++j) { const f32x4 o = v[j] * rstd * gg[j] + bb[j]; ((u32x2*)orow)[lane + 64 * j] = (u32x2){cvtpk(o.x, o.y), cvtpk(o.z, o.w)}; }
}

__device__ __forceinline__ void ln_row_bf16(const bf16* __restrict__ yrow, const f32x4 (&G4)[4], const f32x4 (&B4)[4], bf16* __restrict__ orow, unsigned char* __restrict__ o8, int lane) {
    float v[16]; unpack8(*(const u32x4*)(yrow + 8 * lane), *(float(*)[8])&v[0]); unpack8(*(const u32x4*)(yrow + 512 + 8 * lane), *(float(*)[8])&v[8]);
    float s = 0.f;
#pragma unroll
    for (int j = 0; j < 16; ++j) s += v[j];
    const float mean = wave_sum(s) * (1.f / DM); float s2 = 0.f;
#pragma unroll
    for (int j = 0; j < 16; ++j) { v[j] -= mean; s2 += v[j] * v[j]; }
    const float rstd = rsq(wave_sum(s2) * (1.f / DM) + LN_EPS);
#pragma unroll
    for (int hf = 0; hf < 2; ++hf) { const f32x4 a = (f32x4){v[hf * 8 + 0], v[hf * 8 + 1], v[hf * 8 + 2], v[hf * 8 + 3]} * rstd * G4[2 * hf] + B4[2 * hf], b = (f32x4){v[hf * 8 + 4], v[hf * 8 + 5], v[hf * 8 + 6], v[hf * 8 + 7]} * rstd * G4[2 * hf + 1] + B4[2 * hf + 1];
        *(u32x4*)(orow + hf * 512 + 8 * lane) = (u32x4){cvtpk(a[0], a[1]), cvtpk(a[2], a[3]), cvtpk(b[0], b[1]), cvtpk(b[2], b[3])};
        *(u32x2*)(o8 + hf * 512 + 8 * lane) = (u32x2){pack4_f8(a[0], a[1], a[2], a[3]), pack4_f8(b[0], b[1], b[2], b[3])}; }
}
__device__ __forceinline__ void zero_bytes(void* p, size_t bytes, int gtid, int ngt) {
    u32x4* q = (u32x4*)p; const size_t n = bytes / 16;
    for (size_t i = gtid; i < n; i += ngt) q[i] = (u32x4){0u, 0u, 0u, 0u};
}
__device__ __forceinline__ void sincos_d(float angf, float& sn, float& cs) {
    const double x = (double)angf; const double q = __builtin_rint(x * 0.63661977236758134308);
    const double r = (x - q * 1.57079632679489655800) - q * 6.123233995736766036e-17, r2 = r * r;
    const double sp = r * (1.0 + r2 * (-1.0 / 6 + r2 * (1.0 / 120 + r2 * (-1.0 / 5040 + r2 * (1.0 / 362880 + r2 * (-1.0 / 39916800 + r2 * (1.0 / 6227020800.0)))))));
    const double cp = 1.0 + r2 * (-0.5 + r2 * (1.0 / 24 + r2 * (-1.0 / 720 + r2 * (1.0 / 40320 + r2 * (-1.0 / 3628800 + r2 * (1.0 / 479001600.0))))));
    const int qi = ((int)q) & 3;
    const double s_ = (qi == 0) ? sp : (qi == 1) ? cp : (qi == 2) ? -sp : -cp;
    const double c_ = (qi == 0) ? cp : (qi == 1) ? -sp : (qi == 2) ? -cp : sp;
    sn = (float)s_; cs = (float)c_;
}

__device__ __forceinline__ void p2a_row(int row, u32x4 wA, u32x4 wB, u32x4 wC, const float* __restrict__ rope, const float* __restrict__ g_q_a, const float* __restrict__ g_kv_a,
                                        const float* __restrict__ g_q_gqa, const float* __restrict__ g_k_gqa, float* rs_q, float* rs_kv, bf16* km, bf16* qg, bf16* kg, bf16* vg, int lane) {
    const bool meta = row >= NTOK;
    const int b = row >> 11, s = row & 2047, m = row - NTOK;
    const int pos1 = meta ? m : 16 + s, prow = meta ? -1 : (s >> 6), pcol = meta ? m : (s & 63), key = meta ? 2048 + m : s;
    {
        float f[8]; unpack8(wA, f);
        float ss = 0.f;
#pragma unroll
        for (int j = 0; j < 8; ++j) ss += f[j] * f[j];
        ss += __shfl_xor(ss, 1); ss += __shfl_xor(ss, 2); ss += __shfl_xor(ss, 4); ss += __shfl_xor(ss, 8);
        const float s16 = ss, s32 = ss + __shfl_xor(ss, 16);
        if (lane == 0) rs_q[row] = rsq(s32 * (1.f / 256) + RMS_EPS);
        if (lane == 32) rs_kv[row] = rsq(s16 * (1.f / 128) + RMS_EPS);
        if (lane < 48) {
        } else if (lane < 56) { const int i0 = 4 * (lane - 48); const float* t = rope + ((size_t)(pos1 + 1) * 32 + i0) * 2; float o[8];
#pragma unroll
            for (int j = 0; j < 4; ++j) { const float c = t[2 * j], sn = t[2 * j + 1], x1 = f[2 * j], x2 = f[2 * j + 1]; o[2 * j] = x1 * c - x2 * sn; o[2 * j + 1] = x1 * sn + x2 * c; }
            const u32x4 pk = pack8(o);
            if (!meta) { for (int h = 0; h < 4; ++h) *(u32x4*)(km + ((size_t)(b * 4 + h) * LKP + key) * 192 + 128 + 8 * (lane - 48)) = pk; }
            else { for (int bb = 0; bb < NB; ++bb) for (int h = 0; h < 4; ++h) *(u32x4*)(km + ((size_t)(bb * 4 + h) * LKP + key) * 192 + 128 + 8 * (lane - 48)) = pk; }
        }
    }
    const int p0 = (lane & 15) * 8, half = p0 >> 6, i0 = (p0 & 63) >> 1;
    const int apos = half ? pcol : prow; const float* t = rope + ((size_t)(apos + 1) * 32 + i0) * 2;
    if (!meta) {
        float f[8]; unpack8(wB, f);
        float ss = 0.f;
#pragma unroll
        for (int j = 0; j < 8; ++j) ss += f[j] * f[j];
        ss += __shfl_xor(ss, 1); ss += __shfl_xor(ss, 2); ss += __shfl_xor(ss, 4); ss += __shfl_xor(ss, 8);
        const float rs = rsq(ss * (1.f / 128) + RMS_EPS); float o[8];
#pragma unroll
        for (int j = 0; j < 4; ++j) { const int d1 = half * 64 + i0 + j, d2 = d1 + 32;
            const float x1 = f[2 * j] * rs * g_q_gqa[d1], x2 = f[2 * j + 1] * rs * g_q_gqa[d2], c = t[2 * j], sn = t[2 * j + 1];
            o[2 * j] = x1 * c - x2 * sn; o[2 * j + 1] = x1 * sn + x2 * c; }
        *(u32x4*)(qg + ((size_t)(b * 4 + (lane >> 4)) * 2048 + s) * 128 + p0) = pack8(o);
    }
    {
        float f[8]; unpack8(wC, f);
        float ss = 0.f;
#pragma unroll
        for (int j = 0; j < 8; ++j) ss += f[j] * f[j];
        ss += __shfl_xor(ss, 1); ss += __shfl_xor(ss, 2); ss += __shfl_xor(ss, 4); ss += __shfl_xor(ss, 8);
        float o[8];
        if (lane < 32) { const float rs = rsq(ss * (1.f / 128) + RMS_EPS);
#pragma unroll
            for (int j = 0; j < 4; ++j) { const int d1 = half * 64 + i0 + j, d2 = d1 + 32;
                const float x1 = f[2 * j] * rs * g_k_gqa[d1], x2 = f[2 * j + 1] * rs * g_k_gqa[d2], c = t[2 * j], sn = t[2 * j + 1];
                o[2 * j] = x1 * c - x2 * sn; o[2 * j + 1] = x1 * sn + x2 * c; }
        } else {
#pragma unroll
            for (int j = 0; j < 8; ++j) o[j] = f[j];
        }
        const u32x4 pk = pack8(o); bf16* dst = lane < 32 ? kg : vg; const int hk = (lane >> 4) & 1;
        if (!meta) *(u32x4*)(dst + ((size_t)(b * 2 + hk) * LKP + key) * 128 + p0) = pk;
        else for (int bb = 0; bb < NB; ++bb) *(u32x4*)(dst + ((size_t)(bb * 2 + hk) * LKP + key) * 128 + p0) = pk;
    }
}

__device__ __forceinline__ int crow(int r, int hi) { return (r & 3) + 8 * (r >> 2) + 4 * hi; }
__device__ __forceinline__ int v_st(int k, int c) { const int kk = (k & ~0xC) | ((k & 4) << 1) | ((k & 8) >> 1); return ((kk >> 3) * 4 + (c >> 5)) * 512 + ((kk & 7) * 32 + (c & 31)) * 2; }
__device__ __forceinline__ int v_rd_base(int lane) { return ((lane & 3) << 3) | (((lane >> 2) & 3) << 6) | (((lane >> 4) & 1) << 5) | (((lane >> 5) & 1) << 8); }
constexpr int v_rd_off(int d0, int ks, int half) { return d0 * 512 + ks * 4096 + half * 2048; }
template <int OFF> __device__ __forceinline__ s16x4 tr_read(int vb) {
    s16x4 r; asm volatile("ds_read_b64_tr_b16 %0, %1 offset:%2" : "=&v"(r) : "v"(vb), "i"(OFF) : "memory"); return r;
}
template <int D0> __device__ __forceinline__ void pv_one(f32x16& od, int vb, bf16x8 pa0, bf16x8 pa1, bf16x8 pa2, bf16x8 pa3) {
    const s16x4 l0 = tr_read<v_rd_off(D0, 0, 0)>(vb), h0 = tr_read<v_rd_off(D0, 0, 1)>(vb), l1 = tr_read<v_rd_off(D0, 1, 0)>(vb), h1 = tr_read<v_rd_off(D0, 1, 1)>(vb);
    const s16x4 l2 = tr_read<v_rd_off(D0, 2, 0)>(vb), h2 = tr_read<v_rd_off(D0, 2, 1)>(vb), l3 = tr_read<v_rd_off(D0, 3, 0)>(vb), h3 = tr_read<v_rd_off(D0, 3, 1)>(vb);
    asm volatile("s_waitcnt lgkmcnt(0)" ::: "memory"); SBAR();
#define PK(L, H) (bf16x8){L[0], L[1], L[2], L[3], H[0], H[1], H[2], H[3]}
    od = __builtin_amdgcn_mfma_f32_32x32x16_bf16(pa0, PK(l0, h0), od, 0, 0, 0);
    od = __builtin_amdgcn_mfma_f32_32x32x16_bf16(pa1, PK(l1, h1), od, 0, 0, 0);
    od = __builtin_amdgcn_mfma_f32_32x32x16_bf16(pa2, PK(l2, h2), od, 0, 0, 0);
    od = __builtin_amdgcn_mfma_f32_32x32x16_bf16(pa3, PK(l3, h3), od, 0, 0, 0);
#undef PK
}
__device__ __forceinline__ void pv_d0(f32x16* o, int vb, bf16x8 pa0, bf16x8 pa1, bf16x8 pa2, bf16x8 pa3) {
    pv_one<0>(o[0], vb, pa0, pa1, pa2, pa3); pv_one<1>(o[1], vb, pa0, pa1, pa2, pa3); pv_one<2>(o[2], vb, pa0, pa1, pa2, pa3); pv_one<3>(o[3], vb, pa0, pa1, pa2, pa3);
}
template <int DQK> struct AttnC {
    static constexpr float SCALE = DQK == 192 ? 0.07216878364870322f : 0.08838834764831845f;
    static constexpr float C = SCALE * 1.4426950408889634f, THRS = 8.f / SCALE;
};
template <int DQK>
__device__ __forceinline__ void partialSM(f32x16& p0, f32x16& p1, float& m_reg, float& mn, float& alpha) {
    constexpr float C = AttnC<DQK>::C;
    float pmax = p0[0];
#pragma unroll
    for (int r = 1; r < 16; ++r) pmax = fmaxf(pmax, p0[r]);
#pragma unroll
    for (int r = 0; r < 16; ++r) pmax = fmaxf(pmax, p1[r]);
    { auto rr = __builtin_amdgcn_permlane32_swap(__float_as_uint(pmax), __float_as_uint(pmax), false, false);
      pmax = fmaxf(__uint_as_float(rr[0]), __uint_as_float(rr[1])); }
    if (__builtin_expect(__all(pmax - m_reg <= AttnC<DQK>::THRS), 1)) { mn = m_reg; alpha = 1.f; }
    else { mn = fmaxf(m_reg, pmax); alpha = __builtin_amdgcn_exp2f((m_reg - mn) * C); m_reg = mn; }
    const float mnC = -mn * C;
#pragma unroll
    for (int r = 0; r < 16; ++r) p0[r] = fmaf(p0[r], C, mnC);
#pragma unroll
    for (int r = 0; r < 16; ++r) p1[r] = fmaf(p1[r], C, mnC);
#pragma unroll
    for (int r = 0; r < 16; ++r) p0[r] = __builtin_amdgcn_exp2f(p0[r]);
}
__device__ __forceinline__ void finishSM(f32x16& p0, f32x16& p1, float alpha, float& l_reg, bf16x8& pa0, bf16x8& pa1, bf16x8& pa2, bf16x8& pa3) {
#pragma unroll
    for (int r = 0; r < 16; ++r) p1[r] = __builtin_amdgcn_exp2f(p1[r]);
    float ps = 0;
#pragma unroll
    for (int r = 0; r < 16; ++r) ps += p0[r];
#pragma unroll
    for (int r = 0; r < 16; ++r) ps += p1[r];
    { auto rr = __builtin_amdgcn_permlane32_swap(__float_as_uint(ps), __float_as_uint(ps), false, false);
      ps = __uint_as_float(rr[0]) + __uint_as_float(rr[1]); }
    l_reg = l_reg * alpha + ps;
#define PK4(P, BASE, OUT) do { unsigned a0 = cvtpk(P[BASE + 0], P[BASE + 1]), a1 = cvtpk(P[BASE + 2], P[BASE + 3]);   \
    unsigned b0 = cvtpk(P[BASE + 4], P[BASE + 5]), b1 = cvtpk(P[BASE + 6], P[BASE + 7]);                              \
    auto r0 = __builtin_amdgcn_permlane32_swap(a0, b0, false, false); auto r1 = __builtin_amdgcn_permlane32_swap(a1, b1, false, false); \
    u32x4 w = {r0[0], r1[0], r0[1], r1[1]}; OUT = *reinterpret_cast<bf16x8*>(&w); } while (0)
    PK4(p0, 0, pa0); PK4(p0, 8, pa1); PK4(p1, 0, pa2); PK4(p1, 8, pa3);
#undef PK4
}
template <int DQK>
__device__ __forceinline__ void qkt(f32x16& p0, f32x16& p1, const LAS char* Ks, const bf16x8* qr, const LAS char* ql, const int (&ko)[4]) {
    constexpr int KRB = DQK * 2;
    p0 = f32x16{}; p1 = f32x16{};
#pragma unroll
    for (int d0 = 0; d0 < DQK / 16; ++d0) { const LAS char* kp = Ks + ko[d0 & 3] + (d0 >> 2) * 128;
        const bf16x8 b0 = *(const LAS bf16x8*)(kp);
        const bf16x8 b1 = *(const LAS bf16x8*)(kp + 32 * KRB);
        bf16x8 q; if (d0 < 8) q = qr[d0]; else q = *(const LAS bf16x8*)(ql + (d0 - 8) * 1024);
        p0 = __builtin_amdgcn_mfma_f32_32x32x16_bf16(b0, q, p0, 0, 0, 0);
        p1 = __builtin_amdgcn_mfma_f32_32x32x16_bf16(b1, q, p1, 0, 0, 0); }
}
template <int DQK, int SD>
__device__ __forceinline__ void attn_body(const bf16* __restrict__ Qb, const bf16* __restrict__ Kh, const bf16* __restrict__ Vh, bf16* __restrict__ Ob, LAS char* lds, const float* __restrict__ rope, int pos0, float* __restrict__ ssq) {
    constexpr int ND0 = DQK / 16, KRB = DQK * 2, SHM_K = 64 * KRB, SHM_V = 64 * 128 * 2, NKC = DQK / 64, CPR = DQK / 8, NT = LKP / 64;
    static_assert(NT % 2 == 1, "odd tile count: the tail below takes tiles NT-2 and NT-1");
    int tid = threadIdx.x; asm volatile("" : "+v"(tid));
    const int wid = tid >> 6, lane = tid & 63, r32 = lane & 31, hi = lane >> 5;
    LAS char* V_lds = lds; LAS char* K_lds = lds + 2 * SHM_V;
    __syncthreads();
    float m_reg = -1e30f, l_reg = 0; f32x16 o[4] = {}; bf16x8 qr[8];
    const bf16* Qw = Qb + (size_t)(wid * 32 + r32) * DQK + hi * 8;
#pragma unroll
    for (int d0 = 0; d0 < 8; ++d0) qr[d0] = *reinterpret_cast<const bf16x8*>(Qw + d0 * 16);
    LAS char* ql = lds + 2 * SHM_V + 2 * SHM_K + 2048 + wid * 4096 + lane * 16;
#pragma unroll
    for (int d0 = 8; d0 < ND0; ++d0) {
        float x[8], y[8]; unpack8(*reinterpret_cast<const u32x4*>(Qw + d0 * 16), x);
        const float* t = rope + ((size_t)(pos0 + wid * 32 + r32 + 1) * 32 + (d0 - 8) * 8 + hi * 4) * 2; const f32x4 t0 = *(const f32x4*)t, t1 = *(const f32x4*)(t + 4);
        const float cs[4] = {t0[0], t0[2], t1[0], t1[2]}, sn[4] = {t0[1], t0[3], t1[1], t1[3]};
#pragma unroll
        for (int j = 0; j < 4; ++j) { y[2 * j] = x[2 * j] * cs[j] - x[2 * j + 1] * sn[j]; y[2 * j + 1] = x[2 * j] * sn[j] + x[2 * j + 1] * cs[j]; }
        *(LAS u32x4*)(ql + (d0 - 8) * 1024) = pack8(y); }
    const int sr = tid >> 4, sc = (tid & 15) * 8, vst0 = v_st(sr, sc), vst1 = v_st(32 + sr, sc);
    int kst[NKC];
#pragma unroll
    for (int c = 0; c < NKC; ++c) { const int id = tid + 512 * c, kr = id / CPR, kc = (id - kr * CPR) * 8; kst[c] = kr * KRB + ((kc * 2) ^ ((kr & 7) << 4)); }
    const int voff = tid * 16;
    int ko[4];
#pragma unroll
    for (int q = 0; q < 4; ++q) ko[q] = r32 * KRB + ((q * 32 + hi * 16) ^ ((r32 & 7) << 4));
    const __amdgpu_buffer_rsrc_t rK = __builtin_amdgcn_make_buffer_rsrc((void*)Kh, 0, LKP * KRB, 0x00020000);
    const __amdgpu_buffer_rsrc_t rV = __builtin_amdgcn_make_buffer_rsrc((void*)Vh, 0, LKP * 256, 0x00020000);
    const int vb0 = (int)(unsigned)(uintptr_t)V_lds + v_rd_base(lane);
    struct { bf16x8 vs0, vs1, ks[NKC]; } sr_[SD];
#define SLOAD(i, k0) do { sr_[i].vs0 = __builtin_bit_cast(bf16x8, __builtin_amdgcn_raw_buffer_load_b128(rV, voff, (k0) * 256, 0)); sr_[i].vs1 = __builtin_bit_cast(bf16x8, __builtin_amdgcn_raw_buffer_load_b128(rV, voff, (k0) * 256 + 8192, 0)); \
    _Pragma("unroll") for (int c_ = 0; c_ < NKC; ++c_) sr_[i].ks[c_] = __builtin_bit_cast(bf16x8, __builtin_amdgcn_raw_buffer_load_b128(rK, voff, (k0) * KRB + c_ * 8192, 0)); } while (0)
#define SWRITE(b, i) do { *(LAS bf16x8*)(V_lds + (b) * SHM_V + vst0) = sr_[i].vs0; *(LAS bf16x8*)(V_lds + (b) * SHM_V + vst1) = sr_[i].vs1; \
    _Pragma("unroll") for (int c_ = 0; c_ < NKC; ++c_) *(LAS bf16x8*)(K_lds + (b) * SHM_K + kst[c_]) = sr_[i].ks[c_]; } while (0)
#define SWAIT() do { if constexpr (SD == 2) { if constexpr (NKC == 2) asm volatile("s_waitcnt vmcnt(4)" ::: "memory"); else asm volatile("s_waitcnt vmcnt(5)" ::: "memory"); } \
    else asm volatile("s_waitcnt vmcnt(0)" ::: "memory"); } while (0)
#define RESC(a) do { if (__any((a) < 1.f)) { int t_ = threadIdx.x; asm volatile("" : "+v"(t_)); const int r32_ = t_ & 31, hi_2 = (t_ >> 5) & 1; \
    LAS float* al_ = (LAS float*)(lds + 2 * SHM_V + 2 * SHM_K) + (t_ >> 6) * 64 + 32; if (hi_2 == 0) al_[r32_] = (a); asm volatile("s_waitcnt lgkmcnt(0)" ::: "memory"); \
    _Pragma("unroll") for (int d = 0; d < 4; ++d) _Pragma("unroll") for (int r = 0; r < 16; ++r) o[d][r] *= al_[crow(r, hi_2)]; } } while (0)
    f32x16 pA0, pA1, pB0, pB1; float mnA, mnB, alA, alB; bf16x8 pa0, pa1, pa2, pa3;
    constexpr int SE = 0, SO = SD - 1;
    SLOAD(SE, 0); asm volatile("s_waitcnt vmcnt(0)" ::: "memory"); SWRITE(0, SE); __syncthreads();
    qkt<DQK>(pA0, pA1, K_lds, qr, ql, ko); partialSM<DQK>(pA0, pA1, m_reg, mnA, alA);
    SLOAD(SO, 64); if constexpr (SD == 2) { SLOAD(SE, 128); }
    SWAIT(); SWRITE(1, SO); __syncthreads();
#pragma unroll 1
    for (int j = 1; j + 2 < NT; j += 2) {
        SBAR(); qkt<DQK>(pB0, pB1, K_lds + SHM_K, qr, ql, ko);
        finishSM(pA0, pA1, alA, l_reg, pa0, pa1, pa2, pa3); SBAR();
        SLOAD(SO, (j + SD) * 64); SBAR();
        pv_d0(o, vb0, pa0, pa1, pa2, pa3); partialSM<DQK>(pB0, pB1, m_reg, mnB, alB);
        __syncthreads(); SWAIT(); SWRITE(0, SE);
        RESC(alB); __syncthreads();
        SBAR(); qkt<DQK>(pA0, pA1, K_lds, qr, ql, ko);
        finishSM(pB0, pB1, alB, l_reg, pa0, pa1, pa2, pa3); SBAR();
        SLOAD(SE, (j + 1 + SD) * 64); SBAR();
        pv_d0(o, vb0 + SHM_V, pa0, pa1, pa2, pa3); partialSM<DQK>(pA0, pA1, m_reg, mnA, alA);
        __syncthreads(); SWAIT(); SWRITE(1, SO);
        RESC(alA); __syncthreads();
    }
    SBAR(); qkt<DQK>(pB0, pB1, K_lds + SHM_K, qr, ql, ko);
    finishSM(pA0, pA1, alA, l_reg, pa0, pa1, pa2, pa3); SBAR();
    if constexpr (SD == 1) { SLOAD(SE, (NT - 1) * 64); } SBAR();
    pv_d0(o, vb0, pa0, pa1, pa2, pa3); partialSM<DQK>(pB0, pB1, m_reg, mnB, alB);
    __syncthreads(); asm volatile("s_waitcnt vmcnt(0)" ::: "memory"); SWRITE(0, SE);
    RESC(alB); __syncthreads();
    SBAR(); qkt<DQK>(pA0, pA1, K_lds, qr, ql, ko);
#pragma unroll
    for (int r = 8; r < 16; ++r) pA0[r] = -1e30f;
#pragma unroll
    for (int r = 0; r < 16; ++r) pA1[r] = -1e30f;
    finishSM(pB0, pB1, alB, l_reg, pa0, pa1, pa2, pa3); SBAR();
    pv_d0(o, vb0 + SHM_V, pa0, pa1, pa2, pa3); partialSM<DQK>(pA0, pA1, m_reg, mnA, alA);
    RESC(alA);
    finishSM(pA0, pA1, alA, l_reg, pa0, pa1, pa2, pa3); SBAR();
    pv_d0(o, vb0, pa0, pa1, pa2, pa3);
    { int t_ = threadIdx.x; asm volatile("" : "+v"(t_)); const int r32_ = t_ & 31, hi_2 = (t_ >> 5) & 1, wid_ = t_ >> 6;
      LAS float* li_ = (LAS float*)(lds + 2 * SHM_V + 2 * SHM_K) + wid_ * 64;
      if (hi_2 == 0) li_[r32_] = l_reg; asm volatile("s_waitcnt lgkmcnt(0)" ::: "memory");
      float rli[16];
#pragma unroll
      for (int r = 0; r < 16; ++r) rli[r] = __builtin_amdgcn_rcpf(li_[crow(r, hi_2)]);
      { float ss[16];
#pragma unroll
        for (int r = 0; r < 16; ++r) { float a = 0.f;
#pragma unroll
            for (int d0 = 0; d0 < 4; ++d0) { const float x = o[d0][r] * rli[r]; a += x * x; }
            a += __shfl_xor(a, 1); a += __shfl_xor(a, 2); a += __shfl_xor(a, 4); a += __shfl_xor(a, 8); a += __shfl_xor(a, 16); ss[r] = a; }
        float mine = ss[0];
#pragma unroll
        for (int r = 1; r < 16; ++r) mine = (r32_ == r) ? ss[r] : mine;
        if (r32_ < 16) ssq[(size_t)(wid_ * 32 + crow(r32_, hi_2)) * 8] = mine; }
      bf16* Ow = Ob + (size_t)(wid_ * 32) * DM;
#pragma unroll
      for (int r = 0; r < 16; ++r) { const int orow = crow(r, hi_2);
#pragma unroll
          for (int d0 = 0; d0 < 4; ++d0) Ow[(size_t)orow * DM + d0 * 32 + r32_] = (bf16)(cvtpk(o[d0][r] * rli[r], 0.f) & 0xffffu); } }
#undef SLOAD
#undef SWRITE
#undef SWAIT
#undef RESC
}

constexpr int NPHASE = 14;
struct Args { const float* in[24]; float* out; unsigned char* ws; int ph_lo, ph_hi, bar_region, pad; };
__global__ void __launch_bounds__(NWAVES * 64, 2) hymba_fwd(Args args) {
    extern __shared__ __attribute__((aligned(16))) unsigned char lds[];
    { int t0 = threadIdx.x; asm volatile("" : "+v"(t0)); for (int u = t0; u < 1024; u += NWAVES * 64) ((LAS unsigned*)((LAS unsigned char*)lds + LDSCTL_OFF))[u] = 0u; }
    __syncthreads();
#define XB_OBJ(b_) XcdBarrier b_; { const CAS unsigned char* kq_ = (const CAS unsigned char*)__builtin_amdgcn_kernarg_segment_ptr(); asm volatile("" : "+s"(kq_)); \
    b_.bar = (unsigned*)(*(unsigned char* const CAS*)(kq_ + 200) + WS_CTL) + CW_BAR + *(const int CAS*)(kq_ + 216) * XCD_BAR_WORDS; b_.x = xb_xcc_id(); b_.st = (volatile LAS unsigned*)((LAS unsigned char*)lds + LDSCTL_OFF) + 8; }
#if !MK_SPLIT
    { XB_OBJ(b0_); (void)xcd_barrier_post(b0_.bar, b0_.st); }
#define GRID_BAR() do { XB_OBJ(bb_); xcd_barrier(bb_); } while (0)
#else
#define GRID_BAR() do {} while (0)
#endif
    const int lo = args.ph_lo, hi_ = args.ph_hi;
#ifndef REP_MASK
#define REP_MASK 0
#endif
#define IN(k) (lo <= (k) && (k) < hi_)
#define REPS(k) (((REP_MASK >> (k)) & 1) ? 2 : 1)
#define SEAM(k) do { if (IN(k) && IN((k) + 1)) GRID_BAR(); } while (0)

#define PTRS \
    int bx = blockIdx.x; asm volatile("" : "+s"(bx)); const int G = gridDim.x, vcu = (G % 8 == 0) ? (bx % 8) * (G / 8) + bx / 8 : bx; \
    const int tid = threadIdx.x, lane = tid & 63, wave = __builtin_amdgcn_readfirstlane(tid >> 6); \
    const int gw = vcu * NWAVES + wave, ngw = G * NWAVES, gtid = vcu * (NWAVES * 64) + tid, ngt = G * NWAVES * 64; (void)gw; (void)ngw; (void)gtid; (void)ngt; (void)lane; \
    const CAS unsigned char* kp_ = (const CAS unsigned char*)__builtin_amdgcn_kernarg_segment_ptr(); asm volatile("" : "+s"(kp_)); \
    const float* const CAS* kin = (const float* const CAS*)kp_; unsigned char* ws = *(unsigned char* const CAS*)(kp_ + 200); float* outp = *(float* const CAS*)(kp_ + 192); (void)outp; (void)kin; \
    const float* x = kin[0]; const float* meta_tok = kin[1]; \
    float* rope = (float*)(ws + WS_ROPE); \
    bf16* w_in_t = (bf16*)(ws + WS_WIN); bf16* w_qb_t = (bf16*)(ws + WS_WQB); bf16* w_kvb_t = (bf16*)(ws + WS_WKVB); bf16* w_o_t = (bf16*)(ws + WS_WO); \
    bf16* w_r_t = (bf16*)(ws + WS_WR); unsigned char* w_gu8 = ws + WS_WGU; unsigned char* w_dn8 = ws + WS_WDN; unsigned char* h1f8 = ws + WS_H1F8; \
    bf16* h0 = (bf16*)(ws + WS_H0); bf16* h1 = (bf16*)(ws + WS_H1); float* rs_q = (float*)(ws + WS_QAN); float* rs_kv = rs_q + MPAD; float* ssq = (float*)(ws + WS_KVAN); bf16* z = (bf16*)(ws + WS_Z); \
    bf16* qm = (bf16*)(ws + WS_QM); bf16* km = (bf16*)(ws + WS_KM); bf16* vm = (bf16*)(ws + WS_VM); bf16* qg = (bf16*)(ws + WS_QG); bf16* kg = (bf16*)(ws + WS_KG); bf16* vg = (bf16*)(ws + WS_VG); \
    bf16* ob = (bf16*)(ws + WS_O); bf16* y1 = (bf16*)(ws + WS_Y1); float* logits = (float*)(ws + WS_LOGITS); \
    int* topk = (int*)(ws + WS_TOPK); float* gate = (float*)(ws + WS_GATE); int* pair_pos = (int*)(ws + WS_PAIRPOS); float* row_gate = (float*)(ws + WS_ROWGATE); \
    int* hist = (int*)(ws + WS_HIST); int* moetab = (int*)(ws + WS_MOETAB); int* tile_expert = moetab + 256; \
    int* row_tok = (int*)(ws + WS_XS); unsigned char* act8 = ws + WS_ACT; unsigned char* out2 = ws + WS_OUT2;


    for (int rep_ = 0; rep_ < (IN(0) ? REPS(0) : 0); ++rep_) { if (rep_) GRID_BAR(); PTRS;
        LAS float* scr = (LAS float*)((LAS unsigned char*)lds + wave * 16384);
        constexpr int I_IN = 16 * 46, I_QB = 4 * 24, I_KVB = 4 * 32, I_O = 16 * 32, I_R = 16;
        constexpr int NITEMS = I_IN + I_QB + I_KVB + I_O + I_R;
        for (int it = gw; it < NITEMS; it += ngw) {
            int r = it;
            if (r < I_IN) { transpose_item(kin[4], 1024, NIN, w_in_t, scr, r, lane, MapIn()); continue; } r -= I_IN;
            if (r < I_QB) { transpose_item(kin[6], 256, 768, w_qb_t, scr, r, lane, MapQ(), kin[5]); continue; } r -= I_QB;
            if (r < I_KVB) { transpose_item(kin[8], 128, 1024, w_kvb_t, scr, r, lane, MapId(), kin[7], 256); continue; } r -= I_KVB;
            if (r < I_O) { transpose_item(kin[13], 1024, 1024, w_o_t, scr, r, lane, MapId(), kin[11], 0, kin[12]); continue; } r -= I_O;
            transpose_item(kin[16], 1024, 32, w_r_t, scr, r, lane, MapId());
        }
        transpose_f8_stream(kin[18], 2048, w_gu8, scr, gw, ngw, lane, MapGU(), W8_SCALE);
        transpose_f8_stream(kin[20], 1024, w_dn8, scr, gw, ngw, lane, MapId(), W8_SCALE);
        { f32x4 gg[4], bb[4], cv[4], nv[4];
#pragma unroll
          for (int j = 0; j < 4; ++j) { gg[j] = ((const f32x4*)kin[2])[lane + 64 * j]; bb[j] = ((const f32x4*)kin[3])[lane + 64 * j]; }
#define LN_LOAD(dst, m_) do { const float* xr_ = (m_) < NTOK ? x + (size_t)(m_) * DM : meta_tok + (size_t)((m_) - NTOK) * DM; _Pragma("unroll") for (int j = 0; j < 4; ++j) dst[j] = ((const f32x4*)xr_)[lane + 64 * j]; } while (0)
          if (gw < MROWS) LN_LOAD(cv, gw);
          for (int m = gw; m < MROWS; m += ngw) { const int mn = m + ngw < MROWS ? m + ngw : m; LN_LOAD(nv, mn);
              ln_row_f32_to_bf16(cv, gg, bb, h0 + (size_t)m * DM, lane);
#pragma unroll
              for (int j = 0; j < 4; ++j) cv[j] = nv[j]; }
#undef LN_LOAD
        }
        zero_bytes(h0 + (size_t)MROWS * DM, (size_t)(MPAD - MROWS) * DM * 2, gtid, ngt);
        zero_bytes(w_in_t + (size_t)NIN * 1024, (size_t)(ZLD - NIN) * 1024 * 2, gtid, ngt);
        for (int i = gw; i < 64 + 64 + 32 + 32; i += ngw) {
            bf16* p; size_t rb;
            if (i < 64) { p = km + ((size_t)i * LKP + 2064) * 192; rb = 48 * 192 * 2; }
            else if (i < 128) { p = vm + ((size_t)(i - 64) * LKP + 2064) * 128; rb = 48 * 128 * 2; }
            else if (i < 160) { p = kg + ((size_t)(i - 128) * LKP + 2064) * 128; rb = 48 * 128 * 2; }
            else { p = vg + ((size_t)(i - 160) * LKP + 2064) * 128; rb = 48 * 128 * 2; }
            zero_bytes(p, rb, lane, 64);
        }
        for (int i = gtid; i < 2065 * 32; i += ngt) {
            const int p = i / 32 - 1, f = i & 31; double inv = 1.0;
            for (int q = 0; q < f; ++q) inv *= 0.74989420933245582730;
            const float ang = (float)p * (float)inv; float sn, cs; sincos_d(fabsf(ang), sn, cs); if (ang < 0.f) sn = -sn;
            rope[2 * i] = cs; rope[2 * i + 1] = sn;
        }
    }
    SEAM(0);
    for (int rep_ = 0; rep_ < (IN(1) ? REPS(1) : 0); ++rep_) { if (rep_) GRID_BAR(); PTRS; EpiZ E{z};
#if FAST_Z
        { pg8::Gemm g{h0, w_in_t, NTOK, ZLD, 1024, 1024, nullptr}; pg8::StaticOrder S; S.init(NTOK, ZLD, G, bx); pg8::EpiAdapt<EpiZ> EA{E, 0};
          pg8::gemm_phase<pg8::EpiAdapt<EpiZ>, pg8::StaticOrder, true, true>((LAS unsigned char*)lds, g, S, EA); }
        meta_gemm16<1024>(h0, 1024, w_in_t, NTOK, ZLD, E, gw, ngw, lane);
#else
        simple_gemm(h0, w_in_t, 1024, 0, NTOK + 64, ZLD, E, BSelNone(), gw, ngw, lane);
#endif
    }
    SEAM(1);
    for (int rep_ = 0; rep_ < (IN(2) ? REPS(2) : 0); ++rep_) { if (rep_) GRID_BAR(); PTRS;
#define P2_LOAD(m_, a_, b_, c_) do { const bf16* zr_ = z + (size_t)(m_) * ZLD; a_ = (u32x4){0u, 0u, 0u, 0u}; if (lane < 56) a_ = *(const u32x4*)(zr_ + 8 * lane); b_ = *(const u32x4*)(zr_ + 448 + 8 * lane); c_ = *(const u32x4*)(zr_ + 960 + 8 * lane); } while (0)
        u32x4 wa, wb, wc, na, nb, nc; if (gw < MROWS) P2_LOAD(gw, wa, wb, wc);
        for (int m = gw; m < MROWS; m += ngw) { const int mn = m + ngw < MROWS ? m + ngw : m; P2_LOAD(mn, na, nb, nc);
            p2a_row(m, wa, wb, wc, rope, kin[5], kin[7], kin[9], kin[10], rs_q, rs_kv, km, qg, kg, vg, lane); wa = na; wb = nb; wc = nc; }
#undef P2_LOAD
    }
    SEAM(2);
    for (int rep_ = 0; rep_ < (IN(3) ? REPS(3) : 0); ++rep_) { if (rep_) GRID_BAR(); PTRS;
        { EpiQ E{qm, rs_q}; pg8::Gemm g{z, w_qb_t, NTOK, 768, 256, ZLD, nullptr}; pg8::StaticOrder S; S.init(NTOK, 768, G, bx); pg8::EpiAdapt<EpiQ> EA{E, 0};
          pg8::gemm_phase<pg8::EpiAdapt<EpiQ>, pg8::StaticOrder, true, true>((LAS unsigned char*)lds, g, S, EA); }
        { EpiKV<false> E{km, vm, rs_kv}; pg8::Gemm g{z + 256, w_kvb_t, NTOK, 1024, 256, ZLD, nullptr}; pg8::StaticOrder S; S.init(NTOK, 1024, G, bx); pg8::EpiAdapt<EpiKV<false>> EA{E, 0};
          pg8::gemm_phase<pg8::EpiAdapt<EpiKV<false>>, pg8::StaticOrder, true, true>((LAS unsigned char*)lds, g, S, EA);
          EpiKV<true> EM{km, vm, rs_kv}; meta_gemm16<256>(z + 256, ZLD, w_kvb_t, NTOK, 1024, EM, gw, ngw, lane); }
    }
    SEAM(3);
    for (int rep_ = 0; rep_ < (IN(4) ? REPS(4) : 0); ++rep_) { if (rep_) GRID_BAR(); PTRS;
        for (int u = vcu; u < 1024; u += G) {
            if (u < 512) { const int b = u >> 5, h = (u >> 3) & 3, qb = u & 7, bh = b * 4 + h;
                attn_body<192, 1>(qm + ((size_t)bh * 2048 + qb * 256) * 192, km + (size_t)bh * LKP * 192, vm + (size_t)bh * LKP * 128, ob + ((size_t)b * 2048 + qb * 256) * DM + h * 128, (LAS char*)lds, rope, 16 + qb * 256, ssq + ((size_t)b * 2048 + qb * 256) * 8 + h);
            } else { const int v = u - 512, b = v >> 5, h = (v >> 3) & 3, qb = v & 7, bh = b * 4 + h, bk = b * 2 + (h >> 1);
                attn_body<128, 1>(qg + ((size_t)bh * 2048 + qb * 256) * 128, kg + (size_t)bk * LKP * 128, vg + (size_t)bk * LKP * 128, ob + ((size_t)b * 2048 + qb * 256) * DM + 512 + h * 128, (LAS char*)lds, rope, 0, ssq + ((size_t)b * 2048 + qb * 256) * 8 + 4 + h);
            }
        }
    }
    SEAM(4);
    for (int rep_ = 0; rep_ < (IN(6) ? REPS(6) : 0); ++rep_) { if (rep_) GRID_BAR(); PTRS;
        pg8::Gemm g{ob, w_o_t, NTOK, 1024, 1024, 1024, nullptr}; pg8::StaticOrder S; S.init(NTOK, 1024, G, bx);
        LAS f32x2* T = (LAS f32x2*)((LAS unsigned char*)lds + LDSCTL_OFF + 2048);
        for (int i = tid >> 8; i < 6; i += 2) { pg8::Unit u; if (!S.next(i, u)) break; const int rl = tid & 255; const float* q = ssq + (size_t)(u.pm * 256 + rl) * 8;
            const f32x4 a = *(const f32x4*)q, b = *(const f32x4*)(q + 4);
            const float rm = rsq(((a[0] + a[1]) + (a[2] + a[3])) * (1.f / 512) + RMS_EPS), rg = rsq(((b[0] + b[1]) + (b[2] + b[3])) * (1.f / 512) + RMS_EPS);
            T[i * 256 + rl] = (f32x2){rm / rg, rg}; }
        __syncthreads();
        EpiOF E{y1, h0, T}; HookO H{T};
        pg8::gemm_phase<EpiOF, pg8::StaticOrder, true, true, false, false, HookO>((LAS unsigned char*)lds, g, S, E, H);
    }
    SEAM(6);
#ifndef MOE_SKEW_TICKS
#define MOE_SKEW_TICKS 0
#endif
#define MOE_STAGGER(nunits) do { const int rem_ = (nunits) % G; if (MOE_SKEW_TICKS > 0 && rem_ != 0 && bx >= rem_) { const unsigned long long t0_ = __builtin_amdgcn_s_memrealtime(), w_ = (unsigned long long)(MOE_SKEW_TICKS * ((bx - rem_) % 3 + 1)); \
    while (__builtin_amdgcn_s_memrealtime() - t0_ < w_) __builtin_amdgcn_s_sleep(16); } } while (0)
#define ROUTE_VARS const int tpb = (NTOK + G - 1) / G, tok_lo = bx * tpb, tok_hi = (tok_lo + tpb < NTOK) ? tok_lo + tpb : NTOK; \
    LAS int* L_hist = (LAS int*)((LAS unsigned char*)lds + LDSCTL_OFF + 256); LAS int* L_n = L_hist + 32; LAS int* L_base = L_hist + 64; LAS int* L_off = L_hist + 96; (void)L_n; (void)L_base; (void)L_off;
    for (int rep_ = 0; rep_ < (IN(8) ? REPS(8) : 0); ++rep_) { if (rep_) GRID_BAR(); PTRS; ROUTE_VARS;
        constexpr int WRP = 2064;
        LAS unsigned char* L_wr = (LAS unsigned char*)lds;
        for (int i = tid; i < 32 * 128; i += NWAVES * 64) { const int r = i >> 7, c = i & 127; *(LAS u32x4*)(L_wr + r * WRP + c * 16) = *(const u32x4*)(w_r_t + (size_t)r * 1024 + c * 8); }
        if (tid < 32) L_hist[tid] = 0;
        zero_bytes(row_tok, (size_t)MOE_ROWS_MAX * 4, gtid, ngt);
        __syncthreads();
        const int fr = lane & 15, fq = lane >> 4;
        f32x4 G4[4], B4[4];
#pragma unroll
        for (int hf = 0; hf < 2; ++hf) { const int c = hf * 512 + 8 * lane; G4[2 * hf] = *(const f32x4*)(kin[14] + c); G4[2 * hf + 1] = *(const f32x4*)(kin[14] + c + 4); B4[2 * hf] = *(const f32x4*)(kin[15] + c); B4[2 * hf + 1] = *(const f32x4*)(kin[15] + c + 4); }
        for (int rb = tok_lo + wave * 16; rb < tok_hi; rb += NWAVES * 16) {
            for (int i = 0; i < 16 && rb + i < tok_hi; ++i) ln_row_bf16(y1 + (size_t)(rb + i) * DM, G4, B4, h1 + (size_t)(rb + i) * DM, h1f8 + (size_t)(rb + i) * DM, lane);
            asm volatile("s_waitcnt vmcnt(0)" ::: "memory");
            const int row = rb + fr < NTOK ? rb + fr : NTOK - 1;
            const bf16* ap = h1 + (size_t)row * DM + fq * 8;
            bf16x8 a[32];
#pragma unroll
            for (int ks = 0; ks < 32; ++ks) a[ks] = *(const bf16x8*)(ap + ks * 32);
            f32x4 acc0 = {0.f, 0.f, 0.f, 0.f}, acc1 = {0.f, 0.f, 0.f, 0.f};
            const LAS unsigned char* bp = L_wr + (8 * (fr >> 2) + (fr & 3)) * WRP + fq * 16;
#pragma unroll
            for (int ks = 0; ks < 32; ++ks) { const bf16x8 b0 = *(const LAS bf16x8*)(bp + ks * 64), b1 = *(const LAS bf16x8*)(bp + 4 * WRP + ks * 64);
                acc0 = __builtin_amdgcn_mfma_f32_16x16x32_bf16(b0, a[ks], acc0, 0, 0, 0); acc1 = __builtin_amdgcn_mfma_f32_16x16x32_bf16(b1, a[ks], acc1, 0, 0, 0); }
            const float* br = kin[17] + 8 * fq; const f32x4 bb0 = *(const f32x4*)br, bb1 = *(const f32x4*)(br + 4);
            float v[8] = {acc0[0] + bb0[0], acc0[1] + bb0[1], acc0[2] + bb0[2], acc0[3] + bb0[3], acc1[0] + bb1[0], acc1[1] + bb1[1], acc1[2] + bb1[2], acc1[3] + bb1[3]};
            float tv[4]; int ti[4];
#pragma unroll
            for (int r = 0; r < 4; ++r) { float bv = v[0]; int bi = 8 * fq;
#pragma unroll
                for (int j = 1; j < 8; ++j) if (v[j] > bv) { bv = v[j]; bi = 8 * fq + j; }
#pragma unroll
                for (int off = 16; off <= 32; off <<= 1) { const float ov = __shfl_xor(bv, off); const int oi = __shfl_xor(bi, off); if (ov > bv || (ov == bv && oi < bi)) { bv = ov; bi = oi; } }
                tv[r] = bv; ti[r] = bi;
#pragma unroll
                for (int j = 0; j < 8; ++j) if (bi == 8 * fq + j) v[j] = -INFINITY; }
            const float e1 = __expf(tv[1] - tv[0]), e2 = __expf(tv[2] - tv[0]), e3 = __expf(tv[3] - tv[0]), inv = 1.f / (1.f + e1 + e2 + e3);
            if (fq == 0 && rb + fr < tok_hi) { const int t = rb + fr; *(int4*)(topk + (size_t)t * 4) = make_int4(ti[0], ti[1], ti[2], ti[3]); *(f32x4*)(gate + (size_t)t * 4) = (f32x4){inv, e1 * inv, e2 * inv, e3 * inv};
                atomicAdd((int*)(L_hist + ti[0]), 1); atomicAdd((int*)(L_hist + ti[1]), 1); atomicAdd((int*)(L_hist + ti[2]), 1); atomicAdd((int*)(L_hist + ti[3]), 1); }
        }
        __syncthreads();
        if (tid < 32) hist[bx * 32 + tid] = L_hist[tid];
    }
    SEAM(8);
    for (int rep_ = 0; rep_ < (IN(10) ? REPS(10) : 0); ++rep_) { if (rep_) GRID_BAR(); PTRS; ROUTE_VARS;
        if (tid < 32) { int tot = 0, before = 0; for (int b = 0; b < G; ++b) { const int h = hist[b * 32 + tid]; tot += h; if (b < bx) before += h; } L_n[tid] = tot; L_base[tid] = before; L_hist[tid] = 0; }
        __syncthreads();
        if (tid == 0) { int off = 0; for (int e = 0; e < NE; ++e) { L_off[e] = off; off += (L_n[e] + 255) & ~255; } L_off[NE] = off; }
        __syncthreads();
        for (int p = tok_lo * 4 + tid; p < tok_hi * 4; p += NWAVES * 64) { const int e = topk[p]; const int r = atomicAdd((int*)(L_hist + e), 1); const int pos = L_off[e] + L_base[e] + r;
            row_gate[pos] = gate[p]; pair_pos[p] = pos; row_tok[pos] = p >> 2; }
        __syncthreads();
        if (bx == 0) { if (tid == 0) moetab[0] = L_off[NE];
            if (tid < 32) { moetab[64 + tid] = L_n[tid]; moetab[128 + tid] = L_off[tid]; for (int t = L_off[tid] >> 8; t < (L_off[tid + 1] >> 8); ++t) tile_expert[t] = tid; } }
        __syncthreads();
    }
    SEAM(10);
    for (int rep_ = 0; rep_ < (IN(11) ? REPS(11) : 0); ++rep_) { if (rep_) GRID_BAR(); PTRS; const int rows = moetab[0]; EpiGU8 E{act8, kin[19]};
        pg8::Gemm g{(const bf16*)h1f8, (const bf16*)w_gu8, rows, 2048, 512, 512, row_tok}; LAS int* L_te = (LAS int*)((LAS unsigned char*)lds + LDSCTL_OFF + 2048); for (int i = tid; i < (rows >> 8); i += NWAVES * 64) L_te[i] = tile_expert[i]; __syncthreads();
        pg8::MoeOrder S; S.init(rows >> 8, 8, G, bx, L_te);
        MOE_STAGGER((rows >> 8) * 8);
        pg8::gemm_phase<EpiGU8, pg8::MoeOrder, true, true, true, true>((LAS unsigned char*)lds, g, S, E);
    }
    SEAM(11);
    for (int rep_ = 0; rep_ < (IN(12) ? REPS(12) : 0); ++rep_) { if (rep_) GRID_BAR(); PTRS; const int rows = moetab[0]; EpiDN8 E{out2, kin[21], row_gate};
        pg8::Gemm g{(const bf16*)act8, (const bf16*)w_dn8, rows, 1024, 512, 512, nullptr}; LAS int* L_te = (LAS int*)((LAS unsigned char*)lds + LDSCTL_OFF + 2048); for (int i = tid; i < (rows >> 8); i += NWAVES * 64) L_te[i] = tile_expert[i]; __syncthreads();
        pg8::MoeOrder S; S.init(rows >> 8, 4, G, bx, L_te);
        MOE_STAGGER((rows >> 8) * 4);
        pg8::gemm_phase<EpiDN8, pg8::MoeOrder, true, true, true>((LAS unsigned char*)lds, g, S, E);
    }
    SEAM(12);
    for (int rep_ = 0; rep_ < (IN(13) ? REPS(13) : 0); ++rep_) { if (rep_) GRID_BAR(); PTRS;
        f32x4 G4[4], B4[4];
#pragma unroll
        for (int hf = 0; hf < 2; ++hf) { const int c = hf * 512 + 8 * lane; G4[2 * hf] = *(const f32x4*)(kin[22] + c); G4[2 * hf + 1] = *(const f32x4*)(kin[22] + c + 4); B4[2 * hf] = *(const f32x4*)(kin[23] + c); B4[2 * hf + 1] = *(const f32x4*)(kin[23] + c + 4); }
        int4 pp = gw < NTOK ? *(const int4*)(pair_pos + (size_t)gw * 4) : make_int4(0, 0, 0, 0);
        for (int t = gw; t < NTOK; t += ngw) {
            const int ps[4] = {pp.x, pp.y, pp.z, pp.w};
            u32x4 hv[2]; u32x2 ov[4][2];
#pragma unroll
            for (int hf = 0; hf < 2; ++hf) { hv[hf] = *(const u32x4*)(h1 + (size_t)t * DM + hf * 512 + 8 * lane);
#pragma unroll
                for (int s4 = 0; s4 < 4; ++s4) ov[s4][hf] = *(const u32x2*)(out2 + (size_t)ps[s4] * DM + hf * 512 + 8 * lane); }
            if (t + ngw < NTOK) pp = *(const int4*)(pair_pos + (size_t)(t + ngw) * 4);
            float v[16];
#pragma unroll
            for (int hf = 0; hf < 2; ++hf) { float f[8]; unpack8(hv[hf], f);
                float acc8[8] = {0.f, 0.f, 0.f, 0.f, 0.f, 0.f, 0.f, 0.f};
#pragma unroll
                for (int s4 = 0; s4 < 4; ++s4) {
#pragma unroll
                    for (int w = 0; w < 2; ++w) { const unsigned d = w ? ov[s4][hf].y : ov[s4][hf].x;
                        const f32x2 lo = __builtin_amdgcn_cvt_pk_f32_fp8((int)d, false), hi2 = __builtin_amdgcn_cvt_pk_f32_fp8((int)d, true);
                        acc8[4 * w + 0] += lo[0]; acc8[4 * w + 1] += lo[1]; acc8[4 * w + 2] += hi2[0]; acc8[4 * w + 3] += hi2[1]; } }
#pragma unroll
                for (int j = 0; j < 8; ++j) v[hf * 8 + j] = ALPHA * f[j] + O2_INV * acc8[j]; }
            float s = 0.f;
#pragma unroll
            for (int j = 0; j < 16; ++j) s += v[j];
            const float mean = wave_sum(s) * (1.f / DM); float s2 = 0.f;
#pragma unroll
            for (int j = 0; j < 16; ++j) { v[j] -= mean; s2 += v[j] * v[j]; }
            const float rstd = rsq(wave_sum(s2) * (1.f / DM) + LN_EPS);
#pragma unroll
            for (int hf = 0; hf < 2; ++hf) { float* o = outp + (size_t)t * DM + hf * 512 + 8 * lane;
                *(f32x4*)o = (f32x4){v[hf * 8 + 0], v[hf * 8 + 1], v[hf * 8 + 2], v[hf * 8 + 3]} * rstd * G4[2 * hf] + B4[2 * hf];
                *(f32x4*)(o + 4) = (f32x4){v[hf * 8 + 4], v[hf * 8 + 5], v[hf * 8 + 6], v[hf * 8 + 7]} * rstd * G4[2 * hf + 1] + B4[2 * hf + 1]; }
        }
    }
#undef IN
#undef SEAM
}

extern "C" void kernel_launch(void* const* d_in, const int* in_sizes, int n_in, void* d_out, int out_size, void* d_ws, size_t ws_size, hipStream_t stream) {
    static int grid = 0;
    if (grid == 0) {
        if (n_in != 24 || in_sizes[0] != NTOK * DM || out_size != NTOK * DM || ws_size < WS_END) { fprintf(stderr, "kernel_launch: shape/workspace mismatch (n_in %d, ws %zu)\n", n_in, ws_size); grid = -1; return; }
        int dev = 0, cus = 0, per_cu = 0;
        if (hipGetDevice(&dev) != hipSuccess || hipDeviceGetAttribute(&cus, hipDeviceAttributeMultiprocessorCount, dev) != hipSuccess) { grid = -1; return; }
        if (hipFuncSetAttribute((const void*)hymba_fwd, hipFuncAttributeMaxDynamicSharedMemorySize, LDS_BYTES) != hipSuccess) { fprintf(stderr, "kernel_launch: hipFuncSetAttribute failed\n"); grid = -1; return; }
        if (hipOccupancyMaxActiveBlocksPerMultiprocessor(&per_cu, (const void*)hymba_fwd, NWAVES * 64, LDS_BYTES) != hipSuccess || per_cu < 1) fprintf(stderr, "kernel_launch: occupancy query says %d\n", per_cu);
        (void)hipGetLastError();
        grid = cus;
    }
    if (grid < 0) return;
    (void)hipMemsetAsync((char*)d_ws + WS_CTL, 0, CTL_ZERO_BYTES, stream);
    Args a{};
    for (int i = 0; i < 24; ++i) a.in[i] = (const float*)d_in[i];
    a.out = (float*)d_out; a.ws = (unsigned char*)d_ws;
#if MK_SPLIT
    for (int p = 0; p < NPHASE; ++p) { a.ph_lo = p; a.ph_hi = p + 1; hipLaunchKernelGGL(hymba_fwd, dim3(grid), dim3(NWAVES * 64), LDS_BYTES, stream, a); }
#else
    a.ph_lo = 0; a.ph_hi = NPHASE; hipLaunchKernelGGL(hymba_fwd, dim3(grid), dim3(NWAVES * 64), LDS_BYTES, stream, a);
#ifdef PROBE_RELAUNCH_LO
    a.ph_lo = PROBE_RELAUNCH_LO; a.ph_hi = PROBE_RELAUNCH_HI; a.bar_region = 1; hipLaunchKernelGGL(hymba_fwd, dim3(grid), dim3(NWAVES * 64), LDS_BYTES, stream, a);
#endif
#endif
}
```

```cpp
#include <hip/hip_runtime.h>
#include <cstdio>
#include <cstdint>

#ifndef MK_SPLIT
#define MK_SPLIT 0
#endif

#define LAS __attribute__((address_space(3)))
#define CAS __attribute__((address_space(4)))
typedef unsigned short bf16;
typedef short bf16x8 __attribute__((ext_vector_type(8)));
typedef short s16x4 __attribute__((ext_vector_type(4)));
typedef float f32x2 __attribute__((ext_vector_type(2)));
typedef float f32x4 __attribute__((ext_vector_type(4)));
typedef float f32x16 __attribute__((ext_vector_type(16)));
typedef unsigned u32x2 __attribute__((ext_vector_type(2)));
typedef unsigned u32x4 __attribute__((ext_vector_type(4)));
typedef __bf16 bf16x2_t __attribute__((ext_vector_type(2)));

constexpr int NB = 16, SEQ = 2048, DM = 1024, NMETA = 16;
constexpr int NTOK = NB * SEQ;
constexpr int MROWS = NTOK + NMETA;
constexpr int MPAD = 33024;
constexpr int LKP = 2112;
constexpr int NIN = 1472, ZLD = 1536;
constexpr int NE = 32, NPAIR = NTOK * 4, MOE_TILES_MAX = 544, MOE_ROWS_MAX = MOE_TILES_MAX * 256;
constexpr float ALPHA = 1.189207115002721f;
constexpr float RMS_EPS = 1e-6f, LN_EPS = 1e-5f;

constexpr size_t MiB = 1u << 20;
constexpr size_t WS_CTL = 0, CTL_ZERO_BYTES = 1 * MiB;
constexpr size_t WS_ROPE = 1 * MiB;
constexpr size_t WS_WQB = 2 * MiB;
constexpr size_t WS_WKVB = 2 * MiB + 512 * 1024;
constexpr size_t WS_WR = 3 * MiB;
constexpr size_t WS_LOGITS = 4 * MiB;
constexpr size_t WS_TOPK = 8 * MiB;
constexpr size_t WS_GATE = 8 * MiB + 512 * 1024;
constexpr size_t WS_PAIRPOS = 9 * MiB;
constexpr size_t WS_ROWGATE = 9 * MiB + 512 * 1024;
constexpr size_t WS_HIST = 10 * MiB + 512 * 1024;
constexpr size_t WS_MOETAB = 10 * MiB + 768 * 1024;
constexpr size_t WS_WIN = 12 * MiB;
constexpr size_t WS_WO = 15 * MiB;
constexpr size_t WS_WGU = 32 * MiB;
constexpr size_t WS_WDN = 96 * MiB;
constexpr size_t WS_H1F8 = 128 * MiB;
constexpr size_t WS_H0 = 224 * MiB;
constexpr size_t WS_H1 = 289 * MiB;
constexpr size_t WS_QAN = 353 * MiB;
constexpr size_t WS_KVAN = 370 * MiB;
constexpr size_t WS_Z = 380 * MiB;
constexpr size_t WS_QM = 477 * MiB;
constexpr size_t WS_KM = 525 * MiB;
constexpr size_t WS_VM = 575 * MiB;
constexpr size_t WS_QG = 608 * MiB;
constexpr size_t WS_KG = 640 * MiB;
constexpr size_t WS_VG = 657 * MiB;
constexpr size_t WS_O = 674 * MiB;
constexpr size_t WS_Y1 = 738 * MiB;
constexpr size_t WS_XS = 380 * MiB;
constexpr size_t WS_ACT = 516 * MiB;
constexpr size_t WS_OUT2 = 652 * MiB;
constexpr size_t WS_END = 924 * MiB;
static_assert(WS_Z + (size_t)MPAD * ZLD * 2 <= WS_QM && WS_QM + (size_t)64 * 2048 * 192 * 2 <= WS_KM && WS_KM + (size_t)64 * LKP * 192 * 2 <= WS_VM && WS_VM + (size_t)64 * LKP * 128 * 2 <= WS_QG, "ws map 1");
static_assert(WS_QG + (size_t)64 * 2048 * 128 * 2 <= WS_KG && WS_KG + (size_t)32 * LKP * 128 * 2 <= WS_VG && WS_VG + (size_t)32 * LKP * 128 * 2 <= WS_O && WS_O + (size_t)NTOK * DM * 2 <= WS_Y1 && WS_Y1 + (size_t)NTOK * DM * 4 <= WS_END, "ws map 2");
static_assert(WS_XS + (size_t)MOE_ROWS_MAX * DM <= WS_ACT && WS_ACT + (size_t)MOE_ROWS_MAX * DM <= WS_OUT2 && WS_OUT2 + (size_t)MOE_ROWS_MAX * DM * 2 <= WS_END && WS_WGU + (size_t)NE * 2048 * 1024 <= WS_WDN && WS_WDN + (size_t)NE * 1024 * 1024 <= WS_H1F8 && WS_H1F8 + (size_t)NTOK * DM <= WS_H0, "ws map 3");
static_assert(WS_H0 + (size_t)MPAD * DM * 2 <= WS_H1 && WS_H1 + (size_t)NTOK * DM * 2 <= WS_QAN && WS_QAN + (size_t)MPAD * 256 * 2 <= WS_KVAN && WS_KVAN + (size_t)MPAD * 128 * 2 <= WS_Z, "ws map 4");
constexpr int CW_BAR = 4096;

constexpr int RING_BYTES = 131072;
constexpr int LDSCTL_OFF = RING_BYTES;
constexpr int LDS_BYTES = 147456;
constexpr int NWAVES = 8;

#define LDS_WAIT() asm volatile("s_waitcnt lgkmcnt(0)" ::: "memory")
#define SBAR() __builtin_amdgcn_sched_barrier(0)
__device__ __forceinline__ unsigned cvtpk(float lo, float hi) { f32x2 v = {lo, hi}; bf16x2_t b = __builtin_convertvector(v, bf16x2_t); return __builtin_bit_cast(unsigned, b); }
__device__ __forceinline__ u32x4 pack8(const float (&v)[8]) { u32x4 r = {cvtpk(v[0], v[1]), cvtpk(v[2], v[3]), cvtpk(v[4], v[5]), cvtpk(v[6], v[7])}; return r; }
__device__ __forceinline__ void unpack8(u32x4 w, float (&v)[8]) {
    v[0] = __uint_as_float(w.x << 16); v[1] = __uint_as_float(w.x & 0xffff0000u); v[2] = __uint_as_float(w.y << 16); v[3] = __uint_as_float(w.y & 0xffff0000u);
    v[4] = __uint_as_float(w.z << 16); v[5] = __uint_as_float(w.z & 0xffff0000u); v[6] = __uint_as_float(w.w << 16); v[7] = __uint_as_float(w.w & 0xffff0000u);
}
__device__ __forceinline__ float wave_sum(float v) {
#pragma unroll
    for (int o = 1; o < 64; o <<= 1) v += __shfl_xor(v, o);
    return v;
}
__device__ __forceinline__ float rsq(float x) { return __builtin_amdgcn_rsqf(x); }
typedef int v8i __attribute__((ext_vector_type(8)));
__device__ __forceinline__ unsigned pack4_f8(float a, float b, float c, float d) { int w = 0; w = __builtin_amdgcn_cvt_pk_fp8_f32(a, b, w, false); w = __builtin_amdgcn_cvt_pk_fp8_f32(c, d, w, true); return (unsigned)w; }
constexpr float W8_SCALE = 32.f, W8_INV = 1.f / 32.f;

#define XB_TMO      128
#define XB_XCNT(j)  (256  + 64 * (j))
#define XB_XSUB(j)  (1280 + 64 * (j))
#define XB_XGEN(j)  (2304 + 64 * (j))
#define XB_TOP      3328
#define XB_TOPGEN   3392
#define XCD_BAR_WORDS 3456
#define XB_SPIN_CAP (1u << 18)
__device__ __forceinline__ unsigned xb_ld(unsigned* p)              { return __hip_atomic_load(p, __ATOMIC_RELAXED, __HIP_MEMORY_SCOPE_AGENT); }
__device__ __forceinline__ unsigned xb_add(unsigned* p, unsigned v) { return __hip_atomic_fetch_add(p, v, __ATOMIC_RELAXED, __HIP_MEMORY_SCOPE_AGENT); }
__device__ __forceinline__ unsigned xb_xcc_id() { return (unsigned)__builtin_amdgcn_s_getreg((3 << 11) | 20) & 0xFu; }
#define XB_SPIN(cond, bar) do { unsigned _sp = 0; while (cond) { __builtin_amdgcn_s_sleep(1); \
    if ((++_sp & 255u) == 0u) { if (xb_ld(&(bar)[XB_TMO])) break; if (_sp > XB_SPIN_CAP) { atomicAdd(&(bar)[XB_TMO], 1u); break; } } } } while (0)
struct XcdBarrier { unsigned* bar; unsigned x; volatile LAS unsigned* st; };
__device__ __forceinline__ XcdBarrier xcd_barrier_post(unsigned* bar, volatile LAS unsigned* st) {
    XcdBarrier b; b.bar = bar; b.x = xb_xcc_id(); b.st = st;
    if (threadIdx.x == 0) (void)xb_add(&bar[XB_XCNT(b.x)], 1u);
    return b;
}
__device__ __forceinline__ void xcd_barrier_complete(unsigned* bar, unsigned x, unsigned& nloc, unsigned& nx) {
    const unsigned G = gridDim.x * gridDim.y * gridDim.z;
    unsigned sum, cnt, mine, sp = 0u;
    for (;;) {
        sum = 0u; cnt = 0u; mine = 0u;
#pragma unroll
        for (unsigned j = 0; j < 16; ++j) { const unsigned c = xb_ld(&bar[XB_XCNT(j)]); sum += c; cnt += (c > 0u) ? 1u : 0u; mine = (j == x) ? c : mine; }
        if (sum == G) break;
        __builtin_amdgcn_s_sleep(1);
        if ((++sp & 255u) == 0u) { if (xb_ld(&bar[XB_TMO])) break; if (sp > XB_SPIN_CAP) { atomicAdd(&bar[XB_TMO], 1u); break; } }
    }
    nloc = mine > 0u ? mine : 1u; nx = cnt > 0u ? cnt : 1u;
}
__device__ __forceinline__ void xcd_barrier(const XcdBarrier& b) {
    asm volatile("s_waitcnt vmcnt(0)" ::: "memory");
    __syncthreads();
    if (threadIdx.x == 0) {
        unsigned* bar = b.bar;
        __builtin_amdgcn_s_waitcnt(0);
        unsigned nloc = b.st[0], nx = b.st[1];
        if (nloc == 0u) { xcd_barrier_complete(bar, b.x, nloc, nx); b.st[0] = nloc; b.st[1] = nx; }
        const unsigned old = xb_add(&bar[XB_XSUB(b.x)], 1u);
        const unsigned gen = old / nloc;
        if (old + 1u == (gen + 1u) * nloc) {
            __builtin_amdgcn_fence(__ATOMIC_RELEASE, "agent");
            asm volatile("s_waitcnt vmcnt(0)" ::: "memory");
            const unsigned og = xb_add(&bar[XB_TOP], 1u);
            const unsigned tg = og / nx;
            if (og + 1u == (tg + 1u) * nx) xb_add(&bar[XB_TOPGEN], 1u);
            else XB_SPIN(xb_ld(&bar[XB_TOPGEN]) == tg, bar);
            __builtin_amdgcn_fence(__ATOMIC_ACQUIRE, "agent");
            xb_add(&bar[XB_XGEN(b.x)], 1u);
            asm volatile("s_waitcnt vmcnt(0)" ::: "memory");
        } else {
            XB_SPIN(xb_ld(&bar[XB_XGEN(b.x)]) == gen, bar);
            __builtin_amdgcn_fence(__ATOMIC_ACQUIRE, "agent");
            asm volatile("s_waitcnt vmcnt(0)" ::: "memory");
        }
    }
    __syncthreads();
}

struct BSelNone { __device__ __forceinline__ size_t operator()(int) const { return 0; } };
struct BSelExpert { const int* tile_expert; size_t per; __device__ __forceinline__ size_t operator()(int m0) const { return (size_t)tile_expert[m0 >> 8] * per; } };
template <class Epi, class BSel>
__device__ __forceinline__ void simple_gemm(const bf16* __restrict__ A, const bf16* __restrict__ Bt, int K, int m_lo, int m_hi, int N, const Epi& E, const BSel& bsel, int gw, int ngw, int lane, int lda = 0) {
    if (lda == 0) lda = K;
    const int fr = lane & 15, fq = lane >> 4;
    const int mt = (m_hi - m_lo) / 64, nt = N / 32;
    for (int u = gw; u < mt * nt; u += ngw) {
        const int m0 = m_lo + (u / nt) * 64, n0 = (u % nt) * 32;
        const bf16* ap = A + (size_t)(m0 + fr) * lda + fq * 8;
        const bf16* bp = Bt + bsel(m0) + (size_t)(n0 + 8 * (fr >> 2) + (fr & 3)) * K + fq * 8;
        f32x4 acc[4][2];
#pragma unroll
        for (int i = 0; i < 4; ++i) { acc[i][0] = (f32x4){0.f, 0.f, 0.f, 0.f}; acc[i][1] = (f32x4){0.f, 0.f, 0.f, 0.f}; }
#pragma unroll 2
        for (int k = 0; k < K; k += 32) {
            bf16x8 a[4], b[2];
#pragma unroll
            for (int i = 0; i < 4; ++i) a[i] = *(const bf16x8*)(ap + (size_t)i * 16 * lda + k);
#pragma unroll
            for (int j = 0; j < 2; ++j) b[j] = *(const bf16x8*)(bp + (size_t)j * 4 * K + k);
#pragma unroll
            for (int i = 0; i < 4; ++i)
#pragma unroll
                for (int j = 0; j < 2; ++j) acc[i][j] = __builtin_amdgcn_mfma_f32_16x16x32_bf16(b[j], a[i], acc[i][j], 0, 0, 0);
        }
#pragma unroll
        for (int i = 0; i < 4; ++i) {
            const float v[8] = {acc[i][0][0], acc[i][0][1], acc[i][0][2], acc[i][0][3], acc[i][1][0], acc[i][1][1], acc[i][1][2], acc[i][1][3]};
            E.store8(m0 + 16 * i + fr, n0 + 8 * fq, v);
        }
    }
}


template <int K, class Epi>
__device__ __forceinline__ void smallk_task(const bf16* __restrict__ A, const bf16* __restrict__ Bt, int m0, int ng_lo, int ng_hi, const Epi& E, int lane) {
    constexpr int KS = K / 32;
    const int fr = lane & 15, fq = lane >> 4;
    bf16x8 a[4][KS];
#pragma unroll
    for (int i = 0; i < 4; ++i)
#pragma unroll
        for (int ks = 0; ks < KS; ++ks) a[i][ks] = *(const bf16x8*)(A + (size_t)(m0 + 16 * i + fr) * K + ks * 32 + fq * 8);
#pragma unroll 1
    for (int ng = ng_lo; ng < ng_hi; ++ng) {
        const int n0 = ng * 32;
        const bf16* bp = Bt + (size_t)(n0 + 8 * (fr >> 2) + (fr & 3)) * K + fq * 8;
        bf16x8 b[2][KS];
#pragma unroll
        for (int ks = 0; ks < KS; ++ks) { b[0][ks] = *(const bf16x8*)(bp + ks * 32); b[1][ks] = *(const bf16x8*)(bp + 4 * K + ks * 32); }
        f32x4 acc[4][2];
#pragma unroll
        for (int i = 0; i < 4; ++i) { acc[i][0] = (f32x4){0.f, 0.f, 0.f, 0.f}; acc[i][1] = (f32x4){0.f, 0.f, 0.f, 0.f}; }
#pragma unroll
        for (int ks = 0; ks < KS; ++ks)
#pragma unroll
            for (int i = 0; i < 4; ++i) { acc[i][0] = __builtin_amdgcn_mfma_f32_16x16x32_bf16(b[0][ks], a[i][ks], acc[i][0], 0, 0, 0); acc[i][1] = __builtin_amdgcn_mfma_f32_16x16x32_bf16(b[1][ks], a[i][ks], acc[i][1], 0, 0, 0); }
#pragma unroll
        for (int i = 0; i < 4; ++i) {
            const float v[8] = {acc[i][0][0], acc[i][0][1], acc[i][0][2], acc[i][0][3], acc[i][1][0], acc[i][1][1], acc[i][1][2], acc[i][1][3]};
            E.store8(m0 + 16 * i + fr, n0 + 8 * fq, v);
        }
    }
}


template <int K, class Epi>
__device__ __forceinline__ void meta_gemm16(const bf16* __restrict__ A, int lda, const bf16* __restrict__ Bt, int m0, int N, const Epi& E, int gw, int ngw, int lane) {
    const int fr = lane & 15, fq = lane >> 4;
    for (int ng = gw; ng < N / 32; ng += ngw) {
        const int n0 = ng * 32;
        const bf16* ap = A + (size_t)(m0 + fr) * lda + fq * 8;
        const bf16* bp = Bt + (size_t)(n0 + 8 * (fr >> 2) + (fr & 3)) * K + fq * 8;
        f32x4 acc0 = {0.f, 0.f, 0.f, 0.f}, acc1 = {0.f, 0.f, 0.f, 0.f};
#pragma unroll 8
        for (int k = 0; k < K; k += 32) { const bf16x8 a = *(const bf16x8*)(ap + k), b0 = *(const bf16x8*)(bp + k), b1 = *(const bf16x8*)(bp + 4 * K + k);
            acc0 = __builtin_amdgcn_mfma_f32_16x16x32_bf16(b0, a, acc0, 0, 0, 0); acc1 = __builtin_amdgcn_mfma_f32_16x16x32_bf16(b1, a, acc1, 0, 0, 0); }
        const float v[8] = {acc0[0], acc0[1], acc0[2], acc0[3], acc1[0], acc1[1], acc1[2], acc1[3]};
        E.store8(m0 + fr, n0 + 8 * fq, v);
    }
}

struct EpiZ { bf16* z;
    __device__ __forceinline__ void store8(int row, int col, const float (&v)[8]) const { if (col < NIN) *(u32x4*)(z + (size_t)row * ZLD + col) = pack8(v); } };
struct EpiQ { bf16* qm; const float* rs;
    __device__ __forceinline__ void store8(int row, int col, const float (&v_)[8]) const {
        const int h = col / 192, w = col - h * 192, b = row >> 11, s = row & 2047; const float r_ = rs[row];
        const float o[8] = {v_[0] * r_, v_[1] * r_, v_[2] * r_, v_[3] * r_, v_[4] * r_, v_[5] * r_, v_[6] * r_, v_[7] * r_};
        *(u32x4*)(qm + ((size_t)(b * 4 + h) * 2048 + s) * 192 + w) = pack8(o);
    } };
template <bool META> struct EpiKV { bf16* km; bf16* vm; const float* rs;
    __device__ __forceinline__ void store8(int row, int col, const float (&v_)[8]) const {
        if (META && row >= MROWS) return;
        const float r_ = rs[row]; const float v[8] = {v_[0] * r_, v_[1] * r_, v_[2] * r_, v_[3] * r_, v_[4] * r_, v_[5] * r_, v_[6] * r_, v_[7] * r_};
        const int h = col >> 8, w = col & 255; const u32x4 pk = pack8(v);
        if (!META) { const int b = row >> 11, key = row & 2047; const size_t r = (size_t)(b * 4 + h) * LKP + key;
            if (w < 128) *(u32x4*)(km + r * 192 + w) = pk; else *(u32x4*)(vm + r * 128 + (w - 128)) = pk;
        } else { const int key = 2048 + (row - NTOK);
            for (int b = 0; b < NB; ++b) { const size_t r = (size_t)(b * 4 + h) * LKP + key;
                if (w < 128) *(u32x4*)(km + r * 192 + w) = pk; else *(u32x4*)(vm + r * 128 + (w - 128)) = pk; } }
    } };
struct EpiO { bf16* y1; const bf16* h0;
    __device__ __forceinline__ void store8(int row, int col, const float (&v)[8]) const {
        float h[8]; unpack8(*(const u32x4*)(h0 + (size_t)row * DM + col), h);
        const float o[8] = {ALPHA * h[0] + v[0], ALPHA * h[1] + v[1], ALPHA * h[2] + v[2], ALPHA * h[3] + v[3], ALPHA * h[4] + v[4], ALPHA * h[5] + v[5], ALPHA * h[6] + v[6], ALPHA * h[7] + v[7]};
        *(u32x4*)(y1 + (size_t)row * DM + col) = pack8(o);
    } };
struct EpiLogit { float* logits; const float* bias;
    __device__ __forceinline__ void store8(int row, int col, const float (&v)[8]) const {
        float* y = logits + (size_t)row * NE + col;
        *(f32x4*)y = (f32x4){v[0] + bias[col], v[1] + bias[col + 1], v[2] + bias[col + 2], v[3] + bias[col + 3]};
        *(f32x4*)(y + 4) = (f32x4){v[4] + bias[col + 4], v[5] + bias[col + 5], v[6] + bias[col + 6], v[7] + bias[col + 7]};
    } };
namespace pg8 {
#define PG8_LAS __attribute__((address_space(3)))
typedef unsigned short bf16_t;
constexpr int BM = 256, BK = 64, HALF = 128, HTB = HALF * BK * 2, STAGE_BYTES = 8 * HTB, NXCD = 8, WGM = 8;
__host__ __device__ __forceinline__ int lds_byte(int r, int c) { const int st = (r >> 4) * 2 + (c >> 5), rr = r & 15, cc = c & 31, ob = rr * 64 + cc * 2; return st * 1024 + (ob ^ (((ob >> 9) & 1) << 5)); }
__host__ __device__ __forceinline__ void stage_rc(int b, int& R, int& C) { const int st = b / 1024, sb = b % 1024, swz = sb ^ (((sb >> 9) & 1) << 5); R = (st >> 1) * 16 + swz / 64; C = (st & 1) * 32 + (swz % 64) / 2; }
__host__ __device__ __forceinline__ int perm32(int rho) { const int n = rho >> 4, i = rho & 15; return 8 * (i >> 2) + 4 * n + (i & 3); }
struct Unit { int pm, pn, ui; };
struct Gemm { const bf16_t* A; const bf16_t* Bt; int M, N, K, lda; const int* row_tok; };
struct StaticOrder {
    int nM, nN, nwg, G, c;
    __host__ __device__ void init(int M, int N, int G_, int c_) { nM = M / BM; nN = N / BM; nwg = nM * nN; G = G_; c = c_; }
    __host__ __device__ bool next(int i, Unit& u) const {
        const long L = (long)i * G + c; if (L >= nwg) return false;
        int wgid = (int)L; { const int q = nwg / NXCD, r = nwg % NXCD, xcd = wgid % NXCD, off = wgid / NXCD; wgid = (xcd < r ? xcd * (q + 1) : r * (q + 1) + (xcd - r) * q) + off; }
        const int nig = WGM * nN, gid = wgid / nig, fm = gid * WGM, gsz = (nM - fm) < WGM ? (nM - fm) : WGM;
        u.pm = fm + ((wgid % nig) % gsz); u.pn = (wgid % nig) / gsz; u.ui = i; return true;
    }
    __device__ __forceinline__ void a_ready(const Unit&) const {}
    __device__ __forceinline__ void done(const Unit&) const {}
};
struct MoeOrder {
    StaticOrder so; const PG8_LAS int* tile_expert;
    __device__ void init(int tiles, int nN, int G_, int c_, const PG8_LAS int* te) { so.nM = tiles; so.nN = nN; so.nwg = tiles * nN; so.G = G_; so.c = c_; tile_expert = te; }
    __device__ bool next(int i, Unit& u) const { if (!so.next(i, u)) return false; u.pn += tile_expert[u.pm] * so.nN; return true; }
    __device__ __forceinline__ void a_ready(const Unit&) const {}
    __device__ __forceinline__ void done(const Unit&) const {}
};
template <class E8> struct EpiAdapt {
    static constexpr bool PERM = true, AFTER_DRAIN = false;
    E8 e; int ncols_mod;
    __device__ __forceinline__ void operator()(const f32x4 (&acc)[2][2][4][2], const Unit& u, int wr, int wc, int fr, int fq) const {
        const int row0 = u.pm * BM + wr * 64 + fr; int colt = u.pn * BM; if (ncols_mod) colt %= ncols_mod;
        const int col0 = colt + wc * 32 + 8 * fq;
#pragma unroll
        for (int ai = 0; ai < 2; ++ai)
#pragma unroll
            for (int m = 0; m < 4; ++m)
#pragma unroll
                for (int bj = 0; bj < 2; ++bj) {
                    const float v[8] = {acc[ai][bj][m][0][0], acc[ai][bj][m][0][1], acc[ai][bj][m][0][2], acc[ai][bj][m][0][3], acc[ai][bj][m][1][0], acc[ai][bj][m][1][1], acc[ai][bj][m][1][2], acc[ai][bj][m][1][3]};
                    e.store8(row0 + ai * HALF + m * 16, col0 + bj * HALF, v); }
    }
};
struct NoHook { static constexpr bool ON = false; __device__ __forceinline__ void mid(f32x4 (&)[2][2][4][2], const Unit&, int, int) const {} };
template <class Epi, class Sched, bool ALIGN_EPI = false, bool SP2 = false, bool F8 = false, bool GATHER = false, class Hook = NoHook>
__device__ __forceinline__ void gemm_phase(PG8_LAS unsigned char* lds, const Gemm g, const Sched& S, const Epi& E, const Hook& H = Hook()) {
    const int tid = threadIdx.x, wid = __builtin_amdgcn_readfirstlane(tid >> 6), lane = tid & 63, wr = wid >> 2, wc = wid & 3, fr = lane & 15, fq = lane >> 4;
    const int K = g.K, nt = K / BK;
    unsigned voffA[2], voffB[2];
#pragma unroll
    for (int i = 0; i < 2; ++i) { int R, C; stage_rc(tid * 16 + i * 8192, R, C); const int Rb = Epi::PERM ? ((R & ~31) + perm32(R & 31)) : R;
        voffA[i] = (unsigned)(R * g.lda + C) * 2u; voffB[i] = (unsigned)(Rb * K + C) * 2u; }
    int gR[2]; unsigned gC[2];
#pragma unroll
    for (int i = 0; i < 2; ++i) { int R, C; stage_rc(tid * 16 + i * 8192, R, C); gR[i] = R; gC[i] = (unsigned)C * 2u; }
    const unsigned lda2 = (unsigned)g.lda * 2u;
    unsigned vC[2][2], vN[2][2]; int tkn[2][2];
    static_assert(!GATHER || SP2, "GATHER is written for the SP2 loop");
#define PG8_TOKLD(dst, pm_) do { _Pragma("unroll") for (int h_ = 0; h_ < 2; ++h_) _Pragma("unroll") for (int i_ = 0; i_ < 2; ++i_) dst[h_][i_] = g.row_tok[(pm_) * 256 + h_ * 128 + gR[i_]]; } while (0)
#define PG8_TOKOFF(dst, src) do { _Pragma("unroll") for (int h_ = 0; h_ < 2; ++h_) _Pragma("unroll") for (int i_ = 0; i_ < 2; ++i_) dst[h_][i_] = (unsigned)src[h_][i_] * lda2 + gC[i_]; } while (0)
    const size_t kstep = (size_t)(BK * 2);
    const size_t hstep = (size_t)HALF * K * 2, hstepA = (size_t)HALF * g.lda * 2;
    const size_t tstep = 2 * hstep, tstepA = 2 * hstepA;
    const unsigned ldsw = (unsigned)wid * 1024u;
    const int aoff = lds_byte(wr * 64 + fr, fq * 8), boff = lds_byte(wc * 32 + fr, fq * 8);
#define PG8_SA(b, h) (((b) * 2 + (h)) * HTB)
#define PG8_SB(b, h) ((4 + (b) * 2 + (h)) * HTB)
#define PG8_STAGE(bufoff, gbase, voff) do { _Pragma("unroll") for (int _i = 0; _i < 2; ++_i) \
        __builtin_amdgcn_global_load_lds((const unsigned*)((const char*)(gbase) + (voff)[_i]), (PG8_LAS unsigned*)(lds + (bufoff) + ldsw + _i * 8192), 16, 0, 0); } while (0)
#define PG8_LDA(dst, b, h) do { _Pragma("unroll") for (int m = 0; m < 4; ++m) _Pragma("unroll") for (int k = 0; k < 2; ++k) dst[m][k] = *(const PG8_LAS bf16x8*)(lds + PG8_SA(b, h) + aoff + m * 2048 + k * 1024); } while (0)
#define PG8_LDB(dst, b, h) do { _Pragma("unroll") for (int n = 0; n < 2; ++n) _Pragma("unroll") for (int k = 0; k < 2; ++k) dst[n][k] = *(const PG8_LAS bf16x8*)(lds + PG8_SB(b, h) + boff + n * 2048 + k * 1024); } while (0)
#define PG8_F8CAT(x) __builtin_shufflevector(__builtin_bit_cast(u32x4, (x)[0]), __builtin_bit_cast(u32x4, (x)[1]), 0, 1, 2, 3, 4, 5, 6, 7)
#define PG8_MMA(ai, bj, At, Bt) do { __builtin_amdgcn_s_setprio(1); if constexpr (F8) { _Pragma("unroll") for (int m = 0; m < 4; ++m) _Pragma("unroll") for (int n = 0; n < 2; ++n) \
        acc[ai][bj][m][n] = __builtin_amdgcn_mfma_scale_f32_16x16x128_f8f6f4(__builtin_bit_cast(v8i, PG8_F8CAT(Bt[n])), __builtin_bit_cast(v8i, PG8_F8CAT(At[m])), acc[ai][bj][m][n], 0, 0, 0, 0x7f7f7f7f, 0, 0x7f7f7f7f); \
        _Pragma("unroll") for (int m = 0; m < 4; ++m) _Pragma("unroll") for (int n = 0; n < 2; ++n) asm volatile("" : "+v"(acc[ai][bj][m][n])); } \
    else { _Pragma("unroll") for (int m = 0; m < 4; ++m) _Pragma("unroll") for (int n = 0; n < 2; ++n) _Pragma("unroll") for (int k = 0; k < 2; ++k) \
        acc[ai][bj][m][n] = __builtin_amdgcn_mfma_f32_16x16x32_bf16(Bt[n][k], At[m][k], acc[ai][bj][m][n], 0, 0, 0); } __builtin_amdgcn_s_setprio(0); } while (0)
#define PG8_WAIT_V(n) asm volatile("s_waitcnt vmcnt(" #n ")" ::: "memory")
#define PG8_WAIT_L(n) asm volatile("s_waitcnt lgkmcnt(" #n ")" ::: "memory")
#define PG8_BAR __builtin_amdgcn_s_barrier()
#define PG8_SCHED __builtin_amdgcn_sched_barrier(0)
    Unit cur, nxt; int ui = 0;
    if (!S.next(0, cur)) return;
    f32x4 acc[2][2][4][2];
#pragma unroll
    for (int a = 0; a < 2; ++a)
#pragma unroll
        for (int b = 0; b < 2; ++b)
#pragma unroll
            for (int m = 0; m < 4; ++m)
#pragma unroll
                for (int n = 0; n < 2; ++n) acc[a][b][m][n] = (f32x4){0.f, 0.f, 0.f, 0.f};
    bf16x8 At[4][2], B0[2][2], B1[2][2];
    const char* const gA = (const char*)g.A;
    const char* cA = (const char*)g.A + (size_t)cur.pm * tstepA; const char* cB = (const char*)g.Bt + (size_t)cur.pn * tstep;
    S.a_ready(cur);
    if constexpr (SP2) {
        if constexpr (GATHER) { PG8_TOKLD(tkn, cur.pm); PG8_TOKOFF(vC, tkn); Unit u1_; if (S.next(1, u1_)) { PG8_TOKLD(tkn, u1_.pm); PG8_TOKOFF(vN, tkn); } else { PG8_TOKOFF(vN, tkn); } }
        PG8_STAGE(PG8_SB(0, 0), cB, voffB); PG8_STAGE(PG8_SB(0, 1), cB + hstep, voffB);
        if constexpr (GATHER) { PG8_STAGE(PG8_SA(0, 0), gA, vC[0]); PG8_STAGE(PG8_SA(0, 1), gA, vC[1]); } else { PG8_STAGE(PG8_SA(0, 0), cA, voffA); PG8_STAGE(PG8_SA(0, 1), cA + hstepA, voffA); }
        if (wr == 1) PG8_BAR;
        PG8_WAIT_V(2); PG8_BAR;
        PG8_STAGE(PG8_SB(1, 0), cB + kstep, voffB); if constexpr (GATHER) { PG8_STAGE(PG8_SA(1, 0), gA + kstep, vC[0]); } else { PG8_STAGE(PG8_SA(1, 0), cA + kstep, voffA); } PG8_STAGE(PG8_SB(1, 1), cB + hstep + kstep, voffB);
        PG8_WAIT_V(6); PG8_BAR;
    } else {
        PG8_STAGE(PG8_SB(0, 0), cB, voffB); PG8_STAGE(PG8_SA(0, 0), cA, voffA); PG8_STAGE(PG8_SB(0, 1), cB + hstep, voffB); PG8_STAGE(PG8_SA(0, 1), cA + hstepA, voffA);
        if (wr == 1) PG8_BAR;
        PG8_WAIT_V(4); PG8_BAR;
        PG8_STAGE(PG8_SB(1, 0), cB + kstep, voffB); PG8_STAGE(PG8_SA(1, 0), cA + kstep, voffA); PG8_STAGE(PG8_SB(1, 1), cB + hstep + kstep, voffB);
        PG8_WAIT_V(6); PG8_BAR;
    }
    for (;;) {
        const bool has_next = S.next(ui + 1, nxt);
        const char* nA = has_next ? (const char*)g.A + (size_t)nxt.pm * tstepA : cA; const char* nB = has_next ? (const char*)g.Bt + (size_t)nxt.pn * tstep : cB;
        for (int t = 0; t < nt; t += 2) {
            const bool last = (t == nt - 2);
            const char* a1 = cA + (size_t)(t + 1) * kstep;
            const char* a2 = last ? nA : cA + (size_t)(t + 2) * kstep; const char* b2 = last ? nB : cB + (size_t)(t + 2) * kstep;
            const char* a3 = a2 + kstep; const char* b3 = b2 + kstep;
            if (last && has_next) S.a_ready(nxt);
            if constexpr (Hook::ON) { if (t == nt / 2) H.mid(acc, cur, wr, fr); }
            if constexpr (SP2) {
            const char* ga1 = gA + (size_t)(t + 1) * kstep; const char* ga2 = gA + (last ? (size_t)0 : (size_t)(t + 2) * kstep); const char* ga3 = ga2 + kstep;
            unsigned v2[2][2];
            if constexpr (GATHER) { _Pragma("unroll") for (int h_ = 0; h_ < 2; ++h_) _Pragma("unroll") for (int i_ = 0; i_ < 2; ++i_) v2[h_][i_] = last ? vN[h_][i_] : vC[h_][i_]; }
            PG8_LDB(B0, 0, 0); PG8_LDB(B1, 0, 1); PG8_SCHED; PG8_LDA(At, 0, 0); if constexpr (GATHER) { PG8_STAGE(PG8_SA(1, 1), ga1, vC[1]); } else { PG8_STAGE(PG8_SA(1, 1), a1 + hstepA, voffA); }
            PG8_WAIT_V(8); PG8_WAIT_L(0); PG8_BAR; PG8_MMA(0, 0, At, B0); PG8_MMA(0, 1, At, B1); PG8_BAR; PG8_SCHED;
            PG8_LDA(At, 0, 1); PG8_STAGE(PG8_SB(0, 0), b2, voffB); PG8_STAGE(PG8_SB(0, 1), b2 + hstep, voffB); if constexpr (GATHER) { PG8_STAGE(PG8_SA(0, 0), ga2, v2[0]); } else { PG8_STAGE(PG8_SA(0, 0), a2, voffA); }
            PG8_WAIT_V(8); PG8_WAIT_L(0); PG8_BAR; PG8_MMA(1, 0, At, B0); PG8_MMA(1, 1, At, B1); PG8_BAR; PG8_SCHED;
            PG8_LDB(B0, 1, 0); PG8_LDB(B1, 1, 1); PG8_SCHED; PG8_LDA(At, 1, 0); if constexpr (GATHER) { PG8_STAGE(PG8_SA(0, 1), ga2, v2[1]); } else { PG8_STAGE(PG8_SA(0, 1), a2 + hstepA, voffA); }
            PG8_WAIT_V(8); PG8_WAIT_L(0); PG8_BAR; PG8_MMA(0, 0, At, B0); PG8_MMA(0, 1, At, B1); PG8_BAR; PG8_SCHED;
            PG8_LDA(At, 1, 1); PG8_STAGE(PG8_SB(1, 0), b3, voffB); PG8_STAGE(PG8_SB(1, 1), b3 + hstep, voffB); if constexpr (GATHER) { PG8_STAGE(PG8_SA(1, 0), ga3, v2[0]); } else { PG8_STAGE(PG8_SA(1, 0), a3, voffA); }
            PG8_WAIT_V(8); PG8_WAIT_L(0); PG8_BAR; PG8_MMA(1, 0, At, B0); PG8_MMA(1, 1, At, B1); PG8_BAR; PG8_SCHED;
            } else {
            PG8_LDB(B0, 0, 0); PG8_SCHED; PG8_LDA(At, 0, 0); PG8_STAGE(PG8_SA(1, 1), a1 + hstepA, voffA);
            PG8_WAIT_L(8); PG8_BAR; PG8_WAIT_L(0); PG8_MMA(0, 0, At, B0); PG8_BAR; PG8_SCHED;
            PG8_LDB(B1, 0, 1); PG8_STAGE(PG8_SB(0, 0), b2, voffB);
            PG8_BAR; PG8_WAIT_L(0); PG8_MMA(0, 1, At, B1); PG8_BAR;
            PG8_LDA(At, 0, 1); PG8_STAGE(PG8_SA(0, 0), a2, voffA);
            PG8_BAR; PG8_WAIT_L(0); PG8_MMA(1, 0, At, B0); PG8_BAR; PG8_SCHED;
            PG8_STAGE(PG8_SB(0, 1), b2 + hstep, voffB);
            PG8_WAIT_V(6); PG8_BAR; PG8_MMA(1, 1, At, B1); PG8_BAR;
            PG8_LDB(B0, 1, 0); PG8_SCHED; PG8_LDA(At, 1, 0); PG8_STAGE(PG8_SA(0, 1), a2 + hstepA, voffA);
            PG8_WAIT_L(8); PG8_BAR; PG8_WAIT_L(0); PG8_MMA(0, 0, At, B0); PG8_BAR; PG8_SCHED;
            PG8_LDB(B1, 1, 1); PG8_STAGE(PG8_SB(1, 0), b3, voffB);
            PG8_BAR; PG8_WAIT_L(0); PG8_MMA(0, 1, At, B1); PG8_BAR;
            PG8_LDA(At, 1, 1); PG8_STAGE(PG8_SA(1, 0), a3, voffA);
            PG8_BAR; PG8_WAIT_L(0); PG8_MMA(1, 0, At, B0); PG8_BAR; PG8_SCHED;
            PG8_STAGE(PG8_SB(1, 1), b3 + hstep, voffB);
            PG8_WAIT_V(6); PG8_BAR; PG8_MMA(1, 1, At, B1); PG8_BAR;
            }
        }
        if constexpr (ALIGN_EPI) { if (wr == 0) PG8_BAR; }
        bool has_nn = false;
        if constexpr (GATHER) { Unit nn_; has_nn = has_next && S.next(ui + 2, nn_); if (has_nn) PG8_TOKLD(tkn, nn_.pm); }
        if constexpr (!Epi::AFTER_DRAIN) { E(acc, cur, wr, wc, fr, fq); S.done(cur); }
        if (!has_next) break;
        if constexpr (GATHER) { _Pragma("unroll") for (int h_ = 0; h_ < 2; ++h_) _Pragma("unroll") for (int i_ = 0; i_ < 2; ++i_) vC[h_][i_] = vN[h_][i_]; if (has_nn) PG8_TOKOFF(vN, tkn); }
#pragma unroll
        for (int a = 0; a < 2; ++a)
#pragma unroll
            for (int b = 0; b < 2; ++b)
#pragma unroll
                for (int m = 0; m < 4; ++m)
#pragma unroll
                    for (int n = 0; n < 2; ++n) acc[a][b][m][n] = (f32x4){0.f, 0.f, 0.f, 0.f};
        cur = nxt; cA = nA; cB = nB; ++ui;
        if constexpr (ALIGN_EPI) { if (wr == 1) PG8_BAR; }
    }
    PG8_WAIT_V(0);
    if constexpr (!ALIGN_EPI) { if (wr == 0) PG8_BAR; }
    PG8_BAR;
#undef PG8_SA
#undef PG8_SB
#undef PG8_STAGE
#undef PG8_LDA
#undef PG8_LDB
#undef PG8_MMA
#undef PG8_F8CAT
#undef PG8_TOKLD
#undef PG8_TOKOFF
#undef PG8_WAIT_V
#undef PG8_WAIT_L
#undef PG8_BAR
#undef PG8_SCHED
}
}

__device__ __forceinline__ u32x4 f8_pair16(u32x2 rowA, u32x2 rowB) {
    const auto s0 = __builtin_amdgcn_permlane16_swap(rowA.x, rowB.x, false, false), s1 = __builtin_amdgcn_permlane16_swap(rowA.y, rowB.y, false, false);
    return (u32x4){s0[0], s1[0], s0[1], s1[1]};
}
struct EpiGU8 { static constexpr bool PERM = true, AFTER_DRAIN = false;
    unsigned char* act8; const float* bgu;
    __device__ __forceinline__ void operator()(const f32x4 (&acc)[2][2][4][2], const pg8::Unit& u, int wr, int wc, int fr, int fq) const {
        const int e = u.pn >> 3, ac0 = 128 * (u.pn & 7) + wc * 32 + 8 * fq;
        const float* bb = bgu + (size_t)e * 2048 + 2 * ac0;
        const f32x4 q0 = *(const f32x4*)bb, q1 = *(const f32x4*)(bb + 4), q2 = *(const f32x4*)(bb + 8), q3 = *(const f32x4*)(bb + 12);
        const float bg[8] = {q0[0], q0[2], q1[0], q1[2], q2[0], q2[2], q3[0], q3[2]}, bl[8] = {q0[1], q0[3], q1[1], q1[3], q2[1], q2[3], q3[1], q3[3]};
        const int odd = fq & 1, acs = ac0 - 8 * odd;
#pragma unroll
        for (int ai = 0; ai < 2; ++ai)
#pragma unroll
            for (int mp = 0; mp < 2; ++mp) { u32x2 pk[2];
#pragma unroll
                for (int h = 0; h < 2; ++h) { const int m = 2 * mp + h; float o[8];
#pragma unroll
                    for (int t = 0; t < 8; t += 2) {
                        const f32x2 ag = {acc[ai][0][m][t >> 2][t & 3], acc[ai][0][m][(t + 1) >> 2][(t + 1) & 3]}, al = {acc[ai][1][m][t >> 2][t & 3], acc[ai][1][m][(t + 1) >> 2][(t + 1) & 3]};
                        f32x2 xg = ag * W8_INV + (f32x2){bg[t], bg[t + 1]}, xl = al * W8_INV + (f32x2){bl[t], bl[t + 1]};
                        xg.x = fminf(xg.x, 7.f); xg.y = fminf(xg.y, 7.f); xl.x = __builtin_amdgcn_fmed3f(xl.x, -7.f, 7.f); xl.y = __builtin_amdgcn_fmed3f(xl.y, -7.f, 7.f);
                        const f32x2 ex = xg * (-1.702f * 1.4426950408889634f); f32x2 dn; dn.x = __builtin_amdgcn_exp2f(ex.x); dn.y = __builtin_amdgcn_exp2f(ex.y); dn = dn + 1.f;
                        f32x2 sg; sg.x = __builtin_amdgcn_rcpf(dn.x); sg.y = __builtin_amdgcn_rcpf(dn.y);
                        const f32x2 pq = xg * sg, ov = pq * xl + pq; o[t] = ov.x; o[t + 1] = ov.y; }
                    pk[h] = (u32x2){pack4_f8(o[0], o[1], o[2], o[3]), pack4_f8(o[4], o[5], o[6], o[7])}; }
                const int row = u.pm * 256 + ai * 128 + wr * 64 + (2 * mp + odd) * 16 + fr;
                *(u32x4*)(act8 + (size_t)row * DM + acs) = f8_pair16(pk[0], pk[1]); }
    } };
constexpr float O2_SCALE = 8.f, O2_INV = 1.f / 8.f;
struct EpiDN8 { static constexpr bool PERM = true, AFTER_DRAIN = false;
    unsigned char* out2; const float* bdn; const float* row_gate;
    __device__ __forceinline__ void operator()(const f32x4 (&acc)[2][2][4][2], const pg8::Unit& u, int wr, int wc, int fr, int fq) const {
        const int e = u.pn >> 2, c0 = 256 * (u.pn & 3) + wc * 32 + 8 * fq;
        f32x4 bv[2][2];
#pragma unroll
        for (int bj = 0; bj < 2; ++bj) { bv[bj][0] = *(const f32x4*)(bdn + (size_t)e * DM + c0 + bj * 128); bv[bj][1] = *(const f32x4*)(bdn + (size_t)e * DM + c0 + bj * 128 + 4); }
        const int odd = fq & 1, cs = c0 - 8 * odd;
#pragma unroll
        for (int ai = 0; ai < 2; ++ai)
#pragma unroll
            for (int mp = 0; mp < 2; ++mp) { u32x2 pk[2][2];
#pragma unroll
                for (int h = 0; h < 2; ++h) { const int m = 2 * mp + h; const float g = row_gate[u.pm * 256 + ai * 128 + wr * 64 + m * 16 + fr] * O2_SCALE;
#pragma unroll
                    for (int bj = 0; bj < 2; ++bj) { const f32x4 v0 = (acc[ai][bj][m][0] * W8_INV + bv[bj][0]) * g, v1 = (acc[ai][bj][m][1] * W8_INV + bv[bj][1]) * g;
                        pk[bj][h] = (u32x2){pack4_f8(v0[0], v0[1], v0[2], v0[3]), pack4_f8(v1[0], v1[1], v1[2], v1[3])}; } }
                const int row = u.pm * 256 + ai * 128 + wr * 64 + (2 * mp + odd) * 16 + fr;
#pragma unroll
                for (int bj = 0; bj < 2; ++bj) *(u32x4*)(out2 + (size_t)row * DM + cs + bj * 128) = f8_pair16(pk[bj][0], pk[bj][1]); }
    } };

struct HookO { static constexpr bool ON = true; const LAS f32x2* T;
    __device__ __forceinline__ void mid(f32x4 (&acc)[2][2][4][2], const pg8::Unit& u, int wr, int fr) const {
#pragma unroll
        for (int ai = 0; ai < 2; ++ai)
#pragma unroll
            for (int m = 0; m < 4; ++m) { const float r = T[u.ui * 256 + ai * 128 + wr * 64 + m * 16 + fr].x;
#pragma unroll
                for (int bj = 0; bj < 2; ++bj) { acc[ai][bj][m][0] = acc[ai][bj][m][0] * r; acc[ai][bj][m][1] = acc[ai][bj][m][1] * r; } }
    } };
struct EpiOF { static constexpr bool PERM = true, AFTER_DRAIN = false;
    bf16* y1; const bf16* h0; const LAS f32x2* T;
    __device__ __forceinline__ void operator()(const f32x4 (&acc)[2][2][4][2], const pg8::Unit& u, int wr, int wc, int fr, int fq) const {
        const int c0 = u.pn * 256 + wc * 32 + 8 * fq;
#pragma unroll
        for (int ai = 0; ai < 2; ++ai)
#pragma unroll
            for (int m = 0; m < 4; ++m) { const int rl = ai * 128 + wr * 64 + m * 16 + fr, row = u.pm * 256 + rl; const float r = T[u.ui * 256 + rl].y;
#pragma unroll
                for (int bj = 0; bj < 2; ++bj) { float h[8]; unpack8(*(const u32x4*)(h0 + (size_t)row * DM + c0 + bj * 128), h);
                    const f32x4 a = acc[ai][bj][m][0] * r, b = acc[ai][bj][m][1] * r;
                    const float o[8] = {ALPHA * h[0] + a[0], ALPHA * h[1] + a[1], ALPHA * h[2] + a[2], ALPHA * h[3] + a[3], ALPHA * h[4] + b[0], ALPHA * h[5] + b[1], ALPHA * h[6] + b[2], ALPHA * h[7] + b[3]};
                    *(u32x4*)(y1 + (size_t)row * DM + c0 + bj * 128) = pack8(o); } }
    } };
#ifndef FAST_Z
#define FAST_Z 1
#endif
#ifndef FAST_O
#define FAST_O 1
#endif

struct MapId { __device__ __forceinline__ int operator()(int n) const { return n; } };
struct MapIn { __device__ __forceinline__ int operator()(int n) const {
    if (n >= 384 && n < 448) { const int l = n - 384; return 384 + 2 * (l & 31) + (l >> 5); }
    if (n >= 448 && n < 1216) { const int l = n - 448, hd = l >> 7, d = l & 127; return 448 + hd * 128 + (d >> 6) * 64 + 2 * (d & 31) + ((d >> 5) & 1); }
    return n; } };
struct MapQ { __device__ __forceinline__ int operator()(int n) const { const int h = n / 192, w = n - h * 192; if (w < 128) return n; const int l = w - 128; return h * 192 + 128 + 2 * (l & 31) + (l >> 5); } };
struct MapGU { __device__ __forceinline__ int operator()(int n) const { const int a = n >> 1; return 256 * (a >> 7) + 128 * (n & 1) + (a & 127); } };
template <class Map>
__device__ __forceinline__ void transpose_item(const float* __restrict__ W, int K, int N, bf16* __restrict__ WT, LAS float* scr, int item, int lane, const Map& map, const float* __restrict__ kscale = nullptr, int ldo = 0, const float* __restrict__ kscale2 = nullptr) {
    if (ldo == 0) ldo = K;
    const int nblk = N / 32, kb = item / nblk, nb = item - kb * nblk, k0 = 64 * kb, n0 = 32 * nb;
#pragma unroll 8
    for (int i = 0; i < 32; ++i) { const int kk = 2 * i + (lane >> 5); scr[kk * 33 + (lane & 31)] = (k0 < K) ? W[(size_t)(k0 + kk) * N + n0 + (lane & 31)] * (kscale ? ((kscale2 && k0 + kk >= 512) ? kscale2[k0 + kk - 512] : kscale[k0 + kk]) : 1.f) : 0.f; }
    LDS_WAIT(); asm volatile("" ::: "memory");
    const int c = lane & 7;
#pragma unroll
    for (int j = 0; j < 4; ++j) { const int n = (lane >> 3) + 8 * j; const LAS float* s = scr + (8 * c) * 33 + n;
        u32x4 o; o.x = cvtpk(s[0 * 33], s[1 * 33]); o.y = cvtpk(s[2 * 33], s[3 * 33]); o.z = cvtpk(s[4 * 33], s[5 * 33]); o.w = cvtpk(s[6 * 33], s[7 * 33]);
        *(u32x4*)(WT + (size_t)map(n0 + n) * ldo + k0 + 8 * c) = o; }
    LDS_WAIT(); asm volatile("" ::: "memory");
}

template <class Map>
__device__ __forceinline__ void transpose_item_f8(const float* __restrict__ W, int K, int N, unsigned char* __restrict__ WT, LAS float* scr, int item, int lane, const Map& map, float scale) {
    const int nblk = N / 32, kb = item / nblk, nb = item - kb * nblk, k0 = 64 * kb, n0 = 32 * nb;
#pragma unroll 8
    for (int i = 0; i < 8; ++i) { const int kk = 8 * i + (lane >> 3), c4 = (lane & 7) * 4; const f32x4 w4 = *(const f32x4*)(W + (size_t)(k0 + kk) * N + n0 + c4) * scale;
        LAS float* d_ = scr + kk * 33 + c4; d_[0] = w4[0]; d_[1] = w4[1]; d_[2] = w4[2]; d_[3] = w4[3]; }
    LDS_WAIT(); asm volatile("" ::: "memory");
    const int n = lane >> 1;
#pragma unroll
    for (int j = 0; j < 2; ++j) { const int c = 2 * (lane & 1) + j; const LAS float* s_ = scr + (16 * c) * 33 + n;
        u32x4 o; o.x = pack4_f8(s_[0 * 33], s_[1 * 33], s_[2 * 33], s_[3 * 33]); o.y = pack4_f8(s_[4 * 33], s_[5 * 33], s_[6 * 33], s_[7 * 33]);
        o.z = pack4_f8(s_[8 * 33], s_[9 * 33], s_[10 * 33], s_[11 * 33]); o.w = pack4_f8(s_[12 * 33], s_[13 * 33], s_[14 * 33], s_[15 * 33]);
        *(u32x4*)(WT + (size_t)map(n0 + n) * K + k0 + 16 * c) = o; }
    LDS_WAIT(); asm volatile("" ::: "memory");
}

template <class Map>
__device__ __forceinline__ void transpose_f8_stream(const float* __restrict__ Wall, int N, unsigned char* __restrict__ WTall, LAS float* scr, int gw, int ngw, int lane, const Map& map, float scale) {
    const int nblk = N / 32, per = 16 * nblk, n_items = NE * per;
#define T8_LOAD(dst, it_) do { const int e_ = (it_) / per, r_ = (it_) - e_ * per, kb_ = r_ / nblk, nb_ = r_ - kb_ * nblk; \
        const float* wp_ = Wall + ((size_t)e_ * 1024 + 64 * kb_ + (lane >> 3)) * N + 32 * nb_ + (lane & 7) * 4; \
        _Pragma("unroll") for (int i = 0; i < 8; ++i) dst[i] = *(const f32x4*)(wp_ + (size_t)(8 * i) * N); } while (0)
    f32x4 cur[8], nxt[8];
    int it = gw; if (it < n_items) T8_LOAD(cur, it);
    for (; it < n_items; it += ngw) {
        const int itn = it + ngw; if (itn < n_items) T8_LOAD(nxt, itn);
        const int e = it / per, r = it - e * per, kb = r / nblk, nb = r - kb * nblk, k0 = 64 * kb, n0 = 32 * nb;
#pragma unroll
        for (int i = 0; i < 8; ++i) { LAS float* d_ = scr + (8 * i + (lane >> 3)) * 33 + (lane & 7) * 4; const f32x4 w4 = cur[i] * scale; d_[0] = w4[0]; d_[1] = w4[1]; d_[2] = w4[2]; d_[3] = w4[3]; }
        LDS_WAIT(); asm volatile("" ::: "memory");
        const int n = lane >> 1;
#pragma unroll
        for (int j = 0; j < 2; ++j) { const int c = 2 * (lane & 1) + j; const LAS float* s_ = scr + (16 * c) * 33 + n;
            u32x4 o; o.x = pack4_f8(s_[0 * 33], s_[1 * 33], s_[2 * 33], s_[3 * 33]); o.y = pack4_f8(s_[4 * 33], s_[5 * 33], s_[6 * 33], s_[7 * 33]);
            o.z = pack4_f8(s_[8 * 33], s_[9 * 33], s_[10 * 33], s_[11 * 33]); o.w = pack4_f8(s_[12 * 33], s_[13 * 33], s_[14 * 33], s_[15 * 33]);
            *(u32x4*)(WTall + ((size_t)e * N + map(n0 + n)) * 1024 + k0 + 16 * c) = o; }
        LDS_WAIT(); asm volatile("" ::: "memory");
#pragma unroll
        for (int i = 0; i < 8; ++i) cur[i] = nxt[i];
    }
#undef T8_LOAD
}
__device__ __forceinline__ void ln_row_f32_to_bf16(f32x4 (&v)[4], const f32x4 (&gg)[4], const f32x4 (&bb)[4], bf16* __restrict__ orow, int lane) {
    float s = 0.f;
#pragma unroll
    for (int j = 0; j < 4; ++j) s += (v[j].x + v[j].y) + (v[j].z + v[j].w);
    const float mean = wave_sum(s) * (1.f / DM); float s2 = 0.f;
#pragma unroll
    for (int j = 0; j < 4; ++j) { v[j] = v[j] - mean; s2 += (v[j].x * v[j].x + v[j].y * v[j].y) + (v[j].z * v[j].z + v[j].w * v[j].w); }
    const float rstd = rsq(wave_sum(s2) * (1.f / DM) + LN_EPS);
#pragma unroll
    for (int j = 0; j < 4; ++j) { const f32x4 o = v[j] * rstd * gg[j] + bb[j]; ((u32x2*)orow)[lane + 64 * j] = (u32x2){cvtpk(o.x, o.y), cvtpk(o.z, o.w)}; }
}

__device__ __forceinline__ void ln_row_bf16(const bf16* __restrict__ yrow, const f32x4 (&G4)[4], const f32x4 (&B4)[4], bf16* __restrict__ orow, unsigned char* __restrict__ o8, int lane) {
    float v[16]; unpack8(*(const u32x4*)(yrow + 8 * lane), *(float(*)[8])&v[0]); unpack8(*(const u32x4*)(yrow + 512 + 8 * lane), *(float(*)[8])&v[8]);
    float s = 0.f;
#pragma unroll
    for (int j = 0; j < 16; ++j) s += v[j];
    const float mean = wave_sum(s) * (1.f / DM); float s2 = 0.f;
#pragma unroll
    for (int j = 0; j < 16; ++j) { v[j] -= mean; s2 += v[j] * v[j]; }
    const float rstd = rsq(wave_sum(s2) * (1.f / DM) + LN_EPS);
#pragma unroll
    for (int hf = 0; hf < 2; ++hf) { const f32x4 a = (f32x4){v[hf * 8 + 0], v[hf * 8 + 1], v[hf * 8 + 2], v[hf * 8 + 3]} * rstd * G4[2 * hf] + B4[2 * hf], b = (f32x4){v[hf * 8 + 4], v[hf * 8 + 5], v[hf * 8 + 6], v[hf * 8 + 7]} * rstd * G4[2 * hf + 1] + B4[2 * hf + 1];
        *(u32x4*)(orow + hf * 512 + 8 * lane) = (u32x4){cvtpk(a[0], a[1]), cvtpk(a[2], a[3]), cvtpk(b[0], b[1]), cvtpk(b[2], b[3])};
        *(u32x2*)(o8 + hf * 512 + 8 * lane) = (u32x2){pack4_f8(a[0], a[1], a[2], a[3]), pack4_f8(b[0], b[1], b[2], b[3])}; }
}
__device__ __forceinline__ void zero_bytes(void* p, size_t bytes, int gtid, int ngt) {
    u32x4* q = (u32x4*)p; const size_t n = bytes / 16;
    for (size_t i = gtid; i < n; i += ngt) q[i] = (u32x4){0u, 0u, 0u, 0u};
}
__device__ __forceinline__ void sincos_d(float angf, float& sn, float& cs) {
    const double x = (double)angf; const double q = __builtin_rint(x * 0.63661977236758134308);
    const double r = (x - q * 1.57079632679489655800) - q * 6.123233995736766036e-17, r2 = r * r;
    const double sp = r * (1.0 + r2 * (-1.0 / 6 + r2 * (1.0 / 120 + r2 * (-1.0 / 5040 + r2 * (1.0 / 362880 + r2 * (-1.0 / 39916800 + r2 * (1.0 / 6227020800.0)))))));
    const double cp = 1.0 + r2 * (-0.5 + r2 * (1.0 / 24 + r2 * (-1.0 / 720 + r2 * (1.0 / 40320 + r2 * (-1.0 / 3628800 + r2 * (1.0 / 479001600.0))))));
    const int qi = ((int)q) & 3;
    const double s_ = (qi == 0) ? sp : (qi == 1) ? cp : (qi == 2) ? -sp : -cp;
    const double c_ = (qi == 0) ? cp : (qi == 1) ? -sp : (qi == 2) ? -cp : sp;
    sn = (float)s_; cs = (float)c_;
}

__device__ __forceinline__ void p2a_row(int row, u32x4 wA, u32x4 wB, u32x4 wC, const float* __restrict__ rope, const float* __restrict__ g_q_a, const float* __restrict__ g_kv_a,
                                        const float* __restrict__ g_q_gqa, const float* __restrict__ g_k_gqa, float* rs_q, float* rs_kv, bf16* km, bf16* qg, bf16* kg, bf16* vg, int lane) {
    const bool meta = row >= NTOK;
    const int b = row >> 11, s = row & 2047, m = row - NTOK;
    const int pos1 = meta ? m : 16 + s, prow = meta ? -1 : (s >> 6), pcol = meta ? m : (s & 63), key = meta ? 2048 + m : s;
    {
        float f[8]; unpack8(wA, f);
        float ss = 0.f;
#pragma unroll
        for (int j = 0; j < 8; ++j) ss += f[j] * f[j];
        ss += __shfl_xor(ss, 1); ss += __shfl_xor(ss, 2); ss += __shfl_xor(ss, 4); ss += __shfl_xor(ss, 8);
        const float s16 = ss, s32 = ss + __shfl_xor(ss, 16);
        if (lane == 0) rs_q[row] = rsq(s32 * (1.f / 256) + RMS_EPS);
        if (lane == 32) rs_kv[row] = rsq(s16 * (1.f / 128) + RMS_EPS);
        if (lane < 48) {
        } else if (lane < 56) { const int i0 = 4 * (lane - 48); const float* t = rope + ((size_t)(pos1 + 1) * 32 + i0) * 2; float o[8];
#pragma unroll
            for (int j = 0; j < 4; ++j) { const float c = t[2 * j], sn = t[2 * j + 1], x1 = f[2 * j], x2 = f[2 * j + 1]; o[2 * j] = x1 * c - x2 * sn; o[2 * j + 1] = x1 * sn + x2 * c; }
            const u32x4 pk = pack8(o);
            if (!meta) { for (int h = 0; h < 4; ++h) *(u32x4*)(km + ((size_t)(b * 4 + h) * LKP + key) * 192 + 128 + 8 * (lane - 48)) = pk; }
            else { for (int bb = 0; bb < NB; ++bb) for (int h = 0; h < 4; ++h) *(u32x4*)(km + ((size_t)(bb * 4 + h) * LKP + key) * 192 + 128 + 8 * (lane - 48)) = pk; }
        }
    }
    const int p0 = (lane & 15) * 8, half = p0 >> 6, i0 = (p0 & 63) >> 1;
    const int apos = half ? pcol : prow; const float* t = rope + ((size_t)(apos + 1) * 32 + i0) * 2;
    if (!meta) {
        float f[8]; unpack8(wB, f);
        float ss = 0.f;
#pragma unroll
        for (int j = 0; j < 8; ++j) ss += f[j] * f[j];
        ss += __shfl_xor(ss, 1); ss += __shfl_xor(ss, 2); ss += __shfl_xor(ss, 4); ss += __shfl_xor(ss, 8);
        const float rs = rsq(ss * (1.f / 128) + RMS_EPS); float o[8];
#pragma unroll
        for (int j = 0; j < 4; ++j) { const int d1 = half * 64 + i0 + j, d2 = d1 + 32;
            const float x1 = f[2 * j] * rs * g_q_gqa[d1], x2 = f[2 * j + 1] * rs * g_q_gqa[d2], c = t[2 * j], sn = t[2 * j + 1];
            o[2 * j] = x1 * c - x2 * sn; o[2 * j + 1] = x1 * sn + x2 * c; }
        *(u32x4*)(qg + ((size_t)(b * 4 + (lane >> 4)) * 2048 + s) * 128 + p0) = pack8(o);
    }
    {
        float f[8]; unpack8(wC, f);
        float ss = 0.f;
#pragma unroll
        for (int j = 0; j < 8; ++j) ss += f[j] * f[j];
        ss += __shfl_xor(ss, 1); ss += __shfl_xor(ss, 2); ss += __shfl_xor(ss, 4); ss += __shfl_xor(ss, 8);
        float o[8];
        if (lane < 32) { const float rs = rsq(ss * (1.f / 128) + RMS_EPS);
#pragma unroll
            for (int j = 0; j < 4; ++j) { const int d1 = half * 64 + i0 + j, d2 = d1 + 32;
                const float x1 = f[2 * j] * rs * g_k_gqa[d1], x2 = f[2 * j + 1] * rs * g_k_gqa[d2], c = t[2 * j], sn = t[2 * j + 1];
                o[2 * j] = x1 * c - x2 * sn; o[2 * j + 1] = x1 * sn + x2 * c; }
        } else {
#pragma unroll
            for (int j = 0; j < 8; ++j) o[j] = f[j];
        }
        const u32x4 pk = pack8(o); bf16* dst = lane < 32 ? kg : vg; const int hk = (lane >> 4) & 1;
        if (!meta) *(u32x4*)(dst + ((size_t)(b * 2 + hk) * LKP + key) * 128 + p0) = pk;
        else for (int bb = 0; bb < NB; ++bb) *(u32x4*)(dst + ((size_t)(bb * 2 + hk) * LKP + key) * 128 + p0) = pk;
    }
}

__device__ __forceinline__ int crow(int r, int hi) { return (r & 3) + 8 * (r >> 2) + 4 * hi; }
__device__ __forceinline__ int v_st(int k, int c) { const int kk = (k & ~0xC) | ((k & 4) << 1) | ((k & 8) >> 1); return ((kk >> 3) * 4 + (c >> 5)) * 512 + ((kk & 7) * 32 + (c & 31)) * 2; }
__device__ __forceinline__ int v_rd_base(int lane) { return ((lane & 3) << 3) | (((lane >> 2) & 3) << 6) | (((lane >> 4) & 1) << 5) | (((lane >> 5) & 1) << 8); }
constexpr int v_rd_off(int d0, int ks, int half) { return d0 * 512 + ks * 4096 + half * 2048; }
template <int OFF> __device__ __forceinline__ s16x4 tr_read(int vb) {
    s16x4 r; asm volatile("ds_read_b64_tr_b16 %0, %1 offset:%2" : "=&v"(r) : "v"(vb), "i"(OFF) : "memory"); return r;
}
template <int D0> __device__ __forceinline__ void pv_one(f32x16& od, int vb, bf16x8 pa0, bf16x8 pa1, bf16x8 pa2, bf16x8 pa3) {
    const s16x4 l0 = tr_read<v_rd_off(D0, 0, 0)>(vb), h0 = tr_read<v_rd_off(D0, 0, 1)>(vb), l1 = tr_read<v_rd_off(D0, 1, 0)>(vb), h1 = tr_read<v_rd_off(D0, 1, 1)>(vb);
    const s16x4 l2 = tr_read<v_rd_off(D0, 2, 0)>(vb), h2 = tr_read<v_rd_off(D0, 2, 1)>(vb), l3 = tr_read<v_rd_off(D0, 3, 0)>(vb), h3 = tr_read<v_rd_off(D0, 3, 1)>(vb);
    asm volatile("s_waitcnt lgkmcnt(0)" ::: "memory"); SBAR();
#define PK(L, H) (bf16x8){L[0], L[1], L[2], L[3], H[0], H[1], H[2], H[3]}
    od = __builtin_amdgcn_mfma_f32_32x32x16_bf16(pa0, PK(l0, h0), od, 0, 0, 0);
    od = __builtin_amdgcn_mfma_f32_32x32x16_bf16(pa1, PK(l1, h1), od, 0, 0, 0);
    od = __builtin_amdgcn_mfma_f32_32x32x16_bf16(pa2, PK(l2, h2), od, 0, 0, 0);
    od = __builtin_amdgcn_mfma_f32_32x32x16_bf16(pa3, PK(l3, h3), od, 0, 0, 0);
#undef PK
}
__device__ __forceinline__ void pv_d0(f32x16* o, int vb, bf16x8 pa0, bf16x8 pa1, bf16x8 pa2, bf16x8 pa3) {
    pv_one<0>(o[0], vb, pa0, pa1, pa2, pa3); pv_one<1>(o[1], vb, pa0, pa1, pa2, pa3); pv_one<2>(o[2], vb, pa0, pa1, pa2, pa3); pv_one<3>(o[3], vb, pa0, pa1, pa2, pa3);
}
template <int DQK> struct AttnC {
    static constexpr float SCALE = DQK == 192 ? 0.07216878364870322f : 0.08838834764831845f;
    static constexpr float C = SCALE * 1.4426950408889634f, THRS = 8.f / SCALE;
};
template <int DQK>
__device__ __forceinline__ void partialSM(f32x16& p0, f32x16& p1, float& m_reg, float& mn, float& alpha) {
    constexpr float C = AttnC<DQK>::C;
    float pmax = p0[0];
#pragma unroll
    for (int r = 1; r < 16; ++r) pmax = fmaxf(pmax, p0[r]);
#pragma unroll
    for (int r = 0; r < 16; ++r) pmax = fmaxf(pmax, p1[r]);
    { auto rr = __builtin_amdgcn_permlane32_swap(__float_as_uint(pmax), __float_as_uint(pmax), false, false);
      pmax = fmaxf(__uint_as_float(rr[0]), __uint_as_float(rr[1])); }
    if (__builtin_expect(__all(pmax - m_reg <= AttnC<DQK>::THRS), 1)) { mn = m_reg; alpha = 1.f; }
    else { mn = fmaxf(m_reg, pmax); alpha = __builtin_amdgcn_exp2f((m_reg - mn) * C); m_reg = mn; }
    const float mnC = -mn * C;
#pragma unroll
    for (int r = 0; r < 16; ++r) p0[r] = fmaf(p0[r], C, mnC);
#pragma unroll
    for (int r = 0; r < 16; ++r) p1[r] = fmaf(p1[r], C, mnC);
#pragma unroll
    for (int r = 0; r < 16; ++r) p0[r] = __builtin_amdgcn_exp2f(p0[r]);
}
__device__ __forceinline__ void finishSM(f32x16& p0, f32x16& p1, float alpha, float& l_reg, bf16x8& pa0, bf16x8& pa1, bf16x8& pa2, bf16x8& pa3) {
#pragma unroll
    for (int r = 0; r < 16; ++r) p1[r] = __builtin_amdgcn_exp2f(p1[r]);
    float ps = 0;
#pragma unroll
    for (int r = 0; r < 16; ++r) ps += p0[r];
#pragma unroll
    for (int r = 0; r < 16; ++r) ps += p1[r];
    { auto rr = __builtin_amdgcn_permlane32_swap(__float_as_uint(ps), __float_as_uint(ps), false, false);
      ps = __uint_as_float(rr[0]) + __uint_as_float(rr[1]); }
    l_reg = l_reg * alpha + ps;
#define PK4(P, BASE, OUT) do { unsigned a0 = cvtpk(P[BASE + 0], P[BASE + 1]), a1 = cvtpk(P[BASE + 2], P[BASE + 3]);   \
    unsigned b0 = cvtpk(P[BASE + 4], P[BASE + 5]), b1 = cvtpk(P[BASE + 6], P[BASE + 7]);                              \
    auto r0 = __builtin_amdgcn_permlane32_swap(a0, b0, false, false); auto r1 = __builtin_amdgcn_permlane32_swap(a1, b1, false, false); \
    u32x4 w = {r0[0], r1[0], r0[1], r1[1]}; OUT = *reinterpret_cast<bf16x8*>(&w); } while (0)
    PK4(p0, 0, pa0); PK4(p0, 8, pa1); PK4(p1, 0, pa2); PK4(p1, 8, pa3);
#undef PK4
}
template <int DQK>
__device__ __forceinline__ void qkt(f32x16& p0, f32x16& p1, const LAS char* Ks, const bf16x8* qr, const LAS char* ql, const int (&ko)[4]) {
    constexpr int KRB = DQK * 2, ND = DQK / 16, PF = 3;
    p0 = f32x16{}; p1 = f32x16{};
    bf16x8 kb[ND][2];
#define QKT_RD(d_) do { const LAS char* kp_ = Ks + ko[(d_) & 3] + ((d_) >> 2) * 128; kb[d_][0] = *(const LAS bf16x8*)(kp_); kb[d_][1] = *(const LAS bf16x8*)(kp_ + 32 * KRB); } while (0)
#pragma unroll
    for (int d0 = 0; d0 < PF; ++d0) QKT_RD(d0);
#pragma unroll
    for (int d0 = 0; d0 < ND; ++d0) {
        if (d0 + PF < ND) QKT_RD(d0 + PF);
        bf16x8 q; if (d0 < 8) q = qr[d0]; else q = *(const LAS bf16x8*)(ql + (d0 - 8) * 1024);
        p0 = __builtin_amdgcn_mfma_f32_32x32x16_bf16(kb[d0][0], q, p0, 0, 0, 0);
        p1 = __builtin_amdgcn_mfma_f32_32x32x16_bf16(kb[d0][1], q, p1, 0, 0, 0);
        __builtin_amdgcn_sched_group_barrier(0x8, 2, 0); __builtin_amdgcn_sched_group_barrier(0x100, 2, 0); __builtin_amdgcn_sched_group_barrier(0x2, 6, 0); }
#undef QKT_RD
}
template <int DQK, int SD>
__device__ __forceinline__ void attn_body(const bf16* __restrict__ Qb, const bf16* __restrict__ Kh, const bf16* __restrict__ Vh, bf16* __restrict__ Ob, LAS char* lds, const float* __restrict__ rope, int pos0, float* __restrict__ ssq) {
    constexpr int ND0 = DQK / 16, KRB = DQK * 2, SHM_K = 64 * KRB, SHM_V = 64 * 128 * 2, NKC = DQK / 64, CPR = DQK / 8, NT = LKP / 64;
    static_assert(NT % 2 == 1, "odd tile count: the tail below takes tiles NT-2 and NT-1");
    int tid = threadIdx.x; asm volatile("" : "+v"(tid));
    const int wid = tid >> 6, lane = tid & 63, r32 = lane & 31, hi = lane >> 5;
    LAS char* V_lds = lds; LAS char* K_lds = lds + 2 * SHM_V;
    __syncthreads();
    float m_reg = -1e30f, l_reg = 0; f32x16 o[4] = {}; bf16x8 qr[8];
    const bf16* Qw = Qb + (size_t)(wid * 32 + r32) * DQK + hi * 8;
#pragma unroll
    for (int d0 = 0; d0 < 8; ++d0) qr[d0] = *reinterpret_cast<const bf16x8*>(Qw + d0 * 16);
    LAS char* ql = lds + 2 * SHM_V + 2 * SHM_K + 2048 + wid * 4096 + lane * 16;
#pragma unroll
    for (int d0 = 8; d0 < ND0; ++d0) {
        float x[8], y[8]; unpack8(*reinterpret_cast<const u32x4*>(Qw + d0 * 16), x);
        const float* t = rope + ((size_t)(pos0 + wid * 32 + r32 + 1) * 32 + (d0 - 8) * 8 + hi * 4) * 2; const f32x4 t0 = *(const f32x4*)t, t1 = *(const f32x4*)(t + 4);
        const float cs[4] = {t0[0], t0[2], t1[0], t1[2]}, sn[4] = {t0[1], t0[3], t1[1], t1[3]};
#pragma unroll
        for (int j = 0; j < 4; ++j) { y[2 * j] = x[2 * j] * cs[j] - x[2 * j + 1] * sn[j]; y[2 * j + 1] = x[2 * j] * sn[j] + x[2 * j + 1] * cs[j]; }
        *(LAS u32x4*)(ql + (d0 - 8) * 1024) = pack8(y); }
    const int sr = tid >> 4, sc = (tid & 15) * 8, vst0 = v_st(sr, sc), vst1 = v_st(32 + sr, sc);
    int kst[NKC];
#pragma unroll
    for (int c = 0; c < NKC; ++c) { const int id = tid + 512 * c, kr = id / CPR, kc = (id - kr * CPR) * 8; kst[c] = kr * KRB + ((kc * 2) ^ ((kr & 7) << 4)); }
    const int voff = tid * 16;
    int ko[4];
#pragma unroll
    for (int q = 0; q < 4; ++q) ko[q] = r32 * KRB + ((q * 32 + hi * 16) ^ ((r32 & 7) << 4));
    const __amdgpu_buffer_rsrc_t rK = __builtin_amdgcn_make_buffer_rsrc((void*)Kh, 0, LKP * KRB, 0x00020000);
    const __amdgpu_buffer_rsrc_t rV = __builtin_amdgcn_make_buffer_rsrc((void*)Vh, 0, LKP * 256, 0x00020000);
    const int vb0 = (int)(unsigned)(uintptr_t)V_lds + v_rd_base(lane);
    struct { bf16x8 vs0, vs1, ks[NKC]; } sr_[SD];
#define SLOAD(i, k0) do { sr_[i].vs0 = __builtin_bit_cast(bf16x8, __builtin_amdgcn_raw_buffer_load_b128(rV, voff, (k0) * 256, 0)); sr_[i].vs1 = __builtin_bit_cast(bf16x8, __builtin_amdgcn_raw_buffer_load_b128(rV, voff, (k0) * 256 + 8192, 0)); \
    _Pragma("unroll") for (int c_ = 0; c_ < NKC; ++c_) sr_[i].ks[c_] = __builtin_bit_cast(bf16x8, __builtin_amdgcn_raw_buffer_load_b128(rK, voff, (k0) * KRB + c_ * 8192, 0)); } while (0)
#define SWRITE(b, i) do { *(LAS bf16x8*)(V_lds + (b) * SHM_V + vst0) = sr_[i].vs0; *(LAS bf16x8*)(V_lds + (b) * SHM_V + vst1) = sr_[i].vs1; \
    _Pragma("unroll") for (int c_ = 0; c_ < NKC; ++c_) *(LAS bf16x8*)(K_lds + (b) * SHM_K + kst[c_]) = sr_[i].ks[c_]; } while (0)
#define SWAIT() do { if constexpr (SD == 2) { if constexpr (NKC == 2) asm volatile("s_waitcnt vmcnt(4)" ::: "memory"); else asm volatile("s_waitcnt vmcnt(5)" ::: "memory"); } \
    else asm volatile("s_waitcnt vmcnt(0)" ::: "memory"); } while (0)
#define RESC(a) do { if (__any((a) < 1.f)) { int t_ = threadIdx.x; asm volatile("" : "+v"(t_)); const int r32_ = t_ & 31, hi_2 = (t_ >> 5) & 1; \
    LAS float* al_ = (LAS float*)(lds + 2 * SHM_V + 2 * SHM_K) + (t_ >> 6) * 64 + 32; if (hi_2 == 0) al_[r32_] = (a); asm volatile("s_waitcnt lgkmcnt(0)" ::: "memory"); \
    _Pragma("unroll") for (int d = 0; d < 4; ++d) _Pragma("unroll") for (int r = 0; r < 16; ++r) o[d][r] *= al_[crow(r, hi_2)]; } } while (0)
    f32x16 pA0, pA1, pB0, pB1; float mnA, mnB, alA, alB; bf16x8 pa0, pa1, pa2, pa3;
    constexpr int SE = 0, SO = SD - 1;
    SLOAD(SE, 0); asm volatile("s_waitcnt vmcnt(0)" ::: "memory"); SWRITE(0, SE); __syncthreads();
    qkt<DQK>(pA0, pA1, K_lds, qr, ql, ko); partialSM<DQK>(pA0, pA1, m_reg, mnA, alA);
    SLOAD(SO, 64); if constexpr (SD == 2) { SLOAD(SE, 128); }
    SWAIT(); SWRITE(1, SO); __syncthreads();
#pragma unroll 1
    for (int j = 1; j + 2 < NT; j += 2) {
        SBAR(); qkt<DQK>(pB0, pB1, K_lds + SHM_K, qr, ql, ko);
        finishSM(pA0, pA1, alA, l_reg, pa0, pa1, pa2, pa3); SBAR();
        SLOAD(SO, (j + SD) * 64); SBAR();
        pv_d0(o, vb0, pa0, pa1, pa2, pa3); partialSM<DQK>(pB0, pB1, m_reg, mnB, alB);
        __syncthreads(); SWAIT(); SWRITE(0, SE);
        RESC(alB); __syncthreads();
        SBAR(); qkt<DQK>(pA0, pA1, K_lds, qr, ql, ko);
        finishSM(pB0, pB1, alB, l_reg, pa0, pa1, pa2, pa3); SBAR();
        SLOAD(SE, (j + 1 + SD) * 64); SBAR();
        pv_d0(o, vb0 + SHM_V, pa0, pa1, pa2, pa3); partialSM<DQK>(pA0, pA1, m_reg, mnA, alA);
        __syncthreads(); SWAIT(); SWRITE(1, SO);
        RESC(alA); __syncthreads();
    }
    SBAR(); qkt<DQK>(pB0, pB1, K_lds + SHM_K, qr, ql, ko);
    finishSM(pA0, pA1, alA, l_reg, pa0, pa1, pa2, pa3); SBAR();
    if constexpr (SD == 1) { SLOAD(SE, (NT - 1) * 64); } SBAR();
    pv_d0(o, vb0, pa0, pa1, pa2, pa3); partialSM<DQK>(pB0, pB1, m_reg, mnB, alB);
    __syncthreads(); asm volatile("s_waitcnt vmcnt(0)" ::: "memory"); SWRITE(0, SE);
    RESC(alB); __syncthreads();
    SBAR(); qkt<DQK>(pA0, pA1, K_lds, qr, ql, ko);
#pragma unroll
    for (int r = 8; r < 16; ++r) pA0[r] = -1e30f;
#pragma unroll
    for (int r = 0; r < 16; ++r) pA1[r] = -1e30f;
    finishSM(pB0, pB1, alB, l_reg, pa0, pa1, pa2, pa3); SBAR();
    pv_d0(o, vb0 + SHM_V, pa0, pa1, pa2, pa3); partialSM<DQK>(pA0, pA1, m_reg, mnA, alA);
    RESC(alA);
    finishSM(pA0, pA1, alA, l_reg, pa0, pa1, pa2, pa3); SBAR();
    pv_d0(o, vb0, pa0, pa1, pa2, pa3);
    { int t_ = threadIdx.x; asm volatile("" : "+v"(t_)); const int r32_ = t_ & 31, hi_2 = (t_ >> 5) & 1, wid_ = t_ >> 6;
      LAS float* li_ = (LAS float*)(lds + 2 * SHM_V + 2 * SHM_K) + wid_ * 64;
      if (hi_2 == 0) li_[r32_] = l_reg; asm volatile("s_waitcnt lgkmcnt(0)" ::: "memory");
      float rli[16];
#pragma unroll
      for (int r = 0; r < 16; ++r) rli[r] = __builtin_amdgcn_rcpf(li_[crow(r, hi_2)]);
      { float ss[16];
#pragma unroll
        for (int r = 0; r < 16; ++r) { float a = 0.f;
#pragma unroll
            for (int d0 = 0; d0 < 4; ++d0) { const float x = o[d0][r] * rli[r]; a += x * x; }
            a += __shfl_xor(a, 1); a += __shfl_xor(a, 2); a += __shfl_xor(a, 4); a += __shfl_xor(a, 8); a += __shfl_xor(a, 16); ss[r] = a; }
        float mine = ss[0];
#pragma unroll
        for (int r = 1; r < 16; ++r) mine = (r32_ == r) ? ss[r] : mine;
        if (r32_ < 16) ssq[(size_t)(wid_ * 32 + crow(r32_, hi_2)) * 8] = mine; }
      bf16* Ow = Ob + (size_t)(wid_ * 32) * DM;
#pragma unroll
      for (int r = 0; r < 16; ++r) { const int orow = crow(r, hi_2);
#pragma unroll
          for (int d0 = 0; d0 < 4; ++d0) Ow[(size_t)orow * DM + d0 * 32 + r32_] = (bf16)(cvtpk(o[d0][r] * rli[r], 0.f) & 0xffffu); } }
#undef SLOAD
#undef SWRITE
#undef SWAIT
#undef RESC
}

constexpr int NPHASE = 14;
struct Args { const float* in[24]; float* out; unsigned char* ws; int ph_lo, ph_hi, bar_region, pad; };
__global__ void __launch_bounds__(NWAVES * 64, 2) hymba_fwd(Args args) {
    extern __shared__ __attribute__((aligned(16))) unsigned char lds[];
    { int t0 = threadIdx.x; asm volatile("" : "+v"(t0)); for (int u = t0; u < 1024; u += NWAVES * 64) ((LAS unsigned*)((LAS unsigned char*)lds + LDSCTL_OFF))[u] = 0u; }
    __syncthreads();
#define XB_OBJ(b_) XcdBarrier b_; { const CAS unsigned char* kq_ = (const CAS unsigned char*)__builtin_amdgcn_kernarg_segment_ptr(); asm volatile("" : "+s"(kq_)); \
    b_.bar = (unsigned*)(*(unsigned char* const CAS*)(kq_ + 200) + WS_CTL) + CW_BAR + *(const int CAS*)(kq_ + 216) * XCD_BAR_WORDS; b_.x = xb_xcc_id(); b_.st = (volatile LAS unsigned*)((LAS unsigned char*)lds + LDSCTL_OFF) + 8; }
#if !MK_SPLIT
    { XB_OBJ(b0_); (void)xcd_barrier_post(b0_.bar, b0_.st); }
#define GRID_BAR() do { XB_OBJ(bb_); xcd_barrier(bb_); } while (0)
#else
#define GRID_BAR() do {} while (0)
#endif
    const int lo = args.ph_lo, hi_ = args.ph_hi;
#ifndef REP_MASK
#define REP_MASK 0
#endif
#define IN(k) (lo <= (k) && (k) < hi_)
#define REPS(k) (((REP_MASK >> (k)) & 1) ? 2 : 1)
#define SEAM(k) do { if (IN(k) && IN((k) + 1)) GRID_BAR(); } while (0)

#define PTRS \
    int bx = blockIdx.x; asm volatile("" : "+s"(bx)); const int G = gridDim.x, vcu = (G % 8 == 0) ? (bx % 8) * (G / 8) + bx / 8 : bx; \
    const int tid = threadIdx.x, lane = tid & 63, wave = __builtin_amdgcn_readfirstlane(tid >> 6); \
    const int gw = vcu * NWAVES + wave, ngw = G * NWAVES, gtid = vcu * (NWAVES * 64) + tid, ngt = G * NWAVES * 64; (void)gw; (void)ngw; (void)gtid; (void)ngt; (void)lane; \
    const CAS unsigned char* kp_ = (const CAS unsigned char*)__builtin_amdgcn_kernarg_segment_ptr(); asm volatile("" : "+s"(kp_)); \
    const float* const CAS* kin = (const float* const CAS*)kp_; unsigned char* ws = *(unsigned char* const CAS*)(kp_ + 200); float* outp = *(float* const CAS*)(kp_ + 192); (void)outp; (void)kin; \
    const float* x = kin[0]; const float* meta_tok = kin[1]; \
    float* rope = (float*)(ws + WS_ROPE); \
    bf16* w_in_t = (bf16*)(ws + WS_WIN); bf16* w_qb_t = (bf16*)(ws + WS_WQB); bf16* w_kvb_t = (bf16*)(ws + WS_WKVB); bf16* w_o_t = (bf16*)(ws + WS_WO); \
    bf16* w_r_t = (bf16*)(ws + WS_WR); unsigned char* w_gu8 = ws + WS_WGU; unsigned char* w_dn8 = ws + WS_WDN; unsigned char* h1f8 = ws + WS_H1F8; \
    bf16* h0 = (bf16*)(ws + WS_H0); bf16* h1 = (bf16*)(ws + WS_H1); float* rs_q = (float*)(ws + WS_QAN); float* rs_kv = rs_q + MPAD; float* ssq = (float*)(ws + WS_KVAN); bf16* z = (bf16*)(ws + WS_Z); \
    bf16* qm = (bf16*)(ws + WS_QM); bf16* km = (bf16*)(ws + WS_KM); bf16* vm = (bf16*)(ws + WS_VM); bf16* qg = (bf16*)(ws + WS_QG); bf16* kg = (bf16*)(ws + WS_KG); bf16* vg = (bf16*)(ws + WS_VG); \
    bf16* ob = (bf16*)(ws + WS_O); bf16* y1 = (bf16*)(ws + WS_Y1); float* logits = (float*)(ws + WS_LOGITS); \
    int* topk = (int*)(ws + WS_TOPK); float* gate = (float*)(ws + WS_GATE); int* pair_pos = (int*)(ws + WS_PAIRPOS); float* row_gate = (float*)(ws + WS_ROWGATE); \
    int* hist = (int*)(ws + WS_HIST); int* moetab = (int*)(ws + WS_MOETAB); int* tile_expert = moetab + 256; \
    int* row_tok = (int*)(ws + WS_XS); unsigned char* act8 = ws + WS_ACT; unsigned char* out2 = ws + WS_OUT2;


    for (int rep_ = 0; rep_ < (IN(0) ? REPS(0) : 0); ++rep_) { if (rep_) GRID_BAR(); PTRS;
        LAS float* scr = (LAS float*)((LAS unsigned char*)lds + wave * 16384);
        constexpr int I_IN = 16 * 46, I_QB = 4 * 24, I_KVB = 4 * 32, I_O = 16 * 32, I_R = 16;
        constexpr int NITEMS = I_IN + I_QB + I_KVB + I_O + I_R;
        for (int it = gw; it < NITEMS; it += ngw) {
            int r = it;
            if (r < I_IN) { transpose_item(kin[4], 1024, NIN, w_in_t, scr, r, lane, MapIn()); continue; } r -= I_IN;
            if (r < I_QB) { transpose_item(kin[6], 256, 768, w_qb_t, scr, r, lane, MapQ(), kin[5]); continue; } r -= I_QB;
            if (r < I_KVB) { transpose_item(kin[8], 128, 1024, w_kvb_t, scr, r, lane, MapId(), kin[7], 256); continue; } r -= I_KVB;
            if (r < I_O) { transpose_item(kin[13], 1024, 1024, w_o_t, scr, r, lane, MapId(), kin[11], 0, kin[12]); continue; } r -= I_O;
            transpose_item(kin[16], 1024, 32, w_r_t, scr, r, lane, MapId());
        }
        transpose_f8_stream(kin[18], 2048, w_gu8, scr, gw, ngw, lane, MapGU(), W8_SCALE);
        transpose_f8_stream(kin[20], 1024, w_dn8, scr, gw, ngw, lane, MapId(), W8_SCALE);
        { f32x4 gg[4], bb[4], cv[4], nv[4];
#pragma unroll
          for (int j = 0; j < 4; ++j) { gg[j] = ((const f32x4*)kin[2])[lane + 64 * j]; bb[j] = ((const f32x4*)kin[3])[lane + 64 * j]; }
#define LN_LOAD(dst, m_) do { const float* xr_ = (m_) < NTOK ? x + (size_t)(m_) * DM : meta_tok + (size_t)((m_) - NTOK) * DM; _Pragma("unroll") for (int j = 0; j < 4; ++j) dst[j] = ((const f32x4*)xr_)[lane + 64 * j]; } while (0)
          if (gw < MROWS) LN_LOAD(cv, gw);
          for (int m = gw; m < MROWS; m += ngw) { const int mn = m + ngw < MROWS ? m + ngw : m; LN_LOAD(nv, mn);
              ln_row_f32_to_bf16(cv, gg, bb, h0 + (size_t)m * DM, lane);
#pragma unroll
              for (int j = 0; j < 4; ++j) cv[j] = nv[j]; }
#undef LN_LOAD
        }
        zero_bytes(h0 + (size_t)MROWS * DM, (size_t)(MPAD - MROWS) * DM * 2, gtid, ngt);
        zero_bytes(w_in_t + (size_t)NIN * 1024, (size_t)(ZLD - NIN) * 1024 * 2, gtid, ngt);
        for (int i = gw; i < 64 + 64 + 32 + 32; i += ngw) {
            bf16* p; size_t rb;
            if (i < 64) { p = km + ((size_t)i * LKP + 2064) * 192; rb = 48 * 192 * 2; }
            else if (i < 128) { p = vm + ((size_t)(i - 64) * LKP + 2064) * 128; rb = 48 * 128 * 2; }
            else if (i < 160) { p = kg + ((size_t)(i - 128) * LKP + 2064) * 128; rb = 48 * 128 * 2; }
            else { p = vg + ((size_t)(i - 160) * LKP + 2064) * 128; rb = 48 * 128 * 2; }
            zero_bytes(p, rb, lane, 64);
        }
        for (int i = gtid; i < 2065 * 32; i += ngt) {
            const int p = i / 32 - 1, f = i & 31; double inv = 1.0;
            for (int q = 0; q < f; ++q) inv *= 0.74989420933245582730;
            const float ang = (float)p * (float)inv; float sn, cs; sincos_d(fabsf(ang), sn, cs); if (ang < 0.f) sn = -sn;
            rope[2 * i] = cs; rope[2 * i + 1] = sn;
        }
    }
    SEAM(0);
    for (int rep_ = 0; rep_ < (IN(1) ? REPS(1) : 0); ++rep_) { if (rep_) GRID_BAR(); PTRS; EpiZ E{z};
#if FAST_Z
        { pg8::Gemm g{h0, w_in_t, NTOK, ZLD, 1024, 1024, nullptr}; pg8::StaticOrder S; S.init(NTOK, ZLD, G, bx); pg8::EpiAdapt<EpiZ> EA{E, 0};
          pg8::gemm_phase<pg8::EpiAdapt<EpiZ>, pg8::StaticOrder, true, true>((LAS unsigned char*)lds, g, S, EA); }
        meta_gemm16<1024>(h0, 1024, w_in_t, NTOK, ZLD, E, gw, ngw, lane);
#else
        simple_gemm(h0, w_in_t, 1024, 0, NTOK + 64, ZLD, E, BSelNone(), gw, ngw, lane);
#endif
    }
    SEAM(1);
    for (int rep_ = 0; rep_ < (IN(2) ? REPS(2) : 0); ++rep_) { if (rep_) GRID_BAR(); PTRS;
#define P2_LOAD(m_, a_, b_, c_) do { const bf16* zr_ = z + (size_t)(m_) * ZLD; a_ = (u32x4){0u, 0u, 0u, 0u}; if (lane < 56) a_ = *(const u32x4*)(zr_ + 8 * lane); b_ = *(const u32x4*)(zr_ + 448 + 8 * lane); c_ = *(const u32x4*)(zr_ + 960 + 8 * lane); } while (0)
        u32x4 wa, wb, wc, na, nb, nc; if (gw < MROWS) P2_LOAD(gw, wa, wb, wc);
        for (int m = gw; m < MROWS; m += ngw) { const int mn = m + ngw < MROWS ? m + ngw : m; P2_LOAD(mn, na, nb, nc);
            p2a_row(m, wa, wb, wc, rope, kin[5], kin[7], kin[9], kin[10], rs_q, rs_kv, km, qg, kg, vg, lane); wa = na; wb = nb; wc = nc; }
#undef P2_LOAD
    }
    SEAM(2);
    for (int rep_ = 0; rep_ < (IN(3) ? REPS(3) : 0); ++rep_) { if (rep_) GRID_BAR(); PTRS;
        { EpiQ E{qm, rs_q}; pg8::Gemm g{z, w_qb_t, NTOK, 768, 256, ZLD, nullptr}; pg8::StaticOrder S; S.init(NTOK, 768, G, bx); pg8::EpiAdapt<EpiQ> EA{E, 0};
          pg8::gemm_phase<pg8::EpiAdapt<EpiQ>, pg8::StaticOrder, true, true>((LAS unsigned char*)lds, g, S, EA); }
        { EpiKV<false> E{km, vm, rs_kv}; pg8::Gemm g{z + 256, w_kvb_t, NTOK, 1024, 256, ZLD, nullptr}; pg8::StaticOrder S; S.init(NTOK, 1024, G, bx); pg8::EpiAdapt<EpiKV<false>> EA{E, 0};
          pg8::gemm_phase<pg8::EpiAdapt<EpiKV<false>>, pg8::StaticOrder, true, true>((LAS unsigned char*)lds, g, S, EA);
          EpiKV<true> EM{km, vm, rs_kv}; meta_gemm16<256>(z + 256, ZLD, w_kvb_t, NTOK, 1024, EM, gw, ngw, lane); }
    }
    SEAM(3);
    for (int rep_ = 0; rep_ < (IN(4) ? REPS(4) : 0); ++rep_) { if (rep_) GRID_BAR(); PTRS;
        for (int u = vcu; u < 1024; u += G) {
            if (u < 512) { const int b = u >> 5, h = (u >> 3) & 3, qb = u & 7, bh = b * 4 + h;
                attn_body<192, 1>(qm + ((size_t)bh * 2048 + qb * 256) * 192, km + (size_t)bh * LKP * 192, vm + (size_t)bh * LKP * 128, ob + ((size_t)b * 2048 + qb * 256) * DM + h * 128, (LAS char*)lds, rope, 16 + qb * 256, ssq + ((size_t)b * 2048 + qb * 256) * 8 + h);
            } else { const int v = u - 512, b = v >> 5, h = (v >> 3) & 3, qb = v & 7, bh = b * 4 + h, bk = b * 2 + (h >> 1);
                attn_body<128, 1>(qg + ((size_t)bh * 2048 + qb * 256) * 128, kg + (size_t)bk * LKP * 128, vg + (size_t)bk * LKP * 128, ob + ((size_t)b * 2048 + qb * 256) * DM + 512 + h * 128, (LAS char*)lds, rope, 0, ssq + ((size_t)b * 2048 + qb * 256) * 8 + 4 + h);
            }
        }
    }
    SEAM(4);
    for (int rep_ = 0; rep_ < (IN(6) ? REPS(6) : 0); ++rep_) { if (rep_) GRID_BAR(); PTRS;
        pg8::Gemm g{ob, w_o_t, NTOK, 1024, 1024, 1024, nullptr}; pg8::StaticOrder S; S.init(NTOK, 1024, G, bx);
        LAS f32x2* T = (LAS f32x2*)((LAS unsigned char*)lds + LDSCTL_OFF + 2048);
        for (int i = tid >> 8; i < 6; i += 2) { pg8::Unit u; if (!S.next(i, u)) break; const int rl = tid & 255; const float* q = ssq + (size_t)(u.pm * 256 + rl) * 8;
            const f32x4 a = *(const f32x4*)q, b = *(const f32x4*)(q + 4);
            const float rm = rsq(((a[0] + a[1]) + (a[2] + a[3])) * (1.f / 512) + RMS_EPS), rg = rsq(((b[0] + b[1]) + (b[2] + b[3])) * (1.f / 512) + RMS_EPS);
            T[i * 256 + rl] = (f32x2){rm / rg, rg}; }
        __syncthreads();
        EpiOF E{y1, h0, T}; HookO H{T};
        pg8::gemm_phase<EpiOF, pg8::StaticOrder, true, true, false, false, HookO>((LAS unsigned char*)lds, g, S, E, H);
    }
    SEAM(6);
#ifndef MOE_SKEW_TICKS
#define MOE_SKEW_TICKS 0
#endif
#define MOE_STAGGER(nunits) do { const int rem_ = (nunits) % G; if (MOE_SKEW_TICKS > 0 && rem_ != 0 && bx >= rem_) { const unsigned long long t0_ = __builtin_amdgcn_s_memrealtime(), w_ = (unsigned long long)(MOE_SKEW_TICKS * ((bx - rem_) % 3 + 1)); \
    while (__builtin_amdgcn_s_memrealtime() - t0_ < w_) __builtin_amdgcn_s_sleep(16); } } while (0)
#define ROUTE_VARS const int tpb = (NTOK + G - 1) / G, tok_lo = bx * tpb, tok_hi = (tok_lo + tpb < NTOK) ? tok_lo + tpb : NTOK; \
    LAS int* L_hist = (LAS int*)((LAS unsigned char*)lds + LDSCTL_OFF + 256); LAS int* L_n = L_hist + 32; LAS int* L_base = L_hist + 64; LAS int* L_off = L_hist + 96; (void)L_n; (void)L_base; (void)L_off;
    for (int rep_ = 0; rep_ < (IN(8) ? REPS(8) : 0); ++rep_) { if (rep_) GRID_BAR(); PTRS; ROUTE_VARS;
        constexpr int WRP = 2064;
        LAS unsigned char* L_wr = (LAS unsigned char*)lds;
        for (int i = tid; i < 32 * 128; i += NWAVES * 64) { const int r = i >> 7, c = i & 127; *(LAS u32x4*)(L_wr + r * WRP + c * 16) = *(const u32x4*)(w_r_t + (size_t)r * 1024 + c * 8); }
        if (tid < 32) L_hist[tid] = 0;
        zero_bytes(row_tok, (size_t)MOE_ROWS_MAX * 4, gtid, ngt);
        __syncthreads();
        const int fr = lane & 15, fq = lane >> 4;
        f32x4 G4[4], B4[4];
#pragma unroll
        for (int hf = 0; hf < 2; ++hf) { const int c = hf * 512 + 8 * lane; G4[2 * hf] = *(const f32x4*)(kin[14] + c); G4[2 * hf + 1] = *(const f32x4*)(kin[14] + c + 4); B4[2 * hf] = *(const f32x4*)(kin[15] + c); B4[2 * hf + 1] = *(const f32x4*)(kin[15] + c + 4); }
        for (int rb = tok_lo + wave * 16; rb < tok_hi; rb += NWAVES * 16) {
            for (int i = 0; i < 16 && rb + i < tok_hi; ++i) ln_row_bf16(y1 + (size_t)(rb + i) * DM, G4, B4, h1 + (size_t)(rb + i) * DM, h1f8 + (size_t)(rb + i) * DM, lane);
            asm volatile("s_waitcnt vmcnt(0)" ::: "memory");
            const int row = rb + fr < NTOK ? rb + fr : NTOK - 1;
            const bf16* ap = h1 + (size_t)row * DM + fq * 8;
            bf16x8 a[32];
#pragma unroll
            for (int ks = 0; ks < 32; ++ks) a[ks] = *(const bf16x8*)(ap + ks * 32);
            f32x4 acc0 = {0.f, 0.f, 0.f, 0.f}, acc1 = {0.f, 0.f, 0.f, 0.f};
            const LAS unsigned char* bp = L_wr + (8 * (fr >> 2) + (fr & 3)) * WRP + fq * 16;
#pragma unroll
            for (int ks = 0; ks < 32; ++ks) { const bf16x8 b0 = *(const LAS bf16x8*)(bp + ks * 64), b1 = *(const LAS bf16x8*)(bp + 4 * WRP + ks * 64);
                acc0 = __builtin_amdgcn_mfma_f32_16x16x32_bf16(b0, a[ks], acc0, 0, 0, 0); acc1 = __builtin_amdgcn_mfma_f32_16x16x32_bf16(b1, a[ks], acc1, 0, 0, 0); }
            const float* br = kin[17] + 8 * fq; const f32x4 bb0 = *(const f32x4*)br, bb1 = *(const f32x4*)(br + 4);
            float v[8] = {acc0[0] + bb0[0], acc0[1] + bb0[1], acc0[2] + bb0[2], acc0[3] + bb0[3], acc1[0] + bb1[0], acc1[1] + bb1[1], acc1[2] + bb1[2], acc1[3] + bb1[3]};
            float tv[4]; int ti[4];
#pragma unroll
            for (int r = 0; r < 4; ++r) { float bv = v[0]; int bi = 8 * fq;
#pragma unroll
                for (int j = 1; j < 8; ++j) if (v[j] > bv) { bv = v[j]; bi = 8 * fq + j; }
#pragma unroll
                for (int off = 16; off <= 32; off <<= 1) { const float ov = __shfl_xor(bv, off); const int oi = __shfl_xor(bi, off); if (ov > bv || (ov == bv && oi < bi)) { bv = ov; bi = oi; } }
                tv[r] = bv; ti[r] = bi;
#pragma unroll
                for (int j = 0; j < 8; ++j) if (bi == 8 * fq + j) v[j] = -INFINITY; }
            const float e1 = __expf(tv[1] - tv[0]), e2 = __expf(tv[2] - tv[0]), e3 = __expf(tv[3] - tv[0]), inv = 1.f / (1.f + e1 + e2 + e3);
            if (fq == 0 && rb + fr < tok_hi) { const int t = rb + fr; *(int4*)(topk + (size_t)t * 4) = make_int4(ti[0], ti[1], ti[2], ti[3]); *(f32x4*)(gate + (size_t)t * 4) = (f32x4){inv, e1 * inv, e2 * inv, e3 * inv};
                atomicAdd((int*)(L_hist + ti[0]), 1); atomicAdd((int*)(L_hist + ti[1]), 1); atomicAdd((int*)(L_hist + ti[2]), 1); atomicAdd((int*)(L_hist + ti[3]), 1); }
        }
        __syncthreads();
        if (tid < 32) hist[bx * 32 + tid] = L_hist[tid];
    }
    SEAM(8);
    for (int rep_ = 0; rep_ < (IN(10) ? REPS(10) : 0); ++rep_) { if (rep_) GRID_BAR(); PTRS; ROUTE_VARS;
        if (tid < 32) { int tot = 0, before = 0; for (int b = 0; b < G; ++b) { const int h = hist[b * 32 + tid]; tot += h; if (b < bx) before += h; } L_n[tid] = tot; L_base[tid] = before; L_hist[tid] = 0; }
        __syncthreads();
        if (tid == 0) { int off = 0; for (int e = 0; e < NE; ++e) { L_off[e] = off; off += (L_n[e] + 255) & ~255; } L_off[NE] = off; }
        __syncthreads();
        for (int p = tok_lo * 4 + tid; p < tok_hi * 4; p += NWAVES * 64) { const int e = topk[p]; const int r = atomicAdd((int*)(L_hist + e), 1); const int pos = L_off[e] + L_base[e] + r;
            row_gate[pos] = gate[p]; pair_pos[p] = pos; row_tok[pos] = p >> 2; }
        __syncthreads();
        if (bx == 0) { if (tid == 0) moetab[0] = L_off[NE];
            if (tid < 32) { moetab[64 + tid] = L_n[tid]; moetab[128 + tid] = L_off[tid]; for (int t = L_off[tid] >> 8; t < (L_off[tid + 1] >> 8); ++t) tile_expert[t] = tid; } }
        __syncthreads();
    }
    SEAM(10);
    for (int rep_ = 0; rep_ < (IN(11) ? REPS(11) : 0); ++rep_) { if (rep_) GRID_BAR(); PTRS; const int rows = moetab[0]; EpiGU8 E{act8, kin[19]};
        pg8::Gemm g{(const bf16*)h1f8, (const bf16*)w_gu8, rows, 2048, 512, 512, row_tok}; LAS int* L_te = (LAS int*)((LAS unsigned char*)lds + LDSCTL_OFF + 2048); for (int i = tid; i < (rows >> 8); i += NWAVES * 64) L_te[i] = tile_expert[i]; __syncthreads();
        pg8::MoeOrder S; S.init(rows >> 8, 8, G, bx, L_te);
        MOE_STAGGER((rows >> 8) * 8);
        pg8::gemm_phase<EpiGU8, pg8::MoeOrder, true, true, true, true>((LAS unsigned char*)lds, g, S, E);
    }
    SEAM(11);
    for (int rep_ = 0; rep_ < (IN(12) ? REPS(12) : 0); ++rep_) { if (rep_) GRID_BAR(); PTRS; const int rows = moetab[0]; EpiDN8 E{out2, kin[21], row_gate};
        pg8::Gemm g{(const bf16*)act8, (const bf16*)w_dn8, rows, 1024, 512, 512, nullptr}; LAS int* L_te = (LAS int*)((LAS unsigned char*)lds + LDSCTL_OFF + 2048); for (int i = tid; i < (rows >> 8); i += NWAVES * 64) L_te[i] = tile_expert[i]; __syncthreads();
        pg8::MoeOrder S; S.init(rows >> 8, 4, G, bx, L_te);
        MOE_STAGGER((rows >> 8) * 4);
        pg8::gemm_phase<EpiDN8, pg8::MoeOrder, true, true, true>((LAS unsigned char*)lds, g, S, E);
    }
    SEAM(12);
    for (int rep_ = 0; rep_ < (IN(13) ? REPS(13) : 0); ++rep_) { if (rep_) GRID_BAR(); PTRS;
        f32x4 G4[4], B4[4];
#pragma unroll
        for (int hf = 0; hf < 2; ++hf) { const int c = hf * 512 + 8 * lane; G4[2 * hf] = *(const f32x4*)(kin[22] + c); G4[2 * hf + 1] = *(const f32x4*)(kin[22] + c + 4); B4[2 * hf] = *(const f32x4*)(kin[23] + c); B4[2 * hf + 1] = *(const f32x4*)(kin[23] + c + 4); }
        int4 pp = gw < NTOK ? *(const int4*)(pair_pos + (size_t)gw * 4) : make_int4(0, 0, 0, 0);
        for (int t = gw; t < NTOK; t += ngw) {
            const int ps[4] = {pp.x, pp.y, pp.z, pp.w};
            u32x4 hv[2]; u32x2 ov[4][2];
#pragma unroll
            for (int hf = 0; hf < 2; ++hf) { hv[hf] = *(const u32x4*)(h1 + (size_t)t * DM + hf * 512 + 8 * lane);
#pragma unroll
                for (int s4 = 0; s4 < 4; ++s4) ov[s4][hf] = *(const u32x2*)(out2 + (size_t)ps[s4] * DM + hf * 512 + 8 * lane); }
            if (t + ngw < NTOK) pp = *(const int4*)(pair_pos + (size_t)(t + ngw) * 4);
            float v[16];
#pragma unroll
            for (int hf = 0; hf < 2; ++hf) { float f[8]; unpack8(hv[hf], f);
                float acc8[8] = {0.f, 0.f, 0.f, 0.f, 0.f, 0.f, 0.f, 0.f};
#pragma unroll
                for (int s4 = 0; s4 < 4; ++s4) {
#pragma unroll
                    for (int w = 0; w < 2; ++w) { const unsigned d = w ? ov[s4][hf].y : ov[s4][hf].x;
                        const f32x2 lo = __builtin_amdgcn_cvt_pk_f32_fp8((int)d, false), hi2 = __builtin_amdgcn_cvt_pk_f32_fp8((int)d, true);
                        acc8[4 * w + 0] += lo[0]; acc8[4 * w + 1] += lo[1]; acc8[4 * w + 2] += hi2[0]; acc8[4 * w + 3] += hi2[1]; } }
#pragma unroll
                for (int j = 0; j < 8; ++j) v[hf * 8 + j] = ALPHA * f[j] + O2_INV * acc8[j]; }
            float s = 0.f;
#pragma unroll
            for (int j = 0; j < 16; ++j) s += v[j];
            const float mean = wave_sum(s) * (1.f / DM); float s2 = 0.f;
#pragma unroll
            for (int j = 0; j < 16; ++j) { v[j] -= mean; s2 += v[j] * v[j]; }
            const float rstd = rsq(wave_sum(s2) * (1.f / DM) + LN_EPS);
#pragma unroll
            for (int hf = 0; hf < 2; ++hf) { float* o = outp + (size_t)t * DM + hf * 512 + 8 * lane;
                *(f32x4*)o = (f32x4){v[hf * 8 + 0], v[hf * 8 + 1], v[hf * 8 + 2], v[hf * 8 + 3]} * rstd * G4[2 * hf] + B4[2 * hf];
                *(f32x4*)(o + 4) = (f32x4){v[hf * 8 + 4], v[hf * 8 + 5], v[hf * 8 + 6], v[hf * 8 + 7]} * rstd * G4[2 * hf + 1] + B4[2 * hf + 1]; }
        }
    }
#undef IN
#undef SEAM
}

extern "C" void kernel_launch(void* const* d_in, const int* in_sizes, int n_in, void* d_out, int out_size, void* d_ws, size_t ws_size, hipStream_t stream) {
    static int grid = 0;
    if (grid == 0) {
        if (n_in != 24 || in_sizes[0] != NTOK * DM || out_size != NTOK * DM || ws_size < WS_END) { fprintf(stderr, "kernel_launch: shape/workspace mismatch (n_in %d, ws %zu)\n", n_in, ws_size); grid = -1; return; }
        int dev = 0, cus = 0, per_cu = 0;
        if (hipGetDevice(&dev) != hipSuccess || hipDeviceGetAttribute(&cus, hipDeviceAttributeMultiprocessorCount, dev) != hipSuccess) { grid = -1; return; }
        if (hipFuncSetAttribute((const void*)hymba_fwd, hipFuncAttributeMaxDynamicSharedMemorySize, LDS_BYTES) != hipSuccess) { fprintf(stderr, "kernel_launch: hipFuncSetAttribute failed\n"); grid = -1; return; }
        if (hipOccupancyMaxActiveBlocksPerMultiprocessor(&per_cu, (const void*)hymba_fwd, NWAVES * 64, LDS_BYTES) != hipSuccess || per_cu < 1) fprintf(stderr, "kernel_launch: occupancy query says %d\n", per_cu);
        (void)hipGetLastError();
        grid = cus;
    }
    if (grid < 0) return;
    (void)hipMemsetAsync((char*)d_ws + WS_CTL, 0, CTL_ZERO_BYTES, stream);
    Args a{};
    for (int i = 0; i < 24; ++i) a.in[i] = (const float*)d_in[i];
    a.out = (float*)d_out; a.ws = (unsigned char*)d_ws;
#if MK_SPLIT
    for (int p = 0; p < NPHASE; ++p) { a.ph_lo = p; a.ph_hi = p + 1; hipLaunchKernelGGL(hymba_fwd, dim3(grid), dim3(NWAVES * 64), LDS_BYTES, stream, a); }
#else
    a.ph_lo = 0; a.ph_hi = NPHASE; hipLaunchKernelGGL(hymba_fwd, dim3(grid), dim3(NWAVES * 64), LDS_BYTES, stream, a);
#ifdef PROBE_RELAUNCH_LO
    a.ph_lo = PROBE_RELAUNCH_LO; a.ph_hi = PROBE_RELAUNCH_HI; a.bar_region = 1; hipLaunchKernelGGL(hymba_fwd, dim3(grid), dim3(NWAVES * 64), LDS_BYTES, stream, a);
#endif
#endif
}
```

```cpp
#include <hip/hip_runtime.h>
#include <cstdio>
#include <cstdint>

#ifndef MK_SPLIT
#define MK_SPLIT 0
#endif

#define LAS __attribute__((address_space(3)))
#define CAS __attribute__((address_space(4)))
typedef unsigned short bf16;
typedef short bf16x8 __attribute__((ext_vector_type(8)));
typedef short s16x4 __attribute__((ext_vector_type(4)));
typedef float f32x2 __attribute__((ext_vector_type(2)));
typedef float f32x4 __attribute__((ext_vector_type(4)));
typedef float f32x16 __attribute__((ext_vector_type(16)));
typedef unsigned u32x2 __attribute__((ext_vector_type(2)));
typedef unsigned u32x4 __attribute__((ext_vector_type(4)));
typedef __bf16 bf16x2_t __attribute__((ext_vector_type(2)));

constexpr int NB = 16, SEQ = 2048, DM = 1024, NMETA = 16;
constexpr int NTOK = NB * SEQ;
constexpr int MROWS = NTOK + NMETA;
constexpr int MPAD = 33024;
constexpr int LKP = 2112;
constexpr int NIN = 1472, ZLD = 1536;
constexpr int NE = 32, NPAIR = NTOK * 4, MOE_TILES_MAX = 544, MOE_ROWS_MAX = MOE_TILES_MAX * 256;
constexpr float ALPHA = 1.189207115002721f;
constexpr float RMS_EPS = 1e-6f, LN_EPS = 1e-5f;

constexpr size_t MiB = 1u << 20;
constexpr size_t WS_CTL = 0, CTL_ZERO_BYTES = 1 * MiB;
constexpr size_t WS_ROPE = 1 * MiB;
constexpr size_t WS_WQB = 2 * MiB;
constexpr size_t WS_WKVB = 2 * MiB + 512 * 1024;
constexpr size_t WS_WR = 3 * MiB;
constexpr size_t WS_LOGITS = 4 * MiB;
constexpr size_t WS_TOPK = 8 * MiB;
constexpr size_t WS_GATE = 8 * MiB + 512 * 1024;
constexpr size_t WS_PAIRPOS = 9 * MiB;
constexpr size_t WS_ROWGATE = 9 * MiB + 512 * 1024;
constexpr size_t WS_HIST = 10 * MiB + 512 * 1024;
constexpr size_t WS_MOETAB = 10 * MiB + 768 * 1024;
constexpr size_t WS_WIN = 12 * MiB;
constexpr size_t WS_WO = 15 * MiB;
constexpr size_t WS_WGU = 32 * MiB;
constexpr size_t WS_WDN = 96 * MiB;
constexpr size_t WS_H1F8 = 128 * MiB;
constexpr size_t WS_H0 = 224 * MiB;
constexpr size_t WS_H1 = 289 * MiB;
constexpr size_t WS_QAN = 353 * MiB;
constexpr size_t WS_KVAN = 370 * MiB;
constexpr size_t WS_Z = 380 * MiB;
constexpr size_t WS_QM = 477 * MiB;
constexpr size_t WS_KM = 525 * MiB;
constexpr size_t WS_VM = 575 * MiB;
constexpr size_t WS_QG = 608 * MiB;
constexpr size_t WS_KG = 640 * MiB;
constexpr size_t WS_VG = 657 * MiB;
constexpr size_t WS_O = 674 * MiB;
constexpr size_t WS_Y1 = 738 * MiB;
constexpr size_t WS_XS = 380 * MiB;
constexpr size_t WS_ACT = 516 * MiB;
constexpr size_t WS_OUT2 = 652 * MiB;
constexpr size_t WS_END = 924 * MiB;
static_assert(WS_Z + (size_t)MPAD * ZLD * 2 <= WS_QM && WS_QM + (size_t)64 * 2048 * 192 * 2 <= WS_KM && WS_KM + (size_t)64 * LKP * 192 * 2 <= WS_VM && WS_VM + (size_t)64 * LKP * 128 * 2 <= WS_QG, "ws map 1");
static_assert(WS_QG + (size_t)64 * 2048 * 128 * 2 <= WS_KG && WS_KG + (size_t)32 * LKP * 128 * 2 <= WS_VG && WS_VG + (size_t)32 * LKP * 128 * 2 <= WS_O && WS_O + (size_t)NTOK * DM * 2 <= WS_Y1 && WS_Y1 + (size_t)NTOK * DM * 4 <= WS_END, "ws map 2");
static_assert(WS_XS + (size_t)MOE_ROWS_MAX * DM <= WS_ACT && WS_ACT + (size_t)MOE_ROWS_MAX * DM <= WS_OUT2 && WS_OUT2 + (size_t)MOE_ROWS_MAX * DM * 2 <= WS_END && WS_WGU + (size_t)NE * 2048 * 1024 <= WS_WDN && WS_WDN + (size_t)NE * 1024 * 1024 <= WS_H1F8 && WS_H1F8 + (size_t)NTOK * DM <= WS_H0, "ws map 3");
static_assert(WS_H0 + (size_t)MPAD * DM * 2 <= WS_H1 && WS_H1 + (size_t)NTOK * DM * 2 <= WS_QAN && WS_QAN + (size_t)MPAD * 256 * 2 <= WS_KVAN && WS_KVAN + (size_t)MPAD * 128 * 2 <= WS_Z, "ws map 4");
constexpr int CW_BAR = 4096;

constexpr int RING_BYTES = 131072;
constexpr int LDSCTL_OFF = RING_BYTES;
constexpr int LDS_BYTES = 147456;
constexpr int NWAVES = 8;

#define LDS_WAIT() asm volatile("s_waitcnt lgkmcnt(0)" ::: "memory")
#define SBAR() __builtin_amdgcn_sched_barrier(0)
__device__ __forceinline__ unsigned cvtpk(float lo, float hi) { f32x2 v = {lo, hi}; bf16x2_t b = __builtin_convertvector(v, bf16x2_t); return __builtin_bit_cast(unsigned, b); }
__device__ __forceinline__ u32x4 pack8(const float (&v)[8]) { u32x4 r = {cvtpk(v[0], v[1]), cvtpk(v[2], v[3]), cvtpk(v[4], v[5]), cvtpk(v[6], v[7])}; return r; }
__device__ __forceinline__ void unpack8(u32x4 w, float (&v)[8]) {
    v[0] = __uint_as_float(w.x << 16); v[1] = __uint_as_float(w.x & 0xffff0000u); v[2] = __uint_as_float(w.y << 16); v[3] = __uint_as_float(w.y & 0xffff0000u);
    v[4] = __uint_as_float(w.z << 16); v[5] = __uint_as_float(w.z & 0xffff0000u); v[6] = __uint_as_float(w.w << 16); v[7] = __uint_as_float(w.w & 0xffff0000u);
}
__device__ __forceinline__ float wave_sum(float v) {
#pragma unroll
    for (int o = 1; o < 64; o <<= 1) v += __shfl_xor(v, o);
    return v;
}
__device__ __forceinline__ float rsq(float x) { return __builtin_amdgcn_rsqf(x); }
typedef int v8i __attribute__((ext_vector_type(8)));
__device__ __forceinline__ unsigned pack4_f8(float a, float b, float c, float d) { int w = 0; w = __builtin_amdgcn_cvt_pk_fp8_f32(a, b, w, false); w = __builtin_amdgcn_cvt_pk_fp8_f32(c, d, w, true); return (unsigned)w; }
constexpr float W8_SCALE = 32.f, W8_INV = 1.f / 32.f;

#define XB_TMO      128
#define XB_XCNT(j)  (256  + 64 * (j))
#define XB_XSUB(j)  (1280 + 64 * (j))
#define XB_XGEN(j)  (2304 + 64 * (j))
#define XB_TOP      3328
#define XB_TOPGEN   3392
#define XCD_BAR_WORDS 3456
#define XB_SPIN_CAP (1u << 18)
__device__ __forceinline__ unsigned xb_ld(unsigned* p)              { return __hip_atomic_load(p, __ATOMIC_RELAXED, __HIP_MEMORY_SCOPE_AGENT); }
__device__ __forceinline__ unsigned xb_add(unsigned* p, unsigned v) { return __hip_atomic_fetch_add(p, v, __ATOMIC_RELAXED, __HIP_MEMORY_SCOPE_AGENT); }
__device__ __forceinline__ unsigned xb_xcc_id() { return (unsigned)__builtin_amdgcn_s_getreg((3 << 11) | 20) & 0xFu; }
#define XB_SPIN(cond, bar) do { unsigned _sp = 0; while (cond) { __builtin_amdgcn_s_sleep(1); \
    if ((++_sp & 255u) == 0u) { if (xb_ld(&(bar)[XB_TMO])) break; if (_sp > XB_SPIN_CAP) { atomicAdd(&(bar)[XB_TMO], 1u); break; } } } } while (0)
struct XcdBarrier { unsigned* bar; unsigned x; volatile LAS unsigned* st; };
__device__ __forceinline__ XcdBarrier xcd_barrier_post(unsigned* bar, volatile LAS unsigned* st) {
    XcdBarrier b; b.bar = bar; b.x = xb_xcc_id(); b.st = st;
    if (threadIdx.x == 0) (void)xb_add(&bar[XB_XCNT(b.x)], 1u);
    return b;
}
__device__ __forceinline__ void xcd_barrier_complete(unsigned* bar, unsigned x, unsigned& nloc, unsigned& nx) {
    const unsigned G = gridDim.x * gridDim.y * gridDim.z;
    unsigned sum, cnt, mine, sp = 0u;
    for (;;) {
        sum = 0u; cnt = 0u; mine = 0u;
#pragma unroll
        for (unsigned j = 0; j < 16; ++j) { const unsigned c = xb_ld(&bar[XB_XCNT(j)]); sum += c; cnt += (c > 0u) ? 1u : 0u; mine = (j == x) ? c : mine; }
        if (sum == G) break;
        __builtin_amdgcn_s_sleep(1);
        if ((++sp & 255u) == 0u) { if (xb_ld(&bar[XB_TMO])) break; if (sp > XB_SPIN_CAP) { atomicAdd(&bar[XB_TMO], 1u); break; } }
    }
    nloc = mine > 0u ? mine : 1u; nx = cnt > 0u ? cnt : 1u;
}
__device__ __forceinline__ void xcd_barrier(const XcdBarrier& b) {
    asm volatile("s_waitcnt vmcnt(0)" ::: "memory");
    __syncthreads();
    if (threadIdx.x == 0) {
        unsigned* bar = b.bar;
        __builtin_amdgcn_s_waitcnt(0);
        unsigned nloc = b.st[0], nx = b.st[1];
        if (nloc == 0u) { xcd_barrier_complete(bar, b.x, nloc, nx); b.st[0] = nloc; b.st[1] = nx; }
        const unsigned old = xb_add(&bar[XB_XSUB(b.x)], 1u);
        const unsigned gen = old / nloc;
        if (old + 1u == (gen + 1u) * nloc) {
            __builtin_amdgcn_fence(__ATOMIC_RELEASE, "agent");
            asm volatile("s_waitcnt vmcnt(0)" ::: "memory");
            const unsigned og = xb_add(&bar[XB_TOP], 1u);
            const unsigned tg = og / nx;
            if (og + 1u == (tg + 1u) * nx) xb_add(&bar[XB_TOPGEN], 1u);
            else XB_SPIN(xb_ld(&bar[XB_TOPGEN]) == tg, bar);
            __builtin_amdgcn_fence(__ATOMIC_ACQUIRE, "agent");
            xb_add(&bar[XB_XGEN(b.x)], 1u);
            asm volatile("s_waitcnt vmcnt(0)" ::: "memory");
        } else {
            XB_SPIN(xb_ld(&bar[XB_XGEN(b.x)]) == gen, bar);
            __builtin_amdgcn_fence(__ATOMIC_ACQUIRE, "agent");
            asm volatile("s_waitcnt vmcnt(0)" ::: "memory");
        }
    }
    __syncthreads();
}

struct BSelNone { __device__ __forceinline__ size_t operator()(int) const { return 0; } };
struct BSelExpert { const int* tile_expert; size_t per; __device__ __forceinline__ size_t operator()(int m0) const { return (size_t)tile_expert[m0 >> 8] * per; } };
template <class Epi, class BSel>
__device__ __forceinline__ void simple_gemm(const bf16* __restrict__ A, const bf16* __restrict__ Bt, int K, int m_lo, int m_hi, int N, const Epi& E, const BSel& bsel, int gw, int ngw, int lane, int lda = 0) {
    if (lda == 0) lda = K;
    const int fr = lane & 15, fq = lane >> 4;
    const int mt = (m_hi - m_lo) / 64, nt = N / 32;
    for (int u = gw; u < mt * nt; u += ngw) {
        const int m0 = m_lo + (u / nt) * 64, n0 = (u % nt) * 32;
        const bf16* ap = A + (size_t)(m0 + fr) * lda + fq * 8;
        const bf16* bp = Bt + bsel(m0) + (size_t)(n0 + 8 * (fr >> 2) + (fr & 3)) * K + fq * 8;
        f32x4 acc[4][2];
#pragma unroll
        for (int i = 0; i < 4; ++i) { acc[i][0] = (f32x4){0.f, 0.f, 0.f, 0.f}; acc[i][1] = (f32x4){0.f, 0.f, 0.f, 0.f}; }
#pragma unroll 2
        for (int k = 0; k < K; k += 32) {
            bf16x8 a[4], b[2];
#pragma unroll
            for (int i = 0; i < 4; ++i) a[i] = *(const bf16x8*)(ap + (size_t)i * 16 * lda + k);
#pragma unroll
            for (int j = 0; j < 2; ++j) b[j] = *(const bf16x8*)(bp + (size_t)j * 4 * K + k);
#pragma unroll
            for (int i = 0; i < 4; ++i)
#pragma unroll
                for (int j = 0; j < 2; ++j) acc[i][j] = __builtin_amdgcn_mfma_f32_16x16x32_bf16(b[j], a[i], acc[i][j], 0, 0, 0);
        }
#pragma unroll
        for (int i = 0; i < 4; ++i) {
            const float v[8] = {acc[i][0][0], acc[i][0][1], acc[i][0][2], acc[i][0][3], acc[i][1][0], acc[i][1][1], acc[i][1][2], acc[i][1][3]};
            E.store8(m0 + 16 * i + fr, n0 + 8 * fq, v);
        }
    }
}


template <int K, class Epi>
__device__ __forceinline__ void smallk_task(const bf16* __restrict__ A, const bf16* __restrict__ Bt, int m0, int ng_lo, int ng_hi, const Epi& E, int lane) {
    constexpr int KS = K / 32;
    const int fr = lane & 15, fq = lane >> 4;
    bf16x8 a[4][KS];
#pragma unroll
    for (int i = 0; i < 4; ++i)
#pragma unroll
        for (int ks = 0; ks < KS; ++ks) a[i][ks] = *(const bf16x8*)(A + (size_t)(m0 + 16 * i + fr) * K + ks * 32 + fq * 8);
#pragma unroll 1
    for (int ng = ng_lo; ng < ng_hi; ++ng) {
        const int n0 = ng * 32;
        const bf16* bp = Bt + (size_t)(n0 + 8 * (fr >> 2) + (fr & 3)) * K + fq * 8;
        bf16x8 b[2][KS];
#pragma unroll
        for (int ks = 0; ks < KS; ++ks) { b[0][ks] = *(const bf16x8*)(bp + ks * 32); b[1][ks] = *(const bf16x8*)(bp + 4 * K + ks * 32); }
        f32x4 acc[4][2];
#pragma unroll
        for (int i = 0; i < 4; ++i) { acc[i][0] = (f32x4){0.f, 0.f, 0.f, 0.f}; acc[i][1] = (f32x4){0.f, 0.f, 0.f, 0.f}; }
#pragma unroll
        for (int ks = 0; ks < KS; ++ks)
#pragma unroll
            for (int i = 0; i < 4; ++i) { acc[i][0] = __builtin_amdgcn_mfma_f32_16x16x32_bf16(b[0][ks], a[i][ks], acc[i][0], 0, 0, 0); acc[i][1] = __builtin_amdgcn_mfma_f32_16x16x32_bf16(b[1][ks], a[i][ks], acc[i][1], 0, 0, 0); }
#pragma unroll
        for (int i = 0; i < 4; ++i) {
            const float v[8] = {acc[i][0][0], acc[i][0][1], acc[i][0][2], acc[i][0][3], acc[i][1][0], acc[i][1][1], acc[i][1][2], acc[i][1][3]};
            E.store8(m0 + 16 * i + fr, n0 + 8 * fq, v);
        }
    }
}


template <int K, int RMSK, class Epi>
__device__ __forceinline__ void meta_gemm16(const bf16* __restrict__ A, int lda, const bf16* __restrict__ Bt, int m0, int N, const Epi& E, int gw, int ngw, int lane) {
    const int fr = lane & 15, fq = lane >> 4;
    for (int ng = gw; ng < N / 32; ng += ngw) {
        const int n0 = ng * 32;
        const bf16* ap = A + (size_t)(m0 + fr) * lda + fq * 8;
        const bf16* bp = Bt + (size_t)(n0 + 8 * (fr >> 2) + (fr & 3)) * K + fq * 8;
        f32x4 acc0 = {0.f, 0.f, 0.f, 0.f}, acc1 = {0.f, 0.f, 0.f, 0.f}; float ss = 0.f;
#pragma unroll 8
        for (int k = 0; k < K; k += 32) { const bf16x8 a = *(const bf16x8*)(ap + k), b0 = *(const bf16x8*)(bp + k), b1 = *(const bf16x8*)(bp + 4 * K + k);
            if (RMSK > 0 && k < RMSK) { float f[8]; unpack8(__builtin_bit_cast(u32x4, a), f);
#pragma unroll
                for (int j = 0; j < 8; ++j) ss += f[j] * f[j]; }
            acc0 = __builtin_amdgcn_mfma_f32_16x16x32_bf16(b0, a, acc0, 0, 0, 0); acc1 = __builtin_amdgcn_mfma_f32_16x16x32_bf16(b1, a, acc1, 0, 0, 0); }
        float sc = 1.f;
        if (RMSK > 0) { ss += __shfl_xor(ss, 16); ss += __shfl_xor(ss, 32); sc = rsq(ss * (1.f / RMSK) + RMS_EPS); }
        const float v[8] = {acc0[0] * sc, acc0[1] * sc, acc0[2] * sc, acc0[3] * sc, acc1[0] * sc, acc1[1] * sc, acc1[2] * sc, acc1[3] * sc};
        E.store8(m0 + fr, n0 + 8 * fq, v);
    }
}

struct EpiZ { bf16* z;
    __device__ __forceinline__ void store8(int row, int col, const float (&v)[8]) const { *(u32x4*)(z + (size_t)row * ZLD + col) = pack8(v); } };
struct EpiQ { bf16* qm; const float* rs;
    __device__ __forceinline__ void store8(int row, int col, const float (&v_)[8]) const {
        const int h = col / 192, w = col - h * 192, b = row >> 11, s = row & 2047; const float r_ = rs[row];
        const float o[8] = {v_[0] * r_, v_[1] * r_, v_[2] * r_, v_[3] * r_, v_[4] * r_, v_[5] * r_, v_[6] * r_, v_[7] * r_};
        *(u32x4*)(qm + ((size_t)(b * 4 + h) * 2048 + s) * 192 + w) = pack8(o);
    } };
template <bool META> struct EpiKV { bf16* km; bf16* vm; const float* rs;
    __device__ __forceinline__ void store8(int row, int col, const float (&v_)[8]) const {
        if (META && row >= MROWS) return;
        const float r_ = META ? 1.f : rs[row]; const float v[8] = {v_[0] * r_, v_[1] * r_, v_[2] * r_, v_[3] * r_, v_[4] * r_, v_[5] * r_, v_[6] * r_, v_[7] * r_};
        const int h = col >> 8, w = col & 255; const u32x4 pk = pack8(v);
        if (!META) { const int b = row >> 11, key = row & 2047; const size_t r = (size_t)(b * 4 + h) * LKP + key;
            if (w < 128) *(u32x4*)(km + r * 192 + w) = pk; else *(u32x4*)(vm + r * 128 + (w - 128)) = pk;
        } else { const int key = 2048 + (row - NTOK);
            for (int b = 0; b < NB; ++b) { const size_t r = (size_t)(b * 4 + h) * LKP + key;
                if (w < 128) *(u32x4*)(km + r * 192 + w) = pk; else *(u32x4*)(vm + r * 128 + (w - 128)) = pk; } }
    } };
struct EpiO { bf16* y1; const bf16* h0;
    __device__ __forceinline__ void store8(int row, int col, const float (&v)[8]) const {
        float h[8]; unpack8(*(const u32x4*)(h0 + (size_t)row * DM + col), h);
        const float o[8] = {ALPHA * h[0] + v[0], ALPHA * h[1] + v[1], ALPHA * h[2] + v[2], ALPHA * h[3] + v[3], ALPHA * h[4] + v[4], ALPHA * h[5] + v[5], ALPHA * h[6] + v[6], ALPHA * h[7] + v[7]};
        *(u32x4*)(y1 + (size_t)row * DM + col) = pack8(o);
    } };
struct EpiLogit { float* logits; const float* bias;
    __device__ __forceinline__ void store8(int row, int col, const float (&v)[8]) const {
        float* y = logits + (size_t)row * NE + col;
        *(f32x4*)y = (f32x4){v[0] + bias[col], v[1] + bias[col + 1], v[2] + bias[col + 2], v[3] + bias[col + 3]};
        *(f32x4*)(y + 4) = (f32x4){v[4] + bias[col + 4], v[5] + bias[col + 5], v[6] + bias[col + 6], v[7] + bias[col + 7]};
    } };
namespace pg8 {
#define PG8_LAS __attribute__((address_space(3)))
typedef unsigned short bf16_t;
constexpr int BM = 256, BK = 64, HALF = 128, HTB = HALF * BK * 2, STAGE_BYTES = 8 * HTB, NXCD = 8, WGM = 8;
__host__ __device__ __forceinline__ int lds_byte(int r, int c) { const int st = (r >> 4) * 2 + (c >> 5), rr = r & 15, cc = c & 31, ob = rr * 64 + cc * 2; return st * 1024 + (ob ^ (((ob >> 9) & 1) << 5)); }
__host__ __device__ __forceinline__ void stage_rc(int b, int& R, int& C) { const int st = b / 1024, sb = b % 1024, swz = sb ^ (((sb >> 9) & 1) << 5); R = (st >> 1) * 16 + swz / 64; C = (st & 1) * 32 + (swz % 64) / 2; }
__host__ __device__ __forceinline__ int perm32(int rho) { const int n = rho >> 4, i = rho & 15; return 8 * (i >> 2) + 4 * n + (i & 3); }
struct Unit { int pm, pn, ui; };
struct Gemm { const bf16_t* A; const bf16_t* Bt; int M, N, K, lda; const int* row_tok; };
struct StaticOrder {
    int nM, nN, nwg, G, c;
    __host__ __device__ void init(int M, int N, int G_, int c_) { nM = M / BM; nN = N / BM; nwg = nM * nN; G = G_; c = c_; }
    __host__ __device__ bool next(int i, Unit& u) const {
        const long L = (long)i * G + c; if (L >= nwg) return false;
        int wgid = (int)L; { const int q = nwg / NXCD, r = nwg % NXCD, xcd = wgid % NXCD, off = wgid / NXCD; wgid = (xcd < r ? xcd * (q + 1) : r * (q + 1) + (xcd - r) * q) + off; }
        const int nig = WGM * nN, gid = wgid / nig, fm = gid * WGM, gsz = (nM - fm) < WGM ? (nM - fm) : WGM;
        u.pm = fm + ((wgid % nig) % gsz); u.pn = (wgid % nig) / gsz; u.ui = i; return true;
    }
    __device__ __forceinline__ void a_ready(const Unit&) const {}
    __device__ __forceinline__ void done(const Unit&) const {}
};
struct MoeOrder {
    StaticOrder so; const PG8_LAS int* tile_expert;
    __device__ void init(int tiles, int nN, int G_, int c_, const PG8_LAS int* te) { so.nM = tiles; so.nN = nN; so.nwg = tiles * nN; so.G = G_; so.c = c_; tile_expert = te; }
    __device__ bool next(int i, Unit& u) const { if (!so.next(i, u)) return false; u.pn += tile_expert[u.pm] * so.nN; return true; }
    __device__ __forceinline__ void a_ready(const Unit&) const {}
    __device__ __forceinline__ void done(const Unit&) const {}
};
template <class E8> struct EpiAdapt {
    static constexpr bool PERM = true, AFTER_DRAIN = false;
    E8 e; int ncols_mod;
    __device__ __forceinline__ void operator()(const f32x4 (&acc)[2][2][4][2], const Unit& u, int wr, int wc, int fr, int fq) const {
        const int row0 = u.pm * BM + wr * 64 + fr; int colt = u.pn * BM; if (ncols_mod) colt %= ncols_mod;
        const int col0 = colt + wc * 32 + 8 * fq;
#pragma unroll
        for (int ai = 0; ai < 2; ++ai)
#pragma unroll
            for (int m = 0; m < 4; ++m)
#pragma unroll
                for (int bj = 0; bj < 2; ++bj) {
                    const float v[8] = {acc[ai][bj][m][0][0], acc[ai][bj][m][0][1], acc[ai][bj][m][0][2], acc[ai][bj][m][0][3], acc[ai][bj][m][1][0], acc[ai][bj][m][1][1], acc[ai][bj][m][1][2], acc[ai][bj][m][1][3]};
                    e.store8(row0 + ai * HALF + m * 16, col0 + bj * HALF, v); }
    }
};
struct NoHook { static constexpr bool ON = false; __device__ __forceinline__ void mid(f32x4 (&)[2][2][4][2], const Unit&, int, int) const {} };
template <class Epi, class Sched, bool ALIGN_EPI = false, bool SP2 = false, bool F8 = false, bool GATHER = false, class Hook = NoHook>
__device__ __forceinline__ void gemm_phase(PG8_LAS unsigned char* lds, const Gemm g, const Sched& S, const Epi& E, const Hook& H = Hook()) {
    const int tid = threadIdx.x, wid = __builtin_amdgcn_readfirstlane(tid >> 6), lane = tid & 63, wr = wid >> 2, wc = wid & 3, fr = lane & 15, fq = lane >> 4;
    const int K = g.K, nt = K / BK;
    unsigned voffA[2], voffB[2];
#pragma unroll
    for (int i = 0; i < 2; ++i) { int R, C; stage_rc(tid * 16 + i * 8192, R, C); const int Rb = Epi::PERM ? ((R & ~31) + perm32(R & 31)) : R;
        voffA[i] = (unsigned)(R * g.lda + C) * 2u; voffB[i] = (unsigned)(Rb * K + C) * 2u; }
    int gR[2]; unsigned gC[2];
#pragma unroll
    for (int i = 0; i < 2; ++i) { int R, C; stage_rc(tid * 16 + i * 8192, R, C); gR[i] = R; gC[i] = (unsigned)C * 2u; }
    const unsigned lda2 = (unsigned)g.lda * 2u;
    unsigned vC[2][2], vN[2][2]; int tkn[2][2];
    static_assert(!GATHER || SP2, "GATHER is written for the SP2 loop");
#define PG8_TOKLD(dst, pm_) do { _Pragma("unroll") for (int h_ = 0; h_ < 2; ++h_) _Pragma("unroll") for (int i_ = 0; i_ < 2; ++i_) dst[h_][i_] = g.row_tok[(pm_) * 256 + h_ * 128 + gR[i_]]; } while (0)
#define PG8_TOKOFF(dst, src) do { _Pragma("unroll") for (int h_ = 0; h_ < 2; ++h_) _Pragma("unroll") for (int i_ = 0; i_ < 2; ++i_) dst[h_][i_] = (unsigned)src[h_][i_] * lda2 + gC[i_]; } while (0)
    const size_t kstep = (size_t)(BK * 2);
    const size_t hstep = (size_t)HALF * K * 2, hstepA = (size_t)HALF * g.lda * 2;
    const size_t tstep = 2 * hstep, tstepA = 2 * hstepA;
    const unsigned ldsw = (unsigned)wid * 1024u;
    const int aoff = lds_byte(wr * 64 + fr, fq * 8), boff = lds_byte(wc * 32 + fr, fq * 8);
#define PG8_SA(b, h) (((b) * 2 + (h)) * HTB)
#define PG8_SB(b, h) ((4 + (b) * 2 + (h)) * HTB)
#define PG8_STAGE(bufoff, gbase, voff) do { _Pragma("unroll") for (int _i = 0; _i < 2; ++_i) \
        __builtin_amdgcn_global_load_lds((const unsigned*)((const char*)(gbase) + (voff)[_i]), (PG8_LAS unsigned*)(lds + (bufoff) + ldsw + _i * 8192), 16, 0, 0); } while (0)
#define PG8_LDA(dst, b, h) do { _Pragma("unroll") for (int m = 0; m < 4; ++m) _Pragma("unroll") for (int k = 0; k < 2; ++k) dst[m][k] = *(const PG8_LAS bf16x8*)(lds + PG8_SA(b, h) + aoff + m * 2048 + k * 1024); } while (0)
#define PG8_LDB(dst, b, h) do { _Pragma("unroll") for (int n = 0; n < 2; ++n) _Pragma("unroll") for (int k = 0; k < 2; ++k) dst[n][k] = *(const PG8_LAS bf16x8*)(lds + PG8_SB(b, h) + boff + n * 2048 + k * 1024); } while (0)
#define PG8_F8CAT(x) __builtin_shufflevector(__builtin_bit_cast(u32x4, (x)[0]), __builtin_bit_cast(u32x4, (x)[1]), 0, 1, 2, 3, 4, 5, 6, 7)
#define PG8_MMA(ai, bj, At, Bt) do { __builtin_amdgcn_s_setprio(1); if constexpr (F8) { _Pragma("unroll") for (int m = 0; m < 4; ++m) _Pragma("unroll") for (int n = 0; n < 2; ++n) \
        acc[ai][bj][m][n] = __builtin_amdgcn_mfma_scale_f32_16x16x128_f8f6f4(__builtin_bit_cast(v8i, PG8_F8CAT(Bt[n])), __builtin_bit_cast(v8i, PG8_F8CAT(At[m])), acc[ai][bj][m][n], 0, 0, 0, 0x7f7f7f7f, 0, 0x7f7f7f7f); \
        _Pragma("unroll") for (int m = 0; m < 4; ++m) _Pragma("unroll") for (int n = 0; n < 2; ++n) asm volatile("" : "+v"(acc[ai][bj][m][n])); } \
    else { _Pragma("unroll") for (int m = 0; m < 4; ++m) _Pragma("unroll") for (int n = 0; n < 2; ++n) _Pragma("unroll") for (int k = 0; k < 2; ++k) \
        acc[ai][bj][m][n] = __builtin_amdgcn_mfma_f32_16x16x32_bf16(Bt[n][k], At[m][k], acc[ai][bj][m][n], 0, 0, 0); } __builtin_amdgcn_s_setprio(0); } while (0)
#define PG8_WAIT_V(n) asm volatile("s_waitcnt vmcnt(" #n ")" ::: "memory")
#define PG8_WAIT_L(n) asm volatile("s_waitcnt lgkmcnt(" #n ")" ::: "memory")
#define PG8_BAR __builtin_amdgcn_s_barrier()
#define PG8_SCHED __builtin_amdgcn_sched_barrier(0)
    Unit cur, nxt; int ui = 0;
    if (!S.next(0, cur)) return;
    f32x4 acc[2][2][4][2];
#pragma unroll
    for (int a = 0; a < 2; ++a)
#pragma unroll
        for (int b = 0; b < 2; ++b)
#pragma unroll
            for (int m = 0; m < 4; ++m)
#pragma unroll
                for (int n = 0; n < 2; ++n) acc[a][b][m][n] = (f32x4){0.f, 0.f, 0.f, 0.f};
    bf16x8 At[4][2], B0[2][2], B1[2][2];
    const char* const gA = (const char*)g.A;
    const char* cA = (const char*)g.A + (size_t)cur.pm * tstepA; const char* cB = (const char*)g.Bt + (size_t)cur.pn * tstep;
    S.a_ready(cur);
    if constexpr (SP2) {
        if constexpr (GATHER) { PG8_TOKLD(tkn, cur.pm); PG8_TOKOFF(vC, tkn); Unit u1_; if (S.next(1, u1_)) { PG8_TOKLD(tkn, u1_.pm); PG8_TOKOFF(vN, tkn); } else { PG8_TOKOFF(vN, tkn); } }
        PG8_STAGE(PG8_SB(0, 0), cB, voffB); PG8_STAGE(PG8_SB(0, 1), cB + hstep, voffB);
        if constexpr (GATHER) { PG8_STAGE(PG8_SA(0, 0), gA, vC[0]); PG8_STAGE(PG8_SA(0, 1), gA, vC[1]); } else { PG8_STAGE(PG8_SA(0, 0), cA, voffA); PG8_STAGE(PG8_SA(0, 1), cA + hstepA, voffA); }
        if (wr == 1) PG8_BAR;
        PG8_WAIT_V(2); PG8_BAR;
        PG8_STAGE(PG8_SB(1, 0), cB + kstep, voffB); if constexpr (GATHER) { PG8_STAGE(PG8_SA(1, 0), gA + kstep, vC[0]); } else { PG8_STAGE(PG8_SA(1, 0), cA + kstep, voffA); } PG8_STAGE(PG8_SB(1, 1), cB + hstep + kstep, voffB);
        PG8_WAIT_V(6); PG8_BAR;
    } else {
        PG8_STAGE(PG8_SB(0, 0), cB, voffB); PG8_STAGE(PG8_SA(0, 0), cA, voffA); PG8_STAGE(PG8_SB(0, 1), cB + hstep, voffB); PG8_STAGE(PG8_SA(0, 1), cA + hstepA, voffA);
        if (wr == 1) PG8_BAR;
        PG8_WAIT_V(4); PG8_BAR;
        PG8_STAGE(PG8_SB(1, 0), cB + kstep, voffB); PG8_STAGE(PG8_SA(1, 0), cA + kstep, voffA); PG8_STAGE(PG8_SB(1, 1), cB + hstep + kstep, voffB);
        PG8_WAIT_V(6); PG8_BAR;
    }
    for (;;) {
        const bool has_next = S.next(ui + 1, nxt);
        const char* nA = has_next ? (const char*)g.A + (size_t)nxt.pm * tstepA : cA; const char* nB = has_next ? (const char*)g.Bt + (size_t)nxt.pn * tstep : cB;
        for (int t = 0; t < nt; t += 2) {
            const bool last = (t == nt - 2);
            const char* a1 = cA + (size_t)(t + 1) * kstep;
            const char* a2 = last ? nA : cA + (size_t)(t + 2) * kstep; const char* b2 = last ? nB : cB + (size_t)(t + 2) * kstep;
            const char* a3 = a2 + kstep; const char* b3 = b2 + kstep;
            if (last && has_next) S.a_ready(nxt);
            if constexpr (Hook::ON) { if (t == nt / 2) H.mid(acc, cur, wr, fr); }
            if constexpr (SP2) {
            const char* ga1 = gA + (size_t)(t + 1) * kstep; const char* ga2 = gA + (last ? (size_t)0 : (size_t)(t + 2) * kstep); const char* ga3 = ga2 + kstep;
            unsigned v2[2][2];
            if constexpr (GATHER) { _Pragma("unroll") for (int h_ = 0; h_ < 2; ++h_) _Pragma("unroll") for (int i_ = 0; i_ < 2; ++i_) v2[h_][i_] = last ? vN[h_][i_] : vC[h_][i_]; }
            PG8_LDB(B0, 0, 0); PG8_LDB(B1, 0, 1); PG8_SCHED; PG8_LDA(At, 0, 0); if constexpr (GATHER) { PG8_STAGE(PG8_SA(1, 1), ga1, vC[1]); } else { PG8_STAGE(PG8_SA(1, 1), a1 + hstepA, voffA); }
            PG8_WAIT_V(8); PG8_WAIT_L(0); PG8_BAR; PG8_MMA(0, 0, At, B0); PG8_MMA(0, 1, At, B1); PG8_BAR; PG8_SCHED;
            PG8_LDA(At, 0, 1); PG8_STAGE(PG8_SB(0, 0), b2, voffB); PG8_STAGE(PG8_SB(0, 1), b2 + hstep, voffB); if constexpr (GATHER) { PG8_STAGE(PG8_SA(0, 0), ga2, v2[0]); } else { PG8_STAGE(PG8_SA(0, 0), a2, voffA); }
            PG8_WAIT_V(8); PG8_WAIT_L(0); PG8_BAR; PG8_MMA(1, 0, At, B0); PG8_MMA(1, 1, At, B1); PG8_BAR; PG8_SCHED;
            PG8_LDB(B0, 1, 0); PG8_LDB(B1, 1, 1); PG8_SCHED; PG8_LDA(At, 1, 0); if constexpr (GATHER) { PG8_STAGE(PG8_SA(0, 1), ga2, v2[1]); } else { PG8_STAGE(PG8_SA(0, 1), a2 + hstepA, voffA); }
            PG8_WAIT_V(8); PG8_WAIT_L(0); PG8_BAR; PG8_MMA(0, 0, At, B0); PG8_MMA(0, 1, At, B1); PG8_BAR; PG8_SCHED;
            PG8_LDA(At, 1, 1); PG8_STAGE(PG8_SB(1, 0), b3, voffB); PG8_STAGE(PG8_SB(1, 1), b3 + hstep, voffB); if constexpr (GATHER) { PG8_STAGE(PG8_SA(1, 0), ga3, v2[0]); } else { PG8_STAGE(PG8_SA(1, 0), a3, voffA); }
            PG8_WAIT_V(8); PG8_WAIT_L(0); PG8_BAR; PG8_MMA(1, 0, At, B0); PG8_MMA(1, 1, At, B1); PG8_BAR; PG8_SCHED;
            } else {
            PG8_LDB(B0, 0, 0); PG8_SCHED; PG8_LDA(At, 0, 0); PG8_STAGE(PG8_SA(1, 1), a1 + hstepA, voffA);
            PG8_WAIT_L(8); PG8_BAR; PG8_WAIT_L(0); PG8_MMA(0, 0, At, B0); PG8_BAR; PG8_SCHED;
            PG8_LDB(B1, 0, 1); PG8_STAGE(PG8_SB(0, 0), b2, voffB);
            PG8_BAR; PG8_WAIT_L(0); PG8_MMA(0, 1, At, B1); PG8_BAR;
            PG8_LDA(At, 0, 1); PG8_STAGE(PG8_SA(0, 0), a2, voffA);
            PG8_BAR; PG8_WAIT_L(0); PG8_MMA(1, 0, At, B0); PG8_BAR; PG8_SCHED;
            PG8_STAGE(PG8_SB(0, 1), b2 + hstep, voffB);
            PG8_WAIT_V(6); PG8_BAR; PG8_MMA(1, 1, At, B1); PG8_BAR;
            PG8_LDB(B0, 1, 0); PG8_SCHED; PG8_LDA(At, 1, 0); PG8_STAGE(PG8_SA(0, 1), a2 + hstepA, voffA);
            PG8_WAIT_L(8); PG8_BAR; PG8_WAIT_L(0); PG8_MMA(0, 0, At, B0); PG8_BAR; PG8_SCHED;
            PG8_LDB(B1, 1, 1); PG8_STAGE(PG8_SB(1, 0), b3, voffB);
            PG8_BAR; PG8_WAIT_L(0); PG8_MMA(0, 1, At, B1); PG8_BAR;
            PG8_LDA(At, 1, 1); PG8_STAGE(PG8_SA(1, 0), a3, voffA);
            PG8_BAR; PG8_WAIT_L(0); PG8_MMA(1, 0, At, B0); PG8_BAR; PG8_SCHED;
            PG8_STAGE(PG8_SB(1, 1), b3 + hstep, voffB);
            PG8_WAIT_V(6); PG8_BAR; PG8_MMA(1, 1, At, B1); PG8_BAR;
            }
        }
        if constexpr (ALIGN_EPI) { if (wr == 0) PG8_BAR; }
        bool has_nn = false;
        if constexpr (GATHER) { Unit nn_; has_nn = has_next && S.next(ui + 2, nn_); if (has_nn) PG8_TOKLD(tkn, nn_.pm); }
        if constexpr (!Epi::AFTER_DRAIN) { E(acc, cur, wr, wc, fr, fq); S.done(cur); }
        if (!has_next) break;
        if constexpr (GATHER) { _Pragma("unroll") for (int h_ = 0; h_ < 2; ++h_) _Pragma("unroll") for (int i_ = 0; i_ < 2; ++i_) vC[h_][i_] = vN[h_][i_]; if (has_nn) PG8_TOKOFF(vN, tkn); }
#pragma unroll
        for (int a = 0; a < 2; ++a)
#pragma unroll
            for (int b = 0; b < 2; ++b)
#pragma unroll
                for (int m = 0; m < 4; ++m)
#pragma unroll
                    for (int n = 0; n < 2; ++n) acc[a][b][m][n] = (f32x4){0.f, 0.f, 0.f, 0.f};
        cur = nxt; cA = nA; cB = nB; ++ui;
        if constexpr (ALIGN_EPI) { if (wr == 1) PG8_BAR; }
    }
    PG8_WAIT_V(0);
    if constexpr (!ALIGN_EPI) { if (wr == 0) PG8_BAR; }
    PG8_BAR;
#undef PG8_SA
#undef PG8_SB
#undef PG8_STAGE
#undef PG8_LDA
#undef PG8_LDB
#undef PG8_MMA
#undef PG8_F8CAT
#undef PG8_TOKLD
#undef PG8_TOKOFF
#undef PG8_WAIT_V
#undef PG8_WAIT_L
#undef PG8_BAR
#undef PG8_SCHED
}
}

__device__ __forceinline__ u32x4 f8_pair16(u32x2 rowA, u32x2 rowB) {
    const auto s0 = __builtin_amdgcn_permlane16_swap(rowA.x, rowB.x, false, false), s1 = __builtin_amdgcn_permlane16_swap(rowA.y, rowB.y, false, false);
    return (u32x4){s0[0], s1[0], s0[1], s1[1]};
}
struct EpiGU8 { static constexpr bool PERM = true, AFTER_DRAIN = false;
    unsigned char* act8; const float* bgu;
    __device__ __forceinline__ void operator()(const f32x4 (&acc)[2][2][4][2], const pg8::Unit& u, int wr, int wc, int fr, int fq) const {
        const int e = u.pn >> 3, ac0 = 128 * (u.pn & 7) + wc * 32 + 8 * fq;
        const float* bb = bgu + (size_t)e * 2048 + 2 * ac0;
        const f32x4 q0 = *(const f32x4*)bb, q1 = *(const f32x4*)(bb + 4), q2 = *(const f32x4*)(bb + 8), q3 = *(const f32x4*)(bb + 12);
        const float bg[8] = {q0[0], q0[2], q1[0], q1[2], q2[0], q2[2], q3[0], q3[2]}, bl[8] = {q0[1], q0[3], q1[1], q1[3], q2[1], q2[3], q3[1], q3[3]};
        const int odd = fq & 1, acs = ac0 - 8 * odd;
#pragma unroll
        for (int ai = 0; ai < 2; ++ai)
#pragma unroll
            for (int mp = 0; mp < 2; ++mp) { u32x2 pk[2];
#pragma unroll
                for (int h = 0; h < 2; ++h) { const int m = 2 * mp + h; float o[8];
#pragma unroll
                    for (int t = 0; t < 8; t += 2) {
                        const f32x2 ag = {acc[ai][0][m][t >> 2][t & 3], acc[ai][0][m][(t + 1) >> 2][(t + 1) & 3]}, al = {acc[ai][1][m][t >> 2][t & 3], acc[ai][1][m][(t + 1) >> 2][(t + 1) & 3]};
                        f32x2 xg = ag * W8_INV + (f32x2){bg[t], bg[t + 1]}, xl = al * W8_INV + (f32x2){bl[t], bl[t + 1]};
                        xg.x = fminf(xg.x, 7.f); xg.y = fminf(xg.y, 7.f); xl.x = __builtin_amdgcn_fmed3f(xl.x, -7.f, 7.f); xl.y = __builtin_amdgcn_fmed3f(xl.y, -7.f, 7.f);
                        const f32x2 ex = xg * (-1.702f * 1.4426950408889634f); f32x2 dn; dn.x = __builtin_amdgcn_exp2f(ex.x); dn.y = __builtin_amdgcn_exp2f(ex.y); dn = dn + 1.f;
                        f32x2 sg; sg.x = __builtin_amdgcn_rcpf(dn.x); sg.y = __builtin_amdgcn_rcpf(dn.y);
                        const f32x2 pq = xg * sg, ov = pq * xl + pq; o[t] = ov.x; o[t + 1] = ov.y; }
                    pk[h] = (u32x2){pack4_f8(o[0], o[1], o[2], o[3]), pack4_f8(o[4], o[5], o[6], o[7])}; }
                const int row = u.pm * 256 + ai * 128 + wr * 64 + (2 * mp + odd) * 16 + fr;
                *(u32x4*)(act8 + (size_t)row * DM + acs) = f8_pair16(pk[0], pk[1]); }
    } };
constexpr float O2_SCALE = 8.f, O2_INV = 1.f / 8.f;
struct EpiDN8 { static constexpr bool PERM = true, AFTER_DRAIN = false;
    unsigned char* out2; const float* bdn; const float* row_gate;
    __device__ __forceinline__ void operator()(const f32x4 (&acc)[2][2][4][2], const pg8::Unit& u, int wr, int wc, int fr, int fq) const {
        const int e = u.pn >> 2, c0 = 256 * (u.pn & 3) + wc * 32 + 8 * fq;
        f32x4 bv[2][2];
#pragma unroll
        for (int bj = 0; bj < 2; ++bj) { bv[bj][0] = *(const f32x4*)(bdn + (size_t)e * DM + c0 + bj * 128); bv[bj][1] = *(const f32x4*)(bdn + (size_t)e * DM + c0 + bj * 128 + 4); }
        const int odd = fq & 1, cs = c0 - 8 * odd;
#pragma unroll
        for (int ai = 0; ai < 2; ++ai)
#pragma unroll
            for (int mp = 0; mp < 2; ++mp) { u32x2 pk[2][2];
#pragma unroll
                for (int h = 0; h < 2; ++h) { const int m = 2 * mp + h; const float g = row_gate[u.pm * 256 + ai * 128 + wr * 64 + m * 16 + fr] * O2_SCALE;
#pragma unroll
                    for (int bj = 0; bj < 2; ++bj) { const f32x4 v0 = (acc[ai][bj][m][0] * W8_INV + bv[bj][0]) * g, v1 = (acc[ai][bj][m][1] * W8_INV + bv[bj][1]) * g;
                        pk[bj][h] = (u32x2){pack4_f8(v0[0], v0[1], v0[2], v0[3]), pack4_f8(v1[0], v1[1], v1[2], v1[3])}; } }
                const int row = u.pm * 256 + ai * 128 + wr * 64 + (2 * mp + odd) * 16 + fr;
#pragma unroll
                for (int bj = 0; bj < 2; ++bj) *(u32x4*)(out2 + (size_t)row * DM + cs + bj * 128) = f8_pair16(pk[bj][0], pk[bj][1]); }
    } };

struct HookO { static constexpr bool ON = true; const LAS f32x2* T;
    __device__ __forceinline__ void mid(f32x4 (&acc)[2][2][4][2], const pg8::Unit& u, int wr, int fr) const {
#pragma unroll
        for (int ai = 0; ai < 2; ++ai)
#pragma unroll
            for (int m = 0; m < 4; ++m) { const float r = T[u.ui * 256 + ai * 128 + wr * 64 + m * 16 + fr].x;
#pragma unroll
                for (int bj = 0; bj < 2; ++bj) { acc[ai][bj][m][0] = acc[ai][bj][m][0] * r; acc[ai][bj][m][1] = acc[ai][bj][m][1] * r; } }
    } };
struct EpiOF { static constexpr bool PERM = true, AFTER_DRAIN = false;
    bf16* y1; const bf16* h0; const LAS f32x2* T;
    __device__ __forceinline__ void operator()(const f32x4 (&acc)[2][2][4][2], const pg8::Unit& u, int wr, int wc, int fr, int fq) const {
        const int c0 = u.pn * 256 + wc * 32 + 8 * fq;
#pragma unroll
        for (int ai = 0; ai < 2; ++ai)
#pragma unroll
            for (int m = 0; m < 4; ++m) { const int rl = ai * 128 + wr * 64 + m * 16 + fr, row = u.pm * 256 + rl; const float r = T[u.ui * 256 + rl].y;
#pragma unroll
                for (int bj = 0; bj < 2; ++bj) { float h[8]; unpack8(*(const u32x4*)(h0 + (size_t)row * DM + c0 + bj * 128), h);
                    const f32x4 a = acc[ai][bj][m][0] * r, b = acc[ai][bj][m][1] * r;
                    const float o[8] = {ALPHA * h[0] + a[0], ALPHA * h[1] + a[1], ALPHA * h[2] + a[2], ALPHA * h[3] + a[3], ALPHA * h[4] + b[0], ALPHA * h[5] + b[1], ALPHA * h[6] + b[2], ALPHA * h[7] + b[3]};
                    *(u32x4*)(y1 + (size_t)row * DM + c0 + bj * 128) = pack8(o); } }
    } };

struct EpiZF { static constexpr bool PERM = true, AFTER_DRAIN = false;
    bf16* z; float* rs_q; float* rs_kv; bf16* km; bf16* qg; bf16* kg; bf16* vg; const float* rope; const float* g_q; const float* g_k; LAS float* X;
    __device__ __forceinline__ void operator()(const f32x4 (&acc)[2][2][4][2], const pg8::Unit& u, int wr, int wc, int fr, int fq) const {
        const int pn = u.pn, cw = wc * 32 + 8 * fq;
        LAS float* Xa = X + (wr * 64 + fr) * 4; LAS float* Xb = X + (wr * 64 + fr) * 8;
        asm volatile("" : "+v"(Xa)); asm volatile("" : "+v"(Xb));
        if (pn <= 1) {
#pragma unroll
            for (int ai = 0; ai < 2; ++ai)
#pragma unroll
                for (int m = 0; m < 4; ++m) { const int rl = ai * 128 + wr * 64 + m * 16 + fr, row = u.pm * 256 + rl; float ss = 0.f;
#pragma unroll
                    for (int bj = 0; bj < 2; ++bj) { const f32x4 a = acc[ai][bj][m][0], b = acc[ai][bj][m][1];
                        if (bj == 0 || pn == 0) ss += (a[0] * a[0] + a[1] * a[1]) + (a[2] * a[2] + a[3] * a[3]) + (b[0] * b[0] + b[1] * b[1]) + (b[2] * b[2] + b[3] * b[3]);
                        *(u32x4*)(z + (size_t)row * ZLD + pn * 256 + bj * 128 + cw) = (u32x4){cvtpk(a[0], a[1]), cvtpk(a[2], a[3]), cvtpk(b[0], b[1]), cvtpk(b[2], b[3])}; }
                    ss += __shfl_xor(ss, 16); ss += __shfl_xor(ss, 32);
                    if (fq == 0) Xa[(ai * 128 + m * 16) * 4 + wc] = ss;
                    if (pn == 1 && wc < 2) {
                        const int b_ = row >> 11, s_ = row & 2047; const float* t = rope + ((size_t)(16 + s_ + 1) * 32 + (cw >> 1)) * 2; const f32x4 t0 = *(const f32x4*)t, t1 = *(const f32x4*)(t + 4);
                        const f32x4 a = acc[ai][1][m][0], b = acc[ai][1][m][1];
                        const u32x4 pk = {cvtpk(a[0] * t0[0] - a[1] * t0[1], a[0] * t0[1] + a[1] * t0[0]), cvtpk(a[2] * t0[2] - a[3] * t0[3], a[2] * t0[3] + a[3] * t0[2]),
                                          cvtpk(b[0] * t1[0] - b[1] * t1[1], b[0] * t1[1] + b[1] * t1[0]), cvtpk(b[2] * t1[2] - b[3] * t1[3], b[2] * t1[3] + b[3] * t1[2])};
#pragma unroll
                        for (int h = 0; h < 4; ++h) *(u32x4*)(km + ((size_t)(b_ * 4 + h) * LKP + s_) * 192 + 128 + cw) = pk; } }
            asm volatile("s_waitcnt lgkmcnt(0)" ::: "memory"); __builtin_amdgcn_s_barrier(); asm volatile("" ::: "memory");
            if (wc == 0 && fq == 0) {
#pragma unroll
                for (int ai = 0; ai < 2; ++ai)
#pragma unroll
                    for (int m = 0; m < 4; ++m) { const int rl = ai * 128 + wr * 64 + m * 16 + fr; const f32x4 x = *(const LAS f32x4*)(Xa + (ai * 128 + m * 16) * 4); const float tot = (x[0] + x[1]) + (x[2] + x[3]);
                        if (pn == 0) rs_q[u.pm * 256 + rl] = rsq(tot * (1.f / 256) + RMS_EPS); else rs_kv[u.pm * 256 + rl] = rsq(tot * (1.f / 128) + RMS_EPS); } }
        } else if (pn <= 4) {
            const int half = cw >> 6, i0 = (cw & 63) >> 1; const float* gp = (pn == 4 ? g_k : g_q) + half * 64 + i0;
            const f32x4 g1 = *(const f32x4*)gp, g2 = *(const f32x4*)(gp + 32);
#pragma unroll
            for (int ai = 0; ai < 2; ++ai)
#pragma unroll
                for (int m = 0; m < 4; ++m) { const int rl = ai * 128 + wr * 64 + m * 16 + fr;
#pragma unroll
                    for (int bj = 0; bj < 2; ++bj) { const f32x4 a = acc[ai][bj][m][0], b = acc[ai][bj][m][1];
                        float ss = (a[0] * a[0] + a[1] * a[1]) + (a[2] * a[2] + a[3] * a[3]) + (b[0] * b[0] + b[1] * b[1]) + (b[2] * b[2] + b[3] * b[3]);
                        ss += __shfl_xor(ss, 16); ss += __shfl_xor(ss, 32);
                        if (fq == 0) Xb[((ai * 128 + m * 16) * 2 + bj) * 4 + wc] = ss; } }
            asm volatile("s_waitcnt lgkmcnt(0)" ::: "memory"); __builtin_amdgcn_s_barrier(); asm volatile("" ::: "memory");
#pragma unroll
            for (int ai = 0; ai < 2; ++ai)
#pragma unroll
                for (int m = 0; m < 4; ++m) { const int rl = ai * 128 + wr * 64 + m * 16 + fr, row = u.pm * 256 + rl, b_ = row >> 11, s_ = row & 2047;
                    const int apos = half ? (s_ & 63) : (s_ >> 6); const float* t = rope + ((size_t)(apos + 1) * 32 + i0) * 2; const f32x4 t0 = *(const f32x4*)t, t1 = *(const f32x4*)(t + 4);
#pragma unroll
                    for (int bj = 0; bj < 2; ++bj) { const f32x4 x = *(const LAS f32x4*)(Xb + ((ai * 128 + m * 16) * 2 + bj) * 4); const float rs = rsq(((x[0] + x[1]) + (x[2] + x[3])) * (1.f / 128) + RMS_EPS);
                        const f32x4 a = acc[ai][bj][m][0] * rs, b = acc[ai][bj][m][1] * rs;
                        const float x0 = a[0] * g1[0], y0 = a[1] * g2[0], x1 = a[2] * g1[1], y1 = a[3] * g2[1], x2 = b[0] * g1[2], y2 = b[1] * g2[2], x3 = b[2] * g1[3], y3 = b[3] * g2[3];
                        const u32x4 pk = {cvtpk(x0 * t0[0] - y0 * t0[1], x0 * t0[1] + y0 * t0[0]), cvtpk(x1 * t0[2] - y1 * t0[3], x1 * t0[3] + y1 * t0[2]),
                                          cvtpk(x2 * t1[0] - y2 * t1[1], x2 * t1[1] + y2 * t1[0]), cvtpk(x3 * t1[2] - y3 * t1[3], x3 * t1[3] + y3 * t1[2])};
                        if (pn == 4) *(u32x4*)(kg + ((size_t)(b_ * 2 + bj) * LKP + s_) * 128 + cw) = pk;
                        else *(u32x4*)(qg + ((size_t)(b_ * 4 + (pn - 2) * 2 + bj) * 2048 + s_) * 128 + cw) = pk; } }
        } else {
#pragma unroll
            for (int ai = 0; ai < 2; ++ai)
#pragma unroll
                for (int m = 0; m < 4; ++m) { const int row = u.pm * 256 + ai * 128 + wr * 64 + m * 16 + fr, b_ = row >> 11, s_ = row & 2047;
#pragma unroll
                    for (int bj = 0; bj < 2; ++bj) { const f32x4 a = acc[ai][bj][m][0], b = acc[ai][bj][m][1];
                        *(u32x4*)(vg + ((size_t)(b_ * 2 + bj) * LKP + s_) * 128 + cw) = (u32x4){cvtpk(a[0], a[1]), cvtpk(a[2], a[3]), cvtpk(b[0], b[1]), cvtpk(b[2], b[3])}; } }
        }
    } };
#ifndef FAST_Z
#define FAST_Z 1
#endif
#ifndef FAST_O
#define FAST_O 1
#endif

struct MapId { __device__ __forceinline__ int operator()(int n) const { return n; } };
struct MapIn { __device__ __forceinline__ int operator()(int n) const {
    if (n < 384) return n;
    if (n < 448) { const int l = n - 384; return 384 + 2 * (l & 31) + (l >> 5); }
    if (n < 1216) { const int l = n - 448, hd = l >> 7, d = l & 127; return 512 + hd * 128 + (d >> 6) * 64 + 2 * (d & 31) + ((d >> 5) & 1); }
    return 1280 + (n - 1216); } };
struct MapQ { __device__ __forceinline__ int operator()(int n) const { const int h = n / 192, w = n - h * 192; if (w < 128) return n; const int l = w - 128; return h * 192 + 128 + 2 * (l & 31) + (l >> 5); } };
struct MapGU { __device__ __forceinline__ int operator()(int n) const { const int a = n >> 1; return 256 * (a >> 7) + 128 * (n & 1) + (a & 127); } };
template <class Map>
__device__ __forceinline__ void transpose_item(const float* __restrict__ W, int K, int N, bf16* __restrict__ WT, LAS float* scr, int item, int lane, const Map& map, const float* __restrict__ kscale = nullptr, int ldo = 0, const float* __restrict__ kscale2 = nullptr) {
    if (ldo == 0) ldo = K;
    const int nblk = N / 32, kb = item / nblk, nb = item - kb * nblk, k0 = 64 * kb, n0 = 32 * nb;
#pragma unroll 8
    for (int i = 0; i < 32; ++i) { const int kk = 2 * i + (lane >> 5); scr[kk * 33 + (lane & 31)] = (k0 < K) ? W[(size_t)(k0 + kk) * N + n0 + (lane & 31)] * (kscale ? ((kscale2 && k0 + kk >= 512) ? kscale2[k0 + kk - 512] : kscale[k0 + kk]) : 1.f) : 0.f; }
    LDS_WAIT(); asm volatile("" ::: "memory");
    const int c = lane & 7;
#pragma unroll
    for (int j = 0; j < 4; ++j) { const int n = (lane >> 3) + 8 * j; const LAS float* s = scr + (8 * c) * 33 + n;
        u32x4 o; o.x = cvtpk(s[0 * 33], s[1 * 33]); o.y = cvtpk(s[2 * 33], s[3 * 33]); o.z = cvtpk(s[4 * 33], s[5 * 33]); o.w = cvtpk(s[6 * 33], s[7 * 33]);
        *(u32x4*)(WT + (size_t)map(n0 + n) * ldo + k0 + 8 * c) = o; }
    LDS_WAIT(); asm volatile("" ::: "memory");
}

template <class Map>
__device__ __forceinline__ void transpose_item_f8(const float* __restrict__ W, int K, int N, unsigned char* __restrict__ WT, LAS float* scr, int item, int lane, const Map& map, float scale) {
    const int nblk = N / 32, kb = item / nblk, nb = item - kb * nblk, k0 = 64 * kb, n0 = 32 * nb;
#pragma unroll 8
    for (int i = 0; i < 8; ++i) { const int kk = 8 * i + (lane >> 3), c4 = (lane & 7) * 4; const f32x4 w4 = *(const f32x4*)(W + (size_t)(k0 + kk) * N + n0 + c4) * scale;
        LAS float* d_ = scr + kk * 33 + c4; d_[0] = w4[0]; d_[1] = w4[1]; d_[2] = w4[2]; d_[3] = w4[3]; }
    LDS_WAIT(); asm volatile("" ::: "memory");
    const int n = lane >> 1;
#pragma unroll
    for (int j = 0; j < 2; ++j) { const int c = 2 * (lane & 1) + j; const LAS float* s_ = scr + (16 * c) * 33 + n;
        u32x4 o; o.x = pack4_f8(s_[0 * 33], s_[1 * 33], s_[2 * 33], s_[3 * 33]); o.y = pack4_f8(s_[4 * 33], s_[5 * 33], s_[6 * 33], s_[7 * 33]);
        o.z = pack4_f8(s_[8 * 33], s_[9 * 33], s_[10 * 33], s_[11 * 33]); o.w = pack4_f8(s_[12 * 33], s_[13 * 33], s_[14 * 33], s_[15 * 33]);
        *(u32x4*)(WT + (size_t)map(n0 + n) * K + k0 + 16 * c) = o; }
    LDS_WAIT(); asm volatile("" ::: "memory");
}

template <class Map>
__device__ __forceinline__ void transpose_f8_stream(const float* __restrict__ Wall, int N, unsigned char* __restrict__ WTall, LAS float* scr, int gw, int ngw, int lane, const Map& map, float scale) {
    const int nblk = N / 32, per = 16 * nblk, n_items = NE * per;
#define T8_LOAD(dst, it_) do { const int e_ = (it_) / per, r_ = (it_) - e_ * per, kb_ = r_ / nblk, nb_ = r_ - kb_ * nblk; \
        const float* wp_ = Wall + ((size_t)e_ * 1024 + 64 * kb_ + (lane >> 3)) * N + 32 * nb_ + (lane & 7) * 4; \
        _Pragma("unroll") for (int i = 0; i < 8; ++i) dst[i] = *(const f32x4*)(wp_ + (size_t)(8 * i) * N); } while (0)
    f32x4 cur[8], nxt[8];
    int it = gw; if (it < n_items) T8_LOAD(cur, it);
    for (; it < n_items; it += ngw) {
        const int itn = it + ngw; if (itn < n_items) T8_LOAD(nxt, itn);
        const int e = it / per, r = it - e * per, kb = r / nblk, nb = r - kb * nblk, k0 = 64 * kb, n0 = 32 * nb;
#pragma unroll
        for (int i = 0; i < 8; ++i) { LAS float* d_ = scr + (8 * i + (lane >> 3)) * 33 + (lane & 7) * 4; const f32x4 w4 = cur[i] * scale; d_[0] = w4[0]; d_[1] = w4[1]; d_[2] = w4[2]; d_[3] = w4[3]; }
        LDS_WAIT(); asm volatile("" ::: "memory");
        const int n = lane >> 1;
#pragma unroll
        for (int j = 0; j < 2; ++j) { const int c = 2 * (lane & 1) + j; const LAS float* s_ = scr + (16 * c) * 33 + n;
            u32x4 o; o.x = pack4_f8(s_[0 * 33], s_[1 * 33], s_[2 * 33], s_[3 * 33]); o.y = pack4_f8(s_[4 * 33], s_[5 * 33], s_[6 * 33], s_[7 * 33]);
            o.z = pack4_f8(s_[8 * 33], s_[9 * 33], s_[10 * 33], s_[11 * 33]); o.w = pack4_f8(s_[12 * 33], s_[13 * 33], s_[14 * 33], s_[15 * 33]);
            *(u32x4*)(WTall + ((size_t)e * N + map(n0 + n)) * 1024 + k0 + 16 * c) = o; }
        LDS_WAIT(); asm volatile("" ::: "memory");
#pragma unroll
        for (int i = 0; i < 8; ++i) cur[i] = nxt[i];
    }
#undef T8_LOAD
}
__device__ __forceinline__ void ln_row_f32_to_bf16(f32x4 (&v)[4], const f32x4 (&gg)[4], const f32x4 (&bb)[4], bf16* __restrict__ orow, int lane) {
    float s = 0.f;
#pragma unroll
    for (int j = 0; j < 4; ++j) s += (v[j].x + v[j].y) + (v[j].z + v[j].w);
    const float mean = wave_sum(s) * (1.f / DM); float s2 = 0.f;
#pragma unroll
    for (int j = 0; j < 4; ++j) { v[j] = v[j] - mean; s2 += (v[j].x * v[j].x + v[j].y * v[j].y) + (v[j].z * v[j].z + v[j].w * v[j].w); }
    const float rstd = rsq(wave_sum(s2) * (1.f / DM) + LN_EPS);
#pragma unroll
    for (int j = 0; j < 4; ++j) { const f32x4 o = v[j] * rstd * gg[j] + bb[j]; ((u32x2*)orow)[lane + 64 * j] = (u32x2){cvtpk(o.x, o.y), cvtpk(o.z, o.w)}; }
}

__device__ __forceinline__ void ln_row_bf16(const bf16* __restrict__ yrow, const f32x4 (&G4)[4], const f32x4 (&B4)[4], bf16* __restrict__ orow, unsigned char* __restrict__ o8, int lane) {
    float v[16]; unpack8(*(const u32x4*)(yrow + 8 * lane), *(float(*)[8])&v[0]); unpack8(*(const u32x4*)(yrow + 512 + 8 * lane), *(float(*)[8])&v[8]);
    float s = 0.f;
#pragma unroll
    for (int j = 0; j < 16; ++j) s += v[j];
    const float mean = wave_sum(s) * (1.f / DM); float s2 = 0.f;
#pragma unroll
    for (int j = 0; j < 16; ++j) { v[j] -= mean; s2 += v[j] * v[j]; }
    const float rstd = rsq(wave_sum(s2) * (1.f / DM) + LN_EPS);
#pragma unroll
    for (int hf = 0; hf < 2; ++hf) { const f32x4 a = (f32x4){v[hf * 8 + 0], v[hf * 8 + 1], v[hf * 8 + 2], v[hf * 8 + 3]} * rstd * G4[2 * hf] + B4[2 * hf], b = (f32x4){v[hf * 8 + 4], v[hf * 8 + 5], v[hf * 8 + 6], v[hf * 8 + 7]} * rstd * G4[2 * hf + 1] + B4[2 * hf + 1];
        *(u32x4*)(orow + hf * 512 + 8 * lane) = (u32x4){cvtpk(a[0], a[1]), cvtpk(a[2], a[3]), cvtpk(b[0], b[1]), cvtpk(b[2], b[3])};
        *(u32x2*)(o8 + hf * 512 + 8 * lane) = (u32x2){pack4_f8(a[0], a[1], a[2], a[3]), pack4_f8(b[0], b[1], b[2], b[3])}; }
}
__device__ __forceinline__ void zero_bytes(void* p, size_t bytes, int gtid, int ngt) {
    u32x4* q = (u32x4*)p; const size_t n = bytes / 16;
    for (size_t i = gtid; i < n; i += ngt) q[i] = (u32x4){0u, 0u, 0u, 0u};
}
__device__ __forceinline__ void sincos_d(float angf, float& sn, float& cs) {
    const double x = (double)angf; const double q = __builtin_rint(x * 0.63661977236758134308);
    const double r = (x - q * 1.57079632679489655800) - q * 6.123233995736766036e-17, r2 = r * r;
    const double sp = r * (1.0 + r2 * (-1.0 / 6 + r2 * (1.0 / 120 + r2 * (-1.0 / 5040 + r2 * (1.0 / 362880 + r2 * (-1.0 / 39916800 + r2 * (1.0 / 6227020800.0)))))));
    const double cp = 1.0 + r2 * (-0.5 + r2 * (1.0 / 24 + r2 * (-1.0 / 720 + r2 * (1.0 / 40320 + r2 * (-1.0 / 3628800 + r2 * (1.0 / 479001600.0))))));
    const int qi = ((int)q) & 3;
    const double s_ = (qi == 0) ? sp : (qi == 1) ? cp : (qi == 2) ? -sp : -cp;
    const double c_ = (qi == 0) ? cp : (qi == 1) ? -sp : (qi == 2) ? -cp : sp;
    sn = (float)s_; cs = (float)c_;
}

__device__ __forceinline__ void p2a_row(int row, u32x4 wA, u32x4 wB, u32x4 wC, const float* __restrict__ rope, const float* __restrict__ g_q_a, const float* __restrict__ g_kv_a,
                                        const float* __restrict__ g_q_gqa, const float* __restrict__ g_k_gqa, float* rs_q, float* rs_kv, bf16* km, bf16* qg, bf16* kg, bf16* vg, int lane) {
    const bool meta = row >= NTOK;
    const int b = row >> 11, s = row & 2047, m = row - NTOK;
    const int pos1 = meta ? m : 16 + s, prow = meta ? -1 : (s >> 6), pcol = meta ? m : (s & 63), key = meta ? 2048 + m : s;
    {
        float f[8]; unpack8(wA, f);
        float ss = 0.f;
#pragma unroll
        for (int j = 0; j < 8; ++j) ss += f[j] * f[j];
        ss += __shfl_xor(ss, 1); ss += __shfl_xor(ss, 2); ss += __shfl_xor(ss, 4); ss += __shfl_xor(ss, 8);
        const float s16 = ss, s32 = ss + __shfl_xor(ss, 16);
        if (lane == 0) rs_q[row] = rsq(s32 * (1.f / 256) + RMS_EPS);
        if (lane == 32) rs_kv[row] = rsq(s16 * (1.f / 128) + RMS_EPS);
        if (lane < 48) {
        } else if (lane < 56) { const int i0 = 4 * (lane - 48); const float* t = rope + ((size_t)(pos1 + 1) * 32 + i0) * 2; float o[8];
#pragma unroll
            for (int j = 0; j < 4; ++j) { const float c = t[2 * j], sn = t[2 * j + 1], x1 = f[2 * j], x2 = f[2 * j + 1]; o[2 * j] = x1 * c - x2 * sn; o[2 * j + 1] = x1 * sn + x2 * c; }
            const u32x4 pk = pack8(o);
            if (!meta) { for (int h = 0; h < 4; ++h) *(u32x4*)(km + ((size_t)(b * 4 + h) * LKP + key) * 192 + 128 + 8 * (lane - 48)) = pk; }
            else { for (int bb = 0; bb < NB; ++bb) for (int h = 0; h < 4; ++h) *(u32x4*)(km + ((size_t)(bb * 4 + h) * LKP + key) * 192 + 128 + 8 * (lane - 48)) = pk; }
        }
    }
    const int p0 = (lane & 15) * 8, half = p0 >> 6, i0 = (p0 & 63) >> 1;
    const int apos = half ? pcol : prow; const float* t = rope + ((size_t)(apos + 1) * 32 + i0) * 2;
    if (!meta) {
        float f[8]; unpack8(wB, f);
        float ss = 0.f;
#pragma unroll
        for (int j = 0; j < 8; ++j) ss += f[j] * f[j];
        ss += __shfl_xor(ss, 1); ss += __shfl_xor(ss, 2); ss += __shfl_xor(ss, 4); ss += __shfl_xor(ss, 8);
        const float rs = rsq(ss * (1.f / 128) + RMS_EPS); float o[8];
#pragma unroll
        for (int j = 0; j < 4; ++j) { const int d1 = half * 64 + i0 + j, d2 = d1 + 32;
            const float x1 = f[2 * j] * rs * g_q_gqa[d1], x2 = f[2 * j + 1] * rs * g_q_gqa[d2], c = t[2 * j], sn = t[2 * j + 1];
            o[2 * j] = x1 * c - x2 * sn; o[2 * j + 1] = x1 * sn + x2 * c; }
        *(u32x4*)(qg + ((size_t)(b * 4 + (lane >> 4)) * 2048 + s) * 128 + p0) = pack8(o);
    }
    {
        float f[8]; unpack8(wC, f);
        float ss = 0.f;
#pragma unroll
        for (int j = 0; j < 8; ++j) ss += f[j] * f[j];
        ss += __shfl_xor(ss, 1); ss += __shfl_xor(ss, 2); ss += __shfl_xor(ss, 4); ss += __shfl_xor(ss, 8);
        float o[8];
        if (lane < 32) { const float rs = rsq(ss * (1.f / 128) + RMS_EPS);
#pragma unroll
            for (int j = 0; j < 4; ++j) { const int d1 = half * 64 + i0 + j, d2 = d1 + 32;
                const float x1 = f[2 * j] * rs * g_k_gqa[d1], x2 = f[2 * j + 1] * rs * g_k_gqa[d2], c = t[2 * j], sn = t[2 * j + 1];
                o[2 * j] = x1 * c - x2 * sn; o[2 * j + 1] = x1 * sn + x2 * c; }
        } else {
#pragma unroll
            for (int j = 0; j < 8; ++j) o[j] = f[j];
        }
        const u32x4 pk = pack8(o); bf16* dst = lane < 32 ? kg : vg; const int hk = (lane >> 4) & 1;
        if (!meta) *(u32x4*)(dst + ((size_t)(b * 2 + hk) * LKP + key) * 128 + p0) = pk;
        else for (int bb = 0; bb < NB; ++bb) *(u32x4*)(dst + ((size_t)(bb * 2 + hk) * LKP + key) * 128 + p0) = pk;
    }
}

__device__ __forceinline__ int crow(int r, int hi) { return (r & 3) + 8 * (r >> 2) + 4 * hi; }
__device__ __forceinline__ int v_st(int k, int c) { const int kk = (k & ~0xC) | ((k & 4) << 1) | ((k & 8) >> 1); return ((kk >> 3) * 4 + (c >> 5)) * 512 + ((kk & 7) * 32 + (c & 31)) * 2; }
__device__ __forceinline__ int v_rd_base(int lane) { return ((lane & 3) << 3) | (((lane >> 2) & 3) << 6) | (((lane >> 4) & 1) << 5) | (((lane >> 5) & 1) << 8); }
constexpr int v_rd_off(int d0, int ks, int half) { return d0 * 512 + ks * 4096 + half * 2048; }
template <int OFF> __device__ __forceinline__ s16x4 tr_read(int vb) {
    s16x4 r; asm volatile("ds_read_b64_tr_b16 %0, %1 offset:%2" : "=&v"(r) : "v"(vb), "i"(OFF) : "memory"); return r;
}
template <int D0> __device__ __forceinline__ void pv_one(f32x16& od, int vb, bf16x8 pa0, bf16x8 pa1, bf16x8 pa2, bf16x8 pa3) {
    const s16x4 l0 = tr_read<v_rd_off(D0, 0, 0)>(vb), h0 = tr_read<v_rd_off(D0, 0, 1)>(vb), l1 = tr_read<v_rd_off(D0, 1, 0)>(vb), h1 = tr_read<v_rd_off(D0, 1, 1)>(vb);
    const s16x4 l2 = tr_read<v_rd_off(D0, 2, 0)>(vb), h2 = tr_read<v_rd_off(D0, 2, 1)>(vb), l3 = tr_read<v_rd_off(D0, 3, 0)>(vb), h3 = tr_read<v_rd_off(D0, 3, 1)>(vb);
    asm volatile("s_waitcnt lgkmcnt(0)" ::: "memory"); SBAR();
#define PK(L, H) (bf16x8){L[0], L[1], L[2], L[3], H[0], H[1], H[2], H[3]}
    od = __builtin_amdgcn_mfma_f32_32x32x16_bf16(pa0, PK(l0, h0), od, 0, 0, 0);
    od = __builtin_amdgcn_mfma_f32_32x32x16_bf16(pa1, PK(l1, h1), od, 0, 0, 0);
    od = __builtin_amdgcn_mfma_f32_32x32x16_bf16(pa2, PK(l2, h2), od, 0, 0, 0);
    od = __builtin_amdgcn_mfma_f32_32x32x16_bf16(pa3, PK(l3, h3), od, 0, 0, 0);
#undef PK
}
__device__ __forceinline__ void pv_d0(f32x16* o, int vb, bf16x8 pa0, bf16x8 pa1, bf16x8 pa2, bf16x8 pa3) {
    pv_one<0>(o[0], vb, pa0, pa1, pa2, pa3); pv_one<1>(o[1], vb, pa0, pa1, pa2, pa3); pv_one<2>(o[2], vb, pa0, pa1, pa2, pa3); pv_one<3>(o[3], vb, pa0, pa1, pa2, pa3);
}
template <int DQK> struct AttnC {
    static constexpr float SCALE = DQK == 192 ? 0.07216878364870322f : 0.08838834764831845f;
    static constexpr float C = SCALE * 1.4426950408889634f, THRS = 8.f / SCALE;
};
template <int DQK>
__device__ __forceinline__ void partialSM(f32x16& p0, f32x16& p1, float& m_reg, float& mn, float& alpha) {
    constexpr float C = AttnC<DQK>::C;
    float pmax = p0[0];
#pragma unroll
    for (int r = 1; r < 16; ++r) pmax = fmaxf(pmax, p0[r]);
#pragma unroll
    for (int r = 0; r < 16; ++r) pmax = fmaxf(pmax, p1[r]);
    { auto rr = __builtin_amdgcn_permlane32_swap(__float_as_uint(pmax), __float_as_uint(pmax), false, false);
      pmax = fmaxf(__uint_as_float(rr[0]), __uint_as_float(rr[1])); }
    if (__builtin_expect(__all(pmax - m_reg <= AttnC<DQK>::THRS), 1)) { mn = m_reg; alpha = 1.f; }
    else { mn = fmaxf(m_reg, pmax); alpha = __builtin_amdgcn_exp2f((m_reg - mn) * C); m_reg = mn; }
    const float mnC = -mn * C;
#pragma unroll
    for (int r = 0; r < 16; ++r) p0[r] = fmaf(p0[r], C, mnC);
#pragma unroll
    for (int r = 0; r < 16; ++r) p1[r] = fmaf(p1[r], C, mnC);
#pragma unroll
    for (int r = 0; r < 16; ++r) p0[r] = __builtin_amdgcn_exp2f(p0[r]);
}
__device__ __forceinline__ void finishSM(f32x16& p0, f32x16& p1, float alpha, float& l_reg, bf16x8& pa0, bf16x8& pa1, bf16x8& pa2, bf16x8& pa3) {
#pragma unroll
    for (int r = 0; r < 16; ++r) p1[r] = __builtin_amdgcn_exp2f(p1[r]);
    float ps = 0;
#pragma unroll
    for (int r = 0; r < 16; ++r) ps += p0[r];
#pragma unroll
    for (int r = 0; r < 16; ++r) ps += p1[r];
    { auto rr = __builtin_amdgcn_permlane32_swap(__float_as_uint(ps), __float_as_uint(ps), false, false);
      ps = __uint_as_float(rr[0]) + __uint_as_float(rr[1]); }
    l_reg = l_reg * alpha + ps;
#define PK4(P, BASE, OUT) do { unsigned a0 = cvtpk(P[BASE + 0], P[BASE + 1]), a1 = cvtpk(P[BASE + 2], P[BASE + 3]);   \
    unsigned b0 = cvtpk(P[BASE + 4], P[BASE + 5]), b1 = cvtpk(P[BASE + 6], P[BASE + 7]);                              \
    auto r0 = __builtin_amdgcn_permlane32_swap(a0, b0, false, false); auto r1 = __builtin_amdgcn_permlane32_swap(a1, b1, false, false); \
    u32x4 w = {r0[0], r1[0], r0[1], r1[1]}; OUT = *reinterpret_cast<bf16x8*>(&w); } while (0)
    PK4(p0, 0, pa0); PK4(p0, 8, pa1); PK4(p1, 0, pa2); PK4(p1, 8, pa3);
#undef PK4
}
template <int DQK>
__device__ __forceinline__ void qkt(f32x16& p0, f32x16& p1, const LAS char* Ks, const bf16x8* qr, const LAS char* ql, const int (&ko)[4]) {
    constexpr int KRB = DQK * 2, ND = DQK / 16, PF = 3;
    p0 = f32x16{}; p1 = f32x16{};
    bf16x8 kb[ND][2];
#define QKT_RD(d_) do { const LAS char* kp_ = Ks + ko[(d_) & 3] + ((d_) >> 2) * 128; kb[d_][0] = *(const LAS bf16x8*)(kp_); kb[d_][1] = *(const LAS bf16x8*)(kp_ + 32 * KRB); } while (0)
#pragma unroll
    for (int d0 = 0; d0 < PF; ++d0) QKT_RD(d0);
#pragma unroll
    for (int d0 = 0; d0 < ND; ++d0) {
        if (d0 + PF < ND) QKT_RD(d0 + PF);
        bf16x8 q; if (d0 < 8) q = qr[d0]; else q = *(const LAS bf16x8*)(ql + (d0 - 8) * 1024);
        p0 = __builtin_amdgcn_mfma_f32_32x32x16_bf16(kb[d0][0], q, p0, 0, 0, 0);
        p1 = __builtin_amdgcn_mfma_f32_32x32x16_bf16(kb[d0][1], q, p1, 0, 0, 0);
        __builtin_amdgcn_sched_group_barrier(0x8, 2, 0); __builtin_amdgcn_sched_group_barrier(0x100, 2, 0); __builtin_amdgcn_sched_group_barrier(0x2, 6, 0); }
#undef QKT_RD
}
template <int DQK, int SD>
__device__ __forceinline__ void attn_body(const bf16* __restrict__ Qb, const bf16* __restrict__ Kh, const bf16* __restrict__ Vh, bf16* __restrict__ Ob, LAS char* lds, const float* __restrict__ rope, int pos0, float* __restrict__ ssq) {
    constexpr int ND0 = DQK / 16, KRB = DQK * 2, SHM_K = 64 * KRB, SHM_V = 64 * 128 * 2, NKC = DQK / 64, CPR = DQK / 8, NT = LKP / 64;
    static_assert(NT % 2 == 1, "odd tile count: the tail below takes tiles NT-2 and NT-1");
    int tid = threadIdx.x; asm volatile("" : "+v"(tid));
    const int wid = tid >> 6, lane = tid & 63, r32 = lane & 31, hi = lane >> 5;
    LAS char* V_lds = lds; LAS char* K_lds = lds + 2 * SHM_V;
    __syncthreads();
    float m_reg = -1e30f, l_reg = 0; f32x16 o[4] = {}; bf16x8 qr[8];
    const bf16* Qw = Qb + (size_t)(wid * 32 + r32) * DQK + hi * 8;
#pragma unroll
    for (int d0 = 0; d0 < 8; ++d0) qr[d0] = *reinterpret_cast<const bf16x8*>(Qw + d0 * 16);
    LAS char* ql = lds + 2 * SHM_V + 2 * SHM_K + 2048 + wid * 4096 + lane * 16;
#pragma unroll
    for (int d0 = 8; d0 < ND0; ++d0) {
        float x[8], y[8]; unpack8(*reinterpret_cast<const u32x4*>(Qw + d0 * 16), x);
        const float* t = rope + ((size_t)(pos0 + wid * 32 + r32 + 1) * 32 + (d0 - 8) * 8 + hi * 4) * 2; const f32x4 t0 = *(const f32x4*)t, t1 = *(const f32x4*)(t + 4);
        const float cs[4] = {t0[0], t0[2], t1[0], t1[2]}, sn[4] = {t0[1], t0[3], t1[1], t1[3]};
#pragma unroll
        for (int j = 0; j < 4; ++j) { y[2 * j] = x[2 * j] * cs[j] - x[2 * j + 1] * sn[j]; y[2 * j + 1] = x[2 * j] * sn[j] + x[2 * j + 1] * cs[j]; }
        *(LAS u32x4*)(ql + (d0 - 8) * 1024) = pack8(y); }
    const int sr = tid >> 4, sc = (tid & 15) * 8, vst0 = v_st(sr, sc), vst1 = v_st(32 + sr, sc);
    int kst[NKC];
#pragma unroll
    for (int c = 0; c < NKC; ++c) { const int id = tid + 512 * c, kr = id / CPR, kc = (id - kr * CPR) * 8; kst[c] = kr * KRB + ((kc * 2) ^ ((kr & 7) << 4)); }
    const int voff = tid * 16;
    int ko[4];
#pragma unroll
    for (int q = 0; q < 4; ++q) ko[q] = r32 * KRB + ((q * 32 + hi * 16) ^ ((r32 & 7) << 4));
    const __amdgpu_buffer_rsrc_t rK = __builtin_amdgcn_make_buffer_rsrc((void*)Kh, 0, LKP * KRB, 0x00020000);
    const __amdgpu_buffer_rsrc_t rV = __builtin_amdgcn_make_buffer_rsrc((void*)Vh, 0, LKP * 256, 0x00020000);
    const int vb0 = (int)(unsigned)(uintptr_t)V_lds + v_rd_base(lane);
    struct { bf16x8 vs0, vs1, ks[NKC]; } sr_[SD];
#define SLOAD(i, k0) do { sr_[i].vs0 = __builtin_bit_cast(bf16x8, __builtin_amdgcn_raw_buffer_load_b128(rV, voff, (k0) * 256, 0)); sr_[i].vs1 = __builtin_bit_cast(bf16x8, __builtin_amdgcn_raw_buffer_load_b128(rV, voff, (k0) * 256 + 8192, 0)); \
    _Pragma("unroll") for (int c_ = 0; c_ < NKC; ++c_) sr_[i].ks[c_] = __builtin_bit_cast(bf16x8, __builtin_amdgcn_raw_buffer_load_b128(rK, voff, (k0) * KRB + c_ * 8192, 0)); } while (0)
#define SWRITE(b, i) do { *(LAS bf16x8*)(V_lds + (b) * SHM_V + vst0) = sr_[i].vs0; *(LAS bf16x8*)(V_lds + (b) * SHM_V + vst1) = sr_[i].vs1; \
    _Pragma("unroll") for (int c_ = 0; c_ < NKC; ++c_) *(LAS bf16x8*)(K_lds + (b) * SHM_K + kst[c_]) = sr_[i].ks[c_]; } while (0)
#define SWAIT() do { if constexpr (SD == 2) { if constexpr (NKC == 2) asm volatile("s_waitcnt vmcnt(4)" ::: "memory"); else asm volatile("s_waitcnt vmcnt(5)" ::: "memory"); } \
    else asm volatile("s_waitcnt vmcnt(0)" ::: "memory"); } while (0)
#define RESC(a) do { if (__any((a) < 1.f)) { int t_ = threadIdx.x; asm volatile("" : "+v"(t_)); const int r32_ = t_ & 31, hi_2 = (t_ >> 5) & 1; \
    LAS float* al_ = (LAS float*)(lds + 2 * SHM_V + 2 * SHM_K) + (t_ >> 6) * 64 + 32; if (hi_2 == 0) al_[r32_] = (a); asm volatile("s_waitcnt lgkmcnt(0)" ::: "memory"); \
    _Pragma("unroll") for (int d = 0; d < 4; ++d) _Pragma("unroll") for (int r = 0; r < 16; ++r) o[d][r] *= al_[crow(r, hi_2)]; } } while (0)
    f32x16 pA0, pA1, pB0, pB1; float mnA, mnB, alA, alB; bf16x8 pa0, pa1, pa2, pa3;
    constexpr int SE = 0, SO = SD - 1;
    SLOAD(SE, 0); asm volatile("s_waitcnt vmcnt(0)" ::: "memory"); SWRITE(0, SE); __syncthreads();
    qkt<DQK>(pA0, pA1, K_lds, qr, ql, ko); partialSM<DQK>(pA0, pA1, m_reg, mnA, alA);
    SLOAD(SO, 64); if constexpr (SD == 2) { SLOAD(SE, 128); }
    SWAIT(); SWRITE(1, SO); __syncthreads();
#pragma unroll 1
    for (int j = 1; j + 2 < NT; j += 2) {
        SBAR(); qkt<DQK>(pB0, pB1, K_lds + SHM_K, qr, ql, ko);
        finishSM(pA0, pA1, alA, l_reg, pa0, pa1, pa2, pa3); SBAR();
        SLOAD(SO, (j + SD) * 64); SBAR();
        pv_d0(o, vb0, pa0, pa1, pa2, pa3); partialSM<DQK>(pB0, pB1, m_reg, mnB, alB);
        __syncthreads(); SWAIT(); SWRITE(0, SE);
        RESC(alB); __syncthreads();
        SBAR(); qkt<DQK>(pA0, pA1, K_lds, qr, ql, ko);
        finishSM(pB0, pB1, alB, l_reg, pa0, pa1, pa2, pa3); SBAR();
        SLOAD(SE, (j + 1 + SD) * 64); SBAR();
        pv_d0(o, vb0 + SHM_V, pa0, pa1, pa2, pa3); partialSM<DQK>(pA0, pA1, m_reg, mnA, alA);
        __syncthreads(); SWAIT(); SWRITE(1, SO);
        RESC(alA); __syncthreads();
    }
    SBAR(); qkt<DQK>(pB0, pB1, K_lds + SHM_K, qr, ql, ko);
    finishSM(pA0, pA1, alA, l_reg, pa0, pa1, pa2, pa3); SBAR();
    if constexpr (SD == 1) { SLOAD(SE, (NT - 1) * 64); } SBAR();
    pv_d0(o, vb0, pa0, pa1, pa2, pa3); partialSM<DQK>(pB0, pB1, m_reg, mnB, alB);
    __syncthreads(); asm volatile("s_waitcnt vmcnt(0)" ::: "memory"); SWRITE(0, SE);
    RESC(alB); __syncthreads();
    SBAR(); qkt<DQK>(pA0, pA1, K_lds, qr, ql, ko);
#pragma unroll
    for (int r = 8; r < 16; ++r) pA0[r] = -1e30f;
#pragma unroll
    for (int r = 0; r < 16; ++r) pA1[r] = -1e30f;
    finishSM(pB0, pB1, alB, l_reg, pa0, pa1, pa2, pa3); SBAR();
    pv_d0(o, vb0 + SHM_V, pa0, pa1, pa2, pa3); partialSM<DQK>(pA0, pA1, m_reg, mnA, alA);
    RESC(alA);
    finishSM(pA0, pA1, alA, l_reg, pa0, pa1, pa2, pa3); SBAR();
    pv_d0(o, vb0, pa0, pa1, pa2, pa3);
    { int t_ = threadIdx.x; asm volatile("" : "+v"(t_)); const int r32_ = t_ & 31, hi_2 = (t_ >> 5) & 1, wid_ = t_ >> 6;
      LAS float* li_ = (LAS float*)(lds + 2 * SHM_V + 2 * SHM_K) + wid_ * 64;
      if (hi_2 == 0) li_[r32_] = l_reg; asm volatile("s_waitcnt lgkmcnt(0)" ::: "memory");
      float rli[16];
#pragma unroll
      for (int r = 0; r < 16; ++r) rli[r] = __builtin_amdgcn_rcpf(li_[crow(r, hi_2)]);
      { float ss[16];
#pragma unroll
        for (int r = 0; r < 16; ++r) { float a = 0.f;
#pragma unroll
            for (int d0 = 0; d0 < 4; ++d0) { const float x = o[d0][r] * rli[r]; a += x * x; }
            a += __shfl_xor(a, 1); a += __shfl_xor(a, 2); a += __shfl_xor(a, 4); a += __shfl_xor(a, 8); a += __shfl_xor(a, 16); ss[r] = a; }
        float mine = ss[0];
#pragma unroll
        for (int r = 1; r < 16; ++r) mine = (r32_ == r) ? ss[r] : mine;
        if (r32_ < 16) ssq[(size_t)(wid_ * 32 + crow(r32_, hi_2)) * 8] = mine; }
      bf16* Ow = Ob + (size_t)(wid_ * 32) * DM;
#pragma unroll
      for (int r = 0; r < 16; ++r) { const int orow = crow(r, hi_2);
#pragma unroll
          for (int d0 = 0; d0 < 4; ++d0) Ow[(size_t)orow * DM + d0 * 32 + r32_] = (bf16)(cvtpk(o[d0][r] * rli[r], 0.f) & 0xffffu); } }
#undef SLOAD
#undef SWRITE
#undef SWAIT
#undef RESC
}

constexpr int NPHASE = 14;
struct Args { const float* in[24]; float* out; unsigned char* ws; int ph_lo, ph_hi, bar_region, pad; };
__global__ void __launch_bounds__(NWAVES * 64, 2) hymba_fwd(Args args) {
    extern __shared__ __attribute__((aligned(16))) unsigned char lds[];
    { int t0 = threadIdx.x; asm volatile("" : "+v"(t0)); for (int u = t0; u < 1024; u += NWAVES * 64) ((LAS unsigned*)((LAS unsigned char*)lds + LDSCTL_OFF))[u] = 0u; }
    __syncthreads();
#define XB_OBJ(b_) XcdBarrier b_; { const CAS unsigned char* kq_ = (const CAS unsigned char*)__builtin_amdgcn_kernarg_segment_ptr(); asm volatile("" : "+s"(kq_)); \
    b_.bar = (unsigned*)(*(unsigned char* const CAS*)(kq_ + 200) + WS_CTL) + CW_BAR + *(const int CAS*)(kq_ + 216) * XCD_BAR_WORDS; b_.x = xb_xcc_id(); b_.st = (volatile LAS unsigned*)((LAS unsigned char*)lds + LDSCTL_OFF) + 8; }
#if !MK_SPLIT
    { XB_OBJ(b0_); (void)xcd_barrier_post(b0_.bar, b0_.st); }
#define GRID_BAR() do { XB_OBJ(bb_); xcd_barrier(bb_); } while (0)
#else
#define GRID_BAR() do {} while (0)
#endif
    const int lo = args.ph_lo, hi_ = args.ph_hi;
#ifndef REP_MASK
#define REP_MASK 0
#endif
#define IN(k) (lo <= (k) && (k) < hi_)
#define REPS(k) (((REP_MASK >> (k)) & 1) ? 2 : 1)
#define SEAM(k) do { if (IN(k) && IN((k) + 1)) GRID_BAR(); } while (0)

#define PTRS \
    int bx = blockIdx.x; asm volatile("" : "+s"(bx)); const int G = gridDim.x, vcu = (G % 8 == 0) ? (bx % 8) * (G / 8) + bx / 8 : bx; \
    const int tid = threadIdx.x, lane = tid & 63, wave = __builtin_amdgcn_readfirstlane(tid >> 6); \
    const int gw = vcu * NWAVES + wave, ngw = G * NWAVES, gtid = vcu * (NWAVES * 64) + tid, ngt = G * NWAVES * 64; (void)gw; (void)ngw; (void)gtid; (void)ngt; (void)lane; \
    const CAS unsigned char* kp_ = (const CAS unsigned char*)__builtin_amdgcn_kernarg_segment_ptr(); asm volatile("" : "+s"(kp_)); \
    const float* const CAS* kin = (const float* const CAS*)kp_; unsigned char* ws = *(unsigned char* const CAS*)(kp_ + 200); float* outp = *(float* const CAS*)(kp_ + 192); (void)outp; (void)kin; \
    const float* x = kin[0]; const float* meta_tok = kin[1]; \
    float* rope = (float*)(ws + WS_ROPE); \
    bf16* w_in_t = (bf16*)(ws + WS_WIN); bf16* w_qb_t = (bf16*)(ws + WS_WQB); bf16* w_kvb_t = (bf16*)(ws + WS_WKVB); bf16* w_o_t = (bf16*)(ws + WS_WO); \
    bf16* w_r_t = (bf16*)(ws + WS_WR); unsigned char* w_gu8 = ws + WS_WGU; unsigned char* w_dn8 = ws + WS_WDN; unsigned char* h1f8 = ws + WS_H1F8; \
    bf16* h0 = (bf16*)(ws + WS_H0); bf16* h1 = (bf16*)(ws + WS_H1); float* rs_q = (float*)(ws + WS_QAN); float* rs_kv = rs_q + MPAD; float* ssq = (float*)(ws + WS_KVAN); bf16* z = (bf16*)(ws + WS_Z); \
    bf16* qm = (bf16*)(ws + WS_QM); bf16* km = (bf16*)(ws + WS_KM); bf16* vm = (bf16*)(ws + WS_VM); bf16* qg = (bf16*)(ws + WS_QG); bf16* kg = (bf16*)(ws + WS_KG); bf16* vg = (bf16*)(ws + WS_VG); \
    bf16* ob = (bf16*)(ws + WS_O); bf16* y1 = (bf16*)(ws + WS_Y1); float* logits = (float*)(ws + WS_LOGITS); \
    int* topk = (int*)(ws + WS_TOPK); float* gate = (float*)(ws + WS_GATE); int* pair_pos = (int*)(ws + WS_PAIRPOS); float* row_gate = (float*)(ws + WS_ROWGATE); \
    int* hist = (int*)(ws + WS_HIST); int* moetab = (int*)(ws + WS_MOETAB); int* tile_expert = moetab + 256; \
    int* row_tok = (int*)(ws + WS_XS); unsigned char* act8 = ws + WS_ACT; unsigned char* out2 = ws + WS_OUT2;


    for (int rep_ = 0; rep_ < (IN(0) ? REPS(0) : 0); ++rep_) { if (rep_) GRID_BAR(); PTRS;
        LAS float* scr = (LAS float*)((LAS unsigned char*)lds + wave * 16384);
        constexpr int I_IN = 16 * 46, I_QB = 4 * 24, I_KVB = 4 * 32, I_O = 16 * 32, I_R = 16;
        constexpr int NITEMS = I_IN + I_QB + I_KVB + I_O + I_R;
        for (int it = gw; it < NITEMS; it += ngw) {
            int r = it;
            if (r < I_IN) { transpose_item(kin[4], 1024, NIN, w_in_t, scr, r, lane, MapIn()); continue; } r -= I_IN;
            if (r < I_QB) { transpose_item(kin[6], 256, 768, w_qb_t, scr, r, lane, MapQ(), kin[5]); continue; } r -= I_QB;
            if (r < I_KVB) { transpose_item(kin[8], 128, 1024, w_kvb_t, scr, r, lane, MapId(), kin[7], 256); continue; } r -= I_KVB;
            if (r < I_O) { transpose_item(kin[13], 1024, 1024, w_o_t, scr, r, lane, MapId(), kin[11], 0, kin[12]); continue; } r -= I_O;
            transpose_item(kin[16], 1024, 32, w_r_t, scr, r, lane, MapId());
        }
        transpose_f8_stream(kin[18], 2048, w_gu8, scr, gw, ngw, lane, MapGU(), W8_SCALE);
        transpose_f8_stream(kin[20], 1024, w_dn8, scr, gw, ngw, lane, MapId(), W8_SCALE);
        { f32x4 gg[4], bb[4], cv[4], nv[4];
#pragma unroll
          for (int j = 0; j < 4; ++j) { gg[j] = ((const f32x4*)kin[2])[lane + 64 * j]; bb[j] = ((const f32x4*)kin[3])[lane + 64 * j]; }
#define LN_LOAD(dst, m_) do { const float* xr_ = (m_) < NTOK ? x + (size_t)(m_) * DM : meta_tok + (size_t)((m_) - NTOK) * DM; _Pragma("unroll") for (int j = 0; j < 4; ++j) dst[j] = ((const f32x4*)xr_)[lane + 64 * j]; } while (0)
          if (gw < MROWS) LN_LOAD(cv, gw);
          for (int m = gw; m < MROWS; m += ngw) { const int mn = m + ngw < MROWS ? m + ngw : m; LN_LOAD(nv, mn);
              ln_row_f32_to_bf16(cv, gg, bb, h0 + (size_t)m * DM, lane);
#pragma unroll
              for (int j = 0; j < 4; ++j) cv[j] = nv[j]; }
#undef LN_LOAD
        }
        zero_bytes(h0 + (size_t)MROWS * DM, (size_t)(MPAD - MROWS) * DM * 2, gtid, ngt);
        zero_bytes(w_in_t + (size_t)448 * 1024, (size_t)64 * 1024 * 2, gtid, ngt);
        for (int i = gw; i < 64 + 64 + 32 + 32; i += ngw) {
            bf16* p; size_t rb;
            if (i < 64) { p = km + ((size_t)i * LKP + 2064) * 192; rb = 48 * 192 * 2; }
            else if (i < 128) { p = vm + ((size_t)(i - 64) * LKP + 2064) * 128; rb = 48 * 128 * 2; }
            else if (i < 160) { p = kg + ((size_t)(i - 128) * LKP + 2064) * 128; rb = 48 * 128 * 2; }
            else { p = vg + ((size_t)(i - 160) * LKP + 2064) * 128; rb = 48 * 128 * 2; }
            zero_bytes(p, rb, lane, 64);
        }
        for (int i = gtid; i < 2065 * 32; i += ngt) {
            const int p = i / 32 - 1, f = i & 31; double inv = 1.0;
            for (int q = 0; q < f; ++q) inv *= 0.74989420933245582730;
            const float ang = (float)p * (float)inv; float sn, cs; sincos_d(fabsf(ang), sn, cs); if (ang < 0.f) sn = -sn;
            rope[2 * i] = cs; rope[2 * i + 1] = sn;
        }
    }
    SEAM(0);
    for (int rep_ = 0; rep_ < (IN(1) ? REPS(1) : 0); ++rep_) { if (rep_) GRID_BAR(); PTRS;
        { EpiZF E{z, rs_q, rs_kv, km, qg, kg, vg, rope, kin[9], kin[10], (LAS float*)((LAS unsigned char*)lds + LDSCTL_OFF + 2048)};
          pg8::Gemm g{h0, w_in_t, NTOK, ZLD, 1024, 1024, nullptr}; pg8::StaticOrder S; S.init(NTOK, ZLD, G, bx);
          pg8::gemm_phase<EpiZF, pg8::StaticOrder, true, true>((LAS unsigned char*)lds, g, S, E); }
        { EpiZ E{z}; meta_gemm16<1024, 0>(h0, 1024, w_in_t, NTOK, ZLD, E, gw, ngw, lane); }
    }
    SEAM(1);
    for (int rep_ = 0; rep_ < (IN(3) ? REPS(3) : 0); ++rep_) { if (rep_) GRID_BAR(); PTRS;
        if (vcu == 0) { for (int m = NTOK + wave; m < MROWS; m += NWAVES) { const bf16* zr_ = z + (size_t)m * ZLD; u32x4 wa = {0u, 0u, 0u, 0u}; if (lane < 56) wa = *(const u32x4*)(zr_ + 8 * lane);
            p2a_row(m, wa, *(const u32x4*)(zr_ + 512 + 8 * lane), *(const u32x4*)(zr_ + 1024 + 8 * lane), rope, kin[5], kin[7], kin[9], kin[10], rs_q, rs_kv, km, qg, kg, vg, lane); } }
        { EpiQ E{qm, rs_q}; pg8::Gemm g{z, w_qb_t, NTOK, 768, 256, ZLD, nullptr}; pg8::StaticOrder S; S.init(NTOK, 768, G, bx); pg8::EpiAdapt<EpiQ> EA{E, 0};
          pg8::gemm_phase<pg8::EpiAdapt<EpiQ>, pg8::StaticOrder, true, true>((LAS unsigned char*)lds, g, S, EA); }
        { EpiKV<false> E{km, vm, rs_kv}; pg8::Gemm g{z + 256, w_kvb_t, NTOK, 1024, 256, ZLD, nullptr}; pg8::StaticOrder S; S.init(NTOK, 1024, G, bx); pg8::EpiAdapt<EpiKV<false>> EA{E, 0};
          pg8::gemm_phase<pg8::EpiAdapt<EpiKV<false>>, pg8::StaticOrder, true, true>((LAS unsigned char*)lds, g, S, EA);
          EpiKV<true> EM{km, vm, rs_kv}; meta_gemm16<256, 128>(z + 256, ZLD, w_kvb_t, NTOK, 1024, EM, gw, ngw, lane); }
    }
    SEAM(3);
    for (int rep_ = 0; rep_ < (IN(4) ? REPS(4) : 0); ++rep_) { if (rep_) GRID_BAR(); PTRS;
        for (int u = vcu; u < 1024; u += G) {
            if (u < 512) { const int b = u >> 5, h = (u >> 3) & 3, qb = u & 7, bh = b * 4 + h;
                attn_body<192, 1>(qm + ((size_t)bh * 2048 + qb * 256) * 192, km + (size_t)bh * LKP * 192, vm + (size_t)bh * LKP * 128, ob + ((size_t)b * 2048 + qb * 256) * DM + h * 128, (LAS char*)lds, rope, 16 + qb * 256, ssq + ((size_t)b * 2048 + qb * 256) * 8 + h);
            } else { const int v = u - 512, b = v >> 5, h = (v >> 3) & 3, qb = v & 7, bh = b * 4 + h, bk = b * 2 + (h >> 1);
                attn_body<128, 1>(qg + ((size_t)bh * 2048 + qb * 256) * 128, kg + (size_t)bk * LKP * 128, vg + (size_t)bk * LKP * 128, ob + ((size_t)b * 2048 + qb * 256) * DM + 512 + h * 128, (LAS char*)lds, rope, 0, ssq + ((size_t)b * 2048 + qb * 256) * 8 + 4 + h);
            }
        }
    }
    SEAM(4);
    for (int rep_ = 0; rep_ < (IN(6) ? REPS(6) : 0); ++rep_) { if (rep_) GRID_BAR(); PTRS;
        pg8::Gemm g{ob, w_o_t, NTOK, 1024, 1024, 1024, nullptr}; pg8::StaticOrder S; S.init(NTOK, 1024, G, bx);
        LAS f32x2* T = (LAS f32x2*)((LAS unsigned char*)lds + LDSCTL_OFF + 2048);
        for (int i = tid >> 8; i < 6; i += 2) { pg8::Unit u; if (!S.next(i, u)) break; const int rl = tid & 255; const float* q = ssq + (size_t)(u.pm * 256 + rl) * 8;
            const f32x4 a = *(const f32x4*)q, b = *(const f32x4*)(q + 4);
            const float rm = rsq(((a[0] + a[1]) + (a[2] + a[3])) * (1.f / 512) + RMS_EPS), rg = rsq(((b[0] + b[1]) + (b[2] + b[3])) * (1.f / 512) + RMS_EPS);
            T[i * 256 + rl] = (f32x2){rm / rg, rg}; }
        __syncthreads();
        EpiOF E{y1, h0, T}; HookO H{T};
        pg8::gemm_phase<EpiOF, pg8::StaticOrder, true, true, false, false, HookO>((LAS unsigned char*)lds, g, S, E, H);
    }
    SEAM(6);
#ifndef MOE_SKEW_TICKS
#define MOE_SKEW_TICKS 0
#endif
#define MOE_STAGGER(nunits) do { const int rem_ = (nunits) % G; if (MOE_SKEW_TICKS > 0 && rem_ != 0 && bx >= rem_) { const unsigned long long t0_ = __builtin_amdgcn_s_memrealtime(), w_ = (unsigned long long)(MOE_SKEW_TICKS * ((bx - rem_) % 3 + 1)); \
    while (__builtin_amdgcn_s_memrealtime() - t0_ < w_) __builtin_amdgcn_s_sleep(16); } } while (0)
#define ROUTE_VARS const int tpb = (NTOK + G - 1) / G, tok_lo = bx * tpb, tok_hi = (tok_lo + tpb < NTOK) ? tok_lo + tpb : NTOK; \
    LAS int* L_hist = (LAS int*)((LAS unsigned char*)lds + LDSCTL_OFF + 256); LAS int* L_n = L_hist + 32; LAS int* L_base = L_hist + 64; LAS int* L_off = L_hist + 96; (void)L_n; (void)L_base; (void)L_off;
    for (int rep_ = 0; rep_ < (IN(8) ? REPS(8) : 0); ++rep_) { if (rep_) GRID_BAR(); PTRS; ROUTE_VARS;
        constexpr int WRP = 2064;
        LAS unsigned char* L_wr = (LAS unsigned char*)lds;
        for (int i = tid; i < 32 * 128; i += NWAVES * 64) { const int r = i >> 7, c = i & 127; *(LAS u32x4*)(L_wr + r * WRP + c * 16) = *(const u32x4*)(w_r_t + (size_t)r * 1024 + c * 8); }
        if (tid < 32) L_hist[tid] = 0;
        zero_bytes(row_tok, (size_t)MOE_ROWS_MAX * 4, gtid, ngt);
        __syncthreads();
        const int fr = lane & 15, fq = lane >> 4;
        f32x4 G4[4], B4[4];
#pragma unroll
        for (int hf = 0; hf < 2; ++hf) { const int c = hf * 512 + 8 * lane; G4[2 * hf] = *(const f32x4*)(kin[14] + c); G4[2 * hf + 1] = *(const f32x4*)(kin[14] + c + 4); B4[2 * hf] = *(const f32x4*)(kin[15] + c); B4[2 * hf + 1] = *(const f32x4*)(kin[15] + c + 4); }
        for (int rb = tok_lo + wave * 16; rb < tok_hi; rb += NWAVES * 16) {
            for (int i = 0; i < 16 && rb + i < tok_hi; ++i) ln_row_bf16(y1 + (size_t)(rb + i) * DM, G4, B4, h1 + (size_t)(rb + i) * DM, h1f8 + (size_t)(rb + i) * DM, lane);
            asm volatile("s_waitcnt vmcnt(0)" ::: "memory");
            const int row = rb + fr < NTOK ? rb + fr : NTOK - 1;
            const bf16* ap = h1 + (size_t)row * DM + fq * 8;
            bf16x8 a[32];
#pragma unroll
            for (int ks = 0; ks < 32; ++ks) a[ks] = *(const bf16x8*)(ap + ks * 32);
            f32x4 acc0 = {0.f, 0.f, 0.f, 0.f}, acc1 = {0.f, 0.f, 0.f, 0.f};
            const LAS unsigned char* bp = L_wr + (8 * (fr >> 2) + (fr & 3)) * WRP + fq * 16;
#pragma unroll
            for (int ks = 0; ks < 32; ++ks) { const bf16x8 b0 = *(const LAS bf16x8*)(bp + ks * 64), b1 = *(const LAS bf16x8*)(bp + 4 * WRP + ks * 64);
                acc0 = __builtin_amdgcn_mfma_f32_16x16x32_bf16(b0, a[ks], acc0, 0, 0, 0); acc1 = __builtin_amdgcn_mfma_f32_16x16x32_bf16(b1, a[ks], acc1, 0, 0, 0); }
            const float* br = kin[17] + 8 * fq; const f32x4 bb0 = *(const f32x4*)br, bb1 = *(const f32x4*)(br + 4);
            float v[8] = {acc0[0] + bb0[0], acc0[1] + bb0[1], acc0[2] + bb0[2], acc0[3] + bb0[3], acc1[0] + bb1[0], acc1[1] + bb1[1], acc1[2] + bb1[2], acc1[3] + bb1[3]};
            float tv[4]; int ti[4];
#pragma unroll
            for (int r = 0; r < 4; ++r) { float bv = v[0]; int bi = 8 * fq;
#pragma unroll
                for (int j = 1; j < 8; ++j) if (v[j] > bv) { bv = v[j]; bi = 8 * fq + j; }
#pragma unroll
                for (int off = 16; off <= 32; off <<= 1) { const float ov = __shfl_xor(bv, off); const int oi = __shfl_xor(bi, off); if (ov > bv || (ov == bv && oi < bi)) { bv = ov; bi = oi; } }
                tv[r] = bv; ti[r] = bi;
#pragma unroll
                for (int j = 0; j < 8; ++j) if (bi == 8 * fq + j) v[j] = -INFINITY; }
            const float e1 = __expf(tv[1] - tv[0]), e2 = __expf(tv[2] - tv[0]), e3 = __expf(tv[3] - tv[0]), inv = 1.f / (1.f + e1 + e2 + e3);
            if (fq == 0 && rb + fr < tok_hi) { const int t = rb + fr; *(int4*)(topk + (size_t)t * 4) = make_int4(ti[0], ti[1], ti[2], ti[3]); *(f32x4*)(gate + (size_t)t * 4) = (f32x4){inv, e1 * inv, e2 * inv, e3 * inv};
                atomicAdd((int*)(L_hist + ti[0]), 1); atomicAdd((int*)(L_hist + ti[1]), 1); atomicAdd((int*)(L_hist + ti[2]), 1); atomicAdd((int*)(L_hist + ti[3]), 1); }
        }
        __syncthreads();
        if (tid < 32) hist[bx * 32 + tid] = L_hist[tid];
    }
    SEAM(8);
    for (int rep_ = 0; rep_ < (IN(10) ? REPS(10) : 0); ++rep_) { if (rep_) GRID_BAR(); PTRS; ROUTE_VARS;
        if (tid < 32) { int tot = 0, before = 0; for (int b = 0; b < G; ++b) { const int h = hist[b * 32 + tid]; tot += h; if (b < bx) before += h; } L_n[tid] = tot; L_base[tid] = before; L_hist[tid] = 0; }
        __syncthreads();
        if (tid == 0) { int off = 0; for (int e = 0; e < NE; ++e) { L_off[e] = off; off += (L_n[e] + 255) & ~255; } L_off[NE] = off; }
        __syncthreads();
        for (int p = tok_lo * 4 + tid; p < tok_hi * 4; p += NWAVES * 64) { const int e = topk[p]; const int r = atomicAdd((int*)(L_hist + e), 1); const int pos = L_off[e] + L_base[e] + r;
            row_gate[pos] = gate[p]; pair_pos[p] = pos; row_tok[pos] = p >> 2; }
        __syncthreads();
        if (bx == 0) { if (tid == 0) moetab[0] = L_off[NE];
            if (tid < 32) { moetab[64 + tid] = L_n[tid]; moetab[128 + tid] = L_off[tid]; for (int t = L_off[tid] >> 8; t < (L_off[tid + 1] >> 8); ++t) tile_expert[t] = tid; } }
        __syncthreads();
    }
    SEAM(10);
    for (int rep_ = 0; rep_ < (IN(11) ? REPS(11) : 0); ++rep_) { if (rep_) GRID_BAR(); PTRS; const int rows = moetab[0]; EpiGU8 E{act8, kin[19]};
        pg8::Gemm g{(const bf16*)h1f8, (const bf16*)w_gu8, rows, 2048, 512, 512, row_tok}; LAS int* L_te = (LAS int*)((LAS unsigned char*)lds + LDSCTL_OFF + 2048); for (int i = tid; i < (rows >> 8); i += NWAVES * 64) L_te[i] = tile_expert[i]; __syncthreads();
        pg8::MoeOrder S; S.init(rows >> 8, 8, G, bx, L_te);
        MOE_STAGGER((rows >> 8) * 8);
        pg8::gemm_phase<EpiGU8, pg8::MoeOrder, true, true, true, true>((LAS unsigned char*)lds, g, S, E);
    }
    SEAM(11);
    for (int rep_ = 0; rep_ < (IN(12) ? REPS(12) : 0); ++rep_) { if (rep_) GRID_BAR(); PTRS; const int rows = moetab[0]; EpiDN8 E{out2, kin[21], row_gate};
        pg8::Gemm g{(const bf16*)act8, (const bf16*)w_dn8, rows, 1024, 512, 512, nullptr}; LAS int* L_te = (LAS int*)((LAS unsigned char*)lds + LDSCTL_OFF + 2048); for (int i = tid; i < (rows >> 8); i += NWAVES * 64) L_te[i] = tile_expert[i]; __syncthreads();
        pg8::MoeOrder S; S.init(rows >> 8, 4, G, bx, L_te);
        MOE_STAGGER((rows >> 8) * 4);
        pg8::gemm_phase<EpiDN8, pg8::MoeOrder, true, true, true>((LAS unsigned char*)lds, g, S, E);
    }
    SEAM(12);
    for (int rep_ = 0; rep_ < (IN(13) ? REPS(13) : 0); ++rep_) { if (rep_) GRID_BAR(); PTRS;
        f32x4 G4[4], B4[4];
#pragma unroll
        for (int hf = 0; hf < 2; ++hf) { const int c = hf * 512 + 8 * lane; G4[2 * hf] = *(const f32x4*)(kin[22] + c); G4[2 * hf + 1] = *(const f32x4*)(kin[22] + c + 4); B4[2 * hf] = *(const f32x4*)(kin[23] + c); B4[2 * hf + 1] = *(const f32x4*)(kin[23] + c + 4); }
        int4 pp = gw < NTOK ? *(const int4*)(pair_pos + (size_t)gw * 4) : make_int4(0, 0, 0, 0);
        for (int t = gw; t < NTOK; t += ngw) {
            const int ps[4] = {pp.x, pp.y, pp.z, pp.w};
            u32x4 hv[2]; u32x2 ov[4][2];
#pragma unroll
            for (int hf = 0; hf < 2; ++hf) { hv[hf] = *(const u32x4*)(h1 + (size_t)t * DM + hf * 512 + 8 * lane);
#pragma unroll
                for (int s4 = 0; s4 < 4; ++s4) ov[s4][hf] = *(const u32x2*)(out2 + (size_t)ps[s4] * DM + hf * 512 + 8 * lane); }
            if (t + ngw < NTOK) pp = *(const int4*)(pair_pos + (size_t)(t + ngw) * 4);
            float v[16];
#pragma unroll
            for (int hf = 0; hf < 2; ++hf) { float f[8]; unpack8(hv[hf], f);
                float acc8[8] = {0.f, 0.f, 0.f, 0.f, 0.f, 0.f, 0.f, 0.f};
#pragma unroll
                for (int s4 = 0; s4 < 4; ++s4) {
#pragma unroll
                    for (int w = 0; w < 2; ++w) { const unsigned d = w ? ov[s4][hf].y : ov[s4][hf].x;
                        const f32x2 lo = __builtin_amdgcn_cvt_pk_f32_fp8((int)d, false), hi2 = __builtin_amdgcn_cvt_pk_f32_fp8((int)d, true);
                        acc8[4 * w + 0] += lo[0]; acc8[4 * w + 1] += lo[1]; acc8[4 * w + 2] += hi2[0]; acc8[4 * w + 3] += hi2[1]; } }
#pragma unroll
                for (int j = 0; j < 8; ++j) v[hf * 8 + j] = ALPHA * f[j] + O2_INV * acc8[j]; }
            float s = 0.f;
#pragma unroll
            for (int j = 0; j < 16; ++j) s += v[j];
            const float mean = wave_sum(s) * (1.f / DM); float s2 = 0.f;
#pragma unroll
            for (int j = 0; j < 16; ++j) { v[j] -= mean; s2 += v[j] * v[j]; }
            const float rstd = rsq(wave_sum(s2) * (1.f / DM) + LN_EPS);
#pragma unroll
            for (int hf = 0; hf < 2; ++hf) { float* o = outp + (size_t)t * DM + hf * 512 + 8 * lane;
                *(f32x4*)o = (f32x4){v[hf * 8 + 0], v[hf * 8 + 1], v[hf * 8 + 2], v[hf * 8 + 3]} * rstd * G4[2 * hf] + B4[2 * hf];
                *(f32x4*)(o + 4) = (f32x4){v[hf * 8 + 4], v[hf * 8 + 5], v[hf * 8 + 6], v[hf * 8 + 7]} * rstd * G4[2 * hf + 1] + B4[2 * hf + 1]; }
        }
    }
#undef IN
#undef SEAM
}

extern "C" void kernel_launch(void* const* d_in, const int* in_sizes, int n_in, void* d_out, int out_size, void* d_ws, size_t ws_size, hipStream_t stream) {
    static int grid = 0;
    if (grid == 0) {
        if (n_in != 24 || in_sizes[0] != NTOK * DM || out_size != NTOK * DM || ws_size < WS_END) { fprintf(stderr, "kernel_launch: shape/workspace mismatch (n_in %d, ws %zu)\n", n_in, ws_size); grid = -1; return; }
        int dev = 0, cus = 0, per_cu = 0;
        if (hipGetDevice(&dev) != hipSuccess || hipDeviceGetAttribute(&cus, hipDeviceAttributeMultiprocessorCount, dev) != hipSuccess) { grid = -1; return; }
        if (hipFuncSetAttribute((const void*)hymba_fwd, hipFuncAttributeMaxDynamicSharedMemorySize, LDS_BYTES) != hipSuccess) { fprintf(stderr, "kernel_launch: hipFuncSetAttribute failed\n"); grid = -1; return; }
        if (hipOccupancyMaxActiveBlocksPerMultiprocessor(&per_cu, (const void*)hymba_fwd, NWAVES * 64, LDS_BYTES) != hipSuccess || per_cu < 1) fprintf(stderr, "kernel_launch: occupancy query says %d\n", per_cu);
        (void)hipGetLastError();
        grid = cus;
    }
    if (grid < 0) return;
    (void)hipMemsetAsync((char*)d_ws + WS_CTL, 0, CTL_ZERO_BYTES, stream);
    Args a{};
    for (int i = 0; i < 24; ++i) a.in[i] = (const float*)d_in[i];
    a.out = (float*)d_out; a.ws = (unsigned char*)d_ws;
#if MK_SPLIT
    for (int p = 0; p < NPHASE; ++p) { a.ph_lo = p; a.ph_hi = p + 1; hipLaunchKernelGGL(hymba_fwd, dim3(grid), dim3(NWAVES * 64), LDS_BYTES, stream, a); }
#else
    a.ph_lo = 0; a.ph_hi = NPHASE; hipLaunchKernelGGL(hymba_fwd, dim3(grid), dim3(NWAVES * 64), LDS_BYTES, stream, a);
#ifdef PROBE_RELAUNCH_LO
    a.ph_lo = PROBE_RELAUNCH_LO; a.ph_hi = PROBE_RELAUNCH_HI; a.bar_region = 1; hipLaunchKernelGGL(hymba_fwd, dim3(grid), dim3(NWAVES * 64), LDS_BYTES, stream, a);
#endif
#endif
}
```

```cpp
#include <hip/hip_runtime.h>
#include <cstdio>
#include <cstdint>

#ifndef MK_SPLIT
#define MK_SPLIT 0
#endif

#define LAS __attribute__((address_space(3)))
#define CAS __attribute__((address_space(4)))
typedef unsigned short bf16;
typedef short bf16x8 __attribute__((ext_vector_type(8)));
typedef short s16x4 __attribute__((ext_vector_type(4)));
typedef float f32x2 __attribute__((ext_vector_type(2)));
typedef float f32x4 __attribute__((ext_vector_type(4)));
typedef float f32x16 __attribute__((ext_vector_type(16)));
typedef unsigned u32x2 __attribute__((ext_vector_type(2)));
typedef unsigned u32x4 __attribute__((ext_vector_type(4)));
typedef __bf16 bf16x2_t __attribute__((ext_vector_type(2)));

constexpr int NB = 16, SEQ = 2048, DM = 1024, NMETA = 16;
constexpr int NTOK = NB * SEQ;
constexpr int MROWS = NTOK + NMETA;
constexpr int MPAD = 33024;
constexpr int LKP = 2112;
constexpr int NIN = 1472, ZLD = 1536;
constexpr int NE = 32, NPAIR = NTOK * 4;
constexpr int NTOK_I = NTOK / 2, MT_I = NTOK_I / 256, MOE_TILES_I = 288, MOE_ROWS_I = MOE_TILES_I * 256, MOE_TILES_MAX = 2 * MOE_TILES_I, MOE_ROWS_MAX = MOE_TILES_MAX * 256;
constexpr float ALPHA = 1.189207115002721f;
constexpr float RMS_EPS = 1e-6f, LN_EPS = 1e-5f;

constexpr size_t MiB = 1u << 20;
constexpr size_t WS_CTL = 0, CTL_ZERO_BYTES = 1 * MiB;
constexpr size_t WS_ROPE = 1 * MiB;
constexpr size_t WS_WQB = 2 * MiB;
constexpr size_t WS_WKVB = 2 * MiB + 512 * 1024;
constexpr size_t WS_WR = 3 * MiB;
constexpr size_t WS_LOGITS = 4 * MiB;
constexpr size_t WS_TOPK = 8 * MiB;
constexpr size_t WS_GATE = 8 * MiB + 512 * 1024;
constexpr size_t WS_PAIRPOS = 9 * MiB;
constexpr size_t WS_ROWGATE = 9 * MiB + 512 * 1024;
constexpr size_t WS_HIST = 10 * MiB + 512 * 1024;
constexpr size_t WS_MOETAB = 10 * MiB + 768 * 1024;
constexpr size_t WS_WIN = 12 * MiB;
constexpr size_t WS_WO = 15 * MiB;
constexpr size_t WS_WGU = 32 * MiB;
constexpr size_t WS_WDN = 96 * MiB;
constexpr size_t WS_H1F8 = 128 * MiB;
constexpr size_t WS_H0 = 224 * MiB;
constexpr size_t WS_H1 = 289 * MiB;
constexpr size_t WS_QAN = 353 * MiB;
constexpr size_t WS_KVAN = 370 * MiB;
constexpr size_t WS_Z = 380 * MiB;
constexpr size_t WS_QM = 477 * MiB;
constexpr size_t WS_KM = 525 * MiB;
constexpr size_t WS_VM = 575 * MiB;
constexpr size_t WS_QG = 608 * MiB;
constexpr size_t WS_KG = 640 * MiB;
constexpr size_t WS_VG = 657 * MiB;
constexpr size_t WS_O = 674 * MiB;
constexpr size_t WS_Y1 = 738 * MiB;
constexpr size_t WS_XS = 380 * MiB;
constexpr size_t WS_ACT = 516 * MiB;
constexpr size_t WS_OUT2 = 660 * MiB;
constexpr size_t WS_END = 924 * MiB;
static_assert(WS_Z + (size_t)MPAD * ZLD * 2 <= WS_QM && WS_QM + (size_t)64 * 2048 * 192 * 2 <= WS_KM && WS_KM + (size_t)64 * LKP * 192 * 2 <= WS_VM && WS_VM + (size_t)64 * LKP * 128 * 2 <= WS_QG, "ws map 1");
static_assert(WS_QG + (size_t)64 * 2048 * 128 * 2 <= WS_KG && WS_KG + (size_t)32 * LKP * 128 * 2 <= WS_VG && WS_VG + (size_t)32 * LKP * 128 * 2 <= WS_O && WS_O + (size_t)NTOK * DM * 2 <= WS_Y1 && WS_Y1 + (size_t)NTOK * DM * 4 <= WS_END, "ws map 2");
static_assert(WS_XS + (size_t)MOE_ROWS_MAX * 4 <= WS_ACT && WS_ACT + (size_t)MOE_ROWS_MAX * DM <= WS_OUT2 && WS_OUT2 + (size_t)MOE_ROWS_MAX * DM <= WS_END && (size_t)MOE_ROWS_MAX * 4 <= MiB && WS_WGU + (size_t)NE * 2048 * 1024 <= WS_WDN && WS_WDN + (size_t)NE * 1024 * 1024 <= WS_H1F8 && WS_H1F8 + (size_t)NTOK * DM <= WS_H0, "ws map 3");
static_assert(WS_H0 + (size_t)MPAD * DM * 2 <= WS_H1 && WS_H1 + (size_t)NTOK * DM * 2 <= WS_QAN && WS_QAN + (size_t)MPAD * 256 * 2 <= WS_KVAN && WS_KVAN + (size_t)MPAD * 128 * 2 <= WS_Z, "ws map 4");
constexpr int CW_BAR = 4096;

constexpr int RING_BYTES = 131072;
constexpr int LDSCTL_OFF = RING_BYTES;
constexpr int LDS_BYTES = 147456;
constexpr int NWAVES = 8;

#define LDS_WAIT() asm volatile("s_waitcnt lgkmcnt(0)" ::: "memory")
#define SBAR() __builtin_amdgcn_sched_barrier(0)
__device__ __forceinline__ unsigned cvtpk(float lo, float hi) { f32x2 v = {lo, hi}; bf16x2_t b = __builtin_convertvector(v, bf16x2_t); return __builtin_bit_cast(unsigned, b); }
__device__ __forceinline__ u32x4 pack8(const float (&v)[8]) { u32x4 r = {cvtpk(v[0], v[1]), cvtpk(v[2], v[3]), cvtpk(v[4], v[5]), cvtpk(v[6], v[7])}; return r; }
__device__ __forceinline__ void unpack8(u32x4 w, float (&v)[8]) {
    v[0] = __uint_as_float(w.x << 16); v[1] = __uint_as_float(w.x & 0xffff0000u); v[2] = __uint_as_float(w.y << 16); v[3] = __uint_as_float(w.y & 0xffff0000u);
    v[4] = __uint_as_float(w.z << 16); v[5] = __uint_as_float(w.z & 0xffff0000u); v[6] = __uint_as_float(w.w << 16); v[7] = __uint_as_float(w.w & 0xffff0000u);
}
__device__ __forceinline__ float wave_sum(float v) {
#pragma unroll
    for (int o = 1; o < 64; o <<= 1) v += __shfl_xor(v, o);
    return v;
}
__device__ __forceinline__ float rsq(float x) { return __builtin_amdgcn_rsqf(x); }
typedef int v8i __attribute__((ext_vector_type(8)));
__device__ __forceinline__ unsigned pack4_f8(float a, float b, float c, float d) { int w = 0; w = __builtin_amdgcn_cvt_pk_fp8_f32(a, b, w, false); w = __builtin_amdgcn_cvt_pk_fp8_f32(c, d, w, true); return (unsigned)w; }
constexpr float W8_SCALE = 32.f, W8_INV = 1.f / 32.f;

#define XB_TMO      128
#define XB_XCNT(j)  (256  + 64 * (j))
#define XB_XSUB(j)  (1280 + 64 * (j))
#define XB_XGEN(j)  (2304 + 64 * (j))
#define XB_TOP      3328
#define XB_TOPGEN   3392
#define XCD_BAR_WORDS 3456
#define XB_SPIN_CAP (1u << 18)
__device__ __forceinline__ unsigned xb_ld(unsigned* p)              { return __hip_atomic_load(p, __ATOMIC_RELAXED, __HIP_MEMORY_SCOPE_AGENT); }
__device__ __forceinline__ unsigned xb_add(unsigned* p, unsigned v) { return __hip_atomic_fetch_add(p, v, __ATOMIC_RELAXED, __HIP_MEMORY_SCOPE_AGENT); }
__device__ __forceinline__ unsigned xb_xcc_id() { return (unsigned)__builtin_amdgcn_s_getreg((3 << 11) | 20) & 0xFu; }
#define XB_SPIN(cond, bar) do { unsigned _sp = 0; while (cond) { __builtin_amdgcn_s_sleep(1); \
    if ((++_sp & 255u) == 0u) { if (xb_ld(&(bar)[XB_TMO])) break; if (_sp > XB_SPIN_CAP) { atomicAdd(&(bar)[XB_TMO], 1u); break; } } } } while (0)
struct XcdBarrier { unsigned* bar; unsigned x; volatile LAS unsigned* st; unsigned g; };
__device__ __forceinline__ XcdBarrier xcd_barrier_post(unsigned* bar, volatile LAS unsigned* st) {
    XcdBarrier b; b.bar = bar; b.x = xb_xcc_id(); b.st = st; b.g = 0u;
    if (threadIdx.x == 0) (void)xb_add(&bar[XB_XCNT(b.x)], 1u);
    return b;
}
__device__ __forceinline__ void xcd_barrier_complete(unsigned* bar, unsigned x, unsigned& nloc, unsigned& nx, unsigned G) {
    unsigned sum, cnt, mine, sp = 0u;
    for (;;) {
        sum = 0u; cnt = 0u; mine = 0u;
#pragma unroll
        for (unsigned j = 0; j < 16; ++j) { const unsigned c = xb_ld(&bar[XB_XCNT(j)]); sum += c; cnt += (c > 0u) ? 1u : 0u; mine = (j == x) ? c : mine; }
        if (sum == G) break;
        __builtin_amdgcn_s_sleep(1);
        if ((++sp & 255u) == 0u) { if (xb_ld(&bar[XB_TMO])) break; if (sp > XB_SPIN_CAP) { atomicAdd(&bar[XB_TMO], 1u); break; } }
    }
    nloc = mine > 0u ? mine : 1u; nx = cnt > 0u ? cnt : 1u;
}
__device__ __forceinline__ void xcd_barrier(const XcdBarrier& b) {
    asm volatile("s_waitcnt vmcnt(0)" ::: "memory");
    __syncthreads();
    if (threadIdx.x == 0) {
        unsigned* bar = b.bar;
        __builtin_amdgcn_s_waitcnt(0);
        unsigned nloc = b.st[0], nx = b.st[1];
        if (nloc == 0u) { xcd_barrier_complete(bar, b.x, nloc, nx, b.g); b.st[0] = nloc; b.st[1] = nx; }
        const unsigned old = xb_add(&bar[XB_XSUB(b.x)], 1u);
        const unsigned gen = old / nloc;
        if (old + 1u == (gen + 1u) * nloc) {
            __builtin_amdgcn_fence(__ATOMIC_RELEASE, "agent");
            asm volatile("s_waitcnt vmcnt(0)" ::: "memory");
            const unsigned og = xb_add(&bar[XB_TOP], 1u);
            const unsigned tg = og / nx;
            if (og + 1u == (tg + 1u) * nx) xb_add(&bar[XB_TOPGEN], 1u);
            else XB_SPIN(xb_ld(&bar[XB_TOPGEN]) == tg, bar);
            __builtin_amdgcn_fence(__ATOMIC_ACQUIRE, "agent");
            asm volatile("s_waitcnt vmcnt(0)" ::: "memory");
        } else {
            XB_SPIN(xb_ld(&bar[XB_TOPGEN]) == gen, bar);
            __builtin_amdgcn_fence(__ATOMIC_ACQUIRE, "agent");
            asm volatile("s_waitcnt vmcnt(0)" ::: "memory");
        }
    }
    __syncthreads();
}

struct BSelNone { __device__ __forceinline__ size_t operator()(int) const { return 0; } };
struct BSelExpert { const int* tile_expert; size_t per; __device__ __forceinline__ size_t operator()(int m0) const { return (size_t)tile_expert[m0 >> 8] * per; } };
template <class Epi, class BSel>
__device__ __forceinline__ void simple_gemm(const bf16* __restrict__ A, const bf16* __restrict__ Bt, int K, int m_lo, int m_hi, int N, const Epi& E, const BSel& bsel, int gw, int ngw, int lane, int lda = 0) {
    if (lda == 0) lda = K;
    const int fr = lane & 15, fq = lane >> 4;
    const int mt = (m_hi - m_lo) / 64, nt = N / 32;
    for (int u = gw; u < mt * nt; u += ngw) {
        const int m0 = m_lo + (u / nt) * 64, n0 = (u % nt) * 32;
        const bf16* ap = A + (size_t)(m0 + fr) * lda + fq * 8;
        const bf16* bp = Bt + bsel(m0) + (size_t)(n0 + 8 * (fr >> 2) + (fr & 3)) * K + fq * 8;
        f32x4 acc[4][2];
#pragma unroll
        for (int i = 0; i < 4; ++i) { acc[i][0] = (f32x4){0.f, 0.f, 0.f, 0.f}; acc[i][1] = (f32x4){0.f, 0.f, 0.f, 0.f}; }
#pragma unroll 2
        for (int k = 0; k < K; k += 32) {
            bf16x8 a[4], b[2];
#pragma unroll
            for (int i = 0; i < 4; ++i) a[i] = *(const bf16x8*)(ap + (size_t)i * 16 * lda + k);
#pragma unroll
            for (int j = 0; j < 2; ++j) b[j] = *(const bf16x8*)(bp + (size_t)j * 4 * K + k);
#pragma unroll
            for (int i = 0; i < 4; ++i)
#pragma unroll
                for (int j = 0; j < 2; ++j) acc[i][j] = __builtin_amdgcn_mfma_f32_16x16x32_bf16(b[j], a[i], acc[i][j], 0, 0, 0);
        }
#pragma unroll
        for (int i = 0; i < 4; ++i) {
            const float v[8] = {acc[i][0][0], acc[i][0][1], acc[i][0][2], acc[i][0][3], acc[i][1][0], acc[i][1][1], acc[i][1][2], acc[i][1][3]};
            E.store8(m0 + 16 * i + fr, n0 + 8 * fq, v);
        }
    }
}


template <int K, class Epi>
__device__ __forceinline__ void smallk_task(const bf16* __restrict__ A, const bf16* __restrict__ Bt, int m0, int ng_lo, int ng_hi, const Epi& E, int lane) {
    constexpr int KS = K / 32;
    const int fr = lane & 15, fq = lane >> 4;
    bf16x8 a[4][KS];
#pragma unroll
    for (int i = 0; i < 4; ++i)
#pragma unroll
        for (int ks = 0; ks < KS; ++ks) a[i][ks] = *(const bf16x8*)(A + (size_t)(m0 + 16 * i + fr) * K + ks * 32 + fq * 8);
#pragma unroll 1
    for (int ng = ng_lo; ng < ng_hi; ++ng) {
        const int n0 = ng * 32;
        const bf16* bp = Bt + (size_t)(n0 + 8 * (fr >> 2) + (fr & 3)) * K + fq * 8;
        bf16x8 b[2][KS];
#pragma unroll
        for (int ks = 0; ks < KS; ++ks) { b[0][ks] = *(const bf16x8*)(bp + ks * 32); b[1][ks] = *(const bf16x8*)(bp + 4 * K + ks * 32); }
        f32x4 acc[4][2];
#pragma unroll
        for (int i = 0; i < 4; ++i) { acc[i][0] = (f32x4){0.f, 0.f, 0.f, 0.f}; acc[i][1] = (f32x4){0.f, 0.f, 0.f, 0.f}; }
#pragma unroll
        for (int ks = 0; ks < KS; ++ks)
#pragma unroll
            for (int i = 0; i < 4; ++i) { acc[i][0] = __builtin_amdgcn_mfma_f32_16x16x32_bf16(b[0][ks], a[i][ks], acc[i][0], 0, 0, 0); acc[i][1] = __builtin_amdgcn_mfma_f32_16x16x32_bf16(b[1][ks], a[i][ks], acc[i][1], 0, 0, 0); }
#pragma unroll
        for (int i = 0; i < 4; ++i) {
            const float v[8] = {acc[i][0][0], acc[i][0][1], acc[i][0][2], acc[i][0][3], acc[i][1][0], acc[i][1][1], acc[i][1][2], acc[i][1][3]};
            E.store8(m0 + 16 * i + fr, n0 + 8 * fq, v);
        }
    }
}


template <int K, int RMSK, class Epi>
__device__ __forceinline__ void meta_gemm16(const bf16* __restrict__ A, int lda, const bf16* __restrict__ Bt, int m0, int N, const Epi& E, int gw, int ngw, int lane) {
    const int fr = lane & 15, fq = lane >> 4;
    for (int ng = gw; ng < N / 32; ng += ngw) {
        const int n0 = ng * 32;
        const bf16* ap = A + (size_t)(m0 + fr) * lda + fq * 8;
        const bf16* bp = Bt + (size_t)(n0 + 8 * (fr >> 2) + (fr & 3)) * K + fq * 8;
        f32x4 acc0 = {0.f, 0.f, 0.f, 0.f}, acc1 = {0.f, 0.f, 0.f, 0.f}; float ss = 0.f;
#pragma unroll 8
        for (int k = 0; k < K; k += 32) { const bf16x8 a = *(const bf16x8*)(ap + k), b0 = *(const bf16x8*)(bp + k), b1 = *(const bf16x8*)(bp + 4 * K + k);
            if (RMSK > 0 && k < RMSK) { float f[8]; unpack8(__builtin_bit_cast(u32x4, a), f);
#pragma unroll
                for (int j = 0; j < 8; ++j) ss += f[j] * f[j]; }
            acc0 = __builtin_amdgcn_mfma_f32_16x16x32_bf16(b0, a, acc0, 0, 0, 0); acc1 = __builtin_amdgcn_mfma_f32_16x16x32_bf16(b1, a, acc1, 0, 0, 0); }
        float sc = 1.f;
        if (RMSK > 0) { ss += __shfl_xor(ss, 16); ss += __shfl_xor(ss, 32); sc = rsq(ss * (1.f / RMSK) + RMS_EPS); }
        const float v[8] = {acc0[0] * sc, acc0[1] * sc, acc0[2] * sc, acc0[3] * sc, acc1[0] * sc, acc1[1] * sc, acc1[2] * sc, acc1[3] * sc};
        E.store8(m0 + fr, n0 + 8 * fq, v);
    }
}

template <int K, class Epi>
__device__ __forceinline__ void meta_gemm16_ksplit(const bf16* __restrict__ A, int lda, const bf16* __restrict__ Bt, int m0, int N, const Epi& E, int blk, int nblk, int wave, int lane, LAS float* red) {
    static_assert(K % (NWAVES * 32) == 0, "K splits over the waves in 32-element steps");
    const int fr = lane & 15, fq = lane >> 4;
    for (int ng = blk; ng < N / 32; ng += nblk) {
        const int n0 = ng * 32, k0 = wave * (K / NWAVES);
        const bf16* ap = A + (size_t)(m0 + fr) * lda + fq * 8 + k0;
        const bf16* bp = Bt + (size_t)(n0 + 8 * (fr >> 2) + (fr & 3)) * K + fq * 8 + k0;
        f32x4 acc0 = {0.f, 0.f, 0.f, 0.f}, acc1 = {0.f, 0.f, 0.f, 0.f};
#pragma unroll
        for (int k = 0; k < K / NWAVES; k += 32) { const bf16x8 a = *(const bf16x8*)(ap + k), b0 = *(const bf16x8*)(bp + k), b1 = *(const bf16x8*)(bp + 4 * K + k);
            acc0 = __builtin_amdgcn_mfma_f32_16x16x32_bf16(b0, a, acc0, 0, 0, 0); acc1 = __builtin_amdgcn_mfma_f32_16x16x32_bf16(b1, a, acc1, 0, 0, 0); }
        __syncthreads();
        *(LAS f32x4*)(red + (wave * 64 + lane) * 8) = acc0; *(LAS f32x4*)(red + (wave * 64 + lane) * 8 + 4) = acc1;
        __syncthreads();
        if (wave == 0) { f32x4 s0 = {0.f, 0.f, 0.f, 0.f}, s1 = {0.f, 0.f, 0.f, 0.f};
#pragma unroll
            for (int w = 0; w < NWAVES; ++w) { s0 += *(const LAS f32x4*)(red + (w * 64 + lane) * 8); s1 += *(const LAS f32x4*)(red + (w * 64 + lane) * 8 + 4); }
            const float v[8] = {s0[0], s0[1], s0[2], s0[3], s1[0], s1[1], s1[2], s1[3]};
            E.store8(m0 + fr, n0 + 8 * fq, v); }
    }
}

struct EpiZ { bf16* z;
    __device__ __forceinline__ void store8(int row, int col, const float (&v)[8]) const { *(u32x4*)(z + (size_t)row * ZLD + col) = pack8(v); } };
struct EpiQ { bf16* qm; const float* rs;
    __device__ __forceinline__ void store8(int row, int col, const float (&v_)[8]) const {
        const int h = col / 192, w = col - h * 192, b = row >> 11, s = row & 2047; const float r_ = rs[row];
        const float o[8] = {v_[0] * r_, v_[1] * r_, v_[2] * r_, v_[3] * r_, v_[4] * r_, v_[5] * r_, v_[6] * r_, v_[7] * r_};
        *(u32x4*)(qm + ((size_t)(b * 4 + h) * 2048 + s) * 192 + w) = pack8(o);
    } };
template <bool META> struct EpiKV { bf16* km; bf16* vm; const float* rs; int b_lo, b_hi;
    __device__ __forceinline__ void store8(int row, int col, const float (&v_)[8]) const {
        if (META && row >= MROWS) return;
        const float r_ = META ? 1.f : rs[row]; const float v[8] = {v_[0] * r_, v_[1] * r_, v_[2] * r_, v_[3] * r_, v_[4] * r_, v_[5] * r_, v_[6] * r_, v_[7] * r_};
        const int h = col >> 8, w = col & 255; const u32x4 pk = pack8(v);
        if (!META) { const int b = row >> 11, key = row & 2047; const size_t r = (size_t)(b * 4 + h) * LKP + key;
            if (w < 128) *(u32x4*)(km + r * 192 + w) = pk; else *(u32x4*)(vm + r * 128 + (w - 128)) = pk;
        } else { const int key = 2048 + (row - NTOK);
            for (int b = b_lo; b < b_hi; ++b) { const size_t r = (size_t)(b * 4 + h) * LKP + key;
                if (w < 128) *(u32x4*)(km + r * 192 + w) = pk; else *(u32x4*)(vm + r * 128 + (w - 128)) = pk; } }
    } };
struct EpiO { bf16* y1; const bf16* h0;
    __device__ __forceinline__ void store8(int row, int col, const float (&v)[8]) const {
        float h[8]; unpack8(*(const u32x4*)(h0 + (size_t)row * DM + col), h);
        const float o[8] = {ALPHA * h[0] + v[0], ALPHA * h[1] + v[1], ALPHA * h[2] + v[2], ALPHA * h[3] + v[3], ALPHA * h[4] + v[4], ALPHA * h[5] + v[5], ALPHA * h[6] + v[6], ALPHA * h[7] + v[7]};
        *(u32x4*)(y1 + (size_t)row * DM + col) = pack8(o);
    } };
struct EpiLogit { float* logits; const float* bias;
    __device__ __forceinline__ void store8(int row, int col, const float (&v)[8]) const {
        float* y = logits + (size_t)row * NE + col;
        *(f32x4*)y = (f32x4){v[0] + bias[col], v[1] + bias[col + 1], v[2] + bias[col + 2], v[3] + bias[col + 3]};
        *(f32x4*)(y + 4) = (f32x4){v[4] + bias[col + 4], v[5] + bias[col + 5], v[6] + bias[col + 6], v[7] + bias[col + 7]};
    } };
namespace pg8 {
#define PG8_LAS __attribute__((address_space(3)))
typedef unsigned short bf16_t;
constexpr int BM = 256, BK = 64, HALF = 128, HTB = HALF * BK * 2, STAGE_BYTES = 8 * HTB, NXCD = 8, WGM = 8;
__host__ __device__ __forceinline__ int lds_byte(int r, int c) { const int st = (r >> 4) * 2 + (c >> 5), rr = r & 15, cc = c & 31, ob = rr * 64 + cc * 2; return st * 1024 + (ob ^ (((ob >> 9) & 1) << 5)); }
__host__ __device__ __forceinline__ void stage_rc(int b, int& R, int& C) { const int st = b / 1024, sb = b % 1024, swz = sb ^ (((sb >> 9) & 1) << 5); R = (st >> 1) * 16 + swz / 64; C = (st & 1) * 32 + (swz % 64) / 2; }
__host__ __device__ __forceinline__ int perm32(int rho) { const int n = rho >> 4, i = rho & 15; return 8 * (i >> 2) + 4 * n + (i & 3); }
struct Unit { int pm, pn, ui; };
struct Gemm { const bf16_t* A; const bf16_t* Bt; int M, N, K, lda; const int* row_tok; };
struct StaticOrder {
    int nM, nN, nwg, G, c, pm0;
    __host__ __device__ __forceinline__ void init(int M, int N, int G_, int c_) { nM = M / BM; nN = N / BM; nwg = nM * nN; G = G_; c = c_; pm0 = 0; }
    __host__ __device__ __forceinline__ bool next(int i, Unit& u) const {
        const long L = (long)i * G + c; if (L >= nwg) return false;
        int wgid = (int)L; { const int q = nwg / NXCD, r = nwg % NXCD, xcd = wgid % NXCD, off = wgid / NXCD; wgid = (xcd < r ? xcd * (q + 1) : r * (q + 1) + (xcd - r) * q) + off; }
        const int nig = WGM * nN, gid = wgid / nig, fm = gid * WGM, gsz = (nM - fm) < WGM ? (nM - fm) : WGM;
        u.pm = pm0 + fm + ((wgid % nig) % gsz); u.pn = (wgid % nig) / gsz; u.ui = i; return true;
    }
    __device__ __forceinline__ void a_ready(const Unit&) const {}
    __device__ __forceinline__ void done(const Unit&) const {}
};
struct MoeOrder {
    StaticOrder so; int pm0; const PG8_LAS int* tile_expert;
    __device__ __forceinline__ void init(int tiles, int nN, int G_, int c_, const PG8_LAS int* te) { so.nM = tiles; so.nN = nN; so.nwg = tiles * nN; so.G = G_; so.c = c_; so.pm0 = 0; pm0 = 0; tile_expert = te; }
    __device__ __forceinline__ bool next(int i, Unit& u) const { if (!so.next(i, u)) return false; u.pn += tile_expert[u.pm] * so.nN; u.pm += pm0; return true; }
    __device__ __forceinline__ void a_ready(const Unit&) const {}
    __device__ __forceinline__ void done(const Unit&) const {}
};
template <class E8> struct EpiAdapt {
    static constexpr bool PERM = true, AFTER_DRAIN = false;
    E8 e; int ncols_mod;
    __device__ __forceinline__ void operator()(const f32x4 (&acc)[2][2][4][2], const Unit& u, int wr, int wc, int fr, int fq) const {
        const int row0 = u.pm * BM + wr * 64 + fr; int colt = u.pn * BM; if (ncols_mod) colt %= ncols_mod;
        const int col0 = colt + wc * 32 + 8 * fq;
#pragma unroll
        for (int ai = 0; ai < 2; ++ai)
#pragma unroll
            for (int m = 0; m < 4; ++m)
#pragma unroll
                for (int bj = 0; bj < 2; ++bj) {
                    const float v[8] = {acc[ai][bj][m][0][0], acc[ai][bj][m][0][1], acc[ai][bj][m][0][2], acc[ai][bj][m][0][3], acc[ai][bj][m][1][0], acc[ai][bj][m][1][1], acc[ai][bj][m][1][2], acc[ai][bj][m][1][3]};
                    e.store8(row0 + ai * HALF + m * 16, col0 + bj * HALF, v); }
    }
};
struct NoHook { static constexpr bool ON = false; __device__ __forceinline__ void mid(f32x4 (&)[2][2][4][2], const Unit&, int, int) const {} };
template <class Epi, class Sched, bool ALIGN_EPI = false, bool SP2 = false, bool F8 = false, bool GATHER = false, class Hook = NoHook>
__device__ __forceinline__ void gemm_phase(PG8_LAS unsigned char* lds, const Gemm g, const Sched& S, const Epi& E, const Hook& H = Hook()) {
    int tid = threadIdx.x; asm volatile("" : "+v"(tid));
    const int wid = __builtin_amdgcn_readfirstlane(tid >> 6), lane = tid & 63, wr = wid >> 2, wc = wid & 3, fr = lane & 15, fq = lane >> 4;
    const int K = g.K, nt = K / BK;
    unsigned voffA[2], voffB[2];
#pragma unroll
    for (int i = 0; i < 2; ++i) { int R, C; stage_rc(tid * 16 + i * 8192, R, C); const int Rb = Epi::PERM ? ((R & ~31) + perm32(R & 31)) : R;
        voffA[i] = (unsigned)(R * g.lda + C) * 2u; voffB[i] = (unsigned)(Rb * K + C) * 2u; }
    int gR[2]; unsigned gC[2];
#pragma unroll
    for (int i = 0; i < 2; ++i) { int R, C; stage_rc(tid * 16 + i * 8192, R, C); gR[i] = R; gC[i] = (unsigned)C * 2u; }
    const unsigned lda2 = (unsigned)g.lda * 2u;
    unsigned vC[2][2], vN[2][2]; int tkn[2][2];
    static_assert(!GATHER || SP2, "GATHER is written for the SP2 loop");
#define PG8_TOKLD(dst, pm_) do { _Pragma("unroll") for (int h_ = 0; h_ < 2; ++h_) _Pragma("unroll") for (int i_ = 0; i_ < 2; ++i_) dst[h_][i_] = g.row_tok[(pm_) * 256 + h_ * 128 + gR[i_]]; } while (0)
#define PG8_TOKOFF(dst, src) do { _Pragma("unroll") for (int h_ = 0; h_ < 2; ++h_) _Pragma("unroll") for (int i_ = 0; i_ < 2; ++i_) dst[h_][i_] = (unsigned)src[h_][i_] * lda2 + gC[i_]; } while (0)
    const size_t kstep = (size_t)(BK * 2);
    const size_t hstep = (size_t)HALF * K * 2, hstepA = (size_t)HALF * g.lda * 2;
    const size_t tstep = 2 * hstep, tstepA = 2 * hstepA;
    const unsigned ldsw = (unsigned)wid * 1024u;
    const int aoff = lds_byte(wr * 64 + fr, fq * 8), boff = lds_byte(wc * 32 + fr, fq * 8);
#define PG8_SA(b, h) (((b) * 2 + (h)) * HTB)
#define PG8_SB(b, h) ((4 + (b) * 2 + (h)) * HTB)
#define PG8_STAGE(bufoff, gbase, voff) do { _Pragma("unroll") for (int _i = 0; _i < 2; ++_i) \
        __builtin_amdgcn_global_load_lds((const unsigned*)((const char*)(gbase) + (voff)[_i]), (PG8_LAS unsigned*)(lds + (bufoff) + ldsw + _i * 8192), 16, 0, 0); } while (0)
#define PG8_LDA(dst, b, h) do { _Pragma("unroll") for (int m = 0; m < 4; ++m) _Pragma("unroll") for (int k = 0; k < 2; ++k) dst[m][k] = *(const PG8_LAS bf16x8*)(lds + PG8_SA(b, h) + aoff + m * 2048 + k * 1024); } while (0)
#define PG8_LDB(dst, b, h) do { _Pragma("unroll") for (int n = 0; n < 2; ++n) _Pragma("unroll") for (int k = 0; k < 2; ++k) dst[n][k] = *(const PG8_LAS bf16x8*)(lds + PG8_SB(b, h) + boff + n * 2048 + k * 1024); } while (0)
#define PG8_F8CAT(x) __builtin_shufflevector(__builtin_bit_cast(u32x4, (x)[0]), __builtin_bit_cast(u32x4, (x)[1]), 0, 1, 2, 3, 4, 5, 6, 7)
#define PG8_MMA(ai, bj, At, Bt) do { __builtin_amdgcn_s_setprio(1); if constexpr (F8) { _Pragma("unroll") for (int m = 0; m < 4; ++m) _Pragma("unroll") for (int n = 0; n < 2; ++n) \
        acc[ai][bj][m][n] = __builtin_amdgcn_mfma_scale_f32_16x16x128_f8f6f4(__builtin_bit_cast(v8i, PG8_F8CAT(Bt[n])), __builtin_bit_cast(v8i, PG8_F8CAT(At[m])), acc[ai][bj][m][n], 0, 0, 0, 0, 0, 0); \
        _Pragma("unroll") for (int m = 0; m < 4; ++m) _Pragma("unroll") for (int n = 0; n < 2; ++n) asm volatile("" : "+v"(acc[ai][bj][m][n])); } \
    else { _Pragma("unroll") for (int m = 0; m < 4; ++m) _Pragma("unroll") for (int n = 0; n < 2; ++n) _Pragma("unroll") for (int k = 0; k < 2; ++k) \
        acc[ai][bj][m][n] = __builtin_amdgcn_mfma_f32_16x16x32_bf16(Bt[n][k], At[m][k], acc[ai][bj][m][n], 0, 0, 0); } __builtin_amdgcn_s_setprio(0); } while (0)
#define PG8_WAIT_V(n) asm volatile("s_waitcnt vmcnt(" #n ")" ::: "memory")
#define PG8_WAIT_L(n) asm volatile("s_waitcnt lgkmcnt(" #n ")" ::: "memory")
#define PG8_BAR __builtin_amdgcn_s_barrier()
#define PG8_SCHED __builtin_amdgcn_sched_barrier(0)
    Unit cur, nxt; int ui = 0;
    if (!S.next(0, cur)) return;
    f32x4 acc[2][2][4][2];
#pragma unroll
    for (int a = 0; a < 2; ++a)
#pragma unroll
        for (int b = 0; b < 2; ++b)
#pragma unroll
            for (int m = 0; m < 4; ++m)
#pragma unroll
                for (int n = 0; n < 2; ++n) acc[a][b][m][n] = (f32x4){0.f, 0.f, 0.f, 0.f};
    bf16x8 At[4][2], B0[2][2], B1[2][2];
    const char* const gA = (const char*)g.A;
    const char* cA = (const char*)g.A + (size_t)cur.pm * tstepA; const char* cB = (const char*)g.Bt + (size_t)cur.pn * tstep;
    S.a_ready(cur);
    if constexpr (SP2) {
        if constexpr (GATHER) { PG8_TOKLD(tkn, cur.pm); PG8_TOKOFF(vC, tkn); Unit u1_; if (S.next(1, u1_)) { PG8_TOKLD(tkn, u1_.pm); PG8_TOKOFF(vN, tkn); } else { PG8_TOKOFF(vN, tkn); } }
        PG8_STAGE(PG8_SB(0, 0), cB, voffB); PG8_STAGE(PG8_SB(0, 1), cB + hstep, voffB);
        if constexpr (GATHER) { PG8_STAGE(PG8_SA(0, 0), gA, vC[0]); PG8_STAGE(PG8_SA(0, 1), gA, vC[1]); } else { PG8_STAGE(PG8_SA(0, 0), cA, voffA); PG8_STAGE(PG8_SA(0, 1), cA + hstepA, voffA); }
        if (wr == 1) PG8_BAR;
        PG8_WAIT_V(2); PG8_BAR;
        PG8_STAGE(PG8_SB(1, 0), cB + kstep, voffB); if constexpr (GATHER) { PG8_STAGE(PG8_SA(1, 0), gA + kstep, vC[0]); } else { PG8_STAGE(PG8_SA(1, 0), cA + kstep, voffA); } PG8_STAGE(PG8_SB(1, 1), cB + hstep + kstep, voffB);
        PG8_WAIT_V(6); PG8_BAR;
    } else {
        PG8_STAGE(PG8_SB(0, 0), cB, voffB); PG8_STAGE(PG8_SA(0, 0), cA, voffA); PG8_STAGE(PG8_SB(0, 1), cB + hstep, voffB); PG8_STAGE(PG8_SA(0, 1), cA + hstepA, voffA);
        if (wr == 1) PG8_BAR;
        PG8_WAIT_V(4); PG8_BAR;
        PG8_STAGE(PG8_SB(1, 0), cB + kstep, voffB); PG8_STAGE(PG8_SA(1, 0), cA + kstep, voffA); PG8_STAGE(PG8_SB(1, 1), cB + hstep + kstep, voffB);
        PG8_WAIT_V(6); PG8_BAR;
    }
    for (;;) {
        const bool has_next = S.next(ui + 1, nxt);
        const char* nA = has_next ? (const char*)g.A + (size_t)nxt.pm * tstepA : cA; const char* nB = has_next ? (const char*)g.Bt + (size_t)nxt.pn * tstep : cB;
        for (int t = 0; t < nt; t += 2) {
            const bool last = (t == nt - 2);
            const char* a1 = cA + (size_t)(t + 1) * kstep;
            const char* a2 = last ? nA : cA + (size_t)(t + 2) * kstep; const char* b2 = last ? nB : cB + (size_t)(t + 2) * kstep;
            const char* a3 = a2 + kstep; const char* b3 = b2 + kstep;
            if (last && has_next) S.a_ready(nxt);
            if constexpr (Hook::ON) { if (t == nt / 2) H.mid(acc, cur, wr, fr); }
            if constexpr (SP2) {
            const char* ga1 = gA + (size_t)(t + 1) * kstep; const char* ga2 = gA + (last ? (size_t)0 : (size_t)(t + 2) * kstep); const char* ga3 = ga2 + kstep;
            unsigned v2[2][2];
            if constexpr (GATHER) { _Pragma("unroll") for (int h_ = 0; h_ < 2; ++h_) _Pragma("unroll") for (int i_ = 0; i_ < 2; ++i_) v2[h_][i_] = last ? vN[h_][i_] : vC[h_][i_]; }
            PG8_LDB(B0, 0, 0); PG8_LDB(B1, 0, 1); PG8_SCHED; PG8_LDA(At, 0, 0); if constexpr (GATHER) { PG8_STAGE(PG8_SA(1, 1), ga1, vC[1]); } else { PG8_STAGE(PG8_SA(1, 1), a1 + hstepA, voffA); }
            PG8_WAIT_V(8); PG8_WAIT_L(0); PG8_BAR; PG8_MMA(0, 0, At, B0); PG8_MMA(0, 1, At, B1); PG8_BAR; PG8_SCHED;
            PG8_LDA(At, 0, 1); PG8_STAGE(PG8_SB(0, 0), b2, voffB); PG8_STAGE(PG8_SB(0, 1), b2 + hstep, voffB); if constexpr (GATHER) { PG8_STAGE(PG8_SA(0, 0), ga2, v2[0]); } else { PG8_STAGE(PG8_SA(0, 0), a2, voffA); }
            PG8_WAIT_V(8); PG8_WAIT_L(0); PG8_BAR; PG8_MMA(1, 0, At, B0); PG8_MMA(1, 1, At, B1); PG8_BAR; PG8_SCHED;
            PG8_LDB(B0, 1, 0); PG8_LDB(B1, 1, 1); PG8_SCHED; PG8_LDA(At, 1, 0); if constexpr (GATHER) { PG8_STAGE(PG8_SA(0, 1), ga2, v2[1]); } else { PG8_STAGE(PG8_SA(0, 1), a2 + hstepA, voffA); }
            PG8_WAIT_V(8); PG8_WAIT_L(0); PG8_BAR; PG8_MMA(0, 0, At, B0); PG8_MMA(0, 1, At, B1); PG8_BAR; PG8_SCHED;
            PG8_LDA(At, 1, 1); PG8_STAGE(PG8_SB(1, 0), b3, voffB); PG8_STAGE(PG8_SB(1, 1), b3 + hstep, voffB); if constexpr (GATHER) { PG8_STAGE(PG8_SA(1, 0), ga3, v2[0]); } else { PG8_STAGE(PG8_SA(1, 0), a3, voffA); }
            PG8_WAIT_V(8); PG8_WAIT_L(0); PG8_BAR; PG8_MMA(1, 0, At, B0); PG8_MMA(1, 1, At, B1); PG8_BAR; PG8_SCHED;
            } else {
            PG8_LDB(B0, 0, 0); PG8_SCHED; PG8_LDA(At, 0, 0); PG8_STAGE(PG8_SA(1, 1), a1 + hstepA, voffA);
            PG8_WAIT_L(8); PG8_BAR; PG8_WAIT_L(0); PG8_MMA(0, 0, At, B0); PG8_BAR; PG8_SCHED;
            PG8_LDB(B1, 0, 1); PG8_STAGE(PG8_SB(0, 0), b2, voffB);
            PG8_BAR; PG8_WAIT_L(0); PG8_MMA(0, 1, At, B1); PG8_BAR;
            PG8_LDA(At, 0, 1); PG8_STAGE(PG8_SA(0, 0), a2, voffA);
            PG8_BAR; PG8_WAIT_L(0); PG8_MMA(1, 0, At, B0); PG8_BAR; PG8_SCHED;
            PG8_STAGE(PG8_SB(0, 1), b2 + hstep, voffB);
            PG8_WAIT_V(6); PG8_BAR; PG8_MMA(1, 1, At, B1); PG8_BAR;
            PG8_LDB(B0, 1, 0); PG8_SCHED; PG8_LDA(At, 1, 0); PG8_STAGE(PG8_SA(0, 1), a2 + hstepA, voffA);
            PG8_WAIT_L(8); PG8_BAR; PG8_WAIT_L(0); PG8_MMA(0, 0, At, B0); PG8_BAR; PG8_SCHED;
            PG8_LDB(B1, 1, 1); PG8_STAGE(PG8_SB(1, 0), b3, voffB);
            PG8_BAR; PG8_WAIT_L(0); PG8_MMA(0, 1, At, B1); PG8_BAR;
            PG8_LDA(At, 1, 1); PG8_STAGE(PG8_SA(1, 0), a3, voffA);
            PG8_BAR; PG8_WAIT_L(0); PG8_MMA(1, 0, At, B0); PG8_BAR; PG8_SCHED;
            PG8_STAGE(PG8_SB(1, 1), b3 + hstep, voffB);
            PG8_WAIT_V(6); PG8_BAR; PG8_MMA(1, 1, At, B1); PG8_BAR;
            }
        }
        if constexpr (ALIGN_EPI) { if (wr == 0) PG8_BAR; }
        bool has_nn = false;
        if constexpr (GATHER) { Unit nn_; has_nn = has_next && S.next(ui + 2, nn_); if (has_nn) PG8_TOKLD(tkn, nn_.pm); }
        if constexpr (!Epi::AFTER_DRAIN) { E(acc, cur, wr, wc, fr, fq); S.done(cur); }
        if (!has_next) break;
        if constexpr (GATHER) { _Pragma("unroll") for (int h_ = 0; h_ < 2; ++h_) _Pragma("unroll") for (int i_ = 0; i_ < 2; ++i_) vC[h_][i_] = vN[h_][i_]; if (has_nn) PG8_TOKOFF(vN, tkn); }
#pragma unroll
        for (int a = 0; a < 2; ++a)
#pragma unroll
            for (int b = 0; b < 2; ++b)
#pragma unroll
                for (int m = 0; m < 4; ++m)
#pragma unroll
                    for (int n = 0; n < 2; ++n) acc[a][b][m][n] = (f32x4){0.f, 0.f, 0.f, 0.f};
        cur = nxt; cA = nA; cB = nB; ++ui;
        if constexpr (ALIGN_EPI) { if (wr == 1) PG8_BAR; }
    }
    PG8_WAIT_V(0);
    if constexpr (!ALIGN_EPI) { if (wr == 0) PG8_BAR; }
    PG8_BAR;
#undef PG8_SA
#undef PG8_SB
#undef PG8_STAGE
#undef PG8_LDA
#undef PG8_LDB
#undef PG8_MMA
#undef PG8_F8CAT
#undef PG8_TOKLD
#undef PG8_TOKOFF
#undef PG8_WAIT_V
#undef PG8_WAIT_L
#undef PG8_BAR
#undef PG8_SCHED
}
}

__device__ __forceinline__ u32x4 f8_pair16(u32x2 rowA, u32x2 rowB) {
    const auto s0 = __builtin_amdgcn_permlane16_swap(rowA.x, rowB.x, false, false), s1 = __builtin_amdgcn_permlane16_swap(rowA.y, rowB.y, false, false);
    return (u32x4){s0[0], s1[0], s0[1], s1[1]};
}
struct EpiGU8 { static constexpr bool PERM = true, AFTER_DRAIN = false;
    unsigned char* act8; const float* bgu;
    __device__ __forceinline__ void operator()(const f32x4 (&acc)[2][2][4][2], const pg8::Unit& u, int wr, int wc, int fr, int fq) const {
        const int e = u.pn >> 3, ac0 = 128 * (u.pn & 7) + wc * 32 + 8 * fq;
        const float* bb = bgu + (size_t)e * 2048 + 2 * ac0;
        const f32x4 q0 = *(const f32x4*)bb, q1 = *(const f32x4*)(bb + 4), q2 = *(const f32x4*)(bb + 8), q3 = *(const f32x4*)(bb + 12);
        const float bg[8] = {q0[0], q0[2], q1[0], q1[2], q2[0], q2[2], q3[0], q3[2]}, bl[8] = {q0[1], q0[3], q1[1], q1[3], q2[1], q2[3], q3[1], q3[3]};
        const int odd = fq & 1, acs = ac0 - 8 * odd;
#pragma unroll
        for (int ai = 0; ai < 2; ++ai)
#pragma unroll
            for (int mp = 0; mp < 2; ++mp) { u32x2 pk[2];
#pragma unroll
                for (int h = 0; h < 2; ++h) { const int m = 2 * mp + h; float o[8];
#pragma unroll
                    for (int t = 0; t < 8; t += 2) {
                        const f32x2 ag = {acc[ai][0][m][t >> 2][t & 3], acc[ai][0][m][(t + 1) >> 2][(t + 1) & 3]}, al = {acc[ai][1][m][t >> 2][t & 3], acc[ai][1][m][(t + 1) >> 2][(t + 1) & 3]};
                        f32x2 xg = ag * W8_INV + (f32x2){bg[t], bg[t + 1]}, xl = al * W8_INV + (f32x2){bl[t], bl[t + 1]};
                        xg.x = fminf(xg.x, 7.f); xg.y = fminf(xg.y, 7.f); xl.x = __builtin_amdgcn_fmed3f(xl.x, -7.f, 7.f); xl.y = __builtin_amdgcn_fmed3f(xl.y, -7.f, 7.f);
                        const f32x2 ex = xg * (-1.702f * 1.4426950408889634f); f32x2 dn; dn.x = __builtin_amdgcn_exp2f(ex.x); dn.y = __builtin_amdgcn_exp2f(ex.y); dn = dn + 1.f;
                        f32x2 sg; sg.x = __builtin_amdgcn_rcpf(dn.x); sg.y = __builtin_amdgcn_rcpf(dn.y);
                        const f32x2 pq = xg * sg, ov = pq * xl + pq; o[t] = ov.x; o[t + 1] = ov.y; }
                    pk[h] = (u32x2){pack4_f8(o[0], o[1], o[2], o[3]), pack4_f8(o[4], o[5], o[6], o[7])}; }
                const int row = u.pm * 256 + ai * 128 + wr * 64 + (2 * mp + odd) * 16 + fr;
                *(u32x4*)(act8 + (size_t)row * DM + acs) = f8_pair16(pk[0], pk[1]); }
    } };
constexpr float O2_SCALE = 8.f, O2_INV = 1.f / 8.f;
struct EpiDN8 { static constexpr bool PERM = true, AFTER_DRAIN = false;
    unsigned char* out2; const float* bdn; const float* row_gate;
    __device__ __forceinline__ void operator()(const f32x4 (&acc)[2][2][4][2], const pg8::Unit& u, int wr, int wc, int fr, int fq) const {
        const int e = u.pn >> 2, c0 = 256 * (u.pn & 3) + wc * 32 + 8 * fq;
        f32x4 bv[2][2];
#pragma unroll
        for (int bj = 0; bj < 2; ++bj) { bv[bj][0] = *(const f32x4*)(bdn + (size_t)e * DM + c0 + bj * 128); bv[bj][1] = *(const f32x4*)(bdn + (size_t)e * DM + c0 + bj * 128 + 4); }
        const int odd = fq & 1, cs = c0 - 8 * odd;
#pragma unroll
        for (int ai = 0; ai < 2; ++ai)
#pragma unroll
            for (int mp = 0; mp < 2; ++mp) { u32x2 pk[2][2];
#pragma unroll
                for (int h = 0; h < 2; ++h) { const int m = 2 * mp + h; const float g = row_gate[u.pm * 256 + ai * 128 + wr * 64 + m * 16 + fr] * O2_SCALE;
#pragma unroll
                    for (int bj = 0; bj < 2; ++bj) { const f32x4 v0 = (acc[ai][bj][m][0] * W8_INV + bv[bj][0]) * g, v1 = (acc[ai][bj][m][1] * W8_INV + bv[bj][1]) * g;
                        pk[bj][h] = (u32x2){pack4_f8(v0[0], v0[1], v0[2], v0[3]), pack4_f8(v1[0], v1[1], v1[2], v1[3])}; } }
                const int row = u.pm * 256 + ai * 128 + wr * 64 + (2 * mp + odd) * 16 + fr;
#pragma unroll
                for (int bj = 0; bj < 2; ++bj) *(u32x4*)(out2 + (size_t)row * DM + cs + bj * 128) = f8_pair16(pk[bj][0], pk[bj][1]); }
    } };

struct HookO { static constexpr bool ON = true; const LAS f32x2* T;
    __device__ __forceinline__ void mid(f32x4 (&acc)[2][2][4][2], const pg8::Unit& u, int wr, int fr) const {
#pragma unroll
        for (int ai = 0; ai < 2; ++ai)
#pragma unroll
            for (int m = 0; m < 4; ++m) { const float r = T[u.ui * 256 + ai * 128 + wr * 64 + m * 16 + fr].x;
#pragma unroll
                for (int bj = 0; bj < 2; ++bj) { acc[ai][bj][m][0] = acc[ai][bj][m][0] * r; acc[ai][bj][m][1] = acc[ai][bj][m][1] * r; } }
    } };
struct EpiOF { static constexpr bool PERM = true, AFTER_DRAIN = false;
    bf16* y1; const bf16* h0; const LAS f32x2* T;
    __device__ __forceinline__ void operator()(const f32x4 (&acc)[2][2][4][2], const pg8::Unit& u, int wr, int wc, int fr, int fq) const {
        const int c0 = u.pn * 256 + wc * 32 + 8 * fq;
#pragma unroll
        for (int ai = 0; ai < 2; ++ai)
#pragma unroll
            for (int m = 0; m < 4; ++m) { const int rl = ai * 128 + wr * 64 + m * 16 + fr, row = u.pm * 256 + rl; const float r = T[u.ui * 256 + rl].y;
#pragma unroll
                for (int bj = 0; bj < 2; ++bj) { float h[8]; unpack8(*(const u32x4*)(h0 + (size_t)row * DM + c0 + bj * 128), h);
                    const f32x4 a = acc[ai][bj][m][0] * r, b = acc[ai][bj][m][1] * r;
                    const float o[8] = {ALPHA * h[0] + a[0], ALPHA * h[1] + a[1], ALPHA * h[2] + a[2], ALPHA * h[3] + a[3], ALPHA * h[4] + b[0], ALPHA * h[5] + b[1], ALPHA * h[6] + b[2], ALPHA * h[7] + b[3]};
                    *(u32x4*)(y1 + (size_t)row * DM + c0 + bj * 128) = pack8(o); } }
    } };

struct EpiZF { static constexpr bool PERM = true, AFTER_DRAIN = false;
    bf16* z; float* rs_q; float* rs_kv; bf16* km; bf16* qg; bf16* kg; bf16* vg; const float* rope; const float* g_q; const float* g_k; LAS float* X;
    __device__ __forceinline__ void operator()(const f32x4 (&acc)[2][2][4][2], const pg8::Unit& u, int wr, int wc, int fr, int fq) const {
        const int pn = u.pn, cw = wc * 32 + 8 * fq;
        LAS float* Xa = X + (wr * 64 + fr) * 4; LAS float* Xb = X + (wr * 64 + fr) * 8;
        asm volatile("" : "+v"(Xa)); asm volatile("" : "+v"(Xb));
        if (pn <= 1) {
#pragma unroll
            for (int ai = 0; ai < 2; ++ai)
#pragma unroll
                for (int m = 0; m < 4; ++m) { const int rl = ai * 128 + wr * 64 + m * 16 + fr, row = u.pm * 256 + rl; float ss = 0.f;
#pragma unroll
                    for (int bj = 0; bj < 2; ++bj) { const f32x4 a = acc[ai][bj][m][0], b = acc[ai][bj][m][1];
                        if (bj == 0 || pn == 0) ss += (a[0] * a[0] + a[1] * a[1]) + (a[2] * a[2] + a[3] * a[3]) + (b[0] * b[0] + b[1] * b[1]) + (b[2] * b[2] + b[3] * b[3]);
                        *(u32x4*)(z + (size_t)row * ZLD + pn * 256 + bj * 128 + cw) = (u32x4){cvtpk(a[0], a[1]), cvtpk(a[2], a[3]), cvtpk(b[0], b[1]), cvtpk(b[2], b[3])}; }
                    ss += __shfl_xor(ss, 16); ss += __shfl_xor(ss, 32);
                    if (fq == 0) Xa[(ai * 128 + m * 16) * 4 + wc] = ss;
                    if (pn == 1 && wc < 2) {
                        const int b_ = row >> 11, s_ = row & 2047; const float* t = rope + ((size_t)(16 + s_ + 1) * 32 + (cw >> 1)) * 2; const f32x4 t0 = *(const f32x4*)t, t1 = *(const f32x4*)(t + 4);
                        const f32x4 a = acc[ai][1][m][0], b = acc[ai][1][m][1];
                        const u32x4 pk = {cvtpk(a[0] * t0[0] - a[1] * t0[1], a[0] * t0[1] + a[1] * t0[0]), cvtpk(a[2] * t0[2] - a[3] * t0[3], a[2] * t0[3] + a[3] * t0[2]),
                                          cvtpk(b[0] * t1[0] - b[1] * t1[1], b[0] * t1[1] + b[1] * t1[0]), cvtpk(b[2] * t1[2] - b[3] * t1[3], b[2] * t1[3] + b[3] * t1[2])};
#pragma unroll
                        for (int h = 0; h < 4; ++h) *(u32x4*)(km + ((size_t)(b_ * 4 + h) * LKP + s_) * 192 + 128 + cw) = pk; } }
            asm volatile("s_waitcnt lgkmcnt(0)" ::: "memory"); __builtin_amdgcn_s_barrier(); asm volatile("" ::: "memory");
            if (wc == 0 && fq == 0) {
#pragma unroll
                for (int ai = 0; ai < 2; ++ai)
#pragma unroll
                    for (int m = 0; m < 4; ++m) { const int rl = ai * 128 + wr * 64 + m * 16 + fr; const f32x4 x = *(const LAS f32x4*)(Xa + (ai * 128 + m * 16) * 4); const float tot = (x[0] + x[1]) + (x[2] + x[3]);
                        if (pn == 0) rs_q[u.pm * 256 + rl] = rsq(tot * (1.f / 256) + RMS_EPS); else rs_kv[u.pm * 256 + rl] = rsq(tot * (1.f / 128) + RMS_EPS); } }
        } else if (pn <= 4) {
            const int half = cw >> 6, i0 = (cw & 63) >> 1; const float* gp = (pn == 4 ? g_k : g_q) + half * 64 + i0;
            const f32x4 g1 = *(const f32x4*)gp, g2 = *(const f32x4*)(gp + 32);
#pragma unroll
            for (int ai = 0; ai < 2; ++ai)
#pragma unroll
                for (int m = 0; m < 4; ++m) { const int rl = ai * 128 + wr * 64 + m * 16 + fr;
#pragma unroll
                    for (int bj = 0; bj < 2; ++bj) { const f32x4 a = acc[ai][bj][m][0], b = acc[ai][bj][m][1];
                        float ss = (a[0] * a[0] + a[1] * a[1]) + (a[2] * a[2] + a[3] * a[3]) + (b[0] * b[0] + b[1] * b[1]) + (b[2] * b[2] + b[3] * b[3]);
                        ss += __shfl_xor(ss, 16); ss += __shfl_xor(ss, 32);
                        if (fq == 0) Xb[((ai * 128 + m * 16) * 2 + bj) * 4 + wc] = ss; } }
            asm volatile("s_waitcnt lgkmcnt(0)" ::: "memory"); __builtin_amdgcn_s_barrier(); asm volatile("" ::: "memory");
#pragma unroll
            for (int ai = 0; ai < 2; ++ai)
#pragma unroll
                for (int m = 0; m < 4; ++m) { const int rl = ai * 128 + wr * 64 + m * 16 + fr, row = u.pm * 256 + rl, b_ = row >> 11, s_ = row & 2047;
                    const int apos = half ? (s_ & 63) : (s_ >> 6); const float* t = rope + ((size_t)(apos + 1) * 32 + i0) * 2; const f32x4 t0 = *(const f32x4*)t, t1 = *(const f32x4*)(t + 4);
#pragma unroll
                    for (int bj = 0; bj < 2; ++bj) { const f32x4 x = *(const LAS f32x4*)(Xb + ((ai * 128 + m * 16) * 2 + bj) * 4); const float rs = rsq(((x[0] + x[1]) + (x[2] + x[3])) * (1.f / 128) + RMS_EPS);
                        const f32x4 a = acc[ai][bj][m][0] * rs, b = acc[ai][bj][m][1] * rs;
                        const float x0 = a[0] * g1[0], y0 = a[1] * g2[0], x1 = a[2] * g1[1], y1 = a[3] * g2[1], x2 = b[0] * g1[2], y2 = b[1] * g2[2], x3 = b[2] * g1[3], y3 = b[3] * g2[3];
                        const u32x4 pk = {cvtpk(x0 * t0[0] - y0 * t0[1], x0 * t0[1] + y0 * t0[0]), cvtpk(x1 * t0[2] - y1 * t0[3], x1 * t0[3] + y1 * t0[2]),
                                          cvtpk(x2 * t1[0] - y2 * t1[1], x2 * t1[1] + y2 * t1[0]), cvtpk(x3 * t1[2] - y3 * t1[3], x3 * t1[3] + y3 * t1[2])};
                        if (pn == 4) *(u32x4*)(kg + ((size_t)(b_ * 2 + bj) * LKP + s_) * 128 + cw) = pk;
                        else *(u32x4*)(qg + ((size_t)(b_ * 4 + (pn - 2) * 2 + bj) * 2048 + s_) * 128 + cw) = pk; } }
        } else {
#pragma unroll
            for (int ai = 0; ai < 2; ++ai)
#pragma unroll
                for (int m = 0; m < 4; ++m) { const int row = u.pm * 256 + ai * 128 + wr * 64 + m * 16 + fr, b_ = row >> 11, s_ = row & 2047;
#pragma unroll
                    for (int bj = 0; bj < 2; ++bj) { const f32x4 a = acc[ai][bj][m][0], b = acc[ai][bj][m][1];
                        *(u32x4*)(vg + ((size_t)(b_ * 2 + bj) * LKP + s_) * 128 + cw) = (u32x4){cvtpk(a[0], a[1]), cvtpk(a[2], a[3]), cvtpk(b[0], b[1]), cvtpk(b[2], b[3])}; } }
        }
    } };
#ifndef FAST_Z
#define FAST_Z 1
#endif
#ifndef FAST_O
#define FAST_O 1
#endif

struct MapId { __device__ __forceinline__ int operator()(int n) const { return n; } };
struct MapIn { __device__ __forceinline__ int operator()(int n) const {
    if (n < 384) return n;
    if (n < 448) { const int l = n - 384; return 384 + 2 * (l & 31) + (l >> 5); }
    if (n < 1216) { const int l = n - 448, hd = l >> 7, d = l & 127; return 512 + hd * 128 + (d >> 6) * 64 + 2 * (d & 31) + ((d >> 5) & 1); }
    return 1280 + (n - 1216); } };
struct MapQ { __device__ __forceinline__ int operator()(int n) const { const int h = n / 192, w = n - h * 192; if (w < 128) return n; const int l = w - 128; return h * 192 + 128 + 2 * (l & 31) + (l >> 5); } };
struct MapGU { __device__ __forceinline__ int operator()(int n) const { const int a = n >> 1; return 256 * (a >> 7) + 128 * (n & 1) + (a & 127); } };
template <class Map>
__device__ __forceinline__ void transpose_item(const float* __restrict__ W, int K, int N, bf16* __restrict__ WT, LAS float* scr, int item, int lane, const Map& map, const float* __restrict__ kscale = nullptr, int ldo = 0, const float* __restrict__ kscale2 = nullptr) {
    if (ldo == 0) ldo = K;
    const int nblk = N / 32, kb = item / nblk, nb = item - kb * nblk, k0 = 64 * kb, n0 = 32 * nb;
#pragma unroll
    for (int i = 0; i < 32; ++i) { const int kk = 2 * i + (lane >> 5); scr[kk * 33 + (lane & 31)] = (k0 < K) ? W[(size_t)(k0 + kk) * N + n0 + (lane & 31)] * (kscale ? ((kscale2 && k0 + kk >= 512) ? kscale2[k0 + kk - 512] : kscale[k0 + kk]) : 1.f) : 0.f; }
    LDS_WAIT(); asm volatile("" ::: "memory");
    const int c = lane & 7;
#pragma unroll
    for (int j = 0; j < 4; ++j) { const int n = (lane >> 3) + 8 * j; const LAS float* s = scr + (8 * c) * 33 + n;
        u32x4 o; o.x = cvtpk(s[0 * 33], s[1 * 33]); o.y = cvtpk(s[2 * 33], s[3 * 33]); o.z = cvtpk(s[4 * 33], s[5 * 33]); o.w = cvtpk(s[6 * 33], s[7 * 33]);
        *(u32x4*)(WT + (size_t)map(n0 + n) * ldo + k0 + 8 * c) = o; }
    LDS_WAIT(); asm volatile("" ::: "memory");
}

template <class Map>
__device__ __forceinline__ void transpose_item_f8(const float* __restrict__ W, int K, int N, unsigned char* __restrict__ WT, LAS float* scr, int item, int lane, const Map& map, float scale) {
    const int nblk = N / 32, kb = item / nblk, nb = item - kb * nblk, k0 = 64 * kb, n0 = 32 * nb;
#pragma unroll 8
    for (int i = 0; i < 8; ++i) { const int kk = 8 * i + (lane >> 3), c4 = (lane & 7) * 4; const f32x4 w4 = *(const f32x4*)(W + (size_t)(k0 + kk) * N + n0 + c4) * scale;
        LAS float* d_ = scr + kk * 33 + c4; d_[0] = w4[0]; d_[1] = w4[1]; d_[2] = w4[2]; d_[3] = w4[3]; }
    LDS_WAIT(); asm volatile("" ::: "memory");
    const int n = lane >> 1;
#pragma unroll
    for (int j = 0; j < 2; ++j) { const int c = 2 * (lane & 1) + j; const LAS float* s_ = scr + (16 * c) * 33 + n;
        u32x4 o; o.x = pack4_f8(s_[0 * 33], s_[1 * 33], s_[2 * 33], s_[3 * 33]); o.y = pack4_f8(s_[4 * 33], s_[5 * 33], s_[6 * 33], s_[7 * 33]);
        o.z = pack4_f8(s_[8 * 33], s_[9 * 33], s_[10 * 33], s_[11 * 33]); o.w = pack4_f8(s_[12 * 33], s_[13 * 33], s_[14 * 33], s_[15 * 33]);
        *(u32x4*)(WT + (size_t)map(n0 + n) * K + k0 + 16 * c) = o; }
    LDS_WAIT(); asm volatile("" ::: "memory");
}

template <class Map>
__device__ __forceinline__ void transpose_f8_stream(const float* __restrict__ Wall, int N, unsigned char* __restrict__ WTall, LAS float* scr, int gw, int ngw, int lane, const Map& map, float scale, int e_lo = 0, int e_hi = NE) {
    const int nblk = N / 32, per = 16 * nblk, n_items = e_hi * per;
#define T8_LOAD(dst, it_) do { const int e_ = (it_) / per, r_ = (it_) - e_ * per, kb_ = r_ / nblk, nb_ = r_ - kb_ * nblk; \
        const float* wp_ = Wall + ((size_t)e_ * 1024 + 64 * kb_ + (lane >> 3)) * N + 32 * nb_ + (lane & 7) * 4; \
        _Pragma("unroll") for (int i = 0; i < 8; ++i) dst[i] = *(const f32x4*)(wp_ + (size_t)(8 * i) * N); } while (0)
    f32x4 cur[8], nxt[8];
    int it = e_lo * per + gw; if (it < n_items) T8_LOAD(cur, it);
    for (; it < n_items; it += ngw) {
        const int itn = it + ngw; if (itn < n_items) T8_LOAD(nxt, itn);
        const int e = it / per, r = it - e * per, kb = r / nblk, nb = r - kb * nblk, k0 = 64 * kb, n0 = 32 * nb;
#pragma unroll
        for (int i = 0; i < 8; ++i) { LAS float* d_ = scr + (8 * i + (lane >> 3)) * 33 + (lane & 7) * 4; const f32x4 w4 = cur[i] * scale; d_[0] = w4[0]; d_[1] = w4[1]; d_[2] = w4[2]; d_[3] = w4[3]; }
        LDS_WAIT(); asm volatile("" ::: "memory");
        const int n = lane >> 1;
#pragma unroll
        for (int j = 0; j < 2; ++j) { const int c = 2 * (lane & 1) + j; const LAS float* s_ = scr + (16 * c) * 33 + n;
            u32x4 o; o.x = pack4_f8(s_[0 * 33], s_[1 * 33], s_[2 * 33], s_[3 * 33]); o.y = pack4_f8(s_[4 * 33], s_[5 * 33], s_[6 * 33], s_[7 * 33]);
            o.z = pack4_f8(s_[8 * 33], s_[9 * 33], s_[10 * 33], s_[11 * 33]); o.w = pack4_f8(s_[12 * 33], s_[13 * 33], s_[14 * 33], s_[15 * 33]);
            *(u32x4*)(WTall + ((size_t)e * N + map(n0 + n)) * 1024 + k0 + 16 * c) = o; }
        LDS_WAIT(); asm volatile("" ::: "memory");
#pragma unroll
        for (int i = 0; i < 8; ++i) cur[i] = nxt[i];
    }
#undef T8_LOAD
}
__device__ __forceinline__ void ln_row_f32_to_bf16(f32x4 (&v)[4], const f32x4 (&gg)[4], const f32x4 (&bb)[4], bf16* __restrict__ orow, int lane) {
    float s = 0.f;
#pragma unroll
    for (int j = 0; j < 4; ++j) s += (v[j].x + v[j].y) + (v[j].z + v[j].w);
    const float mean = wave_sum(s) * (1.f / DM); float s2 = 0.f;
#pragma unroll
    for (int j = 0; j < 4; ++j) { v[j] = v[j] - mean; s2 += (v[j].x * v[j].x + v[j].y * v[j].y) + (v[j].z * v[j].z + v[j].w * v[j].w); }
    const float rstd = rsq(wave_sum(s2) * (1.f / DM) + LN_EPS);
#pragma unroll
    for (int j = 0; j < 4; ++j) { const f32x4 o = v[j] * rstd * gg[j] + bb[j]; ((u32x2*)orow)[lane + 64 * j] = (u32x2){cvtpk(o.x, o.y), cvtpk(o.z, o.w)}; }
}

__device__ __forceinline__ void ln_row_bf16(const bf16* __restrict__ yrow, const f32x4 (&G4)[4], const f32x4 (&B4)[4], bf16* __restrict__ orow, unsigned char* __restrict__ o8, int lane) {
    float v[16]; unpack8(*(const u32x4*)(yrow + 8 * lane), *(float(*)[8])&v[0]); unpack8(*(const u32x4*)(yrow + 512 + 8 * lane), *(float(*)[8])&v[8]);
    float s = 0.f;
#pragma unroll
    for (int j = 0; j < 16; ++j) s += v[j];
    const float mean = wave_sum(s) * (1.f / DM); float s2 = 0.f;
#pragma unroll
    for (int j = 0; j < 16; ++j) { v[j] -= mean; s2 += v[j] * v[j]; }
    const float rstd = rsq(wave_sum(s2) * (1.f / DM) + LN_EPS);
#pragma unroll
    for (int hf = 0; hf < 2; ++hf) { const f32x4 a = (f32x4){v[hf * 8 + 0], v[hf * 8 + 1], v[hf * 8 + 2], v[hf * 8 + 3]} * rstd * G4[2 * hf] + B4[2 * hf], b = (f32x4){v[hf * 8 + 4], v[hf * 8 + 5], v[hf * 8 + 6], v[hf * 8 + 7]} * rstd * G4[2 * hf + 1] + B4[2 * hf + 1];
        *(u32x4*)(orow + hf * 512 + 8 * lane) = (u32x4){cvtpk(a[0], a[1]), cvtpk(a[2], a[3]), cvtpk(b[0], b[1]), cvtpk(b[2], b[3])};
        *(u32x2*)(o8 + hf * 512 + 8 * lane) = (u32x2){pack4_f8(a[0], a[1], a[2], a[3]), pack4_f8(b[0], b[1], b[2], b[3])}; }
}
__device__ __forceinline__ void ln_row_f8(const bf16* __restrict__ yrow, const f32x4 (&G4)[4], const f32x4 (&B4)[4], unsigned char* __restrict__ o8, int lane, float& mean_o, float& rstd_o) {
    float v[16]; unpack8(*(const u32x4*)(yrow + 8 * lane), *(float(*)[8])&v[0]); unpack8(*(const u32x4*)(yrow + 512 + 8 * lane), *(float(*)[8])&v[8]);
    float s = 0.f;
#pragma unroll
    for (int j = 0; j < 16; ++j) s += v[j];
    const float mean = wave_sum(s) * (1.f / DM); float s2 = 0.f;
#pragma unroll
    for (int j = 0; j < 16; ++j) { v[j] -= mean; s2 += v[j] * v[j]; }
    const float rstd = rsq(wave_sum(s2) * (1.f / DM) + LN_EPS);
#pragma unroll
    for (int hf = 0; hf < 2; ++hf) { const f32x4 a = (f32x4){v[hf * 8 + 0], v[hf * 8 + 1], v[hf * 8 + 2], v[hf * 8 + 3]} * rstd * G4[2 * hf] + B4[2 * hf], b = (f32x4){v[hf * 8 + 4], v[hf * 8 + 5], v[hf * 8 + 6], v[hf * 8 + 7]} * rstd * G4[2 * hf + 1] + B4[2 * hf + 1];
        *(u32x2*)(o8 + hf * 512 + 8 * lane) = (u32x2){pack4_f8(a[0], a[1], a[2], a[3]), pack4_f8(b[0], b[1], b[2], b[3])}; }
    mean_o = mean; rstd_o = rstd;
}
__device__ __forceinline__ void zero_bytes(void* p, size_t bytes, int gtid, int ngt) {
    u32x4* q = (u32x4*)p; const size_t n = bytes / 16;
    for (size_t i = gtid; i < n; i += ngt) q[i] = (u32x4){0u, 0u, 0u, 0u};
}
__device__ __forceinline__ void sincos_d(float angf, float& sn, float& cs) {
    const double x = (double)angf; const double q = __builtin_rint(x * 0.63661977236758134308);
    const double r = (x - q * 1.57079632679489655800) - q * 6.123233995736766036e-17, r2 = r * r;
    const double sp = r * (1.0 + r2 * (-1.0 / 6 + r2 * (1.0 / 120 + r2 * (-1.0 / 5040 + r2 * (1.0 / 362880 + r2 * (-1.0 / 39916800 + r2 * (1.0 / 6227020800.0)))))));
    const double cp = 1.0 + r2 * (-0.5 + r2 * (1.0 / 24 + r2 * (-1.0 / 720 + r2 * (1.0 / 40320 + r2 * (-1.0 / 3628800 + r2 * (1.0 / 479001600.0))))));
    const int qi = ((int)q) & 3;
    const double s_ = (qi == 0) ? sp : (qi == 1) ? cp : (qi == 2) ? -sp : -cp;
    const double c_ = (qi == 0) ? cp : (qi == 1) ? -sp : (qi == 2) ? -cp : sp;
    sn = (float)s_; cs = (float)c_;
}

__device__ __forceinline__ void p2a_row(int row, u32x4 wA, u32x4 wB, u32x4 wC, const float* __restrict__ rope, const float* __restrict__ g_q_a, const float* __restrict__ g_kv_a,
                                        const float* __restrict__ g_q_gqa, const float* __restrict__ g_k_gqa, float* rs_q, float* rs_kv, bf16* km, bf16* qg, bf16* kg, bf16* vg, int lane, int b_lo = 0, int b_hi = NB) {
    const bool meta = row >= NTOK;
    const int b = row >> 11, s = row & 2047, m = row - NTOK;
    const int pos1 = meta ? m : 16 + s, prow = meta ? -1 : (s >> 6), pcol = meta ? m : (s & 63), key = meta ? 2048 + m : s;
    {
        float f[8]; unpack8(wA, f);
        float ss = 0.f;
#pragma unroll
        for (int j = 0; j < 8; ++j) ss += f[j] * f[j];
        ss += __shfl_xor(ss, 1); ss += __shfl_xor(ss, 2); ss += __shfl_xor(ss, 4); ss += __shfl_xor(ss, 8);
        const float s16 = ss, s32 = ss + __shfl_xor(ss, 16);
        if (lane == 0) rs_q[row] = rsq(s32 * (1.f / 256) + RMS_EPS);
        if (lane == 32) rs_kv[row] = rsq(s16 * (1.f / 128) + RMS_EPS);
        if (lane < 48) {
        } else if (lane < 56) { const int i0 = 4 * (lane - 48); const float* t = rope + ((size_t)(pos1 + 1) * 32 + i0) * 2; float o[8];
#pragma unroll
            for (int j = 0; j < 4; ++j) { const float c = t[2 * j], sn = t[2 * j + 1], x1 = f[2 * j], x2 = f[2 * j + 1]; o[2 * j] = x1 * c - x2 * sn; o[2 * j + 1] = x1 * sn + x2 * c; }
            const u32x4 pk = pack8(o);
            if (!meta) { for (int h = 0; h < 4; ++h) *(u32x4*)(km + ((size_t)(b * 4 + h) * LKP + key) * 192 + 128 + 8 * (lane - 48)) = pk; }
            else { for (int bb = b_lo; bb < b_hi; ++bb) for (int h = 0; h < 4; ++h) *(u32x4*)(km + ((size_t)(bb * 4 + h) * LKP + key) * 192 + 128 + 8 * (lane - 48)) = pk; }
        }
    }
    const int p0 = (lane & 15) * 8, half = p0 >> 6, i0 = (p0 & 63) >> 1;
    const int apos = half ? pcol : prow; const float* t = rope + ((size_t)(apos + 1) * 32 + i0) * 2;
    if (!meta) {
        float f[8]; unpack8(wB, f);
        float ss = 0.f;
#pragma unroll
        for (int j = 0; j < 8; ++j) ss += f[j] * f[j];
        ss += __shfl_xor(ss, 1); ss += __shfl_xor(ss, 2); ss += __shfl_xor(ss, 4); ss += __shfl_xor(ss, 8);
        const float rs = rsq(ss * (1.f / 128) + RMS_EPS); float o[8];
#pragma unroll
        for (int j = 0; j < 4; ++j) { const int d1 = half * 64 + i0 + j, d2 = d1 + 32;
            const float x1 = f[2 * j] * rs * g_q_gqa[d1], x2 = f[2 * j + 1] * rs * g_q_gqa[d2], c = t[2 * j], sn = t[2 * j + 1];
            o[2 * j] = x1 * c - x2 * sn; o[2 * j + 1] = x1 * sn + x2 * c; }
        *(u32x4*)(qg + ((size_t)(b * 4 + (lane >> 4)) * 2048 + s) * 128 + p0) = pack8(o);
    }
    {
        float f[8]; unpack8(wC, f);
        float ss = 0.f;
#pragma unroll
        for (int j = 0; j < 8; ++j) ss += f[j] * f[j];
        ss += __shfl_xor(ss, 1); ss += __shfl_xor(ss, 2); ss += __shfl_xor(ss, 4); ss += __shfl_xor(ss, 8);
        float o[8];
        if (lane < 32) { const float rs = rsq(ss * (1.f / 128) + RMS_EPS);
#pragma unroll
            for (int j = 0; j < 4; ++j) { const int d1 = half * 64 + i0 + j, d2 = d1 + 32;
                const float x1 = f[2 * j] * rs * g_k_gqa[d1], x2 = f[2 * j + 1] * rs * g_k_gqa[d2], c = t[2 * j], sn = t[2 * j + 1];
                o[2 * j] = x1 * c - x2 * sn; o[2 * j + 1] = x1 * sn + x2 * c; }
        } else {
#pragma unroll
            for (int j = 0; j < 8; ++j) o[j] = f[j];
        }
        const u32x4 pk = pack8(o); bf16* dst = lane < 32 ? kg : vg; const int hk = (lane >> 4) & 1;
        if (!meta) *(u32x4*)(dst + ((size_t)(b * 2 + hk) * LKP + key) * 128 + p0) = pk;
        else for (int bb = b_lo; bb < b_hi; ++bb) *(u32x4*)(dst + ((size_t)(bb * 2 + hk) * LKP + key) * 128 + p0) = pk;
    }
}

__device__ __forceinline__ int crow(int r, int hi) { return (r & 3) + 8 * (r >> 2) + 4 * hi; }
__device__ __forceinline__ int v_st(int k, int c) { const int kk = (k & ~0xC) | ((k & 4) << 1) | ((k & 8) >> 1); return ((kk >> 3) * 4 + (c >> 5)) * 512 + ((kk & 7) * 32 + (c & 31)) * 2; }
__device__ __forceinline__ int v_rd_base(int lane) { return ((lane & 3) << 3) | (((lane >> 2) & 3) << 6) | (((lane >> 4) & 1) << 5) | (((lane >> 5) & 1) << 8); }
constexpr int v_rd_off(int d0, int ks, int half) { return d0 * 512 + ks * 4096 + half * 2048; }
template <int OFF> __device__ __forceinline__ s16x4 tr_read(int vb) {
    s16x4 r; asm volatile("ds_read_b64_tr_b16 %0, %1 offset:%2" : "=&v"(r) : "v"(vb), "i"(OFF) : "memory"); return r;
}
template <int D0> __device__ __forceinline__ void pv_one(f32x16& od, int vb, bf16x8 pa0, bf16x8 pa1, bf16x8 pa2, bf16x8 pa3) {
    const s16x4 l0 = tr_read<v_rd_off(D0, 0, 0)>(vb), h0 = tr_read<v_rd_off(D0, 0, 1)>(vb), l1 = tr_read<v_rd_off(D0, 1, 0)>(vb), h1 = tr_read<v_rd_off(D0, 1, 1)>(vb);
    const s16x4 l2 = tr_read<v_rd_off(D0, 2, 0)>(vb), h2 = tr_read<v_rd_off(D0, 2, 1)>(vb), l3 = tr_read<v_rd_off(D0, 3, 0)>(vb), h3 = tr_read<v_rd_off(D0, 3, 1)>(vb);
    asm volatile("s_waitcnt lgkmcnt(0)" ::: "memory"); SBAR();
#define PK(L, H) (bf16x8){L[0], L[1], L[2], L[3], H[0], H[1], H[2], H[3]}
    od = __builtin_amdgcn_mfma_f32_32x32x16_bf16(pa0, PK(l0, h0), od, 0, 0, 0);
    od = __builtin_amdgcn_mfma_f32_32x32x16_bf16(pa1, PK(l1, h1), od, 0, 0, 0);
    od = __builtin_amdgcn_mfma_f32_32x32x16_bf16(pa2, PK(l2, h2), od, 0, 0, 0);
    od = __builtin_amdgcn_mfma_f32_32x32x16_bf16(pa3, PK(l3, h3), od, 0, 0, 0);
#undef PK
}
__device__ __forceinline__ void pv_d0(f32x16* o, int vb, bf16x8 pa0, bf16x8 pa1, bf16x8 pa2, bf16x8 pa3) {
    pv_one<0>(o[0], vb, pa0, pa1, pa2, pa3); pv_one<1>(o[1], vb, pa0, pa1, pa2, pa3); pv_one<2>(o[2], vb, pa0, pa1, pa2, pa3); pv_one<3>(o[3], vb, pa0, pa1, pa2, pa3);
}
template <int DQK> struct AttnC {
    static constexpr float SCALE = DQK == 192 ? 0.07216878364870322f : 0.08838834764831845f;
    static constexpr float C = SCALE * 1.4426950408889634f, THRS = 8.f / SCALE;
};
template <int DQK>
__device__ __forceinline__ void partialSM(f32x16& p0, f32x16& p1, float& m_reg, float& mn, float& alpha) {
    constexpr float C = AttnC<DQK>::C;
    float pmax = p0[0];
#pragma unroll
    for (int r = 1; r < 16; ++r) pmax = fmaxf(pmax, p0[r]);
#pragma unroll
    for (int r = 0; r < 16; ++r) pmax = fmaxf(pmax, p1[r]);
    { auto rr = __builtin_amdgcn_permlane32_swap(__float_as_uint(pmax), __float_as_uint(pmax), false, false);
      pmax = fmaxf(__uint_as_float(rr[0]), __uint_as_float(rr[1])); }
    if (__builtin_expect(__all(pmax - m_reg <= AttnC<DQK>::THRS), 1)) { mn = m_reg; alpha = 1.f; }
    else { mn = fmaxf(m_reg, pmax); alpha = __builtin_amdgcn_exp2f((m_reg - mn) * C); m_reg = mn; }
    const float mnC = -mn * C;
#pragma unroll
    for (int r = 0; r < 16; ++r) p0[r] = fmaf(p0[r], C, mnC);
#pragma unroll
    for (int r = 0; r < 16; ++r) p1[r] = fmaf(p1[r], C, mnC);
#pragma unroll
    for (int r = 0; r < 16; ++r) p0[r] = __builtin_amdgcn_exp2f(p0[r]);
}
template <int DQK>
__device__ __forceinline__ void smaxA(const f32x16& p0, const f32x16& p1, float& m_reg, float& mn, float& alpha) {
    constexpr float C = AttnC<DQK>::C;
    float pmax = p0[0];
#pragma unroll
    for (int r = 1; r < 16; ++r) pmax = fmaxf(pmax, p0[r]);
#pragma unroll
    for (int r = 0; r < 16; ++r) pmax = fmaxf(pmax, p1[r]);
    { auto rr = __builtin_amdgcn_permlane32_swap(__float_as_uint(pmax), __float_as_uint(pmax), false, false);
      pmax = fmaxf(__uint_as_float(rr[0]), __uint_as_float(rr[1])); }
    if (__builtin_expect(__all(pmax - m_reg <= AttnC<DQK>::THRS), 1)) { mn = m_reg; alpha = 1.f; }
    else { mn = fmaxf(m_reg, pmax); alpha = __builtin_amdgcn_exp2f((m_reg - mn) * C); m_reg = mn; }
}
template <int DQK>
__device__ __forceinline__ void smaxB(f32x16& p0, f32x16& p1, float mn) {
    constexpr float C = AttnC<DQK>::C; const float mnC = -mn * C; const f32x2 C2 = {C, C}, M2 = {mnC, mnC};
#pragma unroll
    for (int r = 0; r < 16; r += 2) { const f32x2 v = (f32x2){p0[r], p0[r + 1]} * C2 + M2; p0[r] = v.x; p0[r + 1] = v.y; }
#pragma unroll
    for (int r = 0; r < 16; r += 2) { const f32x2 v = (f32x2){p1[r], p1[r + 1]} * C2 + M2; p1[r] = v.x; p1[r + 1] = v.y; }
}
template <int LO>
__device__ __forceinline__ void smaxC(f32x16& p0) {
#pragma unroll
    for (int r = LO; r < LO + 8; ++r) p0[r] = __builtin_amdgcn_exp2f(p0[r]);
}
#define PIN2(a_, b_) asm volatile("" : "+v"(a_), "+v"(b_))
template <int DQK>
__device__ __forceinline__ void pv_sm(f32x16* o, int vb, bf16x8 pa0, bf16x8 pa1, bf16x8 pa2, bf16x8 pa3, f32x16& c0, f32x16& c1, float& m_reg, float& mn, float& alpha) {
    pv_one<0>(o[0], vb, pa0, pa1, pa2, pa3); smaxA<DQK>(c0, c1, m_reg, mn, alpha); asm volatile("" : "+v"(mn), "+v"(alpha));
    pv_one<1>(o[1], vb, pa0, pa1, pa2, pa3); smaxB<DQK>(c0, c1, mn); PIN2(c0, c1);
    pv_one<2>(o[2], vb, pa0, pa1, pa2, pa3); smaxC<0>(c0); asm volatile("" : "+v"(c0));
    pv_one<3>(o[3], vb, pa0, pa1, pa2, pa3); smaxC<8>(c0); asm volatile("" : "+v"(c0));
}
__device__ __forceinline__ void finishSM(f32x16& p0, f32x16& p1, float alpha, float& l_reg, bf16x8& pa0, bf16x8& pa1, bf16x8& pa2, bf16x8& pa3) {
#pragma unroll
    for (int r = 0; r < 16; ++r) p1[r] = __builtin_amdgcn_exp2f(p1[r]);
    f32x2 ps2 = {0.f, 0.f};
#pragma unroll
    for (int r = 0; r < 16; r += 2) ps2 += (f32x2){p0[r], p0[r + 1]};
#pragma unroll
    for (int r = 0; r < 16; r += 2) ps2 += (f32x2){p1[r], p1[r + 1]};
    float ps = ps2.x + ps2.y;
    { auto rr = __builtin_amdgcn_permlane32_swap(__float_as_uint(ps), __float_as_uint(ps), false, false);
      ps = __uint_as_float(rr[0]) + __uint_as_float(rr[1]); }
    l_reg = l_reg * alpha + ps;
#define PK4(P, BASE, OUT) do { unsigned a0 = cvtpk(P[BASE + 0], P[BASE + 1]), a1 = cvtpk(P[BASE + 2], P[BASE + 3]);   \
    unsigned b0 = cvtpk(P[BASE + 4], P[BASE + 5]), b1 = cvtpk(P[BASE + 6], P[BASE + 7]);                              \
    auto r0 = __builtin_amdgcn_permlane32_swap(a0, b0, false, false); auto r1 = __builtin_amdgcn_permlane32_swap(a1, b1, false, false); \
    u32x4 w = {r0[0], r1[0], r0[1], r1[1]}; OUT = *reinterpret_cast<bf16x8*>(&w); } while (0)
    PK4(p0, 0, pa0); PK4(p0, 8, pa1); PK4(p1, 0, pa2); PK4(p1, 8, pa3);
#undef PK4
}
template <int DQK>
__device__ __forceinline__ void qkt(f32x16& p0, f32x16& p1, const LAS char* Ks, const bf16x8 (&qr)[DQK / 16], const int (&ko)[4]) {
    constexpr int KRB = DQK * 2, ND = DQK / 16, PF = 3;
    p0 = f32x16{}; p1 = f32x16{};
    bf16x8 kb[ND][2];
#define QKT_RD(d_) do { const LAS char* kp_ = Ks + ko[(d_) & 3] + ((d_) >> 2) * 128; kb[d_][0] = *(const LAS bf16x8*)(kp_); kb[d_][1] = *(const LAS bf16x8*)(kp_ + 32 * KRB); } while (0)
#pragma unroll
    for (int d0 = 0; d0 < PF; ++d0) QKT_RD(d0);
#pragma unroll
    for (int d0 = 0; d0 < ND; ++d0) {
        if (d0 + PF < ND) QKT_RD(d0 + PF);
        p0 = __builtin_amdgcn_mfma_f32_32x32x16_bf16(kb[d0][0], qr[d0], p0, 0, 0, 0);
        p1 = __builtin_amdgcn_mfma_f32_32x32x16_bf16(kb[d0][1], qr[d0], p1, 0, 0, 0);
        __builtin_amdgcn_sched_group_barrier(0x8, 2, 0); __builtin_amdgcn_sched_group_barrier(0x100, 2, 0); __builtin_amdgcn_sched_group_barrier(0x2, 6, 0); }
#undef QKT_RD
}
constexpr int CV_ITEMS = 16 * 4096, CV_LDS = 3 * 16384 + 3 * 16384 + 2048, CV_TILE = 16 * 33 * 4;
static_assert(CV_LDS + NWAVES * CV_TILE <= RING_BYTES, "conversion tiles fit under the control words");
struct ConvState { const float* W; unsigned char* WT; int e0; int it, step; int prev; f32x4 va, vb; };
__device__ __forceinline__ void conv_load(ConvState& c) {
    if (c.it < CV_ITEMS) { int t_ = threadIdx.x; asm volatile("" : "+v"(t_)); const int l_ = t_ & 63, kk = l_ >> 3, nn = (l_ & 7) * 4;
        const int e = c.e0 + (c.it >> 12), r = c.it & 4095, kb = r >> 6, nb = r & 63;
        const float* wp = c.W + ((size_t)e * 1024 + 16 * kb + kk) * 2048 + 32 * nb + nn;
        c.va = *(const f32x4*)wp; c.vb = *(const f32x4*)(wp + (size_t)8 * 2048); c.prev = c.it; c.it += c.step; }
    else c.prev = -1;
}
__device__ __forceinline__ void conv_store(ConvState& c, LAS char* lds) {
    if (c.prev >= 0) { int t_ = threadIdx.x; asm volatile("" : "+v"(t_)); const int l_ = t_ & 63, w_ = __builtin_amdgcn_readfirstlane(t_ >> 6), kk = l_ >> 3, nn = (l_ & 7) * 4;
        const int e = c.e0 + (c.prev >> 12), r = c.prev & 4095, kb = r >> 6, nb = r & 63;
        LAS float* scr = (LAS float*)(lds + CV_LDS + w_ * CV_TILE);
        const f32x4 a = c.va * W8_SCALE, b = c.vb * W8_SCALE;
        LAS float* d0 = scr + kk * 33 + nn; d0[0] = a[0]; d0[1] = a[1]; d0[2] = a[2]; d0[3] = a[3];
        LAS float* d1 = scr + (kk + 8) * 33 + nn; d1[0] = b[0]; d1[1] = b[1]; d1[2] = b[2]; d1[3] = b[3];
        asm volatile("s_waitcnt lgkmcnt(0)" ::: "memory");
        const int n = l_ >> 1, kh = l_ & 1; const LAS float* s_ = scr + (8 * kh) * 33 + n;
        const u32x2 o = {pack4_f8(s_[0 * 33], s_[1 * 33], s_[2 * 33], s_[3 * 33]), pack4_f8(s_[4 * 33], s_[5 * 33], s_[6 * 33], s_[7 * 33])};
        *(u32x2*)(c.WT + ((size_t)e * 2048 + MapGU()(32 * nb + n)) * 1024 + 16 * kb + 8 * kh) = o;
        asm volatile("s_waitcnt lgkmcnt(0)" ::: "memory"); }
}
template <int DQK, bool BGRP>
__device__ __forceinline__ void attn_body(const bf16* __restrict__ Qb, const bf16* __restrict__ Kh, const bf16* __restrict__ Vh, bf16* __restrict__ Ob, LAS char* lds, const float* __restrict__ rope, int pos0, float* __restrict__ ssq, ConvState& cv) {
    constexpr int ND0 = DQK / 16, KRB = DQK * 2, SHM_K = 64 * KRB, SHM_V = 64 * 128 * 2, NKC = DQK / 64, NT = LKP / 64, AUX = 3 * SHM_V + 3 * SHM_K;
    static_assert(NT % 2 == 1 && NT >= 5, "odd tile count: step 0 peeled, steps 1..NT-3 in pairs, steps NT-2 and NT-1 and the drain peeled");
    static_assert(AUX + 2048 <= RING_BYTES, "rings + the per-wave alpha / l scratch fit under the control words");
    int tid = threadIdx.x; asm volatile("" : "+v"(tid));
    const int wid = __builtin_amdgcn_readfirstlane(tid >> 6), lane = tid & 63, r32 = lane & 31, hi = lane >> 5;
    LAS char* V_lds = lds; LAS char* K_lds = lds + 3 * SHM_V;
    asm volatile("s_waitcnt lgkmcnt(0)" ::: "memory"); __builtin_amdgcn_s_barrier(); asm volatile("" ::: "memory");
    float m_reg = -1e30f, l_reg = 0; f32x16 o[4] = {}; bf16x8 qr[ND0];
    const bf16* Qw = Qb + (size_t)(wid * 32 + r32) * DQK + hi * 8;
#pragma unroll
    for (int d0 = 0; d0 < 8; ++d0) qr[d0] = *reinterpret_cast<const bf16x8*>(Qw + d0 * 16);
#pragma unroll
    for (int d0 = 8; d0 < ND0; ++d0) {
        float x[8], y[8]; unpack8(*reinterpret_cast<const u32x4*>(Qw + d0 * 16), x);
        const float* t = rope + ((size_t)(pos0 + wid * 32 + r32 + 1) * 32 + (d0 - 8) * 8 + hi * 4) * 2; const f32x4 t0 = *(const f32x4*)t, t1 = *(const f32x4*)(t + 4);
        const float cs[4] = {t0[0], t0[2], t1[0], t1[2]}, sn[4] = {t0[1], t0[3], t1[1], t1[3]};
#pragma unroll
        for (int j = 0; j < 4; ++j) { y[2 * j] = x[2 * j] * cs[j] - x[2 * j + 1] * sn[j]; y[2 * j + 1] = x[2 * j] * sn[j] + x[2 * j + 1] * cs[j]; }
        qr[d0] = __builtin_bit_cast(bf16x8, pack8(y)); }
    unsigned kso[NKC], vso[2];
#pragma unroll
    for (int c = 0; c < NKC; ++c) { const int p = (8 * c + wid) * 1024 + lane * 16, r = p / KRB, cb = p - r * KRB; kso[c] = (unsigned)(r * KRB + (cb ^ ((r & 7) << 4))); }
#pragma unroll
    for (int c = 0; c < 2; ++c) { const int p = (8 * c + wid) * 1024 + lane * 16, sb = p >> 9, wi = p & 511, kk = (sb >> 2) * 8 + (wi >> 6), k = (kk & ~0xC) | ((kk & 4) << 1) | ((kk & 8) >> 1), col = (sb & 3) * 32 + ((wi & 63) >> 1);
        vso[c] = (unsigned)(k * 256 + col * 2); }
    int ko[4];
#pragma unroll
    for (int q = 0; q < 4; ++q) ko[q] = r32 * KRB + ((q * 32 + hi * 16) ^ ((r32 & 7) << 4));
    const int vb0 = (int)(unsigned)(uintptr_t)V_lds + v_rd_base(lane);
    const char* const Kg = (const char*)Kh; const char* const Vg = (const char*)Vh;
#define DMA_K(t_, s_) do { int tt_ = (t_); asm volatile("" : "+s"(tt_)); const char* kt_ = Kg + (size_t)tt_ * SHM_K; _Pragma("unroll") for (int c_ = 0; c_ < NKC; ++c_) \
        __builtin_amdgcn_global_load_lds((const unsigned*)(kt_ + kso[c_]), (LAS unsigned*)(K_lds + (s_) * SHM_K + wid * 1024 + c_ * 8192), 16, 0, 0); } while (0)
#define DMA_V(t_, s_) do { int tt_ = (t_); asm volatile("" : "+s"(tt_)); const char* vt_ = Vg + (size_t)tt_ * SHM_V; _Pragma("unroll") for (int c_ = 0; c_ < 2; ++c_) \
        __builtin_amdgcn_global_load_lds((const unsigned*)(vt_ + vso[c_]), (LAS unsigned*)(V_lds + (s_) * SHM_V + wid * 1024 + c_ * 8192), 16, 0, 0); } while (0)
#define AWAIT(n_) do { if constexpr ((n_) == 3) asm volatile("s_waitcnt vmcnt(3)" ::: "memory"); \
        else if constexpr ((n_) == 2) asm volatile("s_waitcnt vmcnt(2)" ::: "memory"); else asm volatile("s_waitcnt vmcnt(0)" ::: "memory"); __builtin_amdgcn_s_barrier(); asm volatile("" ::: "memory"); } while (0)
#define CONV() do { if constexpr (DQK == 128) { conv_store(cv, lds); conv_load(cv); } } while (0)
#define CONV_FLUSH() do { if constexpr (DQK == 128) { conv_store(cv, lds); cv.prev = -1; } } while (0)
#define RESC(a) do { if (__any((a) < 1.f)) { int t_ = threadIdx.x; asm volatile("" : "+v"(t_)); const int r32_ = t_ & 31, hi_2 = (t_ >> 5) & 1; \
    LAS float* al_ = (LAS float*)(lds + AUX) + (t_ >> 6) * 64 + 32; if (hi_2 == 0) al_[r32_] = (a); asm volatile("s_waitcnt lgkmcnt(0)" ::: "memory"); \
    _Pragma("unroll") for (int d = 0; d < 4; ++d) _Pragma("unroll") for (int r = 0; r < 16; ++r) o[d][r] *= al_[crow(r, hi_2)]; } } while (0)
#define STEP_DMA(DOK_, DOV_, j_) do { if constexpr (DOV_) DMA_V((j_), s0); if constexpr (DOK_) DMA_K((j_) + 2, (s0 == 0 ? 2 : s0 - 1)); } while (0)
#define STEP_A(NW_, DOK_, DOV_, j_, C0, C1, mnC, alC, P0, P1, alP) do { \
        const int sm1_ = s0 == 0 ? 2 : s0 - 1, sp1_ = s0 == 2 ? 0 : s0 + 1; \
        AWAIT(NW_); CONV(); STEP_DMA(DOK_, DOV_, j_); \
        SBAR(); qkt<DQK>(C0, C1, K_lds + s0 * SHM_K, qr, ko); \
        finishSM(P0, P1, alP, l_reg, pa0, pa1, pa2, pa3); SBAR(); \
        pv_sm<DQK>(o, vb0 + sm1_ * SHM_V, pa0, pa1, pa2, pa3, C0, C1, m_reg, mnC, alC); \
        RESC(alC); s0 = sp1_; } while (0)
#define STEP_B(NW_, DOK_, DOV_, j_, C0, C1, P0, P1, mnP, alP) do { \
        const int sp1_ = s0 == 2 ? 0 : s0 + 1; \
        AWAIT(NW_); CONV(); STEP_DMA(DOK_, DOV_, j_); \
        SBAR(); pv_sm<DQK>(o, vb0 + sp1_ * SHM_V, pa0, pa1, pa2, pa3, P0, P1, m_reg, mnP, alP); \
        RESC(alP); \
        SBAR(); qkt<DQK>(C0, C1, K_lds + s0 * SHM_K, qr, ko); \
        finishSM(P0, P1, alP, l_reg, pa0, pa1, pa2, pa3); s0 = sp1_; } while (0)
#define MASK_LAST(C0, C1) do { _Pragma("unroll") for (int r = 8; r < 16; ++r) C0[r] = -1e30f; _Pragma("unroll") for (int r = 0; r < 16; ++r) C1[r] = -1e30f; } while (0)
    f32x16 pA0, pA1, pB0, pB1; float mnA, mnB, alA, alB; bf16x8 pa0, pa1, pa2, pa3;
    DMA_K(0, 0); DMA_K(1, 1);
    int s0 = 0;
    AWAIT(NKC); CONV(); STEP_DMA(true, true, 0);
    if constexpr (!BGRP) {
        qkt<DQK>(pA0, pA1, K_lds, qr, ko); partialSM<DQK>(pA0, pA1, m_reg, mnA, alA);
        s0 = 1;
#pragma unroll 1
        for (int j = 1; j + 2 < NT; j += 2) {
            STEP_A(NKC, true, true, j, pB0, pB1, mnB, alB, pA0, pA1, alA);
            STEP_A(NKC, true, true, j + 1, pA0, pA1, mnA, alA, pB0, pB1, alB);
        }
        STEP_A(NKC, false, true, NT - 2, pB0, pB1, mnB, alB, pA0, pA1, alA);
        { const int sm1_ = s0 == 0 ? 2 : s0 - 1;
          AWAIT(0); CONV(); STEP_DMA(false, true, NT - 1);
          SBAR(); qkt<DQK>(pA0, pA1, K_lds + s0 * SHM_K, qr, ko); MASK_LAST(pA0, pA1);
          finishSM(pB0, pB1, alB, l_reg, pa0, pa1, pa2, pa3); SBAR();
          pv_sm<DQK>(o, vb0 + sm1_ * SHM_V, pa0, pa1, pa2, pa3, pA0, pA1, m_reg, mnA, alA);
          RESC(alA);
          AWAIT(0); CONV_FLUSH();
          finishSM(pA0, pA1, alA, l_reg, pa0, pa1, pa2, pa3); SBAR();
          pv_d0(o, vb0 + s0 * SHM_V, pa0, pa1, pa2, pa3); }
    } else {
        qkt<DQK>(pA0, pA1, K_lds, qr, ko);
        s0 = 1;
        { AWAIT(NKC); CONV(); STEP_DMA(true, true, 1);
          partialSM<DQK>(pA0, pA1, m_reg, mnA, alA);
          SBAR(); qkt<DQK>(pB0, pB1, K_lds + s0 * SHM_K, qr, ko);
          finishSM(pA0, pA1, alA, l_reg, pa0, pa1, pa2, pa3); s0 = 2; }
#pragma unroll 1
        for (int j = 2; j + 4 < NT; j += 2) {
            STEP_B(NKC, true, true, j, pA0, pA1, pB0, pB1, mnB, alB);
            STEP_B(NKC, true, true, j + 1, pB0, pB1, pA0, pA1, mnA, alA);
        }
        STEP_B(NKC, true, true, NT - 3, pA0, pA1, pB0, pB1, mnB, alB);
        STEP_B(NKC, false, true, NT - 2, pB0, pB1, pA0, pA1, mnA, alA);
        { const int sp1_ = s0 == 2 ? 0 : s0 + 1;
          AWAIT(0); CONV(); STEP_DMA(false, true, NT - 1);
          SBAR(); pv_sm<DQK>(o, vb0 + sp1_ * SHM_V, pa0, pa1, pa2, pa3, pB0, pB1, m_reg, mnB, alB);
          RESC(alB);
          SBAR(); qkt<DQK>(pA0, pA1, K_lds + s0 * SHM_K, qr, ko); MASK_LAST(pA0, pA1);
          finishSM(pB0, pB1, alB, l_reg, pa0, pa1, pa2, pa3);
          AWAIT(0); CONV_FLUSH();
          const int sm1_ = s0 == 0 ? 2 : s0 - 1;
          SBAR(); pv_sm<DQK>(o, vb0 + sm1_ * SHM_V, pa0, pa1, pa2, pa3, pA0, pA1, m_reg, mnA, alA);
          RESC(alA);
          finishSM(pA0, pA1, alA, l_reg, pa0, pa1, pa2, pa3); SBAR();
          pv_d0(o, vb0 + s0 * SHM_V, pa0, pa1, pa2, pa3); }
    }
#undef STEP_DMA
#undef STEP_A
#undef STEP_B
#undef MASK_LAST
    { int t_ = threadIdx.x; asm volatile("" : "+v"(t_)); const int r32_ = t_ & 31, hi_2 = (t_ >> 5) & 1, wid_ = t_ >> 6;
      LAS float* li_ = (LAS float*)(lds + AUX) + wid_ * 64;
      if (hi_2 == 0) li_[r32_] = l_reg; asm volatile("s_waitcnt lgkmcnt(0)" ::: "memory");
      float rli[16];
#pragma unroll
      for (int r = 0; r < 16; ++r) rli[r] = __builtin_amdgcn_rcpf(li_[crow(r, hi_2)]);
      { float ss[16];
#pragma unroll
        for (int r = 0; r < 16; ++r) { float a = 0.f;
#pragma unroll
            for (int d0 = 0; d0 < 4; ++d0) { const float x = o[d0][r] * rli[r]; a += x * x; }
            a += __shfl_xor(a, 1); a += __shfl_xor(a, 2); a += __shfl_xor(a, 4); a += __shfl_xor(a, 8); a += __shfl_xor(a, 16); ss[r] = a; }
        float mine = ss[0];
#pragma unroll
        for (int r = 1; r < 16; ++r) mine = (r32_ == r) ? ss[r] : mine;
        if (r32_ < 16) ssq[(size_t)(wid_ * 32 + crow(r32_, hi_2)) * 8] = mine; }
      bf16* Ow = Ob + (size_t)(wid_ * 32) * DM;
#pragma unroll
      for (int r = 0; r < 16; ++r) { const int orow = crow(r, hi_2);
#pragma unroll
          for (int d0 = 0; d0 < 4; ++d0) Ow[(size_t)orow * DM + d0 * 32 + r32_] = (bf16)(cvtpk(o[d0][r] * rli[r], 0.f) & 0xffffu); } }
#undef CONV
#undef CONV_FLUSH
#undef DMA_K
#undef DMA_V
#undef AWAIT
#undef RESC
}

constexpr int NPHASE = 14;
struct Args { const float* in[24]; float* out; unsigned char* ws; int ph_lo, ph_hi, bar_region, pad; };
constexpr int W_DN_LATE = 26;
constexpr int W_DN_P3 = 22;
constexpr int W_DN_A = 0;
constexpr int W_SPLIT = 17;
constexpr int CW_WDONE = 192;
__global__ void __launch_bounds__(NWAVES * 64, 2) hymba_fwd(Args args) {
    extern __shared__ __attribute__((aligned(16))) unsigned char lds[];
    { int t0 = threadIdx.x; asm volatile("" : "+v"(t0)); for (int u = t0; u < 1024; u += NWAVES * 64) ((LAS unsigned*)((LAS unsigned char*)lds + LDSCTL_OFF))[u] = 0u; }
    __syncthreads();
#define XB_OBJ(b_, region_, group_, stw_) XcdBarrier b_; { const CAS unsigned char* kq_ = (const CAS unsigned char*)__builtin_amdgcn_kernarg_segment_ptr(); asm volatile("" : "+s"(kq_)); \
    b_.bar = (unsigned*)(*(unsigned char* const CAS*)(kq_ + 200) + WS_CTL) + CW_BAR + ((region_) + 3 * *(const int CAS*)(kq_ + 216)) * XCD_BAR_WORDS; b_.x = xb_xcc_id(); b_.st = (volatile LAS unsigned*)((LAS unsigned char*)lds + LDSCTL_OFF) + (stw_); b_.g = (unsigned)(group_); }
    { const int G0 = gridDim.x, I0 = (int)blockIdx.x >= (G0 >> 1) ? 1 : 0;
      { XB_OBJ(b0_, 0, G0, 8); (void)xcd_barrier_post(b0_.bar, b0_.st); }
      { XB_OBJ(b1_, 1 + I0, G0 >> 1, 12); (void)xcd_barrier_post(b1_.bar, b1_.st); } }
#ifndef PHM
#define PHM 0xffff
#endif
    const int lo = args.ph_lo, hi_ = args.ph_hi;
#define PH(k) (((PHM >> (k)) & 1) && lo <= (k) && (k) < hi_)
#define FULL_BAR() do { XB_OBJ(bb_, 0, gridDim.x, 8); xcd_barrier(bb_); } while (0)
#define INST_BAR() do { const int I_ = (int)blockIdx.x >= ((int)gridDim.x >> 1) ? 1 : 0; XB_OBJ(bb_, 1 + I_, gridDim.x >> 1, 12); xcd_barrier(bb_); } while (0)

#define PTRS \
    int bx = blockIdx.x; asm volatile("" : "+s"(bx)); const int G = gridDim.x, vcu = (G % 8 == 0) ? (bx % 8) * (G / 8) + bx / 8 : bx; \
    const int tid = threadIdx.x, lane = tid & 63, wave = __builtin_amdgcn_readfirstlane(tid >> 6); \
    const int gw = vcu * NWAVES + wave, ngw = G * NWAVES, gtid = vcu * (NWAVES * 64) + tid, ngt = G * NWAVES * 64; (void)gw; (void)ngw; (void)gtid; (void)ngt; (void)lane; \
    const int Gi = G >> 1, I = bx >= Gi ? 1 : 0, bxi = bx - I * Gi, vci = (Gi % 8 == 0) ? (bxi % 8) * (Gi / 8) + bxi / 8 : bxi;         \
    const int gwi = vci * NWAVES + wave, ngwi = Gi * NWAVES, gti = vci * (NWAVES * 64) + tid, ngti = Gi * NWAVES * 64, row0 = I * NTOK_I, pm0 = I * MT_I; (void)gwi; (void)ngwi; (void)gti; (void)ngti; (void)row0; (void)pm0; \
    const CAS unsigned char* kp_ = (const CAS unsigned char*)__builtin_amdgcn_kernarg_segment_ptr(); asm volatile("" : "+s"(kp_)); \
    const float* const CAS* kin = (const float* const CAS*)kp_; unsigned char* ws = *(unsigned char* const CAS*)(kp_ + 200); float* outp = *(float* const CAS*)(kp_ + 192); (void)outp; (void)kin; \
    const float* x = kin[0]; const float* meta_tok = kin[1]; \
    float* rope = (float*)(ws + WS_ROPE); \
    bf16* w_in_t = (bf16*)(ws + WS_WIN); bf16* w_qb_t = (bf16*)(ws + WS_WQB); bf16* w_kvb_t = (bf16*)(ws + WS_WKVB); bf16* w_o_t = (bf16*)(ws + WS_WO); \
    bf16* w_r_t = (bf16*)(ws + WS_WR); unsigned char* w_gu8 = ws + WS_WGU; unsigned char* w_dn8 = ws + WS_WDN; unsigned char* h1f8 = ws + WS_H1F8; \
    bf16* h0 = (bf16*)(ws + WS_H0); bf16* h1 = (bf16*)(ws + WS_H1); float* rs_q = (float*)(ws + WS_QAN); float* rs_kv = rs_q + MPAD; float* ssq = (float*)(ws + WS_KVAN); bf16* z = (bf16*)(ws + WS_Z); \
    bf16* qm = (bf16*)(ws + WS_QM); bf16* km = (bf16*)(ws + WS_KM); bf16* vm = (bf16*)(ws + WS_VM); bf16* qg = (bf16*)(ws + WS_QG); bf16* kg = (bf16*)(ws + WS_KG); bf16* vg = (bf16*)(ws + WS_VG); \
    bf16* ob = (bf16*)(ws + WS_O); bf16* y1 = (bf16*)(ws + WS_H1);     \
    int* topk = (int*)(ws + WS_TOPK); float* gate = (float*)(ws + WS_GATE); int* pair_pos = (int*)(ws + WS_PAIRPOS); float* row_gate = (float*)(ws + WS_ROWGATE); \
    int* hist = (int*)(ws + WS_HIST); int* moetab = (int*)(ws + WS_MOETAB) + I * 1024; int* tile_expert = moetab + 256;     \
    int* row_tok = (int*)(ws + WS_XS); unsigned char* act8 = ws + WS_ACT; unsigned char* out2 = ws + WS_OUT2; unsigned* ctl = (unsigned*)(ws + WS_CTL); (void)ctl;
#define W_PUBLISH() do { asm volatile("s_waitcnt vmcnt(0)" ::: "memory"); __syncthreads(); if (tid == 0) { __builtin_amdgcn_fence(__ATOMIC_RELEASE, "agent"); asm volatile("s_waitcnt vmcnt(0)" ::: "memory"); \
        (void)__hip_atomic_fetch_add(ctl + CW_WDONE + 64 * I, 1u, __ATOMIC_RELAXED, __HIP_MEMORY_SCOPE_AGENT); } } while (0)

    if (PH(0)) { PTRS;
        LAS float* scr = (LAS float*)((LAS unsigned char*)lds + wave * 16384);
        constexpr int I_IN = 16 * 46, I_QB = 4 * 24, I_KVB = 2 * 32, I_O = 16 * 32, I_R = 16;
        constexpr int NITEMS = I_IN + I_QB + I_KVB + I_O + I_R;
        for (int it = gw; it < NITEMS; it += ngw) {
            int r = it;
            if (r < I_IN) { transpose_item(kin[4], 1024, NIN, w_in_t, scr, r, lane, MapIn()); continue; } r -= I_IN;
            if (r < I_QB) { transpose_item(kin[6], 256, 768, w_qb_t, scr, r, lane, MapQ(), kin[5]); continue; } r -= I_QB;
            if (r < I_KVB) { transpose_item(kin[8], 128, 1024, w_kvb_t, scr, r, lane, MapId(), kin[7]); continue; } r -= I_KVB;
            if (r < I_O) { transpose_item(kin[13], 1024, 1024, w_o_t, scr, r, lane, MapId(), kin[11], 0, kin[12]); continue; } r -= I_O;
            transpose_item(kin[16], 1024, 32, w_r_t, scr, r, lane, MapId(), kin[14]);
        }
        if (gw >= NITEMS && gw < NITEMS + 32) {
            const int e_ = gw - NITEMS; float pu = 0.f, pv = 0.f;
#pragma unroll
            for (int j = 0; j < 16; ++j) { const int c = lane + 64 * j; const float w = kin[16][(size_t)c * 32 + e_]; pu += __uint_as_float(cvtpk(w * kin[14][c], 0.f) << 16); pv += kin[15][c] * w; }
            pu = wave_sum(pu); pv = wave_sum(pv);
            if (lane == 0) { float* rc = (float*)(ws + WS_WR + 65536); rc[e_] = pu; rc[32 + e_] = pv + kin[17][e_]; }
        }
        { f32x4 gg[4], bb[4], cv[4], nv[4];
#pragma unroll
          for (int j = 0; j < 4; ++j) { gg[j] = ((const f32x4*)kin[2])[lane + 64 * j]; bb[j] = ((const f32x4*)kin[3])[lane + 64 * j]; }
#define LN_LOAD(dst, m_) do { const float* xr_ = (m_) < NTOK ? x + (size_t)(m_) * DM : meta_tok + (size_t)((m_) - NTOK) * DM; _Pragma("unroll") for (int j = 0; j < 4; ++j) dst[j] = ((const f32x4*)xr_)[lane + 64 * j]; } while (0)
          LN_LOAD(cv, NTOK_I + gw);
          for (int m = NTOK_I + gw; m < MROWS; m += ngw) { const int mn = m + ngw < MROWS ? m + ngw : m; LN_LOAD(nv, mn);
              ln_row_f32_to_bf16(cv, gg, bb, h0 + (size_t)m * DM, lane);
#pragma unroll
              for (int j = 0; j < 4; ++j) cv[j] = nv[j]; }
        }
        zero_bytes(h0 + (size_t)MROWS * DM, (size_t)(MPAD - MROWS) * DM * 2, gtid, ngt);
        zero_bytes(w_in_t + (size_t)448 * 1024, (size_t)64 * 1024 * 2, gtid, ngt);
        for (int i = gw; i < 64 + 64 + 32 + 32; i += ngw) {
            bf16* p; size_t rb;
            if (i < 64) { p = km + ((size_t)i * LKP + 2064) * 192; rb = 48 * 192 * 2; }
            else if (i < 128) { p = vm + ((size_t)(i - 64) * LKP + 2064) * 128; rb = 48 * 128 * 2; }
            else if (i < 160) { p = kg + ((size_t)(i - 128) * LKP + 2064) * 128; rb = 48 * 128 * 2; }
            else { p = vg + ((size_t)(i - 160) * LKP + 2064) * 128; rb = 48 * 128 * 2; }
            zero_bytes(p, rb, lane, 64);
        }
        for (int i = gtid; i < 2065 * 32; i += ngt) {
            const int p = i / 32 - 1, f = i & 31; double inv = 1.0;
            for (int q = 0; q < f; ++q) inv *= 0.74989420933245582730;
            const float ang = (float)p * (float)inv; float sn, cs; sincos_d(fabsf(ang), sn, cs); if (ang < 0.f) sn = -sn;
            rope[2 * i] = cs; rope[2 * i + 1] = sn;
        }
    }
    if (lo <= 0) FULL_BAR();
    if (PH(0)) { PTRS; if (I == 0) { transpose_f8_stream(kin[20], 1024, w_dn8, (LAS float*)((LAS unsigned char*)lds + wave * 16384), gwi, ngwi, lane, MapId(), W8_SCALE, 0, W_DN_A);
            f32x4 gg[4], bb[4], cv[4], nv[4];
#pragma unroll
            for (int j = 0; j < 4; ++j) { gg[j] = ((const f32x4*)kin[2])[lane + 64 * j]; bb[j] = ((const f32x4*)kin[3])[lane + 64 * j]; }
            LN_LOAD(cv, gwi);
            for (int m = gwi; m < NTOK_I; m += ngwi) { const int mn = m + ngwi < NTOK_I ? m + ngwi : m; LN_LOAD(nv, mn);
                ln_row_f32_to_bf16(cv, gg, bb, h0 + (size_t)m * DM, lane);
#pragma unroll
                for (int j = 0; j < 4; ++j) cv[j] = nv[j]; } } }
#undef LN_LOAD
    { const int I0_ = (int)blockIdx.x >= ((int)gridDim.x >> 1) ? 1 : 0; if (lo <= 0 && I0_ == 0) INST_BAR(); }
    if (PH(1)) { PTRS;
        { EpiZF E{z, rs_q, rs_kv, km, qg, kg, vg, rope, kin[9], kin[10], (LAS float*)((LAS unsigned char*)lds + LDSCTL_OFF + 2048)};
          pg8::Gemm g{h0, w_in_t, NTOK, ZLD, 1024, 1024, nullptr}; pg8::StaticOrder S; S.init(NTOK_I, ZLD, Gi, bxi); S.pm0 = pm0;
          pg8::gemm_phase<EpiZF, pg8::StaticOrder, true, true>((LAS unsigned char*)lds, g, S, E); }
        { EpiZ E{z}; meta_gemm16_ksplit<1024>(h0, 1024, w_in_t, NTOK, ZLD, E, vci, Gi, wave, lane, (LAS float*)lds); }
    }
    if (lo <= 1) INST_BAR();
    if (PH(3)) { PTRS;
        const int mb = Gi > 70 ? 64 : 0;
        if (bxi >= mb && bxi < mb + 2) { for (int m = NTOK + (bxi - mb) * NWAVES + wave; m < MROWS; m += 2 * NWAVES) { const bf16* zr_ = z + (size_t)m * ZLD; u32x4 wa = {0u, 0u, 0u, 0u}; if (lane < 56) wa = *(const u32x4*)(zr_ + 8 * lane);
            p2a_row(m, wa, *(const u32x4*)(zr_ + 512 + 8 * lane), *(const u32x4*)(zr_ + 1024 + 8 * lane), rope, kin[5], kin[7], kin[9], kin[10], rs_q, rs_kv, km, qg, kg, vg, lane, I * 8, I * 8 + 8); } }
        if (bxi >= mb + 2 && bxi < mb + 6) { EpiKV<true> EM{km, vm, rs_kv, I * 8, I * 8 + 8}; meta_gemm16<128, 128>(z + 256, ZLD, w_kvb_t, NTOK, 1024, EM, (bxi - mb - 2) * NWAVES + wave, 4 * NWAVES, lane); }
        { EpiQ E{qm, rs_q}; pg8::Gemm g{z, w_qb_t, NTOK, 768, 256, ZLD, nullptr}; pg8::StaticOrder S; S.init(NTOK_I, 768, Gi, bxi); S.pm0 = pm0; pg8::EpiAdapt<EpiQ> EA{E, 0};
          pg8::gemm_phase<pg8::EpiAdapt<EpiQ>, pg8::StaticOrder, true, true>((LAS unsigned char*)lds, g, S, EA); }
        if (bxi >= mb + 6 && Gi - (mb + 6) >= 32) { transpose_f8_stream(kin[20], 1024, w_dn8, (LAS float*)((LAS unsigned char*)lds + wave * 16384), (bxi - mb - 6) * NWAVES + wave, (Gi - mb - 6) * NWAVES, lane, MapId(), W8_SCALE, W_DN_P3 + 2 * I, W_DN_P3 + 2 * I + 2);
            __syncthreads(); }
        { EpiKV<false> E{km, vm, rs_kv, 0, 0}; pg8::Gemm g{z + 256, w_kvb_t, NTOK, 1024, 128, ZLD, nullptr};   pg8::StaticOrder S; S.init(NTOK_I, 1024, Gi, bxi); S.pm0 = pm0; pg8::EpiAdapt<EpiKV<false>> EA{E, 0};
          pg8::gemm_phase<pg8::EpiAdapt<EpiKV<false>>, pg8::StaticOrder, true, true>((LAS unsigned char*)lds, g, S, EA);
        }
    }
    if (lo <= 3) INST_BAR();
    if (PH(4)) { PTRS;
#define ATTN_CALL(D_, ...) do { if (wave >= 4) attn_body<D_, true>(__VA_ARGS__); else attn_body<D_, false>(__VA_ARGS__); } while (0)
        for (int u = vci; u < 256; u += Gi) { ConvState cv; cv.prev = -1; cv.it = CV_ITEMS; cv.step = 0;
            { const int b = I * 8 + (u >> 5), h = (u >> 3) & 3, qb = u & 7, bh = b * 4 + h;
                ATTN_CALL(192, qm + ((size_t)bh * 2048 + qb * 256) * 192, km + (size_t)bh * LKP * 192, vm + (size_t)bh * LKP * 128, ob + ((size_t)b * 2048 + qb * 256) * DM + h * 128, (LAS char*)lds, rope, 16 + qb * 256, ssq + ((size_t)b * 2048 + qb * 256) * 8 + h, cv);
            } }
        ConvState cv; cv.W = kin[18]; cv.WT = w_gu8; cv.e0 = 16 * I; cv.it = gwi; cv.step = ngwi; cv.prev = -1; cv.va = (f32x4){0.f, 0.f, 0.f, 0.f}; cv.vb = cv.va;
        for (int v = vci; v < 256; v += Gi) {
            { const int b = I * 8 + (v >> 5), h = (v >> 3) & 3, qb = v & 7, bh = b * 4 + h, bk = b * 2 + (h >> 1);
                ATTN_CALL(128, qg + ((size_t)bh * 2048 + qb * 256) * 128, kg + (size_t)bk * LKP * 128, vg + (size_t)bk * LKP * 128, ob + ((size_t)b * 2048 + qb * 256) * DM + 512 + h * 128, (LAS char*)lds, rope, 0, ssq + ((size_t)b * 2048 + qb * 256) * 8 + 4 + h, cv);
            } }
        __syncthreads();
        for (;;) { conv_store(cv, (LAS char*)lds); if (cv.it >= CV_ITEMS) break; conv_load(cv); }
    }
    if (lo <= 4) INST_BAR();
    if (PH(6)) { PTRS;
        pg8::Gemm g{ob, w_o_t, NTOK, 1024, 1024, 1024, nullptr}; pg8::StaticOrder S; S.init(NTOK_I, 1024, Gi, bxi); S.pm0 = pm0;
        LAS f32x2* T = (LAS f32x2*)((LAS unsigned char*)lds + LDSCTL_OFF + 2048);
        for (int i = tid >> 8; i < 6; i += 2) { pg8::Unit u; if (!S.next(i, u)) break; const int rl = tid & 255; const float* q = ssq + (size_t)(u.pm * 256 + rl) * 8;
            const f32x4 a = *(const f32x4*)q, b = *(const f32x4*)(q + 4);
            const float rm = rsq(((a[0] + a[1]) + (a[2] + a[3])) * (1.f / 512) + RMS_EPS), rg = rsq(((b[0] + b[1]) + (b[2] + b[3])) * (1.f / 512) + RMS_EPS);
            T[i * 256 + rl] = (f32x2){rm / rg, rg}; }
        __syncthreads();
        EpiOF E{y1, h0, T}; HookO H{T};
        pg8::gemm_phase<EpiOF, pg8::StaticOrder, true, true, false, false, HookO>((LAS unsigned char*)lds, g, S, E, H);
    }
    if (lo <= 6) INST_BAR();
#define ROUTE_VARS const int tpb = (NTOK_I + Gi - 1) / Gi, tok_lo = row0 + bxi * tpb, tok_hi = (tok_lo + tpb < row0 + NTOK_I) ? tok_lo + tpb : row0 + NTOK_I; \
    LAS int* L_hist = (LAS int*)((LAS unsigned char*)lds + LDSCTL_OFF + 256); LAS int* L_n = L_hist + 32; LAS int* L_base = L_hist + 64; LAS int* L_off = L_hist + 96; (void)L_n; (void)L_base; (void)L_off;
    if (PH(8)) { PTRS; ROUTE_VARS;
        constexpr int WRP = 2064;
        LAS unsigned char* L_wr = (LAS unsigned char*)lds;
        for (int i = tid; i < 32 * 128; i += NWAVES * 64) { const int r = i >> 7, c = i & 127; *(LAS u32x4*)(L_wr + r * WRP + c * 16) = *(const u32x4*)(w_r_t + (size_t)r * 1024 + c * 8); }
        LAS float* L_u = (LAS float*)((LAS unsigned char*)lds + LDSCTL_OFF + 2048) + 1024; LAS float* L_v = L_u + 32;
        if (tid < 64) L_u[tid] = ((const float*)(ws + WS_WR + 65536))[tid];
        if (tid < 32) L_hist[tid] = 0;
        LAS float* L_g = (LAS float*)((LAS unsigned char*)lds + 67584); LAS float* L_b = L_g + 1024;
        if (tid < 256) *(LAS f32x4*)(L_g + 4 * tid) = *(const f32x4*)(kin[14] + 4 * tid); else *(LAS f32x4*)(L_b + 4 * (tid - 256)) = *(const f32x4*)(kin[15] + 4 * (tid - 256));
        for (int i = gti; i < MOE_ROWS_I; i += ngti) row_tok[I * MOE_ROWS_I + i] = row0;
        __syncthreads();
        const int fr = lane & 15, fq = lane >> 4;
        float* ln1st = (float*)(ws + WS_LOGITS);
        for (int rb = tok_lo + wave * 16; rb < tok_hi; rb += NWAVES * 16) {
            const int row = rb + fr < NTOK ? rb + fr : NTOK - 1;
            const bf16* ap = y1 + (size_t)row * DM + fq * 8;
            bf16x8 a[32];
#pragma unroll
            for (int ks = 0; ks < 32; ++ks) a[ks] = *(const bf16x8*)(ap + ks * 32);
            const bool live = rb + fr < tok_hi; float s = 0.f;
#pragma unroll
            for (int ks = 0; ks < 32; ++ks) { float f[8]; unpack8(__builtin_bit_cast(u32x4, a[ks]), f); s += ((f[0] + f[1]) + (f[2] + f[3])) + ((f[4] + f[5]) + (f[6] + f[7])); }
            s += __shfl_xor(s, 16); s += __shfl_xor(s, 32);
            const float m_ = s * (1.f / DM); float s2 = 0.f;
#pragma unroll
            for (int ks = 0; ks < 32; ++ks) asm volatile("" : "+v"(a[ks]));
#pragma unroll
            for (int ks = 0; ks < 32; ++ks) { float f[8]; unpack8(__builtin_bit_cast(u32x4, a[ks]), f);
#pragma unroll
                for (int j = 0; j < 8; ++j) { const float d = f[j] - m_; s2 += d * d; } }
            s2 += __shfl_xor(s2, 16); s2 += __shfl_xor(s2, 32);
            const float r_ = rsq(s2 * (1.f / DM) + LN_EPS);
#pragma unroll
            for (int ks = 0; ks < 32; ++ks) asm volatile("" : "+v"(a[ks]));
            if (fq == 0 && live) *(f32x2*)(ln1st + (size_t)(rb + fr) * 2) = (f32x2){m_, r_};
            { unsigned char* o8 = h1f8 + (size_t)row * DM + fq * 8;
#pragma unroll
              for (int ks = 0; ks < 32; ++ks) { float f[8]; unpack8(__builtin_bit_cast(u32x4, a[ks]), f); const LAS float* gp = L_g + ks * 32 + fq * 8; const LAS float* bq = L_b + ks * 32 + fq * 8;
                  const f32x4 x0 = ((f32x4){f[0], f[1], f[2], f[3]} - m_) * r_ * *(const LAS f32x4*)gp + *(const LAS f32x4*)bq, x1 = ((f32x4){f[4], f[5], f[6], f[7]} - m_) * r_ * *(const LAS f32x4*)(gp + 4) + *(const LAS f32x4*)(bq + 4);
                  if (live) *(u32x2*)(o8 + ks * 32) = (u32x2){pack4_f8(x0[0], x0[1], x0[2], x0[3]), pack4_f8(x1[0], x1[1], x1[2], x1[3])}; } }
            f32x4 acc0 = {0.f, 0.f, 0.f, 0.f}, acc1 = {0.f, 0.f, 0.f, 0.f};
            const LAS unsigned char* bp = L_wr + (8 * (fr >> 2) + (fr & 3)) * WRP + fq * 16;
#pragma unroll
            for (int ks = 0; ks < 32; ++ks) { const bf16x8 b0 = *(const LAS bf16x8*)(bp + ks * 64), b1 = *(const LAS bf16x8*)(bp + 4 * WRP + ks * 64);
                acc0 = __builtin_amdgcn_mfma_f32_16x16x32_bf16(b0, a[ks], acc0, 0, 0, 0); acc1 = __builtin_amdgcn_mfma_f32_16x16x32_bf16(b1, a[ks], acc1, 0, 0, 0); }
            asm volatile("s_waitcnt lgkmcnt(0)" ::: "memory");
            const f32x4 u0 = *(const LAS f32x4*)(L_u + 8 * fq), u1 = *(const LAS f32x4*)(L_u + 8 * fq + 4), w0 = *(const LAS f32x4*)(L_v + 8 * fq), w1 = *(const LAS f32x4*)(L_v + 8 * fq + 4);
            float v[8] = {r_ * (acc0[0] - m_ * u0[0]) + w0[0], r_ * (acc0[1] - m_ * u0[1]) + w0[1], r_ * (acc0[2] - m_ * u0[2]) + w0[2], r_ * (acc0[3] - m_ * u0[3]) + w0[3],
                          r_ * (acc1[0] - m_ * u1[0]) + w1[0], r_ * (acc1[1] - m_ * u1[1]) + w1[1], r_ * (acc1[2] - m_ * u1[2]) + w1[2], r_ * (acc1[3] - m_ * u1[3]) + w1[3]};
            float tv[4]; int ti[4];
#pragma unroll
            for (int r = 0; r < 4; ++r) { float bv = v[0]; int bi = 8 * fq;
#pragma unroll
                for (int j = 1; j < 8; ++j) if (v[j] > bv) { bv = v[j]; bi = 8 * fq + j; }
#pragma unroll
                for (int off = 16; off <= 32; off <<= 1) { const float ov = __shfl_xor(bv, off); const int oi = __shfl_xor(bi, off); if (ov > bv || (ov == bv && oi < bi)) { bv = ov; bi = oi; } }
                tv[r] = bv; ti[r] = bi;
#pragma unroll
                for (int j = 0; j < 8; ++j) if (bi == 8 * fq + j) v[j] = -INFINITY; }
            const float e1 = __expf(tv[1] - tv[0]), e2 = __expf(tv[2] - tv[0]), e3 = __expf(tv[3] - tv[0]), inv = 1.f / (1.f + e1 + e2 + e3);
            if (fq == 0 && rb + fr < tok_hi) { const int t = rb + fr; *(int4*)(topk + (size_t)t * 4) = make_int4(ti[0], ti[1], ti[2], ti[3]); *(f32x4*)(gate + (size_t)t * 4) = (f32x4){inv, e1 * inv, e2 * inv, e3 * inv};
                atomicAdd((int*)(L_hist + ti[0]), 1); atomicAdd((int*)(L_hist + ti[1]), 1); atomicAdd((int*)(L_hist + ti[2]), 1); atomicAdd((int*)(L_hist + ti[3]), 1); }
        }
        __syncthreads();
        if (tid < 32) hist[bx * 32 + tid] = L_hist[tid];
    }
    if (PH(8)) { PTRS; if (I == 1) { LAS float* scr = (LAS float*)((LAS unsigned char*)lds + wave * 16384);
            transpose_f8_stream(kin[20], 1024, w_dn8, scr, gwi, ngwi, lane, MapId(), W8_SCALE, W_DN_A, (Gi - ((Gi > 70 ? 64 : 0) + 6) >= 32) ? W_DN_P3 : W_DN_LATE); } }
    if (lo <= 8) FULL_BAR();
    if (PH(10)) { PTRS; ROUTE_VARS; int* moetab_g = (int*)(ws + WS_MOETAB); int* tile_expert_g = moetab_g + 256;
        { LAS int* L_pt = (LAS int*)((LAS unsigned char*)lds + LDSCTL_OFF + 2048); LAS int* L_pb = L_pt + 512;
          const int e_ = tid & 31, c_ = tid >> 5, nb_ = (G + 15) >> 4; int tot = 0, before = 0;
          if (nb_ <= 16) { int hv_[16];
#pragma unroll
              for (int k = 0; k < 16; ++k) { const int b = c_ * nb_ + k; hv_[k] = (k < nb_ && b < G) ? hist[b * 32 + e_] : 0; }
#pragma unroll
              for (int k = 0; k < 16; ++k) { const int b = c_ * nb_ + k; tot += hv_[k]; if (b < bx) before += hv_[k]; } }
          else for (int b = c_ * nb_; b < (c_ + 1) * nb_ && b < G; ++b) { const int h = hist[b * 32 + e_]; tot += h; if (b < bx) before += h; }
          L_pt[tid] = tot; L_pb[tid] = before; }
        __syncthreads();
        if (tid < 32) { LAS int* L_pt = (LAS int*)((LAS unsigned char*)lds + LDSCTL_OFF + 2048); int tot = 0, before = 0;
#pragma unroll
            for (int c = 0; c < 16; ++c) { tot += L_pt[c * 32 + tid]; before += L_pt[512 + c * 32 + tid]; }
            L_n[tid] = tot; L_base[tid] = before; L_hist[tid] = 0;
            const int pad = (tot + 255) & ~255; int x = pad;
#pragma unroll
            for (int d = 1; d < 32; d <<= 1) { const int y = __shfl_up(x, d); if (tid >= d) x += y; }
            L_off[tid] = x - pad; if (tid == 31) L_off[NE] = x; }
        __syncthreads();
        for (int p = tok_lo * 4 + tid; p < tok_hi * 4; p += NWAVES * 64) { const int e = topk[p]; const float gv = gate[p]; const int r = atomicAdd((int*)(L_hist + e), 1); const int pos = L_off[e] + L_base[e] + r;
            row_gate[pos] = gv; pair_pos[p] = pos; row_tok[pos] = p >> 2; }
        __syncthreads();
        if (bx == 0) { if (tid == 0) moetab_g[0] = L_off[NE];
            if (tid < 32) { moetab_g[64 + tid] = L_n[tid]; moetab_g[128 + tid] = L_off[tid]; for (int t = L_off[tid] >> 8; t < (L_off[tid + 1] >> 8); ++t) tile_expert_g[t] = tid; } }
    }
    if (lo <= 10) FULL_BAR();
    if (PH(11)) { PTRS; const int* moetab_g = (const int*)(ws + WS_MOETAB); const int rows = moetab_g[0]; EpiGU8 E{act8, kin[19]};
        pg8::Gemm g{(const bf16*)h1f8, (const bf16*)w_gu8, rows, 2048, 512, 512, row_tok}; LAS int* L_te = (LAS int*)((LAS unsigned char*)lds + LDSCTL_OFF + 2048); for (int i = tid; i < MOE_TILES_MAX; i += NWAVES * 64) L_te[i] = moetab_g[256 + i]; __syncthreads();
        pg8::MoeOrder S; S.init(rows >> 8, 8, G, bx, L_te);
        pg8::gemm_phase<EpiGU8, pg8::MoeOrder, true, true, true, true>((LAS unsigned char*)lds, g, S, E);
        { const int rem = ((rows >> 8) * 8) % G, nidle = rem ? G - rem : 0, first = nidle >= 64 ? rem : 0, nconv = nidle >= 64 ? nidle : G;
          if (bx >= first) transpose_f8_stream(kin[20], 1024, w_dn8, (LAS float*)((LAS unsigned char*)lds + wave * 16384), (bx - first) * NWAVES + wave, nconv * NWAVES, lane, MapId(), W8_SCALE, W_DN_LATE, 32); }
    }
    if (lo <= 11) FULL_BAR();
    if (PH(12)) { PTRS; const int* moetab_g = (const int*)(ws + WS_MOETAB); const int rows = moetab_g[0]; EpiDN8 E{out2, kin[21], row_gate};
        pg8::Gemm g{(const bf16*)act8, (const bf16*)w_dn8, rows, 1024, 512, 512, nullptr}; LAS int* L_te = (LAS int*)((LAS unsigned char*)lds + LDSCTL_OFF + 2048); for (int i = tid; i < MOE_TILES_MAX; i += NWAVES * 64) L_te[i] = moetab_g[256 + i]; __syncthreads();
        pg8::MoeOrder S; S.init(rows >> 8, 4, G, bx, L_te);
        pg8::gemm_phase<EpiDN8, pg8::MoeOrder, true, true, true>((LAS unsigned char*)lds, g, S, E);
    }
    if (lo <= 12) FULL_BAR();
    if (PH(13)) { PTRS;
        f32x4 G4[4], B4[4];
        f32x4 G1[4], B1[4];
#pragma unroll
        for (int hf = 0; hf < 2; ++hf) { const int c = hf * 512 + 8 * lane; G1[2 * hf] = *(const f32x4*)(kin[14] + c); G1[2 * hf + 1] = *(const f32x4*)(kin[14] + c + 4); B1[2 * hf] = *(const f32x4*)(kin[15] + c); B1[2 * hf + 1] = *(const f32x4*)(kin[15] + c + 4); }
#pragma unroll
        for (int hf = 0; hf < 2; ++hf) { const int c = hf * 512 + 8 * lane; G4[2 * hf] = *(const f32x4*)(kin[22] + c); G4[2 * hf + 1] = *(const f32x4*)(kin[22] + c + 4); B4[2 * hf] = *(const f32x4*)(kin[23] + c); B4[2 * hf + 1] = *(const f32x4*)(kin[23] + c + 4); }
        const int t_end = NTOK;
        int4 pp = *(const int4*)(pair_pos + (size_t)gw * 4);
        for (int t = gw; t < t_end; t += ngw) {
            const int ps[4] = {pp.x, pp.y, pp.z, pp.w};
            u32x4 hv[2]; u32x2 ov[4][2];
#pragma unroll
            for (int hf = 0; hf < 2; ++hf) { hv[hf] = *(const u32x4*)(y1 + (size_t)t * DM + hf * 512 + 8 * lane);
#pragma unroll
                for (int s4 = 0; s4 < 4; ++s4) ov[s4][hf] = *(const u32x2*)(out2 + (size_t)ps[s4] * DM + hf * 512 + 8 * lane); }
            if (t + ngw < t_end) pp = *(const int4*)(pair_pos + (size_t)(t + ngw) * 4);
            const f32x2 st1 = *(const f32x2*)((const float*)(ws + WS_LOGITS) + (size_t)t * 2);
            float v[16];
#pragma unroll
            for (int hf = 0; hf < 2; ++hf) { float f[8]; unpack8(hv[hf], f);
#pragma unroll
                for (int j = 0; j < 8; ++j) f[j] = (f[j] - st1.x) * st1.y * G1[2 * hf + (j >> 2)][j & 3] + B1[2 * hf + (j >> 2)][j & 3];
                float acc8[8] = {0.f, 0.f, 0.f, 0.f, 0.f, 0.f, 0.f, 0.f};
#pragma unroll
                for (int s4 = 0; s4 < 4; ++s4) {
#pragma unroll
                    for (int w = 0; w < 2; ++w) { const unsigned d = w ? ov[s4][hf].y : ov[s4][hf].x;
                        const f32x2 lo = __builtin_amdgcn_cvt_pk_f32_fp8((int)d, false), hi2 = __builtin_amdgcn_cvt_pk_f32_fp8((int)d, true);
                        acc8[4 * w + 0] += lo[0]; acc8[4 * w + 1] += lo[1]; acc8[4 * w + 2] += hi2[0]; acc8[4 * w + 3] += hi2[1]; } }
#pragma unroll
                for (int j = 0; j < 8; ++j) v[hf * 8 + j] = ALPHA * f[j] + O2_INV * acc8[j]; }
            float s = 0.f;
#pragma unroll
            for (int j = 0; j < 16; ++j) s += v[j];
            const float mean = wave_sum(s) * (1.f / DM); float s2 = 0.f;
#pragma unroll
            for (int j = 0; j < 16; ++j) { v[j] -= mean; s2 += v[j] * v[j]; }
            const float rstd = rsq(wave_sum(s2) * (1.f / DM) + LN_EPS);
#pragma unroll
            for (int hf = 0; hf < 2; ++hf) { float* o = outp + (size_t)t * DM + hf * 512 + 8 * lane;
                *(f32x4*)o = (f32x4){v[hf * 8 + 0], v[hf * 8 + 1], v[hf * 8 + 2], v[hf * 8 + 3]} * rstd * G4[2 * hf] + B4[2 * hf];
                *(f32x4*)(o + 4) = (f32x4){v[hf * 8 + 4], v[hf * 8 + 5], v[hf * 8 + 6], v[hf * 8 + 7]} * rstd * G4[2 * hf + 1] + B4[2 * hf + 1]; }
        }
    }
}

extern "C" void kernel_launch(void* const* d_in, const int* in_sizes, int n_in, void* d_out, int out_size, void* d_ws, size_t ws_size, hipStream_t stream) {
    static int grid = 0;
    if (grid == 0) {
        if (n_in != 24 || in_sizes[0] != NTOK * DM || out_size != NTOK * DM || ws_size < WS_END) { fprintf(stderr, "kernel_launch: shape/workspace mismatch (n_in %d, ws %zu)\n", n_in, ws_size); grid = -1; return; }
        int dev = 0, cus = 0, per_cu = 0;
        if (hipGetDevice(&dev) != hipSuccess || hipDeviceGetAttribute(&cus, hipDeviceAttributeMultiprocessorCount, dev) != hipSuccess) { grid = -1; return; }
        if (hipFuncSetAttribute((const void*)hymba_fwd, hipFuncAttributeMaxDynamicSharedMemorySize, LDS_BYTES) != hipSuccess) { fprintf(stderr, "kernel_launch: hipFuncSetAttribute failed\n"); grid = -1; return; }
        if (hipOccupancyMaxActiveBlocksPerMultiprocessor(&per_cu, (const void*)hymba_fwd, NWAVES * 64, LDS_BYTES) != hipSuccess || per_cu < 1) fprintf(stderr, "kernel_launch: occupancy query says %d\n", per_cu);
        (void)hipGetLastError();
        grid = cus & ~15;
        if (grid < 16) { fprintf(stderr, "kernel_launch: %d CUs\n", cus); grid = -1; return; }
    }
    if (grid < 0) return;
    (void)hipMemsetAsync((char*)d_ws + WS_CTL, 0, CTL_ZERO_BYTES, stream);
    Args a{};
    for (int i = 0; i < 24; ++i) a.in[i] = (const float*)d_in[i];
    a.out = (float*)d_out; a.ws = (unsigned char*)d_ws;
    a.ph_lo = 0; a.ph_hi = NPHASE; hipLaunchKernelGGL(hymba_fwd, dim3(grid), dim3(NWAVES * 64), LDS_BYTES, stream, a);
#ifdef PROBE_RELAUNCH_LO
    a.ph_lo = PROBE_RELAUNCH_LO; a.bar_region = 1; hipLaunchKernelGGL(hymba_fwd, dim3(grid), dim3(NWAVES * 64), LDS_BYTES, stream, a);
#endif
}
```
